# Optimizing an MI355X kernel written in HIP

```python
import math
import jax, jax.numpy as jnp
from jax import lax
import numpy as np

D_MODEL = 1024
BATCH = 32
SEQ = 2048
DEPTH = 4

N_META = 16
ATTN_HEADS = 4
ATTN_DK = 64
ATTN_DV = 2 * ATTN_DK
ATTN_WIDTH = ATTN_HEADS * ATTN_DV
CONV_WIDTH = D_MODEL - ATTN_WIDTH
CONV_K = 3
MIX_WIDTH = ATTN_WIDTH + CONV_WIDTH
Q_COLS = ATTN_HEADS * 2 * ATTN_DK
K_COLS = Q_COLS
V_COLS = ATTN_WIDTH
IN_COLS = Q_COLS + K_COLS + V_COLS + 3 * CONV_WIDTH
Q_BLOCK = 128
REL_BUCKETS = 32
REL_MAX_DIST = 128
PEER_HEADS = 8
PEER_NKEYS = 128
PEER_N = PEER_NKEYS * PEER_NKEYS
PEER_DQ = 256
PEER_TOPK = 16
PEER_CHUNK = 256
DEEPNORM_ALPHA = (2 * DEPTH) ** 0.25
DEEPNORM_BETA = (8 * DEPTH) ** -0.25
LN_EPS = 1e-5
RMS_EPS = 1e-5
NEG_BIG = -1e30

kernel_name = "hymba_diffattn_shortconv_peer_deepnorm"


def layer_norm(x, g, b):
    xf = x.astype(jnp.float32)
    mu = xf.mean(-1, keepdims=True)
    var = jnp.square(xf - mu).mean(-1, keepdims=True)
    return ((xf - mu) * lax.rsqrt(var + LN_EPS) * g.astype(jnp.float32) + b.astype(jnp.float32)).astype(x.dtype)


def t5_bucket(qpos, kpos):
    n = jnp.maximum(qpos[:, None] - kpos[None, :], 0)
    max_exact = REL_BUCKETS // 2
    nf = jnp.maximum(n, 1).astype(jnp.float32)
    large = max_exact + (jnp.log(nf / max_exact) / math.log(REL_MAX_DIST / max_exact)
                         * (REL_BUCKETS - max_exact)).astype(jnp.int32)
    large = jnp.minimum(large, REL_BUCKETS - 1)
    return jnp.where(n < max_exact, n, large)


def diff_attn_block(qb, qpos, k, v, kpos, rel_bias, lam):
    logits = jnp.einsum('bqhmd,bkhmd->bhmqk', qb.astype(jnp.float32), k.astype(jnp.float32)) * (ATTN_DK ** -0.5)
    bias = rel_bias.astype(jnp.float32)[t5_bucket(qpos, kpos)]
    bias = jnp.transpose(bias, (2, 0, 1))[None, :, None]
    mask = kpos[None, :] <= qpos[:, None]
    logits = jnp.where(mask, logits + bias, NEG_BIG)
    p = jax.nn.softmax(logits, axis=-1)
    attn = p[:, :, 0] - lam * p[:, :, 1]
    return jnp.einsum('bhqk,bkhd->bqhd', attn, v.astype(jnp.float32))


def differential_attention(q, k, v, rel_bias, lam, subln_g, lam_init):
    Bn, L = q.shape[0], q.shape[1]
    kpos = jnp.arange(L, dtype=jnp.int32)
    mpos = jnp.arange(N_META, dtype=jnp.int32)
    out_meta = diff_attn_block(q[:, :N_META], mpos, k[:, :N_META], v[:, :N_META], mpos, rel_bias, lam)
    n_blk = (L - N_META) // Q_BLOCK
    q_real = q[:, N_META:].reshape(Bn, n_blk, Q_BLOCK, ATTN_HEADS, 2, ATTN_DK)
    q_real = jnp.moveaxis(q_real, 1, 0)

    def one_block(args):
        qb, bi = args
        qpos = N_META + bi * Q_BLOCK + jnp.arange(Q_BLOCK, dtype=jnp.int32)
        return diff_attn_block(qb, qpos, k, v, kpos, rel_bias, lam)

    out_real = lax.map(one_block, (q_real, jnp.arange(n_blk, dtype=jnp.int32)))
    out_real = jnp.moveaxis(out_real, 0, 1).reshape(Bn, L - N_META, ATTN_HEADS, ATTN_DV)
    out = jnp.concatenate([out_meta, out_real], axis=1)
    out = out * lax.rsqrt(jnp.square(out).mean(-1, keepdims=True) + RMS_EPS)
    out = out * subln_g.astype(jnp.float32) * (1.0 - lam_init)
    return out.reshape(Bn, L, ATTN_WIDTH).astype(q.dtype)


def short_conv(z, w):
    return lax.conv_general_dilated(z, w[:, None, :].astype(z.dtype), window_strides=(1,),
                                    padding=[(CONV_K - 1, 0)],
                                    dimension_numbers=('NWC', 'WIO', 'NWC'),
                                    feature_group_count=CONV_WIDTH)


def peer(x, w_q, sub_keys, u, v):
    Bn, L, _ = x.shape
    T = Bn * L
    n_chunks = -(-T // PEER_CHUNK)
    pad = n_chunks * PEER_CHUNK - T
    xt = jnp.pad(x.reshape(T, D_MODEL), ((0, pad), (0, 0))).reshape(n_chunks, PEER_CHUNK, D_MODEL)

    def one_chunk(xc):
        q = (xc @ w_q).reshape(PEER_CHUNK, PEER_HEADS, 2, PEER_DQ // 2)
        s = jnp.einsum('thpd,hpnd->thpn', q.astype(jnp.float32), sub_keys.astype(jnp.float32))
        s1, i1 = lax.top_k(s[:, :, 0], PEER_TOPK)
        s2, i2 = lax.top_k(s[:, :, 1], PEER_TOPK)
        cand = (s1[..., :, None] + s2[..., None, :]).reshape(PEER_CHUNK, PEER_HEADS, PEER_TOPK * PEER_TOPK)
        sc, ci = lax.top_k(cand, PEER_TOPK)
        idx = (jnp.take_along_axis(i1, ci // PEER_TOPK, axis=-1) * PEER_NKEYS
               + jnp.take_along_axis(i2, ci % PEER_TOPK, axis=-1))
        g = jax.nn.softmax(sc, axis=-1)
        ue = u[idx]
        ve = v[idx]
        act = jax.nn.gelu(jnp.einsum('td,thkd->thk', xc, ue), approximate=False)
        return jnp.einsum('thk,thkd->td', (g * act).astype(xc.dtype), ve)

    out = lax.map(one_chunk, xt)
    return out.reshape(n_chunks * PEER_CHUNK, D_MODEL)[:T].reshape(Bn, L, D_MODEL)


def setup_inputs(seed: int = 0) -> dict:
    key = jax.random.key(seed)
    ks = jax.random.split(key, 24)
    f32 = jnp.float32
    nrm = lambda k, shape, s: jax.random.normal(k, shape, f32) * s
    col_scale = jnp.concatenate([
        jnp.ones((Q_COLS + K_COLS,), f32), jnp.full((V_COLS,), DEEPNORM_BETA, f32),
        jnp.ones((2 * CONV_WIDTH,), f32), jnp.full((CONV_WIDTH,), DEEPNORM_BETA, f32)])
    return {
        "x": nrm(ks[0], (BATCH, SEQ, D_MODEL), 1.0),
        "meta_tokens": nrm(ks[1], (N_META, D_MODEL), 1.0),
        "ln_in_g": 1.0 + nrm(ks[2], (D_MODEL,), 0.02),
        "ln_in_b": nrm(ks[3], (D_MODEL,), 0.02),
        "rel_bias": nrm(ks[4], (REL_BUCKETS, ATTN_HEADS), 0.5),
        "w_in": nrm(ks[5], (DEPTH, D_MODEL, IN_COLS), D_MODEL ** -0.5) * col_scale,
        "conv_w": nrm(ks[6], (DEPTH, CONV_K, CONV_WIDTH), CONV_K ** -0.5),
        "lambda_q1": nrm(ks[7], (DEPTH, ATTN_DK), 0.1),
        "lambda_k1": nrm(ks[8], (DEPTH, ATTN_DK), 0.1),
        "lambda_q2": nrm(ks[9], (DEPTH, ATTN_DK), 0.1),
        "lambda_k2": nrm(ks[10], (DEPTH, ATTN_DK), 0.1),
        "subln_g": 1.0 + nrm(ks[11], (DEPTH, ATTN_DV), 0.02),
        "w_out": nrm(ks[12], (DEPTH, MIX_WIDTH, D_MODEL), MIX_WIDTH ** -0.5) * DEEPNORM_BETA,
        "ln1_g": 1.0 + nrm(ks[13], (DEPTH, D_MODEL), 0.02),
        "ln1_b": nrm(ks[14], (DEPTH, D_MODEL), 0.02),
        "peer_w_q": nrm(ks[15], (DEPTH, D_MODEL, PEER_HEADS * PEER_DQ), D_MODEL ** -0.5),
        "peer_sub_keys": nrm(ks[16], (DEPTH, PEER_HEADS, 2, PEER_NKEYS, PEER_DQ // 2), (PEER_DQ // 2) ** -0.5),
        "peer_u": nrm(ks[17], (DEPTH, PEER_N, D_MODEL), D_MODEL ** -0.5),
        "peer_v": nrm(ks[18], (DEPTH, PEER_N, D_MODEL), DEEPNORM_BETA * PEER_HEADS ** -0.5),
        "ln2_g": 1.0 + nrm(ks[19], (DEPTH, D_MODEL), 0.02),
        "ln2_b": nrm(ks[20], (DEPTH, D_MODEL), 0.02),
    }


def reference(x, meta_tokens, ln_in_g, ln_in_b, rel_bias, w_in, conv_w, lambda_q1, lambda_k1,
              lambda_q2, lambda_k2, subln_g, w_out, ln1_g, ln1_b, peer_w_q, peer_sub_keys,
              peer_u, peer_v, ln2_g, ln2_b):
    Bn = x.shape[0]
    meta = jnp.broadcast_to(meta_tokens[None].astype(x.dtype), (Bn, N_META, D_MODEL))
    h = jnp.concatenate([meta, x], axis=1)
    h = layer_norm(h, ln_in_g, ln_in_b)
    L = h.shape[1]
    splits = [Q_COLS, Q_COLS + K_COLS, Q_COLS + K_COLS + V_COLS,
              Q_COLS + K_COLS + V_COLS + CONV_WIDTH, Q_COLS + K_COLS + V_COLS + 2 * CONV_WIDTH]
    for l in range(DEPTH):
        lam_init = 0.8 - 0.6 * math.exp(-0.3 * l)
        lam = (jnp.exp(jnp.dot(lambda_q1[l].astype(jnp.float32), lambda_k1[l].astype(jnp.float32)))
               - jnp.exp(jnp.dot(lambda_q2[l].astype(jnp.float32), lambda_k2[l].astype(jnp.float32)))
               + lam_init)
        proj = h @ w_in[l]
        q, k, v, gb, gc, z = jnp.split(proj, splits, axis=-1)
        q = q.reshape(Bn, L, ATTN_HEADS, 2, ATTN_DK)
        k = k.reshape(Bn, L, ATTN_HEADS, 2, ATTN_DK)
        v = v.reshape(Bn, L, ATTN_HEADS, ATTN_DV)
        attn_out = differential_attention(q, k, v, rel_bias, lam, subln_g[l], lam_init)
        conv_out = gb * short_conv(gc * z, conv_w[l])
        mix = jnp.concatenate([attn_out, conv_out], axis=-1) @ w_out[l]
        h = layer_norm(DEEPNORM_ALPHA * h + mix, ln1_g[l], ln1_b[l])
        ffn = peer(h, peer_w_q[l], peer_sub_keys[l], peer_u[l], peer_v[l])
        h = layer_norm(DEEPNORM_ALPHA * h + ffn, ln2_g[l], ln2_b[l])
    return h[:, N_META:]
```

```cpp
#include <hip/hip_runtime.h>
#include <hip/hip_cooperative_groups.h>
#include <cstdio>
#include <cstdint>
namespace cg = cooperative_groups;

typedef unsigned short u16;
typedef __attribute__((ext_vector_type(8))) short bf16x8;
typedef __attribute__((ext_vector_type(4))) float f32x4;
typedef __attribute__((ext_vector_type(4))) unsigned u32x4;
typedef __attribute__((ext_vector_type(2))) unsigned u32x2;
#define DI __device__ __forceinline__

#define DM 1024
#define NBATCH 32
#define SEQ 2048
#define NMETA 16
#define LSEQ 2064
#define TTOK 66048
#define DEPTH 4
#define INC 3072
#define LP 2112
#define PEER_N 16384
#define NTHREADS 256
#define LDS_MISC 69632
#define LDS_BYTES 71680

#define ALPHA 1.681792830507429f
#define LOG2E 1.4426950408889634f

static constexpr size_t WS_WIN  = 0;
static constexpr size_t WS_WOUT = WS_WIN  + (size_t)4 * 3072 * 1024 * 2;
static constexpr size_t WS_WQB  = WS_WOUT + (size_t)4 * 1024 * 1024 * 2;
static constexpr size_t WS_SKB  = WS_WQB  + (size_t)4 * 1024 * 2048 * 2;
static constexpr size_t WS_WSC  = WS_SKB  + (size_t)4 * 16 * 128 * 128 * 2;
static constexpr size_t WS_UB   = WS_WSC  + (size_t)4 * 2048 * 1024 * 2;
static constexpr size_t WS_VB   = WS_UB   + (size_t)PEER_N * 1024 * 2;
static constexpr size_t WS_H    = WS_VB   + (size_t)PEER_N * 1024 * 2;
static constexpr size_t WS_MIX  = WS_H    + (size_t)TTOK * 1024 * 2;
static constexpr size_t WS_BIG  = WS_MIX  + (size_t)TTOK * 1024 * 2;
static constexpr size_t WS_VT   = WS_BIG  + (size_t)(TTOK + 64) * 3072 * 2;
static constexpr size_t WS_TK   = WS_VT   + (size_t)NBATCH * 4 * 128 * LP * 2;
static constexpr size_t WS_END  = WS_TK   + (size_t)TTOK * 256 * 4;

struct Params {
  const float* in[21];
  float* out;
  char* ws;
};
#define P_X(p) ((p).in[0])
#define P_META(p) ((p).in[1])
#define P_LN_IN_G(p) ((p).in[2])
#define P_LN_IN_B(p) ((p).in[3])
#define P_REL_BIAS(p) ((p).in[4])
#define P_W_IN(p) ((p).in[5])
#define P_CONV_W(p) ((p).in[6])
#define P_LQ1(p) ((p).in[7])
#define P_LK1(p) ((p).in[8])
#define P_LQ2(p) ((p).in[9])
#define P_LK2(p) ((p).in[10])
#define P_SUBLN_G(p) ((p).in[11])
#define P_W_OUT(p) ((p).in[12])
#define P_LN1_G(p) ((p).in[13])
#define P_LN1_B(p) ((p).in[14])
#define P_W_Q(p) ((p).in[15])
#define P_SUB_KEYS(p) ((p).in[16])
#define P_PEER_U(p) ((p).in[17])
#define P_PEER_V(p) ((p).in[18])
#define P_LN2_G(p) ((p).in[19])
#define P_LN2_B(p) ((p).in[20])
#define W_WIN(p) ((u16*)((p).ws + WS_WIN))
#define W_WOUT(p) ((u16*)((p).ws + WS_WOUT))
#define W_WQB(p) ((u16*)((p).ws + WS_WQB))
#define W_SKB(p) ((u16*)((p).ws + WS_SKB))
#define W_WSC(p) ((u16*)((p).ws + WS_WSC))
#define W_UB(p) ((u16*)((p).ws + WS_UB))
#define W_VB(p) ((u16*)((p).ws + WS_VB))
#define W_H(p) ((u16*)((p).ws + WS_H))
#define W_MIX(p) ((u16*)((p).ws + WS_MIX))
#define W_PROJ(p) ((u16*)((p).ws + WS_BIG))
#define W_Y(p) ((float*)((p).ws + WS_BIG))
#define W_VT(p) ((u16*)((p).ws + WS_VT))
#define W_TK(p) ((unsigned*)((p).ws + WS_TK))

DI u16 f2bf(float x) { unsigned u = __float_as_uint(x); u += 0x7fffu + ((u >> 16) & 1u); return (u16)(u >> 16); }
DI unsigned pack2(float a, float b) {
  unsigned ua = __float_as_uint(a), ub = __float_as_uint(b);
  ua += 0x7fffu + ((ua >> 16) & 1u); ub += 0x7fffu + ((ub >> 16) & 1u);
  return (ua >> 16) | (ub & 0xffff0000u);
}
DI float bflo(unsigned w) { return __uint_as_float(w << 16); }
DI float bfhi(unsigned w) { return __uint_as_float(w & 0xffff0000u); }
DI int otid() { int t = threadIdx.x; asm volatile("" : "+v"(t)); return t; }
#define DPP_ADD(v, ctrl) ((v) + __int_as_float(__builtin_amdgcn_update_dpp(0, __float_as_int(v), (ctrl), 0xf, 0xf, true)))
DI float wave_sum(float v) {
  v = DPP_ADD(v, 0xB1);
  v = DPP_ADD(v, 0x4E);
  v = DPP_ADD(v, 0x141);
  v = DPP_ADD(v, 0x140);
  const int iv = __float_as_int(v);
  return __int_as_float(__builtin_amdgcn_readlane(iv, 0)) + __int_as_float(__builtin_amdgcn_readlane(iv, 16)) +
         __int_as_float(__builtin_amdgcn_readlane(iv, 32)) + __int_as_float(__builtin_amdgcn_readlane(iv, 48));
}
DI float shx16(float v) { return __int_as_float(__builtin_amdgcn_ds_swizzle(__float_as_int(v), 0x401F)); }
DI float shx32(float v, int idx32) { return __int_as_float(__builtin_amdgcn_ds_bpermute(idx32, __float_as_int(v))); }
DI f32x4 mfma16(bf16x8 a, bf16x8 b, f32x4 c) { return __builtin_amdgcn_mfma_f32_16x16x32_bf16(a, b, c, 0, 0, 0); }
DI float fast_exp2(float x) { return __builtin_amdgcn_exp2f(x); }

DI void convert_straight(const float* __restrict__ src, u16* __restrict__ dst, size_t n8, size_t gtid, size_t gthreads) {
  for (size_t i = gtid; i < n8; i += gthreads) {
    const f32x4 a = *(const f32x4*)(src + i * 8), b = *(const f32x4*)(src + i * 8 + 4);
    u32x4 o; o[0] = pack2(a[0], a[1]); o[1] = pack2(a[2], a[3]); o[2] = pack2(b[0], b[1]); o[3] = pack2(b[2], b[3]);
    *(u32x4*)(dst + i * 8) = o;
  }
}

DI void transpose_tile(const float* __restrict__ src, int ldn, u16* __restrict__ dst, int ldk, int k0, int n0, float* sm) {
  const int tid = otid();
#pragma unroll
  for (int i = 0; i < 4; ++i) {
    const int r = (tid >> 4) + 16 * i, c4 = tid & 15;
    const f32x4 v = *(const f32x4*)(src + (size_t)(k0 + r) * ldn + n0 + 4 * c4);
    sm[r * 65 + 4 * c4 + 0] = v[0]; sm[r * 65 + 4 * c4 + 1] = v[1]; sm[r * 65 + 4 * c4 + 2] = v[2]; sm[r * 65 + 4 * c4 + 3] = v[3];
  }
  __syncthreads();
#pragma unroll
  for (int i = 0; i < 2; ++i) {
    const int n = (tid >> 3) + 32 * i, kc = tid & 7;
    u32x4 o;
#pragma unroll
    for (int e = 0; e < 4; ++e) o[e] = pack2(sm[(8 * kc + 2 * e) * 65 + n], sm[(8 * kc + 2 * e + 1) * 65 + n]);
    *(u32x4*)(dst + (size_t)(n0 + n) * ldk + k0 + 8 * kc) = o;
  }
  __syncthreads();
}

DI void ln_row(float (&v)[16], const float* __restrict__ g, const float* __restrict__ b, int lane) {
  float s = 0.f;
#pragma unroll
  for (int i = 0; i < 16; ++i) s += v[i];
  const float mu = wave_sum(s) * (1.0f / 1024.0f);
  float q = 0.f;
#pragma unroll
  for (int i = 0; i < 16; ++i) { const float d = v[i] - mu; q += d * d; }
  const float rstd = rsqrtf(wave_sum(q) * (1.0f / 1024.0f) + 1e-5f);
#pragma unroll
  for (int hh = 0; hh < 2; ++hh) {
    const int c = hh * 512 + 8 * lane;
    const f32x4 g0 = *(const f32x4*)(g + c), g1 = *(const f32x4*)(g + c + 4), b0 = *(const f32x4*)(b + c), b1 = *(const f32x4*)(b + c + 4);
#pragma unroll
    for (int e = 0; e < 4; ++e) {
      v[hh * 8 + e] = (v[hh * 8 + e] - mu) * rstd * g0[e] + b0[e];
      v[hh * 8 + 4 + e] = (v[hh * 8 + 4 + e] - mu) * rstd * g1[e] + b1[e];
    }
  }
}
DI void store_row_bf16(u16* __restrict__ dst, const float (&v)[16], int lane) {
#pragma unroll
  for (int hh = 0; hh < 2; ++hh) {
    u32x4 o;
#pragma unroll
    for (int e = 0; e < 4; ++e) o[e] = pack2(v[hh * 8 + 2 * e], v[hh * 8 + 2 * e + 1]);
    *(u32x4*)(dst + hh * 512 + 8 * lane) = o;
  }
}
DI void load_row_f32(const float* __restrict__ src, float (&v)[16], int lane) {
#pragma unroll
  for (int hh = 0; hh < 2; ++hh) {
    const f32x4 a = *(const f32x4*)(src + hh * 512 + 8 * lane), b = *(const f32x4*)(src + hh * 512 + 8 * lane + 4);
#pragma unroll
    for (int e = 0; e < 4; ++e) { v[hh * 8 + e] = a[e]; v[hh * 8 + 4 + e] = b[e]; }
  }
}

enum { EPI_PROJ = 0, EPI_VT = 1, EPI_OUT = 2, EPI_TOPK = 3, EPI_FOLD = 4 };

template <bool SWAP>
DI void gemm_mainloop(const u16* __restrict__ A, int lda, const u16* __restrict__ Bt, int ldb, int K, int m0, int n0, char* smem,
                      f32x4 (&acc)[4][4]) {
  const int tid = otid(), lane = tid & 63, wid = tid >> 6, wm = wid >> 1, wn = wid & 1;
  const int srow = tid >> 3, skc = tid & 7;
  const u16* ap = A + (size_t)(m0 + srow) * lda + skc * 8;
  const u16* bp = Bt + (size_t)(n0 + srow) * ldb + skc * 8;
  const int dst0 = (((srow >> 4) * 2 + (skc >> 2)) * 1024) + (((skc & 3) * 16 + (srow & 15)) * 16);
#pragma unroll
  for (int i = 0; i < 4; ++i)
#pragma unroll
    for (int j = 0; j < 4; ++j) acc[i][j] = (f32x4){0.f, 0.f, 0.f, 0.f};
  u32x4 ra[4], rb[4];
#pragma unroll
  for (int j = 0; j < 4; ++j) { ra[j] = *(const u32x4*)(ap + (size_t)j * 32 * lda); rb[j] = *(const u32x4*)(bp + (size_t)j * 32 * ldb); }
#pragma unroll
  for (int j = 0; j < 4; ++j) { *(u32x4*)(smem + dst0 + j * 4096) = ra[j]; *(u32x4*)(smem + 16384 + dst0 + j * 4096) = rb[j]; }
  __syncthreads();
  const int KT = K >> 6;
  for (int kt = 0; kt < KT; ++kt) {
    char* cur = smem + (kt & 1) * 32768;
    char* nxt = smem + ((kt + 1) & 1) * 32768;
    const bool more = (kt + 1 < KT);
    if (more) {
      const u16* ap2 = ap + (kt + 1) * 64;
      const u16* bp2 = bp + (kt + 1) * 64;
#pragma unroll
      for (int j = 0; j < 4; ++j) { ra[j] = *(const u32x4*)(ap2 + (size_t)j * 32 * lda); rb[j] = *(const u32x4*)(bp2 + (size_t)j * 32 * ldb); }
    }
#pragma unroll
    for (int ks = 0; ks < 2; ++ks) {
      bf16x8 af[4], bfr[4];
#pragma unroll
      for (int i = 0; i < 4; ++i) af[i] = *(const bf16x8*)(cur + (((wm * 4 + i) * 2 + ks) * 1024) + lane * 16);
#pragma unroll
      for (int j = 0; j < 4; ++j) bfr[j] = *(const bf16x8*)(cur + 16384 + (((wn * 4 + j) * 2 + ks) * 1024) + lane * 16);
#pragma unroll
      for (int i = 0; i < 4; ++i)
#pragma unroll
        for (int j = 0; j < 4; ++j) acc[i][j] = SWAP ? mfma16(bfr[j], af[i], acc[i][j]) : mfma16(af[i], bfr[j], acc[i][j]);
    }
    if (more) {
#pragma unroll
      for (int j = 0; j < 4; ++j) { *(u32x4*)(nxt + dst0 + j * 4096) = ra[j]; *(u32x4*)(nxt + 16384 + dst0 + j * 4096) = rb[j]; }
    }
    __syncthreads();
  }
}

DI void insert16(float (&v)[16], float x) {
#pragma unroll
  for (int j = 0; j < 16; ++j) { const float hi = fmaxf(v[j], x); x = fminf(v[j], x); v[j] = hi; }
}

DI void gemm_tile_T(const Params& p, int mode, const u16* A, int lda, const u16* Bt, int ldb, int K, int m0, int n0, char* smem, u16* dstT) {
  const int tid = otid(), lane = tid & 63, wid = tid >> 6, wm = wid >> 1, wn = wid & 1, g = lane >> 4, l15 = lane & 15;
  f32x4 acc[4][4];
  gemm_mainloop<false>(A, lda, Bt, ldb, K, m0, n0, smem, acc);
#pragma unroll
  for (int i = 0; i < 4; ++i)
#pragma unroll
    for (int j = 0; j < 4; ++j) {
      const int m = m0 + wm * 64 + 16 * i + 4 * g, n = n0 + wn * 64 + 16 * j + l15;
      u32x2 o; o[0] = pack2(acc[i][j][0], acc[i][j][1]); o[1] = pack2(acc[i][j][2], acc[i][j][3]);
      if (mode == EPI_VT) {
        const int b = m / LSEQ, pos = m - b * LSEQ, nn = n - 1024;
        *(u32x2*)(W_VT(p) + ((size_t)(b * 512 + nn)) * LP + pos) = o;
      } else {
        *(u32x2*)(dstT + (size_t)n * 1024 + m) = o;
      }
    }
}

DI void gemm_tile_N(const Params& p, int mode, const u16* A, int lda, const u16* Bt, int ldb, int K, int m0, int n0, char* smem) {
  const int tid = otid(), lane = tid & 63, wid = tid >> 6, wm = wid >> 1, wn = wid & 1, g = lane >> 4, l15 = lane & 15;
  f32x4 acc[4][4];
  gemm_mainloop<true>(A, lda, Bt, ldb, K, m0, n0, smem, acc);
  if (mode == EPI_PROJ) {
#pragma unroll
    for (int i = 0; i < 4; ++i)
#pragma unroll
      for (int j = 0; j < 4; ++j) {
        const int m = m0 + wm * 64 + 16 * i + l15, n = n0 + wn * 64 + 16 * j + 4 * g;
        u32x2 o; o[0] = pack2(acc[i][j][0], acc[i][j][1]); o[1] = pack2(acc[i][j][2], acc[i][j][3]);
        *(u32x2*)(W_PROJ(p) + (size_t)m * INC + n) = o;
      }
  } else if (mode == EPI_OUT) {
#pragma unroll
    for (int i = 0; i < 4; ++i)
#pragma unroll
      for (int j = 0; j < 4; ++j) {
        const int m = m0 + wm * 64 + 16 * i + l15, n = n0 + wn * 64 + 16 * j + 4 * g;
        const u32x2 hv = *(const u32x2*)(W_H(p) + (size_t)m * DM + n);
        f32x4 o;
        o[0] = ALPHA * bflo(hv[0]) + acc[i][j][0]; o[1] = ALPHA * bfhi(hv[0]) + acc[i][j][1];
        o[2] = ALPHA * bflo(hv[1]) + acc[i][j][2]; o[3] = ALPHA * bfhi(hv[1]) + acc[i][j][3];
        *(f32x4*)(W_Y(p) + (size_t)m * DM + n) = o;
      }
  } else {
    float* S = (float*)smem;
#pragma unroll
    for (int i = 0; i < 4; ++i)
#pragma unroll
      for (int j = 0; j < 4; ++j) {
        const int tt = wm * 64 + 16 * i + l15, n = wn * 64 + 16 * j + 4 * g;
#pragma unroll
        for (int r = 0; r < 4; ++r) S[tt * 128 + ((n + r + tt) & 127)] = acc[i][j][r];
      }
    __syncthreads();
    const int tt = tid & 127, half = tid >> 7;
    float v[16];
#pragma unroll
    for (int j = 0; j < 16; ++j) v[j] = -3.0e38f;
    for (int i = 0; i < 64; ++i) {
      const int n = half * 64 + i;
      const float x = S[tt * 128 + ((n + tt) & 127)];
      insert16(v, __uint_as_float((__float_as_uint(x) & ~127u) | (unsigned)n));
    }
    __syncthreads();
    if (half == 1) {
#pragma unroll
      for (int j = 0; j < 16; ++j) S[tt * 16 + j] = v[j];
    }
    __syncthreads();
    if (half == 0) {
#pragma unroll
      for (int j = 0; j < 16; ++j) insert16(v, S[tt * 16 + j]);
      unsigned* dst = W_TK(p) + (size_t)(m0 + tt) * 256 + (n0 >> 7) * 16;
#pragma unroll
      for (int q = 0; q < 4; ++q) {
        u32x4 o;
#pragma unroll
        for (int e = 0; e < 4; ++e) o[e] = __float_as_uint(v[4 * q + e]);
        *(u32x4*)(dst + 4 * q) = o;
      }
    }
    __syncthreads();
  }
}

DI void attn_item(const Params& p, int layer, int b, int hh, int qb, char* smem, float lam, float oml) {
  const int tid = otid(), lane = tid & 63, w = tid >> 6, g = lane >> 4, l15 = lane & 15;
  const int idx32 = (lane ^ 32) << 2;
  float* tab = (float*)(smem + LDS_MISC);
  float* sg = tab + 128;
  __syncthreads();
  if (tid < 128) {
    int bucket = tid;
    if (tid >= 16) {
      int lg = 16 + (int)(logf((float)tid * (1.0f / 16.0f)) / 2.0794415416798357f * 16.0f);
      bucket = lg < 31 ? lg : 31;
    }
    tab[tid] = P_REL_BIAS(p)[bucket * 4 + hh] * LOG2E;
    sg[tid] = P_SUBLN_G(p)[layer * 128 + tid] * oml;
  }
  const int qpos = 64 * qb + 16 * w + l15;
  const int qrow = b * LSEQ + (qpos < LSEQ ? qpos : LSEQ - 1);
  bf16x8 qf[2][2];
  {
    const u16* qp = W_PROJ(p) + (size_t)qrow * INC + hh * 128 + g * 8;
#pragma unroll
    for (int m = 0; m < 2; ++m)
#pragma unroll
      for (int ks = 0; ks < 2; ++ks) qf[m][ks] = *(const bf16x8*)(qp + m * 64 + ks * 32);
  }
  const int nkt = qb + 1;
  const int kkey = tid >> 4, kc = tid & 15;
  const u16* ksrc = W_PROJ(p) + (size_t)(b * LSEQ + kkey) * INC + 512 + hh * 128 + kc * 8;
  const int kdst0 = ((((kc >> 3) * 2 + ((kc >> 2) & 1)) * 1024) + (((kc & 3) * 16 + kkey) * 16));
  const int vdv = tid >> 3, vc = tid & 7;
  const u16* vsrc = W_VT(p) + ((size_t)((b * 4 + hh) * 128 + vdv)) * LP + vc * 8;
  const int vdst0 = vdv * 144 + vc * 16;
  char* Kb = smem;
  char* Vb = smem + 32768;

  u32x4 rk[4], rv[4];
#pragma unroll
  for (int j = 0; j < 4; ++j) { rk[j] = *(const u32x4*)(ksrc + (size_t)(16 * j) * INC); rv[j] = *(const u32x4*)(vsrc + (size_t)(32 * j) * LP); }
#pragma unroll
  for (int j = 0; j < 4; ++j) { *(u32x4*)(Kb + kdst0 + j * 4096) = rk[j]; *(u32x4*)(Vb + vdst0 + j * 4608) = rv[j]; }
  __syncthreads();

  f32x4 O[2][8];
#pragma unroll
  for (int m = 0; m < 2; ++m)
#pragma unroll
    for (int dt = 0; dt < 8; ++dt) O[m][dt] = (f32x4){0.f, 0.f, 0.f, 0.f};
  float mrun[2] = {-1.0e30f, -1.0e30f}, lsum[2] = {0.f, 0.f};
  const float tfar = tab[127];

  for (int kt = 0; kt < nkt; ++kt) {
    const int cur = kt & 1;
    const bool more = (kt + 1 < nkt);
    if (more) {
#pragma unroll
      for (int j = 0; j < 4; ++j) {
        rk[j] = *(const u32x4*)(ksrc + (size_t)(64 * (kt + 1) + 16 * j) * INC);
        rv[j] = *(const u32x4*)(vsrc + (size_t)(32 * j) * LP + 64 * (kt + 1));
      }
    }
    const char* kb = Kb + cur * 16384;
    const char* vb = Vb + cur * 18432;
    f32x4 S[2][4];
#pragma unroll
    for (int k16 = 0; k16 < 4; ++k16)
#pragma unroll
      for (int m = 0; m < 2; ++m) {
        f32x4 s = (f32x4){0.f, 0.f, 0.f, 0.f};
#pragma unroll
        for (int ks = 0; ks < 2; ++ks) {
          const bf16x8 a = *(const bf16x8*)(kb + (((k16 * 2 + m) * 2 + ks) * 1024) + lane * 16);
          s = mfma16(a, qf[m][ks], s);
        }
        S[m][k16] = s;
      }
    const bool near = (qb - kt) <= 2;
#pragma unroll
    for (int m = 0; m < 2; ++m)
#pragma unroll
      for (int k16 = 0; k16 < 4; ++k16)
#pragma unroll
        for (int r = 0; r < 4; ++r) {
          float s = S[m][k16][r] * (0.125f * LOG2E);
          if (near) {
            const int dist = qpos - (64 * kt + 16 * k16 + 4 * g + r);
            s = dist < 0 ? -1.0e30f : s + tab[dist < 127 ? dist : 127];
          } else {
            s += tfar;
          }
          S[m][k16][r] = s;
        }
    bf16x8 pb[2][2];
#pragma unroll
    for (int m = 0; m < 2; ++m) {
      float mx = -1.0e30f;
#pragma unroll
      for (int k16 = 0; k16 < 4; ++k16)
#pragma unroll
        for (int r = 0; r < 4; ++r) mx = fmaxf(mx, S[m][k16][r]);
      mx = fmaxf(mx, shx16(mx));
      mx = fmaxf(mx, shx32(mx, idx32));
      const float mnew = fmaxf(mrun[m], mx);
      const float alpha = fast_exp2(mrun[m] - mnew);
      mrun[m] = mnew;
      float ps = 0.f;
#pragma unroll
      for (int k16 = 0; k16 < 4; ++k16)
#pragma unroll
        for (int r = 0; r < 4; ++r) { const float e = fast_exp2(S[m][k16][r] - mnew); S[m][k16][r] = e; ps += e; }
      lsum[m] = lsum[m] * alpha + ps;
#pragma unroll
      for (int dt = 0; dt < 8; ++dt) { O[m][dt][0] *= alpha; O[m][dt][1] *= alpha; O[m][dt][2] *= alpha; O[m][dt][3] *= alpha; }
#pragma unroll
      for (int kk = 0; kk < 2; ++kk) {
        u32x4 t;
        t[0] = pack2(S[m][2 * kk][0], S[m][2 * kk][1]); t[1] = pack2(S[m][2 * kk][2], S[m][2 * kk][3]);
        t[2] = pack2(S[m][2 * kk + 1][0], S[m][2 * kk + 1][1]); t[3] = pack2(S[m][2 * kk + 1][2], S[m][2 * kk + 1][3]);
        pb[m][kk] = __builtin_bit_cast(bf16x8, t);
      }
    }
#pragma unroll
    for (int kk = 0; kk < 2; ++kk)
#pragma unroll
      for (int dt = 0; dt < 8; ++dt) {
        const char* va = vb + (16 * dt + l15) * 144 + (32 * kk + 4 * g) * 2;
        const u32x2 lo = *(const u32x2*)(va), hi = *(const u32x2*)(va + 32);
        u32x4 t; t[0] = lo[0]; t[1] = lo[1]; t[2] = hi[0]; t[3] = hi[1];
        const bf16x8 a = __builtin_bit_cast(bf16x8, t);
        O[0][dt] = mfma16(a, pb[0][kk], O[0][dt]);
        O[1][dt] = mfma16(a, pb[1][kk], O[1][dt]);
      }
    if (more) {
#pragma unroll
      for (int j = 0; j < 4; ++j) {
        *(u32x4*)(Kb + (cur ^ 1) * 16384 + kdst0 + j * 4096) = rk[j];
        *(u32x4*)(Vb + (cur ^ 1) * 18432 + vdst0 + j * 4608) = rv[j];
      }
    }
    __syncthreads();
  }
  float l0 = lsum[0], l1 = lsum[1];
  l0 += shx16(l0); l0 += shx32(l0, idx32);
  l1 += shx16(l1); l1 += shx32(l1, idx32);
  const float c1 = 1.0f / l0, c2 = lam / l1;
  float ss = 0.f;
#pragma unroll
  for (int dt = 0; dt < 8; ++dt)
#pragma unroll
    for (int r = 0; r < 4; ++r) { const float o = O[0][dt][r] * c1 - O[1][dt][r] * c2; O[0][dt][r] = o; ss += o * o; }
  ss += shx16(ss); ss += shx32(ss, idx32);
  const float rinv = rsqrtf(ss * (1.0f / 128.0f) + 1e-5f);
  if (qpos < LSEQ) {
    u16* dst = W_MIX(p) + (size_t)(b * LSEQ + qpos) * DM + hh * 128 + 4 * g;
#pragma unroll
    for (int dt = 0; dt < 8; ++dt) {
      const int dv0 = 16 * dt + 4 * g;
      u32x2 o;
      o[0] = pack2(O[0][dt][0] * rinv * sg[dv0 + 0], O[0][dt][1] * rinv * sg[dv0 + 1]);
      o[1] = pack2(O[0][dt][2] * rinv * sg[dv0 + 2], O[0][dt][3] * rinv * sg[dv0 + 3]);
      *(u32x2*)(dst + 16 * dt) = o;
    }
  }
}

DI void conv_item(const Params& p, int layer, int item) {
  const int tid = otid(), ch = (tid & 63) * 8;
  const float* cw = P_CONV_W(p) + (size_t)layer * 3 * 512;
  float w0[8], w1[8], w2[8];
#pragma unroll
  for (int e = 0; e < 8; ++e) { w0[e] = cw[ch + e]; w1[e] = cw[512 + ch + e]; w2[e] = cw[1024 + ch + e]; }
#pragma unroll
  for (int i = 0; i < 4; ++i) {
    const int t = item * 16 + (tid >> 6) + 4 * i;
    const int pos = t % LSEQ;
    const u16* row = W_PROJ(p) + (size_t)t * INC;
    float accv[8];
#pragma unroll
    for (int e = 0; e < 8; ++e) accv[e] = 0.f;
#pragma unroll
    for (int d = 0; d < 3; ++d) {
      if (pos - 2 + d >= 0) {
        const u16* r2 = row - (size_t)(2 - d) * INC;
        const u32x4 gc = *(const u32x4*)(r2 + 2048 + ch), zz = *(const u32x4*)(r2 + 2560 + ch);
#pragma unroll
        for (int e = 0; e < 4; ++e) {
          const float wlo = d == 0 ? w0[2 * e] : (d == 1 ? w1[2 * e] : w2[2 * e]);
          const float whi = d == 0 ? w0[2 * e + 1] : (d == 1 ? w1[2 * e + 1] : w2[2 * e + 1]);
          accv[2 * e] += wlo * (bflo(gc[e]) * bflo(zz[e]));
          accv[2 * e + 1] += whi * (bfhi(gc[e]) * bfhi(zz[e]));
        }
      }
    }
    const u32x4 gb = *(const u32x4*)(row + 1536 + ch);
    u32x4 o;
#pragma unroll
    for (int e = 0; e < 4; ++e) o[e] = pack2(bflo(gb[e]) * accv[2 * e], bfhi(gb[e]) * accv[2 * e + 1]);
    *(u32x4*)(W_MIX(p) + (size_t)t * DM + 512 + ch) = o;
  }
}

DI void peer_item(const Params& p, int layer, int item, char* smem) {
  const int tid = otid(), lane = tid & 63, w = tid >> 6;
  unsigned* tkl = (unsigned*)smem;
  int* pe_idx = (int*)(smem + 16384);
  float* pe_g = (float*)(smem + 24576);
  const int t0 = item * 16;
  __syncthreads();
  {
    const u32x4* src = (const u32x4*)(W_TK(p) + (size_t)t0 * 256);
#pragma unroll
    for (int i = 0; i < 4; ++i) ((u32x4*)tkl)[tid + 256 * i] = src[tid + 256 * i];
  }
  __syncthreads();
  if (tid < 128) {
    const int tt = tid >> 3, hh = tid & 7;
    const unsigned* L1 = tkl + tt * 256 + (2 * hh) * 16;
    const unsigned* L2 = L1 + 16;
    float s1[16], s2[16], v[16];
#pragma unroll
    for (int j = 0; j < 16; ++j) { s1[j] = __uint_as_float(L1[j] & ~127u); s2[j] = __uint_as_float(L2[j] & ~127u); v[j] = -3.0e38f; }
#pragma unroll
    for (int a = 0; a < 16; ++a)
#pragma unroll
      for (int bb = 0; bb < 16 / (a + 1); ++bb) {
        const float s = s1[a] + s2[bb];
        insert16(v, __uint_as_float((__float_as_uint(s) & ~255u) | (unsigned)(a * 16 + bb)));
      }
    float e[16], sum = 0.f;
    const float mx = __uint_as_float(__float_as_uint(v[0]) & ~255u);
#pragma unroll
    for (int j = 0; j < 16; ++j) { e[j] = __expf(__uint_as_float(__float_as_uint(v[j]) & ~255u) - mx); sum += e[j]; }
    const float inv = 1.0f / sum;
#pragma unroll
    for (int j = 0; j < 16; ++j) {
      const unsigned code = __float_as_uint(v[j]) & 255u;
      const int i1 = (int)(L1[code >> 4] & 127u), i2 = (int)(L2[code & 15u] & 127u);
      pe_idx[tt * 128 + hh * 16 + j] = i1 * 128 + i2;
      pe_g[tt * 128 + hh * 16 + j] = e[j] * inv;
    }
  }
  __syncthreads();
  const u16* ub = W_UB(p);
  const u16* vbt = W_VB(p);
  for (int q = 0; q < 4; ++q) {
    const int tt = w * 4 + q, t = t0 + tt;
    float xf[16];
    {
      const u32x4 a = *(const u32x4*)(W_H(p) + (size_t)t * DM + 8 * lane), c = *(const u32x4*)(W_H(p) + (size_t)t * DM + 512 + 8 * lane);
#pragma unroll
      for (int e = 0; e < 4; ++e) { xf[2 * e] = bflo(a[e]); xf[2 * e + 1] = bfhi(a[e]); xf[8 + 2 * e] = bflo(c[e]); xf[8 + 2 * e + 1] = bfhi(c[e]); }
    }
    const int idxA = pe_idx[tt * 128 + lane], idxB = pe_idx[tt * 128 + 64 + lane];
    const float gA = pe_g[tt * 128 + lane], gB = pe_g[tt * 128 + 64 + lane];
    float actA = 0.f, actB = 0.f;
#pragma unroll 1
    for (int jb = 0; jb < 128; jb += 8) {
      u32x4 r0[8], r1[8];
#pragma unroll
      for (int u = 0; u < 8; ++u) {
        const int e = __builtin_amdgcn_readlane(jb < 64 ? idxA : idxB, (jb + u) & 63);
        const u16* row = ub + (size_t)e * DM + 8 * lane;
        r0[u] = *(const u32x4*)(row); r1[u] = *(const u32x4*)(row + 512);
      }
#pragma unroll
      for (int u = 0; u < 8; ++u) {
        float d = 0.f;
#pragma unroll
        for (int e = 0; e < 4; ++e) {
          d += xf[2 * e] * bflo(r0[u][e]) + xf[2 * e + 1] * bfhi(r0[u][e]);
          d += xf[8 + 2 * e] * bflo(r1[u][e]) + xf[8 + 2 * e + 1] * bfhi(r1[u][e]);
        }
        d = wave_sum(d);
        if (lane == ((jb + u) & 63)) { if (jb < 64) actA = d; else actB = d; }
      }
    }
    const float wA = gA * (0.5f * actA * (1.0f + erff(actA * 0.7071067811865476f)));
    const float wB = gB * (0.5f * actB * (1.0f + erff(actB * 0.7071067811865476f)));
    float acc[16];
#pragma unroll
    for (int i = 0; i < 16; ++i) acc[i] = 0.f;
#pragma unroll 1
    for (int jb = 0; jb < 128; jb += 8) {
      u32x4 r0[8], r1[8];
      float wj[8];
#pragma unroll
      for (int u = 0; u < 8; ++u) {
        const int e = __builtin_amdgcn_readlane(jb < 64 ? idxA : idxB, (jb + u) & 63);
        wj[u] = __int_as_float(__builtin_amdgcn_readlane(__float_as_int(jb < 64 ? wA : wB), (jb + u) & 63));
        const u16* row = vbt + (size_t)e * DM + 8 * lane;
        r0[u] = *(const u32x4*)(row); r1[u] = *(const u32x4*)(row + 512);
      }
#pragma unroll
      for (int u = 0; u < 8; ++u) {
#pragma unroll
        for (int e = 0; e < 4; ++e) {
          acc[2 * e] += wj[u] * bflo(r0[u][e]); acc[2 * e + 1] += wj[u] * bfhi(r0[u][e]);
          acc[8 + 2 * e] += wj[u] * bflo(r1[u][e]); acc[8 + 2 * e + 1] += wj[u] * bfhi(r1[u][e]);
        }
      }
    }
#pragma unroll
    for (int i = 0; i < 16; ++i) acc[i] += ALPHA * xf[i];
    ln_row(acc, P_LN2_G(p) + layer * DM, P_LN2_B(p) + layer * DM, lane);
    if (layer == DEPTH - 1) {
      const int b = t / LSEQ, pos = t - b * LSEQ;
      if (pos >= NMETA) {
        float* dst = p.out + ((size_t)b * SEQ + pos - NMETA) * DM;
#pragma unroll
        for (int hh = 0; hh < 2; ++hh) {
          *(f32x4*)(dst + hh * 512 + 8 * lane) = (f32x4){acc[hh * 8], acc[hh * 8 + 1], acc[hh * 8 + 2], acc[hh * 8 + 3]};
          *(f32x4*)(dst + hh * 512 + 8 * lane + 4) = (f32x4){acc[hh * 8 + 4], acc[hh * 8 + 5], acc[hh * 8 + 6], acc[hh * 8 + 7]};
        }
      }
    } else {
      store_row_bf16(W_H(p) + (size_t)t * DM, acc, lane);
    }
  }
}

DI void phase_prologue(const Params& p, char* smem) {
  const int tid = otid(), lane = tid & 63, wid = tid >> 6;
  const int nblk = gridDim.x, bid = blockIdx.x;
  const size_t gtid = (size_t)bid * NTHREADS + tid, gthreads = (size_t)nblk * NTHREADS;
  for (int it = bid; it < 3072 + 1024; it += nblk) {
    if (it < 3072) {
      const int l = it / 768, r = it % 768, kb = r / 48, nb = r % 48;
      transpose_tile(P_W_IN(p) + (size_t)l * 1024 * 3072, 3072, W_WIN(p) + (size_t)l * 3072 * 1024, 1024, kb * 64, nb * 64, (float*)smem);
    } else {
      const int i2 = it - 3072, l = i2 / 256, r = i2 % 256, kb = r / 16, nb = r % 16;
      transpose_tile(P_W_OUT(p) + (size_t)l * 1024 * 1024, 1024, W_WOUT(p) + (size_t)l * 1024 * 1024, 1024, kb * 64, nb * 64, (float*)smem);
    }
  }
  convert_straight(P_W_Q(p), W_WQB(p), (size_t)4 * 1024 * 2048 / 8, gtid, gthreads);
  convert_straight(P_SUB_KEYS(p), W_SKB(p), (size_t)4 * 16 * 128 * 128 / 8, gtid, gthreads);
  for (int t = bid * 4 + wid; t < TTOK; t += nblk * 4) {
    const int b = t / LSEQ, pos = t - b * LSEQ;
    const float* src = pos < NMETA ? P_META(p) + (size_t)pos * DM : P_X(p) + ((size_t)b * SEQ + pos - NMETA) * DM;
    float v[16];
    load_row_f32(src, v, lane);
    ln_row(v, P_LN_IN_G(p), P_LN_IN_B(p), lane);
    store_row_bf16(W_H(p) + (size_t)t * DM, v, lane);
  }
}

DI void phase_fold(const Params& p, char* smem) {
  for (int it = blockIdx.x; it < 4 * 16 * 8; it += gridDim.x) {
    const int l = it >> 7, hp = (it >> 3) & 15, mt = it & 7;
    gemm_tile_T(p, EPI_FOLD, W_WQB(p) + (size_t)l * 1024 * 2048 + hp * 128, 2048, W_SKB(p) + ((size_t)l * 16 + hp) * 128 * 128, 128, 128, mt * 128, 0, smem,
                W_WSC(p) + (size_t)l * 2048 * 1024 + (size_t)hp * 128 * 1024);
  }
}

DI void phase_proj(const Params& p, int layer, char* smem) {
  const u16* Bt = W_WIN(p) + (size_t)layer * 3072 * 1024;
  for (int tile = blockIdx.x; tile < 516 * 24; tile += gridDim.x) {
    const int mt = tile / 24, nt = tile % 24;
    if (nt >= 8 && nt < 12) gemm_tile_T(p, EPI_VT, W_H(p), DM, Bt, DM, DM, mt * 128, nt * 128, smem, nullptr);
    else gemm_tile_N(p, EPI_PROJ, W_H(p), DM, Bt, DM, DM, mt * 128, nt * 128, smem);
  }
}

DI void phase_attn(const Params& p, int layer, char* smem) {
  const int lane = otid() & 63;
  const float lam_init = 0.8f - 0.6f * expf(-0.3f * (float)layer);
  float d1 = P_LQ1(p)[layer * 64 + lane] * P_LK1(p)[layer * 64 + lane], d2 = P_LQ2(p)[layer * 64 + lane] * P_LK2(p)[layer * 64 + lane];
  d1 = wave_sum(d1); d2 = wave_sum(d2);
  const float lam = expf(d1) - expf(d2) + lam_init;
  for (int it = blockIdx.x; it < 4224 + 4128; it += gridDim.x) {
    if (it < 4224) {
      const int qb = 32 - (it >> 7), bh = it & 127;
      attn_item(p, layer, bh >> 2, bh & 3, qb, smem, lam, 1.0f - lam_init);
    } else {
      conv_item(p, layer, it - 4224);
    }
  }
}

DI void phase_out(const Params& p, int layer, char* smem) {
  const u16* Bt = W_WOUT(p) + (size_t)layer * 1024 * 1024;
  for (int tile = blockIdx.x; tile < 516 * 8; tile += gridDim.x) {
    const int mt = tile / 8, nt = tile % 8;
    gemm_tile_N(p, EPI_OUT, W_MIX(p), DM, Bt, DM, DM, mt * 128, nt * 128, smem);
  }
}

DI void phase_ln1(const Params& p, int layer) {
  const int tid = otid(), lane = tid & 63, wid = tid >> 6;
  const int nblk = gridDim.x, bid = blockIdx.x;
  const size_t gtid = (size_t)bid * NTHREADS + tid, gthreads = (size_t)nblk * NTHREADS;
  for (int t = bid * 4 + wid; t < TTOK; t += nblk * 4) {
    float v[16];
    load_row_f32(W_Y(p) + (size_t)t * DM, v, lane);
    ln_row(v, P_LN1_G(p) + layer * DM, P_LN1_B(p) + layer * DM, lane);
    store_row_bf16(W_H(p) + (size_t)t * DM, v, lane);
  }
  convert_straight(P_PEER_U(p) + (size_t)layer * PEER_N * DM, W_UB(p), (size_t)PEER_N * DM / 8, gtid, gthreads);
  convert_straight(P_PEER_V(p) + (size_t)layer * PEER_N * DM, W_VB(p), (size_t)PEER_N * DM / 8, gtid, gthreads);
}

DI void phase_scores(const Params& p, int layer, char* smem) {
  const u16* Bt = W_WSC(p) + (size_t)layer * 2048 * 1024;
  for (int tile = blockIdx.x; tile < 516 * 16; tile += gridDim.x) {
    const int mt = tile / 16, nt = tile % 16;
    gemm_tile_N(p, EPI_TOPK, W_H(p), DM, Bt, DM, DM, mt * 128, nt * 128, smem);
  }
}

__global__ void __launch_bounds__(NTHREADS, 2) mega(Params p) {
  extern __shared__ __attribute__((aligned(16))) char smem[];
  cg::grid_group grid = cg::this_grid();
  phase_prologue(p, smem);
  grid.sync();
  phase_fold(p, smem);
#pragma unroll 1
  for (int layer = 0; layer < DEPTH; ++layer) {
    phase_proj(p, layer, smem);
    grid.sync();
    phase_attn(p, layer, smem);
    grid.sync();
    phase_out(p, layer, smem);
    grid.sync();
    phase_ln1(p, layer);
    grid.sync();
    phase_scores(p, layer, smem);
    grid.sync();
    for (int it = blockIdx.x; it < TTOK / 16; it += gridDim.x) peer_item(p, layer, it, smem);
    grid.sync();
  }
}

extern "C" void kernel_launch(void* const* d_in, const int* in_sizes, int n_in, void* d_out, int out_size, void* d_ws, size_t ws_size,
                              hipStream_t stream) {
  static int grid_blocks = 0;
  if (grid_blocks == 0) {
    if (ws_size < WS_END) { fprintf(stderr, "kernel_launch: workspace too small: need %zu, got %zu\n", (size_t)WS_END, ws_size); grid_blocks = -1; return; }
    int dev = 0, cus = 0, per_cu = 0;
    hipGetDevice(&dev);
    hipDeviceGetAttribute(&cus, hipDeviceAttributeMultiprocessorCount, dev);
    hipFuncSetAttribute((const void*)mega, hipFuncAttributeMaxDynamicSharedMemorySize, LDS_BYTES);
    hipOccupancyMaxActiveBlocksPerMultiprocessor(&per_cu, (const void*)mega, NTHREADS, LDS_BYTES);
    if (per_cu < 1) per_cu = 1;
    if (per_cu > 2) per_cu = 2;
    grid_blocks = cus * per_cu;
  }
  if (grid_blocks < 0) return;
  Params p{};
  for (int i = 0; i < 21; ++i) p.in[i] = (const float*)d_in[i];
  p.out = (float*)d_out;
  p.ws = (char*)d_ws;
  void* args[] = {&p};
  hipError_t e = hipLaunchCooperativeKernel((const void*)mega, dim3(grid_blocks), dim3(NTHREADS), args, LDS_BYTES, stream);
  if (e != hipSuccess) fprintf(stderr, "cooperative launch failed: %s (grid %d)\n", hipGetErrorString(e), grid_blocks);
}
```

```cpp
#include <hip/hip_runtime.h>
#include <hip/hip_cooperative_groups.h>
#include <cstdio>
#include <cstdint>
namespace cg = cooperative_groups;

typedef unsigned short u16;
typedef __attribute__((ext_vector_type(8))) short bf16x8;
typedef __attribute__((ext_vector_type(4))) float f32x4;
typedef __attribute__((ext_vector_type(4))) unsigned u32x4;
typedef __attribute__((ext_vector_type(2))) unsigned u32x2;
typedef __attribute__((ext_vector_type(2))) float f32x2;
#define DI __device__ __forceinline__

#define DM 1024
#define NBATCH 32
#define SEQ 2048
#define NMETA 16
#define LSEQ 2064
#define TTOK 66048
#define DEPTH 4
#define INC 3072
#define LP 2112
#define PEER_N 16384
#define NTHREADS 256
#define LDS_MISC 69632
#define LDS_BYTES 71680

#define ALPHA 1.681792830507429f
#define LOG2E 1.4426950408889634f

static constexpr size_t WS_WIN  = 0;
static constexpr size_t WS_WOUT = WS_WIN  + (size_t)4 * 3072 * 1024 * 2;
static constexpr size_t WS_WQB  = WS_WOUT + (size_t)4 * 1024 * 1024 * 2;
static constexpr size_t WS_SKB  = WS_WQB  + (size_t)4 * 1024 * 2048 * 2;
static constexpr size_t WS_WSC  = WS_SKB  + (size_t)4 * 16 * 128 * 128 * 2;
static constexpr size_t WS_UB   = WS_WSC  + (size_t)4 * 2048 * 1024 * 2;
static constexpr size_t WS_VB   = WS_UB   + (size_t)PEER_N * 1024;
static constexpr size_t WS_SU   = WS_VB   + (size_t)PEER_N * 1024;
static constexpr size_t WS_SV   = WS_SU   + (size_t)PEER_N * 4;
static constexpr size_t WS_H    = WS_SV   + (size_t)PEER_N * 4;
static constexpr size_t WS_MIX  = WS_H    + (size_t)TTOK * 1024 * 2;
static constexpr size_t WS_BIG  = WS_MIX  + (size_t)TTOK * 1024 * 2;
static constexpr size_t WS_VT   = WS_BIG  + (size_t)(TTOK + 64) * 3072 * 2;
static constexpr size_t WS_TK   = WS_VT   + (size_t)NBATCH * 4 * 128 * LP * 2;
static constexpr size_t WS_END  = WS_TK   + (size_t)TTOK * 256 * 4;

struct Params {
  const float* in[21];
  float* out;
  char* ws;
};
#define P_X(p) ((p).in[0])
#define P_META(p) ((p).in[1])
#define P_LN_IN_G(p) ((p).in[2])
#define P_LN_IN_B(p) ((p).in[3])
#define P_REL_BIAS(p) ((p).in[4])
#define P_W_IN(p) ((p).in[5])
#define P_CONV_W(p) ((p).in[6])
#define P_LQ1(p) ((p).in[7])
#define P_LK1(p) ((p).in[8])
#define P_LQ2(p) ((p).in[9])
#define P_LK2(p) ((p).in[10])
#define P_SUBLN_G(p) ((p).in[11])
#define P_W_OUT(p) ((p).in[12])
#define P_LN1_G(p) ((p).in[13])
#define P_LN1_B(p) ((p).in[14])
#define P_W_Q(p) ((p).in[15])
#define P_SUB_KEYS(p) ((p).in[16])
#define P_PEER_U(p) ((p).in[17])
#define P_PEER_V(p) ((p).in[18])
#define P_LN2_G(p) ((p).in[19])
#define P_LN2_B(p) ((p).in[20])
#define W_WIN(p) ((u16*)((p).ws + WS_WIN))
#define W_WOUT(p) ((u16*)((p).ws + WS_WOUT))
#define W_WQB(p) ((u16*)((p).ws + WS_WQB))
#define W_SKB(p) ((u16*)((p).ws + WS_SKB))
#define W_WSC(p) ((u16*)((p).ws + WS_WSC))
#define W_UB(p) ((unsigned char*)((p).ws + WS_UB))
#define W_VB(p) ((unsigned char*)((p).ws + WS_VB))
#define W_SU(p) ((float*)((p).ws + WS_SU))
#define W_SV(p) ((float*)((p).ws + WS_SV))
#define W_H(p) ((u16*)((p).ws + WS_H))
#define W_MIX(p) ((u16*)((p).ws + WS_MIX))
#define W_PROJ(p) ((u16*)((p).ws + WS_BIG))
#define W_Y(p) ((float*)((p).ws + WS_BIG))
#define W_VT(p) ((u16*)((p).ws + WS_VT))
#define W_TK(p) ((unsigned*)((p).ws + WS_TK))

DI u16 f2bf(float x) { unsigned u = __float_as_uint(x); u += 0x7fffu + ((u >> 16) & 1u); return (u16)(u >> 16); }
DI unsigned pack2(float a, float b) {
  unsigned ua = __float_as_uint(a), ub = __float_as_uint(b);
  ua += 0x7fffu + ((ua >> 16) & 1u); ub += 0x7fffu + ((ub >> 16) & 1u);
  return (ua >> 16) | (ub & 0xffff0000u);
}
DI float bflo(unsigned w) { return __uint_as_float(w << 16); }
DI float bfhi(unsigned w) { return __uint_as_float(w & 0xffff0000u); }
DI int otid() { int t = threadIdx.x; asm volatile("" : "+v"(t)); return t; }
#define DPP_ADD(v, ctrl) ((v) + __int_as_float(__builtin_amdgcn_update_dpp(0, __float_as_int(v), (ctrl), 0xf, 0xf, true)))
DI float wave_sum(float v) {
  v = DPP_ADD(v, 0xB1);
  v = DPP_ADD(v, 0x4E);
  v = DPP_ADD(v, 0x141);
  v = DPP_ADD(v, 0x140);
  const int iv = __float_as_int(v);
  return __int_as_float(__builtin_amdgcn_readlane(iv, 0)) + __int_as_float(__builtin_amdgcn_readlane(iv, 16)) +
         __int_as_float(__builtin_amdgcn_readlane(iv, 32)) + __int_as_float(__builtin_amdgcn_readlane(iv, 48));
}
#define DPP_MAX(v, ctrl) fmaxf((v), __int_as_float(__builtin_amdgcn_update_dpp(0, __float_as_int(v), (ctrl), 0xf, 0xf, true)))
DI float wave_max_nonneg(float v) {
  v = DPP_MAX(v, 0xB1); v = DPP_MAX(v, 0x4E); v = DPP_MAX(v, 0x141); v = DPP_MAX(v, 0x140);
  const int iv = __float_as_int(v);
  return fmaxf(fmaxf(__int_as_float(__builtin_amdgcn_readlane(iv, 0)), __int_as_float(__builtin_amdgcn_readlane(iv, 16))),
               fmaxf(__int_as_float(__builtin_amdgcn_readlane(iv, 32)), __int_as_float(__builtin_amdgcn_readlane(iv, 48))));
}
DI float shx16(float v) { return __int_as_float(__builtin_amdgcn_ds_swizzle(__float_as_int(v), 0x401F)); }
DI float shx32(float v, int idx32) { return __int_as_float(__builtin_amdgcn_ds_bpermute(idx32, __float_as_int(v))); }
DI f32x4 mfma16(bf16x8 a, bf16x8 b, f32x4 c) { return __builtin_amdgcn_mfma_f32_16x16x32_bf16(a, b, c, 0, 0, 0); }
DI float fast_exp2(float x) { return __builtin_amdgcn_exp2f(x); }

DI void convert_straight(const float* __restrict__ src, u16* __restrict__ dst, size_t n8, size_t gtid, size_t gthreads) {
  for (size_t i = gtid; i < n8; i += gthreads) {
    const f32x4 a = *(const f32x4*)(src + i * 8), b = *(const f32x4*)(src + i * 8 + 4);
    u32x4 o; o[0] = pack2(a[0], a[1]); o[1] = pack2(a[2], a[3]); o[2] = pack2(b[0], b[1]); o[3] = pack2(b[2], b[3]);
    *(u32x4*)(dst + i * 8) = o;
  }
}

DI void transpose_tile(const float* __restrict__ src, int ldn, u16* __restrict__ dst, int ldk, int k0, int n0, float* sm) {
  const int tid = otid();
#pragma unroll
  for (int i = 0; i < 4; ++i) {
    const int r = (tid >> 4) + 16 * i, c4 = tid & 15;
    const f32x4 v = *(const f32x4*)(src + (size_t)(k0 + r) * ldn + n0 + 4 * c4);
    sm[r * 65 + 4 * c4 + 0] = v[0]; sm[r * 65 + 4 * c4 + 1] = v[1]; sm[r * 65 + 4 * c4 + 2] = v[2]; sm[r * 65 + 4 * c4 + 3] = v[3];
  }
  __syncthreads();
#pragma unroll
  for (int i = 0; i < 2; ++i) {
    const int n = (tid >> 3) + 32 * i, kc = tid & 7;
    u32x4 o;
#pragma unroll
    for (int e = 0; e < 4; ++e) o[e] = pack2(sm[(8 * kc + 2 * e) * 65 + n], sm[(8 * kc + 2 * e + 1) * 65 + n]);
    *(u32x4*)(dst + (size_t)(n0 + n) * ldk + k0 + 8 * kc) = o;
  }
  __syncthreads();
}

template <int LAYOUT> DI int col0(int lane, int hh) { return LAYOUT ? 16 * lane + 8 * hh : hh * 512 + 8 * lane; }
template <int LAYOUT>
DI void ln_row(float (&v)[16], const float* __restrict__ g, const float* __restrict__ b, int lane) {
  float s = 0.f;
#pragma unroll
  for (int i = 0; i < 16; ++i) s += v[i];
  const float mu = wave_sum(s) * (1.0f / 1024.0f);
  float q = 0.f;
#pragma unroll
  for (int i = 0; i < 16; ++i) { const float d = v[i] - mu; q += d * d; }
  const float rstd = rsqrtf(wave_sum(q) * (1.0f / 1024.0f) + 1e-5f);
#pragma unroll
  for (int hh = 0; hh < 2; ++hh) {
    const int c = col0<LAYOUT>(lane, hh);
    const f32x4 g0 = *(const f32x4*)(g + c), g1 = *(const f32x4*)(g + c + 4), b0 = *(const f32x4*)(b + c), b1 = *(const f32x4*)(b + c + 4);
#pragma unroll
    for (int e = 0; e < 4; ++e) {
      v[hh * 8 + e] = (v[hh * 8 + e] - mu) * rstd * g0[e] + b0[e];
      v[hh * 8 + 4 + e] = (v[hh * 8 + 4 + e] - mu) * rstd * g1[e] + b1[e];
    }
  }
}
template <int LAYOUT>
DI void store_row_bf16(u16* __restrict__ dst, const float (&v)[16], int lane) {
#pragma unroll
  for (int hh = 0; hh < 2; ++hh) {
    u32x4 o;
#pragma unroll
    for (int e = 0; e < 4; ++e) o[e] = pack2(v[hh * 8 + 2 * e], v[hh * 8 + 2 * e + 1]);
    *(u32x4*)(dst + col0<LAYOUT>(lane, hh)) = o;
  }
}
template <int LAYOUT>
DI void load_row_f32(const float* __restrict__ src, float (&v)[16], int lane) {
#pragma unroll
  for (int hh = 0; hh < 2; ++hh) {
    const int c = col0<LAYOUT>(lane, hh);
    const f32x4 a = *(const f32x4*)(src + c), b = *(const f32x4*)(src + c + 4);
#pragma unroll
    for (int e = 0; e < 4; ++e) { v[hh * 8 + e] = a[e]; v[hh * 8 + 4 + e] = b[e]; }
  }
}

enum { EPI_PROJ = 0, EPI_VT = 1, EPI_OUT = 2, EPI_TOPK = 3, EPI_FOLD = 4 };

template <bool SWAP>
DI void gemm_mainloop(const u16* __restrict__ A, int lda, const u16* __restrict__ Bt, int ldb, int K, int m0, int n0, char* smem,
                      f32x4 (&acc)[4][4]) {
  const int tid = otid(), lane = tid & 63, wid = tid >> 6, wm = wid >> 1, wn = wid & 1;
  const int srow = tid >> 3, skc = tid & 7;
  const u16* ap = A + (size_t)(m0 + srow) * lda + skc * 8;
  const u16* bp = Bt + (size_t)(n0 + srow) * ldb + skc * 8;
  const int dst0 = (((srow >> 4) * 2 + (skc >> 2)) * 1024) + (((skc & 3) * 16 + (srow & 15)) * 16);
#pragma unroll
  for (int i = 0; i < 4; ++i)
#pragma unroll
    for (int j = 0; j < 4; ++j) acc[i][j] = (f32x4){0.f, 0.f, 0.f, 0.f};
  u32x4 ra[4], rb[4];
#pragma unroll
  for (int j = 0; j < 4; ++j) { ra[j] = *(const u32x4*)(ap + (size_t)j * 32 * lda); rb[j] = *(const u32x4*)(bp + (size_t)j * 32 * ldb); }
#pragma unroll
  for (int j = 0; j < 4; ++j) { *(u32x4*)(smem + dst0 + j * 4096) = ra[j]; *(u32x4*)(smem + 16384 + dst0 + j * 4096) = rb[j]; }
  __syncthreads();
  const int KT = K >> 6;
  for (int kt = 0; kt < KT; ++kt) {
    char* cur = smem + (kt & 1) * 32768;
    char* nxt = smem + ((kt + 1) & 1) * 32768;
    const bool more = (kt + 1 < KT);
    if (more) {
      const u16* ap2 = ap + (kt + 1) * 64;
      const u16* bp2 = bp + (kt + 1) * 64;
#pragma unroll
      for (int j = 0; j < 4; ++j) { ra[j] = *(const u32x4*)(ap2 + (size_t)j * 32 * lda); rb[j] = *(const u32x4*)(bp2 + (size_t)j * 32 * ldb); }
    }
#pragma unroll
    for (int ks = 0; ks < 2; ++ks) {
      bf16x8 af[4], bfr[4];
#pragma unroll
      for (int i = 0; i < 4; ++i) af[i] = *(const bf16x8*)(cur + (((wm * 4 + i) * 2 + ks) * 1024) + lane * 16);
#pragma unroll
      for (int j = 0; j < 4; ++j) bfr[j] = *(const bf16x8*)(cur + 16384 + (((wn * 4 + j) * 2 + ks) * 1024) + lane * 16);
#pragma unroll
      for (int i = 0; i < 4; ++i)
#pragma unroll
        for (int j = 0; j < 4; ++j) acc[i][j] = SWAP ? mfma16(bfr[j], af[i], acc[i][j]) : mfma16(af[i], bfr[j], acc[i][j]);
    }
    if (more) {
#pragma unroll
      for (int j = 0; j < 4; ++j) { *(u32x4*)(nxt + dst0 + j * 4096) = ra[j]; *(u32x4*)(nxt + 16384 + dst0 + j * 4096) = rb[j]; }
    }
    __syncthreads();
  }
}

DI void insert16(float (&v)[16], float x) {
#pragma unroll
  for (int j = 0; j < 16; ++j) { const float hi = fmaxf(v[j], x); x = fminf(v[j], x); v[j] = hi; }
}

DI void gemm_tile_T(const Params& p, int mode, const u16* A, int lda, const u16* Bt, int ldb, int K, int m0, int n0, char* smem, u16* dstT) {
  const int tid = otid(), lane = tid & 63, wid = tid >> 6, wm = wid >> 1, wn = wid & 1, g = lane >> 4, l15 = lane & 15;
  f32x4 acc[4][4];
  gemm_mainloop<false>(A, lda, Bt, ldb, K, m0, n0, smem, acc);
#pragma unroll
  for (int i = 0; i < 4; ++i)
#pragma unroll
    for (int j = 0; j < 4; ++j) {
      const int m = m0 + wm * 64 + 16 * i + 4 * g, n = n0 + wn * 64 + 16 * j + l15;
      u32x2 o; o[0] = pack2(acc[i][j][0], acc[i][j][1]); o[1] = pack2(acc[i][j][2], acc[i][j][3]);
      if (mode == EPI_VT) {
        const int b = m / LSEQ, pos = m - b * LSEQ, nn = n - 1024;
        *(u32x2*)(W_VT(p) + ((size_t)(b * 512 + nn)) * LP + pos) = o;
      } else {
        *(u32x2*)(dstT + (size_t)n * 1024 + m) = o;
      }
    }
}

DI void gemm_tile_N(const Params& p, int mode, const u16* A, int lda, const u16* Bt, int ldb, int K, int m0, int n0, char* smem) {
  const int tid = otid(), lane = tid & 63, wid = tid >> 6, wm = wid >> 1, wn = wid & 1, g = lane >> 4, l15 = lane & 15;
  f32x4 acc[4][4];
  gemm_mainloop<true>(A, lda, Bt, ldb, K, m0, n0, smem, acc);
  if (mode == EPI_PROJ) {
#pragma unroll
    for (int i = 0; i < 4; ++i)
#pragma unroll
      for (int j = 0; j < 4; ++j) {
        const int m = m0 + wm * 64 + 16 * i + l15, n = n0 + wn * 64 + 16 * j + 4 * g;
        u32x2 o; o[0] = pack2(acc[i][j][0], acc[i][j][1]); o[1] = pack2(acc[i][j][2], acc[i][j][3]);
        *(u32x2*)(W_PROJ(p) + (size_t)m * INC + n) = o;
      }
  } else if (mode == EPI_OUT) {
#pragma unroll
    for (int i = 0; i < 4; ++i)
#pragma unroll
      for (int j = 0; j < 4; ++j) {
        const int m = m0 + wm * 64 + 16 * i + l15, n = n0 + wn * 64 + 16 * j + 4 * g;
        const u32x2 hv = *(const u32x2*)(W_H(p) + (size_t)m * DM + n);
        f32x4 o;
        o[0] = ALPHA * bflo(hv[0]) + acc[i][j][0]; o[1] = ALPHA * bfhi(hv[0]) + acc[i][j][1];
        o[2] = ALPHA * bflo(hv[1]) + acc[i][j][2]; o[3] = ALPHA * bfhi(hv[1]) + acc[i][j][3];
        *(f32x4*)(W_Y(p) + (size_t)m * DM + n) = o;
      }
  } else {
    float* S = (float*)smem;
#pragma unroll
    for (int i = 0; i < 4; ++i)
#pragma unroll
      for (int j = 0; j < 4; ++j) {
        const int tt = wm * 64 + 16 * i + l15, n = wn * 64 + 16 * j + 4 * g;
#pragma unroll
        for (int r = 0; r < 4; ++r) S[tt * 128 + ((n + r + tt) & 127)] = acc[i][j][r];
      }
    __syncthreads();
    const int tt = tid & 127, half = tid >> 7;
    float v[16];
#pragma unroll
    for (int j = 0; j < 16; ++j) v[j] = -3.0e38f;
    for (int i = 0; i < 64; ++i) {
      const int n = half * 64 + i;
      const float x = S[tt * 128 + ((n + tt) & 127)];
      insert16(v, __uint_as_float((__float_as_uint(x) & ~127u) | (unsigned)n));
    }
    __syncthreads();
    if (half == 1) {
#pragma unroll
      for (int j = 0; j < 16; ++j) S[tt * 16 + j] = v[j];
    }
    __syncthreads();
    if (half == 0) {
#pragma unroll
      for (int j = 0; j < 16; ++j) insert16(v, S[tt * 16 + j]);
      unsigned* dst = W_TK(p) + (size_t)(m0 + tt) * 256 + (n0 >> 7) * 16;
#pragma unroll
      for (int q = 0; q < 4; ++q) {
        u32x4 o;
#pragma unroll
        for (int e = 0; e < 4; ++e) o[e] = __float_as_uint(v[4 * q + e]);
        *(u32x4*)(dst + 4 * q) = o;
      }
    }
    __syncthreads();
  }
}

DI void attn_item(const Params& p, int layer, int b, int hh, int qb, char* smem, float lam, float oml) {
  const int tid = otid(), lane = tid & 63, w = tid >> 6, g = lane >> 4, l15 = lane & 15;
  const int idx32 = (lane ^ 32) << 2;
  float* tab = (float*)(smem + LDS_MISC);
  float* sg = tab + 128;
  __syncthreads();
  if (tid < 128) {
    int bucket = tid;
    if (tid >= 16) {
      int lg = 16 + (int)(logf((float)tid * (1.0f / 16.0f)) / 2.0794415416798357f * 16.0f);
      bucket = lg < 31 ? lg : 31;
    }
    tab[tid] = P_REL_BIAS(p)[bucket * 4 + hh] * LOG2E;
    sg[tid] = P_SUBLN_G(p)[layer * 128 + tid] * oml;
  }
  const int qpos = 64 * qb + 16 * w + l15;
  const int qrow = b * LSEQ + (qpos < LSEQ ? qpos : LSEQ - 1);
  bf16x8 qf[2][2];
  {
    const u16* qp = W_PROJ(p) + (size_t)qrow * INC + hh * 128 + g * 8;
#pragma unroll
    for (int m = 0; m < 2; ++m)
#pragma unroll
      for (int ks = 0; ks < 2; ++ks) qf[m][ks] = *(const bf16x8*)(qp + m * 64 + ks * 32);
  }
  const int nkt = qb + 1;
  const int kkey = tid >> 4, kc = tid & 15;
  const u16* ksrc = W_PROJ(p) + (size_t)(b * LSEQ + kkey) * INC + 512 + hh * 128 + kc * 8;
  const int kdst0 = ((((kc >> 3) * 2 + ((kc >> 2) & 1)) * 1024) + (((kc & 3) * 16 + kkey) * 16));
  const int vdv = tid >> 3, vc = tid & 7;
  const u16* vsrc = W_VT(p) + ((size_t)((b * 4 + hh) * 128 + vdv)) * LP + vc * 8;
  const int vdst0 = vdv * 144 + vc * 16;
  char* Kb = smem;
  char* Vb = smem + 32768;

  u32x4 rk[4], rv[4];
#pragma unroll
  for (int j = 0; j < 4; ++j) { rk[j] = *(const u32x4*)(ksrc + (size_t)(16 * j) * INC); rv[j] = *(const u32x4*)(vsrc + (size_t)(32 * j) * LP); }
#pragma unroll
  for (int j = 0; j < 4; ++j) { *(u32x4*)(Kb + kdst0 + j * 4096) = rk[j]; *(u32x4*)(Vb + vdst0 + j * 4608) = rv[j]; }
  __syncthreads();

  f32x4 O[2][8];
#pragma unroll
  for (int m = 0; m < 2; ++m)
#pragma unroll
    for (int dt = 0; dt < 8; ++dt) O[m][dt] = (f32x4){0.f, 0.f, 0.f, 0.f};
  float mrun[2] = {-1.0e30f, -1.0e30f}, lsum[2] = {0.f, 0.f};
  const float tfar = tab[127];

  for (int kt = 0; kt < nkt; ++kt) {
    const int cur = kt & 1;
    const bool more = (kt + 1 < nkt);
    if (more) {
#pragma unroll
      for (int j = 0; j < 4; ++j) {
        rk[j] = *(const u32x4*)(ksrc + (size_t)(64 * (kt + 1) + 16 * j) * INC);
        rv[j] = *(const u32x4*)(vsrc + (size_t)(32 * j) * LP + 64 * (kt + 1));
      }
    }
    const char* kb = Kb + cur * 16384;
    const char* vb = Vb + cur * 18432;
    f32x4 S[2][4];
#pragma unroll
    for (int k16 = 0; k16 < 4; ++k16)
#pragma unroll
      for (int m = 0; m < 2; ++m) {
        f32x4 s = (f32x4){0.f, 0.f, 0.f, 0.f};
#pragma unroll
        for (int ks = 0; ks < 2; ++ks) {
          const bf16x8 a = *(const bf16x8*)(kb + (((k16 * 2 + m) * 2 + ks) * 1024) + lane * 16);
          s = mfma16(a, qf[m][ks], s);
        }
        S[m][k16] = s;
      }
    const bool near = (qb - kt) <= 2;
#pragma unroll
    for (int m = 0; m < 2; ++m)
#pragma unroll
      for (int k16 = 0; k16 < 4; ++k16)
#pragma unroll
        for (int r = 0; r < 4; ++r) {
          float s = S[m][k16][r] * (0.125f * LOG2E);
          if (near) {
            const int dist = qpos - (64 * kt + 16 * k16 + 4 * g + r);
            s = dist < 0 ? -1.0e30f : s + tab[dist < 127 ? dist : 127];
          } else {
            s += tfar;
          }
          S[m][k16][r] = s;
        }
    bf16x8 pb[2][2];
#pragma unroll
    for (int m = 0; m < 2; ++m) {
      float mx = -1.0e30f;
#pragma unroll
      for (int k16 = 0; k16 < 4; ++k16)
#pragma unroll
        for (int r = 0; r < 4; ++r) mx = fmaxf(mx, S[m][k16][r]);
      mx = fmaxf(mx, shx16(mx));
      mx = fmaxf(mx, shx32(mx, idx32));
      const float mnew = fmaxf(mrun[m], mx);
      const float alpha = fast_exp2(mrun[m] - mnew);
      mrun[m] = mnew;
      float ps = 0.f;
#pragma unroll
      for (int k16 = 0; k16 < 4; ++k16)
#pragma unroll
        for (int r = 0; r < 4; ++r) { const float e = fast_exp2(S[m][k16][r] - mnew); S[m][k16][r] = e; ps += e; }
      lsum[m] = lsum[m] * alpha + ps;
#pragma unroll
      for (int dt = 0; dt < 8; ++dt) { O[m][dt][0] *= alpha; O[m][dt][1] *= alpha; O[m][dt][2] *= alpha; O[m][dt][3] *= alpha; }
#pragma unroll
      for (int kk = 0; kk < 2; ++kk) {
        u32x4 t;
        t[0] = pack2(S[m][2 * kk][0], S[m][2 * kk][1]); t[1] = pack2(S[m][2 * kk][2], S[m][2 * kk][3]);
        t[2] = pack2(S[m][2 * kk + 1][0], S[m][2 * kk + 1][1]); t[3] = pack2(S[m][2 * kk + 1][2], S[m][2 * kk + 1][3]);
        pb[m][kk] = __builtin_bit_cast(bf16x8, t);
      }
    }
#pragma unroll
    for (int kk = 0; kk < 2; ++kk)
#pragma unroll
      for (int dt = 0; dt < 8; ++dt) {
        const char* va = vb + (16 * dt + l15) * 144 + (32 * kk + 4 * g) * 2;
        const u32x2 lo = *(const u32x2*)(va), hi = *(const u32x2*)(va + 32);
        u32x4 t; t[0] = lo[0]; t[1] = lo[1]; t[2] = hi[0]; t[3] = hi[1];
        const bf16x8 a = __builtin_bit_cast(bf16x8, t);
        O[0][dt] = mfma16(a, pb[0][kk], O[0][dt]);
        O[1][dt] = mfma16(a, pb[1][kk], O[1][dt]);
      }
    if (more) {
#pragma unroll
      for (int j = 0; j < 4; ++j) {
        *(u32x4*)(Kb + (cur ^ 1) * 16384 + kdst0 + j * 4096) = rk[j];
        *(u32x4*)(Vb + (cur ^ 1) * 18432 + vdst0 + j * 4608) = rv[j];
      }
    }
    __syncthreads();
  }
  float l0 = lsum[0], l1 = lsum[1];
  l0 += shx16(l0); l0 += shx32(l0, idx32);
  l1 += shx16(l1); l1 += shx32(l1, idx32);
  const float c1 = 1.0f / l0, c2 = lam / l1;
  float ss = 0.f;
#pragma unroll
  for (int dt = 0; dt < 8; ++dt)
#pragma unroll
    for (int r = 0; r < 4; ++r) { const float o = O[0][dt][r] * c1 - O[1][dt][r] * c2; O[0][dt][r] = o; ss += o * o; }
  ss += shx16(ss); ss += shx32(ss, idx32);
  const float rinv = rsqrtf(ss * (1.0f / 128.0f) + 1e-5f);
  if (qpos < LSEQ) {
    u16* dst = W_MIX(p) + (size_t)(b * LSEQ + qpos) * DM + hh * 128 + 4 * g;
#pragma unroll
    for (int dt = 0; dt < 8; ++dt) {
      const int dv0 = 16 * dt + 4 * g;
      u32x2 o;
      o[0] = pack2(O[0][dt][0] * rinv * sg[dv0 + 0], O[0][dt][1] * rinv * sg[dv0 + 1]);
      o[1] = pack2(O[0][dt][2] * rinv * sg[dv0 + 2], O[0][dt][3] * rinv * sg[dv0 + 3]);
      *(u32x2*)(dst + 16 * dt) = o;
    }
  }
}

DI void conv_item(const Params& p, int layer, int item) {
  const int tid = otid(), ch = (tid & 63) * 8;
  const float* cw = P_CONV_W(p) + (size_t)layer * 3 * 512;
  float w0[8], w1[8], w2[8];
#pragma unroll
  for (int e = 0; e < 8; ++e) { w0[e] = cw[ch + e]; w1[e] = cw[512 + ch + e]; w2[e] = cw[1024 + ch + e]; }
#pragma unroll
  for (int i = 0; i < 4; ++i) {
    const int t = item * 16 + (tid >> 6) + 4 * i;
    const int pos = t % LSEQ;
    const u16* row = W_PROJ(p) + (size_t)t * INC;
    float accv[8];
#pragma unroll
    for (int e = 0; e < 8; ++e) accv[e] = 0.f;
#pragma unroll
    for (int d = 0; d < 3; ++d) {
      if (pos - 2 + d >= 0) {
        const u16* r2 = row - (size_t)(2 - d) * INC;
        const u32x4 gc = *(const u32x4*)(r2 + 2048 + ch), zz = *(const u32x4*)(r2 + 2560 + ch);
#pragma unroll
        for (int e = 0; e < 4; ++e) {
          const float wlo = d == 0 ? w0[2 * e] : (d == 1 ? w1[2 * e] : w2[2 * e]);
          const float whi = d == 0 ? w0[2 * e + 1] : (d == 1 ? w1[2 * e + 1] : w2[2 * e + 1]);
          accv[2 * e] += wlo * (bflo(gc[e]) * bflo(zz[e]));
          accv[2 * e + 1] += whi * (bfhi(gc[e]) * bfhi(zz[e]));
        }
      }
    }
    const u32x4 gb = *(const u32x4*)(row + 1536 + ch);
    u32x4 o;
#pragma unroll
    for (int e = 0; e < 4; ++e) o[e] = pack2(bflo(gb[e]) * accv[2 * e], bfhi(gb[e]) * accv[2 * e + 1]);
    *(u32x4*)(W_MIX(p) + (size_t)t * DM + 512 + ch) = o;
  }
}

DI void peer_item(const Params& p, int layer, int item, char* smem) {
  const int tid = otid(), lane = tid & 63, w = tid >> 6;
  unsigned* tkl = (unsigned*)smem;
  int* pe_idx = (int*)(smem + 16384);
  float* pe_g = (float*)(smem + 24576);
  const int t0 = item * 16;
  __syncthreads();
  {
    const u32x4* src = (const u32x4*)(W_TK(p) + (size_t)t0 * 256);
#pragma unroll
    for (int i = 0; i < 4; ++i) ((u32x4*)tkl)[tid + 256 * i] = src[tid + 256 * i];
  }
  __syncthreads();
  if (tid < 128) {
    const int tt = tid >> 3, hh = tid & 7;
    const unsigned* L1 = tkl + tt * 256 + (2 * hh) * 16;
    const unsigned* L2 = L1 + 16;
    float s1[16], s2[16], v[16];
#pragma unroll
    for (int j = 0; j < 16; ++j) { s1[j] = __uint_as_float(L1[j] & ~127u); s2[j] = __uint_as_float(L2[j] & ~127u); v[j] = -3.0e38f; }
#pragma unroll
    for (int a = 0; a < 16; ++a)
#pragma unroll
      for (int bb = 0; bb < 16 / (a + 1); ++bb) {
        const float s = s1[a] + s2[bb];
        insert16(v, __uint_as_float((__float_as_uint(s) & ~255u) | (unsigned)(a * 16 + bb)));
      }
    float e[16], sum = 0.f;
    const float mx = __uint_as_float(__float_as_uint(v[0]) & ~255u);
#pragma unroll
    for (int j = 0; j < 16; ++j) { e[j] = __expf(__uint_as_float(__float_as_uint(v[j]) & ~255u) - mx); sum += e[j]; }
    const float inv = 1.0f / sum;
#pragma unroll
    for (int j = 0; j < 16; ++j) {
      const unsigned code = __float_as_uint(v[j]) & 255u;
      const int i1 = (int)(L1[code >> 4] & 127u), i2 = (int)(L2[code & 15u] & 127u);
      pe_idx[tt * 128 + hh * 16 + j] = i1 * 128 + i2;
      pe_g[tt * 128 + hh * 16 + j] = e[j] * inv;
    }
  }
  __syncthreads();
  const unsigned char* ub = W_UB(p);
  const unsigned char* vbt = W_VB(p);
  for (int q = 0; q < 4; ++q) {
    const int tt = w * 4 + q, t = t0 + tt;
    float xf[16];
    {
      const u32x4 a = *(const u32x4*)(W_H(p) + (size_t)t * DM + 16 * lane), c = *(const u32x4*)(W_H(p) + (size_t)t * DM + 16 * lane + 8);
#pragma unroll
      for (int e = 0; e < 4; ++e) { xf[2 * e] = bflo(a[e]); xf[2 * e + 1] = bfhi(a[e]); xf[8 + 2 * e] = bflo(c[e]); xf[8 + 2 * e + 1] = bfhi(c[e]); }
    }
    const int idxA = pe_idx[tt * 128 + lane], idxB = pe_idx[tt * 128 + 64 + lane];
    const float gA = pe_g[tt * 128 + lane], gB = pe_g[tt * 128 + 64 + lane];
    float actA = 0.f, actB = 0.f;
#pragma unroll 1
    for (int jb = 0; jb < 128; jb += 16) {
      u32x4 r[16];
#pragma unroll
      for (int u = 0; u < 16; ++u) {
        const int e = __builtin_amdgcn_readlane(jb < 64 ? idxA : idxB, (jb + u) & 63);
        r[u] = *(const u32x4*)(ub + (size_t)e * DM + 16 * lane);
      }
#pragma unroll
      for (int u = 0; u < 16; ++u) {
        float d = 0.f;
#pragma unroll
        for (int k = 0; k < 4; ++k) {
          const f32x2 lo = __builtin_amdgcn_cvt_pk_f32_fp8((int)r[u][k], false), hi = __builtin_amdgcn_cvt_pk_f32_fp8((int)r[u][k], true);
          d += xf[4 * k] * lo[0] + xf[4 * k + 1] * lo[1] + xf[4 * k + 2] * hi[0] + xf[4 * k + 3] * hi[1];
        }
        d = wave_sum(d);
        if (lane == ((jb + u) & 63)) { if (jb < 64) actA = d; else actB = d; }
      }
    }
    actA *= W_SU(p)[idxA]; actB *= W_SU(p)[idxB];
    const float wA = gA * (0.5f * actA * (1.0f + erff(actA * 0.7071067811865476f))) * W_SV(p)[idxA];
    const float wB = gB * (0.5f * actB * (1.0f + erff(actB * 0.7071067811865476f))) * W_SV(p)[idxB];
    float acc[16];
#pragma unroll
    for (int i = 0; i < 16; ++i) acc[i] = 0.f;
#pragma unroll 1
    for (int jb = 0; jb < 128; jb += 16) {
      u32x4 r[16];
      float wj[16];
#pragma unroll
      for (int u = 0; u < 16; ++u) {
        const int e = __builtin_amdgcn_readlane(jb < 64 ? idxA : idxB, (jb + u) & 63);
        wj[u] = __int_as_float(__builtin_amdgcn_readlane(__float_as_int(jb < 64 ? wA : wB), (jb + u) & 63));
        r[u] = *(const u32x4*)(vbt + (size_t)e * DM + 16 * lane);
      }
#pragma unroll
      for (int u = 0; u < 16; ++u) {
#pragma unroll
        for (int k = 0; k < 4; ++k) {
          const f32x2 lo = __builtin_amdgcn_cvt_pk_f32_fp8((int)r[u][k], false), hi = __builtin_amdgcn_cvt_pk_f32_fp8((int)r[u][k], true);
          acc[4 * k] += wj[u] * lo[0]; acc[4 * k + 1] += wj[u] * lo[1]; acc[4 * k + 2] += wj[u] * hi[0]; acc[4 * k + 3] += wj[u] * hi[1];
        }
      }
    }
#pragma unroll
    for (int i = 0; i < 16; ++i) acc[i] += ALPHA * xf[i];
    ln_row<1>(acc, P_LN2_G(p) + layer * DM, P_LN2_B(p) + layer * DM, lane);
    if (layer == DEPTH - 1) {
      const int b = t / LSEQ, pos = t - b * LSEQ;
      if (pos >= NMETA) {
        float* dst = p.out + ((size_t)b * SEQ + pos - NMETA) * DM + 16 * lane;
#pragma unroll
        for (int k = 0; k < 4; ++k) *(f32x4*)(dst + 4 * k) = (f32x4){acc[4 * k], acc[4 * k + 1], acc[4 * k + 2], acc[4 * k + 3]};
      }
    } else {
      store_row_bf16<1>(W_H(p) + (size_t)t * DM, acc, lane);
    }
  }
}

DI void phase_prologue(const Params& p, char* smem) {
  const int tid = otid(), lane = tid & 63, wid = tid >> 6;
  const int nblk = gridDim.x, bid = blockIdx.x;
  const size_t gtid = (size_t)bid * NTHREADS + tid, gthreads = (size_t)nblk * NTHREADS;
  for (int it = bid; it < 3072 + 1024; it += nblk) {
    if (it < 3072) {
      const int l = it / 768, r = it % 768, kb = r / 48, nb = r % 48;
      transpose_tile(P_W_IN(p) + (size_t)l * 1024 * 3072, 3072, W_WIN(p) + (size_t)l * 3072 * 1024, 1024, kb * 64, nb * 64, (float*)smem);
    } else {
      const int i2 = it - 3072, l = i2 / 256, r = i2 % 256, kb = r / 16, nb = r % 16;
      transpose_tile(P_W_OUT(p) + (size_t)l * 1024 * 1024, 1024, W_WOUT(p) + (size_t)l * 1024 * 1024, 1024, kb * 64, nb * 64, (float*)smem);
    }
  }
  convert_straight(P_W_Q(p), W_WQB(p), (size_t)4 * 1024 * 2048 / 8, gtid, gthreads);
  convert_straight(P_SUB_KEYS(p), W_SKB(p), (size_t)4 * 16 * 128 * 128 / 8, gtid, gthreads);
  for (int t = bid * 4 + wid; t < TTOK; t += nblk * 4) {
    const int b = t / LSEQ, pos = t - b * LSEQ;
    const float* src = pos < NMETA ? P_META(p) + (size_t)pos * DM : P_X(p) + ((size_t)b * SEQ + pos - NMETA) * DM;
    float v[16];
    load_row_f32<0>(src, v, lane);
    ln_row<0>(v, P_LN_IN_G(p), P_LN_IN_B(p), lane);
    store_row_bf16<0>(W_H(p) + (size_t)t * DM, v, lane);
  }
}

DI void phase_fold(const Params& p, char* smem) {
  for (int it = blockIdx.x; it < 4 * 16 * 8; it += gridDim.x) {
    const int l = it >> 7, hp = (it >> 3) & 15, mt = it & 7;
    gemm_tile_T(p, EPI_FOLD, W_WQB(p) + (size_t)l * 1024 * 2048 + hp * 128, 2048, W_SKB(p) + ((size_t)l * 16 + hp) * 128 * 128, 128, 128, mt * 128, 0, smem,
                W_WSC(p) + (size_t)l * 2048 * 1024 + (size_t)hp * 128 * 1024);
  }
}

DI void phase_proj(const Params& p, int layer, char* smem) {
  const u16* Bt = W_WIN(p) + (size_t)layer * 3072 * 1024;
  for (int tile = blockIdx.x; tile < 516 * 24; tile += gridDim.x) {
    const int mt = tile / 24, nt = tile % 24;
    if (nt >= 8 && nt < 12) gemm_tile_T(p, EPI_VT, W_H(p), DM, Bt, DM, DM, mt * 128, nt * 128, smem, nullptr);
    else gemm_tile_N(p, EPI_PROJ, W_H(p), DM, Bt, DM, DM, mt * 128, nt * 128, smem);
  }
}

DI void phase_attn(const Params& p, int layer, char* smem) {
  const int lane = otid() & 63;
  const float lam_init = 0.8f - 0.6f * expf(-0.3f * (float)layer);
  float d1 = P_LQ1(p)[layer * 64 + lane] * P_LK1(p)[layer * 64 + lane], d2 = P_LQ2(p)[layer * 64 + lane] * P_LK2(p)[layer * 64 + lane];
  d1 = wave_sum(d1); d2 = wave_sum(d2);
  const float lam = expf(d1) - expf(d2) + lam_init;
  for (int it = blockIdx.x; it < 4224 + 4128; it += gridDim.x) {
    if (it < 4224) {
      const int qb = 32 - (it >> 7), bh = it & 127;
      attn_item(p, layer, bh >> 2, bh & 3, qb, smem, lam, 1.0f - lam_init);
    } else {
      conv_item(p, layer, it - 4224);
    }
  }
}

DI void phase_out(const Params& p, int layer, char* smem) {
  const u16* Bt = W_WOUT(p) + (size_t)layer * 1024 * 1024;
  for (int tile = blockIdx.x; tile < 516 * 8; tile += gridDim.x) {
    const int mt = tile / 8, nt = tile % 8;
    gemm_tile_N(p, EPI_OUT, W_MIX(p), DM, Bt, DM, DM, mt * 128, nt * 128, smem);
  }
}

DI void phase_ln1(const Params& p, int layer) {
  const int tid = otid(), lane = tid & 63, wid = tid >> 6;
  const int nblk = gridDim.x, bid = blockIdx.x;
  const size_t gtid = (size_t)bid * NTHREADS + tid, gthreads = (size_t)nblk * NTHREADS;
  for (int t = bid * 4 + wid; t < TTOK; t += nblk * 4) {
    float v[16];
    load_row_f32<0>(W_Y(p) + (size_t)t * DM, v, lane);
    ln_row<0>(v, P_LN1_G(p) + layer * DM, P_LN1_B(p) + layer * DM, lane);
    store_row_bf16<0>(W_H(p) + (size_t)t * DM, v, lane);
  }
  for (int r = bid * 4 + wid; r < 2 * PEER_N; r += nblk * 4) {
    const bool isv = r >= PEER_N;
    const int e = isv ? r - PEER_N : r;
    const float* src = (isv ? P_PEER_V(p) : P_PEER_U(p)) + ((size_t)layer * PEER_N + e) * DM + 16 * lane;
    f32x4 a[4];
#pragma unroll
    for (int k = 0; k < 4; ++k) a[k] = *(const f32x4*)(src + 4 * k);
    float am = 0.f;
#pragma unroll
    for (int k = 0; k < 4; ++k) am = fmaxf(am, fmaxf(fmaxf(fabsf(a[k][0]), fabsf(a[k][1])), fmaxf(fabsf(a[k][2]), fabsf(a[k][3]))));
    am = wave_max_nonneg(am);
    const float sc = am > 0.f ? 224.0f / am : 1.0f;
    if (lane == 0) (isv ? W_SV(p) : W_SU(p))[e] = am > 0.f ? am * (1.0f / 224.0f) : 1.0f;
    u32x4 o;
#pragma unroll
    for (int k = 0; k < 4; ++k) {
      int w = 0;
      w = __builtin_amdgcn_cvt_pk_fp8_f32(a[k][0] * sc, a[k][1] * sc, w, false);
      w = __builtin_amdgcn_cvt_pk_fp8_f32(a[k][2] * sc, a[k][3] * sc, w, true);
      o[k] = (unsigned)w;
    }
    *(u32x4*)((isv ? W_VB(p) : W_UB(p)) + (size_t)e * DM + 16 * lane) = o;
  }
}

DI void phase_scores(const Params& p, int layer, char* smem) {
  const u16* Bt = W_WSC(p) + (size_t)layer * 2048 * 1024;
  for (int tile = blockIdx.x; tile < 516 * 16; tile += gridDim.x) {
    const int mt = tile / 16, nt = tile % 16;
    gemm_tile_N(p, EPI_TOPK, W_H(p), DM, Bt, DM, DM, mt * 128, nt * 128, smem);
  }
}

__global__ void __launch_bounds__(NTHREADS, 2) mega(Params p) {
  extern __shared__ __attribute__((aligned(16))) char smem[];
  cg::grid_group grid = cg::this_grid();
  phase_prologue(p, smem);
  grid.sync();
  phase_fold(p, smem);
#pragma unroll 1
  for (int layer = 0; layer < DEPTH; ++layer) {
    phase_proj(p, layer, smem);
    grid.sync();
    phase_attn(p, layer, smem);
    grid.sync();
    phase_out(p, layer, smem);
    grid.sync();
    phase_ln1(p, layer);
    grid.sync();
    phase_scores(p, layer, smem);
    grid.sync();
    for (int it = blockIdx.x; it < TTOK / 16; it += gridDim.x) peer_item(p, layer, it, smem);
    grid.sync();
  }
}

extern "C" void kernel_launch(void* const* d_in, const int* in_sizes, int n_in, void* d_out, int out_size, void* d_ws, size_t ws_size,
                              hipStream_t stream) {
  static int grid_blocks = 0;
  if (grid_blocks == 0) {
    if (ws_size < WS_END) { fprintf(stderr, "kernel_launch: workspace too small: need %zu, got %zu\n", (size_t)WS_END, ws_size); grid_blocks = -1; return; }
    int dev = 0, cus = 0, per_cu = 0;
    hipGetDevice(&dev);
    hipDeviceGetAttribute(&cus, hipDeviceAttributeMultiprocessorCount, dev);
    hipFuncSetAttribute((const void*)mega, hipFuncAttributeMaxDynamicSharedMemorySize, LDS_BYTES);
    hipOccupancyMaxActiveBlocksPerMultiprocessor(&per_cu, (const void*)mega, NTHREADS, LDS_BYTES);
    if (per_cu < 1) per_cu = 1;
    if (per_cu > 2) per_cu = 2;
    grid_blocks = cus * per_cu;
  }
  if (grid_blocks < 0) return;
  Params p{};
  for (int i = 0; i < 21; ++i) p.in[i] = (const float*)d_in[i];
  p.out = (float*)d_out;
  p.ws = (char*)d_ws;
  void* args[] = {&p};
  hipError_t e = hipLaunchCooperativeKernel((const void*)mega, dim3(grid_blocks), dim3(NTHREADS), args, LDS_BYTES, stream);
  if (e != hipSuccess) fprintf(stderr, "cooperative launch failed: %s (grid %d)\n", hipGetErrorString(e), grid_blocks);
}
```

```cpp
#include <hip/hip_runtime.h>
#include <hip/hip_cooperative_groups.h>
#include <cstdio>
#include <cstdint>
namespace cg = cooperative_groups;

typedef unsigned short u16;
typedef __attribute__((ext_vector_type(8))) short bf16x8;
typedef __attribute__((ext_vector_type(4))) float f32x4;
typedef __attribute__((ext_vector_type(4))) unsigned u32x4;
typedef __attribute__((ext_vector_type(2))) unsigned u32x2;
typedef __attribute__((ext_vector_type(2))) float f32x2;
#define DI __device__ __forceinline__
#define LAS __attribute__((address_space(3)))
typedef LAS char lchar;

#define DM 1024
#define NBATCH 32
#define SEQ 2048
#define NMETA 16
#define LSEQ 2064
#define TTOK 66048
#define DEPTH 4
#define INC 3072
#define LP 2112
#define PEER_N 16384
#define NTHREADS 512
#define LDS_MISC 69632
#define LDS_HALF 70656
#define LDS_BYTES 141312

#define ALPHA 1.681792830507429f
#define LOG2E 1.4426950408889634f

static constexpr size_t WS_WIN  = 0;
static constexpr size_t WS_WOUT = WS_WIN  + (size_t)4 * 3072 * 1024 * 2;
static constexpr size_t WS_WQB  = WS_WOUT + (size_t)4 * 1024 * 1024 * 2;
static constexpr size_t WS_SKB  = WS_WQB  + (size_t)4 * 1024 * 2048 * 2;
static constexpr size_t WS_WSC  = WS_SKB  + (size_t)4 * 16 * 128 * 128 * 2;
static constexpr size_t WS_UB   = WS_WSC  + (size_t)4 * 2048 * 1024 * 2;
static constexpr size_t WS_VB   = WS_UB   + (size_t)PEER_N * 1024;
static constexpr size_t WS_SU   = WS_VB   + (size_t)PEER_N * 1024;
static constexpr size_t WS_SV   = WS_SU   + (size_t)PEER_N * 4;
static constexpr size_t WS_H    = WS_SV   + (size_t)PEER_N * 4;
static constexpr size_t WS_MIX  = WS_H    + (size_t)TTOK * 1024 * 2;
static constexpr size_t WS_BIG  = WS_MIX  + (size_t)TTOK * 1024 * 2;
static constexpr size_t WS_VT   = WS_BIG  + (size_t)(TTOK + 64) * 3072 * 2;
static constexpr size_t WS_IDX  = WS_VT   + (size_t)NBATCH * 4 * 128 * LP * 2;
static constexpr size_t WS_G    = WS_IDX  + (size_t)TTOK * 128 * 4;
static constexpr size_t WS_END  = WS_G    + (size_t)TTOK * 128 * 4;

struct Params {
  const float* in[21];
  float* out;
  char* ws;
};
#define P_X(p) ((p).in[0])
#define P_META(p) ((p).in[1])
#define P_LN_IN_G(p) ((p).in[2])
#define P_LN_IN_B(p) ((p).in[3])
#define P_REL_BIAS(p) ((p).in[4])
#define P_W_IN(p) ((p).in[5])
#define P_CONV_W(p) ((p).in[6])
#define P_LQ1(p) ((p).in[7])
#define P_LK1(p) ((p).in[8])
#define P_LQ2(p) ((p).in[9])
#define P_LK2(p) ((p).in[10])
#define P_SUBLN_G(p) ((p).in[11])
#define P_W_OUT(p) ((p).in[12])
#define P_LN1_G(p) ((p).in[13])
#define P_LN1_B(p) ((p).in[14])
#define P_W_Q(p) ((p).in[15])
#define P_SUB_KEYS(p) ((p).in[16])
#define P_PEER_U(p) ((p).in[17])
#define P_PEER_V(p) ((p).in[18])
#define P_LN2_G(p) ((p).in[19])
#define P_LN2_B(p) ((p).in[20])
#define W_WIN(p) ((u16*)((p).ws + WS_WIN))
#define W_WOUT(p) ((u16*)((p).ws + WS_WOUT))
#define W_WQB(p) ((u16*)((p).ws + WS_WQB))
#define W_SKB(p) ((u16*)((p).ws + WS_SKB))
#define W_WSC(p) ((u16*)((p).ws + WS_WSC))
#define W_UB(p) ((unsigned char*)((p).ws + WS_UB))
#define W_VB(p) ((unsigned char*)((p).ws + WS_VB))
#define W_SU(p) ((float*)((p).ws + WS_SU))
#define W_SV(p) ((float*)((p).ws + WS_SV))
#define W_H(p) ((u16*)((p).ws + WS_H))
#define W_MIX(p) ((u16*)((p).ws + WS_MIX))
#define W_PROJ(p) ((u16*)((p).ws + WS_BIG))
#define W_Y(p) ((float*)((p).ws + WS_BIG))
#define W_VT(p) ((u16*)((p).ws + WS_VT))
#define W_IDX(p) ((int*)((p).ws + WS_IDX))
#define W_G(p) ((float*)((p).ws + WS_G))

DI u16 f2bf(float x) { unsigned u = __float_as_uint(x); u += 0x7fffu + ((u >> 16) & 1u); return (u16)(u >> 16); }
DI unsigned pack2(float a, float b) {
  unsigned ua = __float_as_uint(a), ub = __float_as_uint(b);
  ua += 0x7fffu + ((ua >> 16) & 1u); ub += 0x7fffu + ((ub >> 16) & 1u);
  return (ua >> 16) | (ub & 0xffff0000u);
}
DI float bflo(unsigned w) { return __uint_as_float(w << 16); }
DI float bfhi(unsigned w) { return __uint_as_float(w & 0xffff0000u); }
DI int otid_w(int wave) { unsigned z = 0u; asm volatile("" : "+v"(z)); int t = wave * 64 + (int)__builtin_amdgcn_mbcnt_hi(~0u, __builtin_amdgcn_mbcnt_lo(~0u, z)); asm volatile("" : "+v"(t)); return t; }
#define DPP_ADD(v, ctrl) ((v) + __int_as_float(__builtin_amdgcn_update_dpp(0, __float_as_int(v), (ctrl), 0xf, 0xf, true)))
DI float wave_sum(float v) {
  v = DPP_ADD(v, 0xB1);
  v = DPP_ADD(v, 0x4E);
  v = DPP_ADD(v, 0x141);
  v = DPP_ADD(v, 0x140);
  const int iv = __float_as_int(v);
  return __int_as_float(__builtin_amdgcn_readlane(iv, 0)) + __int_as_float(__builtin_amdgcn_readlane(iv, 16)) +
         __int_as_float(__builtin_amdgcn_readlane(iv, 32)) + __int_as_float(__builtin_amdgcn_readlane(iv, 48));
}
#define DPP_MAX(v, ctrl) fmaxf((v), __int_as_float(__builtin_amdgcn_update_dpp(0, __float_as_int(v), (ctrl), 0xf, 0xf, true)))
DI float wave_max_nonneg(float v) {
  v = DPP_MAX(v, 0xB1); v = DPP_MAX(v, 0x4E); v = DPP_MAX(v, 0x141); v = DPP_MAX(v, 0x140);
  const int iv = __float_as_int(v);
  return fmaxf(fmaxf(__int_as_float(__builtin_amdgcn_readlane(iv, 0)), __int_as_float(__builtin_amdgcn_readlane(iv, 16))),
               fmaxf(__int_as_float(__builtin_amdgcn_readlane(iv, 32)), __int_as_float(__builtin_amdgcn_readlane(iv, 48))));
}
DI float shx16(float v) { return __int_as_float(__builtin_amdgcn_ds_swizzle(__float_as_int(v), 0x401F)); }
DI float shx32(float v, int idx32) { return __int_as_float(__builtin_amdgcn_ds_bpermute(idx32, __float_as_int(v))); }
DI f32x4 mfma16(bf16x8 a, bf16x8 b, f32x4 c) { return __builtin_amdgcn_mfma_f32_16x16x32_bf16(a, b, c, 0, 0, 0); }
DI float fast_exp2(float x) { return __builtin_amdgcn_exp2f(x); }

DI void convert_straight(const float* __restrict__ src, u16* __restrict__ dst, size_t n8, size_t gtid, size_t gthreads) {
  for (size_t i = gtid; i < n8; i += gthreads) {
    const f32x4 a = *(const f32x4*)(src + i * 8), b = *(const f32x4*)(src + i * 8 + 4);
    u32x4 o; o[0] = pack2(a[0], a[1]); o[1] = pack2(a[2], a[3]); o[2] = pack2(b[0], b[1]); o[3] = pack2(b[2], b[3]);
    *(u32x4*)(dst + i * 8) = o;
  }
}

DI void transpose_tile(const float* __restrict__ src, int ldn, u16* __restrict__ dst, int ldk, int k0, int n0, float* sm, int tid) {
#pragma unroll
  for (int i = 0; i < 4; ++i) {
    const int r = (tid >> 4) + 16 * i, c4 = tid & 15;
    const f32x4 v = *(const f32x4*)(src + (size_t)(k0 + r) * ldn + n0 + 4 * c4);
    sm[r * 65 + 4 * c4 + 0] = v[0]; sm[r * 65 + 4 * c4 + 1] = v[1]; sm[r * 65 + 4 * c4 + 2] = v[2]; sm[r * 65 + 4 * c4 + 3] = v[3];
  }
  __syncthreads();
#pragma unroll
  for (int i = 0; i < 2; ++i) {
    const int n = (tid >> 3) + 32 * i, kc = tid & 7;
    u32x4 o;
#pragma unroll
    for (int e = 0; e < 4; ++e) o[e] = pack2(sm[(8 * kc + 2 * e) * 65 + n], sm[(8 * kc + 2 * e + 1) * 65 + n]);
    *(u32x4*)(dst + (size_t)(n0 + n) * ldk + k0 + 8 * kc) = o;
  }
  __syncthreads();
}

template <int LAYOUT> DI int col0(int lane, int hh) { return LAYOUT ? 16 * lane + 8 * hh : hh * 512 + 8 * lane; }
template <int LAYOUT>
DI void ln_row(float (&v)[16], const float* __restrict__ g, const float* __restrict__ b, int lane) {
  float s = 0.f;
#pragma unroll
  for (int i = 0; i < 16; ++i) s += v[i];
  const float mu = wave_sum(s) * (1.0f / 1024.0f);
  float q = 0.f;
#pragma unroll
  for (int i = 0; i < 16; ++i) { const float d = v[i] - mu; q += d * d; }
  const float rstd = rsqrtf(wave_sum(q) * (1.0f / 1024.0f) + 1e-5f);
#pragma unroll
  for (int hh = 0; hh < 2; ++hh) {
    const int c = col0<LAYOUT>(lane, hh);
    const f32x4 g0 = *(const f32x4*)(g + c), g1 = *(const f32x4*)(g + c + 4), b0 = *(const f32x4*)(b + c), b1 = *(const f32x4*)(b + c + 4);
#pragma unroll
    for (int e = 0; e < 4; ++e) {
      v[hh * 8 + e] = (v[hh * 8 + e] - mu) * rstd * g0[e] + b0[e];
      v[hh * 8 + 4 + e] = (v[hh * 8 + 4 + e] - mu) * rstd * g1[e] + b1[e];
    }
  }
}
template <int LAYOUT>
DI void store_row_bf16(u16* __restrict__ dst, const float (&v)[16], int lane) {
#pragma unroll
  for (int hh = 0; hh < 2; ++hh) {
    u32x4 o;
#pragma unroll
    for (int e = 0; e < 4; ++e) o[e] = pack2(v[hh * 8 + 2 * e], v[hh * 8 + 2 * e + 1]);
    *(u32x4*)(dst + col0<LAYOUT>(lane, hh)) = o;
  }
}
template <int LAYOUT>
DI void load_row_f32(const float* __restrict__ src, float (&v)[16], int lane) {
#pragma unroll
  for (int hh = 0; hh < 2; ++hh) {
    const int c = col0<LAYOUT>(lane, hh);
    const f32x4 a = *(const f32x4*)(src + c), b = *(const f32x4*)(src + c + 4);
#pragma unroll
    for (int e = 0; e < 4; ++e) { v[hh * 8 + e] = a[e]; v[hh * 8 + 4 + e] = b[e]; }
  }
}

enum { EPI_PROJ = 0, EPI_VT = 1, EPI_OUT = 2, EPI_TOPK = 3, EPI_FOLD = 4 };

template <bool SWAP>
DI void gemm_mainloop(const u16* __restrict__ A, int lda, const u16* __restrict__ Bt, int ldb, int K, int m0, int n0, char* smem,
                      f32x4 (&acc)[4][4], int tid) {
  const int lane = tid & 63, wid = tid >> 6, wm = wid >> 1, wn = wid & 1;
  const int srow = tid >> 3, skc = tid & 7;
  const u16* ap = A + (size_t)(m0 + srow) * lda + skc * 8;
  const u16* bp = Bt + (size_t)(n0 + srow) * ldb + skc * 8;
  const int dst0 = (((srow >> 4) * 2 + (skc >> 2)) * 1024) + (((skc & 3) * 16 + (srow & 15)) * 16);
#pragma unroll
  for (int i = 0; i < 4; ++i)
#pragma unroll
    for (int j = 0; j < 4; ++j) acc[i][j] = (f32x4){0.f, 0.f, 0.f, 0.f};
  u32x4 ra[4], rb[4];
#pragma unroll
  for (int j = 0; j < 4; ++j) { ra[j] = *(const u32x4*)(ap + (size_t)j * 32 * lda); rb[j] = *(const u32x4*)(bp + (size_t)j * 32 * ldb); }
#pragma unroll
  for (int j = 0; j < 4; ++j) { *(u32x4*)(smem + dst0 + j * 4096) = ra[j]; *(u32x4*)(smem + 16384 + dst0 + j * 4096) = rb[j]; }
  __syncthreads();
  const int KT = K >> 6;
  for (int kt = 0; kt < KT; ++kt) {
    char* cur = smem + (kt & 1) * 32768;
    char* nxt = smem + ((kt + 1) & 1) * 32768;
    const bool more = (kt + 1 < KT);
    if (more) {
      const u16* ap2 = ap + (kt + 1) * 64;
      const u16* bp2 = bp + (kt + 1) * 64;
#pragma unroll
      for (int j = 0; j < 4; ++j) { ra[j] = *(const u32x4*)(ap2 + (size_t)j * 32 * lda); rb[j] = *(const u32x4*)(bp2 + (size_t)j * 32 * ldb); }
    }
#pragma unroll
    for (int ks = 0; ks < 2; ++ks) {
      bf16x8 af[4], bfr[4];
#pragma unroll
      for (int i = 0; i < 4; ++i) af[i] = *(const bf16x8*)(cur + (((wm * 4 + i) * 2 + ks) * 1024) + lane * 16);
#pragma unroll
      for (int j = 0; j < 4; ++j) bfr[j] = *(const bf16x8*)(cur + 16384 + (((wn * 4 + j) * 2 + ks) * 1024) + lane * 16);
#pragma unroll
      for (int i = 0; i < 4; ++i)
#pragma unroll
        for (int j = 0; j < 4; ++j) acc[i][j] = SWAP ? mfma16(bfr[j], af[i], acc[i][j]) : mfma16(af[i], bfr[j], acc[i][j]);
    }
    if (more) {
#pragma unroll
      for (int j = 0; j < 4; ++j) { *(u32x4*)(nxt + dst0 + j * 4096) = ra[j]; *(u32x4*)(nxt + 16384 + dst0 + j * 4096) = rb[j]; }
    }
    __syncthreads();
  }
}

DI void insert16(float (&v)[16], float x) {
#pragma unroll
  for (int j = 0; j < 16; ++j) { const float hi = fmaxf(v[j], x); x = fminf(v[j], x); v[j] = hi; }
}

DI void gemm_tile_fold(const u16* A, int lda, const u16* Bt, int ldb, int K, int m0, char* smem, u16* dstT, int tid) {
  const int lane = tid & 63, wid = tid >> 6, wm = wid >> 1, wn = wid & 1, g = lane >> 4, l15 = lane & 15;
  f32x4 acc[4][4];
  gemm_mainloop<false>(A, lda, Bt, ldb, K, m0, 0, smem, acc, tid);
#pragma unroll
  for (int i = 0; i < 4; ++i)
#pragma unroll
    for (int j = 0; j < 4; ++j) {
      const int m = m0 + wm * 64 + 16 * i + 4 * g, n = wn * 64 + 16 * j + l15;
      u32x2 o; o[0] = pack2(acc[i][j][0], acc[i][j][1]); o[1] = pack2(acc[i][j][2], acc[i][j][3]);
      *(u32x2*)(dstT + (size_t)n * 1024 + m) = o;
    }
}

#define GK 1024
#define HTB 16384
DI int lds_byte(int r, int c) {
  const int st = (r >> 4) * 2 + (c >> 5), rr = r & 15, cc = c & 31, ob = rr * 64 + cc * 2;
  return st * 1024 + (ob ^ (((ob >> 9) & 1) << 5));
}
DI void stage_rc(int b, int& R, int& C) {
  const int st = b / 1024, sb = b % 1024, swz = sb ^ (((sb >> 9) & 1) << 5);
  R = (st >> 1) * 16 + swz / 64; C = (st & 1) * 32 + (swz % 64) / 2;
}
#define G_SA(b, h) (shm + ((b) * 2 + (h)) * HTB)
#define G_SB(b, h) (shm + (4 + (b) * 2 + (h)) * HTB)
#define G_STAGE(P, BASE, br, kt) do { const char* _g = (const char*)((BASE) + (size_t)(br) * GK + (kt) * 64); \
    __builtin_amdgcn_global_load_lds((const unsigned*)(_g + goff0), (LAS unsigned*)((P) + tid * 16), 16, 0, 0); \
    __builtin_amdgcn_global_load_lds((const unsigned*)(_g + goff1), (LAS unsigned*)((P) + tid * 16 + 8192), 16, 0, 0); } while (0)
#define G_LDA(dst, b, h) _Pragma("unroll") for (int m = 0; m < 4; ++m) _Pragma("unroll") for (int k = 0; k < 2; ++k) \
    dst[m][k] = *(const LAS bf16x8*)(G_SA(b, h) + lds_byte(wr * 64 + m * 16 + fr, k * 32 + fq * 8))
#define G_LDB(dst, b, h) _Pragma("unroll") for (int n = 0; n < 2; ++n) _Pragma("unroll") for (int k = 0; k < 2; ++k) \
    dst[n][k] = *(const LAS bf16x8*)(G_SB(b, h) + lds_byte(wc * 32 + n * 16 + fr, k * 32 + fq * 8))
#define G_MMA(ai, bj, At, Bx) do { __builtin_amdgcn_s_setprio(1); \
    _Pragma("unroll") for (int m = 0; m < 4; ++m) _Pragma("unroll") for (int n = 0; n < 2; ++n) _Pragma("unroll") for (int k = 0; k < 2; ++k) \
      acc[ai][bj][m][n] = __builtin_amdgcn_mfma_f32_16x16x32_bf16(At[m][k], Bx[n][k], acc[ai][bj][m][n], 0, 0, 0); \
    __builtin_amdgcn_s_setprio(0); } while (0)
#define WAIT_V(n) asm volatile("s_waitcnt vmcnt(" #n ")" ::: "memory")
#define WAIT_L(n) asm volatile("s_waitcnt lgkmcnt(" #n ")" ::: "memory")
#define BAR __builtin_amdgcn_s_barrier()
#define SCHED __builtin_amdgcn_sched_barrier(0)

DI void gemm256_core(const u16* __restrict__ A, const u16* __restrict__ Bt, int brow, int bcol, lchar* shm, int tid, f32x4 (&acc)[2][2][4][2]) {
  const int wid = tid >> 6, lane = tid & 63, wr = wid >> 2, wc = wid & 3, fr = lane & 15, fq = lane >> 4;
  int r0, c0, r1, c1;
  stage_rc(tid * 16, r0, c0); stage_rc(tid * 16 + 8192, r1, c1);
  const unsigned goff0 = (unsigned)(r0 * GK + c0) * 2u, goff1 = (unsigned)(r1 * GK + c1) * 2u;
#pragma unroll
  for (int ai = 0; ai < 2; ++ai)
#pragma unroll
    for (int bj = 0; bj < 2; ++bj)
#pragma unroll
      for (int m = 0; m < 4; ++m)
#pragma unroll
        for (int n = 0; n < 2; ++n) acc[ai][bj][m][n] = (f32x4){0.f, 0.f, 0.f, 0.f};
  bf16x8 At[4][2], B0[2][2], B1[2][2];
  const int nt = GK / 64;
  WAIT_V(0);
  __syncthreads();
  G_STAGE(G_SB(0, 0), Bt, bcol, 0); G_STAGE(G_SA(0, 0), A, brow, 0);
  G_STAGE(G_SB(0, 1), Bt, bcol + 128, 0); G_STAGE(G_SA(0, 1), A, brow + 128, 0);
  if (wr == 1) BAR;
  WAIT_V(4); BAR;
  G_STAGE(G_SB(1, 0), Bt, bcol, 1); G_STAGE(G_SA(1, 0), A, brow, 1); G_STAGE(G_SB(1, 1), Bt, bcol + 128, 1);
  WAIT_V(6); BAR;
  for (int t = 0; t < nt - 2; t += 2) {
    G_LDB(B0, 0, 0); SCHED; G_LDA(At, 0, 0); G_STAGE(G_SA(1, 1), A, brow + 128, t + 1);
    WAIT_L(8); BAR; WAIT_L(0); G_MMA(0, 0, At, B0); BAR; SCHED;
    G_LDB(B1, 0, 1); G_STAGE(G_SB(0, 0), Bt, bcol, t + 2);
    BAR; WAIT_L(0); G_MMA(0, 1, At, B1); BAR;
    G_LDA(At, 0, 1); G_STAGE(G_SA(0, 0), A, brow, t + 2);
    BAR; WAIT_L(0); G_MMA(1, 0, At, B0); BAR; SCHED;
    G_STAGE(G_SB(0, 1), Bt, bcol + 128, t + 2);
    WAIT_V(6); BAR; G_MMA(1, 1, At, B1); BAR;
    G_LDB(B0, 1, 0); SCHED; G_LDA(At, 1, 0); G_STAGE(G_SA(0, 1), A, brow + 128, t + 2);
    WAIT_L(8); BAR; WAIT_L(0); G_MMA(0, 0, At, B0); BAR; SCHED;
    G_LDB(B1, 1, 1); G_STAGE(G_SB(1, 0), Bt, bcol, t + 3);
    BAR; WAIT_L(0); G_MMA(0, 1, At, B1); BAR;
    G_LDA(At, 1, 1); G_STAGE(G_SA(1, 0), A, brow, t + 3);
    BAR; WAIT_L(0); G_MMA(1, 0, At, B0); BAR; SCHED;
    G_STAGE(G_SB(1, 1), Bt, bcol + 128, t + 3);
    WAIT_V(6); BAR; G_MMA(1, 1, At, B1); BAR;
  }
  { G_LDB(B0, 0, 0); G_LDA(At, 0, 0); G_STAGE(G_SA(1, 1), A, brow + 128, nt - 1);
    BAR; WAIT_L(0); G_MMA(0, 0, At, B0); BAR;
    G_LDB(B1, 0, 1); BAR; WAIT_L(0); G_MMA(0, 1, At, B1); BAR;
    G_LDA(At, 0, 1); WAIT_V(4); BAR; WAIT_L(0); G_MMA(1, 0, At, B0); G_MMA(1, 1, At, B1); BAR; }
  { G_LDB(B0, 1, 0); G_LDA(At, 1, 0); WAIT_V(2); BAR; WAIT_L(0); G_MMA(0, 0, At, B0); BAR;
    G_LDB(B1, 1, 1); WAIT_V(0); BAR; WAIT_L(0); G_MMA(0, 1, At, B1); BAR;
    G_LDA(At, 1, 1); BAR; WAIT_L(0); G_MMA(1, 0, At, B0); G_MMA(1, 1, At, B1); BAR; }
  if (wr == 0) BAR;
}

DI void gemm256_tile(const Params& p, int mode, int layer, const u16* R, const u16* Cc, int brow, int bcol, lchar* shm, int tid_in) {
  f32x4 acc[2][2][4][2];
  gemm256_core(R, Cc, brow, bcol, shm, tid_in, acc);
  int tid = tid_in;
  asm volatile("" : "+v"(tid));
  const int wid = tid >> 6, lane = tid & 63, wr = wid >> 2, wc = wid & 3, fr = lane & 15, fq = lane >> 4;
  if (mode == EPI_PROJ) {
#pragma unroll
    for (int ai = 0; ai < 2; ++ai)
#pragma unroll
      for (int bj = 0; bj < 2; ++bj)
#pragma unroll
        for (int m = 0; m < 4; ++m)
#pragma unroll
          for (int n = 0; n < 2; ++n) {
            const int nc = brow + ai * 128 + wr * 64 + m * 16 + fq * 4, tok = bcol + bj * 128 + wc * 32 + n * 16 + fr;
            const f32x4 v = acc[ai][bj][m][n];
            u32x2 o; o[0] = pack2(v[0], v[1]); o[1] = pack2(v[2], v[3]);
            *(u32x2*)(W_PROJ(p) + (size_t)tok * INC + nc) = o;
          }
  } else if (mode == EPI_VT) {
#pragma unroll
    for (int ai = 0; ai < 2; ++ai)
#pragma unroll
      for (int bj = 0; bj < 2; ++bj)
#pragma unroll
        for (int m = 0; m < 4; ++m)
#pragma unroll
          for (int n = 0; n < 2; ++n) {
            const int tok = brow + ai * 128 + wr * 64 + m * 16 + fq * 4, nn = bcol + bj * 128 + wc * 32 + n * 16 + fr - 1024;
            const int b = tok / LSEQ, pos = tok - b * LSEQ;
            const f32x4 v = acc[ai][bj][m][n];
            u32x2 o; o[0] = pack2(v[0], v[1]); o[1] = pack2(v[2], v[3]);
            *(u32x2*)(W_VT(p) + ((size_t)(b * 512 + nn)) * LP + pos) = o;
          }
  } else if (mode == EPI_OUT) {
#pragma unroll
    for (int ai = 0; ai < 2; ++ai)
#pragma unroll
      for (int bj = 0; bj < 2; ++bj)
#pragma unroll
        for (int m = 0; m < 4; ++m)
#pragma unroll
          for (int n = 0; n < 2; ++n) {
            const int nc = brow + ai * 128 + wr * 64 + m * 16 + fq * 4, tok = bcol + bj * 128 + wc * 32 + n * 16 + fr;
            const u32x2 hv = *(const u32x2*)(W_H(p) + (size_t)tok * DM + nc);
            const f32x4 v = acc[ai][bj][m][n];
            f32x4 o;
            o[0] = ALPHA * bflo(hv[0]) + v[0]; o[1] = ALPHA * bfhi(hv[0]) + v[1];
            o[2] = ALPHA * bflo(hv[1]) + v[2]; o[3] = ALPHA * bfhi(hv[1]) + v[3];
            *(f32x4*)(W_Y(p) + (size_t)tok * DM + nc) = o;
          }
  } else {
    LAS float* S = (LAS float*)shm;
    const int tok = tid & 255, kh = tid >> 8;
    float L0[16], L1[16];
#pragma unroll
    for (int ai = 0; ai < 2; ++ai) {
      __syncthreads();
#pragma unroll
      for (int bj = 0; bj < 2; ++bj)
#pragma unroll
        for (int m = 0; m < 4; ++m)
#pragma unroll
          for (int n = 0; n < 2; ++n) {
            const int tk = bj * 128 + wc * 32 + n * 16 + fr, key = wr * 64 + m * 16 + fq * 4;
#pragma unroll
            for (int j = 0; j < 4; ++j) S[tk * 128 + ((key + j + tk) & 127)] = acc[ai][bj][m][n][j];
          }
      __syncthreads();
      float v[16];
#pragma unroll
      for (int j = 0; j < 16; ++j) v[j] = -3.0e38f;
      for (int i = 0; i < 64; ++i) {
        const int key = kh * 64 + i;
        const float x = S[tok * 128 + ((key + tok) & 127)];
        insert16(v, __uint_as_float((__float_as_uint(x) & ~127u) | (unsigned)key));
      }
      __syncthreads();
      if (kh == 1) {
#pragma unroll
        for (int j = 0; j < 16; ++j) S[tok * 16 + j] = v[j];
      }
      __syncthreads();
      if (kh == 0) {
#pragma unroll
        for (int j = 0; j < 16; ++j) insert16(v, S[tok * 16 + j]);
      }
#pragma unroll
      for (int j = 0; j < 16; ++j) { if (ai == 0) L0[j] = v[j]; else L1[j] = v[j]; }
    }
    __syncthreads();
    LAS unsigned* LL = (LAS unsigned*)shm;
    if (kh == 0) {
#pragma unroll
      for (int j = 0; j < 16; ++j) { LL[tok * 32 + ((j + tok) & 31)] = __float_as_uint(L0[j]); LL[tok * 32 + ((16 + j + tok) & 31)] = __float_as_uint(L1[j]); }
      float s1[16], s2[16], v[16];
#pragma unroll
      for (int j = 0; j < 16; ++j) { s1[j] = __uint_as_float(__float_as_uint(L0[j]) & ~127u); s2[j] = __uint_as_float(__float_as_uint(L1[j]) & ~127u); v[j] = -3.0e38f; }
#pragma unroll
      for (int a = 0; a < 16; ++a)
#pragma unroll
        for (int bb = 0; bb < 16 / (a + 1); ++bb) {
          const float sm = s1[a] + s2[bb];
          insert16(v, __uint_as_float((__float_as_uint(sm) & ~255u) | (unsigned)(a * 16 + bb)));
        }
      float e[16], sum = 0.f;
      const float mx = __uint_as_float(__float_as_uint(v[0]) & ~255u);
#pragma unroll
      for (int j = 0; j < 16; ++j) { e[j] = fast_exp2((__uint_as_float(__float_as_uint(v[j]) & ~255u) - mx) * LOG2E); sum += e[j]; }
      const float inv = 1.0f / sum;
      const int hd = brow >> 8;
      int* di = W_IDX(p) + (size_t)(bcol + tok) * 128 + hd * 16;
      float* dg = W_G(p) + (size_t)(bcol + tok) * 128 + hd * 16;
#pragma unroll
      for (int q = 0; q < 4; ++q) {
        u32x4 oi; f32x4 og;
#pragma unroll
        for (int k = 0; k < 4; ++k) {
          const unsigned code = __float_as_uint(v[4 * q + k]) & 255u;
          const unsigned i1 = LL[tok * 32 + (((code >> 4) + tok) & 31)] & 127u, i2 = LL[tok * 32 + ((16 + (code & 15u) + tok) & 31)] & 127u;
          oi[k] = i1 * 128u + i2; og[k] = e[4 * q + k] * inv;
        }
        *(u32x4*)(di + 4 * q) = oi; *(f32x4*)(dg + 4 * q) = og;
      }
    }
    __syncthreads();
  }
}

DI void attn_item(const Params& p, int layer, int b, int hh, int qb, char* smem, float lam, float oml, int tid) {
  const int lane = tid & 63, w = tid >> 6, g = lane >> 4, l15 = lane & 15;
  const int idx32 = (lane ^ 32) << 2;
  float* tab = (float*)(smem + LDS_MISC);
  float* sg = tab + 128;
  __syncthreads();
  if (tid < 128) {
    int bucket = tid;
    if (tid >= 16) {
      int lg = 16 + (int)(logf((float)tid * (1.0f / 16.0f)) / 2.0794415416798357f * 16.0f);
      bucket = lg < 31 ? lg : 31;
    }
    tab[tid] = P_REL_BIAS(p)[bucket * 4 + hh] * LOG2E;
    sg[tid] = P_SUBLN_G(p)[layer * 128 + tid] * oml;
  }
  const int qpos = 64 * qb + 16 * w + l15;
  const int qrow = b * LSEQ + (qpos < LSEQ ? qpos : LSEQ - 1);
  bf16x8 qf[2][2];
  {
    const u16* qp = W_PROJ(p) + (size_t)qrow * INC + hh * 128 + g * 8;
#pragma unroll
    for (int m = 0; m < 2; ++m)
#pragma unroll
      for (int ks = 0; ks < 2; ++ks) qf[m][ks] = *(const bf16x8*)(qp + m * 64 + ks * 32);
  }
  const int nkt = qb + 1;
  const int kkey = tid >> 4, kc = tid & 15;
  const u16* ksrc = W_PROJ(p) + (size_t)(b * LSEQ + kkey) * INC + 512 + hh * 128 + kc * 8;
  const int kdst0 = ((((kc >> 3) * 2 + ((kc >> 2) & 1)) * 1024) + (((kc & 3) * 16 + kkey) * 16));
  const int vdv = tid >> 3, vc = tid & 7;
  const u16* vsrc = W_VT(p) + ((size_t)((b * 4 + hh) * 128 + vdv)) * LP + vc * 8;
  const int vdst0 = vdv * 144 + vc * 16;
  char* Kb = smem;
  char* Vb = smem + 32768;

  u32x4 rs[4];
#pragma unroll
  for (int j = 0; j < 4; ++j) rs[j] = *(const u32x4*)(ksrc + (size_t)(16 * j) * INC);
#pragma unroll
  for (int j = 0; j < 4; ++j) *(u32x4*)(Kb + kdst0 + j * 4096) = rs[j];
#pragma unroll
  for (int j = 0; j < 4; ++j) rs[j] = *(const u32x4*)(vsrc + (size_t)(32 * j) * LP);
#pragma unroll
  for (int j = 0; j < 4; ++j) *(u32x4*)(Vb + vdst0 + j * 4608) = rs[j];
  __syncthreads();

  f32x4 O[2][8];
#pragma unroll
  for (int m = 0; m < 2; ++m)
#pragma unroll
    for (int dt = 0; dt < 8; ++dt) O[m][dt] = (f32x4){0.f, 0.f, 0.f, 0.f};
  float mrun[2] = {-1.0e30f, -1.0e30f}, lsum[2] = {0.f, 0.f};
  const float tfar = tab[127];

  for (int kt = 0; kt < nkt; ++kt) {
    const int cur = kt & 1;
    const bool more = (kt + 1 < nkt);
    if (more) {
#pragma unroll
      for (int j = 0; j < 4; ++j) rs[j] = *(const u32x4*)(ksrc + (size_t)(64 * (kt + 1) + 16 * j) * INC);
    }
    const char* kb = Kb + cur * 16384;
    const char* vb = Vb + cur * 18432;
    f32x4 S[2][4];
#pragma unroll
    for (int k16 = 0; k16 < 4; ++k16)
#pragma unroll
      for (int m = 0; m < 2; ++m) {
        f32x4 s = (f32x4){0.f, 0.f, 0.f, 0.f};
#pragma unroll
        for (int ks = 0; ks < 2; ++ks) {
          const bf16x8 a = *(const bf16x8*)(kb + (((k16 * 2 + m) * 2 + ks) * 1024) + lane * 16);
          s = mfma16(a, qf[m][ks], s);
        }
        S[m][k16] = s;
      }
    const bool near = (qb - kt) <= 2;
#pragma unroll
    for (int m = 0; m < 2; ++m)
#pragma unroll
      for (int k16 = 0; k16 < 4; ++k16)
#pragma unroll
        for (int r = 0; r < 4; ++r) {
          float s = S[m][k16][r] * (0.125f * LOG2E);
          if (near) {
            const int dist = qpos - (64 * kt + 16 * k16 + 4 * g + r);
            s = dist < 0 ? -1.0e30f : s + tab[dist < 127 ? dist : 127];
          } else {
            s += tfar;
          }
          S[m][k16][r] = s;
        }
    bf16x8 pb[2][2];
#pragma unroll
    for (int m = 0; m < 2; ++m) {
      float mx = -1.0e30f;
#pragma unroll
      for (int k16 = 0; k16 < 4; ++k16)
#pragma unroll
        for (int r = 0; r < 4; ++r) mx = fmaxf(mx, S[m][k16][r]);
      mx = fmaxf(mx, shx16(mx));
      mx = fmaxf(mx, shx32(mx, idx32));
      const float mnew = fmaxf(mrun[m], mx);
      const float alpha = fast_exp2(mrun[m] - mnew);
      mrun[m] = mnew;
      float ps = 0.f;
#pragma unroll
      for (int k16 = 0; k16 < 4; ++k16)
#pragma unroll
        for (int r = 0; r < 4; ++r) { const float e = fast_exp2(S[m][k16][r] - mnew); S[m][k16][r] = e; ps += e; }
      lsum[m] = lsum[m] * alpha + ps;
#pragma unroll
      for (int dt = 0; dt < 8; ++dt) { O[m][dt][0] *= alpha; O[m][dt][1] *= alpha; O[m][dt][2] *= alpha; O[m][dt][3] *= alpha; }
#pragma unroll
      for (int kk = 0; kk < 2; ++kk) {
        u32x4 t;
        t[0] = pack2(S[m][2 * kk][0], S[m][2 * kk][1]); t[1] = pack2(S[m][2 * kk][2], S[m][2 * kk][3]);
        t[2] = pack2(S[m][2 * kk + 1][0], S[m][2 * kk + 1][1]); t[3] = pack2(S[m][2 * kk + 1][2], S[m][2 * kk + 1][3]);
        pb[m][kk] = __builtin_bit_cast(bf16x8, t);
      }
    }
    if (more) {
#pragma unroll
      for (int j = 0; j < 4; ++j) *(u32x4*)(Kb + (cur ^ 1) * 16384 + kdst0 + j * 4096) = rs[j];
#pragma unroll
      for (int j = 0; j < 4; ++j) rs[j] = *(const u32x4*)(vsrc + (size_t)(32 * j) * LP + 64 * (kt + 1));
    }
#pragma unroll
    for (int kk = 0; kk < 2; ++kk)
#pragma unroll
      for (int dt = 0; dt < 8; ++dt) {
        const char* va = vb + (16 * dt + l15) * 144 + (32 * kk + 4 * g) * 2;
        const u32x2 lo = *(const u32x2*)(va), hi = *(const u32x2*)(va + 32);
        u32x4 t; t[0] = lo[0]; t[1] = lo[1]; t[2] = hi[0]; t[3] = hi[1];
        const bf16x8 a = __builtin_bit_cast(bf16x8, t);
        O[0][dt] = mfma16(a, pb[0][kk], O[0][dt]);
        O[1][dt] = mfma16(a, pb[1][kk], O[1][dt]);
      }
    if (more) {
#pragma unroll
      for (int j = 0; j < 4; ++j) *(u32x4*)(Vb + (cur ^ 1) * 18432 + vdst0 + j * 4608) = rs[j];
    }
    __syncthreads();
  }
  float l0 = lsum[0], l1 = lsum[1];
  l0 += shx16(l0); l0 += shx32(l0, idx32);
  l1 += shx16(l1); l1 += shx32(l1, idx32);
  const float c1 = 1.0f / l0, c2 = lam / l1;
  float ss = 0.f;
#pragma unroll
  for (int dt = 0; dt < 8; ++dt)
#pragma unroll
    for (int r = 0; r < 4; ++r) { const float o = O[0][dt][r] * c1 - O[1][dt][r] * c2; O[0][dt][r] = o; ss += o * o; }
  ss += shx16(ss); ss += shx32(ss, idx32);
  const float rinv = rsqrtf(ss * (1.0f / 128.0f) + 1e-5f);
  if (qpos < LSEQ) {
    u16* dst = W_MIX(p) + (size_t)(b * LSEQ + qpos) * DM + hh * 128 + 4 * g;
#pragma unroll
    for (int dt = 0; dt < 8; ++dt) {
      const int dv0 = 16 * dt + 4 * g;
      u32x2 o;
      o[0] = pack2(O[0][dt][0] * rinv * sg[dv0 + 0], O[0][dt][1] * rinv * sg[dv0 + 1]);
      o[1] = pack2(O[0][dt][2] * rinv * sg[dv0 + 2], O[0][dt][3] * rinv * sg[dv0 + 3]);
      *(u32x2*)(dst + 16 * dt) = o;
    }
  }
}

DI void conv_item(const Params& p, int layer, int item, int tid) {
  const int ch = (tid & 63) * 8;
  const float* cw = P_CONV_W(p) + (size_t)layer * 3 * 512;
  float w0[8], w1[8], w2[8];
#pragma unroll
  for (int e = 0; e < 8; ++e) { w0[e] = cw[ch + e]; w1[e] = cw[512 + ch + e]; w2[e] = cw[1024 + ch + e]; }
#pragma unroll
  for (int i = 0; i < 4; ++i) {
    const int t = item * 16 + (tid >> 6) + 4 * i;
    const int pos = t % LSEQ;
    const u16* row = W_PROJ(p) + (size_t)t * INC;
    float accv[8];
#pragma unroll
    for (int e = 0; e < 8; ++e) accv[e] = 0.f;
#pragma unroll
    for (int d = 0; d < 3; ++d) {
      if (pos - 2 + d >= 0) {
        const u16* r2 = row - (size_t)(2 - d) * INC;
        const u32x4 gc = *(const u32x4*)(r2 + 2048 + ch), zz = *(const u32x4*)(r2 + 2560 + ch);
#pragma unroll
        for (int e = 0; e < 4; ++e) {
          const float wlo = d == 0 ? w0[2 * e] : (d == 1 ? w1[2 * e] : w2[2 * e]);
          const float whi = d == 0 ? w0[2 * e + 1] : (d == 1 ? w1[2 * e + 1] : w2[2 * e + 1]);
          accv[2 * e] += wlo * (bflo(gc[e]) * bflo(zz[e]));
          accv[2 * e + 1] += whi * (bfhi(gc[e]) * bfhi(zz[e]));
        }
      }
    }
    const u32x4 gb = *(const u32x4*)(row + 1536 + ch);
    u32x4 o;
#pragma unroll
    for (int e = 0; e < 4; ++e) o[e] = pack2(bflo(gb[e]) * accv[2 * e], bfhi(gb[e]) * accv[2 * e + 1]);
    *(u32x4*)(W_MIX(p) + (size_t)t * DM + 512 + ch) = o;
  }
}

DI void peer_token(const Params& p, int layer, int t, int lane) {
  const unsigned char* ub = W_UB(p);
  const unsigned char* vbt = W_VB(p);
  {
    float xf[16];
    {
      const u32x4 a = *(const u32x4*)(W_H(p) + (size_t)t * DM + 16 * lane), c = *(const u32x4*)(W_H(p) + (size_t)t * DM + 16 * lane + 8);
#pragma unroll
      for (int e = 0; e < 4; ++e) { xf[2 * e] = bflo(a[e]); xf[2 * e + 1] = bfhi(a[e]); xf[8 + 2 * e] = bflo(c[e]); xf[8 + 2 * e + 1] = bfhi(c[e]); }
    }
    const int idxA = W_IDX(p)[(size_t)t * 128 + lane], idxB = W_IDX(p)[(size_t)t * 128 + 64 + lane];
    const float gA = W_G(p)[(size_t)t * 128 + lane], gB = W_G(p)[(size_t)t * 128 + 64 + lane];
    float actA = 0.f, actB = 0.f;
#pragma unroll 1
    for (int jb = 0; jb < 128; jb += 16) {
      u32x4 r[16];
#pragma unroll
      for (int u = 0; u < 16; ++u) {
        const int e = __builtin_amdgcn_readlane(jb < 64 ? idxA : idxB, (jb + u) & 63);
        r[u] = *(const u32x4*)(ub + (size_t)e * DM + 16 * lane);
      }
#pragma unroll
      for (int u = 0; u < 16; ++u) {
        float d = 0.f;
#pragma unroll
        for (int k = 0; k < 4; ++k) {
          const f32x2 lo = __builtin_amdgcn_cvt_pk_f32_fp8((int)r[u][k], false), hi = __builtin_amdgcn_cvt_pk_f32_fp8((int)r[u][k], true);
          d += xf[4 * k] * lo[0] + xf[4 * k + 1] * lo[1] + xf[4 * k + 2] * hi[0] + xf[4 * k + 3] * hi[1];
        }
        d = wave_sum(d);
        if (lane == ((jb + u) & 63)) { if (jb < 64) actA = d; else actB = d; }
      }
    }
    actA *= W_SU(p)[idxA]; actB *= W_SU(p)[idxB];
    const float wA = gA * (0.5f * actA * (1.0f + erff(actA * 0.7071067811865476f))) * W_SV(p)[idxA];
    const float wB = gB * (0.5f * actB * (1.0f + erff(actB * 0.7071067811865476f))) * W_SV(p)[idxB];
    float acc[16];
#pragma unroll
    for (int i = 0; i < 16; ++i) acc[i] = 0.f;
#pragma unroll 1
    for (int jb = 0; jb < 128; jb += 16) {
      u32x4 r[16];
      float wj[16];
#pragma unroll
      for (int u = 0; u < 16; ++u) {
        const int e = __builtin_amdgcn_readlane(jb < 64 ? idxA : idxB, (jb + u) & 63);
        wj[u] = __int_as_float(__builtin_amdgcn_readlane(__float_as_int(jb < 64 ? wA : wB), (jb + u) & 63));
        r[u] = *(const u32x4*)(vbt + (size_t)e * DM + 16 * lane);
      }
#pragma unroll
      for (int u = 0; u < 16; ++u) {
#pragma unroll
        for (int k = 0; k < 4; ++k) {
          const f32x2 lo = __builtin_amdgcn_cvt_pk_f32_fp8((int)r[u][k], false), hi = __builtin_amdgcn_cvt_pk_f32_fp8((int)r[u][k], true);
          acc[4 * k] += wj[u] * lo[0]; acc[4 * k + 1] += wj[u] * lo[1]; acc[4 * k + 2] += wj[u] * hi[0]; acc[4 * k + 3] += wj[u] * hi[1];
        }
      }
    }
#pragma unroll
    for (int i = 0; i < 16; ++i) acc[i] += ALPHA * xf[i];
    ln_row<1>(acc, P_LN2_G(p) + layer * DM, P_LN2_B(p) + layer * DM, lane);
    if (layer == DEPTH - 1) {
      const int b = t / LSEQ, pos = t - b * LSEQ;
      if (pos >= NMETA) {
        float* dst = p.out + ((size_t)b * SEQ + pos - NMETA) * DM + 16 * lane;
#pragma unroll
        for (int k = 0; k < 4; ++k) *(f32x4*)(dst + 4 * k) = (f32x4){acc[4 * k], acc[4 * k + 1], acc[4 * k + 2], acc[4 * k + 3]};
      }
    } else {
      store_row_bf16<1>(W_H(p) + (size_t)t * DM, acc, lane);
    }
  }
}

DI void phase_prologue(const Params& p, char* smem, int wave) {
  const int tid = otid_w(wave), lane = tid & 63, wid = tid >> 6, hb = tid >> 8, htid = tid & 255;
  const int nblk = gridDim.x, bid = blockIdx.x;
  const size_t gtid = (size_t)bid * NTHREADS + tid, gthreads = (size_t)nblk * NTHREADS;
  float* sm = (float*)(smem + hb * LDS_HALF);
  for (int it0 = bid; it0 < 2048; it0 += nblk) {
    const int it = it0 * 2 + hb;
    if (it < 3072) {
      const int l = it / 768, r = it % 768, kb = r / 48, nb = r % 48;
      transpose_tile(P_W_IN(p) + (size_t)l * 1024 * 3072, 3072, W_WIN(p) + (size_t)l * 3072 * 1024, 1024, kb * 64, nb * 64, sm, htid);
    } else {
      const int i2 = it - 3072, l = i2 / 256, r = i2 % 256, kb = r / 16, nb = r % 16;
      transpose_tile(P_W_OUT(p) + (size_t)l * 1024 * 1024, 1024, W_WOUT(p) + (size_t)l * 1024 * 1024, 1024, kb * 64, nb * 64, sm, htid);
    }
  }
  convert_straight(P_W_Q(p), W_WQB(p), (size_t)4 * 1024 * 2048 / 8, gtid, gthreads);
  convert_straight(P_SUB_KEYS(p), W_SKB(p), (size_t)4 * 16 * 128 * 128 / 8, gtid, gthreads);
  for (int t = bid * 8 + wid; t < TTOK; t += nblk * 8) {
    const int b = t / LSEQ, pos = t - b * LSEQ;
    const float* src = pos < NMETA ? P_META(p) + (size_t)pos * DM : P_X(p) + ((size_t)b * SEQ + pos - NMETA) * DM;
    float v[16];
    load_row_f32<0>(src, v, lane);
    ln_row<0>(v, P_LN_IN_G(p), P_LN_IN_B(p), lane);
    store_row_bf16<0>(W_H(p) + (size_t)t * DM, v, lane);
  }
}

DI void phase_fold(const Params& p, char* smem, int wave) {
  const int tid = otid_w(wave), hb = tid >> 8, htid = tid & 255;
  for (int it0 = blockIdx.x; it0 < 256; it0 += gridDim.x) {
    const int it = it0 * 2 + hb;
    const int l = it >> 7, hp = (it >> 3) & 15, mt = it & 7;
    gemm_tile_fold(W_WQB(p) + (size_t)l * 1024 * 2048 + hp * 128, 2048, W_SKB(p) + ((size_t)l * 16 + hp) * 128 * 128, 128, 128, mt * 128, smem + hb * 65536,
                   W_WSC(p) + (size_t)l * 2048 * 1024 + (size_t)hp * 128 * 1024, htid);
  }
}

DI bool tile_order(int i, int nM, int nN, int& pm, int& pn) {
  const int nwg = nM * nN;
  const long L = (long)i * gridDim.x + blockIdx.x;
  if (L >= nwg) return false;
  int wgid = (int)L;
  { const int q = nwg / 8, r = nwg % 8, xcd = wgid % 8, off = wgid / 8; wgid = (xcd < r ? xcd * (q + 1) : r * (q + 1) + (xcd - r) * q) + off; }
  const int nig = 8 * nN, gid = wgid / nig, fm = gid * 8, gsz = (nM - fm) < 8 ? (nM - fm) : 8;
  pm = fm + ((wgid % nig) % gsz); pn = (wgid % nig) / gsz;
  return true;
}

DI void phase_gemm(const Params& p, int layer, int which, char* smem, int wave) {
  const int tid0 = otid_w(wave);
  const u16* W = which == 0 ? W_WIN(p) + (size_t)layer * 3072 * 1024 : (which == 1 ? W_WOUT(p) + (size_t)layer * 1024 * 1024 : W_WSC(p) + (size_t)layer * 2048 * 1024);
  const u16* X = which == 1 ? W_MIX(p) : W_H(p);
  const int nN = which == 0 ? 12 : (which == 1 ? 4 : 8);
  int pm, pn;
  for (int i = 0; tile_order(i, 258, nN, pm, pn); ++i) {
    const bool vt = (which == 0) && (pn == 4 || pn == 5);
    const int mode = which == 0 ? (vt ? EPI_VT : EPI_PROJ) : (which == 1 ? EPI_OUT : EPI_TOPK);
    int tid = tid0;
    asm volatile("" : "+v"(tid));
    gemm256_tile(p, mode, layer, vt ? X : W, vt ? W : X, vt ? pm * 256 : pn * 256, vt ? pn * 256 : pm * 256, (lchar*)smem, tid);
  }
}

DI void phase_attn(const Params& p, int layer, char* smem, int wave) {
  const int tid = otid_w(wave), lane = tid & 63, hb = tid >> 8, htid = tid & 255;
  const float lam_init = 0.8f - 0.6f * expf(-0.3f * (float)layer);
  float d1 = P_LQ1(p)[layer * 64 + lane] * P_LK1(p)[layer * 64 + lane], d2 = P_LQ2(p)[layer * 64 + lane] * P_LK2(p)[layer * 64 + lane];
  d1 = wave_sum(d1); d2 = wave_sum(d2);
  const float lam = expf(d1) - expf(d2) + lam_init;
  for (int it = blockIdx.x; it < 2112 + 2064; it += gridDim.x) {
    if (it < 2112) {
      const int it2 = it * 2 + hb, qb = 32 - (it2 >> 7), bh = it2 & 127;
      attn_item(p, layer, bh >> 2, bh & 3, qb, smem + hb * LDS_HALF, lam, 1.0f - lam_init, htid);
    } else {
      conv_item(p, layer, (it - 2112) * 2 + hb, htid);
    }
  }
}

DI void phase_ln1(const Params& p, int layer, int wave) {
  const int tid = otid_w(wave), lane = tid & 63, wid = tid >> 6;
  const int nblk = gridDim.x, bid = blockIdx.x;
  for (int t = bid * 8 + wid; t < TTOK; t += nblk * 8) {
    float v[16];
    load_row_f32<0>(W_Y(p) + (size_t)t * DM, v, lane);
    ln_row<0>(v, P_LN1_G(p) + layer * DM, P_LN1_B(p) + layer * DM, lane);
    store_row_bf16<0>(W_H(p) + (size_t)t * DM, v, lane);
  }
  for (int r = bid * 8 + wid; r < 2 * PEER_N; r += nblk * 8) {
    const bool isv = r >= PEER_N;
    const int e = isv ? r - PEER_N : r;
    const float* src = (isv ? P_PEER_V(p) : P_PEER_U(p)) + ((size_t)layer * PEER_N + e) * DM + 16 * lane;
    f32x4 a[4];
#pragma unroll
    for (int k = 0; k < 4; ++k) a[k] = *(const f32x4*)(src + 4 * k);
    float am = 0.f;
#pragma unroll
    for (int k = 0; k < 4; ++k) am = fmaxf(am, fmaxf(fmaxf(fabsf(a[k][0]), fabsf(a[k][1])), fmaxf(fabsf(a[k][2]), fabsf(a[k][3]))));
    am = wave_max_nonneg(am);
    const float sc = am > 0.f ? 224.0f / am : 1.0f;
    if (lane == 0) (isv ? W_SV(p) : W_SU(p))[e] = am > 0.f ? am * (1.0f / 224.0f) : 1.0f;
    u32x4 o;
#pragma unroll
    for (int k = 0; k < 4; ++k) {
      int w = 0;
      w = __builtin_amdgcn_cvt_pk_fp8_f32(a[k][0] * sc, a[k][1] * sc, w, false);
      w = __builtin_amdgcn_cvt_pk_fp8_f32(a[k][2] * sc, a[k][3] * sc, w, true);
      o[k] = (unsigned)w;
    }
    *(u32x4*)((isv ? W_VB(p) : W_UB(p)) + (size_t)e * DM + 16 * lane) = o;
  }
}

DI void phase_peer(const Params& p, int layer, int wave) {
  const int tid = otid_w(wave), lane = tid & 63, wid = tid >> 6;
  for (int t = blockIdx.x * 8 + wid; t < TTOK; t += gridDim.x * 8) peer_token(p, layer, t, lane);
}

__global__ void __launch_bounds__(NTHREADS, 2) mega(Params p) {
  extern __shared__ __attribute__((aligned(16))) char smem[];
  cg::grid_group grid = cg::this_grid();
  int wave;
  {
    LAS unsigned* ticket = (LAS unsigned*)smem;
    if (threadIdx.x == 0) *ticket = 0u;
    __syncthreads();
    unsigned w = 0;
    if ((threadIdx.x & 63) == 0) w = atomicAdd((unsigned*)ticket, 1u);
    wave = __builtin_amdgcn_readfirstlane((int)w);
    __syncthreads();
  }
  phase_prologue(p, smem, wave);
  grid.sync();
  phase_fold(p, smem, wave);
  grid.sync();
#pragma unroll 1
  for (int step = 0; step < DEPTH * 6; ++step) {
    const int layer = step / 6, ph = step - layer * 6;
    if (ph == 0 || ph == 2 || ph == 4) phase_gemm(p, layer, ph >> 1, smem, wave);
    else if (ph == 1) phase_attn(p, layer, smem, wave);
    else if (ph == 3) phase_ln1(p, layer, wave);
    else phase_peer(p, layer, wave);
    grid.sync();
  }
}

extern "C" void kernel_launch(void* const* d_in, const int* in_sizes, int n_in, void* d_out, int out_size, void* d_ws, size_t ws_size,
                              hipStream_t stream) {
  static int grid_blocks = 0;
  if (grid_blocks == 0) {
    if (ws_size < WS_END) { fprintf(stderr, "kernel_launch: workspace too small: need %zu, got %zu\n", (size_t)WS_END, ws_size); grid_blocks = -1; return; }
    int dev = 0, cus = 0, per_cu = 0;
    hipGetDevice(&dev);
    hipDeviceGetAttribute(&cus, hipDeviceAttributeMultiprocessorCount, dev);
    hipFuncSetAttribute((const void*)mega, hipFuncAttributeMaxDynamicSharedMemorySize, LDS_BYTES);
    hipOccupancyMaxActiveBlocksPerMultiprocessor(&per_cu, (const void*)mega, NTHREADS, LDS_BYTES);
    if (per_cu < 1) per_cu = 1;
    if (per_cu > 1) per_cu = 1;
    grid_blocks = cus * per_cu;
  }
  if (grid_blocks < 0) return;
  Params p{};
  for (int i = 0; i < 21; ++i) p.in[i] = (const float*)d_in[i];
  p.out = (float*)d_out;
  p.ws = (char*)d_ws;
  void* args[] = {&p};
  hipError_t e = hipLaunchCooperativeKernel((const void*)mega, dim3(grid_blocks), dim3(NTHREADS), args, LDS_BYTES, stream);
  if (e != hipSuccess) fprintf(stderr, "cooperative launch failed: %s (grid %d)\n", hipGetErrorString(e), grid_blocks);
}
```

```cpp
#include <hip/hip_runtime.h>
#include <hip/hip_cooperative_groups.h>
#include <cstdio>
#include <cstdint>
namespace cg = cooperative_groups;

typedef unsigned short u16;
typedef __attribute__((ext_vector_type(8))) short bf16x8;
typedef __attribute__((ext_vector_type(4))) float f32x4;
typedef __attribute__((ext_vector_type(4))) unsigned u32x4;
typedef __attribute__((ext_vector_type(2))) unsigned u32x2;
typedef __attribute__((ext_vector_type(2))) float f32x2;
#define DI __device__ __forceinline__
#define LAS __attribute__((address_space(3)))
typedef LAS char lchar;

#define DM 1024
#define NBATCH 32
#define SEQ 2048
#define NMETA 16
#define LSEQ 2064
#define TTOK 66048
#define DEPTH 4
#define INC 3072
#define LP 2112
#define PEER_N 16384
#define NTHREADS 512
#define LDS_MISC 69632
#define LDS_HALF 70656
#define LDS_BYTES 141312

#define ALPHA 1.681792830507429f
#define LOG2E 1.4426950408889634f

static constexpr size_t WS_WIN  = 0;
static constexpr size_t WS_WOUT = WS_WIN  + (size_t)4 * 3072 * 1024 * 2;
static constexpr size_t WS_WQB  = WS_WOUT + (size_t)4 * 1024 * 1024 * 2;
static constexpr size_t WS_SKB  = WS_WQB  + (size_t)4 * 1024 * 2048 * 2;
static constexpr size_t WS_WSC  = WS_SKB  + (size_t)4 * 16 * 128 * 128 * 2;
static constexpr size_t WS_UB   = WS_WSC  + (size_t)4 * 2048 * 1024 * 2;
static constexpr size_t WS_VB   = WS_UB   + (size_t)PEER_N * 1024;
static constexpr size_t WS_SU   = WS_VB   + (size_t)PEER_N * 1024;
static constexpr size_t WS_SV   = WS_SU   + (size_t)PEER_N * 4;
static constexpr size_t WS_H    = WS_SV   + (size_t)PEER_N * 4;
static constexpr size_t WS_MIX  = WS_H    + (size_t)TTOK * 1024 * 2;
static constexpr size_t WS_BIG  = WS_MIX  + (size_t)TTOK * 1024 * 2;
static constexpr size_t WS_VT   = WS_BIG  + (size_t)(TTOK + 64) * 3072 * 2;
static constexpr size_t WS_IDX  = WS_VT   + (size_t)NBATCH * 4 * 128 * LP * 2;
static constexpr size_t WS_G    = WS_IDX  + (size_t)TTOK * 128 * 4;
static constexpr size_t WS_END  = WS_G    + (size_t)TTOK * 128 * 4;

struct Params {
  const float* in[21];
  float* out;
  char* ws;
};
#define P_X(p) ((p).in[0])
#define P_META(p) ((p).in[1])
#define P_LN_IN_G(p) ((p).in[2])
#define P_LN_IN_B(p) ((p).in[3])
#define P_REL_BIAS(p) ((p).in[4])
#define P_W_IN(p) ((p).in[5])
#define P_CONV_W(p) ((p).in[6])
#define P_LQ1(p) ((p).in[7])
#define P_LK1(p) ((p).in[8])
#define P_LQ2(p) ((p).in[9])
#define P_LK2(p) ((p).in[10])
#define P_SUBLN_G(p) ((p).in[11])
#define P_W_OUT(p) ((p).in[12])
#define P_LN1_G(p) ((p).in[13])
#define P_LN1_B(p) ((p).in[14])
#define P_W_Q(p) ((p).in[15])
#define P_SUB_KEYS(p) ((p).in[16])
#define P_PEER_U(p) ((p).in[17])
#define P_PEER_V(p) ((p).in[18])
#define P_LN2_G(p) ((p).in[19])
#define P_LN2_B(p) ((p).in[20])
#define W_WIN(p) ((u16*)((p).ws + WS_WIN))
#define W_WOUT(p) ((u16*)((p).ws + WS_WOUT))
#define W_WQB(p) ((u16*)((p).ws + WS_WQB))
#define W_SKB(p) ((u16*)((p).ws + WS_SKB))
#define W_WSC(p) ((u16*)((p).ws + WS_WSC))
#define W_UB(p) ((unsigned char*)((p).ws + WS_UB))
#define W_VB(p) ((unsigned char*)((p).ws + WS_VB))
#define W_SU(p) ((float*)((p).ws + WS_SU))
#define W_SV(p) ((float*)((p).ws + WS_SV))
#define W_H(p) ((u16*)((p).ws + WS_H))
#define W_MIX(p) ((u16*)((p).ws + WS_MIX))
#define W_PROJ(p) ((u16*)((p).ws + WS_BIG))
#define W_Y(p) ((float*)((p).ws + WS_BIG))
#define W_VT(p) ((u16*)((p).ws + WS_VT))
#define W_IDX(p) ((int*)((p).ws + WS_IDX))
#define W_G(p) ((float*)((p).ws + WS_G))

DI u16 f2bf(float x) { unsigned u = __float_as_uint(x); u += 0x7fffu + ((u >> 16) & 1u); return (u16)(u >> 16); }
DI unsigned pack2(float a, float b) {
  unsigned ua = __float_as_uint(a), ub = __float_as_uint(b);
  ua += 0x7fffu + ((ua >> 16) & 1u); ub += 0x7fffu + ((ub >> 16) & 1u);
  return (ua >> 16) | (ub & 0xffff0000u);
}
DI float bflo(unsigned w) { return __uint_as_float(w << 16); }
DI float bfhi(unsigned w) { return __uint_as_float(w & 0xffff0000u); }
DI int otid_w(int wave) { unsigned z = 0u; asm volatile("" : "+v"(z)); int t = wave * 64 + (int)__builtin_amdgcn_mbcnt_hi(~0u, __builtin_amdgcn_mbcnt_lo(~0u, z)); asm volatile("" : "+v"(t)); return t; }
#define DPP_ADD(v, ctrl) ((v) + __int_as_float(__builtin_amdgcn_update_dpp(0, __float_as_int(v), (ctrl), 0xf, 0xf, true)))
DI float wave_sum(float v) {
  v = DPP_ADD(v, 0xB1);
  v = DPP_ADD(v, 0x4E);
  v = DPP_ADD(v, 0x141);
  v = DPP_ADD(v, 0x140);
  const int iv = __float_as_int(v);
  return __int_as_float(__builtin_amdgcn_readlane(iv, 0)) + __int_as_float(__builtin_amdgcn_readlane(iv, 16)) +
         __int_as_float(__builtin_amdgcn_readlane(iv, 32)) + __int_as_float(__builtin_amdgcn_readlane(iv, 48));
}
#define DPP_MAX(v, ctrl) fmaxf((v), __int_as_float(__builtin_amdgcn_update_dpp(0, __float_as_int(v), (ctrl), 0xf, 0xf, true)))
DI float wave_max_nonneg(float v) {
  v = DPP_MAX(v, 0xB1); v = DPP_MAX(v, 0x4E); v = DPP_MAX(v, 0x141); v = DPP_MAX(v, 0x140);
  const int iv = __float_as_int(v);
  return fmaxf(fmaxf(__int_as_float(__builtin_amdgcn_readlane(iv, 0)), __int_as_float(__builtin_amdgcn_readlane(iv, 16))),
               fmaxf(__int_as_float(__builtin_amdgcn_readlane(iv, 32)), __int_as_float(__builtin_amdgcn_readlane(iv, 48))));
}
DI float shx16(float v) { return __int_as_float(__builtin_amdgcn_ds_swizzle(__float_as_int(v), 0x401F)); }
DI float shx32(float v, int idx32) { return __int_as_float(__builtin_amdgcn_ds_bpermute(idx32, __float_as_int(v))); }
DI f32x4 mfma16(bf16x8 a, bf16x8 b, f32x4 c) { return __builtin_amdgcn_mfma_f32_16x16x32_bf16(a, b, c, 0, 0, 0); }
DI float fast_exp2(float x) { return __builtin_amdgcn_exp2f(x); }

DI void convert_straight(const float* __restrict__ src, u16* __restrict__ dst, size_t n8, size_t gtid, size_t gthreads) {
  for (size_t i = gtid; i < n8; i += gthreads) {
    const f32x4 a = *(const f32x4*)(src + i * 8), b = *(const f32x4*)(src + i * 8 + 4);
    u32x4 o; o[0] = pack2(a[0], a[1]); o[1] = pack2(a[2], a[3]); o[2] = pack2(b[0], b[1]); o[3] = pack2(b[2], b[3]);
    *(u32x4*)(dst + i * 8) = o;
  }
}

DI void transpose_tile(const float* __restrict__ src, int ldn, u16* __restrict__ dst, int ldk, int k0, int n0, float* sm, int tid) {
#pragma unroll
  for (int i = 0; i < 4; ++i) {
    const int r = (tid >> 4) + 16 * i, c4 = tid & 15;
    const f32x4 v = *(const f32x4*)(src + (size_t)(k0 + r) * ldn + n0 + 4 * c4);
    sm[r * 65 + 4 * c4 + 0] = v[0]; sm[r * 65 + 4 * c4 + 1] = v[1]; sm[r * 65 + 4 * c4 + 2] = v[2]; sm[r * 65 + 4 * c4 + 3] = v[3];
  }
  __syncthreads();
#pragma unroll
  for (int i = 0; i < 2; ++i) {
    const int n = (tid >> 3) + 32 * i, kc = tid & 7;
    u32x4 o;
#pragma unroll
    for (int e = 0; e < 4; ++e) o[e] = pack2(sm[(8 * kc + 2 * e) * 65 + n], sm[(8 * kc + 2 * e + 1) * 65 + n]);
    *(u32x4*)(dst + (size_t)(n0 + n) * ldk + k0 + 8 * kc) = o;
  }
  __syncthreads();
}

template <int LAYOUT> DI int col0(int lane, int hh) { return LAYOUT ? 16 * lane + 8 * hh : hh * 512 + 8 * lane; }
template <int LAYOUT>
DI void ln_row(float (&v)[16], const float* __restrict__ g, const float* __restrict__ b, int lane) {
  float s = 0.f;
#pragma unroll
  for (int i = 0; i < 16; ++i) s += v[i];
  const float mu = wave_sum(s) * (1.0f / 1024.0f);
  float q = 0.f;
#pragma unroll
  for (int i = 0; i < 16; ++i) { const float d = v[i] - mu; q += d * d; }
  const float rstd = rsqrtf(wave_sum(q) * (1.0f / 1024.0f) + 1e-5f);
#pragma unroll
  for (int hh = 0; hh < 2; ++hh) {
    const int c = col0<LAYOUT>(lane, hh);
    const f32x4 g0 = *(const f32x4*)(g + c), g1 = *(const f32x4*)(g + c + 4), b0 = *(const f32x4*)(b + c), b1 = *(const f32x4*)(b + c + 4);
#pragma unroll
    for (int e = 0; e < 4; ++e) {
      v[hh * 8 + e] = (v[hh * 8 + e] - mu) * rstd * g0[e] + b0[e];
      v[hh * 8 + 4 + e] = (v[hh * 8 + 4 + e] - mu) * rstd * g1[e] + b1[e];
    }
  }
}
template <int LAYOUT>
DI void store_row_bf16(u16* __restrict__ dst, const float (&v)[16], int lane) {
#pragma unroll
  for (int hh = 0; hh < 2; ++hh) {
    u32x4 o;
#pragma unroll
    for (int e = 0; e < 4; ++e) o[e] = pack2(v[hh * 8 + 2 * e], v[hh * 8 + 2 * e + 1]);
    *(u32x4*)(dst + col0<LAYOUT>(lane, hh)) = o;
  }
}
template <int LAYOUT>
DI void load_row_f32(const float* __restrict__ src, float (&v)[16], int lane) {
#pragma unroll
  for (int hh = 0; hh < 2; ++hh) {
    const int c = col0<LAYOUT>(lane, hh);
    const f32x4 a = *(const f32x4*)(src + c), b = *(const f32x4*)(src + c + 4);
#pragma unroll
    for (int e = 0; e < 4; ++e) { v[hh * 8 + e] = a[e]; v[hh * 8 + 4 + e] = b[e]; }
  }
}

enum { EPI_PROJ = 0, EPI_VT = 1, EPI_OUT = 2, EPI_TOPK = 3, EPI_FOLD = 4 };

template <bool SWAP>
DI void gemm_mainloop(const u16* __restrict__ A, int lda, const u16* __restrict__ Bt, int ldb, int K, int m0, int n0, char* smem,
                      f32x4 (&acc)[4][4], int tid) {
  const int lane = tid & 63, wid = tid >> 6, wm = wid >> 1, wn = wid & 1;
  const int srow = tid >> 3, skc = tid & 7;
  const u16* ap = A + (size_t)(m0 + srow) * lda + skc * 8;
  const u16* bp = Bt + (size_t)(n0 + srow) * ldb + skc * 8;
  const int dst0 = (((srow >> 4) * 2 + (skc >> 2)) * 1024) + (((skc & 3) * 16 + (srow & 15)) * 16);
#pragma unroll
  for (int i = 0; i < 4; ++i)
#pragma unroll
    for (int j = 0; j < 4; ++j) acc[i][j] = (f32x4){0.f, 0.f, 0.f, 0.f};
  u32x4 ra[4], rb[4];
#pragma unroll
  for (int j = 0; j < 4; ++j) { ra[j] = *(const u32x4*)(ap + (size_t)j * 32 * lda); rb[j] = *(const u32x4*)(bp + (size_t)j * 32 * ldb); }
#pragma unroll
  for (int j = 0; j < 4; ++j) { *(u32x4*)(smem + dst0 + j * 4096) = ra[j]; *(u32x4*)(smem + 16384 + dst0 + j * 4096) = rb[j]; }
  __syncthreads();
  const int KT = K >> 6;
  for (int kt = 0; kt < KT; ++kt) {
    char* cur = smem + (kt & 1) * 32768;
    char* nxt = smem + ((kt + 1) & 1) * 32768;
    const bool more = (kt + 1 < KT);
    if (more) {
      const u16* ap2 = ap + (kt + 1) * 64;
      const u16* bp2 = bp + (kt + 1) * 64;
#pragma unroll
      for (int j = 0; j < 4; ++j) { ra[j] = *(const u32x4*)(ap2 + (size_t)j * 32 * lda); rb[j] = *(const u32x4*)(bp2 + (size_t)j * 32 * ldb); }
    }
#pragma unroll
    for (int ks = 0; ks < 2; ++ks) {
      bf16x8 af[4], bfr[4];
#pragma unroll
      for (int i = 0; i < 4; ++i) af[i] = *(const bf16x8*)(cur + (((wm * 4 + i) * 2 + ks) * 1024) + lane * 16);
#pragma unroll
      for (int j = 0; j < 4; ++j) bfr[j] = *(const bf16x8*)(cur + 16384 + (((wn * 4 + j) * 2 + ks) * 1024) + lane * 16);
#pragma unroll
      for (int i = 0; i < 4; ++i)
#pragma unroll
        for (int j = 0; j < 4; ++j) acc[i][j] = SWAP ? mfma16(bfr[j], af[i], acc[i][j]) : mfma16(af[i], bfr[j], acc[i][j]);
    }
    if (more) {
#pragma unroll
      for (int j = 0; j < 4; ++j) { *(u32x4*)(nxt + dst0 + j * 4096) = ra[j]; *(u32x4*)(nxt + 16384 + dst0 + j * 4096) = rb[j]; }
    }
    __syncthreads();
  }
}

DI void insert16(float (&v)[16], float x) {
#pragma unroll
  for (int j = 0; j < 16; ++j) { const float hi = fmaxf(v[j], x); x = fminf(v[j], x); v[j] = hi; }
}

DI void gemm_tile_fold(const u16* A, int lda, const u16* Bt, int ldb, int K, int m0, char* smem, u16* dstT, int tid) {
  const int lane = tid & 63, wid = tid >> 6, wm = wid >> 1, wn = wid & 1, g = lane >> 4, l15 = lane & 15;
  f32x4 acc[4][4];
  gemm_mainloop<false>(A, lda, Bt, ldb, K, m0, 0, smem, acc, tid);
#pragma unroll
  for (int i = 0; i < 4; ++i)
#pragma unroll
    for (int j = 0; j < 4; ++j) {
      const int m = m0 + wm * 64 + 16 * i + 4 * g, n = wn * 64 + 16 * j + l15;
      u32x2 o; o[0] = pack2(acc[i][j][0], acc[i][j][1]); o[1] = pack2(acc[i][j][2], acc[i][j][3]);
      *(u32x2*)(dstT + (size_t)n * 1024 + m) = o;
    }
}

#define GK 1024
#define HTB 16384
DI int lds_byte(int r, int c) {
  const int st = (r >> 4) * 2 + (c >> 5), rr = r & 15, cc = c & 31, ob = rr * 64 + cc * 2;
  return st * 1024 + (ob ^ (((ob >> 9) & 1) << 5));
}
DI void stage_rc(int b, int& R, int& C) {
  const int st = b / 1024, sb = b % 1024, swz = sb ^ (((sb >> 9) & 1) << 5);
  R = (st >> 1) * 16 + swz / 64; C = (st & 1) * 32 + (swz % 64) / 2;
}
#define G_SA(b, h) (shm + ((b) * 2 + (h)) * HTB)
#define G_SB(b, h) (shm + (4 + (b) * 2 + (h)) * HTB)
#define G_STAGE(P, BASE, br, kt) do { const char* _g = (const char*)((BASE) + (size_t)(br) * GK + (kt) * 64); \
    __builtin_amdgcn_global_load_lds((const unsigned*)(_g + goff0), (LAS unsigned*)((P) + tid * 16), 16, 0, 0); \
    __builtin_amdgcn_global_load_lds((const unsigned*)(_g + goff1), (LAS unsigned*)((P) + tid * 16 + 8192), 16, 0, 0); } while (0)
#define G_LDA(dst, b, h) _Pragma("unroll") for (int m = 0; m < 4; ++m) _Pragma("unroll") for (int k = 0; k < 2; ++k) \
    dst[m][k] = *(const LAS bf16x8*)(G_SA(b, h) + lds_byte(wr * 64 + m * 16 + fr, k * 32 + fq * 8))
#define G_LDB(dst, b, h) _Pragma("unroll") for (int n = 0; n < 2; ++n) _Pragma("unroll") for (int k = 0; k < 2; ++k) \
    dst[n][k] = *(const LAS bf16x8*)(G_SB(b, h) + lds_byte(wc * 32 + n * 16 + fr, k * 32 + fq * 8))
#define G_MMA(ai, bj, At, Bx) do { __builtin_amdgcn_s_setprio(1); \
    _Pragma("unroll") for (int m = 0; m < 4; ++m) _Pragma("unroll") for (int n = 0; n < 2; ++n) _Pragma("unroll") for (int k = 0; k < 2; ++k) \
      acc[ai][bj][m][n] = __builtin_amdgcn_mfma_f32_16x16x32_bf16(At[m][k], Bx[n][k], acc[ai][bj][m][n], 0, 0, 0); \
    __builtin_amdgcn_s_setprio(0); } while (0)
#define WAIT_V(n) asm volatile("s_waitcnt vmcnt(" #n ")" ::: "memory")
#define WAIT_L(n) asm volatile("s_waitcnt lgkmcnt(" #n ")" ::: "memory")
#define BAR __builtin_amdgcn_s_barrier()
#define SCHED __builtin_amdgcn_sched_barrier(0)

DI void gemm256_core(const u16* __restrict__ A, const u16* __restrict__ Bt, int brow, int bcol, lchar* shm, int tid, f32x4 (&acc)[2][2][4][2]) {
  const int wid = tid >> 6, lane = tid & 63, wr = wid >> 2, wc = wid & 3, fr = lane & 15, fq = lane >> 4;
  int r0, c0, r1, c1;
  stage_rc(tid * 16, r0, c0); stage_rc(tid * 16 + 8192, r1, c1);
  const unsigned goff0 = (unsigned)(r0 * GK + c0) * 2u, goff1 = (unsigned)(r1 * GK + c1) * 2u;
#pragma unroll
  for (int ai = 0; ai < 2; ++ai)
#pragma unroll
    for (int bj = 0; bj < 2; ++bj)
#pragma unroll
      for (int m = 0; m < 4; ++m)
#pragma unroll
        for (int n = 0; n < 2; ++n) acc[ai][bj][m][n] = (f32x4){0.f, 0.f, 0.f, 0.f};
  bf16x8 At[4][2], B0[2][2], B1[2][2];
  const int nt = GK / 64;
  WAIT_V(0);
  __syncthreads();
  G_STAGE(G_SB(0, 0), Bt, bcol, 0); G_STAGE(G_SA(0, 0), A, brow, 0);
  G_STAGE(G_SB(0, 1), Bt, bcol + 128, 0); G_STAGE(G_SA(0, 1), A, brow + 128, 0);
  if (wr == 1) BAR;
  WAIT_V(4); BAR;
  G_STAGE(G_SB(1, 0), Bt, bcol, 1); G_STAGE(G_SA(1, 0), A, brow, 1); G_STAGE(G_SB(1, 1), Bt, bcol + 128, 1);
  WAIT_V(6); BAR;
  for (int t = 0; t < nt - 2; t += 2) {
    G_LDB(B0, 0, 0); SCHED; G_LDA(At, 0, 0); G_STAGE(G_SA(1, 1), A, brow + 128, t + 1);
    WAIT_L(8); BAR; WAIT_L(0); G_MMA(0, 0, At, B0); BAR; SCHED;
    G_LDB(B1, 0, 1); G_STAGE(G_SB(0, 0), Bt, bcol, t + 2);
    BAR; WAIT_L(0); G_MMA(0, 1, At, B1); BAR;
    G_LDA(At, 0, 1); G_STAGE(G_SA(0, 0), A, brow, t + 2);
    BAR; WAIT_L(0); G_MMA(1, 0, At, B0); BAR; SCHED;
    G_STAGE(G_SB(0, 1), Bt, bcol + 128, t + 2);
    WAIT_V(6); BAR; G_MMA(1, 1, At, B1); BAR;
    G_LDB(B0, 1, 0); SCHED; G_LDA(At, 1, 0); G_STAGE(G_SA(0, 1), A, brow + 128, t + 2);
    WAIT_L(8); BAR; WAIT_L(0); G_MMA(0, 0, At, B0); BAR; SCHED;
    G_LDB(B1, 1, 1); G_STAGE(G_SB(1, 0), Bt, bcol, t + 3);
    BAR; WAIT_L(0); G_MMA(0, 1, At, B1); BAR;
    G_LDA(At, 1, 1); G_STAGE(G_SA(1, 0), A, brow, t + 3);
    BAR; WAIT_L(0); G_MMA(1, 0, At, B0); BAR; SCHED;
    G_STAGE(G_SB(1, 1), Bt, bcol + 128, t + 3);
    WAIT_V(6); BAR; G_MMA(1, 1, At, B1); BAR;
  }
  { G_LDB(B0, 0, 0); G_LDA(At, 0, 0); G_STAGE(G_SA(1, 1), A, brow + 128, nt - 1);
    BAR; WAIT_L(0); G_MMA(0, 0, At, B0); BAR;
    G_LDB(B1, 0, 1); BAR; WAIT_L(0); G_MMA(0, 1, At, B1); BAR;
    G_LDA(At, 0, 1); WAIT_V(4); BAR; WAIT_L(0); G_MMA(1, 0, At, B0); G_MMA(1, 1, At, B1); BAR; }
  { G_LDB(B0, 1, 0); G_LDA(At, 1, 0); WAIT_V(2); BAR; WAIT_L(0); G_MMA(0, 0, At, B0); BAR;
    G_LDB(B1, 1, 1); WAIT_V(0); BAR; WAIT_L(0); G_MMA(0, 1, At, B1); BAR;
    G_LDA(At, 1, 1); BAR; WAIT_L(0); G_MMA(1, 0, At, B0); G_MMA(1, 1, At, B1); BAR; }
  if (wr == 0) BAR;
}

DI void gemm256_tile(const Params& p, int mode, int layer, const u16* R, const u16* Cc, int brow, int bcol, lchar* shm, int tid_in) {
  f32x4 acc[2][2][4][2];
  gemm256_core(R, Cc, brow, bcol, shm, tid_in, acc);
  int tid = tid_in;
  asm volatile("" : "+v"(tid));
  const int wid = tid >> 6, lane = tid & 63, wr = wid >> 2, wc = wid & 3, fr = lane & 15, fq = lane >> 4;
  if (mode == EPI_PROJ) {
#pragma unroll
    for (int ai = 0; ai < 2; ++ai)
#pragma unroll
      for (int bj = 0; bj < 2; ++bj)
#pragma unroll
        for (int m = 0; m < 4; ++m)
#pragma unroll
          for (int n = 0; n < 2; ++n) {
            const int nc = brow + ai * 128 + wr * 64 + m * 16 + fq * 4, tok = bcol + bj * 128 + wc * 32 + n * 16 + fr;
            const f32x4 v = acc[ai][bj][m][n];
            u32x2 o; o[0] = pack2(v[0], v[1]); o[1] = pack2(v[2], v[3]);
            *(u32x2*)(W_PROJ(p) + (size_t)tok * INC + nc) = o;
          }
  } else if (mode == EPI_VT) {
#pragma unroll
    for (int ai = 0; ai < 2; ++ai)
#pragma unroll
      for (int bj = 0; bj < 2; ++bj)
#pragma unroll
        for (int m = 0; m < 4; ++m)
#pragma unroll
          for (int n = 0; n < 2; ++n) {
            const int tok = brow + ai * 128 + wr * 64 + m * 16 + fq * 4, nn = bcol + bj * 128 + wc * 32 + n * 16 + fr - 1024;
            const int b = tok / LSEQ, pos = tok - b * LSEQ;
            const f32x4 v = acc[ai][bj][m][n];
            u32x2 o; o[0] = pack2(v[0], v[1]); o[1] = pack2(v[2], v[3]);
            *(u32x2*)(W_VT(p) + ((size_t)(b * 512 + nn)) * LP + pos) = o;
          }
  } else if (mode == EPI_OUT) {
#pragma unroll
    for (int ai = 0; ai < 2; ++ai)
#pragma unroll
      for (int bj = 0; bj < 2; ++bj)
#pragma unroll
        for (int m = 0; m < 4; ++m)
#pragma unroll
          for (int n = 0; n < 2; ++n) {
            const int nc = brow + ai * 128 + wr * 64 + m * 16 + fq * 4, tok = bcol + bj * 128 + wc * 32 + n * 16 + fr;
            const u32x2 hv = *(const u32x2*)(W_H(p) + (size_t)tok * DM + nc);
            const f32x4 v = acc[ai][bj][m][n];
            f32x4 o;
            o[0] = ALPHA * bflo(hv[0]) + v[0]; o[1] = ALPHA * bfhi(hv[0]) + v[1];
            o[2] = ALPHA * bflo(hv[1]) + v[2]; o[3] = ALPHA * bfhi(hv[1]) + v[3];
            *(f32x4*)(W_Y(p) + (size_t)tok * DM + nc) = o;
          }
  } else {
    LAS float* S = (LAS float*)shm;
    const int tok = tid & 255, kh = tid >> 8;
    float L0[16], L1[16];
#pragma unroll
    for (int ai = 0; ai < 2; ++ai) {
      __syncthreads();
#pragma unroll
      for (int bj = 0; bj < 2; ++bj)
#pragma unroll
        for (int m = 0; m < 4; ++m)
#pragma unroll
          for (int n = 0; n < 2; ++n) {
            const int tk = bj * 128 + wc * 32 + n * 16 + fr, key = wr * 64 + m * 16 + fq * 4;
#pragma unroll
            for (int j = 0; j < 4; ++j) S[tk * 128 + ((key + j + tk) & 127)] = acc[ai][bj][m][n][j];
          }
      __syncthreads();
      float v[16];
#pragma unroll
      for (int j = 0; j < 16; ++j) v[j] = -3.0e38f;
      for (int i = 0; i < 64; ++i) {
        const int key = kh * 64 + i;
        const float x = S[tok * 128 + ((key + tok) & 127)];
        insert16(v, __uint_as_float((__float_as_uint(x) & ~127u) | (unsigned)key));
      }
      __syncthreads();
      if (kh == 1) {
#pragma unroll
        for (int j = 0; j < 16; ++j) S[tok * 16 + j] = v[j];
      }
      __syncthreads();
      if (kh == 0) {
#pragma unroll
        for (int j = 0; j < 16; ++j) insert16(v, S[tok * 16 + j]);
      }
#pragma unroll
      for (int j = 0; j < 16; ++j) { if (ai == 0) L0[j] = v[j]; else L1[j] = v[j]; }
    }
    __syncthreads();
    LAS unsigned* LL = (LAS unsigned*)shm;
    if (kh == 0) {
#pragma unroll
      for (int j = 0; j < 16; ++j) { LL[tok * 32 + ((j + tok) & 31)] = __float_as_uint(L0[j]); LL[tok * 32 + ((16 + j + tok) & 31)] = __float_as_uint(L1[j]); }
      float s1[16], s2[16], v[16];
#pragma unroll
      for (int j = 0; j < 16; ++j) { s1[j] = __uint_as_float(__float_as_uint(L0[j]) & ~127u); s2[j] = __uint_as_float(__float_as_uint(L1[j]) & ~127u); v[j] = -3.0e38f; }
#pragma unroll
      for (int a = 0; a < 16; ++a)
#pragma unroll
        for (int bb = 0; bb < 16 / (a + 1); ++bb) {
          const float sm = s1[a] + s2[bb];
          insert16(v, __uint_as_float((__float_as_uint(sm) & ~255u) | (unsigned)(a * 16 + bb)));
        }
      float e[16], sum = 0.f;
      const float mx = __uint_as_float(__float_as_uint(v[0]) & ~255u);
#pragma unroll
      for (int j = 0; j < 16; ++j) { e[j] = fast_exp2((__uint_as_float(__float_as_uint(v[j]) & ~255u) - mx) * LOG2E); sum += e[j]; }
      const float inv = 1.0f / sum;
      const int hd = brow >> 8;
      int* di = W_IDX(p) + (size_t)(bcol + tok) * 128 + hd * 16;
      float* dg = W_G(p) + (size_t)(bcol + tok) * 128 + hd * 16;
#pragma unroll
      for (int q = 0; q < 4; ++q) {
        u32x4 oi; f32x4 og;
#pragma unroll
        for (int k = 0; k < 4; ++k) {
          const unsigned code = __float_as_uint(v[4 * q + k]) & 255u;
          const unsigned i1 = LL[tok * 32 + (((code >> 4) + tok) & 31)] & 127u, i2 = LL[tok * 32 + ((16 + (code & 15u) + tok) & 31)] & 127u;
          oi[k] = i1 * 128u + i2; og[k] = e[4 * q + k] * inv;
        }
        *(u32x4*)(di + 4 * q) = oi; *(f32x4*)(dg + 4 * q) = og;
      }
    }
    __syncthreads();
  }
}

DI void attn_item(const Params& p, int layer, int b, int hh, int qb, char* smem, float lam, float oml, int tid) {
  const int lane = tid & 63, w = tid >> 6, g = lane >> 4, l15 = lane & 15;
  const int idx32 = (lane ^ 32) << 2;
  float* tab = (float*)(smem + LDS_MISC);
  float* sg = tab + 128;
  __syncthreads();
  if (tid < 128) {
    int bucket = tid;
    if (tid >= 16) {
      int lg = 16 + (int)(logf((float)tid * (1.0f / 16.0f)) / 2.0794415416798357f * 16.0f);
      bucket = lg < 31 ? lg : 31;
    }
    tab[tid] = P_REL_BIAS(p)[bucket * 4 + hh] * LOG2E;
    sg[tid] = P_SUBLN_G(p)[layer * 128 + tid] * oml;
  }
  const int qpos = 64 * qb + 16 * w + l15;
  const int qrow = b * LSEQ + (qpos < LSEQ ? qpos : LSEQ - 1);
  bf16x8 qf[2][2];
  {
    const u16* qp = W_PROJ(p) + (size_t)qrow * INC + hh * 128 + g * 8;
#pragma unroll
    for (int m = 0; m < 2; ++m)
#pragma unroll
      for (int ks = 0; ks < 2; ++ks) qf[m][ks] = *(const bf16x8*)(qp + m * 64 + ks * 32);
  }
  const int nkt = qb + 1;
  const int kkey = tid >> 4, kc = tid & 15;
  const u16* ksrc = W_PROJ(p) + (size_t)(b * LSEQ + kkey) * INC + 512 + hh * 128 + kc * 8;
  const int kdst0 = ((((kc >> 3) * 2 + ((kc >> 2) & 1)) * 1024) + (((kc & 3) * 16 + kkey) * 16));
  const int vdv = tid >> 3, vc = tid & 7;
  const u16* vsrc = W_VT(p) + ((size_t)((b * 4 + hh) * 128 + vdv)) * LP + vc * 8;
  const int vdst0 = vdv * 144 + vc * 16;
  char* Kb = smem;
  char* Vb = smem + 32768;

  u32x4 rs[4];
#pragma unroll
  for (int j = 0; j < 4; ++j) rs[j] = *(const u32x4*)(ksrc + (size_t)(16 * j) * INC);
#pragma unroll
  for (int j = 0; j < 4; ++j) *(u32x4*)(Kb + kdst0 + j * 4096) = rs[j];
#pragma unroll
  for (int j = 0; j < 4; ++j) rs[j] = *(const u32x4*)(vsrc + (size_t)(32 * j) * LP);
#pragma unroll
  for (int j = 0; j < 4; ++j) *(u32x4*)(Vb + vdst0 + j * 4608) = rs[j];
  __syncthreads();

  f32x4 O[2][8];
#pragma unroll
  for (int m = 0; m < 2; ++m)
#pragma unroll
    for (int dt = 0; dt < 8; ++dt) O[m][dt] = (f32x4){0.f, 0.f, 0.f, 0.f};
  float mrun[2] = {-1.0e30f, -1.0e30f}, lsum[2] = {0.f, 0.f};
  const float tfar = tab[127];

  for (int kt = 0; kt < nkt; ++kt) {
    const int cur = kt & 1;
    const bool more = (kt + 1 < nkt);
    if (more) {
#pragma unroll
      for (int j = 0; j < 4; ++j) rs[j] = *(const u32x4*)(ksrc + (size_t)(64 * (kt + 1) + 16 * j) * INC);
    }
    const char* kb = Kb + cur * 16384;
    const char* vb = Vb + cur * 18432;
    f32x4 S[2][4];
#pragma unroll
    for (int k16 = 0; k16 < 4; ++k16)
#pragma unroll
      for (int m = 0; m < 2; ++m) {
        f32x4 s = (f32x4){0.f, 0.f, 0.f, 0.f};
#pragma unroll
        for (int ks = 0; ks < 2; ++ks) {
          const bf16x8 a = *(const bf16x8*)(kb + (((k16 * 2 + m) * 2 + ks) * 1024) + lane * 16);
          s = mfma16(a, qf[m][ks], s);
        }
        S[m][k16] = s;
      }
    const bool near = (qb - kt) <= 2;
#pragma unroll
    for (int m = 0; m < 2; ++m)
#pragma unroll
      for (int k16 = 0; k16 < 4; ++k16)
#pragma unroll
        for (int r = 0; r < 4; ++r) {
          float s = S[m][k16][r] * (0.125f * LOG2E);
          if (near) {
            const int dist = qpos - (64 * kt + 16 * k16 + 4 * g + r);
            s = dist < 0 ? -1.0e30f : s + tab[dist < 127 ? dist : 127];
          } else {
            s += tfar;
          }
          S[m][k16][r] = s;
        }
    bf16x8 pb[2][2];
#pragma unroll
    for (int m = 0; m < 2; ++m) {
      float mx = -1.0e30f;
#pragma unroll
      for (int k16 = 0; k16 < 4; ++k16)
#pragma unroll
        for (int r = 0; r < 4; ++r) mx = fmaxf(mx, S[m][k16][r]);
      mx = fmaxf(mx, shx16(mx));
      mx = fmaxf(mx, shx32(mx, idx32));
      const float mnew = fmaxf(mrun[m], mx);
      const float alpha = fast_exp2(mrun[m] - mnew);
      mrun[m] = mnew;
      float ps = 0.f;
#pragma unroll
      for (int k16 = 0; k16 < 4; ++k16)
#pragma unroll
        for (int r = 0; r < 4; ++r) { const float e = fast_exp2(S[m][k16][r] - mnew); S[m][k16][r] = e; ps += e; }
      lsum[m] = lsum[m] * alpha + ps;
#pragma unroll
      for (int dt = 0; dt < 8; ++dt) { O[m][dt][0] *= alpha; O[m][dt][1] *= alpha; O[m][dt][2] *= alpha; O[m][dt][3] *= alpha; }
#pragma unroll
      for (int kk = 0; kk < 2; ++kk) {
        u32x4 t;
        t[0] = pack2(S[m][2 * kk][0], S[m][2 * kk][1]); t[1] = pack2(S[m][2 * kk][2], S[m][2 * kk][3]);
        t[2] = pack2(S[m][2 * kk + 1][0], S[m][2 * kk + 1][1]); t[3] = pack2(S[m][2 * kk + 1][2], S[m][2 * kk + 1][3]);
        pb[m][kk] = __builtin_bit_cast(bf16x8, t);
      }
    }
    if (more) {
#pragma unroll
      for (int j = 0; j < 4; ++j) *(u32x4*)(Kb + (cur ^ 1) * 16384 + kdst0 + j * 4096) = rs[j];
#pragma unroll
      for (int j = 0; j < 4; ++j) rs[j] = *(const u32x4*)(vsrc + (size_t)(32 * j) * LP + 64 * (kt + 1));
    }
#pragma unroll
    for (int kk = 0; kk < 2; ++kk)
#pragma unroll
      for (int dt = 0; dt < 8; ++dt) {
        const char* va = vb + (16 * dt + l15) * 144 + (32 * kk + 4 * g) * 2;
        const u32x2 lo = *(const u32x2*)(va), hi = *(const u32x2*)(va + 32);
        u32x4 t; t[0] = lo[0]; t[1] = lo[1]; t[2] = hi[0]; t[3] = hi[1];
        const bf16x8 a = __builtin_bit_cast(bf16x8, t);
        O[0][dt] = mfma16(a, pb[0][kk], O[0][dt]);
        O[1][dt] = mfma16(a, pb[1][kk], O[1][dt]);
      }
    if (more) {
#pragma unroll
      for (int j = 0; j < 4; ++j) *(u32x4*)(Vb + (cur ^ 1) * 18432 + vdst0 + j * 4608) = rs[j];
    }
    __syncthreads();
  }
  float l0 = lsum[0], l1 = lsum[1];
  l0 += shx16(l0); l0 += shx32(l0, idx32);
  l1 += shx16(l1); l1 += shx32(l1, idx32);
  const float c1 = 1.0f / l0, c2 = lam / l1;
  float ss = 0.f;
#pragma unroll
  for (int dt = 0; dt < 8; ++dt)
#pragma unroll
    for (int r = 0; r < 4; ++r) { const float o = O[0][dt][r] * c1 - O[1][dt][r] * c2; O[0][dt][r] = o; ss += o * o; }
  ss += shx16(ss); ss += shx32(ss, idx32);
  const float rinv = rsqrtf(ss * (1.0f / 128.0f) + 1e-5f);
  if (qpos < LSEQ) {
    u16* dst = W_MIX(p) + (size_t)(b * LSEQ + qpos) * DM + hh * 128 + 4 * g;
#pragma unroll
    for (int dt = 0; dt < 8; ++dt) {
      const int dv0 = 16 * dt + 4 * g;
      u32x2 o;
      o[0] = pack2(O[0][dt][0] * rinv * sg[dv0 + 0], O[0][dt][1] * rinv * sg[dv0 + 1]);
      o[1] = pack2(O[0][dt][2] * rinv * sg[dv0 + 2], O[0][dt][3] * rinv * sg[dv0 + 3]);
      *(u32x2*)(dst + 16 * dt) = o;
    }
  }
}

DI void conv_item(const Params& p, int layer, int item, int tid) {
  const int ch = (tid & 63) * 8;
  const float* cw = P_CONV_W(p) + (size_t)layer * 3 * 512;
  float w0[8], w1[8], w2[8];
#pragma unroll
  for (int e = 0; e < 8; ++e) { w0[e] = cw[ch + e]; w1[e] = cw[512 + ch + e]; w2[e] = cw[1024 + ch + e]; }
#pragma unroll
  for (int i = 0; i < 4; ++i) {
    const int t = item * 16 + (tid >> 6) + 4 * i;
    const int pos = t % LSEQ;
    const u16* row = W_PROJ(p) + (size_t)t * INC;
    float accv[8];
#pragma unroll
    for (int e = 0; e < 8; ++e) accv[e] = 0.f;
#pragma unroll
    for (int d = 0; d < 3; ++d) {
      if (pos - 2 + d >= 0) {
        const u16* r2 = row - (size_t)(2 - d) * INC;
        const u32x4 gc = *(const u32x4*)(r2 + 2048 + ch), zz = *(const u32x4*)(r2 + 2560 + ch);
#pragma unroll
        for (int e = 0; e < 4; ++e) {
          const float wlo = d == 0 ? w0[2 * e] : (d == 1 ? w1[2 * e] : w2[2 * e]);
          const float whi = d == 0 ? w0[2 * e + 1] : (d == 1 ? w1[2 * e + 1] : w2[2 * e + 1]);
          accv[2 * e] += wlo * (bflo(gc[e]) * bflo(zz[e]));
          accv[2 * e + 1] += whi * (bfhi(gc[e]) * bfhi(zz[e]));
        }
      }
    }
    const u32x4 gb = *(const u32x4*)(row + 1536 + ch);
    u32x4 o;
#pragma unroll
    for (int e = 0; e < 4; ++e) o[e] = pack2(bflo(gb[e]) * accv[2 * e], bfhi(gb[e]) * accv[2 * e + 1]);
    *(u32x4*)(W_MIX(p) + (size_t)t * DM + 512 + ch) = o;
  }
}

DI void peer_token(const Params& p, int layer, int t, int lane) {
  const unsigned char* ub = W_UB(p);
  const unsigned char* vbt = W_VB(p);
  {
    float xf[16];
    {
      const u32x4 a = *(const u32x4*)(W_H(p) + (size_t)t * DM + 16 * lane), c = *(const u32x4*)(W_H(p) + (size_t)t * DM + 16 * lane + 8);
#pragma unroll
      for (int e = 0; e < 4; ++e) { xf[2 * e] = bflo(a[e]); xf[2 * e + 1] = bfhi(a[e]); xf[8 + 2 * e] = bflo(c[e]); xf[8 + 2 * e + 1] = bfhi(c[e]); }
    }
    const int idxA = W_IDX(p)[(size_t)t * 128 + lane], idxB = W_IDX(p)[(size_t)t * 128 + 64 + lane];
    const float gA = W_G(p)[(size_t)t * 128 + lane], gB = W_G(p)[(size_t)t * 128 + 64 + lane];
    float actA = 0.f, actB = 0.f;
#pragma unroll 1
    for (int jb = 0; jb < 128; jb += 16) {
      u32x4 r[16];
#pragma unroll
      for (int u = 0; u < 16; ++u) {
        const int e = __builtin_amdgcn_readlane(jb < 64 ? idxA : idxB, (jb + u) & 63);
        r[u] = *(const u32x4*)(ub + (size_t)e * DM + 16 * lane);
      }
#pragma unroll
      for (int u = 0; u < 16; ++u) {
        float d = 0.f;
#pragma unroll
        for (int k = 0; k < 4; ++k) {
          const f32x2 lo = __builtin_amdgcn_cvt_pk_f32_fp8((int)r[u][k], false), hi = __builtin_amdgcn_cvt_pk_f32_fp8((int)r[u][k], true);
          d += xf[4 * k] * lo[0] + xf[4 * k + 1] * lo[1] + xf[4 * k + 2] * hi[0] + xf[4 * k + 3] * hi[1];
        }
        d = wave_sum(d);
        if (lane == ((jb + u) & 63)) { if (jb < 64) actA = d; else actB = d; }
      }
    }
    actA *= W_SU(p)[idxA]; actB *= W_SU(p)[idxB];
    const float wA = gA * (0.5f * actA * (1.0f + erff(actA * 0.7071067811865476f))) * W_SV(p)[idxA];
    const float wB = gB * (0.5f * actB * (1.0f + erff(actB * 0.7071067811865476f))) * W_SV(p)[idxB];
    float acc[16];
#pragma unroll
    for (int i = 0; i < 16; ++i) acc[i] = 0.f;
#pragma unroll 1
    for (int jb = 0; jb < 128; jb += 16) {
      u32x4 r[16];
      float wj[16];
#pragma unroll
      for (int u = 0; u < 16; ++u) {
        const int e = __builtin_amdgcn_readlane(jb < 64 ? idxA : idxB, (jb + u) & 63);
        wj[u] = __int_as_float(__builtin_amdgcn_readlane(__float_as_int(jb < 64 ? wA : wB), (jb + u) & 63));
        r[u] = *(const u32x4*)(vbt + (size_t)e * DM + 16 * lane);
      }
#pragma unroll
      for (int u = 0; u < 16; ++u) {
#pragma unroll
        for (int k = 0; k < 4; ++k) {
          const f32x2 lo = __builtin_amdgcn_cvt_pk_f32_fp8((int)r[u][k], false), hi = __builtin_amdgcn_cvt_pk_f32_fp8((int)r[u][k], true);
          acc[4 * k] += wj[u] * lo[0]; acc[4 * k + 1] += wj[u] * lo[1]; acc[4 * k + 2] += wj[u] * hi[0]; acc[4 * k + 3] += wj[u] * hi[1];
        }
      }
    }
#pragma unroll
    for (int i = 0; i < 16; ++i) acc[i] += ALPHA * xf[i];
    ln_row<1>(acc, P_LN2_G(p) + layer * DM, P_LN2_B(p) + layer * DM, lane);
    if (layer == DEPTH - 1) {
      const int b = t / LSEQ, pos = t - b * LSEQ;
      if (pos >= NMETA) {
        float* dst = p.out + ((size_t)b * SEQ + pos - NMETA) * DM + 16 * lane;
#pragma unroll
        for (int k = 0; k < 4; ++k) *(f32x4*)(dst + 4 * k) = (f32x4){acc[4 * k], acc[4 * k + 1], acc[4 * k + 2], acc[4 * k + 3]};
      }
    } else {
      store_row_bf16<1>(W_H(p) + (size_t)t * DM, acc, lane);
    }
  }
}

DI void phase_prologue(const Params& p, char* smem, int wave) {
  const int tid = otid_w(wave), lane = tid & 63, wid = tid >> 6, hb = tid >> 8, htid = tid & 255;
  const int nblk = gridDim.x, bid = blockIdx.x;
  const size_t gtid = (size_t)bid * NTHREADS + tid, gthreads = (size_t)nblk * NTHREADS;
  float* sm = (float*)(smem + hb * LDS_HALF);
  for (int it0 = bid; it0 < 2048; it0 += nblk) {
    const int it = it0 * 2 + hb;
    if (it < 3072) {
      const int l = it / 768, r = it % 768, kb = r / 48, nb = r % 48;
      transpose_tile(P_W_IN(p) + (size_t)l * 1024 * 3072, 3072, W_WIN(p) + (size_t)l * 3072 * 1024, 1024, kb * 64, nb * 64, sm, htid);
    } else {
      const int i2 = it - 3072, l = i2 / 256, r = i2 % 256, kb = r / 16, nb = r % 16;
      transpose_tile(P_W_OUT(p) + (size_t)l * 1024 * 1024, 1024, W_WOUT(p) + (size_t)l * 1024 * 1024, 1024, kb * 64, nb * 64, sm, htid);
    }
  }
  convert_straight(P_W_Q(p), W_WQB(p), (size_t)4 * 1024 * 2048 / 8, gtid, gthreads);
  convert_straight(P_SUB_KEYS(p), W_SKB(p), (size_t)4 * 16 * 128 * 128 / 8, gtid, gthreads);
  for (int t = bid * 8 + wid; t < TTOK; t += nblk * 8) {
    const int b = t / LSEQ, pos = t - b * LSEQ;
    const float* src = pos < NMETA ? P_META(p) + (size_t)pos * DM : P_X(p) + ((size_t)b * SEQ + pos - NMETA) * DM;
    float v[16];
    load_row_f32<0>(src, v, lane);
    ln_row<0>(v, P_LN_IN_G(p), P_LN_IN_B(p), lane);
    store_row_bf16<0>(W_H(p) + (size_t)t * DM, v, lane);
  }
}

DI void phase_fold(const Params& p, char* smem, int wave) {
  const int tid = otid_w(wave), hb = tid >> 8, htid = tid & 255;
  for (int it0 = blockIdx.x; it0 < 256; it0 += gridDim.x) {
    const int it = it0 * 2 + hb;
    const int l = it >> 7, hp = (it >> 3) & 15, mt = it & 7;
    gemm_tile_fold(W_WQB(p) + (size_t)l * 1024 * 2048 + hp * 128, 2048, W_SKB(p) + ((size_t)l * 16 + hp) * 128 * 128, 128, 128, mt * 128, smem + hb * 65536,
                   W_WSC(p) + (size_t)l * 2048 * 1024 + (size_t)hp * 128 * 1024, htid);
  }
}

DI bool tile_order(int i, int nM, int nN, int& pm, int& pn) {
  const int nwg = nM * nN;
  const long L = (long)i * gridDim.x + blockIdx.x;
  if (L >= nwg) return false;
  int wgid = (int)L;
  { const int q = nwg / 8, r = nwg % 8, xcd = wgid % 8, off = wgid / 8; wgid = (xcd < r ? xcd * (q + 1) : r * (q + 1) + (xcd - r) * q) + off; }
  const int nig = 8 * nN, gid = wgid / nig, fm = gid * 8, gsz = (nM - fm) < 8 ? (nM - fm) : 8;
  pm = fm + ((wgid % nig) % gsz); pn = (wgid % nig) / gsz;
  return true;
}

DI void phase_gemm(const Params& p, int layer, int which, char* smem, int wave) {
  const int tid0 = otid_w(wave);
  const u16* W = which == 0 ? W_WIN(p) + (size_t)layer * 3072 * 1024 : (which == 1 ? W_WOUT(p) + (size_t)layer * 1024 * 1024 : W_WSC(p) + (size_t)layer * 2048 * 1024);
  const u16* X = which == 1 ? W_MIX(p) : W_H(p);
  const int nN = which == 0 ? 12 : (which == 1 ? 4 : 8);
  int pm, pn;
  for (int i = 0; tile_order(i, 258, nN, pm, pn); ++i) {
    const bool vt = (which == 0) && (pn == 4 || pn == 5);
    const int mode = which == 0 ? (vt ? EPI_VT : EPI_PROJ) : (which == 1 ? EPI_OUT : EPI_TOPK);
    int tid = tid0;
    asm volatile("" : "+v"(tid));
    gemm256_tile(p, mode, layer, vt ? X : W, vt ? W : X, vt ? pm * 256 : pn * 256, vt ? pn * 256 : pm * 256, (lchar*)smem, tid);
  }
}

DI void phase_attn(const Params& p, int layer, char* smem, int wave) {
  const int tid = otid_w(wave), lane = tid & 63, hb = tid >> 8, htid = tid & 255;
  const float lam_init = 0.8f - 0.6f * expf(-0.3f * (float)layer);
  float d1 = P_LQ1(p)[layer * 64 + lane] * P_LK1(p)[layer * 64 + lane], d2 = P_LQ2(p)[layer * 64 + lane] * P_LK2(p)[layer * 64 + lane];
  d1 = wave_sum(d1); d2 = wave_sum(d2);
  const float lam = expf(d1) - expf(d2) + lam_init;
  for (int it = blockIdx.x; it < 2112 + 2064; it += gridDim.x) {
    if (it < 2112) {
      const int it2 = it * 2 + hb, qb = 32 - (it2 >> 7), bh = it2 & 127;
      attn_item(p, layer, bh >> 2, bh & 3, qb, smem + hb * LDS_HALF, lam, 1.0f - lam_init, htid);
    } else {
      conv_item(p, layer, (it - 2112) * 2 + hb, htid);
    }
  }
}

DI void phase_ln1(const Params& p, int layer, int wave) {
  const int tid = otid_w(wave), lane = tid & 63, wid = tid >> 6;
  const int nblk = gridDim.x, bid = blockIdx.x;
  for (int t = bid * 8 + wid; t < TTOK; t += nblk * 8) {
    float v[16];
    load_row_f32<0>(W_Y(p) + (size_t)t * DM, v, lane);
    ln_row<0>(v, P_LN1_G(p) + layer * DM, P_LN1_B(p) + layer * DM, lane);
    store_row_bf16<0>(W_H(p) + (size_t)t * DM, v, lane);
  }
  for (int r = bid * 8 + wid; r < 2 * PEER_N; r += nblk * 8) {
    const bool isv = r >= PEER_N;
    const int e = isv ? r - PEER_N : r;
    const float* src = (isv ? P_PEER_V(p) : P_PEER_U(p)) + ((size_t)layer * PEER_N + e) * DM + 16 * lane;
    f32x4 a[4];
#pragma unroll
    for (int k = 0; k < 4; ++k) a[k] = *(const f32x4*)(src + 4 * k);
    float am = 0.f;
#pragma unroll
    for (int k = 0; k < 4; ++k) am = fmaxf(am, fmaxf(fmaxf(fabsf(a[k][0]), fabsf(a[k][1])), fmaxf(fabsf(a[k][2]), fabsf(a[k][3]))));
    am = wave_max_nonneg(am);
    const float sc = am > 0.f ? 224.0f / am : 1.0f;
    if (lane == 0) (isv ? W_SV(p) : W_SU(p))[e] = am > 0.f ? am * (1.0f / 224.0f) : 1.0f;
    u32x4 o;
#pragma unroll
    for (int k = 0; k < 4; ++k) {
      int w = 0;
      w = __builtin_amdgcn_cvt_pk_fp8_f32(a[k][0] * sc, a[k][1] * sc, w, false);
      w = __builtin_amdgcn_cvt_pk_fp8_f32(a[k][2] * sc, a[k][3] * sc, w, true);
      o[k] = (unsigned)w;
    }
    *(u32x4*)((isv ? W_VB(p) : W_UB(p)) + (size_t)e * DM + 16 * lane) = o;
  }
}

DI void phase_peer(const Params& p, int layer, int wave) {
  const int tid = otid_w(wave), lane = tid & 63, wid = tid >> 6;
  for (int t = blockIdx.x * 8 + wid; t < TTOK; t += gridDim.x * 8) peer_token(p, layer, t, lane);
}

__global__ void __launch_bounds__(NTHREADS, 2) mega(Params p) {
  extern __shared__ __attribute__((aligned(16))) char smem[];
  cg::grid_group grid = cg::this_grid();
  const int wave = __builtin_amdgcn_readfirstlane((int)(threadIdx.x >> 6));
  phase_prologue(p, smem, wave);
  grid.sync();
  phase_fold(p, smem, wave);
  grid.sync();
#pragma unroll 1
  for (int step = 0; step < DEPTH * 6; ++step) {
    const int layer = step / 6, ph = step - layer * 6;
    if (ph == 0 || ph == 2 || ph == 4) phase_gemm(p, layer, ph >> 1, smem, wave);
    else if (ph == 1) phase_attn(p, layer, smem, wave);
    else if (ph == 3) phase_ln1(p, layer, wave);
    else phase_peer(p, layer, wave);
    grid.sync();
  }
}

extern "C" void kernel_launch(void* const* d_in, const int* in_sizes, int n_in, void* d_out, int out_size, void* d_ws, size_t ws_size,
                              hipStream_t stream) {
  static int grid_blocks = 0;
  if (grid_blocks == 0) {
    if (ws_size < WS_END) { fprintf(stderr, "kernel_launch: workspace too small: need %zu, got %zu\n", (size_t)WS_END, ws_size); grid_blocks = -1; return; }
    int dev = 0, cus = 0, per_cu = 0;
    hipGetDevice(&dev);
    hipDeviceGetAttribute(&cus, hipDeviceAttributeMultiprocessorCount, dev);
    hipFuncSetAttribute((const void*)mega, hipFuncAttributeMaxDynamicSharedMemorySize, LDS_BYTES);
    hipOccupancyMaxActiveBlocksPerMultiprocessor(&per_cu, (const void*)mega, NTHREADS, LDS_BYTES);
    if (per_cu < 1) per_cu = 1;
    if (per_cu > 1) per_cu = 1;
    grid_blocks = cus * per_cu;
  }
  if (grid_blocks < 0) return;
  Params p{};
  for (int i = 0; i < 21; ++i) p.in[i] = (const float*)d_in[i];
  p.out = (float*)d_out;
  p.ws = (char*)d_ws;
  void* args[] = {&p};
  hipError_t e = hipLaunchCooperativeKernel((const void*)mega, dim3(grid_blocks), dim3(NTHREADS), args, LDS_BYTES, stream);
  if (e != hipSuccess) fprintf(stderr, "cooperative launch failed: %s (grid %d)\n", hipGetErrorString(e), grid_blocks);
}
```

```cpp
#include <hip/hip_runtime.h>
#include <hip/hip_cooperative_groups.h>
#include <cstdio>
#include <cstdint>
namespace cg = cooperative_groups;

typedef unsigned short u16;
typedef __attribute__((ext_vector_type(8))) short bf16x8;
typedef __attribute__((ext_vector_type(4))) float f32x4;
typedef __attribute__((ext_vector_type(4))) unsigned u32x4;
typedef __attribute__((ext_vector_type(2))) unsigned u32x2;
typedef __attribute__((ext_vector_type(2))) float f32x2;
#define DI __device__ __forceinline__
#define LAS __attribute__((address_space(3)))
typedef LAS char lchar;

#define DM 1024
#define NBATCH 32
#define SEQ 2048
#define NMETA 16
#define LSEQ 2064
#define TTOK 66048
#define DEPTH 4
#define INC 3072
#define LP 2112
#define PEER_N 16384
#define NTHREADS 512
#define LDS_MISC 69632
#define LDS_HALF 70656
#define LDS_XB 141312
#define LDS_BYTES 141328

#define ALPHA 1.681792830507429f
#define LOG2E 1.4426950408889634f

static constexpr size_t WS_WIN  = 0;
static constexpr size_t WS_WOUT = WS_WIN  + (size_t)4 * 3072 * 1024 * 2;
static constexpr size_t WS_WQB  = WS_WOUT + (size_t)4 * 1024 * 1024 * 2;
static constexpr size_t WS_SKB  = WS_WQB  + (size_t)4 * 1024 * 2048 * 2;
static constexpr size_t WS_WSC  = WS_SKB  + (size_t)4 * 16 * 128 * 128 * 2;
static constexpr size_t WS_UB   = WS_WSC  + (size_t)4 * 2048 * 1024 * 2;
static constexpr size_t WS_VB   = WS_UB   + (size_t)PEER_N * 1024;
static constexpr size_t WS_SU   = WS_VB   + (size_t)PEER_N * 1024;
static constexpr size_t WS_SV   = WS_SU   + (size_t)PEER_N * 4;
static constexpr size_t WS_H    = WS_SV   + (size_t)PEER_N * 4;
static constexpr size_t WS_MIX  = WS_H    + (size_t)TTOK * 1024 * 2;
static constexpr size_t WS_BIG  = WS_MIX  + (size_t)TTOK * 1024 * 2;
static constexpr size_t WS_VT   = WS_BIG  + (size_t)(TTOK + 64) * 3072 * 2;
static constexpr size_t WS_IDX  = WS_VT   + (size_t)NBATCH * 4 * 128 * LP * 2;
static constexpr size_t WS_G    = WS_IDX  + (size_t)TTOK * 128 * 4;
static constexpr size_t WS_BAR  = WS_G    + (size_t)TTOK * 128 * 4;
static constexpr size_t WS_END  = WS_BAR  + 16384;

struct Params {
  const float* in[21];
  float* out;
  char* ws;
};
#define P_X(p) ((p).in[0])
#define P_META(p) ((p).in[1])
#define P_LN_IN_G(p) ((p).in[2])
#define P_LN_IN_B(p) ((p).in[3])
#define P_REL_BIAS(p) ((p).in[4])
#define P_W_IN(p) ((p).in[5])
#define P_CONV_W(p) ((p).in[6])
#define P_LQ1(p) ((p).in[7])
#define P_LK1(p) ((p).in[8])
#define P_LQ2(p) ((p).in[9])
#define P_LK2(p) ((p).in[10])
#define P_SUBLN_G(p) ((p).in[11])
#define P_W_OUT(p) ((p).in[12])
#define P_LN1_G(p) ((p).in[13])
#define P_LN1_B(p) ((p).in[14])
#define P_W_Q(p) ((p).in[15])
#define P_SUB_KEYS(p) ((p).in[16])
#define P_PEER_U(p) ((p).in[17])
#define P_PEER_V(p) ((p).in[18])
#define P_LN2_G(p) ((p).in[19])
#define P_LN2_B(p) ((p).in[20])
#define W_WIN(p) ((u16*)((p).ws + WS_WIN))
#define W_WOUT(p) ((u16*)((p).ws + WS_WOUT))
#define W_WQB(p) ((u16*)((p).ws + WS_WQB))
#define W_SKB(p) ((u16*)((p).ws + WS_SKB))
#define W_WSC(p) ((u16*)((p).ws + WS_WSC))
#define W_UB(p) ((unsigned char*)((p).ws + WS_UB))
#define W_VB(p) ((unsigned char*)((p).ws + WS_VB))
#define W_SU(p) ((float*)((p).ws + WS_SU))
#define W_SV(p) ((float*)((p).ws + WS_SV))
#define W_H(p) ((u16*)((p).ws + WS_H))
#define W_MIX(p) ((u16*)((p).ws + WS_MIX))
#define W_PROJ(p) ((u16*)((p).ws + WS_BIG))
#define W_Y(p) ((float*)((p).ws + WS_BIG))
#define W_VT(p) ((u16*)((p).ws + WS_VT))
#define W_IDX(p) ((int*)((p).ws + WS_IDX))
#define W_G(p) ((float*)((p).ws + WS_G))

DI u16 f2bf(float x) { unsigned u = __float_as_uint(x); u += 0x7fffu + ((u >> 16) & 1u); return (u16)(u >> 16); }
DI unsigned pack2(float a, float b) {
  unsigned ua = __float_as_uint(a), ub = __float_as_uint(b);
  ua += 0x7fffu + ((ua >> 16) & 1u); ub += 0x7fffu + ((ub >> 16) & 1u);
  return (ua >> 16) | (ub & 0xffff0000u);
}
DI float bflo(unsigned w) { return __uint_as_float(w << 16); }
DI float bfhi(unsigned w) { return __uint_as_float(w & 0xffff0000u); }
DI int otid_w(int wave) { unsigned z = 0u; asm volatile("" : "+v"(z)); int t = wave * 64 + (int)__builtin_amdgcn_mbcnt_hi(~0u, __builtin_amdgcn_mbcnt_lo(~0u, z)); asm volatile("" : "+v"(t)); return t; }
#define DPP_ADD(v, ctrl) ((v) + __int_as_float(__builtin_amdgcn_update_dpp(0, __float_as_int(v), (ctrl), 0xf, 0xf, true)))
DI float wave_sum(float v) {
  v = DPP_ADD(v, 0xB1);
  v = DPP_ADD(v, 0x4E);
  v = DPP_ADD(v, 0x141);
  v = DPP_ADD(v, 0x140);
  const int iv = __float_as_int(v);
  return __int_as_float(__builtin_amdgcn_readlane(iv, 0)) + __int_as_float(__builtin_amdgcn_readlane(iv, 16)) +
         __int_as_float(__builtin_amdgcn_readlane(iv, 32)) + __int_as_float(__builtin_amdgcn_readlane(iv, 48));
}
#define DPP_MAX(v, ctrl) fmaxf((v), __int_as_float(__builtin_amdgcn_update_dpp(0, __float_as_int(v), (ctrl), 0xf, 0xf, true)))
DI float wave_max_nonneg(float v) {
  v = DPP_MAX(v, 0xB1); v = DPP_MAX(v, 0x4E); v = DPP_MAX(v, 0x141); v = DPP_MAX(v, 0x140);
  const int iv = __float_as_int(v);
  return fmaxf(fmaxf(__int_as_float(__builtin_amdgcn_readlane(iv, 0)), __int_as_float(__builtin_amdgcn_readlane(iv, 16))),
               fmaxf(__int_as_float(__builtin_amdgcn_readlane(iv, 32)), __int_as_float(__builtin_amdgcn_readlane(iv, 48))));
}
DI float shx16(float v) { return __int_as_float(__builtin_amdgcn_ds_swizzle(__float_as_int(v), 0x401F)); }
DI float shx32(float v, int idx32) { return __int_as_float(__builtin_amdgcn_ds_bpermute(idx32, __float_as_int(v))); }
DI f32x4 mfma16(bf16x8 a, bf16x8 b, f32x4 c) { return __builtin_amdgcn_mfma_f32_16x16x32_bf16(a, b, c, 0, 0, 0); }
DI float fast_exp2(float x) { return __builtin_amdgcn_exp2f(x); }

DI void convert_straight(const float* __restrict__ src, u16* __restrict__ dst, size_t n8, size_t gtid, size_t gthreads) {
  for (size_t i = gtid; i < n8; i += gthreads) {
    const f32x4 a = *(const f32x4*)(src + i * 8), b = *(const f32x4*)(src + i * 8 + 4);
    u32x4 o; o[0] = pack2(a[0], a[1]); o[1] = pack2(a[2], a[3]); o[2] = pack2(b[0], b[1]); o[3] = pack2(b[2], b[3]);
    *(u32x4*)(dst + i * 8) = o;
  }
}

DI void transpose_tile(const float* __restrict__ src, int ldn, u16* __restrict__ dst, int ldk, int k0, int n0, float* sm, int tid) {
#pragma unroll
  for (int i = 0; i < 4; ++i) {
    const int r = (tid >> 4) + 16 * i, c4 = tid & 15;
    const f32x4 v = *(const f32x4*)(src + (size_t)(k0 + r) * ldn + n0 + 4 * c4);
    sm[r * 65 + 4 * c4 + 0] = v[0]; sm[r * 65 + 4 * c4 + 1] = v[1]; sm[r * 65 + 4 * c4 + 2] = v[2]; sm[r * 65 + 4 * c4 + 3] = v[3];
  }
  __syncthreads();
#pragma unroll
  for (int i = 0; i < 2; ++i) {
    const int n = (tid >> 3) + 32 * i, kc = tid & 7;
    u32x4 o;
#pragma unroll
    for (int e = 0; e < 4; ++e) o[e] = pack2(sm[(8 * kc + 2 * e) * 65 + n], sm[(8 * kc + 2 * e + 1) * 65 + n]);
    *(u32x4*)(dst + (size_t)(n0 + n) * ldk + k0 + 8 * kc) = o;
  }
  __syncthreads();
}

template <int LAYOUT> DI int col0(int lane, int hh) { return LAYOUT ? 16 * lane + 8 * hh : hh * 512 + 8 * lane; }
template <int LAYOUT>
DI void ln_row(float (&v)[16], const float* __restrict__ g, const float* __restrict__ b, int lane) {
  float s = 0.f;
#pragma unroll
  for (int i = 0; i < 16; ++i) s += v[i];
  const float mu = wave_sum(s) * (1.0f / 1024.0f);
  float q = 0.f;
#pragma unroll
  for (int i = 0; i < 16; ++i) { const float d = v[i] - mu; q += d * d; }
  const float rstd = rsqrtf(wave_sum(q) * (1.0f / 1024.0f) + 1e-5f);
#pragma unroll
  for (int hh = 0; hh < 2; ++hh) {
    const int c = col0<LAYOUT>(lane, hh);
    const f32x4 g0 = *(const f32x4*)(g + c), g1 = *(const f32x4*)(g + c + 4), b0 = *(const f32x4*)(b + c), b1 = *(const f32x4*)(b + c + 4);
#pragma unroll
    for (int e = 0; e < 4; ++e) {
      v[hh * 8 + e] = (v[hh * 8 + e] - mu) * rstd * g0[e] + b0[e];
      v[hh * 8 + 4 + e] = (v[hh * 8 + 4 + e] - mu) * rstd * g1[e] + b1[e];
    }
  }
}
template <int LAYOUT>
DI void store_row_bf16(u16* __restrict__ dst, const float (&v)[16], int lane) {
#pragma unroll
  for (int hh = 0; hh < 2; ++hh) {
    u32x4 o;
#pragma unroll
    for (int e = 0; e < 4; ++e) o[e] = pack2(v[hh * 8 + 2 * e], v[hh * 8 + 2 * e + 1]);
    *(u32x4*)(dst + col0<LAYOUT>(lane, hh)) = o;
  }
}
template <int LAYOUT>
DI void load_row_f32(const float* __restrict__ src, float (&v)[16], int lane) {
#pragma unroll
  for (int hh = 0; hh < 2; ++hh) {
    const int c = col0<LAYOUT>(lane, hh);
    const f32x4 a = *(const f32x4*)(src + c), b = *(const f32x4*)(src + c + 4);
#pragma unroll
    for (int e = 0; e < 4; ++e) { v[hh * 8 + e] = a[e]; v[hh * 8 + 4 + e] = b[e]; }
  }
}

enum { EPI_PROJ = 0, EPI_VT = 1, EPI_OUT = 2, EPI_TOPK = 3, EPI_FOLD = 4 };

template <bool SWAP>
DI void gemm_mainloop(const u16* __restrict__ A, int lda, const u16* __restrict__ Bt, int ldb, int K, int m0, int n0, char* smem,
                      f32x4 (&acc)[4][4], int tid) {
  const int lane = tid & 63, wid = tid >> 6, wm = wid >> 1, wn = wid & 1;
  const int srow = tid >> 3, skc = tid & 7;
  const u16* ap = A + (size_t)(m0 + srow) * lda + skc * 8;
  const u16* bp = Bt + (size_t)(n0 + srow) * ldb + skc * 8;
  const int dst0 = (((srow >> 4) * 2 + (skc >> 2)) * 1024) + (((skc & 3) * 16 + (srow & 15)) * 16);
#pragma unroll
  for (int i = 0; i < 4; ++i)
#pragma unroll
    for (int j = 0; j < 4; ++j) acc[i][j] = (f32x4){0.f, 0.f, 0.f, 0.f};
  u32x4 ra[4], rb[4];
#pragma unroll
  for (int j = 0; j < 4; ++j) { ra[j] = *(const u32x4*)(ap + (size_t)j * 32 * lda); rb[j] = *(const u32x4*)(bp + (size_t)j * 32 * ldb); }
#pragma unroll
  for (int j = 0; j < 4; ++j) { *(u32x4*)(smem + dst0 + j * 4096) = ra[j]; *(u32x4*)(smem + 16384 + dst0 + j * 4096) = rb[j]; }
  __syncthreads();
  const int KT = K >> 6;
  for (int kt = 0; kt < KT; ++kt) {
    char* cur = smem + (kt & 1) * 32768;
    char* nxt = smem + ((kt + 1) & 1) * 32768;
    const bool more = (kt + 1 < KT);
    if (more) {
      const u16* ap2 = ap + (kt + 1) * 64;
      const u16* bp2 = bp + (kt + 1) * 64;
#pragma unroll
      for (int j = 0; j < 4; ++j) { ra[j] = *(const u32x4*)(ap2 + (size_t)j * 32 * lda); rb[j] = *(const u32x4*)(bp2 + (size_t)j * 32 * ldb); }
    }
#pragma unroll
    for (int ks = 0; ks < 2; ++ks) {
      bf16x8 af[4], bfr[4];
#pragma unroll
      for (int i = 0; i < 4; ++i) af[i] = *(const bf16x8*)(cur + (((wm * 4 + i) * 2 + ks) * 1024) + lane * 16);
#pragma unroll
      for (int j = 0; j < 4; ++j) bfr[j] = *(const bf16x8*)(cur + 16384 + (((wn * 4 + j) * 2 + ks) * 1024) + lane * 16);
#pragma unroll
      for (int i = 0; i < 4; ++i)
#pragma unroll
        for (int j = 0; j < 4; ++j) acc[i][j] = SWAP ? mfma16(bfr[j], af[i], acc[i][j]) : mfma16(af[i], bfr[j], acc[i][j]);
    }
    if (more) {
#pragma unroll
      for (int j = 0; j < 4; ++j) { *(u32x4*)(nxt + dst0 + j * 4096) = ra[j]; *(u32x4*)(nxt + 16384 + dst0 + j * 4096) = rb[j]; }
    }
    __syncthreads();
  }
}

DI void insert16(float (&v)[16], float x) {
#pragma unroll
  for (int j = 0; j < 16; ++j) { const float hi = fmaxf(v[j], x); x = fminf(v[j], x); v[j] = hi; }
}

DI void gemm_tile_fold(const u16* A, int lda, const u16* Bt, int ldb, int K, int m0, char* smem, u16* dstT, int tid) {
  const int lane = tid & 63, wid = tid >> 6, wm = wid >> 1, wn = wid & 1, g = lane >> 4, l15 = lane & 15;
  f32x4 acc[4][4];
  gemm_mainloop<false>(A, lda, Bt, ldb, K, m0, 0, smem, acc, tid);
#pragma unroll
  for (int i = 0; i < 4; ++i)
#pragma unroll
    for (int j = 0; j < 4; ++j) {
      const int m = m0 + wm * 64 + 16 * i + 4 * g, n = wn * 64 + 16 * j + l15;
      u32x2 o; o[0] = pack2(acc[i][j][0], acc[i][j][1]); o[1] = pack2(acc[i][j][2], acc[i][j][3]);
      *(u32x2*)(dstT + (size_t)n * 1024 + m) = o;
    }
}

#define GK 1024
#define HTB 16384
DI int lds_byte(int r, int c) {
  const int st = (r >> 4) * 2 + (c >> 5), rr = r & 15, cc = c & 31, ob = rr * 64 + cc * 2;
  return st * 1024 + (ob ^ (((ob >> 9) & 1) << 5));
}
DI void stage_rc(int b, int& R, int& C) {
  const int st = b / 1024, sb = b % 1024, swz = sb ^ (((sb >> 9) & 1) << 5);
  R = (st >> 1) * 16 + swz / 64; C = (st & 1) * 32 + (swz % 64) / 2;
}
#define G_SA(b, h) (shm + ((b) * 2 + (h)) * HTB)
#define G_SB(b, h) (shm + (4 + (b) * 2 + (h)) * HTB)
#define G_STAGE(P, BASE, br, kt) do { const char* _g = (const char*)((BASE) + (size_t)(br) * GK + (kt) * 64); \
    __builtin_amdgcn_global_load_lds((const unsigned*)(_g + goff0), (LAS unsigned*)((P) + tid * 16), 16, 0, 0); \
    __builtin_amdgcn_global_load_lds((const unsigned*)(_g + goff1), (LAS unsigned*)((P) + tid * 16 + 8192), 16, 0, 0); } while (0)
#define G_LDA(dst, b, h) _Pragma("unroll") for (int m = 0; m < 4; ++m) _Pragma("unroll") for (int k = 0; k < 2; ++k) \
    dst[m][k] = *(const LAS bf16x8*)(G_SA(b, h) + lds_byte(wr * 64 + m * 16 + fr, k * 32 + fq * 8))
#define G_LDB(dst, b, h) _Pragma("unroll") for (int n = 0; n < 2; ++n) _Pragma("unroll") for (int k = 0; k < 2; ++k) \
    dst[n][k] = *(const LAS bf16x8*)(G_SB(b, h) + lds_byte(wc * 32 + n * 16 + fr, k * 32 + fq * 8))
#define G_MMA(ai, bj, At, Bx) do { __builtin_amdgcn_s_setprio(1); \
    _Pragma("unroll") for (int m = 0; m < 4; ++m) _Pragma("unroll") for (int n = 0; n < 2; ++n) _Pragma("unroll") for (int k = 0; k < 2; ++k) \
      acc[ai][bj][m][n] = __builtin_amdgcn_mfma_f32_16x16x32_bf16(At[m][k], Bx[n][k], acc[ai][bj][m][n], 0, 0, 0); \
    __builtin_amdgcn_s_setprio(0); } while (0)
#define WAIT_V(n) asm volatile("s_waitcnt vmcnt(" #n ")" ::: "memory")
#define WAIT_L(n) asm volatile("s_waitcnt lgkmcnt(" #n ")" ::: "memory")
#define BAR __builtin_amdgcn_s_barrier()
#define SCHED __builtin_amdgcn_sched_barrier(0)

DI void gemm256_core(const u16* __restrict__ A, const u16* __restrict__ Bt, int brow, int bcol, lchar* shm, int tid, f32x4 (&acc)[2][2][4][2]) {
  const int wid = tid >> 6, lane = tid & 63, wr = wid >> 2, wc = wid & 3, fr = lane & 15, fq = lane >> 4;
  int r0, c0, r1, c1;
  stage_rc(tid * 16, r0, c0); stage_rc(tid * 16 + 8192, r1, c1);
  const unsigned goff0 = (unsigned)(r0 * GK + c0) * 2u, goff1 = (unsigned)(r1 * GK + c1) * 2u;
#pragma unroll
  for (int ai = 0; ai < 2; ++ai)
#pragma unroll
    for (int bj = 0; bj < 2; ++bj)
#pragma unroll
      for (int m = 0; m < 4; ++m)
#pragma unroll
        for (int n = 0; n < 2; ++n) acc[ai][bj][m][n] = (f32x4){0.f, 0.f, 0.f, 0.f};
  bf16x8 At[4][2], B0[2][2], B1[2][2];
  const int nt = GK / 64;
  WAIT_V(0);
  __syncthreads();
  G_STAGE(G_SB(0, 0), Bt, bcol, 0); G_STAGE(G_SA(0, 0), A, brow, 0);
  G_STAGE(G_SB(0, 1), Bt, bcol + 128, 0); G_STAGE(G_SA(0, 1), A, brow + 128, 0);
  if (wr == 1) BAR;
  WAIT_V(4); BAR;
  G_STAGE(G_SB(1, 0), Bt, bcol, 1); G_STAGE(G_SA(1, 0), A, brow, 1); G_STAGE(G_SB(1, 1), Bt, bcol + 128, 1);
  WAIT_V(6); BAR;
  for (int t = 0; t < nt - 2; t += 2) {
    G_LDB(B0, 0, 0); SCHED; G_LDA(At, 0, 0); G_STAGE(G_SA(1, 1), A, brow + 128, t + 1);
    WAIT_L(8); BAR; WAIT_L(0); G_MMA(0, 0, At, B0); BAR; SCHED;
    G_LDB(B1, 0, 1); G_STAGE(G_SB(0, 0), Bt, bcol, t + 2);
    BAR; WAIT_L(0); G_MMA(0, 1, At, B1); BAR;
    G_LDA(At, 0, 1); G_STAGE(G_SA(0, 0), A, brow, t + 2);
    BAR; WAIT_L(0); G_MMA(1, 0, At, B0); BAR; SCHED;
    G_STAGE(G_SB(0, 1), Bt, bcol + 128, t + 2);
    WAIT_V(6); BAR; G_MMA(1, 1, At, B1); BAR;
    G_LDB(B0, 1, 0); SCHED; G_LDA(At, 1, 0); G_STAGE(G_SA(0, 1), A, brow + 128, t + 2);
    WAIT_L(8); BAR; WAIT_L(0); G_MMA(0, 0, At, B0); BAR; SCHED;
    G_LDB(B1, 1, 1); G_STAGE(G_SB(1, 0), Bt, bcol, t + 3);
    BAR; WAIT_L(0); G_MMA(0, 1, At, B1); BAR;
    G_LDA(At, 1, 1); G_STAGE(G_SA(1, 0), A, brow, t + 3);
    BAR; WAIT_L(0); G_MMA(1, 0, At, B0); BAR; SCHED;
    G_STAGE(G_SB(1, 1), Bt, bcol + 128, t + 3);
    WAIT_V(6); BAR; G_MMA(1, 1, At, B1); BAR;
  }
  { G_LDB(B0, 0, 0); G_LDA(At, 0, 0); G_STAGE(G_SA(1, 1), A, brow + 128, nt - 1);
    BAR; WAIT_L(0); G_MMA(0, 0, At, B0); BAR;
    G_LDB(B1, 0, 1); BAR; WAIT_L(0); G_MMA(0, 1, At, B1); BAR;
    G_LDA(At, 0, 1); WAIT_V(4); BAR; WAIT_L(0); G_MMA(1, 0, At, B0); G_MMA(1, 1, At, B1); BAR; }
  { G_LDB(B0, 1, 0); G_LDA(At, 1, 0); WAIT_V(2); BAR; WAIT_L(0); G_MMA(0, 0, At, B0); BAR;
    G_LDB(B1, 1, 1); WAIT_V(0); BAR; WAIT_L(0); G_MMA(0, 1, At, B1); BAR;
    G_LDA(At, 1, 1); BAR; WAIT_L(0); G_MMA(1, 0, At, B0); G_MMA(1, 1, At, B1); BAR; }
  if (wr == 0) BAR;
}

DI void gemm256_tile(const Params& p, int mode, int layer, const u16* R, const u16* Cc, int brow, int bcol, lchar* shm, int tid_in) {
  f32x4 acc[2][2][4][2];
  gemm256_core(R, Cc, brow, bcol, shm, tid_in, acc);
  int tid = tid_in;
  asm volatile("" : "+v"(tid));
  const int wid = tid >> 6, lane = tid & 63, wr = wid >> 2, wc = wid & 3, fr = lane & 15, fq = lane >> 4;
  if (mode == EPI_PROJ) {
#pragma unroll
    for (int ai = 0; ai < 2; ++ai)
#pragma unroll
      for (int bj = 0; bj < 2; ++bj)
#pragma unroll
        for (int m = 0; m < 4; ++m)
#pragma unroll
          for (int n = 0; n < 2; ++n) {
            const int nc = brow + ai * 128 + wr * 64 + m * 16 + fq * 4, tok = bcol + bj * 128 + wc * 32 + n * 16 + fr;
            const f32x4 v = acc[ai][bj][m][n];
            u32x2 o; o[0] = pack2(v[0], v[1]); o[1] = pack2(v[2], v[3]);
            *(u32x2*)(W_PROJ(p) + (size_t)tok * INC + nc) = o;
          }
  } else if (mode == EPI_VT) {
#pragma unroll
    for (int ai = 0; ai < 2; ++ai)
#pragma unroll
      for (int bj = 0; bj < 2; ++bj)
#pragma unroll
        for (int m = 0; m < 4; ++m)
#pragma unroll
          for (int n = 0; n < 2; ++n) {
            const int tok = brow + ai * 128 + wr * 64 + m * 16 + fq * 4, nn = bcol + bj * 128 + wc * 32 + n * 16 + fr - 1024;
            const int b = tok / LSEQ, pos = tok - b * LSEQ;
            const f32x4 v = acc[ai][bj][m][n];
            u32x2 o; o[0] = pack2(v[0], v[1]); o[1] = pack2(v[2], v[3]);
            *(u32x2*)(W_VT(p) + ((size_t)(b * 512 + nn)) * LP + pos) = o;
          }
  } else if (mode == EPI_OUT) {
#pragma unroll
    for (int ai = 0; ai < 2; ++ai)
#pragma unroll
      for (int bj = 0; bj < 2; ++bj)
#pragma unroll
        for (int m = 0; m < 4; ++m)
#pragma unroll
          for (int n = 0; n < 2; ++n) {
            const int nc = brow + ai * 128 + wr * 64 + m * 16 + fq * 4, tok = bcol + bj * 128 + wc * 32 + n * 16 + fr;
            const u32x2 hv = *(const u32x2*)(W_H(p) + (size_t)tok * DM + nc);
            const f32x4 v = acc[ai][bj][m][n];
            f32x4 o;
            o[0] = ALPHA * bflo(hv[0]) + v[0]; o[1] = ALPHA * bfhi(hv[0]) + v[1];
            o[2] = ALPHA * bflo(hv[1]) + v[2]; o[3] = ALPHA * bfhi(hv[1]) + v[3];
            *(f32x4*)(W_Y(p) + (size_t)tok * DM + nc) = o;
          }
  } else {
    LAS float* S = (LAS float*)shm;
    const int tok = tid & 255, kh = tid >> 8;
    float L0[16], L1[16];
#pragma unroll
    for (int ai = 0; ai < 2; ++ai) {
      __syncthreads();
#pragma unroll
      for (int bj = 0; bj < 2; ++bj)
#pragma unroll
        for (int m = 0; m < 4; ++m)
#pragma unroll
          for (int n = 0; n < 2; ++n) {
            const int tk = bj * 128 + wc * 32 + n * 16 + fr, key = wr * 64 + m * 16 + fq * 4;
#pragma unroll
            for (int j = 0; j < 4; ++j) S[tk * 128 + ((key + j + tk) & 127)] = acc[ai][bj][m][n][j];
          }
      __syncthreads();
      float v[16];
#pragma unroll
      for (int j = 0; j < 16; ++j) v[j] = -3.0e38f;
      for (int i = 0; i < 64; ++i) {
        const int key = kh * 64 + i;
        const float x = S[tok * 128 + ((key + tok) & 127)];
        insert16(v, __uint_as_float((__float_as_uint(x) & ~127u) | (unsigned)key));
      }
      __syncthreads();
      if (kh == 1) {
#pragma unroll
        for (int j = 0; j < 16; ++j) S[tok * 16 + j] = v[j];
      }
      __syncthreads();
      if (kh == 0) {
#pragma unroll
        for (int j = 0; j < 16; ++j) insert16(v, S[tok * 16 + j]);
      }
#pragma unroll
      for (int j = 0; j < 16; ++j) { if (ai == 0) L0[j] = v[j]; else L1[j] = v[j]; }
    }
    __syncthreads();
    LAS unsigned* LL = (LAS unsigned*)shm;
    if (kh == 0) {
#pragma unroll
      for (int j = 0; j < 16; ++j) { LL[tok * 32 + ((j + tok) & 31)] = __float_as_uint(L0[j]); LL[tok * 32 + ((16 + j + tok) & 31)] = __float_as_uint(L1[j]); }
      float s1[16], s2[16], v[16];
#pragma unroll
      for (int j = 0; j < 16; ++j) { s1[j] = __uint_as_float(__float_as_uint(L0[j]) & ~127u); s2[j] = __uint_as_float(__float_as_uint(L1[j]) & ~127u); v[j] = -3.0e38f; }
#pragma unroll
      for (int a = 0; a < 16; ++a)
#pragma unroll
        for (int bb = 0; bb < 16 / (a + 1); ++bb) {
          const float sm = s1[a] + s2[bb];
          insert16(v, __uint_as_float((__float_as_uint(sm) & ~255u) | (unsigned)(a * 16 + bb)));
        }
      float e[16], sum = 0.f;
      const float mx = __uint_as_float(__float_as_uint(v[0]) & ~255u);
#pragma unroll
      for (int j = 0; j < 16; ++j) { e[j] = fast_exp2((__uint_as_float(__float_as_uint(v[j]) & ~255u) - mx) * LOG2E); sum += e[j]; }
      const float inv = 1.0f / sum;
      const int hd = brow >> 8;
      int* di = W_IDX(p) + (size_t)(bcol + tok) * 128 + hd * 16;
      float* dg = W_G(p) + (size_t)(bcol + tok) * 128 + hd * 16;
#pragma unroll
      for (int q = 0; q < 4; ++q) {
        u32x4 oi; f32x4 og;
#pragma unroll
        for (int k = 0; k < 4; ++k) {
          const unsigned code = __float_as_uint(v[4 * q + k]) & 255u;
          const unsigned i1 = LL[tok * 32 + (((code >> 4) + tok) & 31)] & 127u, i2 = LL[tok * 32 + ((16 + (code & 15u) + tok) & 31)] & 127u;
          oi[k] = i1 * 128u + i2; og[k] = e[4 * q + k] * inv;
        }
        *(u32x4*)(di + 4 * q) = oi; *(f32x4*)(dg + 4 * q) = og;
      }
    }
    __syncthreads();
  }
}

DI void attn_item(const Params& p, int layer, int b, int hh, int qb, char* smem, float lam, float oml, int tid) {
  const int lane = tid & 63, w = tid >> 6, g = lane >> 4, l15 = lane & 15;
  const int idx32 = (lane ^ 32) << 2;
  float* tab = (float*)(smem + LDS_MISC);
  float* sg = tab + 128;
  __syncthreads();
  if (tid < 128) {
    int bucket = tid;
    if (tid >= 16) {
      int lg = 16 + (int)(logf((float)tid * (1.0f / 16.0f)) / 2.0794415416798357f * 16.0f);
      bucket = lg < 31 ? lg : 31;
    }
    tab[tid] = P_REL_BIAS(p)[bucket * 4 + hh] * LOG2E;
    sg[tid] = P_SUBLN_G(p)[layer * 128 + tid] * oml;
  }
  const int qpos = 64 * qb + 16 * w + l15;
  const int qrow = b * LSEQ + (qpos < LSEQ ? qpos : LSEQ - 1);
  bf16x8 qf[2][2];
  {
    const u16* qp = W_PROJ(p) + (size_t)qrow * INC + hh * 128 + g * 8;
#pragma unroll
    for (int m = 0; m < 2; ++m)
#pragma unroll
      for (int ks = 0; ks < 2; ++ks) qf[m][ks] = *(const bf16x8*)(qp + m * 64 + ks * 32);
  }
  const int nkt = qb + 1;
  const int kkey = tid >> 4, kc = tid & 15;
  const u16* ksrc = W_PROJ(p) + (size_t)(b * LSEQ + kkey) * INC + 512 + hh * 128 + kc * 8;
  const int kdst0 = ((((kc >> 3) * 2 + ((kc >> 2) & 1)) * 1024) + (((kc & 3) * 16 + kkey) * 16));
  const int vdv = tid >> 3, vc = tid & 7;
  const u16* vsrc = W_VT(p) + ((size_t)((b * 4 + hh) * 128 + vdv)) * LP + vc * 8;
  const int vdst0 = vdv * 144 + vc * 16;
  char* Kb = smem;
  char* Vb = smem + 32768;

  u32x4 rs[4];
#pragma unroll
  for (int j = 0; j < 4; ++j) rs[j] = *(const u32x4*)(ksrc + (size_t)(16 * j) * INC);
#pragma unroll
  for (int j = 0; j < 4; ++j) *(u32x4*)(Kb + kdst0 + j * 4096) = rs[j];
#pragma unroll
  for (int j = 0; j < 4; ++j) rs[j] = *(const u32x4*)(vsrc + (size_t)(32 * j) * LP);
#pragma unroll
  for (int j = 0; j < 4; ++j) *(u32x4*)(Vb + vdst0 + j * 4608) = rs[j];
  __syncthreads();

  f32x4 O[2][8];
#pragma unroll
  for (int m = 0; m < 2; ++m)
#pragma unroll
    for (int dt = 0; dt < 8; ++dt) O[m][dt] = (f32x4){0.f, 0.f, 0.f, 0.f};
  float mrun[2] = {-1.0e30f, -1.0e30f}, lsum[2] = {0.f, 0.f};
  const float tfar = tab[127];

  for (int kt = 0; kt < nkt; ++kt) {
    const int cur = kt & 1;
    const bool more = (kt + 1 < nkt);
    if (more) {
#pragma unroll
      for (int j = 0; j < 4; ++j) rs[j] = *(const u32x4*)(ksrc + (size_t)(64 * (kt + 1) + 16 * j) * INC);
    }
    const char* kb = Kb + cur * 16384;
    const char* vb = Vb + cur * 18432;
    f32x4 S[2][4];
#pragma unroll
    for (int k16 = 0; k16 < 4; ++k16)
#pragma unroll
      for (int m = 0; m < 2; ++m) {
        f32x4 s = (f32x4){0.f, 0.f, 0.f, 0.f};
#pragma unroll
        for (int ks = 0; ks < 2; ++ks) {
          const bf16x8 a = *(const bf16x8*)(kb + (((k16 * 2 + m) * 2 + ks) * 1024) + lane * 16);
          s = mfma16(a, qf[m][ks], s);
        }
        S[m][k16] = s;
      }
    const bool near = (qb - kt) <= 2;
#pragma unroll
    for (int m = 0; m < 2; ++m)
#pragma unroll
      for (int k16 = 0; k16 < 4; ++k16)
#pragma unroll
        for (int r = 0; r < 4; ++r) {
          float s = S[m][k16][r] * (0.125f * LOG2E);
          if (near) {
            const int dist = qpos - (64 * kt + 16 * k16 + 4 * g + r);
            s = dist < 0 ? -1.0e30f : s + tab[dist < 127 ? dist : 127];
          } else {
            s += tfar;
          }
          S[m][k16][r] = s;
        }
    bf16x8 pb[2][2];
#pragma unroll
    for (int m = 0; m < 2; ++m) {
      float mx = -1.0e30f;
#pragma unroll
      for (int k16 = 0; k16 < 4; ++k16)
#pragma unroll
        for (int r = 0; r < 4; ++r) mx = fmaxf(mx, S[m][k16][r]);
      mx = fmaxf(mx, shx16(mx));
      mx = fmaxf(mx, shx32(mx, idx32));
      const float mnew = fmaxf(mrun[m], mx);
      const float alpha = fast_exp2(mrun[m] - mnew);
      mrun[m] = mnew;
      float ps = 0.f;
#pragma unroll
      for (int k16 = 0; k16 < 4; ++k16)
#pragma unroll
        for (int r = 0; r < 4; ++r) { const float e = fast_exp2(S[m][k16][r] - mnew); S[m][k16][r] = e; ps += e; }
      lsum[m] = lsum[m] * alpha + ps;
#pragma unroll
      for (int dt = 0; dt < 8; ++dt) { O[m][dt][0] *= alpha; O[m][dt][1] *= alpha; O[m][dt][2] *= alpha; O[m][dt][3] *= alpha; }
#pragma unroll
      for (int kk = 0; kk < 2; ++kk) {
        u32x4 t;
        t[0] = pack2(S[m][2 * kk][0], S[m][2 * kk][1]); t[1] = pack2(S[m][2 * kk][2], S[m][2 * kk][3]);
        t[2] = pack2(S[m][2 * kk + 1][0], S[m][2 * kk + 1][1]); t[3] = pack2(S[m][2 * kk + 1][2], S[m][2 * kk + 1][3]);
        pb[m][kk] = __builtin_bit_cast(bf16x8, t);
      }
    }
    if (more) {
#pragma unroll
      for (int j = 0; j < 4; ++j) *(u32x4*)(Kb + (cur ^ 1) * 16384 + kdst0 + j * 4096) = rs[j];
#pragma unroll
      for (int j = 0; j < 4; ++j) rs[j] = *(const u32x4*)(vsrc + (size_t)(32 * j) * LP + 64 * (kt + 1));
    }
#pragma unroll
    for (int kk = 0; kk < 2; ++kk)
#pragma unroll
      for (int dt = 0; dt < 8; ++dt) {
        const char* va = vb + (16 * dt + l15) * 144 + (32 * kk + 4 * g) * 2;
        const u32x2 lo = *(const u32x2*)(va), hi = *(const u32x2*)(va + 32);
        u32x4 t; t[0] = lo[0]; t[1] = lo[1]; t[2] = hi[0]; t[3] = hi[1];
        const bf16x8 a = __builtin_bit_cast(bf16x8, t);
        O[0][dt] = mfma16(a, pb[0][kk], O[0][dt]);
        O[1][dt] = mfma16(a, pb[1][kk], O[1][dt]);
      }
    if (more) {
#pragma unroll
      for (int j = 0; j < 4; ++j) *(u32x4*)(Vb + (cur ^ 1) * 18432 + vdst0 + j * 4608) = rs[j];
    }
    __syncthreads();
  }
  float l0 = lsum[0], l1 = lsum[1];
  l0 += shx16(l0); l0 += shx32(l0, idx32);
  l1 += shx16(l1); l1 += shx32(l1, idx32);
  const float c1 = 1.0f / l0, c2 = lam / l1;
  float ss = 0.f;
#pragma unroll
  for (int dt = 0; dt < 8; ++dt)
#pragma unroll
    for (int r = 0; r < 4; ++r) { const float o = O[0][dt][r] * c1 - O[1][dt][r] * c2; O[0][dt][r] = o; ss += o * o; }
  ss += shx16(ss); ss += shx32(ss, idx32);
  const float rinv = rsqrtf(ss * (1.0f / 128.0f) + 1e-5f);
  if (qpos < LSEQ) {
    u16* dst = W_MIX(p) + (size_t)(b * LSEQ + qpos) * DM + hh * 128 + 4 * g;
#pragma unroll
    for (int dt = 0; dt < 8; ++dt) {
      const int dv0 = 16 * dt + 4 * g;
      u32x2 o;
      o[0] = pack2(O[0][dt][0] * rinv * sg[dv0 + 0], O[0][dt][1] * rinv * sg[dv0 + 1]);
      o[1] = pack2(O[0][dt][2] * rinv * sg[dv0 + 2], O[0][dt][3] * rinv * sg[dv0 + 3]);
      *(u32x2*)(dst + 16 * dt) = o;
    }
  }
}

DI void conv_item(const Params& p, int layer, int item, int tid) {
  const int ch = (tid & 63) * 8;
  const float* cw = P_CONV_W(p) + (size_t)layer * 3 * 512;
  float w0[8], w1[8], w2[8];
#pragma unroll
  for (int e = 0; e < 8; ++e) { w0[e] = cw[ch + e]; w1[e] = cw[512 + ch + e]; w2[e] = cw[1024 + ch + e]; }
#pragma unroll
  for (int i = 0; i < 4; ++i) {
    const int t = item * 16 + (tid >> 6) + 4 * i;
    const int pos = t % LSEQ;
    const u16* row = W_PROJ(p) + (size_t)t * INC;
    float accv[8];
#pragma unroll
    for (int e = 0; e < 8; ++e) accv[e] = 0.f;
#pragma unroll
    for (int d = 0; d < 3; ++d) {
      if (pos - 2 + d >= 0) {
        const u16* r2 = row - (size_t)(2 - d) * INC;
        const u32x4 gc = *(const u32x4*)(r2 + 2048 + ch), zz = *(const u32x4*)(r2 + 2560 + ch);
#pragma unroll
        for (int e = 0; e < 4; ++e) {
          const float wlo = d == 0 ? w0[2 * e] : (d == 1 ? w1[2 * e] : w2[2 * e]);
          const float whi = d == 0 ? w0[2 * e + 1] : (d == 1 ? w1[2 * e + 1] : w2[2 * e + 1]);
          accv[2 * e] += wlo * (bflo(gc[e]) * bflo(zz[e]));
          accv[2 * e + 1] += whi * (bfhi(gc[e]) * bfhi(zz[e]));
        }
      }
    }
    const u32x4 gb = *(const u32x4*)(row + 1536 + ch);
    u32x4 o;
#pragma unroll
    for (int e = 0; e < 4; ++e) o[e] = pack2(bflo(gb[e]) * accv[2 * e], bfhi(gb[e]) * accv[2 * e + 1]);
    *(u32x4*)(W_MIX(p) + (size_t)t * DM + 512 + ch) = o;
  }
}

DI void phase_prologue(const Params& p, char* smem, int wave) {
  const int tid = otid_w(wave), lane = tid & 63, wid = tid >> 6, hb = tid >> 8, htid = tid & 255;
  const int nblk = gridDim.x, bid = blockIdx.x;
  const size_t gtid = (size_t)bid * NTHREADS + tid, gthreads = (size_t)nblk * NTHREADS;
  float* sm = (float*)(smem + hb * LDS_HALF);
  for (int it0 = bid; it0 < 2048; it0 += nblk) {
    const int it = it0 * 2 + hb;
    if (it < 3072) {
      const int l = it / 768, r = it % 768, kb = r / 48, nb = r % 48;
      transpose_tile(P_W_IN(p) + (size_t)l * 1024 * 3072, 3072, W_WIN(p) + (size_t)l * 3072 * 1024, 1024, kb * 64, nb * 64, sm, htid);
    } else {
      const int i2 = it - 3072, l = i2 / 256, r = i2 % 256, kb = r / 16, nb = r % 16;
      transpose_tile(P_W_OUT(p) + (size_t)l * 1024 * 1024, 1024, W_WOUT(p) + (size_t)l * 1024 * 1024, 1024, kb * 64, nb * 64, sm, htid);
    }
  }
  convert_straight(P_W_Q(p), W_WQB(p), (size_t)4 * 1024 * 2048 / 8, gtid, gthreads);
  convert_straight(P_SUB_KEYS(p), W_SKB(p), (size_t)4 * 16 * 128 * 128 / 8, gtid, gthreads);
  for (int t = bid * 8 + wid; t < TTOK; t += nblk * 8) {
    const int b = t / LSEQ, pos = t - b * LSEQ;
    const float* src = pos < NMETA ? P_META(p) + (size_t)pos * DM : P_X(p) + ((size_t)b * SEQ + pos - NMETA) * DM;
    float v[16];
    load_row_f32<0>(src, v, lane);
    ln_row<0>(v, P_LN_IN_G(p), P_LN_IN_B(p), lane);
    store_row_bf16<0>(W_H(p) + (size_t)t * DM, v, lane);
  }
}

DI void phase_fold(const Params& p, char* smem, int wave) {
  const int tid = otid_w(wave), hb = tid >> 8, htid = tid & 255;
  for (int it0 = blockIdx.x; it0 < 256; it0 += gridDim.x) {
    const int it = it0 * 2 + hb;
    const int l = it >> 7, hp = (it >> 3) & 15, mt = it & 7;
    gemm_tile_fold(W_WQB(p) + (size_t)l * 1024 * 2048 + hp * 128, 2048, W_SKB(p) + ((size_t)l * 16 + hp) * 128 * 128, 128, 128, mt * 128, smem + hb * 65536,
                   W_WSC(p) + (size_t)l * 2048 * 1024 + (size_t)hp * 128 * 1024, htid);
  }
}

DI bool tile_order(int i, int nM, int nN, int& pm, int& pn) {
  const int nwg = nM * nN;
  const long L = (long)i * gridDim.x + blockIdx.x;
  if (L >= nwg) return false;
  int wgid = (int)L;
  { const int q = nwg / 8, r = nwg % 8, xcd = wgid % 8, off = wgid / 8; wgid = (xcd < r ? xcd * (q + 1) : r * (q + 1) + (xcd - r) * q) + off; }
  const int nig = 8 * nN, gid = wgid / nig, fm = gid * 8, gsz = (nM - fm) < 8 ? (nM - fm) : 8;
  pm = fm + ((wgid % nig) % gsz); pn = (wgid % nig) / gsz;
  return true;
}

DI void phase_gemm(const Params& p, int layer, int which, char* smem, int wave) {
  const int tid0 = otid_w(wave);
  const u16* W = which == 0 ? W_WIN(p) + (size_t)layer * 3072 * 1024 : (which == 1 ? W_WOUT(p) + (size_t)layer * 1024 * 1024 : W_WSC(p) + (size_t)layer * 2048 * 1024);
  const u16* X = which == 1 ? W_MIX(p) : W_H(p);
  const int nN = which == 0 ? 12 : (which == 1 ? 4 : 8);
  int pm, pn;
  for (int i = 0; tile_order(i, 258, nN, pm, pn); ++i) {
    const bool vt = (which == 0) && (pn == 4 || pn == 5);
    const int mode = which == 0 ? (vt ? EPI_VT : EPI_PROJ) : (which == 1 ? EPI_OUT : EPI_TOPK);
    int tid = tid0;
    asm volatile("" : "+v"(tid));
    gemm256_tile(p, mode, layer, vt ? X : W, vt ? W : X, vt ? pm * 256 : pn * 256, vt ? pn * 256 : pm * 256, (lchar*)smem, tid);
  }
}

DI void phase_attn(const Params& p, int layer, char* smem, int wave) {
  const int tid = otid_w(wave), lane = tid & 63, hb = tid >> 8, htid = tid & 255;
  const float lam_init = 0.8f - 0.6f * expf(-0.3f * (float)layer);
  float d1 = P_LQ1(p)[layer * 64 + lane] * P_LK1(p)[layer * 64 + lane], d2 = P_LQ2(p)[layer * 64 + lane] * P_LK2(p)[layer * 64 + lane];
  d1 = wave_sum(d1); d2 = wave_sum(d2);
  const float lam = expf(d1) - expf(d2) + lam_init;
  for (int it = blockIdx.x; it < 2112 + 2064; it += gridDim.x) {
    if (it < 2112) {
      const int it2 = it * 2 + hb, qb = 32 - (it2 >> 7), bh = it2 & 127;
      attn_item(p, layer, bh >> 2, bh & 3, qb, smem + hb * LDS_HALF, lam, 1.0f - lam_init, htid);
    } else {
      conv_item(p, layer, (it - 2112) * 2 + hb, htid);
    }
  }
}

DI void phase_ln(const Params& p, int layer, int which, int wave) {
  const int tid = otid_w(wave), lane = tid & 63, wid = tid >> 6;
  const int nblk = gridDim.x, bid = blockIdx.x;
  const float* lg = (which ? P_LN2_G(p) : P_LN1_G(p)) + layer * DM;
  const float* lb = (which ? P_LN2_B(p) : P_LN1_B(p)) + layer * DM;
  const bool final_out = which && (layer == DEPTH - 1);
  for (int t = bid * 8 + wid; t < TTOK; t += nblk * 8) {
    float v[16];
    load_row_f32<0>(W_Y(p) + (size_t)t * DM, v, lane);
    ln_row<0>(v, lg, lb, lane);
    if (final_out) {
      const int b = t / LSEQ, pos = t - b * LSEQ;
      if (pos >= NMETA) {
        float* dst = p.out + ((size_t)b * SEQ + pos - NMETA) * DM;
#pragma unroll
        for (int hh = 0; hh < 2; ++hh) {
          *(f32x4*)(dst + hh * 512 + 8 * lane) = (f32x4){v[hh * 8], v[hh * 8 + 1], v[hh * 8 + 2], v[hh * 8 + 3]};
          *(f32x4*)(dst + hh * 512 + 8 * lane + 4) = (f32x4){v[hh * 8 + 4], v[hh * 8 + 5], v[hh * 8 + 6], v[hh * 8 + 7]};
        }
      }
    } else {
      store_row_bf16<0>(W_H(p) + (size_t)t * DM, v, lane);
    }
  }
  if (which) return;
  for (int r = bid * 8 + wid; r < 2 * PEER_N; r += nblk * 8) {
    const bool isv = r >= PEER_N;
    const int e = isv ? r - PEER_N : r;
    const float* src = (isv ? P_PEER_V(p) : P_PEER_U(p)) + ((size_t)layer * PEER_N + e) * DM + 16 * lane;
    f32x4 a[4];
#pragma unroll
    for (int k = 0; k < 4; ++k) a[k] = *(const f32x4*)(src + 4 * k);
    float am = 0.f;
#pragma unroll
    for (int k = 0; k < 4; ++k) am = fmaxf(am, fmaxf(fmaxf(fabsf(a[k][0]), fabsf(a[k][1])), fmaxf(fabsf(a[k][2]), fabsf(a[k][3]))));
    am = wave_max_nonneg(am);
    const float sc = am > 0.f ? 224.0f / am : 1.0f;
    if (lane == 0) (isv ? W_SV(p) : W_SU(p))[e] = am > 0.f ? am * (1.0f / 224.0f) : 1.0f;
    u32x4 o;
#pragma unroll
    for (int k = 0; k < 4; ++k) {
      int w = 0;
      w = __builtin_amdgcn_cvt_pk_fp8_f32(a[k][0] * sc, a[k][1] * sc, w, false);
      w = __builtin_amdgcn_cvt_pk_fp8_f32(a[k][2] * sc, a[k][3] * sc, w, true);
      o[k] = (unsigned)w;
    }
    *(u32x4*)((isv ? W_VB(p) : W_UB(p)) + (size_t)(lane >> 3) * (PEER_N * 128) + (size_t)e * 128 + 16 * (lane & 7)) = o;
  }
}

#define DPP_F(v, ctrl) __int_as_float(__builtin_amdgcn_update_dpp(0, __float_as_int(v), (ctrl), 0xf, 0xf, true))
DI void phase_peer_dots(const Params& p, int layer, int wave) {
  const int tid = otid_w(wave), lane = tid & 63, wid = tid >> 6, c = lane & 7, r = lane >> 3;
  const int x = blockIdx.x & 7, wslot = (blockIdx.x >> 3) * 8 + wid, nslot = (gridDim.x >> 3) * 8;
  const unsigned char* ub = W_UB(p) + (size_t)x * (PEER_N * 128) + c * 16;
  float* pd = W_Y(p);
  const int bp0 = 4 * r;
  for (int t = wslot; t < TTOK; t += nslot) {
    float xs[16];
    {
      const u16* hp = W_H(p) + (size_t)t * DM + x * 128 + 16 * c;
      const u32x4 a = *(const u32x4*)(hp), b = *(const u32x4*)(hp + 8);
#pragma unroll
      for (int e = 0; e < 4; ++e) { xs[2 * e] = bflo(a[e]); xs[2 * e + 1] = bfhi(a[e]); xs[8 + 2 * e] = bflo(b[e]); xs[8 + 2 * e + 1] = bfhi(b[e]); }
    }
    const int idxA = W_IDX(p)[(size_t)t * 128 + lane], idxB = W_IDX(p)[(size_t)t * 128 + 64 + lane];
    u32x4 rr[16];
#pragma unroll
    for (int g = 0; g < 16; ++g) {
      const int e = __builtin_amdgcn_ds_bpermute(bp0 + 32 * (g & 7), g < 8 ? idxA : idxB);
      rr[g] = *(const u32x4*)(ub + (size_t)e * 128);
    }
    float pA = 0.f, pB = 0.f;
#pragma unroll
    for (int g = 0; g < 16; ++g) {
      float d = 0.f;
#pragma unroll
      for (int k = 0; k < 4; ++k) {
        const f32x2 lo = __builtin_amdgcn_cvt_pk_f32_fp8((int)rr[g][k], false), hi = __builtin_amdgcn_cvt_pk_f32_fp8((int)rr[g][k], true);
        d += xs[4 * k] * lo[0] + xs[4 * k + 1] * lo[1] + xs[4 * k + 2] * hi[0] + xs[4 * k + 3] * hi[1];
      }
      d += DPP_F(d, 0xB1); d += DPP_F(d, 0x4E); d += DPP_F(d, 0x141);
      if (c == (g & 7)) { if (g < 8) pA = d; else pB = d; }
    }
    float* dst = pd + ((size_t)t * 8 + x) * 128 + 8 * c + r;
    dst[0] = pA; dst[64] = pB;
  }
}

DI void phase_peer_w(const Params& p, int layer, int wave) {
  const int tid = otid_w(wave), lane = tid & 63, wid = tid >> 6;
  const float* pd = W_Y(p);
  for (int t = blockIdx.x * 8 + wid; t < TTOK; t += gridDim.x * 8) {
#pragma unroll
    for (int hf = 0; hf < 2; ++hf) {
      const int j = hf * 64 + lane;
      float sacc = 0.f;
#pragma unroll
      for (int xx = 0; xx < 8; ++xx) sacc += pd[((size_t)t * 8 + xx) * 128 + j];
      const int e = W_IDX(p)[(size_t)t * 128 + j];
      const float act = sacc * W_SU(p)[e];
      W_G(p)[(size_t)t * 128 + j] = W_G(p)[(size_t)t * 128 + j] * (0.5f * act * (1.0f + erff(act * 0.7071067811865476f))) * W_SV(p)[e];
    }
  }
}

DI void phase_peer_v(const Params& p, int layer, int wave) {
  const int tid = otid_w(wave), lane = tid & 63, wid = tid >> 6, c = lane & 7, r = lane >> 3;
  const int x = blockIdx.x & 7, wslot = (blockIdx.x >> 3) * 8 + wid, nslot = (gridDim.x >> 3) * 8;
  const unsigned char* vb = W_VB(p) + (size_t)x * (PEER_N * 128) + c * 16;
  float* y2 = W_Y(p);
  const int bp0 = 4 * r, idx32 = (lane ^ 32) << 2;
  for (int t = wslot; t < TTOK; t += nslot) {
    const int idxA = W_IDX(p)[(size_t)t * 128 + lane], idxB = W_IDX(p)[(size_t)t * 128 + 64 + lane];
    const float wA = W_G(p)[(size_t)t * 128 + lane], wB = W_G(p)[(size_t)t * 128 + 64 + lane];
    u32x4 rr[16];
#pragma unroll
    for (int g = 0; g < 16; ++g) {
      const int e = __builtin_amdgcn_ds_bpermute(bp0 + 32 * (g & 7), g < 8 ? idxA : idxB);
      rr[g] = *(const u32x4*)(vb + (size_t)e * 128);
    }
    float acc[16];
#pragma unroll
    for (int i = 0; i < 16; ++i) acc[i] = 0.f;
#pragma unroll
    for (int g = 0; g < 16; ++g) {
      const float wj = __int_as_float(__builtin_amdgcn_ds_bpermute(bp0 + 32 * (g & 7), __float_as_int(g < 8 ? wA : wB)));
#pragma unroll
      for (int k = 0; k < 4; ++k) {
        const f32x2 lo = __builtin_amdgcn_cvt_pk_f32_fp8((int)rr[g][k], false), hi = __builtin_amdgcn_cvt_pk_f32_fp8((int)rr[g][k], true);
        acc[4 * k] += wj * lo[0]; acc[4 * k + 1] += wj * lo[1]; acc[4 * k + 2] += wj * hi[0]; acc[4 * k + 3] += wj * hi[1];
      }
    }
#pragma unroll
    for (int i = 0; i < 16; ++i) {
      float v = acc[i];
      v += DPP_F(v, 0x128);
      v += shx16(v);
      v += shx32(v, idx32);
      acc[i] = v;
    }
    if (r == 0) {
      const u16* hp = W_H(p) + (size_t)t * DM + x * 128 + 16 * c;
      const u32x4 a = *(const u32x4*)(hp), b = *(const u32x4*)(hp + 8);
      float* dst = y2 + (size_t)t * DM + x * 128 + 16 * c;
      *(f32x4*)(dst) = (f32x4){ALPHA * bflo(a[0]) + acc[0], ALPHA * bfhi(a[0]) + acc[1], ALPHA * bflo(a[1]) + acc[2], ALPHA * bfhi(a[1]) + acc[3]};
      *(f32x4*)(dst + 4) = (f32x4){ALPHA * bflo(a[2]) + acc[4], ALPHA * bfhi(a[2]) + acc[5], ALPHA * bflo(a[3]) + acc[6], ALPHA * bfhi(a[3]) + acc[7]};
      *(f32x4*)(dst + 8) = (f32x4){ALPHA * bflo(b[0]) + acc[8], ALPHA * bfhi(b[0]) + acc[9], ALPHA * bflo(b[1]) + acc[10], ALPHA * bfhi(b[1]) + acc[11]};
      *(f32x4*)(dst + 12) = (f32x4){ALPHA * bflo(b[2]) + acc[12], ALPHA * bfhi(b[2]) + acc[13], ALPHA * bflo(b[3]) + acc[14], ALPHA * bfhi(b[3]) + acc[15]};
    }
  }
}

#define XB_TMO      128
#define XB_XCNT(j)  (256  + 64 * (j))
#define XB_XSUB(j)  (1280 + 64 * (j))
#define XB_XGEN(j)  (2304 + 64 * (j))
#define XB_TOP      3328
#define XB_TOPGEN   3392
#define XCD_BAR_WORDS 3456
#define XB_SPIN_CAP (1u << 22)
DI unsigned xb_ld(unsigned* p)              { return __hip_atomic_load(p, __ATOMIC_RELAXED, __HIP_MEMORY_SCOPE_AGENT); }
DI unsigned xb_add(unsigned* p, unsigned v) { return __hip_atomic_fetch_add(p, v, __ATOMIC_RELAXED, __HIP_MEMORY_SCOPE_AGENT); }
DI unsigned xb_xcc_id() { return (unsigned)__builtin_amdgcn_s_getreg((3 << 11) | 20) & 0xFu; }
#define XB_SPIN(cond, bar) do { unsigned _sp = 0; while (cond) { __builtin_amdgcn_s_sleep(1); \
    if ((++_sp & 255u) == 0u) { if (xb_ld(&(bar)[XB_TMO])) break; if (_sp > XB_SPIN_CAP) { atomicAdd(&(bar)[XB_TMO], 1u); break; } } } } while (0)
DI bool is_thread0(int wave) { unsigned z = 0u; asm volatile("" : "+v"(z)); return wave == 0 && __builtin_amdgcn_mbcnt_hi(~0u, __builtin_amdgcn_mbcnt_lo(~0u, z)) == 0u; }
DI void xcd_barrier_complete(unsigned* bar, unsigned x, unsigned& nloc, unsigned& nx) {
  const unsigned G = gridDim.x;
  unsigned sum, cnt, mine, sp = 0u;
  for (;;) {
    sum = 0u; cnt = 0u; mine = 0u;
#pragma unroll
    for (unsigned j = 0; j < 16; ++j) { const unsigned c = xb_ld(&bar[XB_XCNT(j)]); sum += c; cnt += (c > 0u) ? 1u : 0u; mine = (j == x) ? c : mine; }
    if (sum == G) break;
    __builtin_amdgcn_s_sleep(1);
    if ((++sp & 255u) == 0u) { if (xb_ld(&bar[XB_TMO])) break; if (sp > XB_SPIN_CAP) { atomicAdd(&bar[XB_TMO], 1u); break; } }
  }
  nloc = mine > 0u ? mine : 1u; nx = cnt > 0u ? cnt : 1u;
}
DI void xcd_barrier(unsigned* bar, volatile LAS unsigned* st, int wave) {
  asm volatile("s_waitcnt vmcnt(0)" ::: "memory");
  __syncthreads();
  if (is_thread0(wave)) {
    const unsigned x = xb_xcc_id();
    __builtin_amdgcn_s_waitcnt(0);
    unsigned nloc = st[0], nx = st[1];
    if (nloc == 0u) { xcd_barrier_complete(bar, x, nloc, nx); st[0] = nloc; st[1] = nx; }
    const unsigned old = xb_add(&bar[XB_XSUB(x)], 1u);
    const unsigned gen = old / nloc;
    if (old + 1u == (gen + 1u) * nloc) {
      __builtin_amdgcn_fence(__ATOMIC_RELEASE, "agent");
      asm volatile("s_waitcnt vmcnt(0)" ::: "memory");
      const unsigned og = xb_add(&bar[XB_TOP], 1u);
      const unsigned tg = og / nx;
      if (og + 1u == (tg + 1u) * nx) xb_add(&bar[XB_TOPGEN], 1u);
      else XB_SPIN(xb_ld(&bar[XB_TOPGEN]) == tg, bar);
      __builtin_amdgcn_fence(__ATOMIC_ACQUIRE, "agent");
      xb_add(&bar[XB_XGEN(x)], 1u);
      asm volatile("s_waitcnt vmcnt(0)" ::: "memory");
    } else {
      XB_SPIN(xb_ld(&bar[XB_XGEN(x)]) == gen, bar);
      __builtin_amdgcn_fence(__ATOMIC_ACQUIRE, "agent");
      asm volatile("s_waitcnt vmcnt(0)" ::: "memory");
    }
  }
  __syncthreads();
}

__global__ void __launch_bounds__(NTHREADS, 2) mega(Params p) {
  extern __shared__ __attribute__((aligned(16))) char smem[];
  cg::grid_group grid = cg::this_grid();
  const int wave = __builtin_amdgcn_readfirstlane((int)(threadIdx.x >> 6));
  unsigned* bar = (unsigned*)(p.ws + WS_BAR);
  volatile LAS unsigned* st = (volatile LAS unsigned*)((lchar*)smem + LDS_XB);
  if (threadIdx.x == 0) { st[0] = 0u; st[1] = 0u; (void)xb_add(&bar[XB_XCNT(xb_xcc_id())], 1u); }
  __syncthreads();
  phase_prologue(p, smem, wave);
  grid.sync();
  phase_fold(p, smem, wave);
  xcd_barrier(bar, st, wave);
#pragma unroll 1
  for (int step = 0; step < DEPTH * 9; ++step) {
    const int layer = step / 9, ph = step - layer * 9;
    if (ph == 0 || ph == 2 || ph == 4) phase_gemm(p, layer, ph >> 1, smem, wave);
    else if (ph == 1) phase_attn(p, layer, smem, wave);
    else if (ph == 3 || ph == 8) phase_ln(p, layer, ph == 8, wave);
    else if (ph == 5) phase_peer_dots(p, layer, wave);
    else if (ph == 6) phase_peer_w(p, layer, wave);
    else phase_peer_v(p, layer, wave);
    if (step + 1 < DEPTH * 9) xcd_barrier(bar, st, wave);
  }
}

extern "C" void kernel_launch(void* const* d_in, const int* in_sizes, int n_in, void* d_out, int out_size, void* d_ws, size_t ws_size,
                              hipStream_t stream) {
  static int grid_blocks = 0;
  if (grid_blocks == 0) {
    if (ws_size < WS_END) { fprintf(stderr, "kernel_launch: workspace too small: need %zu, got %zu\n", (size_t)WS_END, ws_size); grid_blocks = -1; return; }
    int dev = 0, cus = 0, per_cu = 0;
    hipGetDevice(&dev);
    hipDeviceGetAttribute(&cus, hipDeviceAttributeMultiprocessorCount, dev);
    hipFuncSetAttribute((const void*)mega, hipFuncAttributeMaxDynamicSharedMemorySize, LDS_BYTES);
    hipOccupancyMaxActiveBlocksPerMultiprocessor(&per_cu, (const void*)mega, NTHREADS, LDS_BYTES);
    if (per_cu < 1) per_cu = 1;
    if (per_cu > 1) per_cu = 1;
    grid_blocks = cus * per_cu;
  }
  if (grid_blocks < 0) return;
  Params p{};
  for (int i = 0; i < 21; ++i) p.in[i] = (const float*)d_in[i];
  p.out = (float*)d_out;
  p.ws = (char*)d_ws;
  if (hipMemsetAsync((char*)d_ws + WS_BAR, 0, 16384, stream) != hipSuccess) { fprintf(stderr, "kernel_launch: memset of the barrier words failed\n"); return; }
  void* args[] = {&p};
  hipError_t e = hipLaunchCooperativeKernel((const void*)mega, dim3(grid_blocks), dim3(NTHREADS), args, LDS_BYTES, stream);
  if (e != hipSuccess) fprintf(stderr, "cooperative launch failed: %s (grid %d)\n", hipGetErrorString(e), grid_blocks);
}
```

```cpp
#include <hip/hip_runtime.h>
#include <hip/hip_cooperative_groups.h>
#include <cstdio>
#include <cstdint>
namespace cg = cooperative_groups;

typedef unsigned short u16;
typedef __attribute__((ext_vector_type(8))) short bf16x8;
typedef __attribute__((ext_vector_type(4))) float f32x4;
typedef __attribute__((ext_vector_type(4))) unsigned u32x4;
typedef __attribute__((ext_vector_type(2))) unsigned u32x2;
typedef __attribute__((ext_vector_type(2))) float f32x2;
#define DI __device__ __forceinline__
#define LAS __attribute__((address_space(3)))
typedef LAS char lchar;

#define DM 1024
#define NBATCH 32
#define SEQ 2048
#define NMETA 16
#define LSEQ 2064
#define TTOK 66048
#define DEPTH 4
#define INC 3072
#define LP 2112
#define PEER_N 16384
#define NTHREADS 512
#define LDS_MISC 69632
#define LDS_HALF 70656
#define LDS_XB 141312
#define LDS_BYTES 141328

#define ALPHA 1.681792830507429f
#define LOG2E 1.4426950408889634f

static constexpr size_t WS_WIN  = 0;
static constexpr size_t WS_WOUT = WS_WIN  + (size_t)4 * 3072 * 1024 * 2;
static constexpr size_t WS_WQB  = WS_WOUT + (size_t)4 * 1024 * 1024 * 2;
static constexpr size_t WS_SKB  = WS_WQB  + (size_t)4 * 1024 * 2048 * 2;
static constexpr size_t WS_WSC  = WS_SKB  + (size_t)4 * 16 * 128 * 128 * 2;
static constexpr size_t WS_UB   = WS_WSC  + (size_t)4 * 2048 * 1024 * 2;
static constexpr size_t WS_VB   = WS_UB   + (size_t)PEER_N * 1024;
static constexpr size_t WS_SU   = WS_VB   + (size_t)PEER_N * 1024;
static constexpr size_t WS_SV   = WS_SU   + (size_t)PEER_N * 4;
static constexpr size_t WS_H    = WS_SV   + (size_t)PEER_N * 4;
static constexpr size_t WS_MIX  = WS_H    + (size_t)TTOK * 1024 * 2;
static constexpr size_t WS_BIG  = WS_MIX  + (size_t)TTOK * 1024 * 2;
static constexpr size_t WS_VT   = WS_BIG  + (size_t)(TTOK + 64) * 3072 * 2;
static constexpr size_t WS_IDX  = WS_VT   + (size_t)NBATCH * 4 * 128 * LP * 2;
static constexpr size_t WS_G    = WS_IDX  + (size_t)TTOK * 128 * 4;
static constexpr size_t WS_BAR  = WS_G    + (size_t)TTOK * 128 * 4;
static constexpr size_t WS_END  = WS_BAR  + 16384;

struct Params {
  const float* in[21];
  float* out;
  char* ws;
};
#define P_X(p) ((p).in[0])
#define P_META(p) ((p).in[1])
#define P_LN_IN_G(p) ((p).in[2])
#define P_LN_IN_B(p) ((p).in[3])
#define P_REL_BIAS(p) ((p).in[4])
#define P_W_IN(p) ((p).in[5])
#define P_CONV_W(p) ((p).in[6])
#define P_LQ1(p) ((p).in[7])
#define P_LK1(p) ((p).in[8])
#define P_LQ2(p) ((p).in[9])
#define P_LK2(p) ((p).in[10])
#define P_SUBLN_G(p) ((p).in[11])
#define P_W_OUT(p) ((p).in[12])
#define P_LN1_G(p) ((p).in[13])
#define P_LN1_B(p) ((p).in[14])
#define P_W_Q(p) ((p).in[15])
#define P_SUB_KEYS(p) ((p).in[16])
#define P_PEER_U(p) ((p).in[17])
#define P_PEER_V(p) ((p).in[18])
#define P_LN2_G(p) ((p).in[19])
#define P_LN2_B(p) ((p).in[20])
#define W_WIN(p) ((u16*)((p).ws + WS_WIN))
#define W_WOUT(p) ((u16*)((p).ws + WS_WOUT))
#define W_WQB(p) ((u16*)((p).ws + WS_WQB))
#define W_SKB(p) ((u16*)((p).ws + WS_SKB))
#define W_WSC(p) ((u16*)((p).ws + WS_WSC))
#define W_UB(p) ((unsigned char*)((p).ws + WS_UB))
#define W_VB(p) ((unsigned char*)((p).ws + WS_VB))
#define W_SU(p) ((float*)((p).ws + WS_SU))
#define W_SV(p) ((float*)((p).ws + WS_SV))
#define W_H(p) ((u16*)((p).ws + WS_H))
#define W_MIX(p) ((u16*)((p).ws + WS_MIX))
#define W_PROJ(p) ((u16*)((p).ws + WS_BIG))
#define W_Y(p) ((float*)((p).ws + WS_BIG))
#define W_VT(p) ((u16*)((p).ws + WS_VT))
#define W_IDX(p) ((int*)((p).ws + WS_IDX))
#define W_G(p) ((float*)((p).ws + WS_G))

DI u16 f2bf(float x) { unsigned u = __float_as_uint(x); u += 0x7fffu + ((u >> 16) & 1u); return (u16)(u >> 16); }
typedef __attribute__((ext_vector_type(2))) __bf16 bf16x2_t;
DI unsigned pack2(float a, float b) { const bf16x2_t v = {(__bf16)a, (__bf16)b}; return __builtin_bit_cast(unsigned, v); }
DI float bflo(unsigned w) { return __uint_as_float(w << 16); }
DI float bfhi(unsigned w) { return __uint_as_float(w & 0xffff0000u); }
DI int otid_w(int wave) { unsigned z = 0u; asm volatile("" : "+v"(z)); int t = wave * 64 + (int)__builtin_amdgcn_mbcnt_hi(~0u, __builtin_amdgcn_mbcnt_lo(~0u, z)); asm volatile("" : "+v"(t)); return t; }
#define DPP_ADD(v, ctrl) ((v) + __int_as_float(__builtin_amdgcn_update_dpp(0, __float_as_int(v), (ctrl), 0xf, 0xf, true)))
DI float wave_sum(float v) {
  v = DPP_ADD(v, 0xB1);
  v = DPP_ADD(v, 0x4E);
  v = DPP_ADD(v, 0x141);
  v = DPP_ADD(v, 0x140);
  const int iv = __float_as_int(v);
  return __int_as_float(__builtin_amdgcn_readlane(iv, 0)) + __int_as_float(__builtin_amdgcn_readlane(iv, 16)) +
         __int_as_float(__builtin_amdgcn_readlane(iv, 32)) + __int_as_float(__builtin_amdgcn_readlane(iv, 48));
}
#define DPP_MAX(v, ctrl) fmaxf((v), __int_as_float(__builtin_amdgcn_update_dpp(0, __float_as_int(v), (ctrl), 0xf, 0xf, true)))
DI float wave_max_nonneg(float v) {
  v = DPP_MAX(v, 0xB1); v = DPP_MAX(v, 0x4E); v = DPP_MAX(v, 0x141); v = DPP_MAX(v, 0x140);
  const int iv = __float_as_int(v);
  return fmaxf(fmaxf(__int_as_float(__builtin_amdgcn_readlane(iv, 0)), __int_as_float(__builtin_amdgcn_readlane(iv, 16))),
               fmaxf(__int_as_float(__builtin_amdgcn_readlane(iv, 32)), __int_as_float(__builtin_amdgcn_readlane(iv, 48))));
}
DI float shx16(float v) { return __int_as_float(__builtin_amdgcn_ds_swizzle(__float_as_int(v), 0x401F)); }
DI float shx32(float v, int idx32) { return __int_as_float(__builtin_amdgcn_ds_bpermute(idx32, __float_as_int(v))); }
DI f32x4 mfma16(bf16x8 a, bf16x8 b, f32x4 c) { return __builtin_amdgcn_mfma_f32_16x16x32_bf16(a, b, c, 0, 0, 0); }
DI float fast_exp2(float x) { return __builtin_amdgcn_exp2f(x); }

DI void convert_straight(const float* __restrict__ src, u16* __restrict__ dst, size_t n8, size_t gtid, size_t gthreads) {
  for (size_t i = gtid; i < n8; i += gthreads) {
    const f32x4 a = *(const f32x4*)(src + i * 8), b = *(const f32x4*)(src + i * 8 + 4);
    u32x4 o; o[0] = pack2(a[0], a[1]); o[1] = pack2(a[2], a[3]); o[2] = pack2(b[0], b[1]); o[3] = pack2(b[2], b[3]);
    *(u32x4*)(dst + i * 8) = o;
  }
}

DI void transpose_tile(const float* __restrict__ src, int ldn, u16* __restrict__ dst, int ldk, int k0, int n0, float* sm, int tid) {
#pragma unroll
  for (int i = 0; i < 4; ++i) {
    const int r = (tid >> 4) + 16 * i, c4 = tid & 15;
    const f32x4 v = *(const f32x4*)(src + (size_t)(k0 + r) * ldn + n0 + 4 * c4);
    sm[r * 65 + 4 * c4 + 0] = v[0]; sm[r * 65 + 4 * c4 + 1] = v[1]; sm[r * 65 + 4 * c4 + 2] = v[2]; sm[r * 65 + 4 * c4 + 3] = v[3];
  }
  __syncthreads();
#pragma unroll
  for (int i = 0; i < 2; ++i) {
    const int n = (tid >> 3) + 32 * i, kc = tid & 7;
    u32x4 o;
#pragma unroll
    for (int e = 0; e < 4; ++e) o[e] = pack2(sm[(8 * kc + 2 * e) * 65 + n], sm[(8 * kc + 2 * e + 1) * 65 + n]);
    *(u32x4*)(dst + (size_t)(n0 + n) * ldk + k0 + 8 * kc) = o;
  }
  __syncthreads();
}

template <int LAYOUT> DI int col0(int lane, int hh) { return LAYOUT ? 16 * lane + 8 * hh : hh * 512 + 8 * lane; }
template <int LAYOUT>
DI void ln_row(float (&v)[16], const float* __restrict__ g, const float* __restrict__ b, int lane) {
  float s = 0.f;
#pragma unroll
  for (int i = 0; i < 16; ++i) s += v[i];
  const float mu = wave_sum(s) * (1.0f / 1024.0f);
  float q = 0.f;
#pragma unroll
  for (int i = 0; i < 16; ++i) { const float d = v[i] - mu; q += d * d; }
  const float rstd = rsqrtf(wave_sum(q) * (1.0f / 1024.0f) + 1e-5f);
#pragma unroll
  for (int hh = 0; hh < 2; ++hh) {
    const int c = col0<LAYOUT>(lane, hh);
    const f32x4 g0 = *(const f32x4*)(g + c), g1 = *(const f32x4*)(g + c + 4), b0 = *(const f32x4*)(b + c), b1 = *(const f32x4*)(b + c + 4);
#pragma unroll
    for (int e = 0; e < 4; ++e) {
      v[hh * 8 + e] = (v[hh * 8 + e] - mu) * rstd * g0[e] + b0[e];
      v[hh * 8 + 4 + e] = (v[hh * 8 + 4 + e] - mu) * rstd * g1[e] + b1[e];
    }
  }
}
template <int LAYOUT>
DI void store_row_bf16(u16* __restrict__ dst, const float (&v)[16], int lane) {
#pragma unroll
  for (int hh = 0; hh < 2; ++hh) {
    u32x4 o;
#pragma unroll
    for (int e = 0; e < 4; ++e) o[e] = pack2(v[hh * 8 + 2 * e], v[hh * 8 + 2 * e + 1]);
    *(u32x4*)(dst + col0<LAYOUT>(lane, hh)) = o;
  }
}
template <int LAYOUT>
DI void load_row_f32(const float* __restrict__ src, float (&v)[16], int lane) {
#pragma unroll
  for (int hh = 0; hh < 2; ++hh) {
    const int c = col0<LAYOUT>(lane, hh);
    const f32x4 a = *(const f32x4*)(src + c), b = *(const f32x4*)(src + c + 4);
#pragma unroll
    for (int e = 0; e < 4; ++e) { v[hh * 8 + e] = a[e]; v[hh * 8 + 4 + e] = b[e]; }
  }
}

enum { EPI_PROJ = 0, EPI_VT = 1, EPI_OUT = 2, EPI_TOPK = 3, EPI_FOLD = 4 };

template <bool SWAP>
DI void gemm_mainloop(const u16* __restrict__ A, int lda, const u16* __restrict__ Bt, int ldb, int K, int m0, int n0, char* smem,
                      f32x4 (&acc)[4][4], int tid) {
  const int lane = tid & 63, wid = tid >> 6, wm = wid >> 1, wn = wid & 1;
  const int srow = tid >> 3, skc = tid & 7;
  const u16* ap = A + (size_t)(m0 + srow) * lda + skc * 8;
  const u16* bp = Bt + (size_t)(n0 + srow) * ldb + skc * 8;
  const int dst0 = (((srow >> 4) * 2 + (skc >> 2)) * 1024) + (((skc & 3) * 16 + (srow & 15)) * 16);
#pragma unroll
  for (int i = 0; i < 4; ++i)
#pragma unroll
    for (int j = 0; j < 4; ++j) acc[i][j] = (f32x4){0.f, 0.f, 0.f, 0.f};
  u32x4 ra[4], rb[4];
#pragma unroll
  for (int j = 0; j < 4; ++j) { ra[j] = *(const u32x4*)(ap + (size_t)j * 32 * lda); rb[j] = *(const u32x4*)(bp + (size_t)j * 32 * ldb); }
#pragma unroll
  for (int j = 0; j < 4; ++j) { *(u32x4*)(smem + dst0 + j * 4096) = ra[j]; *(u32x4*)(smem + 16384 + dst0 + j * 4096) = rb[j]; }
  __syncthreads();
  const int KT = K >> 6;
  for (int kt = 0; kt < KT; ++kt) {
    char* cur = smem + (kt & 1) * 32768;
    char* nxt = smem + ((kt + 1) & 1) * 32768;
    const bool more = (kt + 1 < KT);
    if (more) {
      const u16* ap2 = ap + (kt + 1) * 64;
      const u16* bp2 = bp + (kt + 1) * 64;
#pragma unroll
      for (int j = 0; j < 4; ++j) { ra[j] = *(const u32x4*)(ap2 + (size_t)j * 32 * lda); rb[j] = *(const u32x4*)(bp2 + (size_t)j * 32 * ldb); }
    }
#pragma unroll
    for (int ks = 0; ks < 2; ++ks) {
      bf16x8 af[4], bfr[4];
#pragma unroll
      for (int i = 0; i < 4; ++i) af[i] = *(const bf16x8*)(cur + (((wm * 4 + i) * 2 + ks) * 1024) + lane * 16);
#pragma unroll
      for (int j = 0; j < 4; ++j) bfr[j] = *(const bf16x8*)(cur + 16384 + (((wn * 4 + j) * 2 + ks) * 1024) + lane * 16);
#pragma unroll
      for (int i = 0; i < 4; ++i)
#pragma unroll
        for (int j = 0; j < 4; ++j) acc[i][j] = SWAP ? mfma16(bfr[j], af[i], acc[i][j]) : mfma16(af[i], bfr[j], acc[i][j]);
    }
    if (more) {
#pragma unroll
      for (int j = 0; j < 4; ++j) { *(u32x4*)(nxt + dst0 + j * 4096) = ra[j]; *(u32x4*)(nxt + 16384 + dst0 + j * 4096) = rb[j]; }
    }
    __syncthreads();
  }
}

DI void insert16(float (&v)[16], float x) {
#pragma unroll
  for (int j = 0; j < 16; ++j) { const float hi = fmaxf(v[j], x); x = fminf(v[j], x); v[j] = hi; }
}

DI void gemm_tile_fold(const u16* A, int lda, const u16* Bt, int ldb, int K, int m0, char* smem, u16* dstT, int tid) {
  const int lane = tid & 63, wid = tid >> 6, wm = wid >> 1, wn = wid & 1, g = lane >> 4, l15 = lane & 15;
  f32x4 acc[4][4];
  gemm_mainloop<false>(A, lda, Bt, ldb, K, m0, 0, smem, acc, tid);
#pragma unroll
  for (int i = 0; i < 4; ++i)
#pragma unroll
    for (int j = 0; j < 4; ++j) {
      const int m = m0 + wm * 64 + 16 * i + 4 * g, n = wn * 64 + 16 * j + l15;
      u32x2 o; o[0] = pack2(acc[i][j][0], acc[i][j][1]); o[1] = pack2(acc[i][j][2], acc[i][j][3]);
      *(u32x2*)(dstT + (size_t)n * 1024 + m) = o;
    }
}

#define GK 1024
#define HTB 16384
DI int lds_byte(int r, int c) {
  const int st = (r >> 4) * 2 + (c >> 5), rr = r & 15, cc = c & 31, ob = rr * 64 + cc * 2;
  return st * 1024 + (ob ^ (((ob >> 9) & 1) << 5));
}
DI void stage_rc(int b, int& R, int& C) {
  const int st = b / 1024, sb = b % 1024, swz = sb ^ (((sb >> 9) & 1) << 5);
  R = (st >> 1) * 16 + swz / 64; C = (st & 1) * 32 + (swz % 64) / 2;
}
#define G_SA(b, h) (shm + ((b) * 2 + (h)) * HTB)
#define G_SB(b, h) (shm + (4 + (b) * 2 + (h)) * HTB)
#define G_STAGE(P, BASE, br, kt) do { const char* _g = (const char*)((BASE) + (size_t)(br) * GK + (kt) * 64); \
    __builtin_amdgcn_global_load_lds((const unsigned*)(_g + goff0), (LAS unsigned*)((P) + tid * 16), 16, 0, 0); \
    __builtin_amdgcn_global_load_lds((const unsigned*)(_g + goff1), (LAS unsigned*)((P) + tid * 16 + 8192), 16, 0, 0); } while (0)
#define G_LDA(dst, b, h) _Pragma("unroll") for (int m = 0; m < 4; ++m) _Pragma("unroll") for (int k = 0; k < 2; ++k) \
    dst[m][k] = *(const LAS bf16x8*)(G_SA(b, h) + lds_byte(wr * 64 + m * 16 + fr, k * 32 + fq * 8))
#define G_LDB(dst, b, h) _Pragma("unroll") for (int n = 0; n < 2; ++n) _Pragma("unroll") for (int k = 0; k < 2; ++k) \
    dst[n][k] = *(const LAS bf16x8*)(G_SB(b, h) + lds_byte(wc * 32 + n * 16 + fr, k * 32 + fq * 8))
#define G_MMA(ai, bj, At, Bx) do { __builtin_amdgcn_s_setprio(1); \
    _Pragma("unroll") for (int m = 0; m < 4; ++m) _Pragma("unroll") for (int n = 0; n < 2; ++n) _Pragma("unroll") for (int k = 0; k < 2; ++k) \
      acc[ai][bj][m][n] = __builtin_amdgcn_mfma_f32_16x16x32_bf16(At[m][k], Bx[n][k], acc[ai][bj][m][n], 0, 0, 0); \
    __builtin_amdgcn_s_setprio(0); } while (0)
#define WAIT_V(n) asm volatile("s_waitcnt vmcnt(" #n ")" ::: "memory")
#define WAIT_L(n) asm volatile("s_waitcnt lgkmcnt(" #n ")" ::: "memory")
#define BAR __builtin_amdgcn_s_barrier()
#define SCHED __builtin_amdgcn_sched_barrier(0)

DI void gemm256_core(const u16* __restrict__ A, const u16* __restrict__ Bt, int brow, int bcol, lchar* shm, int tid, f32x4 (&acc)[2][2][4][2]) {
  const int wid = tid >> 6, lane = tid & 63, wr = wid >> 2, wc = wid & 3, fr = lane & 15, fq = lane >> 4;
  int r0, c0, r1, c1;
  stage_rc(tid * 16, r0, c0); stage_rc(tid * 16 + 8192, r1, c1);
  const unsigned goff0 = (unsigned)(r0 * GK + c0) * 2u, goff1 = (unsigned)(r1 * GK + c1) * 2u;
#pragma unroll
  for (int ai = 0; ai < 2; ++ai)
#pragma unroll
    for (int bj = 0; bj < 2; ++bj)
#pragma unroll
      for (int m = 0; m < 4; ++m)
#pragma unroll
        for (int n = 0; n < 2; ++n) acc[ai][bj][m][n] = (f32x4){0.f, 0.f, 0.f, 0.f};
  bf16x8 At[4][2], B0[2][2], B1[2][2];
  const int nt = GK / 64;
  WAIT_V(0);
  __syncthreads();
  G_STAGE(G_SB(0, 0), Bt, bcol, 0); G_STAGE(G_SA(0, 0), A, brow, 0);
  G_STAGE(G_SB(0, 1), Bt, bcol + 128, 0); G_STAGE(G_SA(0, 1), A, brow + 128, 0);
  if (wr == 1) BAR;
  WAIT_V(4); BAR;
  G_STAGE(G_SB(1, 0), Bt, bcol, 1); G_STAGE(G_SA(1, 0), A, brow, 1); G_STAGE(G_SB(1, 1), Bt, bcol + 128, 1);
  WAIT_V(6); BAR;
  for (int t = 0; t < nt - 2; t += 2) {
    G_LDB(B0, 0, 0); SCHED; G_LDA(At, 0, 0); G_STAGE(G_SA(1, 1), A, brow + 128, t + 1);
    WAIT_L(8); BAR; WAIT_L(0); G_MMA(0, 0, At, B0); BAR; SCHED;
    G_LDB(B1, 0, 1); G_STAGE(G_SB(0, 0), Bt, bcol, t + 2);
    BAR; WAIT_L(0); G_MMA(0, 1, At, B1); BAR;
    G_LDA(At, 0, 1); G_STAGE(G_SA(0, 0), A, brow, t + 2);
    BAR; WAIT_L(0); G_MMA(1, 0, At, B0); BAR; SCHED;
    G_STAGE(G_SB(0, 1), Bt, bcol + 128, t + 2);
    WAIT_V(6); BAR; G_MMA(1, 1, At, B1); BAR;
    G_LDB(B0, 1, 0); SCHED; G_LDA(At, 1, 0); G_STAGE(G_SA(0, 1), A, brow + 128, t + 2);
    WAIT_L(8); BAR; WAIT_L(0); G_MMA(0, 0, At, B0); BAR; SCHED;
    G_LDB(B1, 1, 1); G_STAGE(G_SB(1, 0), Bt, bcol, t + 3);
    BAR; WAIT_L(0); G_MMA(0, 1, At, B1); BAR;
    G_LDA(At, 1, 1); G_STAGE(G_SA(1, 0), A, brow, t + 3);
    BAR; WAIT_L(0); G_MMA(1, 0, At, B0); BAR; SCHED;
    G_STAGE(G_SB(1, 1), Bt, bcol + 128, t + 3);
    WAIT_V(6); BAR; G_MMA(1, 1, At, B1); BAR;
  }
  { G_LDB(B0, 0, 0); G_LDA(At, 0, 0); G_STAGE(G_SA(1, 1), A, brow + 128, nt - 1);
    BAR; WAIT_L(0); G_MMA(0, 0, At, B0); BAR;
    G_LDB(B1, 0, 1); BAR; WAIT_L(0); G_MMA(0, 1, At, B1); BAR;
    G_LDA(At, 0, 1); WAIT_V(4); BAR; WAIT_L(0); G_MMA(1, 0, At, B0); G_MMA(1, 1, At, B1); BAR; }
  { G_LDB(B0, 1, 0); G_LDA(At, 1, 0); WAIT_V(2); BAR; WAIT_L(0); G_MMA(0, 0, At, B0); BAR;
    G_LDB(B1, 1, 1); WAIT_V(0); BAR; WAIT_L(0); G_MMA(0, 1, At, B1); BAR;
    G_LDA(At, 1, 1); BAR; WAIT_L(0); G_MMA(1, 0, At, B0); G_MMA(1, 1, At, B1); BAR; }
  if (wr == 0) BAR;
}

DI void gemm256_tile(const Params& p, int mode, int layer, const u16* R, const u16* Cc, int brow, int bcol, lchar* shm, int tid_in) {
  f32x4 acc[2][2][4][2];
  gemm256_core(R, Cc, brow, bcol, shm, tid_in, acc);
  int tid = tid_in;
  asm volatile("" : "+v"(tid));
  const int wid = tid >> 6, lane = tid & 63, wr = wid >> 2, wc = wid & 3, fr = lane & 15, fq = lane >> 4;
  if (mode == EPI_PROJ) {
#pragma unroll
    for (int ai = 0; ai < 2; ++ai)
#pragma unroll
      for (int bj = 0; bj < 2; ++bj)
#pragma unroll
        for (int m = 0; m < 4; ++m)
#pragma unroll
          for (int n = 0; n < 2; ++n) {
            const int nc = brow + ai * 128 + wr * 64 + m * 16 + fq * 4, tok = bcol + bj * 128 + wc * 32 + n * 16 + fr;
            const f32x4 v = acc[ai][bj][m][n];
            u32x2 o; o[0] = pack2(v[0], v[1]); o[1] = pack2(v[2], v[3]);
            *(u32x2*)(W_PROJ(p) + (size_t)tok * INC + nc) = o;
          }
  } else if (mode == EPI_VT) {
#pragma unroll
    for (int ai = 0; ai < 2; ++ai)
#pragma unroll
      for (int bj = 0; bj < 2; ++bj)
#pragma unroll
        for (int m = 0; m < 4; ++m)
#pragma unroll
          for (int n = 0; n < 2; ++n) {
            const int tok = brow + ai * 128 + wr * 64 + m * 16 + fq * 4, nn = bcol + bj * 128 + wc * 32 + n * 16 + fr - 1024;
            const int b = tok / LSEQ, pos = tok - b * LSEQ;
            const f32x4 v = acc[ai][bj][m][n];
            u32x2 o; o[0] = pack2(v[0], v[1]); o[1] = pack2(v[2], v[3]);
            *(u32x2*)(W_VT(p) + ((size_t)(b * 512 + nn)) * LP + pos) = o;
          }
  } else if (mode == EPI_OUT) {
#pragma unroll
    for (int ai = 0; ai < 2; ++ai)
#pragma unroll
      for (int bj = 0; bj < 2; ++bj) {
        u32x2 hv[4][2];
#pragma unroll
        for (int m = 0; m < 4; ++m)
#pragma unroll
          for (int n = 0; n < 2; ++n) {
            const int nc = brow + ai * 128 + wr * 64 + m * 16 + fq * 4, tok = bcol + bj * 128 + wc * 32 + n * 16 + fr;
            hv[m][n] = *(const u32x2*)(W_H(p) + (size_t)tok * DM + nc);
          }
#pragma unroll
        for (int m = 0; m < 4; ++m)
#pragma unroll
          for (int n = 0; n < 2; ++n) {
            const int nc = brow + ai * 128 + wr * 64 + m * 16 + fq * 4, tok = bcol + bj * 128 + wc * 32 + n * 16 + fr;
            const f32x4 v = acc[ai][bj][m][n];
            f32x4 o;
            o[0] = ALPHA * bflo(hv[m][n][0]) + v[0]; o[1] = ALPHA * bfhi(hv[m][n][0]) + v[1];
            o[2] = ALPHA * bflo(hv[m][n][1]) + v[2]; o[3] = ALPHA * bfhi(hv[m][n][1]) + v[3];
            *(f32x4*)(W_Y(p) + (size_t)tok * DM + nc) = o;
          }
      }
  } else {
    LAS float* S = (LAS float*)shm;
    const int tok = tid & 255, kh = tid >> 8;
    float L0[16], L1[16];
#pragma unroll
    for (int ai = 0; ai < 2; ++ai) {
      __syncthreads();
#pragma unroll
      for (int bj = 0; bj < 2; ++bj)
#pragma unroll
        for (int m = 0; m < 4; ++m)
#pragma unroll
          for (int n = 0; n < 2; ++n) {
            const int tk = bj * 128 + wc * 32 + n * 16 + fr, key = wr * 64 + m * 16 + fq * 4;
#pragma unroll
            for (int j = 0; j < 4; ++j) S[tk * 128 + ((key + j + tk) & 127)] = acc[ai][bj][m][n][j];
          }
      __syncthreads();
      float v[16];
#pragma unroll
      for (int j = 0; j < 16; ++j) v[j] = -3.0e38f;
      for (int i = 0; i < 64; ++i) {
        const int key = kh * 64 + i;
        const float x = S[tok * 128 + ((key + tok) & 127)];
        insert16(v, __uint_as_float((__float_as_uint(x) & ~127u) | (unsigned)key));
      }
      __syncthreads();
      if (kh == 1) {
#pragma unroll
        for (int j = 0; j < 16; ++j) S[tok * 16 + j] = v[j];
      }
      __syncthreads();
      if (kh == 0) {
#pragma unroll
        for (int j = 0; j < 16; ++j) insert16(v, S[tok * 16 + j]);
      }
#pragma unroll
      for (int j = 0; j < 16; ++j) { if (ai == 0) L0[j] = v[j]; else L1[j] = v[j]; }
    }
    __syncthreads();
    LAS unsigned* LL = (LAS unsigned*)shm;
    if (kh == 0) {
#pragma unroll
      for (int j = 0; j < 16; ++j) { LL[tok * 32 + ((j + tok) & 31)] = __float_as_uint(L0[j]); LL[tok * 32 + ((16 + j + tok) & 31)] = __float_as_uint(L1[j]); }
      float s1[16], s2[16], v[16];
#pragma unroll
      for (int j = 0; j < 16; ++j) { s1[j] = __uint_as_float(__float_as_uint(L0[j]) & ~127u); s2[j] = __uint_as_float(__float_as_uint(L1[j]) & ~127u); v[j] = -3.0e38f; }
#pragma unroll
      for (int a = 0; a < 16; ++a)
#pragma unroll
        for (int bb = 0; bb < 16 / (a + 1); ++bb) {
          const float sm = s1[a] + s2[bb];
          insert16(v, __uint_as_float((__float_as_uint(sm) & ~255u) | (unsigned)(a * 16 + bb)));
        }
      float e[16], sum = 0.f;
      const float mx = __uint_as_float(__float_as_uint(v[0]) & ~255u);
#pragma unroll
      for (int j = 0; j < 16; ++j) { e[j] = fast_exp2((__uint_as_float(__float_as_uint(v[j]) & ~255u) - mx) * LOG2E); sum += e[j]; }
      const float inv = 1.0f / sum;
      const int hd = brow >> 8;
      int* di = W_IDX(p) + (size_t)(bcol + tok) * 128 + hd * 16;
      float* dg = W_G(p) + (size_t)(bcol + tok) * 128 + hd * 16;
#pragma unroll
      for (int q = 0; q < 4; ++q) {
        u32x4 oi; f32x4 og;
#pragma unroll
        for (int k = 0; k < 4; ++k) {
          const unsigned code = __float_as_uint(v[4 * q + k]) & 255u;
          const unsigned i1 = LL[tok * 32 + (((code >> 4) + tok) & 31)] & 127u, i2 = LL[tok * 32 + ((16 + (code & 15u) + tok) & 31)] & 127u;
          oi[k] = i1 * 128u + i2; og[k] = e[4 * q + k] * inv;
        }
        *(u32x4*)(di + 4 * q) = oi; *(f32x4*)(dg + 4 * q) = og;
      }
    }
    __syncthreads();
  }
}

#define ATT_MISC 131072
DI void attn_item(const Params& p, int layer, int b, int hh, int jq, lchar* sm, float lam, float oml, int tid) {
  const int lane = tid & 63, w = tid >> 6, g = lane >> 4, l15 = lane & 15;
  const int idx32 = (lane ^ 32) << 2;
  LAS float* tab = (LAS float*)(sm + ATT_MISC);
  LAS float* sg = tab + 128;
  __syncthreads();
  if (tid < 128) {
    int bucket = tid;
    if (tid >= 16) {
      int lg = 16 + (int)(logf((float)tid * (1.0f / 16.0f)) / 2.0794415416798357f * 16.0f);
      bucket = lg < 31 ? lg : 31;
    }
    tab[tid] = P_REL_BIAS(p)[bucket * 4 + hh] * LOG2E;
    sg[tid] = P_SUBLN_G(p)[layer * 128 + tid] * oml;
  }
  const int q0w = 128 * jq + 16 * w;
  const int qpos = q0w + l15;
  const int qrow = b * LSEQ + (qpos < LSEQ ? qpos : LSEQ - 1);
  bf16x8 qf[2][2];
  {
    const u16* qp = W_PROJ(p) + (size_t)qrow * INC + hh * 128 + g * 8;
#pragma unroll
    for (int m = 0; m < 2; ++m)
#pragma unroll
      for (int ks = 0; ks < 2; ++ks) qf[m][ks] = *(const bf16x8*)(qp + m * 64 + ks * 32);
  }
  const int nkt = (2 * jq + 2) < 33 ? (2 * jq + 2) : 33;
  const char* ksrc[2]; const char* vsrc[2];
#pragma unroll
  for (int i = 0; i < 2; ++i) {
    const int bk = 2 * w + i, k16 = bk >> 2, m = (bk >> 1) & 1, ks = bk & 1;
    ksrc[i] = (const char*)(W_PROJ(p) + (size_t)(b * LSEQ + 16 * k16 + l15) * INC + 512 + hh * 128 + m * 64 + ks * 32 + g * 8);
    const int dv = 8 * bk + (lane >> 3), c = (lane & 7) ^ ((dv >> 1) & 7);
    vsrc[i] = (const char*)(W_VT(p) + ((size_t)((b * 4 + hh) * 128 + dv)) * LP + c * 8);
  }
  lchar* dmak = sm + (2 * w) * 1024 + lane * 16;
#define ATT_ISSUE(KT, SLOT) do { const size_t _ko = (size_t)(KT) * (64 * INC * 2), _vo = (size_t)(KT) * 128; lchar* _d = dmak + (SLOT) * 32768; \
    __builtin_amdgcn_global_load_lds((const unsigned*)(ksrc[0] + _ko), (LAS unsigned*)(_d), 16, 0, 0); \
    __builtin_amdgcn_global_load_lds((const unsigned*)(ksrc[1] + _ko), (LAS unsigned*)(_d + 1024), 16, 0, 0); \
    __builtin_amdgcn_global_load_lds((const unsigned*)(vsrc[0] + _vo), (LAS unsigned*)(_d + 16384), 16, 0, 0); \
    __builtin_amdgcn_global_load_lds((const unsigned*)(vsrc[1] + _vo), (LAS unsigned*)(_d + 16384 + 1024), 16, 0, 0); } while (0)
  int voff[2][2];
#pragma unroll
  for (int kk = 0; kk < 2; ++kk)
#pragma unroll
    for (int sc = 0; sc < 2; ++sc) voff[kk][sc] = l15 * 128 + (((4 * kk + 2 * sc + (g >> 1)) ^ ((l15 >> 1) & 7)) * 16) + 8 * (g & 1);

  f32x4 O[2][8];
#pragma unroll
  for (int m = 0; m < 2; ++m)
#pragma unroll
    for (int dt = 0; dt < 8; ++dt) O[m][dt] = (f32x4){0.f, 0.f, 0.f, 0.f};
  float mrun[2] = {-1.0e30f, -1.0e30f}, lsum[2] = {0.f, 0.f};

  WAIT_V(0);
  __syncthreads();
  const float tfar = tab[127];
  ATT_ISSUE(0, 0);
  ATT_ISSUE((1 < nkt ? 1 : nkt - 1), 1);
  for (int kt = 0; kt < nkt; ++kt) {
    { const int kn = (kt + 2 < nkt) ? kt + 2 : nkt - 1; ATT_ISSUE(kn, (kt + 2) & 3); }
    WAIT_V(8); BAR;
    if (64 * kt <= q0w + 15) {
      const lchar* kb = sm + (kt & 3) * 32768;
      const lchar* vb = kb + 16384;
      f32x4 S[2][4];
#pragma unroll
      for (int k16 = 0; k16 < 4; ++k16)
#pragma unroll
        for (int m = 0; m < 2; ++m) {
          f32x4 sacc = (f32x4){0.f, 0.f, 0.f, 0.f};
#pragma unroll
          for (int ks = 0; ks < 2; ++ks) {
            const bf16x8 a = *(const LAS bf16x8*)(kb + (((k16 * 2 + m) * 2 + ks) * 1024) + lane * 16);
            sacc = mfma16(a, qf[m][ks], sacc);
          }
          S[m][k16] = sacc;
        }
      const bool near = (q0w - 64 * kt) < 176;
#pragma unroll
      for (int m = 0; m < 2; ++m)
#pragma unroll
        for (int k16 = 0; k16 < 4; ++k16)
#pragma unroll
          for (int r = 0; r < 4; ++r) {
            float sv = S[m][k16][r] * (0.125f * LOG2E);
            if (near) {
              const int dist = qpos - (64 * kt + 16 * k16 + 4 * g + r);
              sv = dist < 0 ? -1.0e30f : sv + tab[dist < 127 ? dist : 127];
            } else {
              sv += tfar;
            }
            S[m][k16][r] = sv;
          }
      bf16x8 pb[2][2];
#pragma unroll
      for (int m = 0; m < 2; ++m) {
        float mx = -1.0e30f;
#pragma unroll
        for (int k16 = 0; k16 < 4; ++k16)
#pragma unroll
          for (int r = 0; r < 4; ++r) mx = fmaxf(mx, S[m][k16][r]);
        mx = fmaxf(mx, shx16(mx));
        mx = fmaxf(mx, shx32(mx, idx32));
        if (__builtin_amdgcn_ballot_w64(mx > mrun[m] + 8.0f) != 0ull) {
          const float mnew = fmaxf(mrun[m], mx);
          const float alpha = fast_exp2(mrun[m] - mnew);
          mrun[m] = mnew;
          lsum[m] *= alpha;
#pragma unroll
          for (int dt = 0; dt < 8; ++dt) { O[m][dt][0] *= alpha; O[m][dt][1] *= alpha; O[m][dt][2] *= alpha; O[m][dt][3] *= alpha; }
        }
        const float mref = mrun[m];
        float ps = 0.f;
#pragma unroll
        for (int k16 = 0; k16 < 4; ++k16)
#pragma unroll
          for (int r = 0; r < 4; ++r) { const float e = fast_exp2(S[m][k16][r] - mref); S[m][k16][r] = e; ps += e; }
        lsum[m] += ps;
#pragma unroll
        for (int kk = 0; kk < 2; ++kk) {
          u32x4 t;
          t[0] = pack2(S[m][2 * kk][0], S[m][2 * kk][1]); t[1] = pack2(S[m][2 * kk][2], S[m][2 * kk][3]);
          t[2] = pack2(S[m][2 * kk + 1][0], S[m][2 * kk + 1][1]); t[3] = pack2(S[m][2 * kk + 1][2], S[m][2 * kk + 1][3]);
          pb[m][kk] = __builtin_bit_cast(bf16x8, t);
        }
      }
#pragma unroll
      for (int kk = 0; kk < 2; ++kk)
#pragma unroll
        for (int dt = 0; dt < 8; ++dt) {
          const u32x2 lo = *(const LAS u32x2*)(vb + dt * 2048 + voff[kk][0]), hi = *(const LAS u32x2*)(vb + dt * 2048 + voff[kk][1]);
          u32x4 t; t[0] = lo[0]; t[1] = lo[1]; t[2] = hi[0]; t[3] = hi[1];
          const bf16x8 a = __builtin_bit_cast(bf16x8, t);
          O[0][dt] = mfma16(a, pb[0][kk], O[0][dt]);
          O[1][dt] = mfma16(a, pb[1][kk], O[1][dt]);
        }
    }
  }
  WAIT_V(0);
#undef ATT_ISSUE
  float l0 = lsum[0], l1 = lsum[1];
  l0 += shx16(l0); l0 += shx32(l0, idx32);
  l1 += shx16(l1); l1 += shx32(l1, idx32);
  const float c1 = 1.0f / l0, c2 = lam / l1;
  float ss = 0.f;
#pragma unroll
  for (int dt = 0; dt < 8; ++dt)
#pragma unroll
    for (int r = 0; r < 4; ++r) { const float o = O[0][dt][r] * c1 - O[1][dt][r] * c2; O[0][dt][r] = o; ss += o * o; }
  ss += shx16(ss); ss += shx32(ss, idx32);
  const float rinv = rsqrtf(ss * (1.0f / 128.0f) + 1e-5f);
  if (qpos < LSEQ) {
    u16* dst = W_MIX(p) + (size_t)(b * LSEQ + qpos) * DM + hh * 128 + 4 * g;
#pragma unroll
    for (int dt = 0; dt < 8; ++dt) {
      const int dv0 = 16 * dt + 4 * g;
      u32x2 o;
      o[0] = pack2(O[0][dt][0] * rinv * sg[dv0 + 0], O[0][dt][1] * rinv * sg[dv0 + 1]);
      o[1] = pack2(O[0][dt][2] * rinv * sg[dv0 + 2], O[0][dt][3] * rinv * sg[dv0 + 3]);
      *(u32x2*)(dst + 16 * dt) = o;
    }
  }
}

DI void conv_item(const Params& p, int layer, int item, int tid) {
  const int ch = (tid & 63) * 8;
  const float* cw = P_CONV_W(p) + (size_t)layer * 3 * 512;
  float w0[8], w1[8], w2[8];
#pragma unroll
  for (int e = 0; e < 8; ++e) { w0[e] = cw[ch + e]; w1[e] = cw[512 + ch + e]; w2[e] = cw[1024 + ch + e]; }
#pragma unroll
  for (int i = 0; i < 4; ++i) {
    const int t = item * 16 + (tid >> 6) + 4 * i;
    const int pos = t % LSEQ;
    const u16* row = W_PROJ(p) + (size_t)t * INC;
    float accv[8];
#pragma unroll
    for (int e = 0; e < 8; ++e) accv[e] = 0.f;
#pragma unroll
    for (int d = 0; d < 3; ++d) {
      if (pos - 2 + d >= 0) {
        const u16* r2 = row - (size_t)(2 - d) * INC;
        const u32x4 gc = *(const u32x4*)(r2 + 2048 + ch), zz = *(const u32x4*)(r2 + 2560 + ch);
#pragma unroll
        for (int e = 0; e < 4; ++e) {
          const float wlo = d == 0 ? w0[2 * e] : (d == 1 ? w1[2 * e] : w2[2 * e]);
          const float whi = d == 0 ? w0[2 * e + 1] : (d == 1 ? w1[2 * e + 1] : w2[2 * e + 1]);
          accv[2 * e] += wlo * (bflo(gc[e]) * bflo(zz[e]));
          accv[2 * e + 1] += whi * (bfhi(gc[e]) * bfhi(zz[e]));
        }
      }
    }
    const u32x4 gb = *(const u32x4*)(row + 1536 + ch);
    u32x4 o;
#pragma unroll
    for (int e = 0; e < 4; ++e) o[e] = pack2(bflo(gb[e]) * accv[2 * e], bfhi(gb[e]) * accv[2 * e + 1]);
    *(u32x4*)(W_MIX(p) + (size_t)t * DM + 512 + ch) = o;
  }
}

DI void phase_prologue(const Params& p, char* smem, int wave) {
  const int tid = otid_w(wave), lane = tid & 63, wid = tid >> 6, hb = tid >> 8, htid = tid & 255;
  const int nblk = gridDim.x, bid = blockIdx.x;
  const size_t gtid = (size_t)bid * NTHREADS + tid, gthreads = (size_t)nblk * NTHREADS;
  float* sm = (float*)(smem + hb * LDS_HALF);
  for (int it0 = bid; it0 < 2048; it0 += nblk) {
    const int it = it0 * 2 + hb;
    if (it < 3072) {
      const int l = it / 768, r = it % 768, kb = r / 48, nb = r % 48;
      transpose_tile(P_W_IN(p) + (size_t)l * 1024 * 3072, 3072, W_WIN(p) + (size_t)l * 3072 * 1024, 1024, kb * 64, nb * 64, sm, htid);
    } else {
      const int i2 = it - 3072, l = i2 / 256, r = i2 % 256, kb = r / 16, nb = r % 16;
      transpose_tile(P_W_OUT(p) + (size_t)l * 1024 * 1024, 1024, W_WOUT(p) + (size_t)l * 1024 * 1024, 1024, kb * 64, nb * 64, sm, htid);
    }
  }
  convert_straight(P_W_Q(p), W_WQB(p), (size_t)4 * 1024 * 2048 / 8, gtid, gthreads);
  convert_straight(P_SUB_KEYS(p), W_SKB(p), (size_t)4 * 16 * 128 * 128 / 8, gtid, gthreads);
  for (int t = bid * 8 + wid; t < TTOK; t += nblk * 8) {
    const int b = t / LSEQ, pos = t - b * LSEQ;
    const float* src = pos < NMETA ? P_META(p) + (size_t)pos * DM : P_X(p) + ((size_t)b * SEQ + pos - NMETA) * DM;
    float v[16];
    load_row_f32<0>(src, v, lane);
    ln_row<0>(v, P_LN_IN_G(p), P_LN_IN_B(p), lane);
    store_row_bf16<0>(W_H(p) + (size_t)t * DM, v, lane);
  }
}

DI void phase_fold(const Params& p, char* smem, int wave) {
  const int tid = otid_w(wave), hb = tid >> 8, htid = tid & 255;
  for (int it0 = blockIdx.x; it0 < 256; it0 += gridDim.x) {
    const int it = it0 * 2 + hb;
    const int l = it >> 7, hp = (it >> 3) & 15, mt = it & 7;
    gemm_tile_fold(W_WQB(p) + (size_t)l * 1024 * 2048 + hp * 128, 2048, W_SKB(p) + ((size_t)l * 16 + hp) * 128 * 128, 128, 128, mt * 128, smem + hb * 65536,
                   W_WSC(p) + (size_t)l * 2048 * 1024 + (size_t)hp * 128 * 1024, htid);
  }
}

DI bool tile_order(int i, int nM, int nN, int& pm, int& pn) {
  const int nwg = nM * nN;
  const long L = (long)i * gridDim.x + blockIdx.x;
  if (L >= nwg) return false;
  int wgid = (int)L;
  { const int q = nwg / 8, r = nwg % 8, xcd = wgid % 8, off = wgid / 8; wgid = (xcd < r ? xcd * (q + 1) : r * (q + 1) + (xcd - r) * q) + off; }
  const int nig = 8 * nN, gid = wgid / nig, fm = gid * 8, gsz = (nM - fm) < 8 ? (nM - fm) : 8;
  pm = fm + ((wgid % nig) % gsz); pn = (wgid % nig) / gsz;
  return true;
}

DI void phase_gemm(const Params& p, int layer, int which, char* smem, int wave) {
  const int tid0 = otid_w(wave);
  const u16* W = which == 0 ? W_WIN(p) + (size_t)layer * 3072 * 1024 : (which == 1 ? W_WOUT(p) + (size_t)layer * 1024 * 1024 : W_WSC(p) + (size_t)layer * 2048 * 1024);
  const u16* X = which == 1 ? W_MIX(p) : W_H(p);
  const int nN = which == 0 ? 12 : (which == 1 ? 4 : 8);
  int pm, pn;
  for (int i = 0; tile_order(i, 258, nN, pm, pn); ++i) {
    const bool vt = (which == 0) && (pn == 4 || pn == 5);
    const int mode = which == 0 ? (vt ? EPI_VT : EPI_PROJ) : (which == 1 ? EPI_OUT : EPI_TOPK);
    int tid = tid0;
    asm volatile("" : "+v"(tid));
    gemm256_tile(p, mode, layer, vt ? X : W, vt ? W : X, vt ? pm * 256 : pn * 256, vt ? pn * 256 : pm * 256, (lchar*)smem, tid);
  }
}

DI void phase_attn(const Params& p, int layer, char* smem, int wave) {
  const int tid = otid_w(wave), lane = tid & 63, hb = tid >> 8, htid = tid & 255;
  const float lam_init = 0.8f - 0.6f * expf(-0.3f * (float)layer);
  float d1 = P_LQ1(p)[layer * 64 + lane] * P_LK1(p)[layer * 64 + lane], d2 = P_LQ2(p)[layer * 64 + lane] * P_LK2(p)[layer * 64 + lane];
  d1 = wave_sum(d1); d2 = wave_sum(d2);
  const float lam = expf(d1) - expf(d2) + lam_init;
  for (int rd = 0; rd * (int)gridDim.x < 2176; ++rd) {
    const int o = rd * gridDim.x + ((rd & 1) ? (int)gridDim.x - 1 - (int)blockIdx.x : (int)blockIdx.x);
    if (o < 2176) { const int jq = 16 - (o >> 7), bh = o & 127; attn_item(p, layer, bh >> 2, bh & 3, jq, (lchar*)smem, lam, 1.0f - lam_init, tid); }
  }
  for (int it = blockIdx.x; it < 2064; it += gridDim.x) conv_item(p, layer, it * 2 + hb, htid);
}

DI void phase_ln(const Params& p, int layer, int which, int wave) {
  const int tid = otid_w(wave), lane = tid & 63, wid = tid >> 6;
  const int nblk = gridDim.x, bid = blockIdx.x;
  const float* lg = (which ? P_LN2_G(p) : P_LN1_G(p)) + layer * DM;
  const float* lb = (which ? P_LN2_B(p) : P_LN1_B(p)) + layer * DM;
  const bool final_out = which && (layer == DEPTH - 1);
  for (int t = bid * 8 + wid; t < TTOK; t += nblk * 8) {
    float v[16];
    load_row_f32<0>(W_Y(p) + (size_t)t * DM, v, lane);
    ln_row<0>(v, lg, lb, lane);
    if (final_out) {
      const int b = t / LSEQ, pos = t - b * LSEQ;
      if (pos >= NMETA) {
        float* dst = p.out + ((size_t)b * SEQ + pos - NMETA) * DM;
#pragma unroll
        for (int hh = 0; hh < 2; ++hh) {
          *(f32x4*)(dst + hh * 512 + 8 * lane) = (f32x4){v[hh * 8], v[hh * 8 + 1], v[hh * 8 + 2], v[hh * 8 + 3]};
          *(f32x4*)(dst + hh * 512 + 8 * lane + 4) = (f32x4){v[hh * 8 + 4], v[hh * 8 + 5], v[hh * 8 + 6], v[hh * 8 + 7]};
        }
      }
    } else {
      store_row_bf16<0>(W_H(p) + (size_t)t * DM, v, lane);
    }
  }
  if (which) return;
  for (int r = bid * 8 + wid; r < 2 * PEER_N; r += nblk * 8) {
    const bool isv = r >= PEER_N;
    const int e = isv ? r - PEER_N : r;
    const float* src = (isv ? P_PEER_V(p) : P_PEER_U(p)) + ((size_t)layer * PEER_N + e) * DM + 16 * lane;
    f32x4 a[4];
#pragma unroll
    for (int k = 0; k < 4; ++k) a[k] = *(const f32x4*)(src + 4 * k);
    float am = 0.f;
#pragma unroll
    for (int k = 0; k < 4; ++k) am = fmaxf(am, fmaxf(fmaxf(fabsf(a[k][0]), fabsf(a[k][1])), fmaxf(fabsf(a[k][2]), fabsf(a[k][3]))));
    am = wave_max_nonneg(am);
    const float sc = am > 0.f ? 224.0f / am : 1.0f;
    if (lane == 0) (isv ? W_SV(p) : W_SU(p))[e] = am > 0.f ? am * (1.0f / 224.0f) : 1.0f;
    u32x4 o;
#pragma unroll
    for (int k = 0; k < 4; ++k) {
      int w = 0;
      w = __builtin_amdgcn_cvt_pk_fp8_f32(a[k][0] * sc, a[k][1] * sc, w, false);
      w = __builtin_amdgcn_cvt_pk_fp8_f32(a[k][2] * sc, a[k][3] * sc, w, true);
      o[k] = (unsigned)w;
    }
    *(u32x4*)((isv ? W_VB(p) : W_UB(p)) + (size_t)(lane >> 3) * (PEER_N * 128) + (size_t)e * 128 + 16 * (lane & 7)) = o;
  }
}

#define DPP_F(v, ctrl) __int_as_float(__builtin_amdgcn_update_dpp(0, __float_as_int(v), (ctrl), 0xf, 0xf, true))
#define PEER_META(T, IA, IB, HA, HB) do { const int _t = (T) < TTOK ? (T) : wslot; \
    IA = W_IDX(p)[(size_t)_t * 128 + lane]; IB = W_IDX(p)[(size_t)_t * 128 + 64 + lane]; \
    const u16* _hp = W_H(p) + (size_t)_t * DM + x * 128 + 16 * c; HA = *(const u32x4*)(_hp); HB = *(const u32x4*)(_hp + 8); } while (0)
#define PEER_GATHER(TAB, IA, IB, RR) do { _Pragma("unroll") for (int g = 0; g < 16; ++g) { \
    const int _e = __builtin_amdgcn_ds_bpermute(bp0 + 32 * (g & 7), g < 8 ? IA : IB); RR[g] = *(const u32x4*)((TAB) + (size_t)_e * 128); } } while (0)
#define PEER_UNPACK(XS, HA, HB) do { _Pragma("unroll") for (int e = 0; e < 4; ++e) { \
    XS[e] = (f32x2){bflo(HA[e]), bfhi(HA[e])}; XS[4 + e] = (f32x2){bflo(HB[e]), bfhi(HB[e])}; } } while (0)

DI void phase_peer_dots(const Params& p, int layer, int wave) {
  const int tid = otid_w(wave), lane = tid & 63, wid = tid >> 6, c = lane & 7, r = lane >> 3;
  const int x = blockIdx.x & 7, wslot = (blockIdx.x >> 3) * 8 + wid, nslot = (gridDim.x >> 3) * 8;
  const unsigned char* ub = W_UB(p) + (size_t)x * (PEER_N * 128) + c * 16;
  float* pd = W_Y(p);
  const int bp0 = 4 * r;
  int iAa, iBa, iAb, iBb;
  u32x4 hAa, hBa, hAb, hBb, rrA[16], rrB[16];
  f32x2 xs[8];
#define DOTS_COMPUTE(T, RR) do { if ((T) < TTOK) { float pA = 0.f, pB = 0.f; \
    _Pragma("unroll") for (int g = 0; g < 16; ++g) { f32x2 d2 = (f32x2){0.f, 0.f}; \
      _Pragma("unroll") for (int k = 0; k < 4; ++k) { \
        const f32x2 lo = __builtin_amdgcn_cvt_pk_f32_fp8((int)RR[g][k], false), hi = __builtin_amdgcn_cvt_pk_f32_fp8((int)RR[g][k], true); \
        d2 += xs[2 * k] * lo; d2 += xs[2 * k + 1] * hi; } \
      float d = d2[0] + d2[1]; d += DPP_F(d, 0xB1); d += DPP_F(d, 0x4E); d += DPP_F(d, 0x141); \
      if (c == (g & 7)) { if (g < 8) pA = d; else pB = d; } } \
    float* _dst = pd + ((size_t)(T) * 8 + x) * 128 + 8 * c + r; _dst[0] = pA; _dst[64] = pB; } } while (0)
  int t = wslot;
  PEER_META(t, iAa, iBa, hAa, hBa);
  PEER_META(t + nslot, iAb, iBb, hAb, hBb);
  PEER_GATHER(ub, iAa, iBa, rrA);
  for (; t < TTOK; t += 2 * nslot) {
    PEER_UNPACK(xs, hAa, hBa);
    PEER_META(t + 2 * nslot, iAa, iBa, hAa, hBa);
    PEER_GATHER(ub, iAb, iBb, rrB);
    DOTS_COMPUTE(t, rrA);
    PEER_UNPACK(xs, hAb, hBb);
    PEER_META(t + 3 * nslot, iAb, iBb, hAb, hBb);
    PEER_GATHER(ub, iAa, iBa, rrA);
    DOTS_COMPUTE(t + nslot, rrB);
  }
#undef DOTS_COMPUTE
}

DI void phase_peer_w(const Params& p, int layer, int wave) {
  const int tid = otid_w(wave), lane = tid & 63, wid = tid >> 6;
  const float* pd = W_Y(p);
  for (int t = blockIdx.x * 8 + wid; t < TTOK; t += gridDim.x * 8) {
#pragma unroll
    for (int hf = 0; hf < 2; ++hf) {
      const int j = hf * 64 + lane;
      float sacc = 0.f;
#pragma unroll
      for (int xx = 0; xx < 8; ++xx) sacc += pd[((size_t)t * 8 + xx) * 128 + j];
      const int e = W_IDX(p)[(size_t)t * 128 + j];
      const float act = sacc * W_SU(p)[e];
      W_G(p)[(size_t)t * 128 + j] = W_G(p)[(size_t)t * 128 + j] * (0.5f * act * (1.0f + erff(act * 0.7071067811865476f))) * W_SV(p)[e];
    }
  }
}

#define PEER_META_V(T, IA, IB, WA, WB, HA, HB) do { const int _t = (T) < TTOK ? (T) : wslot; \
    IA = W_IDX(p)[(size_t)_t * 128 + lane]; IB = W_IDX(p)[(size_t)_t * 128 + 64 + lane]; \
    WA = W_G(p)[(size_t)_t * 128 + lane]; WB = W_G(p)[(size_t)_t * 128 + 64 + lane]; \
    const u16* _hp = W_H(p) + (size_t)_t * DM + x * 128 + 16 * c; HA = *(const u32x4*)(_hp); HB = *(const u32x4*)(_hp + 8); } while (0)
DI void phase_peer_v(const Params& p, int layer, int wave) {
  const int tid = otid_w(wave), lane = tid & 63, wid = tid >> 6, c = lane & 7, r = lane >> 3;
  const int x = blockIdx.x & 7, wslot = (blockIdx.x >> 3) * 8 + wid, nslot = (gridDim.x >> 3) * 8;
  const unsigned char* vb = W_VB(p) + (size_t)x * (PEER_N * 128) + c * 16;
  float* y2 = W_Y(p);
  const int bp0 = 4 * r, idx32 = (lane ^ 32) << 2;
  int iAa, iBa, iAb, iBb;
  float wAa, wBa, wAb, wBb, wA, wB;
  u32x4 hAa, hBa, hAb, hBb, rrA[16], rrB[16];
  f32x2 xs[8];
#define V_COMPUTE(T, RR) do { if ((T) < TTOK) { f32x2 acc[8]; \
    _Pragma("unroll") for (int i = 0; i < 8; ++i) acc[i] = (f32x2){0.f, 0.f}; \
    _Pragma("unroll") for (int g = 0; g < 16; ++g) { \
      const float wj = __int_as_float(__builtin_amdgcn_ds_bpermute(bp0 + 32 * (g & 7), __float_as_int(g < 8 ? wA : wB))); \
      const f32x2 wj2 = (f32x2){wj, wj}; \
      _Pragma("unroll") for (int k = 0; k < 4; ++k) { \
        const f32x2 lo = __builtin_amdgcn_cvt_pk_f32_fp8((int)RR[g][k], false), hi = __builtin_amdgcn_cvt_pk_f32_fp8((int)RR[g][k], true); \
        acc[2 * k] += wj2 * lo; acc[2 * k + 1] += wj2 * hi; } } \
    _Pragma("unroll") for (int i = 0; i < 8; ++i) { _Pragma("unroll") for (int q = 0; q < 2; ++q) { \
        float v = acc[i][q]; v += DPP_F(v, 0x128); v += shx16(v); v += shx32(v, idx32); acc[i][q] = v; } } \
    if (r == 0) { float* _dst = y2 + (size_t)(T) * DM + x * 128 + 16 * c; \
      _Pragma("unroll") for (int q = 0; q < 4; ++q) \
        *(f32x4*)(_dst + 4 * q) = (f32x4){ALPHA * xs[2 * q][0] + acc[2 * q][0], ALPHA * xs[2 * q][1] + acc[2 * q][1], \
                                         ALPHA * xs[2 * q + 1][0] + acc[2 * q + 1][0], ALPHA * xs[2 * q + 1][1] + acc[2 * q + 1][1]}; } } } while (0)
  int t = wslot;
  PEER_META_V(t, iAa, iBa, wAa, wBa, hAa, hBa);
  PEER_META_V(t + nslot, iAb, iBb, wAb, wBb, hAb, hBb);
  PEER_GATHER(vb, iAa, iBa, rrA);
  for (; t < TTOK; t += 2 * nslot) {
    PEER_UNPACK(xs, hAa, hBa); wA = wAa; wB = wBa;
    PEER_META_V(t + 2 * nslot, iAa, iBa, wAa, wBa, hAa, hBa);
    PEER_GATHER(vb, iAb, iBb, rrB);
    V_COMPUTE(t, rrA);
    PEER_UNPACK(xs, hAb, hBb); wA = wAb; wB = wBb;
    PEER_META_V(t + 3 * nslot, iAb, iBb, wAb, wBb, hAb, hBb);
    PEER_GATHER(vb, iAa, iBa, rrA);
    V_COMPUTE(t + nslot, rrB);
  }
#undef V_COMPUTE
}

#define XB_TMO      128
#define XB_XCNT(j)  (256  + 64 * (j))
#define XB_XSUB(j)  (1280 + 64 * (j))
#define XB_XGEN(j)  (2304 + 64 * (j))
#define XB_TOP      3328
#define XB_TOPGEN   3392
#define XCD_BAR_WORDS 3456
#define XB_SPIN_CAP (1u << 22)
DI unsigned xb_ld(unsigned* p)              { return __hip_atomic_load(p, __ATOMIC_RELAXED, __HIP_MEMORY_SCOPE_AGENT); }
DI unsigned xb_add(unsigned* p, unsigned v) { return __hip_atomic_fetch_add(p, v, __ATOMIC_RELAXED, __HIP_MEMORY_SCOPE_AGENT); }
DI unsigned xb_xcc_id() { return (unsigned)__builtin_amdgcn_s_getreg((3 << 11) | 20) & 0xFu; }
#define XB_SPIN(cond, bar) do { unsigned _sp = 0; while (cond) { __builtin_amdgcn_s_sleep(1); \
    if ((++_sp & 255u) == 0u) { if (xb_ld(&(bar)[XB_TMO])) break; if (_sp > XB_SPIN_CAP) { atomicAdd(&(bar)[XB_TMO], 1u); break; } } } } while (0)
DI bool is_thread0(int wave) { unsigned z = 0u; asm volatile("" : "+v"(z)); return wave == 0 && __builtin_amdgcn_mbcnt_hi(~0u, __builtin_amdgcn_mbcnt_lo(~0u, z)) == 0u; }
DI void xcd_barrier_complete(unsigned* bar, unsigned x, unsigned& nloc, unsigned& nx) {
  const unsigned G = gridDim.x;
  unsigned sum, cnt, mine, sp = 0u;
  for (;;) {
    sum = 0u; cnt = 0u; mine = 0u;
#pragma unroll
    for (unsigned j = 0; j < 16; ++j) { const unsigned c = xb_ld(&bar[XB_XCNT(j)]); sum += c; cnt += (c > 0u) ? 1u : 0u; mine = (j == x) ? c : mine; }
    if (sum == G) break;
    __builtin_amdgcn_s_sleep(1);
    if ((++sp & 255u) == 0u) { if (xb_ld(&bar[XB_TMO])) break; if (sp > XB_SPIN_CAP) { atomicAdd(&bar[XB_TMO], 1u); break; } }
  }
  nloc = mine > 0u ? mine : 1u; nx = cnt > 0u ? cnt : 1u;
}
DI void xcd_barrier(unsigned* bar, volatile LAS unsigned* st, int wave) {
  asm volatile("s_waitcnt vmcnt(0)" ::: "memory");
  __syncthreads();
  if (is_thread0(wave)) {
    const unsigned x = xb_xcc_id();
    __builtin_amdgcn_s_waitcnt(0);
    unsigned nloc = st[0], nx = st[1];
    if (nloc == 0u) { xcd_barrier_complete(bar, x, nloc, nx); st[0] = nloc; st[1] = nx; }
    const unsigned old = xb_add(&bar[XB_XSUB(x)], 1u);
    const unsigned gen = old / nloc;
    if (old + 1u == (gen + 1u) * nloc) {
      __builtin_amdgcn_fence(__ATOMIC_RELEASE, "agent");
      asm volatile("s_waitcnt vmcnt(0)" ::: "memory");
      const unsigned og = xb_add(&bar[XB_TOP], 1u);
      const unsigned tg = og / nx;
      if (og + 1u == (tg + 1u) * nx) xb_add(&bar[XB_TOPGEN], 1u);
      else XB_SPIN(xb_ld(&bar[XB_TOPGEN]) == tg, bar);
      __builtin_amdgcn_fence(__ATOMIC_ACQUIRE, "agent");
      xb_add(&bar[XB_XGEN(x)], 1u);
      asm volatile("s_waitcnt vmcnt(0)" ::: "memory");
    } else {
      XB_SPIN(xb_ld(&bar[XB_XGEN(x)]) == gen, bar);
      __builtin_amdgcn_fence(__ATOMIC_ACQUIRE, "agent");
      asm volatile("s_waitcnt vmcnt(0)" ::: "memory");
    }
  }
  __syncthreads();
}

__global__ void __launch_bounds__(NTHREADS, 2) mega(Params p) {
  extern __shared__ __attribute__((aligned(16))) char smem[];
  cg::grid_group grid = cg::this_grid();
  const int wave = __builtin_amdgcn_readfirstlane((int)(threadIdx.x >> 6));
  unsigned* bar = (unsigned*)(p.ws + WS_BAR);
  volatile LAS unsigned* st = (volatile LAS unsigned*)((lchar*)smem + LDS_XB);
  if (threadIdx.x == 0) { st[0] = 0u; st[1] = 0u; (void)xb_add(&bar[XB_XCNT(xb_xcc_id())], 1u); }
  __syncthreads();
  phase_prologue(p, smem, wave);
  grid.sync();
  phase_fold(p, smem, wave);
  xcd_barrier(bar, st, wave);
#pragma unroll 1
  for (int step = 0; step < DEPTH * 9; ++step) {
    const int layer = step / 9, ph = step - layer * 9;
    if (ph == 0 || ph == 2 || ph == 4) phase_gemm(p, layer, ph >> 1, smem, wave);
    else if (ph == 1) phase_attn(p, layer, smem, wave);
    else if (ph == 3 || ph == 8) phase_ln(p, layer, ph == 8, wave);
    else if (ph == 5) phase_peer_dots(p, layer, wave);
    else if (ph == 6) phase_peer_w(p, layer, wave);
    else phase_peer_v(p, layer, wave);
    if (step + 1 < DEPTH * 9) xcd_barrier(bar, st, wave);
  }
}

extern "C" void kernel_launch(void* const* d_in, const int* in_sizes, int n_in, void* d_out, int out_size, void* d_ws, size_t ws_size,
                              hipStream_t stream) {
  static int grid_blocks = 0;
  if (grid_blocks == 0) {
    if (ws_size < WS_END) { fprintf(stderr, "kernel_launch: workspace too small: need %zu, got %zu\n", (size_t)WS_END, ws_size); grid_blocks = -1; return; }
    int dev = 0, cus = 0, per_cu = 0;
    hipGetDevice(&dev);
    hipDeviceGetAttribute(&cus, hipDeviceAttributeMultiprocessorCount, dev);
    hipFuncSetAttribute((const void*)mega, hipFuncAttributeMaxDynamicSharedMemorySize, LDS_BYTES);
    hipOccupancyMaxActiveBlocksPerMultiprocessor(&per_cu, (const void*)mega, NTHREADS, LDS_BYTES);
    if (per_cu < 1) per_cu = 1;
    if (per_cu > 1) per_cu = 1;
    grid_blocks = cus * per_cu;
  }
  if (grid_blocks < 0) return;
  Params p{};
  for (int i = 0; i < 21; ++i) p.in[i] = (const float*)d_in[i];
  p.out = (float*)d_out;
  p.ws = (char*)d_ws;
  if (hipMemsetAsync((char*)d_ws + WS_BAR, 0, 16384, stream) != hipSuccess) { fprintf(stderr, "kernel_launch: memset of the barrier words failed\n"); return; }
  void* args[] = {&p};
  hipError_t e = hipLaunchCooperativeKernel((const void*)mega, dim3(grid_blocks), dim3(NTHREADS), args, LDS_BYTES, stream);
  if (e != hipSuccess) fprintf(stderr, "cooperative launch failed: %s (grid %d)\n", hipGetErrorString(e), grid_blocks);
}
```

```cpp
#include <hip/hip_runtime.h>
#include <hip/hip_cooperative_groups.h>
#include <cstdio>
#include <cstdint>
namespace cg = cooperative_groups;

typedef unsigned short u16;
typedef __attribute__((ext_vector_type(8))) short bf16x8;
typedef __attribute__((ext_vector_type(4))) float f32x4;
typedef __attribute__((ext_vector_type(4))) unsigned u32x4;
typedef __attribute__((ext_vector_type(2))) unsigned u32x2;
typedef __attribute__((ext_vector_type(2))) float f32x2;
#define DI __device__ __forceinline__
#define LAS __attribute__((address_space(3)))
typedef LAS char lchar;

#define DM 1024
#define NBATCH 32
#define SEQ 2048
#define NMETA 16
#define LSEQ 2064
#define TTOK 66048
#define DEPTH 4
#define INC 3072
#define LP 2112
#define PEER_N 16384
#define NTHREADS 512
#define LDS_MISC 69632
#define LDS_HALF 70656
#define LDS_XB 141312
#define LDS_BYTES 141328

#define ALPHA 1.681792830507429f
#define LOG2E 1.4426950408889634f

static constexpr size_t WS_WIN  = 0;
static constexpr size_t WS_WOUT = WS_WIN  + (size_t)4 * 3072 * 1024 * 2;
static constexpr size_t WS_WQB  = WS_WOUT + (size_t)4 * 1024 * 1024 * 2;
static constexpr size_t WS_SKB  = WS_WQB  + (size_t)4 * 1024 * 2048 * 2;
static constexpr size_t WS_WSC  = WS_SKB  + (size_t)4 * 16 * 128 * 128 * 2;
static constexpr size_t WS_UB   = WS_WSC  + (size_t)4 * 2048 * 1024 * 2;
static constexpr size_t WS_VB   = WS_UB   + (size_t)PEER_N * 1024;
static constexpr size_t WS_SU   = WS_VB   + (size_t)PEER_N * 1024;
static constexpr size_t WS_SV   = WS_SU   + (size_t)PEER_N * 4;
static constexpr size_t WS_H    = WS_SV   + (size_t)PEER_N * 4;
static constexpr size_t WS_MIX  = WS_H    + (size_t)TTOK * 1024 * 2;
static constexpr size_t WS_BIG  = WS_MIX  + (size_t)TTOK * 1024 * 2;
static constexpr size_t WS_VT   = WS_BIG  + (size_t)(TTOK + 64) * 3072 * 2;
static constexpr size_t WS_IDX  = WS_VT   + (size_t)NBATCH * 4 * 128 * LP * 2;
static constexpr size_t WS_G    = WS_IDX  + (size_t)TTOK * 128 * 4;
static constexpr size_t WS_BAR  = WS_G    + (size_t)TTOK * 128 * 4;
static constexpr size_t WS_END  = WS_BAR  + 16384;

struct Params {
  const float* in[21];
  float* out;
  char* ws;
};
#define P_X(p) ((p).in[0])
#define P_META(p) ((p).in[1])
#define P_LN_IN_G(p) ((p).in[2])
#define P_LN_IN_B(p) ((p).in[3])
#define P_REL_BIAS(p) ((p).in[4])
#define P_W_IN(p) ((p).in[5])
#define P_CONV_W(p) ((p).in[6])
#define P_LQ1(p) ((p).in[7])
#define P_LK1(p) ((p).in[8])
#define P_LQ2(p) ((p).in[9])
#define P_LK2(p) ((p).in[10])
#define P_SUBLN_G(p) ((p).in[11])
#define P_W_OUT(p) ((p).in[12])
#define P_LN1_G(p) ((p).in[13])
#define P_LN1_B(p) ((p).in[14])
#define P_W_Q(p) ((p).in[15])
#define P_SUB_KEYS(p) ((p).in[16])
#define P_PEER_U(p) ((p).in[17])
#define P_PEER_V(p) ((p).in[18])
#define P_LN2_G(p) ((p).in[19])
#define P_LN2_B(p) ((p).in[20])
#define W_WIN(p) ((u16*)((p).ws + WS_WIN))
#define W_WOUT(p) ((u16*)((p).ws + WS_WOUT))
#define W_WQB(p) ((u16*)((p).ws + WS_WQB))
#define W_SKB(p) ((u16*)((p).ws + WS_SKB))
#define W_WSC(p) ((u16*)((p).ws + WS_WSC))
#define W_UB(p) ((unsigned char*)((p).ws + WS_UB))
#define W_VB(p) ((unsigned char*)((p).ws + WS_VB))
#define W_SU(p) ((float*)((p).ws + WS_SU))
#define W_SV(p) ((float*)((p).ws + WS_SV))
#define W_H(p) ((u16*)((p).ws + WS_H))
#define W_MIX(p) ((u16*)((p).ws + WS_MIX))
#define W_PROJ(p) ((u16*)((p).ws + WS_BIG))
#define W_Y(p) ((u16*)((p).ws + WS_BIG))
#define W_VT(p) ((u16*)((p).ws + WS_VT))
#define W_IDX(p) ((int*)((p).ws + WS_IDX))
#define W_G(p) ((float*)((p).ws + WS_G))

DI u16 f2bf(float x) { unsigned u = __float_as_uint(x); u += 0x7fffu + ((u >> 16) & 1u); return (u16)(u >> 16); }
typedef __attribute__((ext_vector_type(2))) __bf16 bf16x2_t;
DI unsigned pack2(float a, float b) { const bf16x2_t v = {(__bf16)a, (__bf16)b}; return __builtin_bit_cast(unsigned, v); }
DI float bflo(unsigned w) { return __uint_as_float(w << 16); }
DI float bfhi(unsigned w) { return __uint_as_float(w & 0xffff0000u); }
DI int otid_w(int wave) { unsigned z = 0u; asm volatile("" : "+v"(z)); int t = wave * 64 + (int)__builtin_amdgcn_mbcnt_hi(~0u, __builtin_amdgcn_mbcnt_lo(~0u, z)); asm volatile("" : "+v"(t)); return t; }
#define DPP_ADD(v, ctrl) ((v) + __int_as_float(__builtin_amdgcn_update_dpp(0, __float_as_int(v), (ctrl), 0xf, 0xf, true)))
DI float wave_sum(float v) {
  v = DPP_ADD(v, 0xB1);
  v = DPP_ADD(v, 0x4E);
  v = DPP_ADD(v, 0x141);
  v = DPP_ADD(v, 0x140);
  const int iv = __float_as_int(v);
  return __int_as_float(__builtin_amdgcn_readlane(iv, 0)) + __int_as_float(__builtin_amdgcn_readlane(iv, 16)) +
         __int_as_float(__builtin_amdgcn_readlane(iv, 32)) + __int_as_float(__builtin_amdgcn_readlane(iv, 48));
}
#define DPP_MAX(v, ctrl) fmaxf((v), __int_as_float(__builtin_amdgcn_update_dpp(0, __float_as_int(v), (ctrl), 0xf, 0xf, true)))
DI float wave_max_nonneg(float v) {
  v = DPP_MAX(v, 0xB1); v = DPP_MAX(v, 0x4E); v = DPP_MAX(v, 0x141); v = DPP_MAX(v, 0x140);
  const int iv = __float_as_int(v);
  return fmaxf(fmaxf(__int_as_float(__builtin_amdgcn_readlane(iv, 0)), __int_as_float(__builtin_amdgcn_readlane(iv, 16))),
               fmaxf(__int_as_float(__builtin_amdgcn_readlane(iv, 32)), __int_as_float(__builtin_amdgcn_readlane(iv, 48))));
}
DI float shx16(float v) { return __int_as_float(__builtin_amdgcn_ds_swizzle(__float_as_int(v), 0x401F)); }
DI float shx32(float v, int idx32) { return __int_as_float(__builtin_amdgcn_ds_bpermute(idx32, __float_as_int(v))); }
DI f32x4 mfma16(bf16x8 a, bf16x8 b, f32x4 c) { return __builtin_amdgcn_mfma_f32_16x16x32_bf16(a, b, c, 0, 0, 0); }
DI float fast_exp2(float x) { return __builtin_amdgcn_exp2f(x); }

DI void convert_straight(const float* __restrict__ src, u16* __restrict__ dst, size_t n8, size_t gtid, size_t gthreads) {
  for (size_t i = gtid; i < n8; i += gthreads) {
    const f32x4 a = *(const f32x4*)(src + i * 8), b = *(const f32x4*)(src + i * 8 + 4);
    u32x4 o; o[0] = pack2(a[0], a[1]); o[1] = pack2(a[2], a[3]); o[2] = pack2(b[0], b[1]); o[3] = pack2(b[2], b[3]);
    *(u32x4*)(dst + i * 8) = o;
  }
}

DI void transpose_tile(const float* __restrict__ src, int ldn, u16* __restrict__ dst, int ldk, int k0, int n0, float* sm, int tid) {
#pragma unroll
  for (int i = 0; i < 4; ++i) {
    const int r = (tid >> 4) + 16 * i, c4 = tid & 15;
    const f32x4 v = *(const f32x4*)(src + (size_t)(k0 + r) * ldn + n0 + 4 * c4);
    sm[r * 65 + 4 * c4 + 0] = v[0]; sm[r * 65 + 4 * c4 + 1] = v[1]; sm[r * 65 + 4 * c4 + 2] = v[2]; sm[r * 65 + 4 * c4 + 3] = v[3];
  }
  __syncthreads();
#pragma unroll
  for (int i = 0; i < 2; ++i) {
    const int n = (tid >> 3) + 32 * i, kc = tid & 7;
    u32x4 o;
#pragma unroll
    for (int e = 0; e < 4; ++e) o[e] = pack2(sm[(8 * kc + 2 * e) * 65 + n], sm[(8 * kc + 2 * e + 1) * 65 + n]);
    *(u32x4*)(dst + (size_t)(n0 + n) * ldk + k0 + 8 * kc) = o;
  }
  __syncthreads();
}

template <int LAYOUT> DI int col0(int lane, int hh) { return LAYOUT ? 16 * lane + 8 * hh : hh * 512 + 8 * lane; }
template <int LAYOUT>
DI void ln_row(float (&v)[16], const float* __restrict__ g, const float* __restrict__ b, int lane) {
  float s = 0.f;
#pragma unroll
  for (int i = 0; i < 16; ++i) s += v[i];
  const float mu = wave_sum(s) * (1.0f / 1024.0f);
  float q = 0.f;
#pragma unroll
  for (int i = 0; i < 16; ++i) { const float d = v[i] - mu; q += d * d; }
  const float rstd = rsqrtf(wave_sum(q) * (1.0f / 1024.0f) + 1e-5f);
#pragma unroll
  for (int hh = 0; hh < 2; ++hh) {
    const int c = col0<LAYOUT>(lane, hh);
    const f32x4 g0 = *(const f32x4*)(g + c), g1 = *(const f32x4*)(g + c + 4), b0 = *(const f32x4*)(b + c), b1 = *(const f32x4*)(b + c + 4);
#pragma unroll
    for (int e = 0; e < 4; ++e) {
      v[hh * 8 + e] = (v[hh * 8 + e] - mu) * rstd * g0[e] + b0[e];
      v[hh * 8 + 4 + e] = (v[hh * 8 + 4 + e] - mu) * rstd * g1[e] + b1[e];
    }
  }
}
template <int LAYOUT>
DI void store_row_bf16(u16* __restrict__ dst, const float (&v)[16], int lane) {
#pragma unroll
  for (int hh = 0; hh < 2; ++hh) {
    u32x4 o;
#pragma unroll
    for (int e = 0; e < 4; ++e) o[e] = pack2(v[hh * 8 + 2 * e], v[hh * 8 + 2 * e + 1]);
    *(u32x4*)(dst + col0<LAYOUT>(lane, hh)) = o;
  }
}
template <int LAYOUT>
DI void load_row_bf16(const u16* __restrict__ src, float (&v)[16], int lane) {
#pragma unroll
  for (int hh = 0; hh < 2; ++hh) {
    const u32x4 a = *(const u32x4*)(src + col0<LAYOUT>(lane, hh));
#pragma unroll
    for (int e = 0; e < 4; ++e) { v[hh * 8 + 2 * e] = bflo(a[e]); v[hh * 8 + 2 * e + 1] = bfhi(a[e]); }
  }
}
template <int LAYOUT>
DI void load_row_f32(const float* __restrict__ src, float (&v)[16], int lane) {
#pragma unroll
  for (int hh = 0; hh < 2; ++hh) {
    const int c = col0<LAYOUT>(lane, hh);
    const f32x4 a = *(const f32x4*)(src + c), b = *(const f32x4*)(src + c + 4);
#pragma unroll
    for (int e = 0; e < 4; ++e) { v[hh * 8 + e] = a[e]; v[hh * 8 + 4 + e] = b[e]; }
  }
}

enum { EPI_PROJ = 0, EPI_VT = 1, EPI_OUT = 2, EPI_TOPK = 3, EPI_FOLD = 4 };

template <bool SWAP>
DI void gemm_mainloop(const u16* __restrict__ A, int lda, const u16* __restrict__ Bt, int ldb, int K, int m0, int n0, char* smem,
                      f32x4 (&acc)[4][4], int tid) {
  const int lane = tid & 63, wid = tid >> 6, wm = wid >> 1, wn = wid & 1;
  const int srow = tid >> 3, skc = tid & 7;
  const u16* ap = A + (size_t)(m0 + srow) * lda + skc * 8;
  const u16* bp = Bt + (size_t)(n0 + srow) * ldb + skc * 8;
  const int dst0 = (((srow >> 4) * 2 + (skc >> 2)) * 1024) + (((skc & 3) * 16 + (srow & 15)) * 16);
#pragma unroll
  for (int i = 0; i < 4; ++i)
#pragma unroll
    for (int j = 0; j < 4; ++j) acc[i][j] = (f32x4){0.f, 0.f, 0.f, 0.f};
  u32x4 ra[4], rb[4];
#pragma unroll
  for (int j = 0; j < 4; ++j) { ra[j] = *(const u32x4*)(ap + (size_t)j * 32 * lda); rb[j] = *(const u32x4*)(bp + (size_t)j * 32 * ldb); }
#pragma unroll
  for (int j = 0; j < 4; ++j) { *(u32x4*)(smem + dst0 + j * 4096) = ra[j]; *(u32x4*)(smem + 16384 + dst0 + j * 4096) = rb[j]; }
  __syncthreads();
  const int KT = K >> 6;
  for (int kt = 0; kt < KT; ++kt) {
    char* cur = smem + (kt & 1) * 32768;
    char* nxt = smem + ((kt + 1) & 1) * 32768;
    const bool more = (kt + 1 < KT);
    if (more) {
      const u16* ap2 = ap + (kt + 1) * 64;
      const u16* bp2 = bp + (kt + 1) * 64;
#pragma unroll
      for (int j = 0; j < 4; ++j) { ra[j] = *(const u32x4*)(ap2 + (size_t)j * 32 * lda); rb[j] = *(const u32x4*)(bp2 + (size_t)j * 32 * ldb); }
    }
#pragma unroll
    for (int ks = 0; ks < 2; ++ks) {
      bf16x8 af[4], bfr[4];
#pragma unroll
      for (int i = 0; i < 4; ++i) af[i] = *(const bf16x8*)(cur + (((wm * 4 + i) * 2 + ks) * 1024) + lane * 16);
#pragma unroll
      for (int j = 0; j < 4; ++j) bfr[j] = *(const bf16x8*)(cur + 16384 + (((wn * 4 + j) * 2 + ks) * 1024) + lane * 16);
#pragma unroll
      for (int i = 0; i < 4; ++i)
#pragma unroll
        for (int j = 0; j < 4; ++j) acc[i][j] = SWAP ? mfma16(bfr[j], af[i], acc[i][j]) : mfma16(af[i], bfr[j], acc[i][j]);
    }
    if (more) {
#pragma unroll
      for (int j = 0; j < 4; ++j) { *(u32x4*)(nxt + dst0 + j * 4096) = ra[j]; *(u32x4*)(nxt + 16384 + dst0 + j * 4096) = rb[j]; }
    }
    __syncthreads();
  }
}

DI void insert16(float (&v)[16], float x) {
#pragma unroll
  for (int j = 0; j < 16; ++j) { const float hi = fmaxf(v[j], x); x = fminf(v[j], x); v[j] = hi; }
}

DI void gemm_tile_fold(const u16* A, int lda, const u16* Bt, int ldb, int K, int m0, char* smem, u16* dstT, int tid) {
  const int lane = tid & 63, wid = tid >> 6, wm = wid >> 1, wn = wid & 1, g = lane >> 4, l15 = lane & 15;
  f32x4 acc[4][4];
  gemm_mainloop<false>(A, lda, Bt, ldb, K, m0, 0, smem, acc, tid);
#pragma unroll
  for (int i = 0; i < 4; ++i)
#pragma unroll
    for (int j = 0; j < 4; ++j) {
      const int m = m0 + wm * 64 + 16 * i + 4 * g, n = wn * 64 + 16 * j + l15;
      u32x2 o; o[0] = pack2(acc[i][j][0], acc[i][j][1]); o[1] = pack2(acc[i][j][2], acc[i][j][3]);
      *(u32x2*)(dstT + (size_t)n * 1024 + m) = o;
    }
}

#define GK 1024
#define HTB 16384
DI int lds_byte(int r, int c) {
  const int st = (r >> 4) * 2 + (c >> 5), rr = r & 15, cc = c & 31, ob = rr * 64 + cc * 2;
  return st * 1024 + (ob ^ (((ob >> 9) & 1) << 5));
}
DI void stage_rc(int b, int& R, int& C) {
  const int st = b / 1024, sb = b % 1024, swz = sb ^ (((sb >> 9) & 1) << 5);
  R = (st >> 1) * 16 + swz / 64; C = (st & 1) * 32 + (swz % 64) / 2;
}
#define G_SA(b, h) (shm + ((b) * 2 + (h)) * HTB)
#define G_SB(b, h) (shm + (4 + (b) * 2 + (h)) * HTB)
#define G_STAGE(P, BASE, br, kt) do { const char* _g = (const char*)((BASE) + (size_t)(br) * GK + (kt) * 64); \
    __builtin_amdgcn_global_load_lds((const unsigned*)(_g + goff0), (LAS unsigned*)((P) + tid * 16), 16, 0, 0); \
    __builtin_amdgcn_global_load_lds((const unsigned*)(_g + goff1), (LAS unsigned*)((P) + tid * 16 + 8192), 16, 0, 0); } while (0)
#define G_LDA(dst, b, h) _Pragma("unroll") for (int m = 0; m < 4; ++m) _Pragma("unroll") for (int k = 0; k < 2; ++k) \
    dst[m][k] = *(const LAS bf16x8*)(G_SA(b, h) + lds_byte(wr * 64 + m * 16 + fr, k * 32 + fq * 8))
#define G_LDB(dst, b, h) _Pragma("unroll") for (int n = 0; n < 2; ++n) _Pragma("unroll") for (int k = 0; k < 2; ++k) \
    dst[n][k] = *(const LAS bf16x8*)(G_SB(b, h) + lds_byte(wc * 32 + n * 16 + fr, k * 32 + fq * 8))
#define G_MMA(ai, bj, At, Bx) do { __builtin_amdgcn_s_setprio(1); \
    _Pragma("unroll") for (int m = 0; m < 4; ++m) _Pragma("unroll") for (int n = 0; n < 2; ++n) _Pragma("unroll") for (int k = 0; k < 2; ++k) \
      acc[ai][bj][m][n] = __builtin_amdgcn_mfma_f32_16x16x32_bf16(At[m][k], Bx[n][k], acc[ai][bj][m][n], 0, 0, 0); \
    __builtin_amdgcn_s_setprio(0); } while (0)
#define WAIT_V(n) asm volatile("s_waitcnt vmcnt(" #n ")" ::: "memory")
#define WAIT_L(n) asm volatile("s_waitcnt lgkmcnt(" #n ")" ::: "memory")
#define BAR __builtin_amdgcn_s_barrier()
#define SCHED __builtin_amdgcn_sched_barrier(0)

DI void gemm256_core(const u16* __restrict__ A, const u16* __restrict__ Bt, int brow, int bcol, lchar* shm, int tid, f32x4 (&acc)[2][2][4][2]) {
  const int wid = tid >> 6, lane = tid & 63, wr = wid >> 2, wc = wid & 3, fr = lane & 15, fq = lane >> 4;
  int r0, c0, r1, c1;
  stage_rc(tid * 16, r0, c0); stage_rc(tid * 16 + 8192, r1, c1);
  const unsigned goff0 = (unsigned)(r0 * GK + c0) * 2u, goff1 = (unsigned)(r1 * GK + c1) * 2u;
#pragma unroll
  for (int ai = 0; ai < 2; ++ai)
#pragma unroll
    for (int bj = 0; bj < 2; ++bj)
#pragma unroll
      for (int m = 0; m < 4; ++m)
#pragma unroll
        for (int n = 0; n < 2; ++n) acc[ai][bj][m][n] = (f32x4){0.f, 0.f, 0.f, 0.f};
  bf16x8 At[4][2], B0[2][2], B1[2][2];
  const int nt = GK / 64;
  WAIT_V(0);
  __syncthreads();
  G_STAGE(G_SB(0, 0), Bt, bcol, 0); G_STAGE(G_SA(0, 0), A, brow, 0);
  G_STAGE(G_SB(0, 1), Bt, bcol + 128, 0); G_STAGE(G_SA(0, 1), A, brow + 128, 0);
  if (wr == 1) BAR;
  WAIT_V(4); BAR;
  G_STAGE(G_SB(1, 0), Bt, bcol, 1); G_STAGE(G_SA(1, 0), A, brow, 1); G_STAGE(G_SB(1, 1), Bt, bcol + 128, 1);
  WAIT_V(6); BAR;
  for (int t = 0; t < nt - 2; t += 2) {
    G_LDB(B0, 0, 0); SCHED; G_LDA(At, 0, 0); G_STAGE(G_SA(1, 1), A, brow + 128, t + 1);
    WAIT_L(8); BAR; WAIT_L(0); G_MMA(0, 0, At, B0); BAR; SCHED;
    G_LDB(B1, 0, 1); G_STAGE(G_SB(0, 0), Bt, bcol, t + 2);
    BAR; WAIT_L(0); G_MMA(0, 1, At, B1); BAR;
    G_LDA(At, 0, 1); G_STAGE(G_SA(0, 0), A, brow, t + 2);
    BAR; WAIT_L(0); G_MMA(1, 0, At, B0); BAR; SCHED;
    G_STAGE(G_SB(0, 1), Bt, bcol + 128, t + 2);
    WAIT_V(6); BAR; G_MMA(1, 1, At, B1); BAR;
    G_LDB(B0, 1, 0); SCHED; G_LDA(At, 1, 0); G_STAGE(G_SA(0, 1), A, brow + 128, t + 2);
    WAIT_L(8); BAR; WAIT_L(0); G_MMA(0, 0, At, B0); BAR; SCHED;
    G_LDB(B1, 1, 1); G_STAGE(G_SB(1, 0), Bt, bcol, t + 3);
    BAR; WAIT_L(0); G_MMA(0, 1, At, B1); BAR;
    G_LDA(At, 1, 1); G_STAGE(G_SA(1, 0), A, brow, t + 3);
    BAR; WAIT_L(0); G_MMA(1, 0, At, B0); BAR; SCHED;
    G_STAGE(G_SB(1, 1), Bt, bcol + 128, t + 3);
    WAIT_V(6); BAR; G_MMA(1, 1, At, B1); BAR;
  }
  { G_LDB(B0, 0, 0); G_LDA(At, 0, 0); G_STAGE(G_SA(1, 1), A, brow + 128, nt - 1);
    BAR; WAIT_L(0); G_MMA(0, 0, At, B0); BAR;
    G_LDB(B1, 0, 1); BAR; WAIT_L(0); G_MMA(0, 1, At, B1); BAR;
    G_LDA(At, 0, 1); WAIT_V(4); BAR; WAIT_L(0); G_MMA(1, 0, At, B0); G_MMA(1, 1, At, B1); BAR; }
  { G_LDB(B0, 1, 0); G_LDA(At, 1, 0); WAIT_V(2); BAR; WAIT_L(0); G_MMA(0, 0, At, B0); BAR;
    G_LDB(B1, 1, 1); WAIT_V(0); BAR; WAIT_L(0); G_MMA(0, 1, At, B1); BAR;
    G_LDA(At, 1, 1); BAR; WAIT_L(0); G_MMA(1, 0, At, B0); G_MMA(1, 1, At, B1); BAR; }
  if (wr == 0) BAR;
}

DI void gemm256_tile(const Params& p, int mode, int layer, const u16* R, const u16* Cc, int brow, int bcol, lchar* shm, int tid_in) {
  f32x4 acc[2][2][4][2];
  gemm256_core(R, Cc, brow, bcol, shm, tid_in, acc);
  int tid = tid_in;
  asm volatile("" : "+v"(tid));
  const int wid = tid >> 6, lane = tid & 63, wr = wid >> 2, wc = wid & 3, fr = lane & 15, fq = lane >> 4;
  if (mode == EPI_PROJ) {
#pragma unroll
    for (int ai = 0; ai < 2; ++ai)
#pragma unroll
      for (int bj = 0; bj < 2; ++bj)
#pragma unroll
        for (int m = 0; m < 4; ++m)
#pragma unroll
          for (int n = 0; n < 2; ++n) {
            const int nc = brow + ai * 128 + wr * 64 + m * 16 + fq * 4, tok = bcol + bj * 128 + wc * 32 + n * 16 + fr;
            const f32x4 v = acc[ai][bj][m][n];
            u32x2 o; o[0] = pack2(v[0], v[1]); o[1] = pack2(v[2], v[3]);
            *(u32x2*)(W_PROJ(p) + (size_t)tok * INC + nc) = o;
          }
  } else if (mode == EPI_VT) {
#pragma unroll
    for (int ai = 0; ai < 2; ++ai)
#pragma unroll
      for (int bj = 0; bj < 2; ++bj)
#pragma unroll
        for (int m = 0; m < 4; ++m)
#pragma unroll
          for (int n = 0; n < 2; ++n) {
            const int tok = brow + ai * 128 + wr * 64 + m * 16 + fq * 4, nn = bcol + bj * 128 + wc * 32 + n * 16 + fr - 1024;
            const int b = tok / LSEQ, pos = tok - b * LSEQ;
            const f32x4 v = acc[ai][bj][m][n];
            u32x2 o; o[0] = pack2(v[0], v[1]); o[1] = pack2(v[2], v[3]);
            *(u32x2*)(W_VT(p) + ((size_t)(b * 512 + nn)) * LP + pos) = o;
          }
  } else if (mode == EPI_OUT) {
#pragma unroll
    for (int ai = 0; ai < 2; ++ai)
#pragma unroll
      for (int bj = 0; bj < 2; ++bj) {
        u32x2 hv[4][2];
#pragma unroll
        for (int m = 0; m < 4; ++m)
#pragma unroll
          for (int n = 0; n < 2; ++n) {
            const int nc = brow + ai * 128 + wr * 64 + m * 16 + fq * 4, tok = bcol + bj * 128 + wc * 32 + n * 16 + fr;
            hv[m][n] = *(const u32x2*)(W_H(p) + (size_t)tok * DM + nc);
          }
#pragma unroll
        for (int m = 0; m < 4; ++m)
#pragma unroll
          for (int n = 0; n < 2; ++n) {
            const int nc = brow + ai * 128 + wr * 64 + m * 16 + fq * 4, tok = bcol + bj * 128 + wc * 32 + n * 16 + fr;
            const f32x4 v = acc[ai][bj][m][n];
            u32x2 o;
            o[0] = pack2(ALPHA * bflo(hv[m][n][0]) + v[0], ALPHA * bfhi(hv[m][n][0]) + v[1]);
            o[1] = pack2(ALPHA * bflo(hv[m][n][1]) + v[2], ALPHA * bfhi(hv[m][n][1]) + v[3]);
            *(u32x2*)(W_Y(p) + (size_t)tok * DM + nc) = o;
          }
      }
  } else {
    LAS float* S = (LAS float*)shm;
    const int tok = tid & 255, kh = tid >> 8;
    float L0[16], L1[16];
#pragma unroll
    for (int ai = 0; ai < 2; ++ai) {
      __syncthreads();
#pragma unroll
      for (int bj = 0; bj < 2; ++bj)
#pragma unroll
        for (int m = 0; m < 4; ++m)
#pragma unroll
          for (int n = 0; n < 2; ++n) {
            const int tk = bj * 128 + wc * 32 + n * 16 + fr, key = wr * 64 + m * 16 + fq * 4;
#pragma unroll
            for (int j = 0; j < 4; ++j) S[tk * 128 + ((key + j + tk) & 127)] = acc[ai][bj][m][n][j];
          }
      __syncthreads();
      float v[16];
#pragma unroll
      for (int j = 0; j < 16; ++j) v[j] = -3.0e38f;
      for (int i = 0; i < 64; ++i) {
        const int key = kh * 64 + i;
        const float x = S[tok * 128 + ((key + tok) & 127)];
        insert16(v, __uint_as_float((__float_as_uint(x) & ~127u) | (unsigned)key));
      }
      __syncthreads();
      if (kh == 1) {
#pragma unroll
        for (int j = 0; j < 16; ++j) S[tok * 16 + j] = v[j];
      }
      __syncthreads();
      if (kh == 0) {
#pragma unroll
        for (int j = 0; j < 16; ++j) insert16(v, S[tok * 16 + j]);
      }
#pragma unroll
      for (int j = 0; j < 16; ++j) { if (ai == 0) L0[j] = v[j]; else L1[j] = v[j]; }
    }
    __syncthreads();
    LAS unsigned* LL = (LAS unsigned*)shm;
    if (kh == 0) {
#pragma unroll
      for (int j = 0; j < 16; ++j) { LL[tok * 32 + ((j + tok) & 31)] = __float_as_uint(L0[j]); LL[tok * 32 + ((16 + j + tok) & 31)] = __float_as_uint(L1[j]); }
      float s1[16], s2[16], v[16];
#pragma unroll
      for (int j = 0; j < 16; ++j) { s1[j] = __uint_as_float(__float_as_uint(L0[j]) & ~127u); s2[j] = __uint_as_float(__float_as_uint(L1[j]) & ~127u); v[j] = -3.0e38f; }
#pragma unroll
      for (int a = 0; a < 16; ++a)
#pragma unroll
        for (int bb = 0; bb < 16 / (a + 1); ++bb) {
          const float sm = s1[a] + s2[bb];
          insert16(v, __uint_as_float((__float_as_uint(sm) & ~255u) | (unsigned)(a * 16 + bb)));
        }
      float e[16], sum = 0.f;
      const float mx = __uint_as_float(__float_as_uint(v[0]) & ~255u);
#pragma unroll
      for (int j = 0; j < 16; ++j) { e[j] = fast_exp2((__uint_as_float(__float_as_uint(v[j]) & ~255u) - mx) * LOG2E); sum += e[j]; }
      const float inv = 1.0f / sum;
      const int hd = brow >> 8;
      int* di = W_IDX(p) + (size_t)(bcol + tok) * 128 + hd * 16;
      float* dg = W_G(p) + (size_t)(bcol + tok) * 128 + hd * 16;
#pragma unroll
      for (int q = 0; q < 4; ++q) {
        u32x4 oi; f32x4 og;
#pragma unroll
        for (int k = 0; k < 4; ++k) {
          const unsigned code = __float_as_uint(v[4 * q + k]) & 255u;
          const unsigned i1 = LL[tok * 32 + (((code >> 4) + tok) & 31)] & 127u, i2 = LL[tok * 32 + ((16 + (code & 15u) + tok) & 31)] & 127u;
          oi[k] = i1 * 128u + i2; og[k] = e[4 * q + k] * inv;
        }
        *(u32x4*)(di + 4 * q) = oi; *(f32x4*)(dg + 4 * q) = og;
      }
    }
    __syncthreads();
  }
}

#define ATT_MISC 131072
DI void attn_item(const Params& p, int layer, int b, int hh, int jq, lchar* sm, float lam, float oml, int tid) {
  const int lane = tid & 63, w = tid >> 6, g = lane >> 4, l15 = lane & 15;
  const int idx32 = (lane ^ 32) << 2;
  LAS float* tab = (LAS float*)(sm + ATT_MISC);
  LAS float* sg = tab + 208;
  __syncthreads();
  if (tid < 208) {
    const int d = tid - 80;
    float tv = -1.0e30f;
    if (d >= 0) {
      int bucket = d;
      if (d >= 16) {
        int lg = 16 + (int)(logf((float)d * (1.0f / 16.0f)) / 2.0794415416798357f * 16.0f);
        bucket = lg < 31 ? lg : 31;
      }
      tv = P_REL_BIAS(p)[bucket * 4 + hh] * LOG2E;
    }
    tab[tid] = tv;
    if (tid < 128) sg[tid] = P_SUBLN_G(p)[layer * 128 + tid] * oml;
  }
  const int q0w = 128 * jq + 16 * w;
  const int qpos = q0w + l15;
  const int qrow = b * LSEQ + (qpos < LSEQ ? qpos : LSEQ - 1);
  bf16x8 qf[2][2];
  {
    const u16* qp = W_PROJ(p) + (size_t)qrow * INC + hh * 128 + g * 8;
#pragma unroll
    for (int m = 0; m < 2; ++m)
#pragma unroll
      for (int ks = 0; ks < 2; ++ks) qf[m][ks] = *(const bf16x8*)(qp + m * 64 + ks * 32);
  }
  const int nkt = (2 * jq + 2) < 33 ? (2 * jq + 2) : 33;
  const char* ksrc[2]; const char* vsrc[2];
#pragma unroll
  for (int i = 0; i < 2; ++i) {
    const int bk = 2 * w + i, k16 = bk >> 2, m = (bk >> 1) & 1, ks = bk & 1;
    const int krow = 32 * (k16 >> 1) + 8 * (l15 >> 2) + 4 * (k16 & 1) + (l15 & 3);
    ksrc[i] = (const char*)(W_PROJ(p) + (size_t)(b * LSEQ + krow) * INC + 512 + hh * 128 + m * 64 + ks * 32 + g * 8);
    const int dv = 8 * bk + (lane >> 3), c = (lane & 7) ^ ((dv >> 1) & 7);
    vsrc[i] = (const char*)(W_VT(p) + ((size_t)((b * 4 + hh) * 128 + dv)) * LP + c * 8);
  }
  lchar* dmak = sm + (2 * w) * 1024 + lane * 16;
#define ATT_ISSUE(KT, SLOT) do { const size_t _ko = (size_t)(KT) * (64 * INC * 2), _vo = (size_t)(KT) * 128; lchar* _d = dmak + (SLOT) * 32768; \
    __builtin_amdgcn_global_load_lds((const unsigned*)(ksrc[0] + _ko), (LAS unsigned*)(_d), 16, 0, 0); \
    __builtin_amdgcn_global_load_lds((const unsigned*)(ksrc[1] + _ko), (LAS unsigned*)(_d + 1024), 16, 0, 0); \
    __builtin_amdgcn_global_load_lds((const unsigned*)(vsrc[0] + _vo), (LAS unsigned*)(_d + 16384), 16, 0, 0); \
    __builtin_amdgcn_global_load_lds((const unsigned*)(vsrc[1] + _vo), (LAS unsigned*)(_d + 16384 + 1024), 16, 0, 0); } while (0)
  int voff[2];
#pragma unroll
  for (int kk = 0; kk < 2; ++kk) voff[kk] = l15 * 128 + (((4 * kk + g) ^ ((l15 >> 1) & 7)) * 16);

  f32x4 O[2][8];
#pragma unroll
  for (int m = 0; m < 2; ++m)
#pragma unroll
    for (int dt = 0; dt < 8; ++dt) O[m][dt] = (f32x4){0.f, 0.f, 0.f, 0.f};
  float mrun[2] = {-1.0e30f, -1.0e30f}, lsum[2] = {0.f, 0.f};

  WAIT_V(0);
  __syncthreads();
  const float tfar = tab[207];
  ATT_ISSUE(0, 0);
  ATT_ISSUE((1 < nkt ? 1 : nkt - 1), 1);
  for (int kt = 0; kt < nkt; ++kt) {
    { const int kn = (kt + 2 < nkt) ? kt + 2 : nkt - 1; ATT_ISSUE(kn, (kt + 2) & 3); }
    WAIT_V(8); BAR;
    if (64 * kt <= q0w + 15) {
      const lchar* kb = sm + (kt & 3) * 32768;
      const lchar* vb = kb + 16384;
      f32x4 S[2][4];
#pragma unroll
      for (int kh = 0; kh < 2; ++kh) {
        bf16x8 kf[2][2][2];
#pragma unroll
        for (int q = 0; q < 2; ++q)
#pragma unroll
          for (int m = 0; m < 2; ++m)
#pragma unroll
            for (int ks = 0; ks < 2; ++ks) kf[q][m][ks] = *(const LAS bf16x8*)(kb + ((((2 * kh + q) * 2 + m) * 2 + ks) * 1024) + lane * 16);
        SCHED;
#pragma unroll
        for (int q = 0; q < 2; ++q)
#pragma unroll
          for (int m = 0; m < 2; ++m) {
            f32x4 sacc = (f32x4){0.f, 0.f, 0.f, 0.f};
            sacc = mfma16(kf[q][m][0], qf[m][0], sacc);
            sacc = mfma16(kf[q][m][1], qf[m][1], sacc);
            S[m][2 * kh + q] = sacc;
          }
      }
      const bool near = (q0w - 64 * kt) < 176;
#pragma unroll
      for (int m = 0; m < 2; ++m)
#pragma unroll
        for (int k16 = 0; k16 < 4; ++k16)
#pragma unroll
          for (int r = 0; r < 4; ++r) {
            float sv = S[m][k16][r] * (0.125f * LOG2E);
            if (near) {
              const int di = qpos + 80 - (64 * kt + 32 * (k16 >> 1) + 8 * g + 4 * (k16 & 1) + r);
              sv += tab[di < 207 ? di : 207];
            } else {
              sv += tfar;
            }
            S[m][k16][r] = sv;
          }
      bf16x8 pb[2][2];
#pragma unroll
      for (int m = 0; m < 2; ++m) {
        float mx = -1.0e30f;
#pragma unroll
        for (int k16 = 0; k16 < 4; ++k16)
#pragma unroll
          for (int r = 0; r < 4; ++r) mx = fmaxf(mx, S[m][k16][r]);
        mx = fmaxf(mx, shx16(mx));
        mx = fmaxf(mx, shx32(mx, idx32));
        if (__builtin_amdgcn_ballot_w64(mx > mrun[m] + 8.0f) != 0ull) {
          const float mnew = fmaxf(mrun[m], mx);
          const float alpha = fast_exp2(mrun[m] - mnew);
          mrun[m] = mnew;
          lsum[m] *= alpha;
#pragma unroll
          for (int dt = 0; dt < 8; ++dt) { O[m][dt][0] *= alpha; O[m][dt][1] *= alpha; O[m][dt][2] *= alpha; O[m][dt][3] *= alpha; }
        }
        const float mref = mrun[m];
        float ps = 0.f;
#pragma unroll
        for (int k16 = 0; k16 < 4; ++k16)
#pragma unroll
          for (int r = 0; r < 4; ++r) { const float e = fast_exp2(S[m][k16][r] - mref); S[m][k16][r] = e; ps += e; }
        lsum[m] += ps;
#pragma unroll
        for (int kk = 0; kk < 2; ++kk) {
          u32x4 t;
          t[0] = pack2(S[m][2 * kk][0], S[m][2 * kk][1]); t[1] = pack2(S[m][2 * kk][2], S[m][2 * kk][3]);
          t[2] = pack2(S[m][2 * kk + 1][0], S[m][2 * kk + 1][1]); t[3] = pack2(S[m][2 * kk + 1][2], S[m][2 * kk + 1][3]);
          pb[m][kk] = __builtin_bit_cast(bf16x8, t);
        }
      }
#pragma unroll
      for (int kk = 0; kk < 2; ++kk) {
        bf16x8 vf[8];
#pragma unroll
        for (int dt = 0; dt < 8; ++dt) vf[dt] = *(const LAS bf16x8*)(vb + dt * 2048 + voff[kk]);
        SCHED;
#pragma unroll
        for (int dt = 0; dt < 8; ++dt) {
          O[0][dt] = mfma16(vf[dt], pb[0][kk], O[0][dt]);
          O[1][dt] = mfma16(vf[dt], pb[1][kk], O[1][dt]);
        }
      }
    }
  }
  WAIT_V(0);
#undef ATT_ISSUE
  float l0 = lsum[0], l1 = lsum[1];
  l0 += shx16(l0); l0 += shx32(l0, idx32);
  l1 += shx16(l1); l1 += shx32(l1, idx32);
  const float c1 = 1.0f / l0, c2 = lam / l1;
  float ss = 0.f;
#pragma unroll
  for (int dt = 0; dt < 8; ++dt)
#pragma unroll
    for (int r = 0; r < 4; ++r) { const float o = O[0][dt][r] * c1 - O[1][dt][r] * c2; O[0][dt][r] = o; ss += o * o; }
  ss += shx16(ss); ss += shx32(ss, idx32);
  const float rinv = rsqrtf(ss * (1.0f / 128.0f) + 1e-5f);
  if (qpos < LSEQ) {
    u16* dst = W_MIX(p) + (size_t)(b * LSEQ + qpos) * DM + hh * 128 + 4 * g;
#pragma unroll
    for (int dt = 0; dt < 8; ++dt) {
      const int dv0 = 16 * dt + 4 * g;
      u32x2 o;
      o[0] = pack2(O[0][dt][0] * rinv * sg[dv0 + 0], O[0][dt][1] * rinv * sg[dv0 + 1]);
      o[1] = pack2(O[0][dt][2] * rinv * sg[dv0 + 2], O[0][dt][3] * rinv * sg[dv0 + 3]);
      *(u32x2*)(dst + 16 * dt) = o;
    }
  }
}

DI void conv_item(const Params& p, int layer, int item, int tid) {
  const int ch = (tid & 63) * 8, t0 = item * 16 + 4 * (tid >> 6);
  const int pos0 = t0 % LSEQ;
  const bool head = pos0 == 0;
  const u16* row0 = W_PROJ(p) + (size_t)t0 * INC;
  u32x4 gc[6], zz[6], gb[4];
#pragma unroll
  for (int j = 0; j < 6; ++j) {
    const u16* r2 = row0 + (ptrdiff_t)((head && j < 2) ? 0 : (j - 2)) * INC;
    gc[j] = *(const u32x4*)(r2 + 2048 + ch); zz[j] = *(const u32x4*)(r2 + 2560 + ch);
  }
#pragma unroll
  for (int i = 0; i < 4; ++i) gb[i] = *(const u32x4*)(row0 + (size_t)i * INC + 1536 + ch);
  const float* cw = P_CONV_W(p) + (size_t)layer * 3 * 512 + ch;
  float w0[8], w1[8], w2[8];
#pragma unroll
  for (int e = 0; e < 8; ++e) { w0[e] = cw[e]; w1[e] = cw[512 + e]; w2[e] = cw[1024 + e]; }
  float pr[6][8];
#pragma unroll
  for (int j = 0; j < 6; ++j) {
    const float keep = (head && j < 2) ? 0.f : 1.f;
#pragma unroll
    for (int e = 0; e < 4; ++e) { pr[j][2 * e] = keep * bflo(gc[j][e]) * bflo(zz[j][e]); pr[j][2 * e + 1] = keep * bfhi(gc[j][e]) * bfhi(zz[j][e]); }
  }
#pragma unroll
  for (int i = 0; i < 4; ++i) {
    u32x4 o;
#pragma unroll
    for (int e = 0; e < 4; ++e) {
      const float a0 = w0[2 * e] * pr[i][2 * e] + w1[2 * e] * pr[i + 1][2 * e] + w2[2 * e] * pr[i + 2][2 * e];
      const float a1 = w0[2 * e + 1] * pr[i][2 * e + 1] + w1[2 * e + 1] * pr[i + 1][2 * e + 1] + w2[2 * e + 1] * pr[i + 2][2 * e + 1];
      o[e] = pack2(bflo(gb[i][e]) * a0, bfhi(gb[i][e]) * a1);
    }
    *(u32x4*)(W_MIX(p) + (size_t)(t0 + i) * DM + 512 + ch) = o;
  }
}

DI void phase_prologue(const Params& p, char* smem, int wave) {
  const int tid = otid_w(wave), lane = tid & 63, wid = tid >> 6, hb = tid >> 8, htid = tid & 255;
  const int nblk = gridDim.x, bid = blockIdx.x;
  const size_t gtid = (size_t)bid * NTHREADS + tid, gthreads = (size_t)nblk * NTHREADS;
  float* sm = (float*)(smem + hb * LDS_HALF);
  for (int it0 = bid; it0 < 2048; it0 += nblk) {
    const int it = it0 * 2 + hb;
    if (it < 3072) {
      const int l = it / 768, r = it % 768, kb = r / 48, nb = r % 48;
      transpose_tile(P_W_IN(p) + (size_t)l * 1024 * 3072, 3072, W_WIN(p) + (size_t)l * 3072 * 1024, 1024, kb * 64, nb * 64, sm, htid);
    } else {
      const int i2 = it - 3072, l = i2 / 256, r = i2 % 256, kb = r / 16, nb = r % 16;
      transpose_tile(P_W_OUT(p) + (size_t)l * 1024 * 1024, 1024, W_WOUT(p) + (size_t)l * 1024 * 1024, 1024, kb * 64, nb * 64, sm, htid);
    }
  }
  convert_straight(P_W_Q(p), W_WQB(p), (size_t)4 * 1024 * 2048 / 8, gtid, gthreads);
  convert_straight(P_SUB_KEYS(p), W_SKB(p), (size_t)4 * 16 * 128 * 128 / 8, gtid, gthreads);
  for (int t = bid * 8 + wid; t < TTOK; t += nblk * 8) {
    const int b = t / LSEQ, pos = t - b * LSEQ;
    const float* src = pos < NMETA ? P_META(p) + (size_t)pos * DM : P_X(p) + ((size_t)b * SEQ + pos - NMETA) * DM;
    float v[16];
    load_row_f32<0>(src, v, lane);
    ln_row<0>(v, P_LN_IN_G(p), P_LN_IN_B(p), lane);
    store_row_bf16<0>(W_H(p) + (size_t)t * DM, v, lane);
  }
}

DI void phase_fold(const Params& p, char* smem, int wave) {
  const int tid = otid_w(wave), hb = tid >> 8, htid = tid & 255;
  for (int it0 = blockIdx.x; it0 < 256; it0 += gridDim.x) {
    const int it = it0 * 2 + hb;
    const int l = it >> 7, hp = (it >> 3) & 15, mt = it & 7;
    gemm_tile_fold(W_WQB(p) + (size_t)l * 1024 * 2048 + hp * 128, 2048, W_SKB(p) + ((size_t)l * 16 + hp) * 128 * 128, 128, 128, mt * 128, smem + hb * 65536,
                   W_WSC(p) + (size_t)l * 2048 * 1024 + (size_t)hp * 128 * 1024, htid);
  }
}

DI bool tile_order(int i, int nM, int nN, int& pm, int& pn) {
  const int nwg = nM * nN;
  const long L = (long)i * gridDim.x + blockIdx.x;
  if (L >= nwg) return false;
  int wgid = (int)L;
  { const int q = nwg / 8, r = nwg % 8, xcd = wgid % 8, off = wgid / 8; wgid = (xcd < r ? xcd * (q + 1) : r * (q + 1) + (xcd - r) * q) + off; }
  const int nig = 8 * nN, gid = wgid / nig, fm = gid * 8, gsz = (nM - fm) < 8 ? (nM - fm) : 8;
  pm = fm + ((wgid % nig) % gsz); pn = (wgid % nig) / gsz;
  return true;
}

DI void phase_gemm(const Params& p, int layer, int which, char* smem, int wave) {
  const int tid0 = otid_w(wave);
  const u16* W = which == 0 ? W_WIN(p) + (size_t)layer * 3072 * 1024 : (which == 1 ? W_WOUT(p) + (size_t)layer * 1024 * 1024 : W_WSC(p) + (size_t)layer * 2048 * 1024);
  const u16* X = which == 1 ? W_MIX(p) : W_H(p);
  const int nN = which == 0 ? 12 : (which == 1 ? 4 : 8);
  int pm, pn;
  for (int i = 0; tile_order(i, 258, nN, pm, pn); ++i) {
    const bool vt = (which == 0) && (pn == 4 || pn == 5);
    const int mode = which == 0 ? (vt ? EPI_VT : EPI_PROJ) : (which == 1 ? EPI_OUT : EPI_TOPK);
    int tid = tid0;
    asm volatile("" : "+v"(tid));
    gemm256_tile(p, mode, layer, vt ? X : W, vt ? W : X, vt ? pm * 256 : pn * 256, vt ? pn * 256 : pm * 256, (lchar*)smem, tid);
  }
}

DI void phase_attn(const Params& p, int layer, char* smem, int wave) {
  const int tid = otid_w(wave), lane = tid & 63, hb = tid >> 8, htid = tid & 255;
  const float lam_init = 0.8f - 0.6f * expf(-0.3f * (float)layer);
  float d1 = P_LQ1(p)[layer * 64 + lane] * P_LK1(p)[layer * 64 + lane], d2 = P_LQ2(p)[layer * 64 + lane] * P_LK2(p)[layer * 64 + lane];
  d1 = wave_sum(d1); d2 = wave_sum(d2);
  const float lam = expf(d1) - expf(d2) + lam_init;
  for (int rd = 0; rd * (int)gridDim.x < 2176; ++rd) {
    const int o = rd * gridDim.x + ((rd & 1) ? (int)gridDim.x - 1 - (int)blockIdx.x : (int)blockIdx.x);
    if (o < 2176) { const int jq = 16 - (o >> 7), bh = o & 127; attn_item(p, layer, bh >> 2, bh & 3, jq, (lchar*)smem, lam, 1.0f - lam_init, tid); }
  }
  for (int it = blockIdx.x; it < 2064; it += gridDim.x) conv_item(p, layer, it * 2 + hb, htid);
}

DI void phase_ln(const Params& p, int layer, int which, int wave) {
  const int tid = otid_w(wave), lane = tid & 63, wid = tid >> 6;
  const int nblk = gridDim.x, bid = blockIdx.x;
  const float* lg = (which ? P_LN2_G(p) : P_LN1_G(p)) + layer * DM;
  const float* lb = (which ? P_LN2_B(p) : P_LN1_B(p)) + layer * DM;
  const bool final_out = which && (layer == DEPTH - 1);
  for (int t = bid * 8 + wid; t < TTOK; t += nblk * 8) {
    float v[16];
    load_row_bf16<0>(W_Y(p) + (size_t)t * DM, v, lane);
    ln_row<0>(v, lg, lb, lane);
    if (final_out) {
      const int b = t / LSEQ, pos = t - b * LSEQ;
      if (pos >= NMETA) {
        float* dst = p.out + ((size_t)b * SEQ + pos - NMETA) * DM;
#pragma unroll
        for (int hh = 0; hh < 2; ++hh) {
          *(f32x4*)(dst + hh * 512 + 8 * lane) = (f32x4){v[hh * 8], v[hh * 8 + 1], v[hh * 8 + 2], v[hh * 8 + 3]};
          *(f32x4*)(dst + hh * 512 + 8 * lane + 4) = (f32x4){v[hh * 8 + 4], v[hh * 8 + 5], v[hh * 8 + 6], v[hh * 8 + 7]};
        }
      }
    } else {
      store_row_bf16<0>(W_H(p) + (size_t)t * DM, v, lane);
    }
  }
  if (which) return;
  for (int r = bid * 8 + wid; r < 2 * PEER_N; r += nblk * 8) {
    const bool isv = r >= PEER_N;
    const int e = isv ? r - PEER_N : r;
    const float* src = (isv ? P_PEER_V(p) : P_PEER_U(p)) + ((size_t)layer * PEER_N + e) * DM + 16 * lane;
    f32x4 a[4];
#pragma unroll
    for (int k = 0; k < 4; ++k) a[k] = *(const f32x4*)(src + 4 * k);
    float am = 0.f;
#pragma unroll
    for (int k = 0; k < 4; ++k) am = fmaxf(am, fmaxf(fmaxf(fabsf(a[k][0]), fabsf(a[k][1])), fmaxf(fabsf(a[k][2]), fabsf(a[k][3]))));
    am = wave_max_nonneg(am);
    const float sc = am > 0.f ? 224.0f / am : 1.0f;
    if (lane == 0) (isv ? W_SV(p) : W_SU(p))[e] = am > 0.f ? am * (1.0f / 224.0f) : 1.0f;
    u32x4 o;
#pragma unroll
    for (int k = 0; k < 4; ++k) {
      int w = 0;
      w = __builtin_amdgcn_cvt_pk_fp8_f32(a[k][0] * sc, a[k][1] * sc, w, false);
      w = __builtin_amdgcn_cvt_pk_fp8_f32(a[k][2] * sc, a[k][3] * sc, w, true);
      o[k] = (unsigned)w;
    }
    *(u32x4*)((isv ? W_VB(p) : W_UB(p)) + (size_t)(lane >> 3) * (PEER_N * 128) + (size_t)e * 128 + 16 * (lane & 7)) = o;
  }
}

#define DPP_F(v, ctrl) __int_as_float(__builtin_amdgcn_update_dpp(0, __float_as_int(v), (ctrl), 0xf, 0xf, true))
#define PEER_META(T, IA, IB, HA, HB) do { const int _t = (T) < TTOK ? (T) : wslot; \
    IA = W_IDX(p)[(size_t)_t * 128 + lane]; IB = W_IDX(p)[(size_t)_t * 128 + 64 + lane]; \
    const u16* _hp = W_H(p) + (size_t)_t * DM + x * 128 + 16 * c; HA = *(const u32x4*)(_hp); HB = *(const u32x4*)(_hp + 8); } while (0)
#define PEER_GATHER(TAB, IA, IB, RR) do { _Pragma("unroll") for (int g = 0; g < 16; ++g) { \
    const int _e = __builtin_amdgcn_ds_bpermute(bp0 + 32 * (g & 7), g < 8 ? IA : IB); RR[g] = *(const u32x4*)((TAB) + (size_t)_e * 128); } } while (0)
#define PEER_UNPACK(XS, HA, HB) do { _Pragma("unroll") for (int e = 0; e < 4; ++e) { \
    XS[e] = (f32x2){bflo(HA[e]), bfhi(HA[e])}; XS[4 + e] = (f32x2){bflo(HB[e]), bfhi(HB[e])}; } } while (0)

DI void phase_peer_dots(const Params& p, int layer, int wave) {
  const int tid = otid_w(wave), lane = tid & 63, wid = tid >> 6, c = lane & 7, r = lane >> 3;
  const int x = blockIdx.x & 7, wslot = (blockIdx.x >> 3) * 8 + wid, nslot = (gridDim.x >> 3) * 8;
  const unsigned char* ub = W_UB(p) + (size_t)x * (PEER_N * 128) + c * 16;
  u16* pd = W_Y(p);
  const int bp0 = 4 * r;
  int iAa, iBa, iAb, iBb;
  u32x4 hAa, hBa, hAb, hBb, rrA[16], rrB[16];
  f32x2 xs[8];
#define DOTS_COMPUTE(T, RR) do { if ((T) < TTOK) { float pA = 0.f, pB = 0.f; \
    _Pragma("unroll") for (int g = 0; g < 16; ++g) { f32x2 d2 = (f32x2){0.f, 0.f}; \
      _Pragma("unroll") for (int k = 0; k < 4; ++k) { \
        const f32x2 lo = __builtin_amdgcn_cvt_pk_f32_fp8((int)RR[g][k], false), hi = __builtin_amdgcn_cvt_pk_f32_fp8((int)RR[g][k], true); \
        d2 += xs[2 * k] * lo; d2 += xs[2 * k + 1] * hi; } \
      float d = d2[0] + d2[1]; d += DPP_F(d, 0xB1); d += DPP_F(d, 0x4E); d += DPP_F(d, 0x141); \
      if (c == (g & 7)) { if (g < 8) pA = d; else pB = d; } } \
    u16* _dst = pd + ((size_t)(T) * 8 + x) * 128 + 8 * c + r; _dst[0] = (u16)(pack2(pA, 0.f) & 0xffffu); _dst[64] = (u16)(pack2(pB, 0.f) & 0xffffu); } } while (0)
  int t = wslot;
  PEER_META(t, iAa, iBa, hAa, hBa);
  PEER_META(t + nslot, iAb, iBb, hAb, hBb);
  PEER_GATHER(ub, iAa, iBa, rrA);
  for (; t < TTOK; t += 2 * nslot) {
    PEER_UNPACK(xs, hAa, hBa);
    PEER_META(t + 2 * nslot, iAa, iBa, hAa, hBa);
    PEER_GATHER(ub, iAb, iBb, rrB);
    DOTS_COMPUTE(t, rrA);
    PEER_UNPACK(xs, hAb, hBb);
    PEER_META(t + 3 * nslot, iAb, iBb, hAb, hBb);
    PEER_GATHER(ub, iAa, iBa, rrA);
    DOTS_COMPUTE(t + nslot, rrB);
  }
#undef DOTS_COMPUTE
}

DI void phase_peer_w(const Params& p, int layer, int wave) {
  const int tid = otid_w(wave), lane = tid & 63, wid = tid >> 6;
  const u16* pd = W_Y(p);
  for (int t = blockIdx.x * 8 + wid; t < TTOK; t += gridDim.x * 8) {
#pragma unroll
    for (int hf = 0; hf < 2; ++hf) {
      const int j = hf * 64 + lane;
      float sacc = 0.f;
#pragma unroll
      for (int xx = 0; xx < 8; ++xx) sacc += __uint_as_float(((unsigned)pd[((size_t)t * 8 + xx) * 128 + j]) << 16);
      const int e = W_IDX(p)[(size_t)t * 128 + j];
      const float act = sacc * W_SU(p)[e];
      W_G(p)[(size_t)t * 128 + j] = W_G(p)[(size_t)t * 128 + j] * (0.5f * act * (1.0f + erff(act * 0.7071067811865476f))) * W_SV(p)[e];
    }
  }
}

#define PEER_META_V(T, IA, IB, WA, WB, HA, HB) do { const int _t = (T) < TTOK ? (T) : wslot; \
    IA = W_IDX(p)[(size_t)_t * 128 + lane]; IB = W_IDX(p)[(size_t)_t * 128 + 64 + lane]; \
    WA = W_G(p)[(size_t)_t * 128 + lane]; WB = W_G(p)[(size_t)_t * 128 + 64 + lane]; \
    const u16* _hp = W_H(p) + (size_t)_t * DM + x * 128 + 16 * c; HA = *(const u32x4*)(_hp); HB = *(const u32x4*)(_hp + 8); } while (0)
DI void phase_peer_v(const Params& p, int layer, int wave) {
  const int tid = otid_w(wave), lane = tid & 63, wid = tid >> 6, c = lane & 7, r = lane >> 3;
  const int x = blockIdx.x & 7, wslot = (blockIdx.x >> 3) * 8 + wid, nslot = (gridDim.x >> 3) * 8;
  const unsigned char* vb = W_VB(p) + (size_t)x * (PEER_N * 128) + c * 16;
  u16* y2 = W_Y(p);
  const int bp0 = 4 * r, idx32 = (lane ^ 32) << 2;
  int iAa, iBa, iAb, iBb;
  float wAa, wBa, wAb, wBb, wA, wB;
  u32x4 hAa, hBa, hAb, hBb, rrA[16], rrB[16];
  f32x2 xs[8];
#define V_COMPUTE(T, RR) do { if ((T) < TTOK) { f32x2 acc[8]; \
    _Pragma("unroll") for (int i = 0; i < 8; ++i) acc[i] = (f32x2){0.f, 0.f}; \
    _Pragma("unroll") for (int g = 0; g < 16; ++g) { \
      const float wj = __int_as_float(__builtin_amdgcn_ds_bpermute(bp0 + 32 * (g & 7), __float_as_int(g < 8 ? wA : wB))); \
      const f32x2 wj2 = (f32x2){wj, wj}; \
      _Pragma("unroll") for (int k = 0; k < 4; ++k) { \
        const f32x2 lo = __builtin_amdgcn_cvt_pk_f32_fp8((int)RR[g][k], false), hi = __builtin_amdgcn_cvt_pk_f32_fp8((int)RR[g][k], true); \
        acc[2 * k] += wj2 * lo; acc[2 * k + 1] += wj2 * hi; } } \
    _Pragma("unroll") for (int i = 0; i < 8; ++i) { _Pragma("unroll") for (int q = 0; q < 2; ++q) { \
        float v = acc[i][q]; v += DPP_F(v, 0x128); v += shx16(v); v += shx32(v, idx32); acc[i][q] = v; } } \
    if (r == 0) { u16* _dst = y2 + (size_t)(T) * DM + x * 128 + 16 * c; \
      _Pragma("unroll") for (int q = 0; q < 2; ++q) { u32x4 _o; \
        _Pragma("unroll") for (int e = 0; e < 4; ++e) _o[e] = pack2(ALPHA * xs[4 * q + e][0] + acc[4 * q + e][0], ALPHA * xs[4 * q + e][1] + acc[4 * q + e][1]); \
        *(u32x4*)(_dst + 8 * q) = _o; } } } } while (0)
  int t = wslot;
  PEER_META_V(t, iAa, iBa, wAa, wBa, hAa, hBa);
  PEER_META_V(t + nslot, iAb, iBb, wAb, wBb, hAb, hBb);
  PEER_GATHER(vb, iAa, iBa, rrA);
  for (; t < TTOK; t += 2 * nslot) {
    PEER_UNPACK(xs, hAa, hBa); wA = wAa; wB = wBa;
    PEER_META_V(t + 2 * nslot, iAa, iBa, wAa, wBa, hAa, hBa);
    PEER_GATHER(vb, iAb, iBb, rrB);
    V_COMPUTE(t, rrA);
    PEER_UNPACK(xs, hAb, hBb); wA = wAb; wB = wBb;
    PEER_META_V(t + 3 * nslot, iAb, iBb, wAb, wBb, hAb, hBb);
    PEER_GATHER(vb, iAa, iBa, rrA);
    V_COMPUTE(t + nslot, rrB);
  }
#undef V_COMPUTE
}

#define XB_TMO      128
#define XB_XCNT(j)  (256  + 64 * (j))
#define XB_XSUB(j)  (1280 + 64 * (j))
#define XB_XGEN(j)  (2304 + 64 * (j))
#define XB_TOP      3328
#define XB_TOPGEN   3392
#define XCD_BAR_WORDS 3456
#define XB_SPIN_CAP (1u << 22)
DI unsigned xb_ld(unsigned* p)              { return __hip_atomic_load(p, __ATOMIC_RELAXED, __HIP_MEMORY_SCOPE_AGENT); }
DI unsigned xb_add(unsigned* p, unsigned v) { return __hip_atomic_fetch_add(p, v, __ATOMIC_RELAXED, __HIP_MEMORY_SCOPE_AGENT); }
DI unsigned xb_xcc_id() { return (unsigned)__builtin_amdgcn_s_getreg((3 << 11) | 20) & 0xFu; }
#define XB_SPIN(cond, bar) do { unsigned _sp = 0; while (cond) { __builtin_amdgcn_s_sleep(1); \
    if ((++_sp & 255u) == 0u) { if (xb_ld(&(bar)[XB_TMO])) break; if (_sp > XB_SPIN_CAP) { atomicAdd(&(bar)[XB_TMO], 1u); break; } } } } while (0)
DI bool is_thread0(int wave) { unsigned z = 0u; asm volatile("" : "+v"(z)); return wave == 0 && __builtin_amdgcn_mbcnt_hi(~0u, __builtin_amdgcn_mbcnt_lo(~0u, z)) == 0u; }
DI void xcd_barrier_complete(unsigned* bar, unsigned x, unsigned& nloc, unsigned& nx) {
  const unsigned G = gridDim.x;
  unsigned sum, cnt, mine, sp = 0u;
  for (;;) {
    sum = 0u; cnt = 0u; mine = 0u;
#pragma unroll
    for (unsigned j = 0; j < 16; ++j) { const unsigned c = xb_ld(&bar[XB_XCNT(j)]); sum += c; cnt += (c > 0u) ? 1u : 0u; mine = (j == x) ? c : mine; }
    if (sum == G) break;
    __builtin_amdgcn_s_sleep(1);
    if ((++sp & 255u) == 0u) { if (xb_ld(&bar[XB_TMO])) break; if (sp > XB_SPIN_CAP) { atomicAdd(&bar[XB_TMO], 1u); break; } }
  }
  nloc = mine > 0u ? mine : 1u; nx = cnt > 0u ? cnt : 1u;
}
DI void xcd_barrier(unsigned* bar, volatile LAS unsigned* st, int wave) {
  asm volatile("s_waitcnt vmcnt(0)" ::: "memory");
  __syncthreads();
  if (is_thread0(wave)) {
    const unsigned x = xb_xcc_id();
    __builtin_amdgcn_s_waitcnt(0);
    unsigned nloc = st[0], nx = st[1];
    if (nloc == 0u) { xcd_barrier_complete(bar, x, nloc, nx); st[0] = nloc; st[1] = nx; }
    const unsigned old = xb_add(&bar[XB_XSUB(x)], 1u);
    const unsigned gen = old / nloc;
    if (old + 1u == (gen + 1u) * nloc) {
      __builtin_amdgcn_fence(__ATOMIC_RELEASE, "agent");
      asm volatile("s_waitcnt vmcnt(0)" ::: "memory");
      const unsigned og = xb_add(&bar[XB_TOP], 1u);
      const unsigned tg = og / nx;
      if (og + 1u == (tg + 1u) * nx) xb_add(&bar[XB_TOPGEN], 1u);
      else XB_SPIN(xb_ld(&bar[XB_TOPGEN]) == tg, bar);
      __builtin_amdgcn_fence(__ATOMIC_ACQUIRE, "agent");
      xb_add(&bar[XB_XGEN(x)], 1u);
      asm volatile("s_waitcnt vmcnt(0)" ::: "memory");
    } else {
      XB_SPIN(xb_ld(&bar[XB_XGEN(x)]) == gen, bar);
      __builtin_amdgcn_fence(__ATOMIC_ACQUIRE, "agent");
      asm volatile("s_waitcnt vmcnt(0)" ::: "memory");
    }
  }
  __syncthreads();
}

__global__ void __launch_bounds__(NTHREADS, 2) mega(Params p) {
  extern __shared__ __attribute__((aligned(16))) char smem[];
  cg::grid_group grid = cg::this_grid();
  const int wave = __builtin_amdgcn_readfirstlane((int)(threadIdx.x >> 6));
  unsigned* bar = (unsigned*)(p.ws + WS_BAR);
  volatile LAS unsigned* st = (volatile LAS unsigned*)((lchar*)smem + LDS_XB);
  if (threadIdx.x == 0) { st[0] = 0u; st[1] = 0u; (void)xb_add(&bar[XB_XCNT(xb_xcc_id())], 1u); }
  __syncthreads();
  phase_prologue(p, smem, wave);
  grid.sync();
  phase_fold(p, smem, wave);
  xcd_barrier(bar, st, wave);
#pragma unroll 1
  for (int step = 0; step < DEPTH * 9; ++step) {
    const int layer = step / 9, ph = step - layer * 9;
    if (ph == 0 || ph == 2 || ph == 4) phase_gemm(p, layer, ph >> 1, smem, wave);
    else if (ph == 1) phase_attn(p, layer, smem, wave);
    else if (ph == 3 || ph == 8) phase_ln(p, layer, ph == 8, wave);
    else if (ph == 5) phase_peer_dots(p, layer, wave);
    else if (ph == 6) phase_peer_w(p, layer, wave);
    else phase_peer_v(p, layer, wave);
    if (step + 1 < DEPTH * 9) xcd_barrier(bar, st, wave);
  }
}

extern "C" void kernel_launch(void* const* d_in, const int* in_sizes, int n_in, void* d_out, int out_size, void* d_ws, size_t ws_size,
                              hipStream_t stream) {
  static int grid_blocks = 0;
  if (grid_blocks == 0) {
    if (ws_size < WS_END) { fprintf(stderr, "kernel_launch: workspace too small: need %zu, got %zu\n", (size_t)WS_END, ws_size); grid_blocks = -1; return; }
    int dev = 0, cus = 0, per_cu = 0;
    hipGetDevice(&dev);
    hipDeviceGetAttribute(&cus, hipDeviceAttributeMultiprocessorCount, dev);
    hipFuncSetAttribute((const void*)mega, hipFuncAttributeMaxDynamicSharedMemorySize, LDS_BYTES);
    hipOccupancyMaxActiveBlocksPerMultiprocessor(&per_cu, (const void*)mega, NTHREADS, LDS_BYTES);
    if (per_cu < 1) per_cu = 1;
    if (per_cu > 1) per_cu = 1;
    grid_blocks = cus * per_cu;
  }
  if (grid_blocks < 0) return;
  Params p{};
  for (int i = 0; i < 21; ++i) p.in[i] = (const float*)d_in[i];
  p.out = (float*)d_out;
  p.ws = (char*)d_ws;
  if (hipMemsetAsync((char*)d_ws + WS_BAR, 0, 16384, stream) != hipSuccess) { fprintf(stderr, "kernel_launch: memset of the barrier words failed\n"); return; }
  void* args[] = {&p};
  hipError_t e = hipLaunchCooperativeKernel((const void*)mega, dim3(grid_blocks), dim3(NTHREADS), args, LDS_BYTES, stream);
  if (e != hipSuccess) fprintf(stderr, "cooperative launch failed: %s (grid %d)\n", hipGetErrorString(e), grid_blocks);
}
```

```cpp
#include <hip/hip_runtime.h>
#include <hip/hip_cooperative_groups.h>
#include <cstdio>
#include <cstdint>
namespace cg = cooperative_groups;

typedef unsigned short u16;
typedef __attribute__((ext_vector_type(8))) short bf16x8;
typedef __attribute__((ext_vector_type(4))) float f32x4;
typedef __attribute__((ext_vector_type(4))) unsigned u32x4;
typedef __attribute__((ext_vector_type(2))) unsigned u32x2;
typedef __attribute__((ext_vector_type(2))) float f32x2;
#define DI __device__ __forceinline__
#define LAS __attribute__((address_space(3)))
typedef LAS char lchar;

#define DM 1024
#define NBATCH 32
#define SEQ 2048
#define NMETA 16
#define LSEQ 2064
#define TTOK 66048
#define DEPTH 4
#define INC 3072
#define LP 2112
#define PEER_N 16384
#define NTHREADS 512
#define LDS_MISC 69632
#define LDS_HALF 70656
#define LDS_XB 141312
#define LDS_BYTES 141328

#define ALPHA 1.681792830507429f
#define LOG2E 1.4426950408889634f

static constexpr size_t WS_WIN  = 0;
static constexpr size_t WS_WOUT = WS_WIN  + (size_t)4 * 3072 * 1024 * 2;
static constexpr size_t WS_WQB  = WS_WOUT + (size_t)4 * 1024 * 1024 * 2;
static constexpr size_t WS_SKB  = WS_WQB  + (size_t)4 * 1024 * 2048 * 2;
static constexpr size_t WS_WSC  = WS_SKB  + (size_t)4 * 16 * 128 * 128 * 2;
static constexpr size_t WS_UB   = WS_WSC  + (size_t)4 * 2048 * 1024 * 2;
static constexpr size_t WS_VB   = WS_UB   + (size_t)PEER_N * 1024;
static constexpr size_t WS_SU   = WS_VB   + (size_t)PEER_N * 1024;
static constexpr size_t WS_SV   = WS_SU   + (size_t)PEER_N * 4;
static constexpr size_t WS_H    = WS_SV   + (size_t)PEER_N * 4;
static constexpr size_t WS_MIX  = WS_H    + (size_t)TTOK * 1024 * 2;
static constexpr size_t WS_BIG  = WS_MIX  + (size_t)TTOK * 1024 * 2;
static constexpr size_t WS_VT   = WS_BIG  + (size_t)(TTOK + 64) * 3072 * 2;
static constexpr size_t WS_IDX  = WS_VT   + (size_t)NBATCH * 4 * 128 * LP * 2;
static constexpr size_t WS_G    = WS_IDX  + (size_t)TTOK * 128 * 4;
static constexpr size_t WS_BAR  = WS_G    + (size_t)TTOK * 128 * 4;
static constexpr size_t WS_END  = WS_BAR  + 16384;

struct Params {
  const float* in[21];
  float* out;
  char* ws;
};
#define P_X(p) ((p).in[0])
#define P_META(p) ((p).in[1])
#define P_LN_IN_G(p) ((p).in[2])
#define P_LN_IN_B(p) ((p).in[3])
#define P_REL_BIAS(p) ((p).in[4])
#define P_W_IN(p) ((p).in[5])
#define P_CONV_W(p) ((p).in[6])
#define P_LQ1(p) ((p).in[7])
#define P_LK1(p) ((p).in[8])
#define P_LQ2(p) ((p).in[9])
#define P_LK2(p) ((p).in[10])
#define P_SUBLN_G(p) ((p).in[11])
#define P_W_OUT(p) ((p).in[12])
#define P_LN1_G(p) ((p).in[13])
#define P_LN1_B(p) ((p).in[14])
#define P_W_Q(p) ((p).in[15])
#define P_SUB_KEYS(p) ((p).in[16])
#define P_PEER_U(p) ((p).in[17])
#define P_PEER_V(p) ((p).in[18])
#define P_LN2_G(p) ((p).in[19])
#define P_LN2_B(p) ((p).in[20])
#define W_WIN(p) ((u16*)((p).ws + WS_WIN))
#define W_WOUT(p) ((u16*)((p).ws + WS_WOUT))
#define W_WQB(p) ((u16*)((p).ws + WS_WQB))
#define W_SKB(p) ((u16*)((p).ws + WS_SKB))
#define W_WSC(p) ((u16*)((p).ws + WS_WSC))
#define W_UB(p) ((unsigned char*)((p).ws + WS_UB))
#define W_VB(p) ((unsigned char*)((p).ws + WS_VB))
#define W_SU(p) ((float*)((p).ws + WS_SU))
#define W_SV(p) ((float*)((p).ws + WS_SV))
#define W_H(p) ((u16*)((p).ws + WS_H))
#define W_MIX(p) ((u16*)((p).ws + WS_MIX))
#define W_PROJ(p) ((u16*)((p).ws + WS_BIG))
#define W_Y(p) ((u16*)((p).ws + WS_BIG))
#define W_VT(p) ((u16*)((p).ws + WS_VT))
#define W_IDX(p) ((int*)((p).ws + WS_IDX))
#define W_G(p) ((float*)((p).ws + WS_G))

DI u16 f2bf(float x) { unsigned u = __float_as_uint(x); u += 0x7fffu + ((u >> 16) & 1u); return (u16)(u >> 16); }
typedef __attribute__((ext_vector_type(2))) __bf16 bf16x2_t;
DI unsigned pack2(float a, float b) { const bf16x2_t v = {(__bf16)a, (__bf16)b}; return __builtin_bit_cast(unsigned, v); }
DI float bflo(unsigned w) { return __uint_as_float(w << 16); }
DI float bfhi(unsigned w) { return __uint_as_float(w & 0xffff0000u); }
DI int otid_w(int wave) { unsigned z = 0u; asm volatile("" : "+v"(z)); int t = wave * 64 + (int)__builtin_amdgcn_mbcnt_hi(~0u, __builtin_amdgcn_mbcnt_lo(~0u, z)); asm volatile("" : "+v"(t)); return t; }
#define DPP_ADD(v, ctrl) ((v) + __int_as_float(__builtin_amdgcn_update_dpp(0, __float_as_int(v), (ctrl), 0xf, 0xf, true)))
DI float wave_sum(float v) {
  v = DPP_ADD(v, 0xB1);
  v = DPP_ADD(v, 0x4E);
  v = DPP_ADD(v, 0x141);
  v = DPP_ADD(v, 0x140);
  const int iv = __float_as_int(v);
  return __int_as_float(__builtin_amdgcn_readlane(iv, 0)) + __int_as_float(__builtin_amdgcn_readlane(iv, 16)) +
         __int_as_float(__builtin_amdgcn_readlane(iv, 32)) + __int_as_float(__builtin_amdgcn_readlane(iv, 48));
}
#define DPP_MAX(v, ctrl) fmaxf((v), __int_as_float(__builtin_amdgcn_update_dpp(0, __float_as_int(v), (ctrl), 0xf, 0xf, true)))
DI float wave_max_nonneg(float v) {
  v = DPP_MAX(v, 0xB1); v = DPP_MAX(v, 0x4E); v = DPP_MAX(v, 0x141); v = DPP_MAX(v, 0x140);
  const int iv = __float_as_int(v);
  return fmaxf(fmaxf(__int_as_float(__builtin_amdgcn_readlane(iv, 0)), __int_as_float(__builtin_amdgcn_readlane(iv, 16))),
               fmaxf(__int_as_float(__builtin_amdgcn_readlane(iv, 32)), __int_as_float(__builtin_amdgcn_readlane(iv, 48))));
}
DI float shx16(float v) { return __int_as_float(__builtin_amdgcn_ds_swizzle(__float_as_int(v), 0x401F)); }
DI float shx32(float v, int idx32) { return __int_as_float(__builtin_amdgcn_ds_bpermute(idx32, __float_as_int(v))); }
DI f32x4 mfma16(bf16x8 a, bf16x8 b, f32x4 c) { return __builtin_amdgcn_mfma_f32_16x16x32_bf16(a, b, c, 0, 0, 0); }
DI float fast_exp2(float x) { return __builtin_amdgcn_exp2f(x); }

DI void convert_straight(const float* __restrict__ src, u16* __restrict__ dst, size_t n8, size_t gtid, size_t gthreads) {
  for (size_t i = gtid; i < n8; i += gthreads) {
    const f32x4 a = *(const f32x4*)(src + i * 8), b = *(const f32x4*)(src + i * 8 + 4);
    u32x4 o; o[0] = pack2(a[0], a[1]); o[1] = pack2(a[2], a[3]); o[2] = pack2(b[0], b[1]); o[3] = pack2(b[2], b[3]);
    *(u32x4*)(dst + i * 8) = o;
  }
}

DI void transpose_tile(const float* __restrict__ src, int ldn, u16* __restrict__ dst, int ldk, int k0, int n0, float* sm, int tid) {
#pragma unroll
  for (int i = 0; i < 4; ++i) {
    const int r = (tid >> 4) + 16 * i, c4 = tid & 15;
    const f32x4 v = *(const f32x4*)(src + (size_t)(k0 + r) * ldn + n0 + 4 * c4);
    sm[r * 65 + 4 * c4 + 0] = v[0]; sm[r * 65 + 4 * c4 + 1] = v[1]; sm[r * 65 + 4 * c4 + 2] = v[2]; sm[r * 65 + 4 * c4 + 3] = v[3];
  }
  __syncthreads();
#pragma unroll
  for (int i = 0; i < 2; ++i) {
    const int n = (tid >> 3) + 32 * i, kc = tid & 7;
    u32x4 o;
#pragma unroll
    for (int e = 0; e < 4; ++e) o[e] = pack2(sm[(8 * kc + 2 * e) * 65 + n], sm[(8 * kc + 2 * e + 1) * 65 + n]);
    *(u32x4*)(dst + (size_t)(n0 + n) * ldk + k0 + 8 * kc) = o;
  }
  __syncthreads();
}

template <int LAYOUT> DI int col0(int lane, int hh) { return LAYOUT ? 16 * lane + 8 * hh : hh * 512 + 8 * lane; }
template <int LAYOUT>
DI void ln_row(float (&v)[16], const float* __restrict__ g, const float* __restrict__ b, int lane) {
  float s = 0.f;
#pragma unroll
  for (int i = 0; i < 16; ++i) s += v[i];
  const float mu = wave_sum(s) * (1.0f / 1024.0f);
  float q = 0.f;
#pragma unroll
  for (int i = 0; i < 16; ++i) { const float d = v[i] - mu; q += d * d; }
  const float rstd = rsqrtf(wave_sum(q) * (1.0f / 1024.0f) + 1e-5f);
#pragma unroll
  for (int hh = 0; hh < 2; ++hh) {
    const int c = col0<LAYOUT>(lane, hh);
    const f32x4 g0 = *(const f32x4*)(g + c), g1 = *(const f32x4*)(g + c + 4), b0 = *(const f32x4*)(b + c), b1 = *(const f32x4*)(b + c + 4);
#pragma unroll
    for (int e = 0; e < 4; ++e) {
      v[hh * 8 + e] = (v[hh * 8 + e] - mu) * rstd * g0[e] + b0[e];
      v[hh * 8 + 4 + e] = (v[hh * 8 + 4 + e] - mu) * rstd * g1[e] + b1[e];
    }
  }
}
template <int LAYOUT>
DI void store_row_bf16(u16* __restrict__ dst, const float (&v)[16], int lane) {
#pragma unroll
  for (int hh = 0; hh < 2; ++hh) {
    u32x4 o;
#pragma unroll
    for (int e = 0; e < 4; ++e) o[e] = pack2(v[hh * 8 + 2 * e], v[hh * 8 + 2 * e + 1]);
    *(u32x4*)(dst + col0<LAYOUT>(lane, hh)) = o;
  }
}
template <int LAYOUT>
DI void load_row_bf16(const u16* __restrict__ src, float (&v)[16], int lane) {
#pragma unroll
  for (int hh = 0; hh < 2; ++hh) {
    const u32x4 a = *(const u32x4*)(src + col0<LAYOUT>(lane, hh));
#pragma unroll
    for (int e = 0; e < 4; ++e) { v[hh * 8 + 2 * e] = bflo(a[e]); v[hh * 8 + 2 * e + 1] = bfhi(a[e]); }
  }
}
template <int LAYOUT>
DI void load_row_f32(const float* __restrict__ src, float (&v)[16], int lane) {
#pragma unroll
  for (int hh = 0; hh < 2; ++hh) {
    const int c = col0<LAYOUT>(lane, hh);
    const f32x4 a = *(const f32x4*)(src + c), b = *(const f32x4*)(src + c + 4);
#pragma unroll
    for (int e = 0; e < 4; ++e) { v[hh * 8 + e] = a[e]; v[hh * 8 + 4 + e] = b[e]; }
  }
}

enum { EPI_PROJ = 0, EPI_VT = 1, EPI_OUT = 2, EPI_TOPK = 3, EPI_FOLD = 4 };

template <bool SWAP>
DI void gemm_mainloop(const u16* __restrict__ A, int lda, const u16* __restrict__ Bt, int ldb, int K, int m0, int n0, char* smem,
                      f32x4 (&acc)[4][4], int tid) {
  const int lane = tid & 63, wid = tid >> 6, wm = wid >> 1, wn = wid & 1;
  const int srow = tid >> 3, skc = tid & 7;
  const u16* ap = A + (size_t)(m0 + srow) * lda + skc * 8;
  const u16* bp = Bt + (size_t)(n0 + srow) * ldb + skc * 8;
  const int dst0 = (((srow >> 4) * 2 + (skc >> 2)) * 1024) + (((skc & 3) * 16 + (srow & 15)) * 16);
#pragma unroll
  for (int i = 0; i < 4; ++i)
#pragma unroll
    for (int j = 0; j < 4; ++j) acc[i][j] = (f32x4){0.f, 0.f, 0.f, 0.f};
  u32x4 ra[4], rb[4];
#pragma unroll
  for (int j = 0; j < 4; ++j) { ra[j] = *(const u32x4*)(ap + (size_t)j * 32 * lda); rb[j] = *(const u32x4*)(bp + (size_t)j * 32 * ldb); }
#pragma unroll
  for (int j = 0; j < 4; ++j) { *(u32x4*)(smem + dst0 + j * 4096) = ra[j]; *(u32x4*)(smem + 16384 + dst0 + j * 4096) = rb[j]; }
  __syncthreads();
  const int KT = K >> 6;
  for (int kt = 0; kt < KT; ++kt) {
    char* cur = smem + (kt & 1) * 32768;
    char* nxt = smem + ((kt + 1) & 1) * 32768;
    const bool more = (kt + 1 < KT);
    if (more) {
      const u16* ap2 = ap + (kt + 1) * 64;
      const u16* bp2 = bp + (kt + 1) * 64;
#pragma unroll
      for (int j = 0; j < 4; ++j) { ra[j] = *(const u32x4*)(ap2 + (size_t)j * 32 * lda); rb[j] = *(const u32x4*)(bp2 + (size_t)j * 32 * ldb); }
    }
#pragma unroll
    for (int ks = 0; ks < 2; ++ks) {
      bf16x8 af[4], bfr[4];
#pragma unroll
      for (int i = 0; i < 4; ++i) af[i] = *(const bf16x8*)(cur + (((wm * 4 + i) * 2 + ks) * 1024) + lane * 16);
#pragma unroll
      for (int j = 0; j < 4; ++j) bfr[j] = *(const bf16x8*)(cur + 16384 + (((wn * 4 + j) * 2 + ks) * 1024) + lane * 16);
#pragma unroll
      for (int i = 0; i < 4; ++i)
#pragma unroll
        for (int j = 0; j < 4; ++j) acc[i][j] = SWAP ? mfma16(bfr[j], af[i], acc[i][j]) : mfma16(af[i], bfr[j], acc[i][j]);
    }
    if (more) {
#pragma unroll
      for (int j = 0; j < 4; ++j) { *(u32x4*)(nxt + dst0 + j * 4096) = ra[j]; *(u32x4*)(nxt + 16384 + dst0 + j * 4096) = rb[j]; }
    }
    __syncthreads();
  }
}

DI void insert16(float (&v)[16], float x) {
#pragma unroll
  for (int j = 0; j < 16; ++j) { const float hi = fmaxf(v[j], x); x = fminf(v[j], x); v[j] = hi; }
}

DI void gemm_tile_fold(const u16* A, int lda, const u16* Bt, int ldb, int K, int m0, char* smem, u16* dstT, int tid) {
  const int lane = tid & 63, wid = tid >> 6, wm = wid >> 1, wn = wid & 1, g = lane >> 4, l15 = lane & 15;
  f32x4 acc[4][4];
  gemm_mainloop<false>(A, lda, Bt, ldb, K, m0, 0, smem, acc, tid);
#pragma unroll
  for (int i = 0; i < 4; ++i)
#pragma unroll
    for (int j = 0; j < 4; ++j) {
      const int m = m0 + wm * 64 + 16 * i + 4 * g, n = wn * 64 + 16 * j + l15;
      u32x2 o; o[0] = pack2(acc[i][j][0], acc[i][j][1]); o[1] = pack2(acc[i][j][2], acc[i][j][3]);
      *(u32x2*)(dstT + (size_t)n * 1024 + m) = o;
    }
}

#define GK 1024
#define HTB 16384
DI int lds_byte(int r, int c) {
  const int st = (r >> 4) * 2 + (c >> 5), rr = r & 15, cc = c & 31, ob = rr * 64 + cc * 2;
  return st * 1024 + (ob ^ (((ob >> 9) & 1) << 5));
}
DI void stage_rc(int b, int& R, int& C) {
  const int st = b / 1024, sb = b % 1024, swz = sb ^ (((sb >> 9) & 1) << 5);
  R = (st >> 1) * 16 + swz / 64; C = (st & 1) * 32 + (swz % 64) / 2;
}
#define G_SA(b, h) (shm + ((b) * 2 + (h)) * HTB)
#define G_SB(b, h) (shm + (4 + (b) * 2 + (h)) * HTB)
#define G_STAGE(P, BASE, br, kt) do { const char* _g = (const char*)((BASE) + (size_t)(br) * GK + (kt) * 64); \
    __builtin_amdgcn_global_load_lds((const unsigned*)(_g + goff0), (LAS unsigned*)((P) + tid * 16), 16, 0, 0); \
    __builtin_amdgcn_global_load_lds((const unsigned*)(_g + goff1), (LAS unsigned*)((P) + tid * 16 + 8192), 16, 0, 0); } while (0)
#define G_LDA(dst, b, h) _Pragma("unroll") for (int m = 0; m < 4; ++m) _Pragma("unroll") for (int k = 0; k < 2; ++k) \
    dst[m][k] = *(const LAS bf16x8*)(G_SA(b, h) + lds_byte(wr * 64 + m * 16 + fr, k * 32 + fq * 8))
#define G_LDB(dst, b, h) _Pragma("unroll") for (int n = 0; n < 2; ++n) _Pragma("unroll") for (int k = 0; k < 2; ++k) \
    dst[n][k] = *(const LAS bf16x8*)(G_SB(b, h) + lds_byte(wc * 32 + n * 16 + fr, k * 32 + fq * 8))
#define G_MMA(ai, bj, At, Bx) do { __builtin_amdgcn_s_setprio(1); \
    _Pragma("unroll") for (int m = 0; m < 4; ++m) _Pragma("unroll") for (int n = 0; n < 2; ++n) _Pragma("unroll") for (int k = 0; k < 2; ++k) \
      acc[ai][bj][m][n] = __builtin_amdgcn_mfma_f32_16x16x32_bf16(At[m][k], Bx[n][k], acc[ai][bj][m][n], 0, 0, 0); \
    __builtin_amdgcn_s_setprio(0); } while (0)
#define WAIT_V(n) asm volatile("s_waitcnt vmcnt(" #n ")" ::: "memory")
#define WAIT_L(n) asm volatile("s_waitcnt lgkmcnt(" #n ")" ::: "memory")
#define BAR __builtin_amdgcn_s_barrier()
#define SCHED __builtin_amdgcn_sched_barrier(0)

DI void gemm256_core(const u16* __restrict__ A, const u16* __restrict__ Bt, int brow, int bcol, lchar* shm, int tid, f32x4 (&acc)[2][2][4][2]) {
  const int wid = tid >> 6, lane = tid & 63, wr = wid >> 2, wc = wid & 3, fr = lane & 15, fq = lane >> 4;
  int r0, c0, r1, c1;
  stage_rc(tid * 16, r0, c0); stage_rc(tid * 16 + 8192, r1, c1);
  const unsigned goff0 = (unsigned)(r0 * GK + c0) * 2u, goff1 = (unsigned)(r1 * GK + c1) * 2u;
#pragma unroll
  for (int ai = 0; ai < 2; ++ai)
#pragma unroll
    for (int bj = 0; bj < 2; ++bj)
#pragma unroll
      for (int m = 0; m < 4; ++m)
#pragma unroll
        for (int n = 0; n < 2; ++n) acc[ai][bj][m][n] = (f32x4){0.f, 0.f, 0.f, 0.f};
  bf16x8 At[4][2], B0[2][2], B1[2][2];
  const int nt = GK / 64;
  WAIT_V(0);
  __syncthreads();
  G_STAGE(G_SB(0, 0), Bt, bcol, 0); G_STAGE(G_SA(0, 0), A, brow, 0);
  G_STAGE(G_SB(0, 1), Bt, bcol + 128, 0); G_STAGE(G_SA(0, 1), A, brow + 128, 0);
  if (wr == 1) BAR;
  WAIT_V(4); BAR;
  G_STAGE(G_SB(1, 0), Bt, bcol, 1); G_STAGE(G_SA(1, 0), A, brow, 1); G_STAGE(G_SB(1, 1), Bt, bcol + 128, 1);
  WAIT_V(6); BAR;
  for (int t = 0; t < nt - 2; t += 2) {
    G_LDB(B0, 0, 0); SCHED; G_LDA(At, 0, 0); G_STAGE(G_SA(1, 1), A, brow + 128, t + 1);
    WAIT_L(8); BAR; WAIT_L(0); G_MMA(0, 0, At, B0); BAR; SCHED;
    G_LDB(B1, 0, 1); G_STAGE(G_SB(0, 0), Bt, bcol, t + 2);
    BAR; WAIT_L(0); G_MMA(0, 1, At, B1); BAR;
    G_LDA(At, 0, 1); G_STAGE(G_SA(0, 0), A, brow, t + 2);
    BAR; WAIT_L(0); G_MMA(1, 0, At, B0); BAR; SCHED;
    G_STAGE(G_SB(0, 1), Bt, bcol + 128, t + 2);
    WAIT_V(6); BAR; G_MMA(1, 1, At, B1); BAR;
    G_LDB(B0, 1, 0); SCHED; G_LDA(At, 1, 0); G_STAGE(G_SA(0, 1), A, brow + 128, t + 2);
    WAIT_L(8); BAR; WAIT_L(0); G_MMA(0, 0, At, B0); BAR; SCHED;
    G_LDB(B1, 1, 1); G_STAGE(G_SB(1, 0), Bt, bcol, t + 3);
    BAR; WAIT_L(0); G_MMA(0, 1, At, B1); BAR;
    G_LDA(At, 1, 1); G_STAGE(G_SA(1, 0), A, brow, t + 3);
    BAR; WAIT_L(0); G_MMA(1, 0, At, B0); BAR; SCHED;
    G_STAGE(G_SB(1, 1), Bt, bcol + 128, t + 3);
    WAIT_V(6); BAR; G_MMA(1, 1, At, B1); BAR;
  }
  { G_LDB(B0, 0, 0); G_LDA(At, 0, 0); G_STAGE(G_SA(1, 1), A, brow + 128, nt - 1);
    BAR; WAIT_L(0); G_MMA(0, 0, At, B0); BAR;
    G_LDB(B1, 0, 1); BAR; WAIT_L(0); G_MMA(0, 1, At, B1); BAR;
    G_LDA(At, 0, 1); WAIT_V(4); BAR; WAIT_L(0); G_MMA(1, 0, At, B0); G_MMA(1, 1, At, B1); BAR; }
  { G_LDB(B0, 1, 0); G_LDA(At, 1, 0); WAIT_V(2); BAR; WAIT_L(0); G_MMA(0, 0, At, B0); BAR;
    G_LDB(B1, 1, 1); WAIT_V(0); BAR; WAIT_L(0); G_MMA(0, 1, At, B1); BAR;
    G_LDA(At, 1, 1); BAR; WAIT_L(0); G_MMA(1, 0, At, B0); G_MMA(1, 1, At, B1); BAR; }
  if (wr == 0) BAR;
}

DI void gemm256_tile(const Params& p, int mode, int layer, const u16* R, const u16* Cc, int brow, int bcol, lchar* shm, int tid_in) {
  f32x4 acc[2][2][4][2];
  gemm256_core(R, Cc, brow, bcol, shm, tid_in, acc);
  int tid = tid_in;
  asm volatile("" : "+v"(tid));
  const int wid = tid >> 6, lane = tid & 63, wr = wid >> 2, wc = wid & 3, fr = lane & 15, fq = lane >> 4;
  if (mode == EPI_PROJ) {
#pragma unroll
    for (int ai = 0; ai < 2; ++ai)
#pragma unroll
      for (int bj = 0; bj < 2; ++bj)
#pragma unroll
        for (int m = 0; m < 4; ++m)
#pragma unroll
          for (int n = 0; n < 2; ++n) {
            const int nc = brow + ai * 128 + wr * 64 + m * 16 + fq * 4, tok = bcol + bj * 128 + wc * 32 + n * 16 + fr;
            const f32x4 v = acc[ai][bj][m][n];
            u32x2 o; o[0] = pack2(v[0], v[1]); o[1] = pack2(v[2], v[3]);
            *(u32x2*)(W_PROJ(p) + (size_t)tok * INC + nc) = o;
          }
  } else if (mode == EPI_VT) {
#pragma unroll
    for (int ai = 0; ai < 2; ++ai)
#pragma unroll
      for (int bj = 0; bj < 2; ++bj)
#pragma unroll
        for (int m = 0; m < 4; ++m)
#pragma unroll
          for (int n = 0; n < 2; ++n) {
            const int tok = brow + ai * 128 + wr * 64 + m * 16 + fq * 4, nn = bcol + bj * 128 + wc * 32 + n * 16 + fr - 1024;
            const int b = tok / LSEQ, pos = tok - b * LSEQ;
            const f32x4 v = acc[ai][bj][m][n];
            u32x2 o; o[0] = pack2(v[0], v[1]); o[1] = pack2(v[2], v[3]);
            *(u32x2*)(W_VT(p) + ((size_t)(b * 512 + nn)) * LP + pos) = o;
          }
  } else if (mode == EPI_OUT) {
#pragma unroll
    for (int ai = 0; ai < 2; ++ai)
#pragma unroll
      for (int bj = 0; bj < 2; ++bj) {
        u32x2 hv[4][2];
#pragma unroll
        for (int m = 0; m < 4; ++m)
#pragma unroll
          for (int n = 0; n < 2; ++n) {
            const int nc = brow + ai * 128 + wr * 64 + m * 16 + fq * 4, tok = bcol + bj * 128 + wc * 32 + n * 16 + fr;
            hv[m][n] = *(const u32x2*)(W_H(p) + (size_t)tok * DM + nc);
          }
#pragma unroll
        for (int m = 0; m < 4; ++m)
#pragma unroll
          for (int n = 0; n < 2; ++n) {
            const int nc = brow + ai * 128 + wr * 64 + m * 16 + fq * 4, tok = bcol + bj * 128 + wc * 32 + n * 16 + fr;
            const f32x4 v = acc[ai][bj][m][n];
            u32x2 o;
            o[0] = pack2(ALPHA * bflo(hv[m][n][0]) + v[0], ALPHA * bfhi(hv[m][n][0]) + v[1]);
            o[1] = pack2(ALPHA * bflo(hv[m][n][1]) + v[2], ALPHA * bfhi(hv[m][n][1]) + v[3]);
            *(u32x2*)(W_Y(p) + (size_t)tok * DM + nc) = o;
          }
      }
  } else {
    LAS float* S = (LAS float*)shm;
    const int tok = tid & 255, kh = tid >> 8;
    float L0[16], L1[16];
#pragma unroll
    for (int ai = 0; ai < 2; ++ai) {
      __syncthreads();
#pragma unroll
      for (int bj = 0; bj < 2; ++bj)
#pragma unroll
        for (int m = 0; m < 4; ++m)
#pragma unroll
          for (int n = 0; n < 2; ++n) {
            const int tk = bj * 128 + wc * 32 + n * 16 + fr, key = wr * 64 + m * 16 + fq * 4;
#pragma unroll
            for (int j = 0; j < 4; ++j) S[tk * 128 + ((key + j + tk) & 127)] = acc[ai][bj][m][n][j];
          }
      __syncthreads();
      float v[16];
#pragma unroll
      for (int j = 0; j < 16; ++j) v[j] = -3.0e38f;
      for (int i = 0; i < 64; ++i) {
        const int key = kh * 64 + i;
        const float x = S[tok * 128 + ((key + tok) & 127)];
        insert16(v, __uint_as_float((__float_as_uint(x) & ~127u) | (unsigned)key));
      }
      __syncthreads();
      if (kh == 1) {
#pragma unroll
        for (int j = 0; j < 16; ++j) S[tok * 16 + j] = v[j];
      }
      __syncthreads();
      if (kh == 0) {
#pragma unroll
        for (int j = 0; j < 16; ++j) insert16(v, S[tok * 16 + j]);
      }
#pragma unroll
      for (int j = 0; j < 16; ++j) { if (ai == 0) L0[j] = v[j]; else L1[j] = v[j]; }
    }
    __syncthreads();
    LAS unsigned* LL = (LAS unsigned*)shm;
    if (kh == 0) {
#pragma unroll
      for (int j = 0; j < 16; ++j) { LL[tok * 32 + ((j + tok) & 31)] = __float_as_uint(L0[j]); LL[tok * 32 + ((16 + j + tok) & 31)] = __float_as_uint(L1[j]); }
      float s1[16], s2[16], v[16];
#pragma unroll
      for (int j = 0; j < 16; ++j) { s1[j] = __uint_as_float(__float_as_uint(L0[j]) & ~127u); s2[j] = __uint_as_float(__float_as_uint(L1[j]) & ~127u); v[j] = -3.0e38f; }
#pragma unroll
      for (int a = 0; a < 16; ++a)
#pragma unroll
        for (int bb = 0; bb < 16 / (a + 1); ++bb) {
          const float sm = s1[a] + s2[bb];
          insert16(v, __uint_as_float((__float_as_uint(sm) & ~255u) | (unsigned)(a * 16 + bb)));
        }
      float e[16], sum = 0.f;
      const float mx = __uint_as_float(__float_as_uint(v[0]) & ~255u);
#pragma unroll
      for (int j = 0; j < 16; ++j) { e[j] = fast_exp2((__uint_as_float(__float_as_uint(v[j]) & ~255u) - mx) * LOG2E); sum += e[j]; }
      const float inv = 1.0f / sum;
      const int hd = brow >> 8;
      int* di = W_IDX(p) + (size_t)(bcol + tok) * 128 + hd * 16;
      float* dg = W_G(p) + (size_t)(bcol + tok) * 128 + hd * 16;
#pragma unroll
      for (int q = 0; q < 4; ++q) {
        u32x4 oi; f32x4 og;
#pragma unroll
        for (int k = 0; k < 4; ++k) {
          const unsigned code = __float_as_uint(v[4 * q + k]) & 255u;
          const unsigned i1 = LL[tok * 32 + (((code >> 4) + tok) & 31)] & 127u, i2 = LL[tok * 32 + ((16 + (code & 15u) + tok) & 31)] & 127u;
          oi[k] = i1 * 128u + i2; og[k] = e[4 * q + k] * inv;
        }
        *(u32x4*)(di + 4 * q) = oi; *(f32x4*)(dg + 4 * q) = og;
      }
    }
    __syncthreads();
  }
}

#define ATT_MISC 131072
DI void attn_item(const Params& p, int layer, int b, int hh, int jq, lchar* sm, float lam, float oml, int tid) {
  const int lane = tid & 63, w = tid >> 6, g = lane >> 4, l15 = lane & 15;
  const int idx32 = (lane ^ 32) << 2;
  LAS float* tab = (LAS float*)(sm + ATT_MISC);
  LAS float* sg = tab + 208;
  __syncthreads();
  if (tid < 208) {
    const int d = tid - 80;
    float tv = -1.0e30f;
    if (d >= 0) {
      int bucket = d;
      if (d >= 16) {
        int lg = 16 + (int)(logf((float)d * (1.0f / 16.0f)) / 2.0794415416798357f * 16.0f);
        bucket = lg < 31 ? lg : 31;
      }
      tv = P_REL_BIAS(p)[bucket * 4 + hh] * LOG2E;
    }
    tab[tid] = tv;
    if (tid < 128) sg[tid] = P_SUBLN_G(p)[layer * 128 + tid] * oml;
  }
  const int q0w = 128 * jq + 16 * w;
  const int qpos = q0w + l15;
  const int qrow = b * LSEQ + (qpos < LSEQ ? qpos : LSEQ - 1);
  bf16x8 qf[2][2];
  {
    const u16* qp = W_PROJ(p) + (size_t)qrow * INC + hh * 128 + g * 8;
#pragma unroll
    for (int m = 0; m < 2; ++m)
#pragma unroll
      for (int ks = 0; ks < 2; ++ks) qf[m][ks] = *(const bf16x8*)(qp + m * 64 + ks * 32);
  }
  const int nkt = (2 * jq + 2) < 33 ? (2 * jq + 2) : 33;
  const char* ksrc[2]; const char* vsrc[2];
#pragma unroll
  for (int i = 0; i < 2; ++i) {
    const int bk = 2 * w + i, k16 = bk >> 2, m = (bk >> 1) & 1, ks = bk & 1;
    const int krow = 32 * (k16 >> 1) + 8 * (l15 >> 2) + 4 * (k16 & 1) + (l15 & 3);
    ksrc[i] = (const char*)(W_PROJ(p) + (size_t)(b * LSEQ + krow) * INC + 512 + hh * 128 + m * 64 + ks * 32 + g * 8);
    const int dv = 8 * bk + (lane >> 3), c = (lane & 7) ^ ((dv >> 1) & 7);
    vsrc[i] = (const char*)(W_VT(p) + ((size_t)((b * 4 + hh) * 128 + dv)) * LP + c * 8);
  }
  lchar* dmak = sm + (2 * w) * 1024 + lane * 16;
#define ATT_ISSUE(KT, SLOT) do { const size_t _ko = (size_t)(KT) * (64 * INC * 2), _vo = (size_t)(KT) * 128; lchar* _d = dmak + (SLOT) * 32768; \
    __builtin_amdgcn_global_load_lds((const unsigned*)(ksrc[0] + _ko), (LAS unsigned*)(_d), 16, 0, 0); \
    __builtin_amdgcn_global_load_lds((const unsigned*)(ksrc[1] + _ko), (LAS unsigned*)(_d + 1024), 16, 0, 0); \
    __builtin_amdgcn_global_load_lds((const unsigned*)(vsrc[0] + _vo), (LAS unsigned*)(_d + 16384), 16, 0, 0); \
    __builtin_amdgcn_global_load_lds((const unsigned*)(vsrc[1] + _vo), (LAS unsigned*)(_d + 16384 + 1024), 16, 0, 0); } while (0)
  int voff[2];
#pragma unroll
  for (int kk = 0; kk < 2; ++kk) voff[kk] = l15 * 128 + (((4 * kk + g) ^ ((l15 >> 1) & 7)) * 16);

  f32x4 O[2][8];
#pragma unroll
  for (int m = 0; m < 2; ++m)
#pragma unroll
    for (int dt = 0; dt < 8; ++dt) O[m][dt] = (f32x4){0.f, 0.f, 0.f, 0.f};
  float mrun[2] = {-1.0e30f, -1.0e30f}, lsum[2] = {0.f, 0.f};

  WAIT_V(0);
  __syncthreads();
  const float tfar = tab[207];
  ATT_ISSUE(0, 0);
  ATT_ISSUE((1 < nkt ? 1 : nkt - 1), 1);
  for (int kt = 0; kt < nkt; ++kt) {
    { const int kn = (kt + 2 < nkt) ? kt + 2 : nkt - 1; ATT_ISSUE(kn, (kt + 2) & 3); }
    WAIT_V(8); BAR;
    if (64 * kt <= q0w + 15) {
      const lchar* kb = sm + (kt & 3) * 32768;
      const lchar* vb = kb + 16384;
      f32x4 S[2][4];
#pragma unroll
      for (int kh = 0; kh < 2; ++kh) {
        bf16x8 kf[2][2][2];
#pragma unroll
        for (int q = 0; q < 2; ++q)
#pragma unroll
          for (int m = 0; m < 2; ++m)
#pragma unroll
            for (int ks = 0; ks < 2; ++ks) kf[q][m][ks] = *(const LAS bf16x8*)(kb + ((((2 * kh + q) * 2 + m) * 2 + ks) * 1024) + lane * 16);
        SCHED;
#pragma unroll
        for (int q = 0; q < 2; ++q)
#pragma unroll
          for (int m = 0; m < 2; ++m) {
            f32x4 sacc = (f32x4){0.f, 0.f, 0.f, 0.f};
            sacc = mfma16(kf[q][m][0], qf[m][0], sacc);
            sacc = mfma16(kf[q][m][1], qf[m][1], sacc);
            S[m][2 * kh + q] = sacc;
          }
      }
      const bool near = (q0w - 64 * kt) < 176;
#pragma unroll
      for (int m = 0; m < 2; ++m)
#pragma unroll
        for (int k16 = 0; k16 < 4; ++k16)
#pragma unroll
          for (int r = 0; r < 4; ++r) {
            float sv = S[m][k16][r] * (0.125f * LOG2E);
            if (near) {
              const int di = qpos + 80 - (64 * kt + 32 * (k16 >> 1) + 8 * g + 4 * (k16 & 1) + r);
              sv += tab[di < 207 ? di : 207];
            } else {
              sv += tfar;
            }
            S[m][k16][r] = sv;
          }
      bf16x8 pb[2][2];
#pragma unroll
      for (int m = 0; m < 2; ++m) {
        float mx = -1.0e30f;
#pragma unroll
        for (int k16 = 0; k16 < 4; ++k16)
#pragma unroll
          for (int r = 0; r < 4; ++r) mx = fmaxf(mx, S[m][k16][r]);
        mx = fmaxf(mx, shx16(mx));
        mx = fmaxf(mx, shx32(mx, idx32));
        if (__builtin_amdgcn_ballot_w64(mx > mrun[m] + 8.0f) != 0ull) {
          const float mnew = fmaxf(mrun[m], mx);
          const float alpha = fast_exp2(mrun[m] - mnew);
          mrun[m] = mnew;
          lsum[m] *= alpha;
#pragma unroll
          for (int dt = 0; dt < 8; ++dt) { O[m][dt][0] *= alpha; O[m][dt][1] *= alpha; O[m][dt][2] *= alpha; O[m][dt][3] *= alpha; }
        }
        const float mref = mrun[m];
        float ps = 0.f;
#pragma unroll
        for (int k16 = 0; k16 < 4; ++k16)
#pragma unroll
          for (int r = 0; r < 4; ++r) { const float e = fast_exp2(S[m][k16][r] - mref); S[m][k16][r] = e; ps += e; }
        lsum[m] += ps;
#pragma unroll
        for (int kk = 0; kk < 2; ++kk) {
          u32x4 t;
          t[0] = pack2(S[m][2 * kk][0], S[m][2 * kk][1]); t[1] = pack2(S[m][2 * kk][2], S[m][2 * kk][3]);
          t[2] = pack2(S[m][2 * kk + 1][0], S[m][2 * kk + 1][1]); t[3] = pack2(S[m][2 * kk + 1][2], S[m][2 * kk + 1][3]);
          pb[m][kk] = __builtin_bit_cast(bf16x8, t);
        }
      }
#pragma unroll
      for (int kk = 0; kk < 2; ++kk) {
        bf16x8 vf[8];
#pragma unroll
        for (int dt = 0; dt < 8; ++dt) vf[dt] = *(const LAS bf16x8*)(vb + dt * 2048 + voff[kk]);
        SCHED;
#pragma unroll
        for (int dt = 0; dt < 8; ++dt) {
          O[0][dt] = mfma16(vf[dt], pb[0][kk], O[0][dt]);
          O[1][dt] = mfma16(vf[dt], pb[1][kk], O[1][dt]);
        }
      }
    }
  }
  WAIT_V(0);
#undef ATT_ISSUE
  float l0 = lsum[0], l1 = lsum[1];
  l0 += shx16(l0); l0 += shx32(l0, idx32);
  l1 += shx16(l1); l1 += shx32(l1, idx32);
  const float c1 = 1.0f / l0, c2 = lam / l1;
  float ss = 0.f;
#pragma unroll
  for (int dt = 0; dt < 8; ++dt)
#pragma unroll
    for (int r = 0; r < 4; ++r) { const float o = O[0][dt][r] * c1 - O[1][dt][r] * c2; O[0][dt][r] = o; ss += o * o; }
  ss += shx16(ss); ss += shx32(ss, idx32);
  const float rinv = rsqrtf(ss * (1.0f / 128.0f) + 1e-5f);
  if (qpos < LSEQ) {
    u16* dst = W_MIX(p) + (size_t)(b * LSEQ + qpos) * DM + hh * 128 + 4 * g;
#pragma unroll
    for (int dt = 0; dt < 8; ++dt) {
      const int dv0 = 16 * dt + 4 * g;
      u32x2 o;
      o[0] = pack2(O[0][dt][0] * rinv * sg[dv0 + 0], O[0][dt][1] * rinv * sg[dv0 + 1]);
      o[1] = pack2(O[0][dt][2] * rinv * sg[dv0 + 2], O[0][dt][3] * rinv * sg[dv0 + 3]);
      *(u32x2*)(dst + 16 * dt) = o;
    }
  }
}

DI void conv_item(const Params& p, int layer, int item, int tid) {
  const int ch = (tid & 63) * 8, t0 = item * 16 + 4 * (tid >> 6);
  const int pos0 = t0 % LSEQ;
  const bool head = pos0 == 0;
  const u16* row0 = W_PROJ(p) + (size_t)t0 * INC;
  u32x4 gc[6], zz[6], gb[4];
#pragma unroll
  for (int j = 0; j < 6; ++j) {
    const u16* r2 = row0 + (ptrdiff_t)((head && j < 2) ? 0 : (j - 2)) * INC;
    gc[j] = *(const u32x4*)(r2 + 2048 + ch); zz[j] = *(const u32x4*)(r2 + 2560 + ch);
  }
#pragma unroll
  for (int i = 0; i < 4; ++i) gb[i] = *(const u32x4*)(row0 + (size_t)i * INC + 1536 + ch);
  const float* cw = P_CONV_W(p) + (size_t)layer * 3 * 512 + ch;
  float w0[8], w1[8], w2[8];
#pragma unroll
  for (int e = 0; e < 8; ++e) { w0[e] = cw[e]; w1[e] = cw[512 + e]; w2[e] = cw[1024 + e]; }
  float pr[6][8];
#pragma unroll
  for (int j = 0; j < 6; ++j) {
    const float keep = (head && j < 2) ? 0.f : 1.f;
#pragma unroll
    for (int e = 0; e < 4; ++e) { pr[j][2 * e] = keep * bflo(gc[j][e]) * bflo(zz[j][e]); pr[j][2 * e + 1] = keep * bfhi(gc[j][e]) * bfhi(zz[j][e]); }
  }
#pragma unroll
  for (int i = 0; i < 4; ++i) {
    u32x4 o;
#pragma unroll
    for (int e = 0; e < 4; ++e) {
      const float a0 = w0[2 * e] * pr[i][2 * e] + w1[2 * e] * pr[i + 1][2 * e] + w2[2 * e] * pr[i + 2][2 * e];
      const float a1 = w0[2 * e + 1] * pr[i][2 * e + 1] + w1[2 * e + 1] * pr[i + 1][2 * e + 1] + w2[2 * e + 1] * pr[i + 2][2 * e + 1];
      o[e] = pack2(bflo(gb[i][e]) * a0, bfhi(gb[i][e]) * a1);
    }
    *(u32x4*)(W_MIX(p) + (size_t)(t0 + i) * DM + 512 + ch) = o;
  }
}

DI void phase_prologue(const Params& p, char* smem, int wave) {
  const int tid = otid_w(wave), lane = tid & 63, wid = tid >> 6, hb = tid >> 8, htid = tid & 255;
  const int nblk = gridDim.x, bid = blockIdx.x;
  const size_t gtid = (size_t)bid * NTHREADS + tid, gthreads = (size_t)nblk * NTHREADS;
  float* sm = (float*)(smem + hb * LDS_HALF);
  for (int it0 = bid; it0 < 2048; it0 += nblk) {
    const int it = it0 * 2 + hb;
    if (it < 3072) {
      const int l = it / 768, r = it % 768, kb = r / 48, nb = r % 48;
      transpose_tile(P_W_IN(p) + (size_t)l * 1024 * 3072, 3072, W_WIN(p) + (size_t)l * 3072 * 1024, 1024, kb * 64, nb * 64, sm, htid);
    } else {
      const int i2 = it - 3072, l = i2 / 256, r = i2 % 256, kb = r / 16, nb = r % 16;
      transpose_tile(P_W_OUT(p) + (size_t)l * 1024 * 1024, 1024, W_WOUT(p) + (size_t)l * 1024 * 1024, 1024, kb * 64, nb * 64, sm, htid);
    }
  }
  convert_straight(P_W_Q(p), W_WQB(p), (size_t)4 * 1024 * 2048 / 8, gtid, gthreads);
  convert_straight(P_SUB_KEYS(p), W_SKB(p), (size_t)4 * 16 * 128 * 128 / 8, gtid, gthreads);
  for (int t = bid * 8 + wid; t < TTOK; t += nblk * 8) {
    const int b = t / LSEQ, pos = t - b * LSEQ;
    const float* src = pos < NMETA ? P_META(p) + (size_t)pos * DM : P_X(p) + ((size_t)b * SEQ + pos - NMETA) * DM;
    float v[16];
    load_row_f32<0>(src, v, lane);
    ln_row<0>(v, P_LN_IN_G(p), P_LN_IN_B(p), lane);
    store_row_bf16<0>(W_H(p) + (size_t)t * DM, v, lane);
  }
}

DI void phase_fold(const Params& p, char* smem, int wave) {
  const int tid = otid_w(wave), hb = tid >> 8, htid = tid & 255;
  for (int it0 = blockIdx.x; it0 < 256; it0 += gridDim.x) {
    const int it = it0 * 2 + hb;
    const int l = it >> 7, hp = (it >> 3) & 15, mt = it & 7;
    gemm_tile_fold(W_WQB(p) + (size_t)l * 1024 * 2048 + hp * 128, 2048, W_SKB(p) + ((size_t)l * 16 + hp) * 128 * 128, 128, 128, mt * 128, smem + hb * 65536,
                   W_WSC(p) + (size_t)l * 2048 * 1024 + (size_t)hp * 128 * 1024, htid);
  }
}

DI bool tile_order(int i, int nM, int nN, int& pm, int& pn) {
  const int nwg = nM * nN;
  const long L = (long)i * gridDim.x + blockIdx.x;
  if (L >= nwg) return false;
  int wgid = (int)L;
  { const int q = nwg / 8, r = nwg % 8, xcd = wgid % 8, off = wgid / 8; wgid = (xcd < r ? xcd * (q + 1) : r * (q + 1) + (xcd - r) * q) + off; }
  const int nig = 8 * nN, gid = wgid / nig, fm = gid * 8, gsz = (nM - fm) < 8 ? (nM - fm) : 8;
  pm = fm + ((wgid % nig) % gsz); pn = (wgid % nig) / gsz;
  return true;
}

DI void phase_gemm(const Params& p, int layer, int which, char* smem, int wave) {
  const int tid0 = otid_w(wave);
  const u16* W = which == 0 ? W_WIN(p) + (size_t)layer * 3072 * 1024 : (which == 1 ? W_WOUT(p) + (size_t)layer * 1024 * 1024 : W_WSC(p) + (size_t)layer * 2048 * 1024);
  const u16* X = which == 1 ? W_MIX(p) : W_H(p);
  const int nN = which == 0 ? 12 : (which == 1 ? 4 : 8);
  int pm, pn;
  for (int i = 0; tile_order(i, 258, nN, pm, pn); ++i) {
    const bool vt = (which == 0) && (pn == 4 || pn == 5);
    const int mode = which == 0 ? (vt ? EPI_VT : EPI_PROJ) : (which == 1 ? EPI_OUT : EPI_TOPK);
    int tid = tid0;
    asm volatile("" : "+v"(tid));
    gemm256_tile(p, mode, layer, vt ? X : W, vt ? W : X, vt ? pm * 256 : pn * 256, vt ? pn * 256 : pm * 256, (lchar*)smem, tid);
  }
}

DI void phase_attn(const Params& p, int layer, char* smem, int wave) {
  const int tid = otid_w(wave), lane = tid & 63, hb = tid >> 8, htid = tid & 255;
  const float lam_init = 0.8f - 0.6f * expf(-0.3f * (float)layer);
  float d1 = P_LQ1(p)[layer * 64 + lane] * P_LK1(p)[layer * 64 + lane], d2 = P_LQ2(p)[layer * 64 + lane] * P_LK2(p)[layer * 64 + lane];
  d1 = wave_sum(d1); d2 = wave_sum(d2);
  const float lam = expf(d1) - expf(d2) + lam_init;
  for (int rd = 0; rd * (int)gridDim.x < 2176; ++rd) {
    const int o = rd * gridDim.x + ((rd & 1) ? (int)gridDim.x - 1 - (int)blockIdx.x : (int)blockIdx.x);
    if (o < 2176) { const int jq = 16 - (o >> 7), bh = o & 127; attn_item(p, layer, bh >> 2, bh & 3, jq, (lchar*)smem, lam, 1.0f - lam_init, tid); }
  }
  for (int it = blockIdx.x; it < 2064; it += gridDim.x) conv_item(p, layer, it * 2 + hb, htid);
}

DI void phase_ln(const Params& p, int layer, int which, int wave) {
  const int tid = otid_w(wave), lane = tid & 63, wid = tid >> 6;
  const int nblk = gridDim.x, bid = blockIdx.x;
  const float* lg = (which ? P_LN2_G(p) : P_LN1_G(p)) + layer * DM;
  const float* lb = (which ? P_LN2_B(p) : P_LN1_B(p)) + layer * DM;
  const bool final_out = which && (layer == DEPTH - 1);
  for (int t = bid * 8 + wid; t < TTOK; t += nblk * 8) {
    float v[16];
    load_row_bf16<0>(W_Y(p) + (size_t)t * DM, v, lane);
    ln_row<0>(v, lg, lb, lane);
    if (final_out) {
      const int b = t / LSEQ, pos = t - b * LSEQ;
      if (pos >= NMETA) {
        float* dst = p.out + ((size_t)b * SEQ + pos - NMETA) * DM;
#pragma unroll
        for (int hh = 0; hh < 2; ++hh) {
          *(f32x4*)(dst + hh * 512 + 8 * lane) = (f32x4){v[hh * 8], v[hh * 8 + 1], v[hh * 8 + 2], v[hh * 8 + 3]};
          *(f32x4*)(dst + hh * 512 + 8 * lane + 4) = (f32x4){v[hh * 8 + 4], v[hh * 8 + 5], v[hh * 8 + 6], v[hh * 8 + 7]};
        }
      }
    } else {
      store_row_bf16<0>(W_H(p) + (size_t)t * DM, v, lane);
    }
  }
  if (which) return;
  for (int r = bid * 8 + wid; r < 2 * PEER_N; r += nblk * 8) {
    const bool isv = r >= PEER_N;
    const int e = isv ? r - PEER_N : r;
    const float* src = (isv ? P_PEER_V(p) : P_PEER_U(p)) + ((size_t)layer * PEER_N + e) * DM + 16 * lane;
    f32x4 a[4];
#pragma unroll
    for (int k = 0; k < 4; ++k) a[k] = *(const f32x4*)(src + 4 * k);
    float am = 0.f;
#pragma unroll
    for (int k = 0; k < 4; ++k) am = fmaxf(am, fmaxf(fmaxf(fabsf(a[k][0]), fabsf(a[k][1])), fmaxf(fabsf(a[k][2]), fabsf(a[k][3]))));
    am = wave_max_nonneg(am);
    const float top = isv ? 224.0f : 127.0f;
    const float sc = am > 0.f ? top / am : 1.0f;
    if (lane == 0) (isv ? W_SV(p) : W_SU(p))[e] = am > 0.f ? am / top : 1.0f;
    u32x4 o;
#pragma unroll
    for (int k = 0; k < 4; ++k) {
      if (isv) {
        int w = 0;
        w = __builtin_amdgcn_cvt_pk_fp8_f32(a[k][0] * sc, a[k][1] * sc, w, false);
        w = __builtin_amdgcn_cvt_pk_fp8_f32(a[k][2] * sc, a[k][3] * sc, w, true);
        o[k] = (unsigned)w;
      } else {
        const int q0 = __float2int_rn(a[k][0] * sc), q1 = __float2int_rn(a[k][1] * sc), q2 = __float2int_rn(a[k][2] * sc), q3 = __float2int_rn(a[k][3] * sc);
        o[k] = ((unsigned)q0 & 255u) | (((unsigned)q1 & 255u) << 8) | (((unsigned)q2 & 255u) << 16) | ((unsigned)q3 << 24);
      }
    }
    *(u32x4*)((isv ? W_VB(p) : W_UB(p)) + (size_t)(lane >> 3) * (PEER_N * 128) + (size_t)e * 128 + 16 * (lane & 7)) = o;
  }
}

#define DPP_F(v, ctrl) __int_as_float(__builtin_amdgcn_update_dpp(0, __float_as_int(v), (ctrl), 0xf, 0xf, true))
#define PEER_META(T, IA, IB, HA, HB) do { const int _t = (T) < TTOK ? (T) : wslot; \
    IA = W_IDX(p)[(size_t)_t * 128 + lane]; IB = W_IDX(p)[(size_t)_t * 128 + 64 + lane]; \
    const u16* _hp = W_H(p) + (size_t)_t * DM + x * 128 + 16 * c; HA = *(const u32x4*)(_hp); HB = *(const u32x4*)(_hp + 8); } while (0)
#define PEER_GATHER(TAB, IA, IB, RR) do { _Pragma("unroll") for (int g = 0; g < 16; ++g) { \
    const int _e = __builtin_amdgcn_ds_bpermute(bp0 + 32 * (g & 7), g < 8 ? IA : IB); RR[g] = *(const u32x4*)((TAB) + (size_t)_e * 128); } } while (0)
#define PEER_UNPACK(XS, HA, HB) do { _Pragma("unroll") for (int e = 0; e < 4; ++e) { \
    XS[e] = (f32x2){bflo(HA[e]), bfhi(HA[e])}; XS[4 + e] = (f32x2){bflo(HB[e]), bfhi(HB[e])}; } } while (0)

#define DPP_I(v, ctrl) __builtin_amdgcn_update_dpp(0, (v), (ctrl), 0xf, 0xf, true)
DI void phase_peer_dots(const Params& p, int layer, int wave) {
  const int tid = otid_w(wave), lane = tid & 63, wid = tid >> 6, c = lane & 7, r = lane >> 3;
  const int x = blockIdx.x & 7, wslot = (blockIdx.x >> 3) * 8 + wid, nslot = (gridDim.x >> 3) * 8;
  const unsigned char* ub = W_UB(p) + (size_t)x * (PEER_N * 128) + c * 16;
  u16* pd = W_Y(p);
  const int bp0 = 4 * r;
  int iAa, iBa, iAb, iBb;
  u32x4 hAa, hBa, hAb, hBb, rrA[16], rrB[16];
  int xq[4];
  float xscale;
#define DOTS_QUANT(HA, HB) do { float _xv[16]; \
    _Pragma("unroll") for (int e = 0; e < 4; ++e) { _xv[2 * e] = bflo(HA[e]); _xv[2 * e + 1] = bfhi(HA[e]); _xv[8 + 2 * e] = bflo(HB[e]); _xv[8 + 2 * e + 1] = bfhi(HB[e]); } \
    float _am = 0.f; _Pragma("unroll") for (int e = 0; e < 16; ++e) _am = fmaxf(_am, fabsf(_xv[e])); \
    _am = DPP_MAX(_am, 0xB1); _am = DPP_MAX(_am, 0x4E); _am = DPP_MAX(_am, 0x141); \
    const float _qs = _am > 0.f ? 127.0f / _am : 0.f; xscale = _am * (1.0f / 127.0f); \
    _Pragma("unroll") for (int k = 0; k < 4; ++k) { \
      const int q0 = __float2int_rn(_xv[4 * k] * _qs), q1 = __float2int_rn(_xv[4 * k + 1] * _qs), q2 = __float2int_rn(_xv[4 * k + 2] * _qs), q3 = __float2int_rn(_xv[4 * k + 3] * _qs); \
      xq[k] = (int)(((unsigned)q0 & 255u) | (((unsigned)q1 & 255u) << 8) | (((unsigned)q2 & 255u) << 16) | ((unsigned)q3 << 24)); } } while (0)
#define DOTS_COMPUTE(T, RR) do { if ((T) < TTOK) { int pA = 0, pB = 0; \
    _Pragma("unroll") for (int g = 0; g < 16; ++g) { int d = 0; \
      _Pragma("unroll") for (int k = 0; k < 4; ++k) d = __builtin_amdgcn_sdot4((int)RR[g][k], xq[k], d, false); \
      d += DPP_I(d, 0xB1); d += DPP_I(d, 0x4E); d += DPP_I(d, 0x141); \
      if (c == (g & 7)) { if (g < 8) pA = d; else pB = d; } } \
    u16* _dst = pd + ((size_t)(T) * 8 + x) * 128 + 8 * c + r; \
    _dst[0] = (u16)(pack2((float)pA * xscale, 0.f) & 0xffffu); _dst[64] = (u16)(pack2((float)pB * xscale, 0.f) & 0xffffu); } } while (0)
  int t = wslot;
  PEER_META(t, iAa, iBa, hAa, hBa);
  PEER_META(t + nslot, iAb, iBb, hAb, hBb);
  PEER_GATHER(ub, iAa, iBa, rrA);
  for (; t < TTOK; t += 2 * nslot) {
    DOTS_QUANT(hAa, hBa);
    PEER_META(t + 2 * nslot, iAa, iBa, hAa, hBa);
    PEER_GATHER(ub, iAb, iBb, rrB);
    DOTS_COMPUTE(t, rrA);
    DOTS_QUANT(hAb, hBb);
    PEER_META(t + 3 * nslot, iAb, iBb, hAb, hBb);
    PEER_GATHER(ub, iAa, iBa, rrA);
    DOTS_COMPUTE(t + nslot, rrB);
  }
#undef DOTS_COMPUTE
#undef DOTS_QUANT
}

DI void phase_peer_w(const Params& p, int layer, int wave) {
  const int tid = otid_w(wave), lane = tid & 63, wid = tid >> 6;
  const u16* pd = W_Y(p);
  for (int t = blockIdx.x * 8 + wid; t < TTOK; t += gridDim.x * 8) {
#pragma unroll
    for (int hf = 0; hf < 2; ++hf) {
      const int j = hf * 64 + lane;
      float sacc = 0.f;
#pragma unroll
      for (int xx = 0; xx < 8; ++xx) sacc += __uint_as_float(((unsigned)pd[((size_t)t * 8 + xx) * 128 + j]) << 16);
      const int e = W_IDX(p)[(size_t)t * 128 + j];
      const float act = sacc * W_SU(p)[e];
      W_G(p)[(size_t)t * 128 + j] = W_G(p)[(size_t)t * 128 + j] * (0.5f * act * (1.0f + erff(act * 0.7071067811865476f))) * W_SV(p)[e];
    }
  }
}

#define PEER_META_V(T, IA, IB, WA, WB, HA, HB) do { const int _t = (T) < TTOK ? (T) : wslot; \
    IA = W_IDX(p)[(size_t)_t * 128 + lane]; IB = W_IDX(p)[(size_t)_t * 128 + 64 + lane]; \
    WA = W_G(p)[(size_t)_t * 128 + lane]; WB = W_G(p)[(size_t)_t * 128 + 64 + lane]; \
    const u16* _hp = W_H(p) + (size_t)_t * DM + x * 128 + 16 * c; HA = *(const u32x4*)(_hp); HB = *(const u32x4*)(_hp + 8); } while (0)
DI void phase_peer_v(const Params& p, int layer, int wave) {
  const int tid = otid_w(wave), lane = tid & 63, wid = tid >> 6, c = lane & 7, r = lane >> 3;
  const int x = blockIdx.x & 7, wslot = (blockIdx.x >> 3) * 8 + wid, nslot = (gridDim.x >> 3) * 8;
  const unsigned char* vb = W_VB(p) + (size_t)x * (PEER_N * 128) + c * 16;
  u16* y2 = W_Y(p);
  const int bp0 = 4 * r, idx32 = (lane ^ 32) << 2;
  int iAa, iBa, iAb, iBb;
  float wAa, wBa, wAb, wBb, wA, wB;
  u32x4 hAa, hBa, hAb, hBb, rrA[16], rrB[16];
  f32x2 xs[8];
#define V_COMPUTE(T, RR) do { if ((T) < TTOK) { f32x2 acc[8]; \
    _Pragma("unroll") for (int i = 0; i < 8; ++i) acc[i] = (f32x2){0.f, 0.f}; \
    _Pragma("unroll") for (int g = 0; g < 16; ++g) { \
      const float wj = __int_as_float(__builtin_amdgcn_ds_bpermute(bp0 + 32 * (g & 7), __float_as_int(g < 8 ? wA : wB))); \
      const f32x2 wj2 = (f32x2){wj, wj}; \
      _Pragma("unroll") for (int k = 0; k < 4; ++k) { \
        const f32x2 lo = __builtin_amdgcn_cvt_pk_f32_fp8((int)RR[g][k], false), hi = __builtin_amdgcn_cvt_pk_f32_fp8((int)RR[g][k], true); \
        acc[2 * k] += wj2 * lo; acc[2 * k + 1] += wj2 * hi; } } \
    _Pragma("unroll") for (int i = 0; i < 8; ++i) { _Pragma("unroll") for (int q = 0; q < 2; ++q) { \
        float v = acc[i][q]; v += DPP_F(v, 0x128); v += shx16(v); v += shx32(v, idx32); acc[i][q] = v; } } \
    if (r == 0) { u16* _dst = y2 + (size_t)(T) * DM + x * 128 + 16 * c; \
      _Pragma("unroll") for (int q = 0; q < 2; ++q) { u32x4 _o; \
        _Pragma("unroll") for (int e = 0; e < 4; ++e) _o[e] = pack2(ALPHA * xs[4 * q + e][0] + acc[4 * q + e][0], ALPHA * xs[4 * q + e][1] + acc[4 * q + e][1]); \
        *(u32x4*)(_dst + 8 * q) = _o; } } } } while (0)
  int t = wslot;
  PEER_META_V(t, iAa, iBa, wAa, wBa, hAa, hBa);
  PEER_META_V(t + nslot, iAb, iBb, wAb, wBb, hAb, hBb);
  PEER_GATHER(vb, iAa, iBa, rrA);
  for (; t < TTOK; t += 2 * nslot) {
    PEER_UNPACK(xs, hAa, hBa); wA = wAa; wB = wBa;
    PEER_META_V(t + 2 * nslot, iAa, iBa, wAa, wBa, hAa, hBa);
    PEER_GATHER(vb, iAb, iBb, rrB);
    V_COMPUTE(t, rrA);
    PEER_UNPACK(xs, hAb, hBb); wA = wAb; wB = wBb;
    PEER_META_V(t + 3 * nslot, iAb, iBb, wAb, wBb, hAb, hBb);
    PEER_GATHER(vb, iAa, iBa, rrA);
    V_COMPUTE(t + nslot, rrB);
  }
#undef V_COMPUTE
}

#define XB_TMO      128
#define XB_XCNT(j)  (256  + 64 * (j))
#define XB_XSUB(j)  (1280 + 64 * (j))
#define XB_XGEN(j)  (2304 + 64 * (j))
#define XB_TOP      3328
#define XB_TOPGEN   3392
#define XCD_BAR_WORDS 3456
#define XB_SPIN_CAP (1u << 22)
DI unsigned xb_ld(unsigned* p)              { return __hip_atomic_load(p, __ATOMIC_RELAXED, __HIP_MEMORY_SCOPE_AGENT); }
DI unsigned xb_add(unsigned* p, unsigned v) { return __hip_atomic_fetch_add(p, v, __ATOMIC_RELAXED, __HIP_MEMORY_SCOPE_AGENT); }
DI unsigned xb_xcc_id() { return (unsigned)__builtin_amdgcn_s_getreg((3 << 11) | 20) & 0xFu; }
#define XB_SPIN(cond, bar) do { unsigned _sp = 0; while (cond) { __builtin_amdgcn_s_sleep(1); \
    if ((++_sp & 255u) == 0u) { if (xb_ld(&(bar)[XB_TMO])) break; if (_sp > XB_SPIN_CAP) { atomicAdd(&(bar)[XB_TMO], 1u); break; } } } } while (0)
DI bool is_thread0(int wave) { unsigned z = 0u; asm volatile("" : "+v"(z)); return wave == 0 && __builtin_amdgcn_mbcnt_hi(~0u, __builtin_amdgcn_mbcnt_lo(~0u, z)) == 0u; }
DI void xcd_barrier_complete(unsigned* bar, unsigned x, unsigned& nloc, unsigned& nx) {
  const unsigned G = gridDim.x;
  unsigned sum, cnt, mine, sp = 0u;
  for (;;) {
    sum = 0u; cnt = 0u; mine = 0u;
#pragma unroll
    for (unsigned j = 0; j < 16; ++j) { const unsigned c = xb_ld(&bar[XB_XCNT(j)]); sum += c; cnt += (c > 0u) ? 1u : 0u; mine = (j == x) ? c : mine; }
    if (sum == G) break;
    __builtin_amdgcn_s_sleep(1);
    if ((++sp & 255u) == 0u) { if (xb_ld(&bar[XB_TMO])) break; if (sp > XB_SPIN_CAP) { atomicAdd(&bar[XB_TMO], 1u); break; } }
  }
  nloc = mine > 0u ? mine : 1u; nx = cnt > 0u ? cnt : 1u;
}
DI void xcd_barrier(unsigned* bar, volatile LAS unsigned* st, int wave) {
  asm volatile("s_waitcnt vmcnt(0)" ::: "memory");
  __syncthreads();
  if (is_thread0(wave)) {
    const unsigned x = xb_xcc_id();
    __builtin_amdgcn_s_waitcnt(0);
    unsigned nloc = st[0], nx = st[1];
    if (nloc == 0u) { xcd_barrier_complete(bar, x, nloc, nx); st[0] = nloc; st[1] = nx; }
    const unsigned old = xb_add(&bar[XB_XSUB(x)], 1u);
    const unsigned gen = old / nloc;
    if (old + 1u == (gen + 1u) * nloc) {
      __builtin_amdgcn_fence(__ATOMIC_RELEASE, "agent");
      asm volatile("s_waitcnt vmcnt(0)" ::: "memory");
      const unsigned og = xb_add(&bar[XB_TOP], 1u);
      const unsigned tg = og / nx;
      if (og + 1u == (tg + 1u) * nx) xb_add(&bar[XB_TOPGEN], 1u);
      else XB_SPIN(xb_ld(&bar[XB_TOPGEN]) == tg, bar);
      __builtin_amdgcn_fence(__ATOMIC_ACQUIRE, "agent");
      xb_add(&bar[XB_XGEN(x)], 1u);
      asm volatile("s_waitcnt vmcnt(0)" ::: "memory");
    } else {
      XB_SPIN(xb_ld(&bar[XB_XGEN(x)]) == gen, bar);
      __builtin_amdgcn_fence(__ATOMIC_ACQUIRE, "agent");
      asm volatile("s_waitcnt vmcnt(0)" ::: "memory");
    }
  }
  __syncthreads();
}

__global__ void __launch_bounds__(NTHREADS, 2) mega(Params p) {
  extern __shared__ __attribute__((aligned(16))) char smem[];
  cg::grid_group grid = cg::this_grid();
  const int wave = __builtin_amdgcn_readfirstlane((int)(threadIdx.x >> 6));
  unsigned* bar = (unsigned*)(p.ws + WS_BAR);
  volatile LAS unsigned* st = (volatile LAS unsigned*)((lchar*)smem + LDS_XB);
  if (threadIdx.x == 0) { st[0] = 0u; st[1] = 0u; (void)xb_add(&bar[XB_XCNT(xb_xcc_id())], 1u); }
  __syncthreads();
  phase_prologue(p, smem, wave);
  grid.sync();
  phase_fold(p, smem, wave);
  xcd_barrier(bar, st, wave);
#pragma unroll 1
  for (int step = 0; step < DEPTH * 9; ++step) {
    const int layer = step / 9, ph = step - layer * 9;
    if (ph == 0 || ph == 2 || ph == 4) phase_gemm(p, layer, ph >> 1, smem, wave);
    else if (ph == 1) phase_attn(p, layer, smem, wave);
    else if (ph == 3 || ph == 8) phase_ln(p, layer, ph == 8, wave);
    else if (ph == 5) phase_peer_dots(p, layer, wave);
    else if (ph == 6) phase_peer_w(p, layer, wave);
    else phase_peer_v(p, layer, wave);
    if (step + 1 < DEPTH * 9) xcd_barrier(bar, st, wave);
  }
}

extern "C" void kernel_launch(void* const* d_in, const int* in_sizes, int n_in, void* d_out, int out_size, void* d_ws, size_t ws_size,
                              hipStream_t stream) {
  static int grid_blocks = 0;
  if (grid_blocks == 0) {
    if (ws_size < WS_END) { fprintf(stderr, "kernel_launch: workspace too small: need %zu, got %zu\n", (size_t)WS_END, ws_size); grid_blocks = -1; return; }
    int dev = 0, cus = 0, per_cu = 0;
    hipGetDevice(&dev);
    hipDeviceGetAttribute(&cus, hipDeviceAttributeMultiprocessorCount, dev);
    hipFuncSetAttribute((const void*)mega, hipFuncAttributeMaxDynamicSharedMemorySize, LDS_BYTES);
    hipOccupancyMaxActiveBlocksPerMultiprocessor(&per_cu, (const void*)mega, NTHREADS, LDS_BYTES);
    if (per_cu < 1) per_cu = 1;
    if (per_cu > 1) per_cu = 1;
    grid_blocks = cus * per_cu;
  }
  if (grid_blocks < 0) return;
  Params p{};
  for (int i = 0; i < 21; ++i) p.in[i] = (const float*)d_in[i];
  p.out = (float*)d_out;
  p.ws = (char*)d_ws;
  if (hipMemsetAsync((char*)d_ws + WS_BAR, 0, 16384, stream) != hipSuccess) { fprintf(stderr, "kernel_launch: memset of the barrier words failed\n"); return; }
  void* args[] = {&p};
  hipError_t e = hipLaunchCooperativeKernel((const void*)mega, dim3(grid_blocks), dim3(NTHREADS), args, LDS_BYTES, stream);
  if (e != hipSuccess) fprintf(stderr, "cooperative launch failed: %s (grid %d)\n", hipGetErrorString(e), grid_blocks);
}
```

```cpp
#include <hip/hip_runtime.h>
#include <hip/hip_cooperative_groups.h>
#include <cstdio>
#include <cstdint>
namespace cg = cooperative_groups;

typedef unsigned short u16;
typedef __attribute__((ext_vector_type(8))) short bf16x8;
typedef __attribute__((ext_vector_type(4))) float f32x4;
typedef __attribute__((ext_vector_type(4))) unsigned u32x4;
typedef __attribute__((ext_vector_type(2))) unsigned u32x2;
typedef __attribute__((ext_vector_type(2))) float f32x2;
#define DI __device__ __forceinline__
#define LAS __attribute__((address_space(3)))
typedef LAS char lchar;

#define DM 1024
#define NBATCH 32
#define SEQ 2048
#define NMETA 16
#define LSEQ 2064
#define TTOK 66048
#define DEPTH 4
#define INC 3072
#define LP 2112
#define PEER_N 16384
#define NTHREADS 512
#define LDS_MISC 69632
#define LDS_HALF 70656
#define LDS_XB 141312
#define LDS_BYTES 141328

#define ALPHA 1.681792830507429f
#define LOG2E 1.4426950408889634f

static constexpr size_t WS_WIN  = 0;
static constexpr size_t WS_WOUT = WS_WIN  + (size_t)4 * 3072 * 1024 * 2;
static constexpr size_t WS_WQB  = WS_WOUT + (size_t)4 * 1024 * 1024 * 2;
static constexpr size_t WS_SKB  = WS_WQB  + (size_t)4 * 1024 * 2048 * 2;
static constexpr size_t WS_WSC  = WS_SKB  + (size_t)4 * 16 * 128 * 128 * 2;
static constexpr size_t WS_UB   = WS_WSC  + (size_t)4 * 2048 * 1024 * 2;
static constexpr size_t WS_VB   = WS_UB   + (size_t)PEER_N * 1024;
static constexpr size_t WS_SU   = WS_VB   + (size_t)PEER_N * 1024;
static constexpr size_t WS_SV   = WS_SU   + (size_t)PEER_N * 4;
static constexpr size_t WS_H    = WS_SV   + (size_t)PEER_N * 4;
static constexpr size_t WS_MIX  = WS_H    + (size_t)TTOK * 1024 * 2;
static constexpr size_t WS_BIG  = WS_MIX  + (size_t)TTOK * 1024 * 2;
static constexpr size_t WS_VT   = WS_BIG  + (size_t)(TTOK + 64) * 3072 * 2;
static constexpr size_t WS_IDX  = WS_VT   + (size_t)NBATCH * 4 * 128 * LP * 2;
static constexpr size_t WS_G    = WS_IDX  + (size_t)TTOK * 128 * 4;
static constexpr size_t WS_BAR  = WS_G    + (size_t)TTOK * 128 * 4;
static constexpr size_t WS_END  = WS_BAR  + 16384;

struct Params {
  const float* in[21];
  float* out;
  char* ws;
};
#define P_X(p) ((p).in[0])
#define P_META(p) ((p).in[1])
#define P_LN_IN_G(p) ((p).in[2])
#define P_LN_IN_B(p) ((p).in[3])
#define P_REL_BIAS(p) ((p).in[4])
#define P_W_IN(p) ((p).in[5])
#define P_CONV_W(p) ((p).in[6])
#define P_LQ1(p) ((p).in[7])
#define P_LK1(p) ((p).in[8])
#define P_LQ2(p) ((p).in[9])
#define P_LK2(p) ((p).in[10])
#define P_SUBLN_G(p) ((p).in[11])
#define P_W_OUT(p) ((p).in[12])
#define P_LN1_G(p) ((p).in[13])
#define P_LN1_B(p) ((p).in[14])
#define P_W_Q(p) ((p).in[15])
#define P_SUB_KEYS(p) ((p).in[16])
#define P_PEER_U(p) ((p).in[17])
#define P_PEER_V(p) ((p).in[18])
#define P_LN2_G(p) ((p).in[19])
#define P_LN2_B(p) ((p).in[20])
#define W_WIN(p) ((u16*)((p).ws + WS_WIN))
#define W_WOUT(p) ((u16*)((p).ws + WS_WOUT))
#define W_WQB(p) ((u16*)((p).ws + WS_WQB))
#define W_SKB(p) ((u16*)((p).ws + WS_SKB))
#define W_WSC(p) ((u16*)((p).ws + WS_WSC))
#define W_UB(p) ((unsigned char*)((p).ws + WS_UB))
#define W_VB(p) ((unsigned char*)((p).ws + WS_VB))
#define W_SU(p) ((float*)((p).ws + WS_SU))
#define W_SV(p) ((float*)((p).ws + WS_SV))
#define W_H(p) ((u16*)((p).ws + WS_H))
#define W_MIX(p) ((u16*)((p).ws + WS_MIX))
#define W_PROJ(p) ((u16*)((p).ws + WS_BIG))
#define W_Y(p) ((u16*)((p).ws + WS_BIG))
#define W_VT(p) ((u16*)((p).ws + WS_VT))
#define W_IDX(p) ((int*)((p).ws + WS_IDX))
#define W_G(p) ((float*)((p).ws + WS_G))

DI u16 f2bf(float x) { unsigned u = __float_as_uint(x); u += 0x7fffu + ((u >> 16) & 1u); return (u16)(u >> 16); }
typedef __attribute__((ext_vector_type(2))) __bf16 bf16x2_t;
DI unsigned pack2(float a, float b) { const bf16x2_t v = {(__bf16)a, (__bf16)b}; return __builtin_bit_cast(unsigned, v); }
DI float bflo(unsigned w) { return __uint_as_float(w << 16); }
DI float bfhi(unsigned w) { return __uint_as_float(w & 0xffff0000u); }
DI int otid_w(int wave) { unsigned z = 0u; asm volatile("" : "+v"(z)); int t = wave * 64 + (int)__builtin_amdgcn_mbcnt_hi(~0u, __builtin_amdgcn_mbcnt_lo(~0u, z)); asm volatile("" : "+v"(t)); return t; }
#define DPP_ADD(v, ctrl) ((v) + __int_as_float(__builtin_amdgcn_update_dpp(0, __float_as_int(v), (ctrl), 0xf, 0xf, true)))
DI float wave_sum(float v) {
  v = DPP_ADD(v, 0xB1);
  v = DPP_ADD(v, 0x4E);
  v = DPP_ADD(v, 0x141);
  v = DPP_ADD(v, 0x140);
  const int iv = __float_as_int(v);
  return __int_as_float(__builtin_amdgcn_readlane(iv, 0)) + __int_as_float(__builtin_amdgcn_readlane(iv, 16)) +
         __int_as_float(__builtin_amdgcn_readlane(iv, 32)) + __int_as_float(__builtin_amdgcn_readlane(iv, 48));
}
#define DPP_MAX(v, ctrl) fmaxf((v), __int_as_float(__builtin_amdgcn_update_dpp(0, __float_as_int(v), (ctrl), 0xf, 0xf, true)))
DI float wave_max_nonneg(float v) {
  v = DPP_MAX(v, 0xB1); v = DPP_MAX(v, 0x4E); v = DPP_MAX(v, 0x141); v = DPP_MAX(v, 0x140);
  const int iv = __float_as_int(v);
  return fmaxf(fmaxf(__int_as_float(__builtin_amdgcn_readlane(iv, 0)), __int_as_float(__builtin_amdgcn_readlane(iv, 16))),
               fmaxf(__int_as_float(__builtin_amdgcn_readlane(iv, 32)), __int_as_float(__builtin_amdgcn_readlane(iv, 48))));
}
DI float shx16(float v) { return __int_as_float(__builtin_amdgcn_ds_swizzle(__float_as_int(v), 0x401F)); }
DI float shx32(float v, int idx32) { return __int_as_float(__builtin_amdgcn_ds_bpermute(idx32, __float_as_int(v))); }
DI f32x4 mfma16(bf16x8 a, bf16x8 b, f32x4 c) { return __builtin_amdgcn_mfma_f32_16x16x32_bf16(a, b, c, 0, 0, 0); }
DI float fast_exp2(float x) { return __builtin_amdgcn_exp2f(x); }

DI void convert_straight(const float* __restrict__ src, u16* __restrict__ dst, size_t n8, size_t gtid, size_t gthreads) {
  for (size_t i = gtid; i < n8; i += gthreads) {
    const f32x4 a = *(const f32x4*)(src + i * 8), b = *(const f32x4*)(src + i * 8 + 4);
    u32x4 o; o[0] = pack2(a[0], a[1]); o[1] = pack2(a[2], a[3]); o[2] = pack2(b[0], b[1]); o[3] = pack2(b[2], b[3]);
    *(u32x4*)(dst + i * 8) = o;
  }
}

DI void transpose_tile(const float* __restrict__ src, int ldn, u16* __restrict__ dst, int ldk, int k0, int n0, float* sm, int tid) {
#pragma unroll
  for (int i = 0; i < 4; ++i) {
    const int r = (tid >> 4) + 16 * i, c4 = tid & 15;
    const f32x4 v = *(const f32x4*)(src + (size_t)(k0 + r) * ldn + n0 + 4 * c4);
    sm[r * 65 + 4 * c4 + 0] = v[0]; sm[r * 65 + 4 * c4 + 1] = v[1]; sm[r * 65 + 4 * c4 + 2] = v[2]; sm[r * 65 + 4 * c4 + 3] = v[3];
  }
  __syncthreads();
#pragma unroll
  for (int i = 0; i < 2; ++i) {
    const int n = (tid >> 3) + 32 * i, kc = tid & 7;
    u32x4 o;
#pragma unroll
    for (int e = 0; e < 4; ++e) o[e] = pack2(sm[(8 * kc + 2 * e) * 65 + n], sm[(8 * kc + 2 * e + 1) * 65 + n]);
    *(u32x4*)(dst + (size_t)(n0 + n) * ldk + k0 + 8 * kc) = o;
  }
  __syncthreads();
}

template <int LAYOUT> DI int col0(int lane, int hh) { return LAYOUT ? 16 * lane + 8 * hh : hh * 512 + 8 * lane; }
template <int LAYOUT>
DI void ln_row(float (&v)[16], const float* __restrict__ g, const float* __restrict__ b, int lane) {
  float s = 0.f;
#pragma unroll
  for (int i = 0; i < 16; ++i) s += v[i];
  const float mu = wave_sum(s) * (1.0f / 1024.0f);
  float q = 0.f;
#pragma unroll
  for (int i = 0; i < 16; ++i) { const float d = v[i] - mu; q += d * d; }
  const float rstd = rsqrtf(wave_sum(q) * (1.0f / 1024.0f) + 1e-5f);
#pragma unroll
  for (int hh = 0; hh < 2; ++hh) {
    const int c = col0<LAYOUT>(lane, hh);
    const f32x4 g0 = *(const f32x4*)(g + c), g1 = *(const f32x4*)(g + c + 4), b0 = *(const f32x4*)(b + c), b1 = *(const f32x4*)(b + c + 4);
#pragma unroll
    for (int e = 0; e < 4; ++e) {
      v[hh * 8 + e] = (v[hh * 8 + e] - mu) * rstd * g0[e] + b0[e];
      v[hh * 8 + 4 + e] = (v[hh * 8 + 4 + e] - mu) * rstd * g1[e] + b1[e];
    }
  }
}
template <int LAYOUT>
DI void store_row_bf16(u16* __restrict__ dst, const float (&v)[16], int lane) {
#pragma unroll
  for (int hh = 0; hh < 2; ++hh) {
    u32x4 o;
#pragma unroll
    for (int e = 0; e < 4; ++e) o[e] = pack2(v[hh * 8 + 2 * e], v[hh * 8 + 2 * e + 1]);
    *(u32x4*)(dst + col0<LAYOUT>(lane, hh)) = o;
  }
}
template <int LAYOUT>
DI void load_row_bf16(const u16* __restrict__ src, float (&v)[16], int lane) {
#pragma unroll
  for (int hh = 0; hh < 2; ++hh) {
    const u32x4 a = *(const u32x4*)(src + col0<LAYOUT>(lane, hh));
#pragma unroll
    for (int e = 0; e < 4; ++e) { v[hh * 8 + 2 * e] = bflo(a[e]); v[hh * 8 + 2 * e + 1] = bfhi(a[e]); }
  }
}
template <int LAYOUT>
DI void load_row_f32(const float* __restrict__ src, float (&v)[16], int lane) {
#pragma unroll
  for (int hh = 0; hh < 2; ++hh) {
    const int c = col0<LAYOUT>(lane, hh);
    const f32x4 a = *(const f32x4*)(src + c), b = *(const f32x4*)(src + c + 4);
#pragma unroll
    for (int e = 0; e < 4; ++e) { v[hh * 8 + e] = a[e]; v[hh * 8 + 4 + e] = b[e]; }
  }
}

enum { EPI_PROJ = 0, EPI_VT = 1, EPI_OUT = 2, EPI_TOPK = 3, EPI_FOLD = 4 };

template <bool SWAP>
DI void gemm_mainloop(const u16* __restrict__ A, int lda, const u16* __restrict__ Bt, int ldb, int K, int m0, int n0, char* smem,
                      f32x4 (&acc)[4][4], int tid) {
  const int lane = tid & 63, wid = tid >> 6, wm = wid >> 1, wn = wid & 1;
  const int srow = tid >> 3, skc = tid & 7;
  const u16* ap = A + (size_t)(m0 + srow) * lda + skc * 8;
  const u16* bp = Bt + (size_t)(n0 + srow) * ldb + skc * 8;
  const int dst0 = (((srow >> 4) * 2 + (skc >> 2)) * 1024) + (((skc & 3) * 16 + (srow & 15)) * 16);
#pragma unroll
  for (int i = 0; i < 4; ++i)
#pragma unroll
    for (int j = 0; j < 4; ++j) acc[i][j] = (f32x4){0.f, 0.f, 0.f, 0.f};
  u32x4 ra[4], rb[4];
#pragma unroll
  for (int j = 0; j < 4; ++j) { ra[j] = *(const u32x4*)(ap + (size_t)j * 32 * lda); rb[j] = *(const u32x4*)(bp + (size_t)j * 32 * ldb); }
#pragma unroll
  for (int j = 0; j < 4; ++j) { *(u32x4*)(smem + dst0 + j * 4096) = ra[j]; *(u32x4*)(smem + 16384 + dst0 + j * 4096) = rb[j]; }
  __syncthreads();
  const int KT = K >> 6;
  for (int kt = 0; kt < KT; ++kt) {
    char* cur = smem + (kt & 1) * 32768;
    char* nxt = smem + ((kt + 1) & 1) * 32768;
    const bool more = (kt + 1 < KT);
    if (more) {
      const u16* ap2 = ap + (kt + 1) * 64;
      const u16* bp2 = bp + (kt + 1) * 64;
#pragma unroll
      for (int j = 0; j < 4; ++j) { ra[j] = *(const u32x4*)(ap2 + (size_t)j * 32 * lda); rb[j] = *(const u32x4*)(bp2 + (size_t)j * 32 * ldb); }
    }
#pragma unroll
    for (int ks = 0; ks < 2; ++ks) {
      bf16x8 af[4], bfr[4];
#pragma unroll
      for (int i = 0; i < 4; ++i) af[i] = *(const bf16x8*)(cur + (((wm * 4 + i) * 2 + ks) * 1024) + lane * 16);
#pragma unroll
      for (int j = 0; j < 4; ++j) bfr[j] = *(const bf16x8*)(cur + 16384 + (((wn * 4 + j) * 2 + ks) * 1024) + lane * 16);
#pragma unroll
      for (int i = 0; i < 4; ++i)
#pragma unroll
        for (int j = 0; j < 4; ++j) acc[i][j] = SWAP ? mfma16(bfr[j], af[i], acc[i][j]) : mfma16(af[i], bfr[j], acc[i][j]);
    }
    if (more) {
#pragma unroll
      for (int j = 0; j < 4; ++j) { *(u32x4*)(nxt + dst0 + j * 4096) = ra[j]; *(u32x4*)(nxt + 16384 + dst0 + j * 4096) = rb[j]; }
    }
    __syncthreads();
  }
}

DI void ce_desc(float& hi, float& lo) { const float a = hi, b = lo; hi = fmaxf(a, b); lo = fminf(a, b); }
DI void bitonic_merge16(float (&v)[16]) {
#pragma unroll
  for (int j = 8; j > 0; j >>= 1)
#pragma unroll
    for (int i = 0; i < 16; ++i) if ((i & j) == 0) ce_desc(v[i], v[i | j]);
}
DI void bitonic_sort16(float (&v)[16]) {
#pragma unroll
  for (int k = 2; k <= 16; k <<= 1)
#pragma unroll
    for (int j = k >> 1; j > 0; j >>= 1)
#pragma unroll
      for (int i = 0; i < 16; ++i) {
        const int l = i ^ j;
        if (l > i) { if ((i & k) == 0 || k == 16) ce_desc(v[i], v[l]); else ce_desc(v[l], v[i]); }
      }
}
DI void merge_top16(float (&v)[16], const float (&w)[16]) {
#pragma unroll
  for (int i = 0; i < 16; ++i) v[i] = fmaxf(v[i], w[15 - i]);
  bitonic_merge16(v);
}
DI void insert16(float (&v)[16], float x) {
#pragma unroll
  for (int j = 0; j < 16; ++j) { const float hi = fmaxf(v[j], x); x = fminf(v[j], x); v[j] = hi; }
}

DI void gemm_tile_fold(const u16* A, int lda, const u16* Bt, int ldb, int K, int m0, char* smem, u16* dstT, int tid) {
  const int lane = tid & 63, wid = tid >> 6, wm = wid >> 1, wn = wid & 1, g = lane >> 4, l15 = lane & 15;
  f32x4 acc[4][4];
  gemm_mainloop<false>(A, lda, Bt, ldb, K, m0, 0, smem, acc, tid);
#pragma unroll
  for (int i = 0; i < 4; ++i)
#pragma unroll
    for (int j = 0; j < 4; ++j) {
      const int m = m0 + wm * 64 + 16 * i + 4 * g, n = wn * 64 + 16 * j + l15;
      u32x2 o; o[0] = pack2(acc[i][j][0], acc[i][j][1]); o[1] = pack2(acc[i][j][2], acc[i][j][3]);
      *(u32x2*)(dstT + (size_t)n * 1024 + m) = o;
    }
}

#define GK 1024
#define HTB 16384
DI int lds_byte(int r, int c) {
  const int st = (r >> 4) * 2 + (c >> 5), rr = r & 15, cc = c & 31, ob = rr * 64 + cc * 2;
  return st * 1024 + (ob ^ (((ob >> 9) & 1) << 5));
}
DI void stage_rc(int b, int& R, int& C) {
  const int st = b / 1024, sb = b % 1024, swz = sb ^ (((sb >> 9) & 1) << 5);
  R = (st >> 1) * 16 + swz / 64; C = (st & 1) * 32 + (swz % 64) / 2;
}
#define G_SA(b, h) (shm + ((b) * 2 + (h)) * HTB)
#define G_SB(b, h) (shm + (4 + (b) * 2 + (h)) * HTB)
#define G_STAGE(P, BASE, br, kt) do { const char* _g = (const char*)((BASE) + (size_t)(br) * GK + (kt) * 64); \
    __builtin_amdgcn_global_load_lds((const unsigned*)(_g + goff0), (LAS unsigned*)((P) + tid * 16), 16, 0, 0); \
    __builtin_amdgcn_global_load_lds((const unsigned*)(_g + goff1), (LAS unsigned*)((P) + tid * 16 + 8192), 16, 0, 0); } while (0)
#define G_LDA(dst, b, h) _Pragma("unroll") for (int m = 0; m < 4; ++m) _Pragma("unroll") for (int k = 0; k < 2; ++k) \
    dst[m][k] = *(const LAS bf16x8*)(G_SA(b, h) + lds_byte(wr * 64 + m * 16 + fr, k * 32 + fq * 8))
#define G_LDB(dst, b, h) _Pragma("unroll") for (int n = 0; n < 2; ++n) _Pragma("unroll") for (int k = 0; k < 2; ++k) \
    dst[n][k] = *(const LAS bf16x8*)(G_SB(b, h) + lds_byte(wc * 32 + n * 16 + fr, k * 32 + fq * 8))
#define G_MMA(ai, bj, At, Bx) do { __builtin_amdgcn_s_setprio(1); \
    _Pragma("unroll") for (int m = 0; m < 4; ++m) _Pragma("unroll") for (int n = 0; n < 2; ++n) _Pragma("unroll") for (int k = 0; k < 2; ++k) \
      acc[ai][bj][m][n] = __builtin_amdgcn_mfma_f32_16x16x32_bf16(At[m][k], Bx[n][k], acc[ai][bj][m][n], 0, 0, 0); \
    __builtin_amdgcn_s_setprio(0); } while (0)
#define WAIT_V(n) asm volatile("s_waitcnt vmcnt(" #n ")" ::: "memory")
#define WAIT_L(n) asm volatile("s_waitcnt lgkmcnt(" #n ")" ::: "memory")
#define BAR __builtin_amdgcn_s_barrier()
#define SCHED __builtin_amdgcn_sched_barrier(0)

DI void gemm256_core(const u16* __restrict__ A, const u16* __restrict__ Bt, int brow, int bcol, lchar* shm, int tid, f32x4 (&acc)[2][2][4][2]) {
  const int wid = tid >> 6, lane = tid & 63, wr = wid >> 2, wc = wid & 3, fr = lane & 15, fq = lane >> 4;
  int r0, c0, r1, c1;
  stage_rc(tid * 16, r0, c0); stage_rc(tid * 16 + 8192, r1, c1);
  const unsigned goff0 = (unsigned)(r0 * GK + c0) * 2u, goff1 = (unsigned)(r1 * GK + c1) * 2u;
#pragma unroll
  for (int ai = 0; ai < 2; ++ai)
#pragma unroll
    for (int bj = 0; bj < 2; ++bj)
#pragma unroll
      for (int m = 0; m < 4; ++m)
#pragma unroll
        for (int n = 0; n < 2; ++n) acc[ai][bj][m][n] = (f32x4){0.f, 0.f, 0.f, 0.f};
  bf16x8 At[4][2], B0[2][2], B1[2][2];
  const int nt = GK / 64;
  WAIT_V(0);
  __syncthreads();
  G_STAGE(G_SB(0, 0), Bt, bcol, 0); G_STAGE(G_SA(0, 0), A, brow, 0);
  G_STAGE(G_SB(0, 1), Bt, bcol + 128, 0); G_STAGE(G_SA(0, 1), A, brow + 128, 0);
  if (wr == 1) BAR;
  WAIT_V(4); BAR;
  G_STAGE(G_SB(1, 0), Bt, bcol, 1); G_STAGE(G_SA(1, 0), A, brow, 1); G_STAGE(G_SB(1, 1), Bt, bcol + 128, 1);
  WAIT_V(6); BAR;
  for (int t = 0; t < nt - 2; t += 2) {
    G_LDB(B0, 0, 0); SCHED; G_LDA(At, 0, 0); G_STAGE(G_SA(1, 1), A, brow + 128, t + 1);
    WAIT_L(8); BAR; WAIT_L(0); G_MMA(0, 0, At, B0); BAR; SCHED;
    G_LDB(B1, 0, 1); G_STAGE(G_SB(0, 0), Bt, bcol, t + 2);
    BAR; WAIT_L(0); G_MMA(0, 1, At, B1); BAR;
    G_LDA(At, 0, 1); G_STAGE(G_SA(0, 0), A, brow, t + 2);
    BAR; WAIT_L(0); G_MMA(1, 0, At, B0); BAR; SCHED;
    G_STAGE(G_SB(0, 1), Bt, bcol + 128, t + 2);
    WAIT_V(6); BAR; G_MMA(1, 1, At, B1); BAR;
    G_LDB(B0, 1, 0); SCHED; G_LDA(At, 1, 0); G_STAGE(G_SA(0, 1), A, brow + 128, t + 2);
    WAIT_L(8); BAR; WAIT_L(0); G_MMA(0, 0, At, B0); BAR; SCHED;
    G_LDB(B1, 1, 1); G_STAGE(G_SB(1, 0), Bt, bcol, t + 3);
    BAR; WAIT_L(0); G_MMA(0, 1, At, B1); BAR;
    G_LDA(At, 1, 1); G_STAGE(G_SA(1, 0), A, brow, t + 3);
    BAR; WAIT_L(0); G_MMA(1, 0, At, B0); BAR; SCHED;
    G_STAGE(G_SB(1, 1), Bt, bcol + 128, t + 3);
    WAIT_V(6); BAR; G_MMA(1, 1, At, B1); BAR;
  }
  { G_LDB(B0, 0, 0); G_LDA(At, 0, 0); G_STAGE(G_SA(1, 1), A, brow + 128, nt - 1);
    BAR; WAIT_L(0); G_MMA(0, 0, At, B0); BAR;
    G_LDB(B1, 0, 1); BAR; WAIT_L(0); G_MMA(0, 1, At, B1); BAR;
    G_LDA(At, 0, 1); WAIT_V(4); BAR; WAIT_L(0); G_MMA(1, 0, At, B0); G_MMA(1, 1, At, B1); BAR; }
  { G_LDB(B0, 1, 0); G_LDA(At, 1, 0); WAIT_V(2); BAR; WAIT_L(0); G_MMA(0, 0, At, B0); BAR;
    G_LDB(B1, 1, 1); WAIT_V(0); BAR; WAIT_L(0); G_MMA(0, 1, At, B1); BAR;
    G_LDA(At, 1, 1); BAR; WAIT_L(0); G_MMA(1, 0, At, B0); G_MMA(1, 1, At, B1); BAR; }
  if (wr == 0) BAR;
}

DI void gemm256_tile(const Params& p, int mode, int layer, const u16* R, const u16* Cc, int brow, int bcol, lchar* shm, int tid_in) {
  f32x4 acc[2][2][4][2];
  gemm256_core(R, Cc, brow, bcol, shm, tid_in, acc);
  int tid = tid_in;
  asm volatile("" : "+v"(tid));
  const int wid = tid >> 6, lane = tid & 63, wr = wid >> 2, wc = wid & 3, fr = lane & 15, fq = lane >> 4;
  if (mode == EPI_PROJ) {
#pragma unroll
    for (int ai = 0; ai < 2; ++ai)
#pragma unroll
      for (int bj = 0; bj < 2; ++bj)
#pragma unroll
        for (int m = 0; m < 4; ++m)
#pragma unroll
          for (int n = 0; n < 2; ++n) {
            const int nc = brow + ai * 128 + wr * 64 + m * 16 + fq * 4, tok = bcol + bj * 128 + wc * 32 + n * 16 + fr;
            const f32x4 v = acc[ai][bj][m][n];
            u32x2 o; o[0] = pack2(v[0], v[1]); o[1] = pack2(v[2], v[3]);
            *(u32x2*)(W_PROJ(p) + (size_t)tok * INC + nc) = o;
          }
  } else if (mode == EPI_VT) {
#pragma unroll
    for (int ai = 0; ai < 2; ++ai)
#pragma unroll
      for (int bj = 0; bj < 2; ++bj)
#pragma unroll
        for (int m = 0; m < 4; ++m)
#pragma unroll
          for (int n = 0; n < 2; ++n) {
            const int tok = brow + ai * 128 + wr * 64 + m * 16 + fq * 4, nn = bcol + bj * 128 + wc * 32 + n * 16 + fr - 1024;
            const int b = tok / LSEQ, pos = tok - b * LSEQ;
            const f32x4 v = acc[ai][bj][m][n];
            u32x2 o; o[0] = pack2(v[0], v[1]); o[1] = pack2(v[2], v[3]);
            *(u32x2*)(W_VT(p) + ((size_t)(b * 512 + nn)) * LP + pos) = o;
          }
  } else if (mode == EPI_OUT) {
#pragma unroll
    for (int ai = 0; ai < 2; ++ai)
#pragma unroll
      for (int bj = 0; bj < 2; ++bj) {
        u32x2 hv[4][2];
#pragma unroll
        for (int m = 0; m < 4; ++m)
#pragma unroll
          for (int n = 0; n < 2; ++n) {
            const int nc = brow + ai * 128 + wr * 64 + m * 16 + fq * 4, tok = bcol + bj * 128 + wc * 32 + n * 16 + fr;
            hv[m][n] = *(const u32x2*)(W_H(p) + (size_t)tok * DM + nc);
          }
#pragma unroll
        for (int m = 0; m < 4; ++m)
#pragma unroll
          for (int n = 0; n < 2; ++n) {
            const int nc = brow + ai * 128 + wr * 64 + m * 16 + fq * 4, tok = bcol + bj * 128 + wc * 32 + n * 16 + fr;
            const f32x4 v = acc[ai][bj][m][n];
            u32x2 o;
            o[0] = pack2(ALPHA * bflo(hv[m][n][0]) + v[0], ALPHA * bfhi(hv[m][n][0]) + v[1]);
            o[1] = pack2(ALPHA * bflo(hv[m][n][1]) + v[2], ALPHA * bfhi(hv[m][n][1]) + v[3]);
            *(u32x2*)(W_Y(p) + (size_t)tok * DM + nc) = o;
          }
      }
  } else {
    LAS float* S = (LAS float*)shm;
    const int tok = tid & 255, kh = tid >> 8;
    float L0[16], L1[16];
#pragma unroll
    for (int ai = 0; ai < 2; ++ai) {
      __syncthreads();
#pragma unroll
      for (int bj = 0; bj < 2; ++bj)
#pragma unroll
        for (int m = 0; m < 4; ++m)
#pragma unroll
          for (int n = 0; n < 2; ++n) {
            const int tk = bj * 128 + wc * 32 + n * 16 + fr, key = wr * 64 + m * 16 + fq * 4;
#pragma unroll
            for (int j = 0; j < 4; ++j) S[tk * 128 + ((key + j + tk) & 127)] = acc[ai][bj][m][n][j];
          }
      __syncthreads();
      float v[16];
#pragma unroll 1
      for (int ch = 0; ch < 4; ++ch) {
        float wk[16];
#pragma unroll
        for (int i = 0; i < 16; ++i) {
          const int key = kh * 64 + ch * 16 + i;
          const float x = S[tok * 128 + ((key + tok) & 127)];
          wk[i] = __uint_as_float((__float_as_uint(x) & ~127u) | (unsigned)key);
        }
        bitonic_sort16(wk);
        if (ch == 0) {
#pragma unroll
          for (int i = 0; i < 16; ++i) v[i] = wk[i];
        } else {
          merge_top16(v, wk);
        }
      }
      __syncthreads();
      if (kh == 1) {
#pragma unroll
        for (int j = 0; j < 16; ++j) S[tok * 16 + j] = v[j];
      }
      __syncthreads();
      if (kh == 0) {
        float wk[16];
#pragma unroll
        for (int j = 0; j < 16; ++j) wk[j] = S[tok * 16 + j];
        merge_top16(v, wk);
      }
#pragma unroll
      for (int j = 0; j < 16; ++j) { if (ai == 0) L0[j] = v[j]; else L1[j] = v[j]; }
    }
    __syncthreads();
    LAS unsigned* LL = (LAS unsigned*)shm;
    if (kh == 0) {
#pragma unroll
      for (int j = 0; j < 16; ++j) { LL[tok * 32 + ((j + tok) & 31)] = __float_as_uint(L0[j]); LL[tok * 32 + ((16 + j + tok) & 31)] = __float_as_uint(L1[j]); }
      float s1[16], s2[16], v[16];
#pragma unroll
      for (int j = 0; j < 16; ++j) { s1[j] = __uint_as_float(__float_as_uint(L0[j]) & ~127u); s2[j] = __uint_as_float(__float_as_uint(L1[j]) & ~127u); v[j] = -3.0e38f; }
#pragma unroll
      for (int ch = 0; ch < 4; ++ch) {
        float wk[16];
#pragma unroll
        for (int i = 0; i < 16; ++i) {
          constexpr unsigned char PAIRS[64] = {0, 1, 2, 3, 4, 5, 6, 7, 8, 9, 10, 11, 12, 13, 14, 15, 16, 17, 18, 19, 20, 21, 22, 23, 32, 33, 34, 35, 36, 48, 49, 50, 51, 64, 65, 66, 80, 81, 96, 97, 112, 113, 128, 144, 160, 176, 192, 208, 224, 240, 255, 255, 255, 255, 255, 255, 255, 255, 255, 255, 255, 255, 255, 255};
          const int code = PAIRS[ch * 16 + i];
          if (code == 255) { wk[i] = -3.0e38f; }
          else { const float sm = s1[code >> 4] + s2[code & 15]; wk[i] = __uint_as_float((__float_as_uint(sm) & ~255u) | (unsigned)code); }
        }
        if (ch == 0) {
#pragma unroll
          for (int i = 0; i < 16; ++i) v[i] = wk[i];
        } else {
          bitonic_sort16(wk);
          merge_top16(v, wk);
        }
      }
      float e[16], sum = 0.f;
      const float mx = __uint_as_float(__float_as_uint(v[0]) & ~255u);
#pragma unroll
      for (int j = 0; j < 16; ++j) { e[j] = fast_exp2((__uint_as_float(__float_as_uint(v[j]) & ~255u) - mx) * LOG2E); sum += e[j]; }
      const float inv = 1.0f / sum;
      const int hd = brow >> 8;
      int* di = W_IDX(p) + (size_t)(bcol + tok) * 128 + hd * 16;
      float* dg = W_G(p) + (size_t)(bcol + tok) * 128 + hd * 16;
#pragma unroll
      for (int q = 0; q < 4; ++q) {
        u32x4 oi; f32x4 og;
#pragma unroll
        for (int k = 0; k < 4; ++k) {
          const unsigned code = __float_as_uint(v[4 * q + k]) & 255u;
          const unsigned i1 = LL[tok * 32 + (((code >> 4) + tok) & 31)] & 127u, i2 = LL[tok * 32 + ((16 + (code & 15u) + tok) & 31)] & 127u;
          oi[k] = i1 * 128u + i2; og[k] = e[4 * q + k] * inv;
        }
        *(u32x4*)(di + 4 * q) = oi; *(f32x4*)(dg + 4 * q) = og;
      }
    }
    __syncthreads();
  }
}

#define ATT_MISC 131072
DI void attn_item(const Params& p, int layer, int b, int hh, int jq, lchar* sm, float lam, float oml, int tid) {
  const int lane = tid & 63, w = tid >> 6, g = lane >> 4, l15 = lane & 15;
  const int idx32 = (lane ^ 32) << 2;
  LAS float* tab = (LAS float*)(sm + ATT_MISC);
  LAS float* sg = tab + 208;
  __syncthreads();
  if (tid < 208) {
    const int d = tid - 80;
    float tv = -1.0e30f;
    if (d >= 0) {
      int bucket = d;
      if (d >= 16) {
        int lg = 16 + (int)(logf((float)d * (1.0f / 16.0f)) / 2.0794415416798357f * 16.0f);
        bucket = lg < 31 ? lg : 31;
      }
      tv = P_REL_BIAS(p)[bucket * 4 + hh] * LOG2E;
    }
    tab[tid] = tv;
    if (tid < 128) sg[tid] = P_SUBLN_G(p)[layer * 128 + tid] * oml;
  }
  const int q0w = 128 * jq + 16 * w;
  const int qpos = q0w + l15;
  const int qrow = b * LSEQ + (qpos < LSEQ ? qpos : LSEQ - 1);
  bf16x8 qf[2][2];
  {
    const u16* qp = W_PROJ(p) + (size_t)qrow * INC + hh * 128 + g * 8;
#pragma unroll
    for (int m = 0; m < 2; ++m)
#pragma unroll
      for (int ks = 0; ks < 2; ++ks) {
        const u32x4 raw = *(const u32x4*)(qp + m * 64 + ks * 32);
        u32x4 sc;
#pragma unroll
        for (int e = 0; e < 4; ++e) sc[e] = pack2(bflo(raw[e]) * (0.125f * LOG2E), bfhi(raw[e]) * (0.125f * LOG2E));
        qf[m][ks] = __builtin_bit_cast(bf16x8, sc);
      }
  }
  const int nkt = (2 * jq + 2) < 33 ? (2 * jq + 2) : 33;
  const char* ksrc[2]; const char* vsrc[2];
#pragma unroll
  for (int i = 0; i < 2; ++i) {
    const int bk = 2 * w + i, k16 = bk >> 2, m = (bk >> 1) & 1, ks = bk & 1;
    const int krow = 32 * (k16 >> 1) + 8 * (l15 >> 2) + 4 * (k16 & 1) + (l15 & 3);
    ksrc[i] = (const char*)(W_PROJ(p) + (size_t)(b * LSEQ + krow) * INC + 512 + hh * 128 + m * 64 + ks * 32 + g * 8);
    const int dv = 8 * bk + (lane >> 3), c = (lane & 7) ^ ((dv >> 1) & 7);
    vsrc[i] = (const char*)(W_VT(p) + ((size_t)((b * 4 + hh) * 128 + dv)) * LP + c * 8);
  }
  lchar* dmak = sm + (2 * w) * 1024 + lane * 16;
#define ATT_ISSUE(KT, SLOT) do { const size_t _ko = (size_t)(KT) * (64 * INC * 2), _vo = (size_t)(KT) * 128; lchar* _d = dmak + (SLOT) * 32768; \
    __builtin_amdgcn_global_load_lds((const unsigned*)(ksrc[0] + _ko), (LAS unsigned*)(_d), 16, 0, 0); \
    __builtin_amdgcn_global_load_lds((const unsigned*)(ksrc[1] + _ko), (LAS unsigned*)(_d + 1024), 16, 0, 0); \
    __builtin_amdgcn_global_load_lds((const unsigned*)(vsrc[0] + _vo), (LAS unsigned*)(_d + 16384), 16, 0, 0); \
    __builtin_amdgcn_global_load_lds((const unsigned*)(vsrc[1] + _vo), (LAS unsigned*)(_d + 16384 + 1024), 16, 0, 0); } while (0)
  int voff[2];
#pragma unroll
  for (int kk = 0; kk < 2; ++kk) voff[kk] = l15 * 128 + (((4 * kk + g) ^ ((l15 >> 1) & 7)) * 16);

  f32x4 O[2][8];
#pragma unroll
  for (int m = 0; m < 2; ++m)
#pragma unroll
    for (int dt = 0; dt < 8; ++dt) O[m][dt] = (f32x4){0.f, 0.f, 0.f, 0.f};
  float mrun[2] = {0.f, 0.f};
  f32x4 Osum[2] = {(f32x4){0.f, 0.f, 0.f, 0.f}, (f32x4){0.f, 0.f, 0.f, 0.f}};
  bf16x8 ones;
  { const short o1 = (l15 == 0) ? (short)0x3f80 : (short)0; ones = (bf16x8){o1, o1, o1, o1, o1, o1, o1, o1}; }

  WAIT_V(0);
  __syncthreads();
  const float tfar = tab[207];
  ATT_ISSUE(0, 0);
  ATT_ISSUE((1 < nkt ? 1 : nkt - 1), 1);
  for (int kt = 0; kt < nkt; ++kt) {
    { const int kn = (kt + 2 < nkt) ? kt + 2 : nkt - 1; ATT_ISSUE(kn, (kt + 2) & 3); }
    WAIT_V(8); BAR;
    if (64 * kt <= q0w + 15) {
      const lchar* kb = sm + (kt & 3) * 32768;
      const lchar* vb = kb + 16384;
      const bool near = (q0w - 64 * kt) < 176;
      const float tadd = near ? 0.f : tfar;
      const float sinit[2] = {tadd - mrun[0], tadd - mrun[1]};
      f32x4 S[2][4];
#pragma unroll
      for (int kh = 0; kh < 2; ++kh) {
        bf16x8 kf[2][2][2];
#pragma unroll
        for (int q = 0; q < 2; ++q)
#pragma unroll
          for (int m = 0; m < 2; ++m)
#pragma unroll
            for (int ks = 0; ks < 2; ++ks) kf[q][m][ks] = *(const LAS bf16x8*)(kb + ((((2 * kh + q) * 2 + m) * 2 + ks) * 1024) + lane * 16);
        SCHED;
#pragma unroll
        for (int q = 0; q < 2; ++q)
#pragma unroll
          for (int m = 0; m < 2; ++m) {
            f32x4 sacc = (f32x4){sinit[m], sinit[m], sinit[m], sinit[m]};
            sacc = mfma16(kf[q][m][0], qf[m][0], sacc);
            sacc = mfma16(kf[q][m][1], qf[m][1], sacc);
            S[m][2 * kh + q] = sacc;
          }
      }
      if (near) {
#pragma unroll
        for (int m = 0; m < 2; ++m)
#pragma unroll
          for (int k16 = 0; k16 < 4; ++k16)
#pragma unroll
            for (int r = 0; r < 4; ++r) {
              const int di = qpos + 80 - (64 * kt + 32 * (k16 >> 1) + 8 * g + 4 * (k16 & 1) + r);
              S[m][k16][r] += tab[di < 207 ? di : 207];
            }
      }
      bf16x8 pb[2][2];
#pragma unroll
      for (int m = 0; m < 2; ++m) {
        float mx = fmaxf(fmaxf(S[m][0][0], S[m][0][1]), fmaxf(S[m][0][2], S[m][0][3]));
#pragma unroll
        for (int k16 = 1; k16 < 4; ++k16) mx = fmaxf(fmaxf(mx, fmaxf(S[m][k16][0], S[m][k16][1])), fmaxf(S[m][k16][2], S[m][k16][3]));
        mx = fmaxf(mx, shx16(mx));
        mx = fmaxf(mx, shx32(mx, idx32));
        if (kt == 0 || __builtin_amdgcn_ballot_w64(mx > 8.0f) != 0ull) {
          const float dlt = kt == 0 ? mx : fmaxf(mx, 0.f);
          const float alpha = fast_exp2(-dlt);
          mrun[m] += dlt;
#pragma unroll
          for (int dt = 0; dt < 8; ++dt) { O[m][dt][0] *= alpha; O[m][dt][1] *= alpha; O[m][dt][2] *= alpha; O[m][dt][3] *= alpha; }
          Osum[m][0] *= alpha; Osum[m][1] *= alpha; Osum[m][2] *= alpha; Osum[m][3] *= alpha;
#pragma unroll
          for (int k16 = 0; k16 < 4; ++k16)
#pragma unroll
            for (int r = 0; r < 4; ++r) S[m][k16][r] -= dlt;
        }
#pragma unroll
        for (int k16 = 0; k16 < 4; ++k16)
#pragma unroll
          for (int r = 0; r < 4; ++r) S[m][k16][r] = fast_exp2(S[m][k16][r]);
#pragma unroll
        for (int kk = 0; kk < 2; ++kk) {
          u32x4 t;
          t[0] = pack2(S[m][2 * kk][0], S[m][2 * kk][1]); t[1] = pack2(S[m][2 * kk][2], S[m][2 * kk][3]);
          t[2] = pack2(S[m][2 * kk + 1][0], S[m][2 * kk + 1][1]); t[3] = pack2(S[m][2 * kk + 1][2], S[m][2 * kk + 1][3]);
          pb[m][kk] = __builtin_bit_cast(bf16x8, t);
          Osum[m] = mfma16(ones, pb[m][kk], Osum[m]);
        }
      }
#pragma unroll
      for (int kk = 0; kk < 2; ++kk) {
        bf16x8 vf[8];
#pragma unroll
        for (int dt = 0; dt < 8; ++dt) vf[dt] = *(const LAS bf16x8*)(vb + dt * 2048 + voff[kk]);
        SCHED;
#pragma unroll
        for (int dt = 0; dt < 8; ++dt) {
          O[0][dt] = mfma16(vf[dt], pb[0][kk], O[0][dt]);
          O[1][dt] = mfma16(vf[dt], pb[1][kk], O[1][dt]);
        }
      }
    }
  }
  WAIT_V(0);
#undef ATT_ISSUE
  float l0 = g == 0 ? Osum[0][0] : 0.f, l1 = g == 0 ? Osum[1][0] : 0.f;
  l0 += shx16(l0); l0 += shx32(l0, idx32);
  l1 += shx16(l1); l1 += shx32(l1, idx32);
  const float c1 = 1.0f / l0, c2 = lam / l1;
  float ss = 0.f;
#pragma unroll
  for (int dt = 0; dt < 8; ++dt)
#pragma unroll
    for (int r = 0; r < 4; ++r) { const float o = O[0][dt][r] * c1 - O[1][dt][r] * c2; O[0][dt][r] = o; ss += o * o; }
  ss += shx16(ss); ss += shx32(ss, idx32);
  const float rinv = rsqrtf(ss * (1.0f / 128.0f) + 1e-5f);
  if (qpos < LSEQ) {
    u16* dst = W_MIX(p) + (size_t)(b * LSEQ + qpos) * DM + hh * 128 + 4 * g;
#pragma unroll
    for (int dt = 0; dt < 8; ++dt) {
      const int dv0 = 16 * dt + 4 * g;
      u32x2 o;
      o[0] = pack2(O[0][dt][0] * rinv * sg[dv0 + 0], O[0][dt][1] * rinv * sg[dv0 + 1]);
      o[1] = pack2(O[0][dt][2] * rinv * sg[dv0 + 2], O[0][dt][3] * rinv * sg[dv0 + 3]);
      *(u32x2*)(dst + 16 * dt) = o;
    }
  }
}

DI void conv_item(const Params& p, int layer, int item, int tid) {
  const int ch = (tid & 63) * 8, t0 = item * 16 + 4 * (tid >> 6);
  const int pos0 = t0 % LSEQ;
  const bool head = pos0 == 0;
  const u16* row0 = W_PROJ(p) + (size_t)t0 * INC;
  u32x4 gc[6], zz[6], gb[4];
#pragma unroll
  for (int j = 0; j < 6; ++j) {
    const u16* r2 = row0 + (ptrdiff_t)((head && j < 2) ? 0 : (j - 2)) * INC;
    gc[j] = *(const u32x4*)(r2 + 2048 + ch); zz[j] = *(const u32x4*)(r2 + 2560 + ch);
  }
#pragma unroll
  for (int i = 0; i < 4; ++i) gb[i] = *(const u32x4*)(row0 + (size_t)i * INC + 1536 + ch);
  const float* cw = P_CONV_W(p) + (size_t)layer * 3 * 512 + ch;
  float w0[8], w1[8], w2[8];
#pragma unroll
  for (int e = 0; e < 8; ++e) { w0[e] = cw[e]; w1[e] = cw[512 + e]; w2[e] = cw[1024 + e]; }
  float pr[6][8];
#pragma unroll
  for (int j = 0; j < 6; ++j) {
    const float keep = (head && j < 2) ? 0.f : 1.f;
#pragma unroll
    for (int e = 0; e < 4; ++e) { pr[j][2 * e] = keep * bflo(gc[j][e]) * bflo(zz[j][e]); pr[j][2 * e + 1] = keep * bfhi(gc[j][e]) * bfhi(zz[j][e]); }
  }
#pragma unroll
  for (int i = 0; i < 4; ++i) {
    u32x4 o;
#pragma unroll
    for (int e = 0; e < 4; ++e) {
      const float a0 = w0[2 * e] * pr[i][2 * e] + w1[2 * e] * pr[i + 1][2 * e] + w2[2 * e] * pr[i + 2][2 * e];
      const float a1 = w0[2 * e + 1] * pr[i][2 * e + 1] + w1[2 * e + 1] * pr[i + 1][2 * e + 1] + w2[2 * e + 1] * pr[i + 2][2 * e + 1];
      o[e] = pack2(bflo(gb[i][e]) * a0, bfhi(gb[i][e]) * a1);
    }
    *(u32x4*)(W_MIX(p) + (size_t)(t0 + i) * DM + 512 + ch) = o;
  }
}

DI void phase_prologue(const Params& p, char* smem, int wave) {
  const int tid = otid_w(wave), lane = tid & 63, wid = tid >> 6, hb = tid >> 8, htid = tid & 255;
  const int nblk = gridDim.x, bid = blockIdx.x;
  const size_t gtid = (size_t)bid * NTHREADS + tid, gthreads = (size_t)nblk * NTHREADS;
  float* sm = (float*)(smem + hb * LDS_HALF);
  for (int it0 = bid; it0 < 2048; it0 += nblk) {
    const int it = it0 * 2 + hb;
    if (it < 3072) {
      const int l = it / 768, r = it % 768, kb = r / 48, nb = r % 48;
      transpose_tile(P_W_IN(p) + (size_t)l * 1024 * 3072, 3072, W_WIN(p) + (size_t)l * 3072 * 1024, 1024, kb * 64, nb * 64, sm, htid);
    } else {
      const int i2 = it - 3072, l = i2 / 256, r = i2 % 256, kb = r / 16, nb = r % 16;
      transpose_tile(P_W_OUT(p) + (size_t)l * 1024 * 1024, 1024, W_WOUT(p) + (size_t)l * 1024 * 1024, 1024, kb * 64, nb * 64, sm, htid);
    }
  }
  convert_straight(P_W_Q(p), W_WQB(p), (size_t)4 * 1024 * 2048 / 8, gtid, gthreads);
  convert_straight(P_SUB_KEYS(p), W_SKB(p), (size_t)4 * 16 * 128 * 128 / 8, gtid, gthreads);
  for (int t = bid * 8 + wid; t < TTOK; t += nblk * 8) {
    const int b = t / LSEQ, pos = t - b * LSEQ;
    const float* src = pos < NMETA ? P_META(p) + (size_t)pos * DM : P_X(p) + ((size_t)b * SEQ + pos - NMETA) * DM;
    float v[16];
    load_row_f32<0>(src, v, lane);
    ln_row<0>(v, P_LN_IN_G(p), P_LN_IN_B(p), lane);
    store_row_bf16<0>(W_H(p) + (size_t)t * DM, v, lane);
  }
}

DI void phase_fold(const Params& p, char* smem, int wave) {
  const int tid = otid_w(wave), hb = tid >> 8, htid = tid & 255;
  for (int it0 = blockIdx.x; it0 < 256; it0 += gridDim.x) {
    const int it = it0 * 2 + hb;
    const int l = it >> 7, hp = (it >> 3) & 15, mt = it & 7;
    gemm_tile_fold(W_WQB(p) + (size_t)l * 1024 * 2048 + hp * 128, 2048, W_SKB(p) + ((size_t)l * 16 + hp) * 128 * 128, 128, 128, mt * 128, smem + hb * 65536,
                   W_WSC(p) + (size_t)l * 2048 * 1024 + (size_t)hp * 128 * 1024, htid);
  }
}

DI bool tile_order(int i, int nM, int nN, int& pm, int& pn) {
  const int nwg = nM * nN;
  const long L = (long)i * gridDim.x + blockIdx.x;
  if (L >= nwg) return false;
  int wgid = (int)L;
  { const int q = nwg / 8, r = nwg % 8, xcd = wgid % 8, off = wgid / 8; wgid = (xcd < r ? xcd * (q + 1) : r * (q + 1) + (xcd - r) * q) + off; }
  const int nig = 8 * nN, gid = wgid / nig, fm = gid * 8, gsz = (nM - fm) < 8 ? (nM - fm) : 8;
  pm = fm + ((wgid % nig) % gsz); pn = (wgid % nig) / gsz;
  return true;
}

DI void phase_gemm(const Params& p, int layer, int which, char* smem, int wave) {
  const int tid0 = otid_w(wave);
  const u16* W = which == 0 ? W_WIN(p) + (size_t)layer * 3072 * 1024 : (which == 1 ? W_WOUT(p) + (size_t)layer * 1024 * 1024 : W_WSC(p) + (size_t)layer * 2048 * 1024);
  const u16* X = which == 1 ? W_MIX(p) : W_H(p);
  const int nN = which == 0 ? 12 : (which == 1 ? 4 : 8);
  int pm, pn;
  for (int i = 0; tile_order(i, 258, nN, pm, pn); ++i) {
    const bool vt = (which == 0) && (pn == 4 || pn == 5);
    const int mode = which == 0 ? (vt ? EPI_VT : EPI_PROJ) : (which == 1 ? EPI_OUT : EPI_TOPK);
    int tid = tid0;
    asm volatile("" : "+v"(tid));
    gemm256_tile(p, mode, layer, vt ? X : W, vt ? W : X, vt ? pm * 256 : pn * 256, vt ? pn * 256 : pm * 256, (lchar*)smem, tid);
  }
}

DI void phase_attn(const Params& p, int layer, char* smem, int wave) {
  const int tid = otid_w(wave), lane = tid & 63, hb = tid >> 8, htid = tid & 255;
  const float lam_init = 0.8f - 0.6f * expf(-0.3f * (float)layer);
  float d1 = P_LQ1(p)[layer * 64 + lane] * P_LK1(p)[layer * 64 + lane], d2 = P_LQ2(p)[layer * 64 + lane] * P_LK2(p)[layer * 64 + lane];
  d1 = wave_sum(d1); d2 = wave_sum(d2);
  const float lam = expf(d1) - expf(d2) + lam_init;
  for (int rd = 0; rd * (int)gridDim.x < 2176; ++rd) {
    const int o = rd * gridDim.x + ((rd & 1) ? (int)gridDim.x - 1 - (int)blockIdx.x : (int)blockIdx.x);
    if (o < 2176) { const int jq = 16 - (o >> 7), bh = o & 127; attn_item(p, layer, bh >> 2, bh & 3, jq, (lchar*)smem, lam, 1.0f - lam_init, tid); }
  }
  for (int it = blockIdx.x; it < 2064; it += gridDim.x) conv_item(p, layer, it * 2 + hb, htid);
}

DI void phase_ln(const Params& p, int layer, int which, int wave) {
  const int tid = otid_w(wave), lane = tid & 63, wid = tid >> 6;
  const int nblk = gridDim.x, bid = blockIdx.x;
  const float* lg = (which ? P_LN2_G(p) : P_LN1_G(p)) + layer * DM;
  const float* lb = (which ? P_LN2_B(p) : P_LN1_B(p)) + layer * DM;
  const bool final_out = which && (layer == DEPTH - 1);
  for (int t = bid * 8 + wid; t < TTOK; t += nblk * 8) {
    float v[16];
    load_row_bf16<0>(W_Y(p) + (size_t)t * DM, v, lane);
    ln_row<0>(v, lg, lb, lane);
    if (final_out) {
      const int b = t / LSEQ, pos = t - b * LSEQ;
      if (pos >= NMETA) {
        float* dst = p.out + ((size_t)b * SEQ + pos - NMETA) * DM;
#pragma unroll
        for (int hh = 0; hh < 2; ++hh) {
          *(f32x4*)(dst + hh * 512 + 8 * lane) = (f32x4){v[hh * 8], v[hh * 8 + 1], v[hh * 8 + 2], v[hh * 8 + 3]};
          *(f32x4*)(dst + hh * 512 + 8 * lane + 4) = (f32x4){v[hh * 8 + 4], v[hh * 8 + 5], v[hh * 8 + 6], v[hh * 8 + 7]};
        }
      }
    } else {
      store_row_bf16<0>(W_H(p) + (size_t)t * DM, v, lane);
    }
  }
  if (which) return;
  for (int r = bid * 8 + wid; r < 2 * PEER_N; r += nblk * 8) {
    const bool isv = r >= PEER_N;
    const int e = isv ? r - PEER_N : r;
    const float* src = (isv ? P_PEER_V(p) : P_PEER_U(p)) + ((size_t)layer * PEER_N + e) * DM + 16 * lane;
    f32x4 a[4];
#pragma unroll
    for (int k = 0; k < 4; ++k) a[k] = *(const f32x4*)(src + 4 * k);
    float am = 0.f;
#pragma unroll
    for (int k = 0; k < 4; ++k) am = fmaxf(am, fmaxf(fmaxf(fabsf(a[k][0]), fabsf(a[k][1])), fmaxf(fabsf(a[k][2]), fabsf(a[k][3]))));
    am = wave_max_nonneg(am);
    const float top = isv ? 224.0f : 127.0f;
    const float sc = am > 0.f ? top / am : 1.0f;
    if (lane == 0) (isv ? W_SV(p) : W_SU(p))[e] = am > 0.f ? am / top : 1.0f;
    u32x4 o;
#pragma unroll
    for (int k = 0; k < 4; ++k) {
      if (isv) {
        int w = 0;
        w = __builtin_amdgcn_cvt_pk_fp8_f32(a[k][0] * sc, a[k][1] * sc, w, false);
        w = __builtin_amdgcn_cvt_pk_fp8_f32(a[k][2] * sc, a[k][3] * sc, w, true);
        o[k] = (unsigned)w;
      } else {
        const int q0 = __float2int_rn(a[k][0] * sc), q1 = __float2int_rn(a[k][1] * sc), q2 = __float2int_rn(a[k][2] * sc), q3 = __float2int_rn(a[k][3] * sc);
        o[k] = ((unsigned)q0 & 255u) | (((unsigned)q1 & 255u) << 8) | (((unsigned)q2 & 255u) << 16) | ((unsigned)q3 << 24);
      }
    }
    *(u32x4*)((isv ? W_VB(p) : W_UB(p)) + (size_t)(lane >> 3) * (PEER_N * 128) + (size_t)e * 128 + 16 * (lane & 7)) = o;
  }
}

#define DPP_F(v, ctrl) __int_as_float(__builtin_amdgcn_update_dpp(0, __float_as_int(v), (ctrl), 0xf, 0xf, true))
#define PEER_META(T, IA, IB, HA, HB) do { const int _t = (T) < TTOK ? (T) : wslot; \
    IA = W_IDX(p)[(size_t)_t * 128 + lane]; IB = W_IDX(p)[(size_t)_t * 128 + 64 + lane]; \
    const u16* _hp = W_H(p) + (size_t)_t * DM + x * 128 + 16 * c; HA = *(const u32x4*)(_hp); HB = *(const u32x4*)(_hp + 8); } while (0)
#define PEER_GATHER(TAB, IA, IB, RR) do { _Pragma("unroll") for (int g = 0; g < 16; ++g) { \
    const int _e = __builtin_amdgcn_ds_bpermute(bp0 + 32 * (g & 7), g < 8 ? IA : IB); RR[g] = *(const u32x4*)((TAB) + (size_t)_e * 128); } } while (0)
#define PEER_UNPACK(XS, HA, HB) do { _Pragma("unroll") for (int e = 0; e < 4; ++e) { \
    XS[e] = (f32x2){bflo(HA[e]), bfhi(HA[e])}; XS[4 + e] = (f32x2){bflo(HB[e]), bfhi(HB[e])}; } } while (0)

#define DPP_I(v, ctrl) __builtin_amdgcn_update_dpp(0, (v), (ctrl), 0xf, 0xf, true)
DI void phase_peer_dots(const Params& p, int layer, int wave) {
  const int tid = otid_w(wave), lane = tid & 63, wid = tid >> 6, c = lane & 7, r = lane >> 3;
  const int x = blockIdx.x & 7, wslot = (blockIdx.x >> 3) * 8 + wid, nslot = (gridDim.x >> 3) * 8;
  const unsigned char* ub = W_UB(p) + (size_t)x * (PEER_N * 128) + c * 16;
  u16* pd = W_Y(p);
  const int bp0 = 4 * r;
  int iAa, iBa, iAb, iBb;
  u32x4 hAa, hBa, hAb, hBb, rrA[16], rrB[16];
  int xq[4];
  float xscale;
#define DOTS_QUANT(HA, HB) do { float _xv[16]; \
    _Pragma("unroll") for (int e = 0; e < 4; ++e) { _xv[2 * e] = bflo(HA[e]); _xv[2 * e + 1] = bfhi(HA[e]); _xv[8 + 2 * e] = bflo(HB[e]); _xv[8 + 2 * e + 1] = bfhi(HB[e]); } \
    float _am = 0.f; _Pragma("unroll") for (int e = 0; e < 16; ++e) _am = fmaxf(_am, fabsf(_xv[e])); \
    _am = DPP_MAX(_am, 0xB1); _am = DPP_MAX(_am, 0x4E); _am = DPP_MAX(_am, 0x141); \
    const float _qs = _am > 0.f ? 127.0f / _am : 0.f; xscale = _am * (1.0f / 127.0f); \
    _Pragma("unroll") for (int k = 0; k < 4; ++k) { \
      const int q0 = __float2int_rn(_xv[4 * k] * _qs), q1 = __float2int_rn(_xv[4 * k + 1] * _qs), q2 = __float2int_rn(_xv[4 * k + 2] * _qs), q3 = __float2int_rn(_xv[4 * k + 3] * _qs); \
      xq[k] = (int)(((unsigned)q0 & 255u) | (((unsigned)q1 & 255u) << 8) | (((unsigned)q2 & 255u) << 16) | ((unsigned)q3 << 24)); } } while (0)
#define DOTS_COMPUTE(T, RR) do { if ((T) < TTOK) { int pA = 0, pB = 0; \
    _Pragma("unroll") for (int g = 0; g < 16; ++g) { int d = 0; \
      _Pragma("unroll") for (int k = 0; k < 4; ++k) d = __builtin_amdgcn_sdot4((int)RR[g][k], xq[k], d, false); \
      d += DPP_I(d, 0xB1); d += DPP_I(d, 0x4E); d += DPP_I(d, 0x141); \
      if (c == (g & 7)) { if (g < 8) pA = d; else pB = d; } } \
    u16* _dst = pd + ((size_t)(T) * 8 + x) * 128 + 8 * c + r; \
    _dst[0] = (u16)(pack2((float)pA * xscale, 0.f) & 0xffffu); _dst[64] = (u16)(pack2((float)pB * xscale, 0.f) & 0xffffu); } } while (0)
  int t = wslot;
  PEER_META(t, iAa, iBa, hAa, hBa);
  PEER_META(t + nslot, iAb, iBb, hAb, hBb);
  PEER_GATHER(ub, iAa, iBa, rrA);
  for (; t < TTOK; t += 2 * nslot) {
    DOTS_QUANT(hAa, hBa);
    PEER_META(t + 2 * nslot, iAa, iBa, hAa, hBa);
    PEER_GATHER(ub, iAb, iBb, rrB);
    DOTS_COMPUTE(t, rrA);
    DOTS_QUANT(hAb, hBb);
    PEER_META(t + 3 * nslot, iAb, iBb, hAb, hBb);
    PEER_GATHER(ub, iAa, iBa, rrA);
    DOTS_COMPUTE(t + nslot, rrB);
  }
#undef DOTS_COMPUTE
#undef DOTS_QUANT
}

DI void phase_peer_w(const Params& p, int layer, int wave) {
  const int tid = otid_w(wave), lane = tid & 63, wid = tid >> 6;
  const u16* pd = W_Y(p);
  for (int t = blockIdx.x * 8 + wid; t < TTOK; t += gridDim.x * 8) {
#pragma unroll
    for (int hf = 0; hf < 2; ++hf) {
      const int j = hf * 64 + lane;
      float sacc = 0.f;
#pragma unroll
      for (int xx = 0; xx < 8; ++xx) sacc += __uint_as_float(((unsigned)pd[((size_t)t * 8 + xx) * 128 + j]) << 16);
      const int e = W_IDX(p)[(size_t)t * 128 + j];
      const float act = sacc * W_SU(p)[e];
      W_G(p)[(size_t)t * 128 + j] = W_G(p)[(size_t)t * 128 + j] * (0.5f * act * (1.0f + erff(act * 0.7071067811865476f))) * W_SV(p)[e];
    }
  }
}

#define PEER_META_V(T, IA, IB, WA, WB, HA, HB) do { const int _t = (T) < TTOK ? (T) : wslot; \
    IA = W_IDX(p)[(size_t)_t * 128 + lane]; IB = W_IDX(p)[(size_t)_t * 128 + 64 + lane]; \
    WA = W_G(p)[(size_t)_t * 128 + lane]; WB = W_G(p)[(size_t)_t * 128 + 64 + lane]; \
    const u16* _hp = W_H(p) + (size_t)_t * DM + x * 128 + 16 * c; HA = *(const u32x4*)(_hp); HB = *(const u32x4*)(_hp + 8); } while (0)
DI void phase_peer_v(const Params& p, int layer, int wave) {
  const int tid = otid_w(wave), lane = tid & 63, wid = tid >> 6, c = lane & 7, r = lane >> 3;
  const int x = blockIdx.x & 7, wslot = (blockIdx.x >> 3) * 8 + wid, nslot = (gridDim.x >> 3) * 8;
  const unsigned char* vb = W_VB(p) + (size_t)x * (PEER_N * 128) + c * 16;
  u16* y2 = W_Y(p);
  const int bp0 = 4 * r, idx32 = (lane ^ 32) << 2;
  int iAa, iBa, iAb, iBb;
  float wAa, wBa, wAb, wBb, wA, wB;
  u32x4 hAa, hBa, hAb, hBb, rrA[16], rrB[16];
  f32x2 xs[8];
#define V_COMPUTE(T, RR) do { if ((T) < TTOK) { f32x2 acc[8]; \
    _Pragma("unroll") for (int i = 0; i < 8; ++i) acc[i] = (f32x2){0.f, 0.f}; \
    _Pragma("unroll") for (int g = 0; g < 16; ++g) { \
      const float wj = __int_as_float(__builtin_amdgcn_ds_bpermute(bp0 + 32 * (g & 7), __float_as_int(g < 8 ? wA : wB))); \
      const f32x2 wj2 = (f32x2){wj, wj}; \
      _Pragma("unroll") for (int k = 0; k < 4; ++k) { \
        const f32x2 lo = __builtin_amdgcn_cvt_pk_f32_fp8((int)RR[g][k], false), hi = __builtin_amdgcn_cvt_pk_f32_fp8((int)RR[g][k], true); \
        acc[2 * k] += wj2 * lo; acc[2 * k + 1] += wj2 * hi; } } \
    _Pragma("unroll") for (int i = 0; i < 8; ++i) { _Pragma("unroll") for (int q = 0; q < 2; ++q) { \
        float v = acc[i][q]; v += DPP_F(v, 0x128); v += shx16(v); v += shx32(v, idx32); acc[i][q] = v; } } \
    if (r == 0) { u16* _dst = y2 + (size_t)(T) * DM + x * 128 + 16 * c; \
      _Pragma("unroll") for (int q = 0; q < 2; ++q) { u32x4 _o; \
        _Pragma("unroll") for (int e = 0; e < 4; ++e) _o[e] = pack2(ALPHA * xs[4 * q + e][0] + acc[4 * q + e][0], ALPHA * xs[4 * q + e][1] + acc[4 * q + e][1]); \
        *(u32x4*)(_dst + 8 * q) = _o; } } } } while (0)
  int t = wslot;
  PEER_META_V(t, iAa, iBa, wAa, wBa, hAa, hBa);
  PEER_META_V(t + nslot, iAb, iBb, wAb, wBb, hAb, hBb);
  PEER_GATHER(vb, iAa, iBa, rrA);
  for (; t < TTOK; t += 2 * nslot) {
    PEER_UNPACK(xs, hAa, hBa); wA = wAa; wB = wBa;
    PEER_META_V(t + 2 * nslot, iAa, iBa, wAa, wBa, hAa, hBa);
    PEER_GATHER(vb, iAb, iBb, rrB);
    V_COMPUTE(t, rrA);
    PEER_UNPACK(xs, hAb, hBb); wA = wAb; wB = wBb;
    PEER_META_V(t + 3 * nslot, iAb, iBb, wAb, wBb, hAb, hBb);
    PEER_GATHER(vb, iAa, iBa, rrA);
    V_COMPUTE(t + nslot, rrB);
  }
#undef V_COMPUTE
}

#define XB_TMO      128
#define XB_XCNT(j)  (256  + 64 * (j))
#define XB_XSUB(j)  (1280 + 64 * (j))
#define XB_XGEN(j)  (2304 + 64 * (j))
#define XB_TOP      3328
#define XB_TOPGEN   3392
#define XCD_BAR_WORDS 3456
#define XB_SPIN_CAP (1u << 22)
DI unsigned xb_ld(unsigned* p)              { return __hip_atomic_load(p, __ATOMIC_RELAXED, __HIP_MEMORY_SCOPE_AGENT); }
DI unsigned xb_add(unsigned* p, unsigned v) { return __hip_atomic_fetch_add(p, v, __ATOMIC_RELAXED, __HIP_MEMORY_SCOPE_AGENT); }
DI unsigned xb_xcc_id() { return (unsigned)__builtin_amdgcn_s_getreg((3 << 11) | 20) & 0xFu; }
#define XB_SPIN(cond, bar) do { unsigned _sp = 0; while (cond) { __builtin_amdgcn_s_sleep(1); \
    if ((++_sp & 255u) == 0u) { if (xb_ld(&(bar)[XB_TMO])) break; if (_sp > XB_SPIN_CAP) { atomicAdd(&(bar)[XB_TMO], 1u); break; } } } } while (0)
DI bool is_thread0(int wave) { unsigned z = 0u; asm volatile("" : "+v"(z)); return wave == 0 && __builtin_amdgcn_mbcnt_hi(~0u, __builtin_amdgcn_mbcnt_lo(~0u, z)) == 0u; }
DI void xcd_barrier_complete(unsigned* bar, unsigned x, unsigned& nloc, unsigned& nx) {
  const unsigned G = gridDim.x;
  unsigned sum, cnt, mine, sp = 0u;
  for (;;) {
    sum = 0u; cnt = 0u; mine = 0u;
#pragma unroll
    for (unsigned j = 0; j < 16; ++j) { const unsigned c = xb_ld(&bar[XB_XCNT(j)]); sum += c; cnt += (c > 0u) ? 1u : 0u; mine = (j == x) ? c : mine; }
    if (sum == G) break;
    __builtin_amdgcn_s_sleep(1);
    if ((++sp & 255u) == 0u) { if (xb_ld(&bar[XB_TMO])) break; if (sp > XB_SPIN_CAP) { atomicAdd(&bar[XB_TMO], 1u); break; } }
  }
  nloc = mine > 0u ? mine : 1u; nx = cnt > 0u ? cnt : 1u;
}
DI void xcd_barrier(unsigned* bar, volatile LAS unsigned* st, int wave) {
  asm volatile("s_waitcnt vmcnt(0)" ::: "memory");
  __syncthreads();
  if (is_thread0(wave)) {
    const unsigned x = xb_xcc_id();
    __builtin_amdgcn_s_waitcnt(0);
    unsigned nloc = st[0], nx = st[1];
    if (nloc == 0u) { xcd_barrier_complete(bar, x, nloc, nx); st[0] = nloc; st[1] = nx; }
    const unsigned old = xb_add(&bar[XB_XSUB(x)], 1u);
    const unsigned gen = old / nloc;
    if (old + 1u == (gen + 1u) * nloc) {
      __builtin_amdgcn_fence(__ATOMIC_RELEASE, "agent");
      asm volatile("s_waitcnt vmcnt(0)" ::: "memory");
      const unsigned og = xb_add(&bar[XB_TOP], 1u);
      const unsigned tg = og / nx;
      if (og + 1u == (tg + 1u) * nx) xb_add(&bar[XB_TOPGEN], 1u);
      else XB_SPIN(xb_ld(&bar[XB_TOPGEN]) == tg, bar);
      __builtin_amdgcn_fence(__ATOMIC_ACQUIRE, "agent");
      xb_add(&bar[XB_XGEN(x)], 1u);
      asm volatile("s_waitcnt vmcnt(0)" ::: "memory");
    } else {
      XB_SPIN(xb_ld(&bar[XB_XGEN(x)]) == gen, bar);
      __builtin_amdgcn_fence(__ATOMIC_ACQUIRE, "agent");
      asm volatile("s_waitcnt vmcnt(0)" ::: "memory");
    }
  }
  __syncthreads();
}

__global__ void __launch_bounds__(NTHREADS, 2) mega(Params p) {
  extern __shared__ __attribute__((aligned(16))) char smem[];
  cg::grid_group grid = cg::this_grid();
  const int wave = __builtin_amdgcn_readfirstlane((int)(threadIdx.x >> 6));
  unsigned* bar = (unsigned*)(p.ws + WS_BAR);
  volatile LAS unsigned* st = (volatile LAS unsigned*)((lchar*)smem + LDS_XB);
  if (threadIdx.x == 0) { st[0] = 0u; st[1] = 0u; (void)xb_add(&bar[XB_XCNT(xb_xcc_id())], 1u); }
  __syncthreads();
  phase_prologue(p, smem, wave);
  grid.sync();
  phase_fold(p, smem, wave);
  xcd_barrier(bar, st, wave);
#pragma unroll 1
  for (int step = 0; step < DEPTH * 9; ++step) {
    const int layer = step / 9, ph = step - layer * 9;
    if (ph == 0 || ph == 2 || ph == 4) phase_gemm(p, layer, ph >> 1, smem, wave);
    else if (ph == 1) phase_attn(p, layer, smem, wave);
    else if (ph == 3 || ph == 8) phase_ln(p, layer, ph == 8, wave);
    else if (ph == 5) phase_peer_dots(p, layer, wave);
    else if (ph == 6) phase_peer_w(p, layer, wave);
    else phase_peer_v(p, layer, wave);
    if (step + 1 < DEPTH * 9) xcd_barrier(bar, st, wave);
  }
}

extern "C" void kernel_launch(void* const* d_in, const int* in_sizes, int n_in, void* d_out, int out_size, void* d_ws, size_t ws_size,
                              hipStream_t stream) {
  static int grid_blocks = 0;
  if (grid_blocks == 0) {
    if (ws_size < WS_END) { fprintf(stderr, "kernel_launch: workspace too small: need %zu, got %zu\n", (size_t)WS_END, ws_size); grid_blocks = -1; return; }
    int dev = 0, cus = 0, per_cu = 0;
    hipGetDevice(&dev);
    hipDeviceGetAttribute(&cus, hipDeviceAttributeMultiprocessorCount, dev);
    hipFuncSetAttribute((const void*)mega, hipFuncAttributeMaxDynamicSharedMemorySize, LDS_BYTES);
    hipOccupancyMaxActiveBlocksPerMultiprocessor(&per_cu, (const void*)mega, NTHREADS, LDS_BYTES);
    if (per_cu < 1) per_cu = 1;
    if (per_cu > 1) per_cu = 1;
    grid_blocks = cus * per_cu;
  }
  if (grid_blocks < 0) return;
  Params p{};
  for (int i = 0; i < 21; ++i) p.in[i] = (const float*)d_in[i];
  p.out = (float*)d_out;
  p.ws = (char*)d_ws;
  if (hipMemsetAsync((char*)d_ws + WS_BAR, 0, 16384, stream) != hipSuccess) { fprintf(stderr, "kernel_launch: memset of the barrier words failed\n"); return; }
  void* args[] = {&p};
  hipError_t e = hipLaunchCooperativeKernel((const void*)mega, dim3(grid_blocks), dim3(NTHREADS), args, LDS_BYTES, stream);
  if (e != hipSuccess) fprintf(stderr, "cooperative launch failed: %s (grid %d)\n", hipGetErrorString(e), grid_blocks);
}
```

```cpp
#include <hip/hip_runtime.h>
#include <hip/hip_cooperative_groups.h>
#include <cstdio>
#include <cstdint>
namespace cg = cooperative_groups;

typedef unsigned short u16;
typedef __attribute__((ext_vector_type(8))) short bf16x8;
typedef __attribute__((ext_vector_type(4))) float f32x4;
typedef __attribute__((ext_vector_type(4))) unsigned u32x4;
typedef __attribute__((ext_vector_type(2))) unsigned u32x2;
typedef __attribute__((ext_vector_type(2))) float f32x2;
#define DI __device__ __forceinline__
#define LAS __attribute__((address_space(3)))
typedef LAS char lchar;

#define DM 1024
#define NBATCH 32
#define SEQ 2048
#define NMETA 16
#define LSEQ 2064
#define TTOK 66048
#define DEPTH 4
#define INC 3072
#define LP 2112
#define PEER_N 16384
#define NTHREADS 512
#define LDS_MISC 69632
#define LDS_HALF 70656
#define LDS_XB 141312
#define LDS_BYTES 141328

#define ALPHA 1.681792830507429f
#define LOG2E 1.4426950408889634f

static constexpr size_t WS_WIN  = 0;
static constexpr size_t WS_WOUT = WS_WIN  + (size_t)4 * 3072 * 1024 * 2;
static constexpr size_t WS_WQB  = WS_WOUT + (size_t)4 * 1024 * 1024 * 2;
static constexpr size_t WS_SKB  = WS_WQB  + (size_t)4 * 1024 * 2048 * 2;
static constexpr size_t WS_WSC  = WS_SKB  + (size_t)4 * 16 * 128 * 128 * 2;
static constexpr size_t WS_UB   = WS_WSC  + (size_t)4 * 2048 * 1024 * 2;
static constexpr size_t WS_VB   = WS_UB   + (size_t)PEER_N * 1024;
static constexpr size_t WS_SU   = WS_VB   + (size_t)PEER_N * 1024;
static constexpr size_t WS_SV   = WS_SU   + (size_t)PEER_N * 4;
static constexpr size_t WS_H    = WS_SV   + (size_t)PEER_N * 4;
static constexpr size_t WS_MIX  = WS_H    + (size_t)TTOK * 1024 * 2;
static constexpr size_t WS_BIG  = WS_MIX  + (size_t)TTOK * 1024 * 2;
static constexpr size_t WS_VT   = WS_BIG  + (size_t)(TTOK + 64) * 3072 * 2;
static constexpr size_t WS_IDX  = WS_VT   + (size_t)NBATCH * 4 * 128 * LP * 2;
static constexpr size_t WS_G    = WS_IDX  + (size_t)TTOK * 128 * 4;
static constexpr size_t WS_BAR  = WS_G    + (size_t)TTOK * 128 * 4;
static constexpr size_t WS_END  = WS_BAR  + 16384;

struct Params {
  const float* in[21];
  float* out;
  char* ws;
};
#define P_X(p) ((p).in[0])
#define P_META(p) ((p).in[1])
#define P_LN_IN_G(p) ((p).in[2])
#define P_LN_IN_B(p) ((p).in[3])
#define P_REL_BIAS(p) ((p).in[4])
#define P_W_IN(p) ((p).in[5])
#define P_CONV_W(p) ((p).in[6])
#define P_LQ1(p) ((p).in[7])
#define P_LK1(p) ((p).in[8])
#define P_LQ2(p) ((p).in[9])
#define P_LK2(p) ((p).in[10])
#define P_SUBLN_G(p) ((p).in[11])
#define P_W_OUT(p) ((p).in[12])
#define P_LN1_G(p) ((p).in[13])
#define P_LN1_B(p) ((p).in[14])
#define P_W_Q(p) ((p).in[15])
#define P_SUB_KEYS(p) ((p).in[16])
#define P_PEER_U(p) ((p).in[17])
#define P_PEER_V(p) ((p).in[18])
#define P_LN2_G(p) ((p).in[19])
#define P_LN2_B(p) ((p).in[20])
#define W_WIN(p) ((u16*)((p).ws + WS_WIN))
#define W_WOUT(p) ((u16*)((p).ws + WS_WOUT))
#define W_WQB(p) ((u16*)((p).ws + WS_WQB))
#define W_SKB(p) ((u16*)((p).ws + WS_SKB))
#define W_WSC(p) ((u16*)((p).ws + WS_WSC))
#define W_UB(p) ((unsigned char*)((p).ws + WS_UB))
#define W_VB(p) ((unsigned char*)((p).ws + WS_VB))
#define W_SU(p) ((float*)((p).ws + WS_SU))
#define W_SV(p) ((float*)((p).ws + WS_SV))
#define W_H(p) ((u16*)((p).ws + WS_H))
#define W_MIX(p) ((u16*)((p).ws + WS_MIX))
#define W_PROJ(p) ((u16*)((p).ws + WS_BIG))
#define W_Y(p) ((u16*)((p).ws + WS_BIG))
#define W_VT(p) ((u16*)((p).ws + WS_VT))
#define W_IDX(p) ((int*)((p).ws + WS_IDX))
#define W_G(p) ((float*)((p).ws + WS_G))

DI u16 f2bf(float x) { unsigned u = __float_as_uint(x); u += 0x7fffu + ((u >> 16) & 1u); return (u16)(u >> 16); }
typedef __attribute__((ext_vector_type(2))) __bf16 bf16x2_t;
DI unsigned pack2(float a, float b) { const bf16x2_t v = {(__bf16)a, (__bf16)b}; return __builtin_bit_cast(unsigned, v); }
DI float bflo(unsigned w) { return __uint_as_float(w << 16); }
DI float bfhi(unsigned w) { return __uint_as_float(w & 0xffff0000u); }
DI int otid_w(int wave) { unsigned z = 0u; asm volatile("" : "+v"(z)); int t = wave * 64 + (int)__builtin_amdgcn_mbcnt_hi(~0u, __builtin_amdgcn_mbcnt_lo(~0u, z)); asm volatile("" : "+v"(t)); return t; }
#define DPP_ADD(v, ctrl) ((v) + __int_as_float(__builtin_amdgcn_update_dpp(0, __float_as_int(v), (ctrl), 0xf, 0xf, true)))
DI float wave_sum(float v) {
  v = DPP_ADD(v, 0xB1);
  v = DPP_ADD(v, 0x4E);
  v = DPP_ADD(v, 0x141);
  v = DPP_ADD(v, 0x140);
  const int iv = __float_as_int(v);
  return __int_as_float(__builtin_amdgcn_readlane(iv, 0)) + __int_as_float(__builtin_amdgcn_readlane(iv, 16)) +
         __int_as_float(__builtin_amdgcn_readlane(iv, 32)) + __int_as_float(__builtin_amdgcn_readlane(iv, 48));
}
#define DPP_MAX(v, ctrl) fmaxf((v), __int_as_float(__builtin_amdgcn_update_dpp(0, __float_as_int(v), (ctrl), 0xf, 0xf, true)))
DI float wave_max_nonneg(float v) {
  v = DPP_MAX(v, 0xB1); v = DPP_MAX(v, 0x4E); v = DPP_MAX(v, 0x141); v = DPP_MAX(v, 0x140);
  const int iv = __float_as_int(v);
  return fmaxf(fmaxf(__int_as_float(__builtin_amdgcn_readlane(iv, 0)), __int_as_float(__builtin_amdgcn_readlane(iv, 16))),
               fmaxf(__int_as_float(__builtin_amdgcn_readlane(iv, 32)), __int_as_float(__builtin_amdgcn_readlane(iv, 48))));
}
DI float shx16(float v) { return __int_as_float(__builtin_amdgcn_ds_swizzle(__float_as_int(v), 0x401F)); }
DI float shx32(float v, int idx32) { return __int_as_float(__builtin_amdgcn_ds_bpermute(idx32, __float_as_int(v))); }
DI f32x4 mfma16(bf16x8 a, bf16x8 b, f32x4 c) { return __builtin_amdgcn_mfma_f32_16x16x32_bf16(a, b, c, 0, 0, 0); }
DI float fast_exp2(float x) { return __builtin_amdgcn_exp2f(x); }

DI void convert_straight(const float* __restrict__ src, u16* __restrict__ dst, size_t n8, size_t gtid, size_t gthreads) {
  for (size_t i = gtid; i < n8; i += gthreads) {
    const f32x4 a = *(const f32x4*)(src + i * 8), b = *(const f32x4*)(src + i * 8 + 4);
    u32x4 o; o[0] = pack2(a[0], a[1]); o[1] = pack2(a[2], a[3]); o[2] = pack2(b[0], b[1]); o[3] = pack2(b[2], b[3]);
    *(u32x4*)(dst + i * 8) = o;
  }
}

DI void transpose_tile(const float* __restrict__ src, int ldn, u16* __restrict__ dst, int ldk, int k0, int n0, float* sm, int tid) {
#pragma unroll
  for (int i = 0; i < 4; ++i) {
    const int r = (tid >> 4) + 16 * i, c4 = tid & 15;
    const f32x4 v = *(const f32x4*)(src + (size_t)(k0 + r) * ldn + n0 + 4 * c4);
    sm[r * 65 + 4 * c4 + 0] = v[0]; sm[r * 65 + 4 * c4 + 1] = v[1]; sm[r * 65 + 4 * c4 + 2] = v[2]; sm[r * 65 + 4 * c4 + 3] = v[3];
  }
  __syncthreads();
#pragma unroll
  for (int i = 0; i < 2; ++i) {
    const int n = (tid >> 3) + 32 * i, kc = tid & 7;
    u32x4 o;
#pragma unroll
    for (int e = 0; e < 4; ++e) o[e] = pack2(sm[(8 * kc + 2 * e) * 65 + n], sm[(8 * kc + 2 * e + 1) * 65 + n]);
    *(u32x4*)(dst + (size_t)(n0 + n) * ldk + k0 + 8 * kc) = o;
  }
  __syncthreads();
}

template <int LAYOUT> DI int col0(int lane, int hh) { return LAYOUT ? 16 * lane + 8 * hh : hh * 512 + 8 * lane; }
template <int LAYOUT>
DI void ln_row(float (&v)[16], const float* __restrict__ g, const float* __restrict__ b, int lane) {
  float s = 0.f;
#pragma unroll
  for (int i = 0; i < 16; ++i) s += v[i];
  const float mu = wave_sum(s) * (1.0f / 1024.0f);
  float q = 0.f;
#pragma unroll
  for (int i = 0; i < 16; ++i) { const float d = v[i] - mu; q += d * d; }
  const float rstd = rsqrtf(wave_sum(q) * (1.0f / 1024.0f) + 1e-5f);
#pragma unroll
  for (int hh = 0; hh < 2; ++hh) {
    const int c = col0<LAYOUT>(lane, hh);
    const f32x4 g0 = *(const f32x4*)(g + c), g1 = *(const f32x4*)(g + c + 4), b0 = *(const f32x4*)(b + c), b1 = *(const f32x4*)(b + c + 4);
#pragma unroll
    for (int e = 0; e < 4; ++e) {
      v[hh * 8 + e] = (v[hh * 8 + e] - mu) * rstd * g0[e] + b0[e];
      v[hh * 8 + 4 + e] = (v[hh * 8 + 4 + e] - mu) * rstd * g1[e] + b1[e];
    }
  }
}
template <int LAYOUT>
DI void store_row_bf16(u16* __restrict__ dst, const float (&v)[16], int lane) {
#pragma unroll
  for (int hh = 0; hh < 2; ++hh) {
    u32x4 o;
#pragma unroll
    for (int e = 0; e < 4; ++e) o[e] = pack2(v[hh * 8 + 2 * e], v[hh * 8 + 2 * e + 1]);
    *(u32x4*)(dst + col0<LAYOUT>(lane, hh)) = o;
  }
}
template <int LAYOUT>
DI void load_row_bf16(const u16* __restrict__ src, float (&v)[16], int lane) {
#pragma unroll
  for (int hh = 0; hh < 2; ++hh) {
    const u32x4 a = *(const u32x4*)(src + col0<LAYOUT>(lane, hh));
#pragma unroll
    for (int e = 0; e < 4; ++e) { v[hh * 8 + 2 * e] = bflo(a[e]); v[hh * 8 + 2 * e + 1] = bfhi(a[e]); }
  }
}
template <int LAYOUT>
DI void load_row_f32(const float* __restrict__ src, float (&v)[16], int lane) {
#pragma unroll
  for (int hh = 0; hh < 2; ++hh) {
    const int c = col0<LAYOUT>(lane, hh);
    const f32x4 a = *(const f32x4*)(src + c), b = *(const f32x4*)(src + c + 4);
#pragma unroll
    for (int e = 0; e < 4; ++e) { v[hh * 8 + e] = a[e]; v[hh * 8 + 4 + e] = b[e]; }
  }
}

enum { EPI_PROJ = 0, EPI_VT = 1, EPI_OUT = 2, EPI_TOPK = 3, EPI_FOLD = 4 };

template <bool SWAP>
DI void gemm_mainloop(const u16* __restrict__ A, int lda, const u16* __restrict__ Bt, int ldb, int K, int m0, int n0, char* smem,
                      f32x4 (&acc)[4][4], int tid) {
  const int lane = tid & 63, wid = tid >> 6, wm = wid >> 1, wn = wid & 1;
  const int srow = tid >> 3, skc = tid & 7;
  const u16* ap = A + (size_t)(m0 + srow) * lda + skc * 8;
  const u16* bp = Bt + (size_t)(n0 + srow) * ldb + skc * 8;
  const int dst0 = (((srow >> 4) * 2 + (skc >> 2)) * 1024) + (((skc & 3) * 16 + (srow & 15)) * 16);
#pragma unroll
  for (int i = 0; i < 4; ++i)
#pragma unroll
    for (int j = 0; j < 4; ++j) acc[i][j] = (f32x4){0.f, 0.f, 0.f, 0.f};
  u32x4 ra[4], rb[4];
#pragma unroll
  for (int j = 0; j < 4; ++j) { ra[j] = *(const u32x4*)(ap + (size_t)j * 32 * lda); rb[j] = *(const u32x4*)(bp + (size_t)j * 32 * ldb); }
#pragma unroll
  for (int j = 0; j < 4; ++j) { *(u32x4*)(smem + dst0 + j * 4096) = ra[j]; *(u32x4*)(smem + 16384 + dst0 + j * 4096) = rb[j]; }
  __syncthreads();
  const int KT = K >> 6;
  for (int kt = 0; kt < KT; ++kt) {
    char* cur = smem + (kt & 1) * 32768;
    char* nxt = smem + ((kt + 1) & 1) * 32768;
    const bool more = (kt + 1 < KT);
    if (more) {
      const u16* ap2 = ap + (kt + 1) * 64;
      const u16* bp2 = bp + (kt + 1) * 64;
#pragma unroll
      for (int j = 0; j < 4; ++j) { ra[j] = *(const u32x4*)(ap2 + (size_t)j * 32 * lda); rb[j] = *(const u32x4*)(bp2 + (size_t)j * 32 * ldb); }
    }
#pragma unroll
    for (int ks = 0; ks < 2; ++ks) {
      bf16x8 af[4], bfr[4];
#pragma unroll
      for (int i = 0; i < 4; ++i) af[i] = *(const bf16x8*)(cur + (((wm * 4 + i) * 2 + ks) * 1024) + lane * 16);
#pragma unroll
      for (int j = 0; j < 4; ++j) bfr[j] = *(const bf16x8*)(cur + 16384 + (((wn * 4 + j) * 2 + ks) * 1024) + lane * 16);
#pragma unroll
      for (int i = 0; i < 4; ++i)
#pragma unroll
        for (int j = 0; j < 4; ++j) acc[i][j] = SWAP ? mfma16(bfr[j], af[i], acc[i][j]) : mfma16(af[i], bfr[j], acc[i][j]);
    }
    if (more) {
#pragma unroll
      for (int j = 0; j < 4; ++j) { *(u32x4*)(nxt + dst0 + j * 4096) = ra[j]; *(u32x4*)(nxt + 16384 + dst0 + j * 4096) = rb[j]; }
    }
    __syncthreads();
  }
}

DI void ce_desc(float& hi, float& lo) { const float a = hi, b = lo; hi = fmaxf(a, b); lo = fminf(a, b); }
DI void bitonic_merge16(float (&v)[16]) {
#pragma unroll
  for (int j = 8; j > 0; j >>= 1)
#pragma unroll
    for (int i = 0; i < 16; ++i) if ((i & j) == 0) ce_desc(v[i], v[i | j]);
}
DI void bitonic_sort16(float (&v)[16]) {
#pragma unroll
  for (int k = 2; k <= 16; k <<= 1)
#pragma unroll
    for (int j = k >> 1; j > 0; j >>= 1)
#pragma unroll
      for (int i = 0; i < 16; ++i) {
        const int l = i ^ j;
        if (l > i) { if ((i & k) == 0 || k == 16) ce_desc(v[i], v[l]); else ce_desc(v[l], v[i]); }
      }
}
DI void merge_top16(float (&v)[16], const float (&w)[16]) {
#pragma unroll
  for (int i = 0; i < 16; ++i) v[i] = fmaxf(v[i], w[15 - i]);
  bitonic_merge16(v);
}
DI void insert16(float (&v)[16], float x) {
#pragma unroll
  for (int j = 0; j < 16; ++j) { const float hi = fmaxf(v[j], x); x = fminf(v[j], x); v[j] = hi; }
}

DI void gemm_tile_fold(const u16* A, int lda, const u16* Bt, int ldb, int K, int m0, char* smem, u16* dstT, int tid) {
  const int lane = tid & 63, wid = tid >> 6, wm = wid >> 1, wn = wid & 1, g = lane >> 4, l15 = lane & 15;
  f32x4 acc[4][4];
  gemm_mainloop<false>(A, lda, Bt, ldb, K, m0, 0, smem, acc, tid);
#pragma unroll
  for (int i = 0; i < 4; ++i)
#pragma unroll
    for (int j = 0; j < 4; ++j) {
      const int m = m0 + wm * 64 + 16 * i + 4 * g, n = wn * 64 + 16 * j + l15;
      u32x2 o; o[0] = pack2(acc[i][j][0], acc[i][j][1]); o[1] = pack2(acc[i][j][2], acc[i][j][3]);
      *(u32x2*)(dstT + (size_t)n * 1024 + m) = o;
    }
}

#define GK 1024
#define HTB 16384
DI int lds_byte(int r, int c) {
  const int st = (r >> 4) * 2 + (c >> 5), rr = r & 15, cc = c & 31, ob = rr * 64 + cc * 2;
  return st * 1024 + (ob ^ (((ob >> 9) & 1) << 5));
}
DI void stage_rc(int b, int& R, int& C) {
  const int st = b / 1024, sb = b % 1024, swz = sb ^ (((sb >> 9) & 1) << 5);
  R = (st >> 1) * 16 + swz / 64; C = (st & 1) * 32 + (swz % 64) / 2;
}
#define G_SA(b, h) (shm + ((b) * 2 + (h)) * HTB)
#define G_SB(b, h) (shm + (4 + (b) * 2 + (h)) * HTB)
#define G_STAGE(P, BASE, br, kt) do { const char* _g = (const char*)((BASE) + (size_t)(br) * GK + (kt) * 64); \
    __builtin_amdgcn_global_load_lds((const unsigned*)(_g + goff0), (LAS unsigned*)((P) + tid * 16), 16, 0, 0); \
    __builtin_amdgcn_global_load_lds((const unsigned*)(_g + goff1), (LAS unsigned*)((P) + tid * 16 + 8192), 16, 0, 0); } while (0)
#define G_LDA(dst, b, h) _Pragma("unroll") for (int m = 0; m < 4; ++m) _Pragma("unroll") for (int k = 0; k < 2; ++k) \
    dst[m][k] = *(const LAS bf16x8*)(G_SA(b, h) + lds_byte(wr * 64 + m * 16 + fr, k * 32 + fq * 8))
#define G_LDB(dst, b, h) _Pragma("unroll") for (int n = 0; n < 2; ++n) _Pragma("unroll") for (int k = 0; k < 2; ++k) \
    dst[n][k] = *(const LAS bf16x8*)(G_SB(b, h) + lds_byte(wc * 32 + n * 16 + fr, k * 32 + fq * 8))
#define G_MMA(ai, bj, At, Bx) do { __builtin_amdgcn_s_setprio(1); \
    _Pragma("unroll") for (int m = 0; m < 4; ++m) _Pragma("unroll") for (int n = 0; n < 2; ++n) _Pragma("unroll") for (int k = 0; k < 2; ++k) \
      acc[ai][bj][m][n] = __builtin_amdgcn_mfma_f32_16x16x32_bf16(At[m][k], Bx[n][k], acc[ai][bj][m][n], 0, 0, 0); \
    __builtin_amdgcn_s_setprio(0); } while (0)
#define WAIT_V(n) asm volatile("s_waitcnt vmcnt(" #n ")" ::: "memory")
#define WAIT_L(n) asm volatile("s_waitcnt lgkmcnt(" #n ")" ::: "memory")
#define BAR __builtin_amdgcn_s_barrier()
#define SCHED __builtin_amdgcn_sched_barrier(0)

DI void gemm256_core(const u16* __restrict__ A, const u16* __restrict__ Bt, int brow, int bcol, lchar* shm, int tid, f32x4 (&acc)[2][2][4][2]) {
  const int wid = tid >> 6, lane = tid & 63, wr = wid >> 2, wc = wid & 3, fr = lane & 15, fq = lane >> 4;
  int r0, c0, r1, c1;
  stage_rc(tid * 16, r0, c0); stage_rc(tid * 16 + 8192, r1, c1);
  const unsigned goff0 = (unsigned)(r0 * GK + c0) * 2u, goff1 = (unsigned)(r1 * GK + c1) * 2u;
#pragma unroll
  for (int ai = 0; ai < 2; ++ai)
#pragma unroll
    for (int bj = 0; bj < 2; ++bj)
#pragma unroll
      for (int m = 0; m < 4; ++m)
#pragma unroll
        for (int n = 0; n < 2; ++n) acc[ai][bj][m][n] = (f32x4){0.f, 0.f, 0.f, 0.f};
  bf16x8 At[4][2], B0[2][2], B1[2][2];
  const int nt = GK / 64;
  WAIT_V(0);
  __syncthreads();
  G_STAGE(G_SB(0, 0), Bt, bcol, 0); G_STAGE(G_SA(0, 0), A, brow, 0);
  G_STAGE(G_SB(0, 1), Bt, bcol + 128, 0); G_STAGE(G_SA(0, 1), A, brow + 128, 0);
  if (wr == 1) BAR;
  WAIT_V(4); BAR;
  G_STAGE(G_SB(1, 0), Bt, bcol, 1); G_STAGE(G_SA(1, 0), A, brow, 1); G_STAGE(G_SB(1, 1), Bt, bcol + 128, 1);
  WAIT_V(6); BAR;
  for (int t = 0; t < nt - 2; t += 2) {
    G_LDB(B0, 0, 0); SCHED; G_LDA(At, 0, 0); G_STAGE(G_SA(1, 1), A, brow + 128, t + 1);
    WAIT_L(8); BAR; WAIT_L(0); G_MMA(0, 0, At, B0); BAR; SCHED;
    G_LDB(B1, 0, 1); G_STAGE(G_SB(0, 0), Bt, bcol, t + 2);
    BAR; WAIT_L(0); G_MMA(0, 1, At, B1); BAR;
    G_LDA(At, 0, 1); G_STAGE(G_SA(0, 0), A, brow, t + 2);
    BAR; WAIT_L(0); G_MMA(1, 0, At, B0); BAR; SCHED;
    G_STAGE(G_SB(0, 1), Bt, bcol + 128, t + 2);
    WAIT_V(6); BAR; G_MMA(1, 1, At, B1); BAR;
    G_LDB(B0, 1, 0); SCHED; G_LDA(At, 1, 0); G_STAGE(G_SA(0, 1), A, brow + 128, t + 2);
    WAIT_L(8); BAR; WAIT_L(0); G_MMA(0, 0, At, B0); BAR; SCHED;
    G_LDB(B1, 1, 1); G_STAGE(G_SB(1, 0), Bt, bcol, t + 3);
    BAR; WAIT_L(0); G_MMA(0, 1, At, B1); BAR;
    G_LDA(At, 1, 1); G_STAGE(G_SA(1, 0), A, brow, t + 3);
    BAR; WAIT_L(0); G_MMA(1, 0, At, B0); BAR; SCHED;
    G_STAGE(G_SB(1, 1), Bt, bcol + 128, t + 3);
    WAIT_V(6); BAR; G_MMA(1, 1, At, B1); BAR;
  }
  { G_LDB(B0, 0, 0); G_LDA(At, 0, 0); G_STAGE(G_SA(1, 1), A, brow + 128, nt - 1);
    BAR; WAIT_L(0); G_MMA(0, 0, At, B0); BAR;
    G_LDB(B1, 0, 1); BAR; WAIT_L(0); G_MMA(0, 1, At, B1); BAR;
    G_LDA(At, 0, 1); WAIT_V(4); BAR; WAIT_L(0); G_MMA(1, 0, At, B0); G_MMA(1, 1, At, B1); BAR; }
  { G_LDB(B0, 1, 0); G_LDA(At, 1, 0); WAIT_V(2); BAR; WAIT_L(0); G_MMA(0, 0, At, B0); BAR;
    G_LDB(B1, 1, 1); WAIT_V(0); BAR; WAIT_L(0); G_MMA(0, 1, At, B1); BAR;
    G_LDA(At, 1, 1); BAR; WAIT_L(0); G_MMA(1, 0, At, B0); G_MMA(1, 1, At, B1); BAR; }
  if (wr == 0) BAR;
}

DI void gemm256_tile(const Params& p, int mode, int layer, const u16* R, const u16* Cc, int brow, int bcol, lchar* shm, int tid_in) {
  f32x4 acc[2][2][4][2];
  gemm256_core(R, Cc, brow, bcol, shm, tid_in, acc);
  int tid = tid_in;
  asm volatile("" : "+v"(tid));
  const int wid = tid >> 6, lane = tid & 63, wr = wid >> 2, wc = wid & 3, fr = lane & 15, fq = lane >> 4;
  if (mode == EPI_PROJ) {
#pragma unroll
    for (int ai = 0; ai < 2; ++ai)
#pragma unroll
      for (int bj = 0; bj < 2; ++bj)
#pragma unroll
        for (int m = 0; m < 4; ++m)
#pragma unroll
          for (int n = 0; n < 2; ++n) {
            const int nc = brow + ai * 128 + wr * 64 + m * 16 + fq * 4, tok = bcol + bj * 128 + wc * 32 + n * 16 + fr;
            const f32x4 v = acc[ai][bj][m][n];
            u32x2 o; o[0] = pack2(v[0], v[1]); o[1] = pack2(v[2], v[3]);
            *(u32x2*)(W_PROJ(p) + (size_t)tok * INC + nc) = o;
          }
  } else if (mode == EPI_VT) {
#pragma unroll
    for (int ai = 0; ai < 2; ++ai)
#pragma unroll
      for (int bj = 0; bj < 2; ++bj)
#pragma unroll
        for (int m = 0; m < 4; ++m)
#pragma unroll
          for (int n = 0; n < 2; ++n) {
            const int tok = brow + ai * 128 + wr * 64 + m * 16 + fq * 4, nn = bcol + bj * 128 + wc * 32 + n * 16 + fr - 1024;
            const int b = tok / LSEQ, pos = tok - b * LSEQ;
            const f32x4 v = acc[ai][bj][m][n];
            u32x2 o; o[0] = pack2(v[0], v[1]); o[1] = pack2(v[2], v[3]);
            *(u32x2*)(W_VT(p) + ((size_t)(b * 512 + nn)) * LP + pos) = o;
          }
  } else if (mode == EPI_OUT) {
#pragma unroll
    for (int ai = 0; ai < 2; ++ai)
#pragma unroll
      for (int bj = 0; bj < 2; ++bj) {
        u32x2 hv[4][2];
#pragma unroll
        for (int m = 0; m < 4; ++m)
#pragma unroll
          for (int n = 0; n < 2; ++n) {
            const int nc = brow + ai * 128 + wr * 64 + m * 16 + fq * 4, tok = bcol + bj * 128 + wc * 32 + n * 16 + fr;
            hv[m][n] = *(const u32x2*)(W_H(p) + (size_t)tok * DM + nc);
          }
#pragma unroll
        for (int m = 0; m < 4; ++m)
#pragma unroll
          for (int n = 0; n < 2; ++n) {
            const int nc = brow + ai * 128 + wr * 64 + m * 16 + fq * 4, tok = bcol + bj * 128 + wc * 32 + n * 16 + fr;
            const f32x4 v = acc[ai][bj][m][n];
            u32x2 o;
            o[0] = pack2(ALPHA * bflo(hv[m][n][0]) + v[0], ALPHA * bfhi(hv[m][n][0]) + v[1]);
            o[1] = pack2(ALPHA * bflo(hv[m][n][1]) + v[2], ALPHA * bfhi(hv[m][n][1]) + v[3]);
            *(u32x2*)(W_Y(p) + (size_t)tok * DM + nc) = o;
          }
      }
  } else {
    LAS float* S = (LAS float*)shm;
    const int tok = tid & 255, kh = tid >> 8;
    float L0[16], L1[16];
#pragma unroll
    for (int ai = 0; ai < 2; ++ai) {
      __syncthreads();
#pragma unroll
      for (int bj = 0; bj < 2; ++bj)
#pragma unroll
        for (int m = 0; m < 4; ++m)
#pragma unroll
          for (int n = 0; n < 2; ++n) {
            const int tk = bj * 128 + wc * 32 + n * 16 + fr, key = wr * 64 + m * 16 + fq * 4;
#pragma unroll
            for (int j = 0; j < 4; ++j) S[tk * 128 + ((key + j + tk) & 127)] = acc[ai][bj][m][n][j];
          }
      __syncthreads();
      float v[16];
#pragma unroll 1
      for (int ch = 0; ch < 4; ++ch) {
        float wk[16];
#pragma unroll
        for (int i = 0; i < 16; ++i) {
          const int key = kh * 64 + ch * 16 + i;
          const float x = S[tok * 128 + ((key + tok) & 127)];
          wk[i] = __uint_as_float((__float_as_uint(x) & ~127u) | (unsigned)key);
        }
        bitonic_sort16(wk);
        if (ch == 0) {
#pragma unroll
          for (int i = 0; i < 16; ++i) v[i] = wk[i];
        } else {
          merge_top16(v, wk);
        }
      }
      __syncthreads();
      if (kh == 1) {
#pragma unroll
        for (int j = 0; j < 16; ++j) S[tok * 16 + j] = v[j];
      }
      __syncthreads();
      if (kh == 0) {
        float wk[16];
#pragma unroll
        for (int j = 0; j < 16; ++j) wk[j] = S[tok * 16 + j];
        merge_top16(v, wk);
      }
#pragma unroll
      for (int j = 0; j < 16; ++j) { if (ai == 0) L0[j] = v[j]; else L1[j] = v[j]; }
    }
    __syncthreads();
    LAS unsigned* LL = (LAS unsigned*)shm;
    if (kh == 0) {
#pragma unroll
      for (int j = 0; j < 16; ++j) { LL[tok * 32 + ((j + tok) & 31)] = __float_as_uint(L0[j]); LL[tok * 32 + ((16 + j + tok) & 31)] = __float_as_uint(L1[j]); }
      float s1[16], s2[16], v[16];
#pragma unroll
      for (int j = 0; j < 16; ++j) { s1[j] = __uint_as_float(__float_as_uint(L0[j]) & ~127u); s2[j] = __uint_as_float(__float_as_uint(L1[j]) & ~127u); v[j] = -3.0e38f; }
#pragma unroll
      for (int ch = 0; ch < 4; ++ch) {
        float wk[16];
#pragma unroll
        for (int i = 0; i < 16; ++i) {
          constexpr unsigned char PAIRS[64] = {0, 1, 2, 3, 4, 5, 6, 7, 8, 9, 10, 11, 12, 13, 14, 15, 16, 17, 18, 19, 20, 21, 22, 23, 32, 33, 34, 35, 36, 48, 49, 50, 51, 64, 65, 66, 80, 81, 96, 97, 112, 113, 128, 144, 160, 176, 192, 208, 224, 240, 255, 255, 255, 255, 255, 255, 255, 255, 255, 255, 255, 255, 255, 255};
          const int code = PAIRS[ch * 16 + i];
          if (code == 255) { wk[i] = -3.0e38f; }
          else { const float sm = s1[code >> 4] + s2[code & 15]; wk[i] = __uint_as_float((__float_as_uint(sm) & ~255u) | (unsigned)code); }
        }
        if (ch == 0) {
#pragma unroll
          for (int i = 0; i < 16; ++i) v[i] = wk[i];
        } else {
          bitonic_sort16(wk);
          merge_top16(v, wk);
        }
      }
      float e[16], sum = 0.f;
      const float mx = __uint_as_float(__float_as_uint(v[0]) & ~255u);
#pragma unroll
      for (int j = 0; j < 16; ++j) { e[j] = fast_exp2((__uint_as_float(__float_as_uint(v[j]) & ~255u) - mx) * LOG2E); sum += e[j]; }
      const float inv = 1.0f / sum;
      const int hd = brow >> 8;
      int* di = W_IDX(p) + (size_t)(bcol + tok) * 128 + hd * 16;
      float* dg = W_G(p) + (size_t)(bcol + tok) * 128 + hd * 16;
#pragma unroll
      for (int q = 0; q < 4; ++q) {
        u32x4 oi; f32x4 og;
#pragma unroll
        for (int k = 0; k < 4; ++k) {
          const unsigned code = __float_as_uint(v[4 * q + k]) & 255u;
          const unsigned i1 = LL[tok * 32 + (((code >> 4) + tok) & 31)] & 127u, i2 = LL[tok * 32 + ((16 + (code & 15u) + tok) & 31)] & 127u;
          oi[k] = i1 * 128u + i2; og[k] = e[4 * q + k] * inv;
        }
        *(u32x4*)(di + 4 * q) = oi; *(f32x4*)(dg + 4 * q) = og;
      }
    }
    __syncthreads();
  }
}

#define ATT_MISC 131072
DI void attn_item(const Params& p, int layer, int b, int hh, int jq, lchar* sm, float lam, float oml, int tid) {
  const int lane = tid & 63, w = tid >> 6, g = lane >> 4, l15 = lane & 15;
  const int idx32 = (lane ^ 32) << 2;
  LAS float* tab = (LAS float*)(sm + ATT_MISC);
  LAS float* sg = tab + 208;
  __syncthreads();
  if (tid < 208) {
    const int d = tid - 80;
    float tv = -1.0e30f;
    if (d >= 0) {
      int bucket = d;
      if (d >= 16) {
        int lg = 16 + (int)(logf((float)d * (1.0f / 16.0f)) / 2.0794415416798357f * 16.0f);
        bucket = lg < 31 ? lg : 31;
      }
      tv = P_REL_BIAS(p)[bucket * 4 + hh] * LOG2E;
    }
    tab[tid] = tv;
    if (tid < 128) sg[tid] = P_SUBLN_G(p)[layer * 128 + tid] * oml;
  }
  const int q0w = 128 * jq + 16 * w;
  const int qpos = q0w + l15;
  const int qrow = b * LSEQ + (qpos < LSEQ ? qpos : LSEQ - 1);
  bf16x8 qf[2][2];
  {
    const u16* qp = W_PROJ(p) + (size_t)qrow * INC + hh * 128 + g * 8;
#pragma unroll
    for (int m = 0; m < 2; ++m)
#pragma unroll
      for (int ks = 0; ks < 2; ++ks) {
        const u32x4 raw = *(const u32x4*)(qp + m * 64 + ks * 32);
        u32x4 sc;
#pragma unroll
        for (int e = 0; e < 4; ++e) sc[e] = pack2(bflo(raw[e]) * (0.125f * LOG2E), bfhi(raw[e]) * (0.125f * LOG2E));
        qf[m][ks] = __builtin_bit_cast(bf16x8, sc);
      }
  }
  const int nkt = (2 * jq + 2) < 33 ? (2 * jq + 2) : 33;
  const char* ksrc[2]; const char* vsrc[2];
#pragma unroll
  for (int i = 0; i < 2; ++i) {
    const int bk = 2 * w + i, k16 = bk >> 2, m = (bk >> 1) & 1, ks = bk & 1;
    const int krow = 32 * (k16 >> 1) + 8 * (l15 >> 2) + 4 * (k16 & 1) + (l15 & 3);
    ksrc[i] = (const char*)(W_PROJ(p) + (size_t)(b * LSEQ + krow) * INC + 512 + hh * 128 + m * 64 + ks * 32 + g * 8);
    const int dv = 8 * bk + (lane >> 3), c = (lane & 7) ^ ((dv >> 1) & 7);
    vsrc[i] = (const char*)(W_VT(p) + ((size_t)((b * 4 + hh) * 128 + dv)) * LP + c * 8);
  }
  lchar* dmak = sm + (2 * w) * 1024 + lane * 16;
#define ATT_ISSUE(KT, SLOT) do { const size_t _ko = (size_t)(KT) * (64 * INC * 2), _vo = (size_t)(KT) * 128; lchar* _d = dmak + (SLOT) * 32768; \
    __builtin_amdgcn_global_load_lds((const unsigned*)(ksrc[0] + _ko), (LAS unsigned*)(_d), 16, 0, 0); \
    __builtin_amdgcn_global_load_lds((const unsigned*)(ksrc[1] + _ko), (LAS unsigned*)(_d + 1024), 16, 0, 0); \
    __builtin_amdgcn_global_load_lds((const unsigned*)(vsrc[0] + _vo), (LAS unsigned*)(_d + 16384), 16, 0, 0); \
    __builtin_amdgcn_global_load_lds((const unsigned*)(vsrc[1] + _vo), (LAS unsigned*)(_d + 16384 + 1024), 16, 0, 0); } while (0)
  int voff[2];
#pragma unroll
  for (int kk = 0; kk < 2; ++kk) voff[kk] = l15 * 128 + (((4 * kk + g) ^ ((l15 >> 1) & 7)) * 16);

  f32x4 O[2][8];
#pragma unroll
  for (int m = 0; m < 2; ++m)
#pragma unroll
    for (int dt = 0; dt < 8; ++dt) O[m][dt] = (f32x4){0.f, 0.f, 0.f, 0.f};
  float mrun[2] = {0.f, 0.f};
  f32x4 Osum[2] = {(f32x4){0.f, 0.f, 0.f, 0.f}, (f32x4){0.f, 0.f, 0.f, 0.f}};
  bf16x8 ones;
  { const short o1 = (l15 == 0) ? (short)0x3f80 : (short)0; ones = (bf16x8){o1, o1, o1, o1, o1, o1, o1, o1}; }

  WAIT_V(0);
  __syncthreads();
  const float tfar = tab[207];
  ATT_ISSUE(0, 0);
  ATT_ISSUE((1 < nkt ? 1 : nkt - 1), 1);
  for (int kt = 0; kt < nkt; ++kt) {
    { const int kn = (kt + 2 < nkt) ? kt + 2 : nkt - 1; ATT_ISSUE(kn, (kt + 2) & 3); }
    WAIT_V(8); BAR;
    if (64 * kt <= q0w + 15) {
      const lchar* kb = sm + (kt & 3) * 32768;
      const lchar* vb = kb + 16384;
      const bool near = (q0w - 64 * kt) < 176;
      const float tadd = near ? 0.f : tfar;
      const float sinit[2] = {tadd - mrun[0], tadd - mrun[1]};
      f32x4 S[2][4];
#pragma unroll
      for (int kh = 0; kh < 2; ++kh) {
        bf16x8 kf[2][2][2];
#pragma unroll
        for (int q = 0; q < 2; ++q)
#pragma unroll
          for (int m = 0; m < 2; ++m)
#pragma unroll
            for (int ks = 0; ks < 2; ++ks) kf[q][m][ks] = *(const LAS bf16x8*)(kb + ((((2 * kh + q) * 2 + m) * 2 + ks) * 1024) + lane * 16);
        SCHED;
#pragma unroll
        for (int q = 0; q < 2; ++q)
#pragma unroll
          for (int m = 0; m < 2; ++m) {
            f32x4 sacc = (f32x4){sinit[m], sinit[m], sinit[m], sinit[m]};
            sacc = mfma16(kf[q][m][0], qf[m][0], sacc);
            sacc = mfma16(kf[q][m][1], qf[m][1], sacc);
            S[m][2 * kh + q] = sacc;
          }
      }
      if (near) {
#pragma unroll
        for (int m = 0; m < 2; ++m)
#pragma unroll
          for (int k16 = 0; k16 < 4; ++k16)
#pragma unroll
            for (int r = 0; r < 4; ++r) {
              const int di = qpos + 80 - (64 * kt + 32 * (k16 >> 1) + 8 * g + 4 * (k16 & 1) + r);
              S[m][k16][r] += tab[di < 207 ? di : 207];
            }
      }
      bf16x8 pb[2][2];
#pragma unroll
      for (int m = 0; m < 2; ++m) {
        float mx = fmaxf(fmaxf(S[m][0][0], S[m][0][1]), fmaxf(S[m][0][2], S[m][0][3]));
#pragma unroll
        for (int k16 = 1; k16 < 4; ++k16) mx = fmaxf(fmaxf(mx, fmaxf(S[m][k16][0], S[m][k16][1])), fmaxf(S[m][k16][2], S[m][k16][3]));
        mx = fmaxf(mx, shx16(mx));
        mx = fmaxf(mx, shx32(mx, idx32));
        if (kt == 0 || __builtin_amdgcn_ballot_w64(mx > 8.0f) != 0ull) {
          const float dlt = kt == 0 ? mx : fmaxf(mx, 0.f);
          const float alpha = fast_exp2(-dlt);
          mrun[m] += dlt;
#pragma unroll
          for (int dt = 0; dt < 8; ++dt) { O[m][dt][0] *= alpha; O[m][dt][1] *= alpha; O[m][dt][2] *= alpha; O[m][dt][3] *= alpha; }
          Osum[m][0] *= alpha; Osum[m][1] *= alpha; Osum[m][2] *= alpha; Osum[m][3] *= alpha;
#pragma unroll
          for (int k16 = 0; k16 < 4; ++k16)
#pragma unroll
            for (int r = 0; r < 4; ++r) S[m][k16][r] -= dlt;
        }
#pragma unroll
        for (int k16 = 0; k16 < 4; ++k16)
#pragma unroll
          for (int r = 0; r < 4; ++r) S[m][k16][r] = fast_exp2(S[m][k16][r]);
#pragma unroll
        for (int kk = 0; kk < 2; ++kk) {
          u32x4 t;
          t[0] = pack2(S[m][2 * kk][0], S[m][2 * kk][1]); t[1] = pack2(S[m][2 * kk][2], S[m][2 * kk][3]);
          t[2] = pack2(S[m][2 * kk + 1][0], S[m][2 * kk + 1][1]); t[3] = pack2(S[m][2 * kk + 1][2], S[m][2 * kk + 1][3]);
          pb[m][kk] = __builtin_bit_cast(bf16x8, t);
          Osum[m] = mfma16(ones, pb[m][kk], Osum[m]);
        }
      }
#pragma unroll
      for (int kk = 0; kk < 2; ++kk) {
        bf16x8 vf[8];
#pragma unroll
        for (int dt = 0; dt < 8; ++dt) vf[dt] = *(const LAS bf16x8*)(vb + dt * 2048 + voff[kk]);
        SCHED;
#pragma unroll
        for (int dt = 0; dt < 8; ++dt) {
          O[0][dt] = mfma16(vf[dt], pb[0][kk], O[0][dt]);
          O[1][dt] = mfma16(vf[dt], pb[1][kk], O[1][dt]);
        }
      }
    }
  }
  WAIT_V(0);
#undef ATT_ISSUE
  float l0 = g == 0 ? Osum[0][0] : 0.f, l1 = g == 0 ? Osum[1][0] : 0.f;
  l0 += shx16(l0); l0 += shx32(l0, idx32);
  l1 += shx16(l1); l1 += shx32(l1, idx32);
  const float c1 = 1.0f / l0, c2 = lam / l1;
  float ss = 0.f;
#pragma unroll
  for (int dt = 0; dt < 8; ++dt)
#pragma unroll
    for (int r = 0; r < 4; ++r) { const float o = O[0][dt][r] * c1 - O[1][dt][r] * c2; O[0][dt][r] = o; ss += o * o; }
  ss += shx16(ss); ss += shx32(ss, idx32);
  const float rinv = rsqrtf(ss * (1.0f / 128.0f) + 1e-5f);
  if (qpos < LSEQ) {
    u16* dst = W_MIX(p) + (size_t)(b * LSEQ + qpos) * DM + hh * 128 + 4 * g;
#pragma unroll
    for (int dt = 0; dt < 8; ++dt) {
      const int dv0 = 16 * dt + 4 * g;
      u32x2 o;
      o[0] = pack2(O[0][dt][0] * rinv * sg[dv0 + 0], O[0][dt][1] * rinv * sg[dv0 + 1]);
      o[1] = pack2(O[0][dt][2] * rinv * sg[dv0 + 2], O[0][dt][3] * rinv * sg[dv0 + 3]);
      *(u32x2*)(dst + 16 * dt) = o;
    }
  }
}

DI void conv_item(const Params& p, int layer, int item, int tid) {
  const int ch = (tid & 63) * 8, t0 = item * 16 + 4 * (tid >> 6);
  const int pos0 = t0 % LSEQ;
  const bool head = pos0 == 0;
  const u16* row0 = W_PROJ(p) + (size_t)t0 * INC;
  u32x4 gc[6], zz[6], gb[4];
#pragma unroll
  for (int j = 0; j < 6; ++j) {
    const u16* r2 = row0 + (ptrdiff_t)((head && j < 2) ? 0 : (j - 2)) * INC;
    gc[j] = *(const u32x4*)(r2 + 2048 + ch); zz[j] = *(const u32x4*)(r2 + 2560 + ch);
  }
#pragma unroll
  for (int i = 0; i < 4; ++i) gb[i] = *(const u32x4*)(row0 + (size_t)i * INC + 1536 + ch);
  const float* cw = P_CONV_W(p) + (size_t)layer * 3 * 512 + ch;
  float w0[8], w1[8], w2[8];
#pragma unroll
  for (int e = 0; e < 8; ++e) { w0[e] = cw[e]; w1[e] = cw[512 + e]; w2[e] = cw[1024 + e]; }
  float pr[6][8];
#pragma unroll
  for (int j = 0; j < 6; ++j) {
    const float keep = (head && j < 2) ? 0.f : 1.f;
#pragma unroll
    for (int e = 0; e < 4; ++e) { pr[j][2 * e] = keep * bflo(gc[j][e]) * bflo(zz[j][e]); pr[j][2 * e + 1] = keep * bfhi(gc[j][e]) * bfhi(zz[j][e]); }
  }
#pragma unroll
  for (int i = 0; i < 4; ++i) {
    u32x4 o;
#pragma unroll
    for (int e = 0; e < 4; ++e) {
      const float a0 = w0[2 * e] * pr[i][2 * e] + w1[2 * e] * pr[i + 1][2 * e] + w2[2 * e] * pr[i + 2][2 * e];
      const float a1 = w0[2 * e + 1] * pr[i][2 * e + 1] + w1[2 * e + 1] * pr[i + 1][2 * e + 1] + w2[2 * e + 1] * pr[i + 2][2 * e + 1];
      o[e] = pack2(bflo(gb[i][e]) * a0, bfhi(gb[i][e]) * a1);
    }
    *(u32x4*)(W_MIX(p) + (size_t)(t0 + i) * DM + 512 + ch) = o;
  }
}

DI void phase_prologue(const Params& p, char* smem, int wave) {
  const int tid = otid_w(wave), lane = tid & 63, wid = tid >> 6, hb = tid >> 8, htid = tid & 255;
  const int nblk = gridDim.x, bid = blockIdx.x;
  const size_t gtid = (size_t)bid * NTHREADS + tid, gthreads = (size_t)nblk * NTHREADS;
  float* sm = (float*)(smem + hb * LDS_HALF);
  for (int it0 = bid; it0 < 2048; it0 += nblk) {
    const int it = it0 * 2 + hb;
    if (it < 3072) {
      const int l = it / 768, r = it % 768, kb = r / 48, nb = r % 48;
      transpose_tile(P_W_IN(p) + (size_t)l * 1024 * 3072, 3072, W_WIN(p) + (size_t)l * 3072 * 1024, 1024, kb * 64, nb * 64, sm, htid);
    } else {
      const int i2 = it - 3072, l = i2 / 256, r = i2 % 256, kb = r / 16, nb = r % 16;
      transpose_tile(P_W_OUT(p) + (size_t)l * 1024 * 1024, 1024, W_WOUT(p) + (size_t)l * 1024 * 1024, 1024, kb * 64, nb * 64, sm, htid);
    }
  }
  convert_straight(P_W_Q(p), W_WQB(p), (size_t)4 * 1024 * 2048 / 8, gtid, gthreads);
  convert_straight(P_SUB_KEYS(p), W_SKB(p), (size_t)4 * 16 * 128 * 128 / 8, gtid, gthreads);
  for (int t = bid * 8 + wid; t < TTOK; t += nblk * 8) {
    const int b = t / LSEQ, pos = t - b * LSEQ;
    const float* src = pos < NMETA ? P_META(p) + (size_t)pos * DM : P_X(p) + ((size_t)b * SEQ + pos - NMETA) * DM;
    float v[16];
    load_row_f32<0>(src, v, lane);
    ln_row<0>(v, P_LN_IN_G(p), P_LN_IN_B(p), lane);
    store_row_bf16<0>(W_H(p) + (size_t)t * DM, v, lane);
  }
}

DI void phase_fold(const Params& p, char* smem, int wave) {
  const int tid = otid_w(wave), hb = tid >> 8, htid = tid & 255;
  for (int it0 = blockIdx.x; it0 < 256; it0 += gridDim.x) {
    const int it = it0 * 2 + hb;
    const int l = it >> 7, hp = (it >> 3) & 15, mt = it & 7;
    gemm_tile_fold(W_WQB(p) + (size_t)l * 1024 * 2048 + hp * 128, 2048, W_SKB(p) + ((size_t)l * 16 + hp) * 128 * 128, 128, 128, mt * 128, smem + hb * 65536,
                   W_WSC(p) + (size_t)l * 2048 * 1024 + (size_t)hp * 128 * 1024, htid);
  }
}

DI bool tile_order(int i, int nM, int nN, int& pm, int& pn) {
  const int nwg = nM * nN;
  const long L = (long)i * gridDim.x + blockIdx.x;
  if (L >= nwg) return false;
  int wgid = (int)L;
  { const int q = nwg / 8, r = nwg % 8, xcd = wgid % 8, off = wgid / 8; wgid = (xcd < r ? xcd * (q + 1) : r * (q + 1) + (xcd - r) * q) + off; }
  const int nig = 8 * nN, gid = wgid / nig, fm = gid * 8, gsz = (nM - fm) < 8 ? (nM - fm) : 8;
  pm = fm + ((wgid % nig) % gsz); pn = (wgid % nig) / gsz;
  return true;
}

DI void phase_gemm(const Params& p, int layer, int which, char* smem, int wave) {
  const int tid0 = otid_w(wave);
  const u16* W = which == 0 ? W_WIN(p) + (size_t)layer * 3072 * 1024 : (which == 1 ? W_WOUT(p) + (size_t)layer * 1024 * 1024 : W_WSC(p) + (size_t)layer * 2048 * 1024);
  const u16* X = which == 1 ? W_MIX(p) : W_H(p);
  const int nN = which == 0 ? 12 : (which == 1 ? 4 : 8);
  int pm, pn;
  for (int i = 0; tile_order(i, 258, nN, pm, pn); ++i) {
    const bool vt = (which == 0) && (pn == 4 || pn == 5);
    const int mode = which == 0 ? (vt ? EPI_VT : EPI_PROJ) : (which == 1 ? EPI_OUT : EPI_TOPK);
    int tid = tid0;
    asm volatile("" : "+v"(tid));
    gemm256_tile(p, mode, layer, vt ? X : W, vt ? W : X, vt ? pm * 256 : pn * 256, vt ? pn * 256 : pm * 256, (lchar*)smem, tid);
  }
}

DI void phase_attn(const Params& p, int layer, char* smem, int wave) {
  const int tid = otid_w(wave), lane = tid & 63, hb = tid >> 8, htid = tid & 255;
  const float lam_init = 0.8f - 0.6f * expf(-0.3f * (float)layer);
  float d1 = P_LQ1(p)[layer * 64 + lane] * P_LK1(p)[layer * 64 + lane], d2 = P_LQ2(p)[layer * 64 + lane] * P_LK2(p)[layer * 64 + lane];
  d1 = wave_sum(d1); d2 = wave_sum(d2);
  const float lam = expf(d1) - expf(d2) + lam_init;
  for (int rd = 0; rd * (int)gridDim.x < 2176; ++rd) {
    const int o = rd * gridDim.x + ((rd & 1) ? (int)gridDim.x - 1 - (int)blockIdx.x : (int)blockIdx.x);
    if (o < 2176) { const int jq = 16 - (o >> 7), bh = o & 127; attn_item(p, layer, bh >> 2, bh & 3, jq, (lchar*)smem, lam, 1.0f - lam_init, tid); }
  }
  for (int it = blockIdx.x; it < 2064; it += gridDim.x) conv_item(p, layer, it * 2 + hb, htid);
}

DI void phase_ln(const Params& p, int layer, int which, int wave) {
  const int tid = otid_w(wave), lane = tid & 63, wid = tid >> 6;
  const int nblk = gridDim.x, bid = blockIdx.x;
  const float* lg = (which ? P_LN2_G(p) : P_LN1_G(p)) + layer * DM;
  const float* lb = (which ? P_LN2_B(p) : P_LN1_B(p)) + layer * DM;
  const bool final_out = which && (layer == DEPTH - 1);
  for (int t = bid * 8 + wid; t < TTOK; t += nblk * 8) {
    float v[16];
    load_row_bf16<0>(W_Y(p) + (size_t)t * DM, v, lane);
    ln_row<0>(v, lg, lb, lane);
    if (final_out) {
      const int b = t / LSEQ, pos = t - b * LSEQ;
      if (pos >= NMETA) {
        float* dst = p.out + ((size_t)b * SEQ + pos - NMETA) * DM;
#pragma unroll
        for (int hh = 0; hh < 2; ++hh) {
          *(f32x4*)(dst + hh * 512 + 8 * lane) = (f32x4){v[hh * 8], v[hh * 8 + 1], v[hh * 8 + 2], v[hh * 8 + 3]};
          *(f32x4*)(dst + hh * 512 + 8 * lane + 4) = (f32x4){v[hh * 8 + 4], v[hh * 8 + 5], v[hh * 8 + 6], v[hh * 8 + 7]};
        }
      }
    } else {
      store_row_bf16<0>(W_H(p) + (size_t)t * DM, v, lane);
    }
  }
  if (which) return;
  for (int r = bid * 8 + wid; r < 2 * PEER_N; r += nblk * 8) {
    const bool isv = r >= PEER_N;
    const int e = isv ? r - PEER_N : r;
    const float* src = (isv ? P_PEER_V(p) : P_PEER_U(p)) + ((size_t)layer * PEER_N + e) * DM + 16 * lane;
    f32x4 a[4];
#pragma unroll
    for (int k = 0; k < 4; ++k) a[k] = *(const f32x4*)(src + 4 * k);
    float am = 0.f;
#pragma unroll
    for (int k = 0; k < 4; ++k) am = fmaxf(am, fmaxf(fmaxf(fabsf(a[k][0]), fabsf(a[k][1])), fmaxf(fabsf(a[k][2]), fabsf(a[k][3]))));
    am = wave_max_nonneg(am);
    const float top = isv ? 224.0f : 127.0f;
    const float sc = am > 0.f ? top / am : 1.0f;
    if (lane == 0) (isv ? W_SV(p) : W_SU(p))[e] = am > 0.f ? am / top : 1.0f;
    u32x4 o;
#pragma unroll
    for (int k = 0; k < 4; ++k) {
      if (isv) {
        int w = 0;
        w = __builtin_amdgcn_cvt_pk_fp8_f32(a[k][0] * sc, a[k][1] * sc, w, false);
        w = __builtin_amdgcn_cvt_pk_fp8_f32(a[k][2] * sc, a[k][3] * sc, w, true);
        o[k] = (unsigned)w;
      } else {
        const int q0 = __float2int_rn(a[k][0] * sc), q1 = __float2int_rn(a[k][1] * sc), q2 = __float2int_rn(a[k][2] * sc), q3 = __float2int_rn(a[k][3] * sc);
        o[k] = ((unsigned)q0 & 255u) | (((unsigned)q1 & 255u) << 8) | (((unsigned)q2 & 255u) << 16) | ((unsigned)q3 << 24);
      }
    }
    *(u32x4*)((isv ? W_VB(p) : W_UB(p)) + (size_t)(lane >> 3) * (PEER_N * 128) + (size_t)e * 128 + 16 * (lane & 7)) = o;
  }
}

#define DPP_F(v, ctrl) __int_as_float(__builtin_amdgcn_update_dpp(0, __float_as_int(v), (ctrl), 0xf, 0xf, true))
#define PEER_META(T, IA, IB, HA, HB) do { const int _t = (T) < TTOK ? (T) : wslot; \
    IA = W_IDX(p)[(size_t)_t * 128 + lane]; IB = W_IDX(p)[(size_t)_t * 128 + 64 + lane]; \
    const u16* _hp = W_H(p) + (size_t)_t * DM + x * 128 + 16 * c; HA = *(const u32x4*)(_hp); HB = *(const u32x4*)(_hp + 8); } while (0)
#define PEER_GATHER(TAB, IA, IB, RR) do { _Pragma("unroll") for (int g = 0; g < 16; ++g) { \
    const unsigned _e = (unsigned)__builtin_amdgcn_ds_bpermute(bp0 + 32 * (g & 7), g < 8 ? IA : IB); RR[g] = *(const u32x4*)((TAB) + (_e * 128u + c16)); } } while (0)
#define PEER_UNPACK(XS, HA, HB) do { _Pragma("unroll") for (int e = 0; e < 4; ++e) { \
    XS[e] = (f32x2){bflo(HA[e]), bfhi(HA[e])}; XS[4 + e] = (f32x2){bflo(HB[e]), bfhi(HB[e])}; } } while (0)

#define DPP_I(v, ctrl) __builtin_amdgcn_update_dpp(0, (v), (ctrl), 0xf, 0xf, true)
DI void phase_peer_dots(const Params& p, int layer, int wave) {
  const int tid = otid_w(wave), lane = tid & 63, wid = tid >> 6, c = lane & 7, r = lane >> 3;
  const int x = blockIdx.x & 7, wslot = (blockIdx.x >> 3) * 8 + wid, nslot = (gridDim.x >> 3) * 8;
  const unsigned char* ub = W_UB(p) + (size_t)x * (PEER_N * 128);
  const unsigned c16 = (unsigned)c * 16u;
  u16* pd = W_Y(p);
  const int bp0 = 4 * r;
  int iAa, iBa, iAb, iBb;
  u32x4 hAa, hBa, hAb, hBb, rrA[16], rrB[16];
  int xq[4];
  float xscale;
#define DOTS_QUANT(HA, HB) do { float _xv[16]; \
    _Pragma("unroll") for (int e = 0; e < 4; ++e) { _xv[2 * e] = bflo(HA[e]); _xv[2 * e + 1] = bfhi(HA[e]); _xv[8 + 2 * e] = bflo(HB[e]); _xv[8 + 2 * e + 1] = bfhi(HB[e]); } \
    float _am = 0.f; _Pragma("unroll") for (int e = 0; e < 16; ++e) _am = fmaxf(_am, fabsf(_xv[e])); \
    _am = DPP_MAX(_am, 0xB1); _am = DPP_MAX(_am, 0x4E); _am = DPP_MAX(_am, 0x141); \
    const float _qs = _am > 0.f ? 127.0f / _am : 0.f; xscale = _am * (1.0f / 127.0f); \
    _Pragma("unroll") for (int k = 0; k < 4; ++k) { \
      const int q0 = __float2int_rn(_xv[4 * k] * _qs), q1 = __float2int_rn(_xv[4 * k + 1] * _qs), q2 = __float2int_rn(_xv[4 * k + 2] * _qs), q3 = __float2int_rn(_xv[4 * k + 3] * _qs); \
      xq[k] = (int)(((unsigned)q0 & 255u) | (((unsigned)q1 & 255u) << 8) | (((unsigned)q2 & 255u) << 16) | ((unsigned)q3 << 24)); } } while (0)
#define DOTS_COMPUTE(T, RR) do { if ((T) < TTOK) { int pA = 0, pB = 0; \
    _Pragma("unroll") for (int g = 0; g < 16; ++g) { int d = 0; \
      _Pragma("unroll") for (int k = 0; k < 4; ++k) d = __builtin_amdgcn_sdot4((int)RR[g][k], xq[k], d, false); \
      d += DPP_I(d, 0xB1); d += DPP_I(d, 0x4E); d += DPP_I(d, 0x141); \
      if (c == (g & 7)) { if (g < 8) pA = d; else pB = d; } } \
    u16* _dst = pd + ((size_t)(T) * 8 + x) * 128 + 8 * c + r; \
    _dst[0] = (u16)(pack2((float)pA * xscale, 0.f) & 0xffffu); _dst[64] = (u16)(pack2((float)pB * xscale, 0.f) & 0xffffu); } } while (0)
  int t = wslot;
  PEER_META(t, iAa, iBa, hAa, hBa);
  PEER_META(t + nslot, iAb, iBb, hAb, hBb);
  PEER_GATHER(ub, iAa, iBa, rrA);
  for (; t < TTOK; t += 2 * nslot) {
    DOTS_QUANT(hAa, hBa);
    PEER_META(t + 2 * nslot, iAa, iBa, hAa, hBa);
    PEER_GATHER(ub, iAb, iBb, rrB);
    DOTS_COMPUTE(t, rrA);
    DOTS_QUANT(hAb, hBb);
    PEER_META(t + 3 * nslot, iAb, iBb, hAb, hBb);
    PEER_GATHER(ub, iAa, iBa, rrA);
    DOTS_COMPUTE(t + nslot, rrB);
  }
#undef DOTS_COMPUTE
#undef DOTS_QUANT
}

DI void phase_peer_w(const Params& p, int layer, int wave) {
  const int tid = otid_w(wave), lane = tid & 63, wid = tid >> 6;
  const u16* pd = W_Y(p);
  for (int t = blockIdx.x * 8 + wid; t < TTOK; t += gridDim.x * 8) {
#pragma unroll
    for (int hf = 0; hf < 2; ++hf) {
      const int j = hf * 64 + lane;
      float sacc = 0.f;
#pragma unroll
      for (int xx = 0; xx < 8; ++xx) sacc += __uint_as_float(((unsigned)pd[((size_t)t * 8 + xx) * 128 + j]) << 16);
      const int e = W_IDX(p)[(size_t)t * 128 + j];
      const float act = sacc * W_SU(p)[e];
      W_G(p)[(size_t)t * 128 + j] = W_G(p)[(size_t)t * 128 + j] * (0.5f * act * (1.0f + erff(act * 0.7071067811865476f))) * W_SV(p)[e];
    }
  }
}

#define PEER_META_V(T, IA, IB, WA, WB, HR) do { const int _t = (T) < TTOK ? (T) : wslot; \
    IA = W_IDX(p)[(size_t)_t * 128 + lane]; IB = W_IDX(p)[(size_t)_t * 128 + 64 + lane]; \
    WA = W_G(p)[(size_t)_t * 128 + lane]; WB = W_G(p)[(size_t)_t * 128 + 64 + lane]; \
    HR = *(const u32x2*)(W_H(p) + (size_t)_t * DM + ocol); } while (0)
DI float swap32_add(float a, float b) {
  const u32x2 r = __builtin_amdgcn_permlane32_swap(__float_as_uint(a), __float_as_uint(b), false, false);
  return __uint_as_float(r[0]) + __uint_as_float(r[1]);
}
DI float swap16_add(float a, float b) {
  const u32x2 r = __builtin_amdgcn_permlane16_swap(__float_as_uint(a), __float_as_uint(b), false, false);
  return __uint_as_float(r[0]) + __uint_as_float(r[1]);
}
DI void phase_peer_v(const Params& p, int layer, int wave) {
  const int tid = otid_w(wave), lane = tid & 63, wid = tid >> 6, c = lane & 7, r = lane >> 3;
  const int x = blockIdx.x & 7, wslot = (blockIdx.x >> 3) * 8 + wid, nslot = (gridDim.x >> 3) * 8;
  const unsigned char* vb = W_VB(p) + (size_t)x * (PEER_N * 128);
  const unsigned c16 = (unsigned)c * 16u;
  u16* y2 = W_Y(p);
  const int bp0 = 4 * r;
  const int ocol = x * 128 + 16 * c + 4 * ((lane >> 4) & 1) + 8 * (lane >> 5);
  int iAa, iBa, iAb, iBb;
  float wAa, wBa, wAb, wBb, wA, wB;
  u32x2 hRa, hRb, hR;
  u32x4 rrA[16], rrB[16];
#define V_COMPUTE(T, RR) do { if ((T) < TTOK) { f32x2 acc[8]; \
    _Pragma("unroll") for (int i = 0; i < 8; ++i) acc[i] = (f32x2){0.f, 0.f}; \
    _Pragma("unroll") for (int g = 0; g < 16; ++g) { \
      const float wj = __int_as_float(__builtin_amdgcn_ds_bpermute(bp0 + 32 * (g & 7), __float_as_int(g < 8 ? wA : wB))); \
      const f32x2 wj2 = (f32x2){wj, wj}; \
      _Pragma("unroll") for (int k = 0; k < 4; ++k) { \
        const f32x2 lo = __builtin_amdgcn_cvt_pk_f32_fp8((int)RR[g][k], false), hi = __builtin_amdgcn_cvt_pk_f32_fp8((int)RR[g][k], true); \
        acc[2 * k] += wj2 * lo; acc[2 * k + 1] += wj2 * hi; } } \
    float P8[8], Q4[4]; \
    _Pragma("unroll") for (int i = 0; i < 8; ++i) P8[i] = swap32_add(acc[i >> 1][i & 1], acc[(i + 8) >> 1][i & 1]);     \
    _Pragma("unroll") for (int i = 0; i < 4; ++i) Q4[i] = swap16_add(P8[i], P8[i + 4]);                                 \
    _Pragma("unroll") for (int i = 0; i < 4; ++i) Q4[i] += DPP_F(Q4[i], 0x128);                                         \
    if ((lane & 8) == 0) { u32x2 _o; \
      _o[0] = pack2(ALPHA * bflo(hR[0]) + Q4[0], ALPHA * bfhi(hR[0]) + Q4[1]); \
      _o[1] = pack2(ALPHA * bflo(hR[1]) + Q4[2], ALPHA * bfhi(hR[1]) + Q4[3]); \
      *(u32x2*)(y2 + (size_t)(T) * DM + ocol) = _o; } } } while (0)
  int t = wslot;
  PEER_META_V(t, iAa, iBa, wAa, wBa, hRa);
  PEER_META_V(t + nslot, iAb, iBb, wAb, wBb, hRb);
  PEER_GATHER(vb, iAa, iBa, rrA);
  for (; t < TTOK; t += 2 * nslot) {
    wA = wAa; wB = wBa; hR = hRa;
    PEER_META_V(t + 2 * nslot, iAa, iBa, wAa, wBa, hRa);
    PEER_GATHER(vb, iAb, iBb, rrB);
    V_COMPUTE(t, rrA);
    wA = wAb; wB = wBb; hR = hRb;
    PEER_META_V(t + 3 * nslot, iAb, iBb, wAb, wBb, hRb);
    PEER_GATHER(vb, iAa, iBa, rrA);
    V_COMPUTE(t + nslot, rrB);
  }
#undef V_COMPUTE
}

#define XB_TMO      128
#define XB_XCNT(j)  (256  + 64 * (j))
#define XB_XSUB(j)  (1280 + 64 * (j))
#define XB_XGEN(j)  (2304 + 64 * (j))
#define XB_TOP      3328
#define XB_TOPGEN   3392
#define XCD_BAR_WORDS 3456
#define XB_SPIN_CAP (1u << 22)
DI unsigned xb_ld(unsigned* p)              { return __hip_atomic_load(p, __ATOMIC_RELAXED, __HIP_MEMORY_SCOPE_AGENT); }
DI unsigned xb_add(unsigned* p, unsigned v) { return __hip_atomic_fetch_add(p, v, __ATOMIC_RELAXED, __HIP_MEMORY_SCOPE_AGENT); }
DI unsigned xb_xcc_id() { return (unsigned)__builtin_amdgcn_s_getreg((3 << 11) | 20) & 0xFu; }
#define XB_SPIN(cond, bar) do { unsigned _sp = 0; while (cond) { __builtin_amdgcn_s_sleep(1); \
    if ((++_sp & 255u) == 0u) { if (xb_ld(&(bar)[XB_TMO])) break; if (_sp > XB_SPIN_CAP) { atomicAdd(&(bar)[XB_TMO], 1u); break; } } } } while (0)
DI bool is_thread0(int wave) { unsigned z = 0u; asm volatile("" : "+v"(z)); return wave == 0 && __builtin_amdgcn_mbcnt_hi(~0u, __builtin_amdgcn_mbcnt_lo(~0u, z)) == 0u; }
DI void xcd_barrier_complete(unsigned* bar, unsigned x, unsigned& nloc, unsigned& nx) {
  const unsigned G = gridDim.x;
  unsigned sum, cnt, mine, sp = 0u;
  for (;;) {
    sum = 0u; cnt = 0u; mine = 0u;
#pragma unroll
    for (unsigned j = 0; j < 16; ++j) { const unsigned c = xb_ld(&bar[XB_XCNT(j)]); sum += c; cnt += (c > 0u) ? 1u : 0u; mine = (j == x) ? c : mine; }
    if (sum == G) break;
    __builtin_amdgcn_s_sleep(1);
    if ((++sp & 255u) == 0u) { if (xb_ld(&bar[XB_TMO])) break; if (sp > XB_SPIN_CAP) { atomicAdd(&bar[XB_TMO], 1u); break; } }
  }
  nloc = mine > 0u ? mine : 1u; nx = cnt > 0u ? cnt : 1u;
}
DI void xcd_barrier(unsigned* bar, volatile LAS unsigned* st, int wave) {
  asm volatile("s_waitcnt vmcnt(0)" ::: "memory");
  __syncthreads();
  if (is_thread0(wave)) {
    const unsigned x = xb_xcc_id();
    __builtin_amdgcn_s_waitcnt(0);
    unsigned nloc = st[0], nx = st[1];
    if (nloc == 0u) { xcd_barrier_complete(bar, x, nloc, nx); st[0] = nloc; st[1] = nx; }
    const unsigned old = xb_add(&bar[XB_XSUB(x)], 1u);
    const unsigned gen = old / nloc;
    if (old + 1u == (gen + 1u) * nloc) {
      __builtin_amdgcn_fence(__ATOMIC_RELEASE, "agent");
      asm volatile("s_waitcnt vmcnt(0)" ::: "memory");
      const unsigned og = xb_add(&bar[XB_TOP], 1u);
      const unsigned tg = og / nx;
      if (og + 1u == (tg + 1u) * nx) xb_add(&bar[XB_TOPGEN], 1u);
      else XB_SPIN(xb_ld(&bar[XB_TOPGEN]) == tg, bar);
      __builtin_amdgcn_fence(__ATOMIC_ACQUIRE, "agent");
      xb_add(&bar[XB_XGEN(x)], 1u);
      asm volatile("s_waitcnt vmcnt(0)" ::: "memory");
    } else {
      XB_SPIN(xb_ld(&bar[XB_XGEN(x)]) == gen, bar);
      __builtin_amdgcn_fence(__ATOMIC_ACQUIRE, "agent");
      asm volatile("s_waitcnt vmcnt(0)" ::: "memory");
    }
  }
  __syncthreads();
}

__global__ void __launch_bounds__(NTHREADS, 2) mega(Params p) {
  extern __shared__ __attribute__((aligned(16))) char smem[];
  cg::grid_group grid = cg::this_grid();
  const int wave = __builtin_amdgcn_readfirstlane((int)(threadIdx.x >> 6));
  unsigned* bar = (unsigned*)(p.ws + WS_BAR);
  volatile LAS unsigned* st = (volatile LAS unsigned*)((lchar*)smem + LDS_XB);
  if (threadIdx.x == 0) { st[0] = 0u; st[1] = 0u; (void)xb_add(&bar[XB_XCNT(xb_xcc_id())], 1u); }
  __syncthreads();
  phase_prologue(p, smem, wave);
  grid.sync();
  phase_fold(p, smem, wave);
  xcd_barrier(bar, st, wave);
#pragma unroll 1
  for (int step = 0; step < DEPTH * 9; ++step) {
    const int layer = step / 9, ph = step - layer * 9;
    if (ph == 0 || ph == 2 || ph == 4) phase_gemm(p, layer, ph >> 1, smem, wave);
    else if (ph == 1) phase_attn(p, layer, smem, wave);
    else if (ph == 3 || ph == 8) phase_ln(p, layer, ph == 8, wave);
    else if (ph == 5) phase_peer_dots(p, layer, wave);
    else if (ph == 6) phase_peer_w(p, layer, wave);
    else phase_peer_v(p, layer, wave);
    if (step + 1 < DEPTH * 9) xcd_barrier(bar, st, wave);
  }
}

extern "C" void kernel_launch(void* const* d_in, const int* in_sizes, int n_in, void* d_out, int out_size, void* d_ws, size_t ws_size,
                              hipStream_t stream) {
  static int grid_blocks = 0;
  if (grid_blocks == 0) {
    if (ws_size < WS_END) { fprintf(stderr, "kernel_launch: workspace too small: need %zu, got %zu\n", (size_t)WS_END, ws_size); grid_blocks = -1; return; }
    int dev = 0, cus = 0, per_cu = 0;
    hipGetDevice(&dev);
    hipDeviceGetAttribute(&cus, hipDeviceAttributeMultiprocessorCount, dev);
    hipFuncSetAttribute((const void*)mega, hipFuncAttributeMaxDynamicSharedMemorySize, LDS_BYTES);
    hipOccupancyMaxActiveBlocksPerMultiprocessor(&per_cu, (const void*)mega, NTHREADS, LDS_BYTES);
    if (per_cu < 1) per_cu = 1;
    if (per_cu > 1) per_cu = 1;
    grid_blocks = cus * per_cu;
  }
  if (grid_blocks < 0) return;
  Params p{};
  for (int i = 0; i < 21; ++i) p.in[i] = (const float*)d_in[i];
  p.out = (float*)d_out;
  p.ws = (char*)d_ws;
  if (hipMemsetAsync((char*)d_ws + WS_BAR, 0, 16384, stream) != hipSuccess) { fprintf(stderr, "kernel_launch: memset of the barrier words failed\n"); return; }
  void* args[] = {&p};
  hipError_t e = hipLaunchCooperativeKernel((const void*)mega, dim3(grid_blocks), dim3(NTHREADS), args, LDS_BYTES, stream);
  if (e != hipSuccess) fprintf(stderr, "cooperative launch failed: %s (grid %d)\n", hipGetErrorString(e), grid_blocks);
}
```

```cpp
#include <hip/hip_runtime.h>
#include <hip/hip_cooperative_groups.h>
#include <cstdio>
#include <cstdint>
namespace cg = cooperative_groups;

typedef unsigned short u16;
typedef __attribute__((ext_vector_type(8))) short bf16x8;
typedef __attribute__((ext_vector_type(4))) float f32x4;
typedef __attribute__((ext_vector_type(4))) unsigned u32x4;
typedef __attribute__((ext_vector_type(2))) unsigned u32x2;
typedef __attribute__((ext_vector_type(2))) float f32x2;
#define DI __device__ __forceinline__
#define LAS __attribute__((address_space(3)))
typedef LAS char lchar;

#define DM 1024
#define NBATCH 32
#define SEQ 2048
#define NMETA 16
#define LSEQ 2064
#define TTOK 66048
#define DEPTH 4
#define INC 3072
#define LP 2112
#define PEER_N 16384
#define NTHREADS 512
#define LDS_MISC 69632
#define LDS_HALF 70656
#define LDS_XB 141312
#define LDS_BYTES 141328

#define ALPHA 1.681792830507429f
#define LOG2E 1.4426950408889634f

static constexpr size_t WS_WIN  = 0;
static constexpr size_t WS_WOUT = WS_WIN  + (size_t)4 * 3072 * 1024 * 2;
static constexpr size_t WS_WQB  = WS_WOUT + (size_t)4 * 1024 * 1024 * 2;
static constexpr size_t WS_SKB  = WS_WQB  + (size_t)4 * 1024 * 2048 * 2;
static constexpr size_t WS_WSC  = WS_SKB  + (size_t)4 * 16 * 128 * 128 * 2;
static constexpr size_t WS_UB   = WS_WSC  + (size_t)4 * 2048 * 1024 * 2;
static constexpr size_t WS_VB   = WS_UB   + (size_t)PEER_N * 1024;
static constexpr size_t WS_SU   = WS_VB   + (size_t)PEER_N * 1024;
static constexpr size_t WS_SV   = WS_SU   + (size_t)PEER_N * 4;
static constexpr size_t WS_H    = WS_SV   + (size_t)PEER_N * 4;
static constexpr size_t WS_MIX  = WS_H    + (size_t)TTOK * 1024 * 2;
static constexpr size_t WS_BIG  = WS_MIX  + (size_t)TTOK * 1024 * 2;
static constexpr size_t WS_VT   = WS_BIG  + (size_t)(TTOK + 64) * 3072 * 2;
static constexpr size_t WS_IDX  = WS_VT   + (size_t)NBATCH * 4 * 128 * LP * 2;
static constexpr size_t WS_G    = WS_IDX  + (size_t)TTOK * 128 * 4;
static constexpr size_t WS_W16  = WS_G    + (size_t)TTOK * 128 * 4;
static constexpr size_t WS_BAR  = WS_W16  + (size_t)TTOK * 128 * 2;
static constexpr size_t WS_END  = WS_BAR  + 16384;

struct Params {
  const float* in[21];
  float* out;
  char* ws;
};
#define P_X(p) ((p).in[0])
#define P_META(p) ((p).in[1])
#define P_LN_IN_G(p) ((p).in[2])
#define P_LN_IN_B(p) ((p).in[3])
#define P_REL_BIAS(p) ((p).in[4])
#define P_W_IN(p) ((p).in[5])
#define P_CONV_W(p) ((p).in[6])
#define P_LQ1(p) ((p).in[7])
#define P_LK1(p) ((p).in[8])
#define P_LQ2(p) ((p).in[9])
#define P_LK2(p) ((p).in[10])
#define P_SUBLN_G(p) ((p).in[11])
#define P_W_OUT(p) ((p).in[12])
#define P_LN1_G(p) ((p).in[13])
#define P_LN1_B(p) ((p).in[14])
#define P_W_Q(p) ((p).in[15])
#define P_SUB_KEYS(p) ((p).in[16])
#define P_PEER_U(p) ((p).in[17])
#define P_PEER_V(p) ((p).in[18])
#define P_LN2_G(p) ((p).in[19])
#define P_LN2_B(p) ((p).in[20])
#define W_WIN(p) ((u16*)((p).ws + WS_WIN))
#define W_WOUT(p) ((u16*)((p).ws + WS_WOUT))
#define W_WQB(p) ((u16*)((p).ws + WS_WQB))
#define W_SKB(p) ((u16*)((p).ws + WS_SKB))
#define W_WSC(p) ((u16*)((p).ws + WS_WSC))
#define W_UB(p) ((unsigned char*)((p).ws + WS_UB))
#define W_VB(p) ((unsigned char*)((p).ws + WS_VB))
#define W_SU(p) ((float*)((p).ws + WS_SU))
#define W_SV(p) ((float*)((p).ws + WS_SV))
#define W_H(p) ((u16*)((p).ws + WS_H))
#define W_MIX(p) ((u16*)((p).ws + WS_MIX))
#define W_PROJ(p) ((u16*)((p).ws + WS_BIG))
#define W_Y(p) ((u16*)((p).ws + WS_BIG))
#define W_VT(p) ((u16*)((p).ws + WS_VT))
#define W_IDX(p) ((u16*)((p).ws + WS_IDX))
#define W_W16(p) ((u16*)((p).ws + WS_W16))
#define W_G(p) ((float*)((p).ws + WS_G))

DI u16 f2bf(float x) { unsigned u = __float_as_uint(x); u += 0x7fffu + ((u >> 16) & 1u); return (u16)(u >> 16); }
typedef __attribute__((ext_vector_type(2))) __bf16 bf16x2_t;
DI unsigned pack2(float a, float b) { const bf16x2_t v = {(__bf16)a, (__bf16)b}; return __builtin_bit_cast(unsigned, v); }
DI float bflo(unsigned w) { return __uint_as_float(w << 16); }
DI float bfhi(unsigned w) { return __uint_as_float(w & 0xffff0000u); }
DI int otid_w(int wave) { unsigned z = 0u; asm volatile("" : "+v"(z)); int t = wave * 64 + (int)__builtin_amdgcn_mbcnt_hi(~0u, __builtin_amdgcn_mbcnt_lo(~0u, z)); asm volatile("" : "+v"(t)); return t; }
#define DPP_ADD(v, ctrl) ((v) + __int_as_float(__builtin_amdgcn_update_dpp(0, __float_as_int(v), (ctrl), 0xf, 0xf, true)))
DI float wave_sum(float v) {
  v = DPP_ADD(v, 0xB1);
  v = DPP_ADD(v, 0x4E);
  v = DPP_ADD(v, 0x141);
  v = DPP_ADD(v, 0x140);
  const int iv = __float_as_int(v);
  return __int_as_float(__builtin_amdgcn_readlane(iv, 0)) + __int_as_float(__builtin_amdgcn_readlane(iv, 16)) +
         __int_as_float(__builtin_amdgcn_readlane(iv, 32)) + __int_as_float(__builtin_amdgcn_readlane(iv, 48));
}
#define DPP_MAX(v, ctrl) fmaxf((v), __int_as_float(__builtin_amdgcn_update_dpp(0, __float_as_int(v), (ctrl), 0xf, 0xf, true)))
DI float wave_max_nonneg(float v) {
  v = DPP_MAX(v, 0xB1); v = DPP_MAX(v, 0x4E); v = DPP_MAX(v, 0x141); v = DPP_MAX(v, 0x140);
  const int iv = __float_as_int(v);
  return fmaxf(fmaxf(__int_as_float(__builtin_amdgcn_readlane(iv, 0)), __int_as_float(__builtin_amdgcn_readlane(iv, 16))),
               fmaxf(__int_as_float(__builtin_amdgcn_readlane(iv, 32)), __int_as_float(__builtin_amdgcn_readlane(iv, 48))));
}
DI float shx16(float v) { return __int_as_float(__builtin_amdgcn_ds_swizzle(__float_as_int(v), 0x401F)); }
DI float shx32(float v, int idx32) { return __int_as_float(__builtin_amdgcn_ds_bpermute(idx32, __float_as_int(v))); }
DI f32x4 mfma16(bf16x8 a, bf16x8 b, f32x4 c) { return __builtin_amdgcn_mfma_f32_16x16x32_bf16(a, b, c, 0, 0, 0); }
DI float fast_exp2(float x) { return __builtin_amdgcn_exp2f(x); }

DI void convert_straight(const float* __restrict__ src, u16* __restrict__ dst, size_t n8, size_t gtid, size_t gthreads) {
  for (size_t i = gtid; i < n8; i += gthreads) {
    const f32x4 a = *(const f32x4*)(src + i * 8), b = *(const f32x4*)(src + i * 8 + 4);
    u32x4 o; o[0] = pack2(a[0], a[1]); o[1] = pack2(a[2], a[3]); o[2] = pack2(b[0], b[1]); o[3] = pack2(b[2], b[3]);
    *(u32x4*)(dst + i * 8) = o;
  }
}

DI void transpose_tile(const float* __restrict__ src, int ldn, u16* __restrict__ dst, int ldk, int k0, int n0, float* sm, int tid) {
#pragma unroll
  for (int i = 0; i < 4; ++i) {
    const int r = (tid >> 4) + 16 * i, c4 = tid & 15;
    const f32x4 v = *(const f32x4*)(src + (size_t)(k0 + r) * ldn + n0 + 4 * c4);
    sm[r * 65 + 4 * c4 + 0] = v[0]; sm[r * 65 + 4 * c4 + 1] = v[1]; sm[r * 65 + 4 * c4 + 2] = v[2]; sm[r * 65 + 4 * c4 + 3] = v[3];
  }
  __syncthreads();
#pragma unroll
  for (int i = 0; i < 2; ++i) {
    const int n = (tid >> 3) + 32 * i, kc = tid & 7;
    u32x4 o;
#pragma unroll
    for (int e = 0; e < 4; ++e) o[e] = pack2(sm[(8 * kc + 2 * e) * 65 + n], sm[(8 * kc + 2 * e + 1) * 65 + n]);
    *(u32x4*)(dst + (size_t)(n0 + n) * ldk + k0 + 8 * kc) = o;
  }
  __syncthreads();
}

template <int LAYOUT> DI int col0(int lane, int hh) { return LAYOUT ? 16 * lane + 8 * hh : hh * 512 + 8 * lane; }
template <int LAYOUT>
DI void ln_row(float (&v)[16], const float* __restrict__ g, const float* __restrict__ b, int lane) {
  float s = 0.f;
#pragma unroll
  for (int i = 0; i < 16; ++i) s += v[i];
  const float mu = wave_sum(s) * (1.0f / 1024.0f);
  float q = 0.f;
#pragma unroll
  for (int i = 0; i < 16; ++i) { const float d = v[i] - mu; q += d * d; }
  const float rstd = rsqrtf(wave_sum(q) * (1.0f / 1024.0f) + 1e-5f);
#pragma unroll
  for (int hh = 0; hh < 2; ++hh) {
    const int c = col0<LAYOUT>(lane, hh);
    const f32x4 g0 = *(const f32x4*)(g + c), g1 = *(const f32x4*)(g + c + 4), b0 = *(const f32x4*)(b + c), b1 = *(const f32x4*)(b + c + 4);
#pragma unroll
    for (int e = 0; e < 4; ++e) {
      v[hh * 8 + e] = (v[hh * 8 + e] - mu) * rstd * g0[e] + b0[e];
      v[hh * 8 + 4 + e] = (v[hh * 8 + 4 + e] - mu) * rstd * g1[e] + b1[e];
    }
  }
}
template <int LAYOUT>
DI void store_row_bf16(u16* __restrict__ dst, const float (&v)[16], int lane) {
#pragma unroll
  for (int hh = 0; hh < 2; ++hh) {
    u32x4 o;
#pragma unroll
    for (int e = 0; e < 4; ++e) o[e] = pack2(v[hh * 8 + 2 * e], v[hh * 8 + 2 * e + 1]);
    *(u32x4*)(dst + col0<LAYOUT>(lane, hh)) = o;
  }
}
template <int LAYOUT>
DI void load_row_bf16(const u16* __restrict__ src, float (&v)[16], int lane) {
#pragma unroll
  for (int hh = 0; hh < 2; ++hh) {
    const u32x4 a = *(const u32x4*)(src + col0<LAYOUT>(lane, hh));
#pragma unroll
    for (int e = 0; e < 4; ++e) { v[hh * 8 + 2 * e] = bflo(a[e]); v[hh * 8 + 2 * e + 1] = bfhi(a[e]); }
  }
}
template <int LAYOUT>
DI void load_row_f32(const float* __restrict__ src, float (&v)[16], int lane) {
#pragma unroll
  for (int hh = 0; hh < 2; ++hh) {
    const int c = col0<LAYOUT>(lane, hh);
    const f32x4 a = *(const f32x4*)(src + c), b = *(const f32x4*)(src + c + 4);
#pragma unroll
    for (int e = 0; e < 4; ++e) { v[hh * 8 + e] = a[e]; v[hh * 8 + 4 + e] = b[e]; }
  }
}

enum { EPI_PROJ = 0, EPI_VT = 1, EPI_OUT = 2, EPI_TOPK = 3, EPI_FOLD = 4 };

template <bool SWAP>
DI void gemm_mainloop(const u16* __restrict__ A, int lda, const u16* __restrict__ Bt, int ldb, int K, int m0, int n0, char* smem,
                      f32x4 (&acc)[4][4], int tid) {
  const int lane = tid & 63, wid = tid >> 6, wm = wid >> 1, wn = wid & 1;
  const int srow = tid >> 3, skc = tid & 7;
  const u16* ap = A + (size_t)(m0 + srow) * lda + skc * 8;
  const u16* bp = Bt + (size_t)(n0 + srow) * ldb + skc * 8;
  const int dst0 = (((srow >> 4) * 2 + (skc >> 2)) * 1024) + (((skc & 3) * 16 + (srow & 15)) * 16);
#pragma unroll
  for (int i = 0; i < 4; ++i)
#pragma unroll
    for (int j = 0; j < 4; ++j) acc[i][j] = (f32x4){0.f, 0.f, 0.f, 0.f};
  u32x4 ra[4], rb[4];
#pragma unroll
  for (int j = 0; j < 4; ++j) { ra[j] = *(const u32x4*)(ap + (size_t)j * 32 * lda); rb[j] = *(const u32x4*)(bp + (size_t)j * 32 * ldb); }
#pragma unroll
  for (int j = 0; j < 4; ++j) { *(u32x4*)(smem + dst0 + j * 4096) = ra[j]; *(u32x4*)(smem + 16384 + dst0 + j * 4096) = rb[j]; }
  __syncthreads();
  const int KT = K >> 6;
  for (int kt = 0; kt < KT; ++kt) {
    char* cur = smem + (kt & 1) * 32768;
    char* nxt = smem + ((kt + 1) & 1) * 32768;
    const bool more = (kt + 1 < KT);
    if (more) {
      const u16* ap2 = ap + (kt + 1) * 64;
      const u16* bp2 = bp + (kt + 1) * 64;
#pragma unroll
      for (int j = 0; j < 4; ++j) { ra[j] = *(const u32x4*)(ap2 + (size_t)j * 32 * lda); rb[j] = *(const u32x4*)(bp2 + (size_t)j * 32 * ldb); }
    }
#pragma unroll
    for (int ks = 0; ks < 2; ++ks) {
      bf16x8 af[4], bfr[4];
#pragma unroll
      for (int i = 0; i < 4; ++i) af[i] = *(const bf16x8*)(cur + (((wm * 4 + i) * 2 + ks) * 1024) + lane * 16);
#pragma unroll
      for (int j = 0; j < 4; ++j) bfr[j] = *(const bf16x8*)(cur + 16384 + (((wn * 4 + j) * 2 + ks) * 1024) + lane * 16);
#pragma unroll
      for (int i = 0; i < 4; ++i)
#pragma unroll
        for (int j = 0; j < 4; ++j) acc[i][j] = SWAP ? mfma16(bfr[j], af[i], acc[i][j]) : mfma16(af[i], bfr[j], acc[i][j]);
    }
    if (more) {
#pragma unroll
      for (int j = 0; j < 4; ++j) { *(u32x4*)(nxt + dst0 + j * 4096) = ra[j]; *(u32x4*)(nxt + 16384 + dst0 + j * 4096) = rb[j]; }
    }
    __syncthreads();
  }
}

DI void ce_desc(float& hi, float& lo) { const float a = hi, b = lo; hi = fmaxf(a, b); lo = fminf(a, b); }
DI void bitonic_merge16(float (&v)[16]) {
#pragma unroll
  for (int j = 8; j > 0; j >>= 1)
#pragma unroll
    for (int i = 0; i < 16; ++i) if ((i & j) == 0) ce_desc(v[i], v[i | j]);
}
DI void bitonic_sort16(float (&v)[16]) {
#pragma unroll
  for (int k = 2; k <= 16; k <<= 1)
#pragma unroll
    for (int j = k >> 1; j > 0; j >>= 1)
#pragma unroll
      for (int i = 0; i < 16; ++i) {
        const int l = i ^ j;
        if (l > i) { if ((i & k) == 0 || k == 16) ce_desc(v[i], v[l]); else ce_desc(v[l], v[i]); }
      }
}
DI void merge_top16(float (&v)[16], const float (&w)[16]) {
#pragma unroll
  for (int i = 0; i < 16; ++i) v[i] = fmaxf(v[i], w[15 - i]);
  bitonic_merge16(v);
}
DI void insert16(float (&v)[16], float x) {
#pragma unroll
  for (int j = 0; j < 16; ++j) { const float hi = fmaxf(v[j], x); x = fminf(v[j], x); v[j] = hi; }
}

DI void gemm_tile_fold(const u16* A, int lda, const u16* Bt, int ldb, int K, int m0, char* smem, u16* dstT, int tid) {
  const int lane = tid & 63, wid = tid >> 6, wm = wid >> 1, wn = wid & 1, g = lane >> 4, l15 = lane & 15;
  f32x4 acc[4][4];
  gemm_mainloop<false>(A, lda, Bt, ldb, K, m0, 0, smem, acc, tid);
#pragma unroll
  for (int i = 0; i < 4; ++i)
#pragma unroll
    for (int j = 0; j < 4; ++j) {
      const int m = m0 + wm * 64 + 16 * i + 4 * g, n = wn * 64 + 16 * j + l15;
      u32x2 o; o[0] = pack2(acc[i][j][0], acc[i][j][1]); o[1] = pack2(acc[i][j][2], acc[i][j][3]);
      *(u32x2*)(dstT + (size_t)n * 1024 + m) = o;
    }
}

#define GK 1024
#define HTB 16384
DI int lds_byte(int r, int c) {
  const int st = (r >> 4) * 2 + (c >> 5), rr = r & 15, cc = c & 31, ob = rr * 64 + cc * 2;
  return st * 1024 + (ob ^ (((ob >> 9) & 1) << 5));
}
DI void stage_rc(int b, int& R, int& C) {
  const int st = b / 1024, sb = b % 1024, swz = sb ^ (((sb >> 9) & 1) << 5);
  R = (st >> 1) * 16 + swz / 64; C = (st & 1) * 32 + (swz % 64) / 2;
}
#define G_SA(b, h) (shm + ((b) * 2 + (h)) * HTB)
#define G_SB(b, h) (shm + (4 + (b) * 2 + (h)) * HTB)
#define G_STAGE(P, BASE, br, kt) do { const char* _g = (const char*)((BASE) + (size_t)(br) * GK + (kt) * 64); \
    __builtin_amdgcn_global_load_lds((const unsigned*)(_g + goff0), (LAS unsigned*)((P) + tid * 16), 16, 0, 0); \
    __builtin_amdgcn_global_load_lds((const unsigned*)(_g + goff1), (LAS unsigned*)((P) + tid * 16 + 8192), 16, 0, 0); } while (0)
#define G_LDA(dst, b, h) _Pragma("unroll") for (int m = 0; m < 4; ++m) _Pragma("unroll") for (int k = 0; k < 2; ++k) \
    dst[m][k] = *(const LAS bf16x8*)(G_SA(b, h) + lds_byte(wr * 64 + m * 16 + fr, k * 32 + fq * 8))
#define G_LDB(dst, b, h) _Pragma("unroll") for (int n = 0; n < 2; ++n) _Pragma("unroll") for (int k = 0; k < 2; ++k) \
    dst[n][k] = *(const LAS bf16x8*)(G_SB(b, h) + lds_byte(wc * 32 + n * 16 + fr, k * 32 + fq * 8))
#define G_MMA(ai, bj, At, Bx) do { __builtin_amdgcn_s_setprio(1); \
    _Pragma("unroll") for (int m = 0; m < 4; ++m) _Pragma("unroll") for (int n = 0; n < 2; ++n) _Pragma("unroll") for (int k = 0; k < 2; ++k) \
      acc[ai][bj][m][n] = __builtin_amdgcn_mfma_f32_16x16x32_bf16(At[m][k], Bx[n][k], acc[ai][bj][m][n], 0, 0, 0); \
    __builtin_amdgcn_s_setprio(0); } while (0)
#define WAIT_V(n) asm volatile("s_waitcnt vmcnt(" #n ")" ::: "memory")
#define WAIT_L(n) asm volatile("s_waitcnt lgkmcnt(" #n ")" ::: "memory")
#define BAR __builtin_amdgcn_s_barrier()
#define SCHED __builtin_amdgcn_sched_barrier(0)

DI void gemm256_core(const u16* __restrict__ A, const u16* __restrict__ Bt, int brow, int bcol, lchar* shm, int tid, f32x4 (&acc)[2][2][4][2]) {
  const int wid = tid >> 6, lane = tid & 63, wr = wid >> 2, wc = wid & 3, fr = lane & 15, fq = lane >> 4;
  int r0, c0, r1, c1;
  stage_rc(tid * 16, r0, c0); stage_rc(tid * 16 + 8192, r1, c1);
  const unsigned goff0 = (unsigned)(r0 * GK + c0) * 2u, goff1 = (unsigned)(r1 * GK + c1) * 2u;
#pragma unroll
  for (int ai = 0; ai < 2; ++ai)
#pragma unroll
    for (int bj = 0; bj < 2; ++bj)
#pragma unroll
      for (int m = 0; m < 4; ++m)
#pragma unroll
        for (int n = 0; n < 2; ++n) acc[ai][bj][m][n] = (f32x4){0.f, 0.f, 0.f, 0.f};
  bf16x8 At[4][2], B0[2][2], B1[2][2];
  const int nt = GK / 64;
  WAIT_V(0);
  __syncthreads();
  G_STAGE(G_SB(0, 0), Bt, bcol, 0); G_STAGE(G_SA(0, 0), A, brow, 0);
  G_STAGE(G_SB(0, 1), Bt, bcol + 128, 0); G_STAGE(G_SA(0, 1), A, brow + 128, 0);
  if (wr == 1) BAR;
  WAIT_V(4); BAR;
  G_STAGE(G_SB(1, 0), Bt, bcol, 1); G_STAGE(G_SA(1, 0), A, brow, 1); G_STAGE(G_SB(1, 1), Bt, bcol + 128, 1);
  WAIT_V(6); BAR;
  for (int t = 0; t < nt - 2; t += 2) {
    G_LDB(B0, 0, 0); SCHED; G_LDA(At, 0, 0); G_STAGE(G_SA(1, 1), A, brow + 128, t + 1);
    WAIT_L(8); BAR; WAIT_L(0); G_MMA(0, 0, At, B0); BAR; SCHED;
    G_LDB(B1, 0, 1); G_STAGE(G_SB(0, 0), Bt, bcol, t + 2);
    BAR; WAIT_L(0); G_MMA(0, 1, At, B1); BAR;
    G_LDA(At, 0, 1); G_STAGE(G_SA(0, 0), A, brow, t + 2);
    BAR; WAIT_L(0); G_MMA(1, 0, At, B0); BAR; SCHED;
    G_STAGE(G_SB(0, 1), Bt, bcol + 128, t + 2);
    WAIT_V(6); BAR; G_MMA(1, 1, At, B1); BAR;
    G_LDB(B0, 1, 0); SCHED; G_LDA(At, 1, 0); G_STAGE(G_SA(0, 1), A, brow + 128, t + 2);
    WAIT_L(8); BAR; WAIT_L(0); G_MMA(0, 0, At, B0); BAR; SCHED;
    G_LDB(B1, 1, 1); G_STAGE(G_SB(1, 0), Bt, bcol, t + 3);
    BAR; WAIT_L(0); G_MMA(0, 1, At, B1); BAR;
    G_LDA(At, 1, 1); G_STAGE(G_SA(1, 0), A, brow, t + 3);
    BAR; WAIT_L(0); G_MMA(1, 0, At, B0); BAR; SCHED;
    G_STAGE(G_SB(1, 1), Bt, bcol + 128, t + 3);
    WAIT_V(6); BAR; G_MMA(1, 1, At, B1); BAR;
  }
  { G_LDB(B0, 0, 0); G_LDA(At, 0, 0); G_STAGE(G_SA(1, 1), A, brow + 128, nt - 1);
    BAR; WAIT_L(0); G_MMA(0, 0, At, B0); BAR;
    G_LDB(B1, 0, 1); BAR; WAIT_L(0); G_MMA(0, 1, At, B1); BAR;
    G_LDA(At, 0, 1); WAIT_V(4); BAR; WAIT_L(0); G_MMA(1, 0, At, B0); G_MMA(1, 1, At, B1); BAR; }
  { G_LDB(B0, 1, 0); G_LDA(At, 1, 0); WAIT_V(2); BAR; WAIT_L(0); G_MMA(0, 0, At, B0); BAR;
    G_LDB(B1, 1, 1); WAIT_V(0); BAR; WAIT_L(0); G_MMA(0, 1, At, B1); BAR;
    G_LDA(At, 1, 1); BAR; WAIT_L(0); G_MMA(1, 0, At, B0); G_MMA(1, 1, At, B1); BAR; }
  if (wr == 0) BAR;
}

DI void gemm256_tile(const Params& p, int mode, int layer, const u16* R, const u16* Cc, int brow, int bcol, lchar* shm, int tid_in) {
  f32x4 acc[2][2][4][2];
  gemm256_core(R, Cc, brow, bcol, shm, tid_in, acc);
  int tid = tid_in;
  asm volatile("" : "+v"(tid));
  const int wid = tid >> 6, lane = tid & 63, wr = wid >> 2, wc = wid & 3, fr = lane & 15, fq = lane >> 4;
  if (mode == EPI_PROJ) {
#pragma unroll
    for (int ai = 0; ai < 2; ++ai)
#pragma unroll
      for (int bj = 0; bj < 2; ++bj)
#pragma unroll
        for (int m = 0; m < 4; ++m)
#pragma unroll
          for (int n = 0; n < 2; ++n) {
            const int nc = brow + ai * 128 + wr * 64 + m * 16 + fq * 4, tok = bcol + bj * 128 + wc * 32 + n * 16 + fr;
            const f32x4 v = acc[ai][bj][m][n];
            u32x2 o; o[0] = pack2(v[0], v[1]); o[1] = pack2(v[2], v[3]);
            *(u32x2*)(W_PROJ(p) + (size_t)tok * INC + nc) = o;
          }
  } else if (mode == EPI_VT) {
#pragma unroll
    for (int ai = 0; ai < 2; ++ai)
#pragma unroll
      for (int bj = 0; bj < 2; ++bj)
#pragma unroll
        for (int m = 0; m < 4; ++m)
#pragma unroll
          for (int n = 0; n < 2; ++n) {
            const int tok = brow + ai * 128 + wr * 64 + m * 16 + fq * 4, nn = bcol + bj * 128 + wc * 32 + n * 16 + fr - 1024;
            const int b = tok / LSEQ, pos = tok - b * LSEQ;
            const f32x4 v = acc[ai][bj][m][n];
            u32x2 o; o[0] = pack2(v[0], v[1]); o[1] = pack2(v[2], v[3]);
            *(u32x2*)(W_VT(p) + ((size_t)(b * 512 + nn)) * LP + pos) = o;
          }
  } else if (mode == EPI_OUT) {
#pragma unroll
    for (int ai = 0; ai < 2; ++ai)
#pragma unroll
      for (int bj = 0; bj < 2; ++bj) {
        u32x2 hv[4][2];
#pragma unroll
        for (int m = 0; m < 4; ++m)
#pragma unroll
          for (int n = 0; n < 2; ++n) {
            const int nc = brow + ai * 128 + wr * 64 + m * 16 + fq * 4, tok = bcol + bj * 128 + wc * 32 + n * 16 + fr;
            hv[m][n] = *(const u32x2*)(W_H(p) + (size_t)tok * DM + nc);
          }
#pragma unroll
        for (int m = 0; m < 4; ++m)
#pragma unroll
          for (int n = 0; n < 2; ++n) {
            const int nc = brow + ai * 128 + wr * 64 + m * 16 + fq * 4, tok = bcol + bj * 128 + wc * 32 + n * 16 + fr;
            const f32x4 v = acc[ai][bj][m][n];
            u32x2 o;
            o[0] = pack2(ALPHA * bflo(hv[m][n][0]) + v[0], ALPHA * bfhi(hv[m][n][0]) + v[1]);
            o[1] = pack2(ALPHA * bflo(hv[m][n][1]) + v[2], ALPHA * bfhi(hv[m][n][1]) + v[3]);
            *(u32x2*)(W_Y(p) + (size_t)tok * DM + nc) = o;
          }
      }
  } else {
    LAS float* S = (LAS float*)shm;
    const int tok = tid & 255, kh = tid >> 8;
    float L0[16], L1[16];
#pragma unroll
    for (int ai = 0; ai < 2; ++ai) {
      __syncthreads();
#pragma unroll
      for (int bj = 0; bj < 2; ++bj)
#pragma unroll
        for (int m = 0; m < 4; ++m)
#pragma unroll
          for (int n = 0; n < 2; ++n) {
            const int tk = bj * 128 + wc * 32 + n * 16 + fr, key = wr * 64 + m * 16 + fq * 4;
#pragma unroll
            for (int j = 0; j < 4; ++j) S[tk * 128 + ((key + j + tk) & 127)] = acc[ai][bj][m][n][j];
          }
      __syncthreads();
      float v[16];
#pragma unroll 1
      for (int ch = 0; ch < 4; ++ch) {
        float wk[16];
#pragma unroll
        for (int i = 0; i < 16; ++i) {
          const int key = kh * 64 + ch * 16 + i;
          const float x = S[tok * 128 + ((key + tok) & 127)];
          wk[i] = __uint_as_float((__float_as_uint(x) & ~127u) | (unsigned)key);
        }
        bitonic_sort16(wk);
        if (ch == 0) {
#pragma unroll
          for (int i = 0; i < 16; ++i) v[i] = wk[i];
        } else {
          merge_top16(v, wk);
        }
      }
      __syncthreads();
      if (kh == 1) {
#pragma unroll
        for (int j = 0; j < 16; ++j) S[tok * 16 + j] = v[j];
      }
      __syncthreads();
      if (kh == 0) {
        float wk[16];
#pragma unroll
        for (int j = 0; j < 16; ++j) wk[j] = S[tok * 16 + j];
        merge_top16(v, wk);
      }
#pragma unroll
      for (int j = 0; j < 16; ++j) { if (ai == 0) L0[j] = v[j]; else L1[j] = v[j]; }
    }
    __syncthreads();
    LAS unsigned* LL = (LAS unsigned*)shm;
    if (kh == 0) {
#pragma unroll
      for (int j = 0; j < 16; ++j) { LL[tok * 32 + ((j + tok) & 31)] = __float_as_uint(L0[j]); LL[tok * 32 + ((16 + j + tok) & 31)] = __float_as_uint(L1[j]); }
      float s1[16], s2[16], v[16];
#pragma unroll
      for (int j = 0; j < 16; ++j) { s1[j] = __uint_as_float(__float_as_uint(L0[j]) & ~127u); s2[j] = __uint_as_float(__float_as_uint(L1[j]) & ~127u); v[j] = -3.0e38f; }
#pragma unroll
      for (int ch = 0; ch < 4; ++ch) {
        float wk[16];
#pragma unroll
        for (int i = 0; i < 16; ++i) {
          constexpr unsigned char PAIRS[64] = {0, 1, 2, 3, 4, 5, 6, 7, 8, 9, 10, 11, 12, 13, 14, 15, 16, 17, 18, 19, 20, 21, 22, 23, 32, 33, 34, 35, 36, 48, 49, 50, 51, 64, 65, 66, 80, 81, 96, 97, 112, 113, 128, 144, 160, 176, 192, 208, 224, 240, 255, 255, 255, 255, 255, 255, 255, 255, 255, 255, 255, 255, 255, 255};
          const int code = PAIRS[ch * 16 + i];
          if (code == 255) { wk[i] = -3.0e38f; }
          else { const float sm = s1[code >> 4] + s2[code & 15]; wk[i] = __uint_as_float((__float_as_uint(sm) & ~255u) | (unsigned)code); }
        }
        if (ch == 0) {
#pragma unroll
          for (int i = 0; i < 16; ++i) v[i] = wk[i];
        } else {
          bitonic_sort16(wk);
          merge_top16(v, wk);
        }
      }
      float e[16], sum = 0.f;
      const float mx = __uint_as_float(__float_as_uint(v[0]) & ~255u);
#pragma unroll
      for (int j = 0; j < 16; ++j) { e[j] = fast_exp2((__uint_as_float(__float_as_uint(v[j]) & ~255u) - mx) * LOG2E); sum += e[j]; }
      const float inv = 1.0f / sum;
      const int hd = brow >> 8;
      u16* di = W_IDX(p) + (size_t)(bcol + tok) * 128 + hd * 16;
      float* dg = W_G(p) + (size_t)(bcol + tok) * 128 + hd * 16;
      unsigned eid[16];
#pragma unroll
      for (int k = 0; k < 16; ++k) {
        const unsigned code = __float_as_uint(v[k]) & 255u;
        const unsigned i1 = LL[tok * 32 + (((code >> 4) + tok) & 31)] & 127u, i2 = LL[tok * 32 + ((16 + (code & 15u) + tok) & 31)] & 127u;
        eid[k] = i1 * 128u + i2;
      }
#pragma unroll
      for (int q = 0; q < 4; ++q) *(f32x4*)(dg + 4 * q) = (f32x4){e[4 * q] * inv, e[4 * q + 1] * inv, e[4 * q + 2] * inv, e[4 * q + 3] * inv};
#pragma unroll
      for (int q = 0; q < 2; ++q)
        *(u32x4*)(di + 8 * q) = (u32x4){eid[8 * q] | (eid[8 * q + 1] << 16), eid[8 * q + 2] | (eid[8 * q + 3] << 16), eid[8 * q + 4] | (eid[8 * q + 5] << 16), eid[8 * q + 6] | (eid[8 * q + 7] << 16)};
    }
    __syncthreads();
  }
}

#define ATT_MISC 131072
DI void attn_item(const Params& p, int layer, int b, int hh, int jq, lchar* sm, float lam, float oml, int tid) {
  const int lane = tid & 63, w = tid >> 6, g = lane >> 4, l15 = lane & 15;
  const int idx32 = (lane ^ 32) << 2;
  LAS float* tab = (LAS float*)(sm + ATT_MISC);
  LAS float* sg = tab + 208;
  __syncthreads();
  if (tid < 208) {
    const int d = tid - 80;
    float tv = -1.0e30f;
    if (d >= 0) {
      int bucket = d;
      if (d >= 16) {
        int lg = 16 + (int)(logf((float)d * (1.0f / 16.0f)) / 2.0794415416798357f * 16.0f);
        bucket = lg < 31 ? lg : 31;
      }
      tv = P_REL_BIAS(p)[bucket * 4 + hh] * LOG2E;
    }
    tab[tid] = tv;
    if (tid < 128) sg[tid] = P_SUBLN_G(p)[layer * 128 + tid] * oml;
  }
  const int q0w = 128 * jq + 16 * w;
  const int qpos = q0w + l15;
  const int qrow = b * LSEQ + (qpos < LSEQ ? qpos : LSEQ - 1);
  bf16x8 qf[2][2];
  {
    const u16* qp = W_PROJ(p) + (size_t)qrow * INC + hh * 128 + g * 8;
#pragma unroll
    for (int m = 0; m < 2; ++m)
#pragma unroll
      for (int ks = 0; ks < 2; ++ks) {
        const u32x4 raw = *(const u32x4*)(qp + m * 64 + ks * 32);
        u32x4 sc;
#pragma unroll
        for (int e = 0; e < 4; ++e) sc[e] = pack2(bflo(raw[e]) * (0.125f * LOG2E), bfhi(raw[e]) * (0.125f * LOG2E));
        qf[m][ks] = __builtin_bit_cast(bf16x8, sc);
      }
  }
  const int nkt = (2 * jq + 2) < 33 ? (2 * jq + 2) : 33;
  const char* ksrc[2]; const char* vsrc[2];
#pragma unroll
  for (int i = 0; i < 2; ++i) {
    const int bk = 2 * w + i, k16 = bk >> 2, m = (bk >> 1) & 1, ks = bk & 1;
    const int krow = 32 * (k16 >> 1) + 8 * (l15 >> 2) + 4 * (k16 & 1) + (l15 & 3);
    ksrc[i] = (const char*)(W_PROJ(p) + (size_t)(b * LSEQ + krow) * INC + 512 + hh * 128 + m * 64 + ks * 32 + g * 8);
    const int dv = 8 * bk + (lane >> 3), c = (lane & 7) ^ ((dv >> 1) & 7);
    vsrc[i] = (const char*)(W_VT(p) + ((size_t)((b * 4 + hh) * 128 + dv)) * LP + c * 8);
  }
  lchar* dmak = sm + (2 * w) * 1024 + lane * 16;
#define ATT_ISSUE(KT, SLOT) do { const size_t _ko = (size_t)(KT) * (64 * INC * 2), _vo = (size_t)(KT) * 128; lchar* _d = dmak + (SLOT) * 32768; \
    __builtin_amdgcn_global_load_lds((const unsigned*)(ksrc[0] + _ko), (LAS unsigned*)(_d), 16, 0, 0); \
    __builtin_amdgcn_global_load_lds((const unsigned*)(ksrc[1] + _ko), (LAS unsigned*)(_d + 1024), 16, 0, 0); \
    __builtin_amdgcn_global_load_lds((const unsigned*)(vsrc[0] + _vo), (LAS unsigned*)(_d + 16384), 16, 0, 0); \
    __builtin_amdgcn_global_load_lds((const unsigned*)(vsrc[1] + _vo), (LAS unsigned*)(_d + 16384 + 1024), 16, 0, 0); } while (0)
  int voff[2];
#pragma unroll
  for (int kk = 0; kk < 2; ++kk) voff[kk] = l15 * 128 + (((4 * kk + g) ^ ((l15 >> 1) & 7)) * 16);

  f32x4 O[2][8];
#pragma unroll
  for (int m = 0; m < 2; ++m)
#pragma unroll
    for (int dt = 0; dt < 8; ++dt) O[m][dt] = (f32x4){0.f, 0.f, 0.f, 0.f};
  float mrun[2] = {0.f, 0.f};
  f32x4 Osum[2] = {(f32x4){0.f, 0.f, 0.f, 0.f}, (f32x4){0.f, 0.f, 0.f, 0.f}};
  bf16x8 ones;
  { const short o1 = (l15 == 0) ? (short)0x3f80 : (short)0; ones = (bf16x8){o1, o1, o1, o1, o1, o1, o1, o1}; }

  WAIT_V(0);
  __syncthreads();
  const float tfar = tab[207];
  ATT_ISSUE(0, 0);
  ATT_ISSUE((1 < nkt ? 1 : nkt - 1), 1);
  for (int kt = 0; kt < nkt; ++kt) {
    { const int kn = (kt + 2 < nkt) ? kt + 2 : nkt - 1; ATT_ISSUE(kn, (kt + 2) & 3); }
    WAIT_V(8); BAR;
    if (64 * kt <= q0w + 15) {
      const lchar* kb = sm + (kt & 3) * 32768;
      const lchar* vb = kb + 16384;
      const bool near = (q0w - 64 * kt) < 176;
      const float tadd = near ? 0.f : tfar;
      const float sinit[2] = {tadd - mrun[0], tadd - mrun[1]};
      f32x4 S[2][4];
#pragma unroll
      for (int kh = 0; kh < 2; ++kh) {
        bf16x8 kf[2][2][2];
#pragma unroll
        for (int q = 0; q < 2; ++q)
#pragma unroll
          for (int m = 0; m < 2; ++m)
#pragma unroll
            for (int ks = 0; ks < 2; ++ks) kf[q][m][ks] = *(const LAS bf16x8*)(kb + ((((2 * kh + q) * 2 + m) * 2 + ks) * 1024) + lane * 16);
        SCHED;
#pragma unroll
        for (int q = 0; q < 2; ++q)
#pragma unroll
          for (int m = 0; m < 2; ++m) {
            f32x4 sacc = (f32x4){sinit[m], sinit[m], sinit[m], sinit[m]};
            sacc = mfma16(kf[q][m][0], qf[m][0], sacc);
            sacc = mfma16(kf[q][m][1], qf[m][1], sacc);
            S[m][2 * kh + q] = sacc;
          }
      }
      if (near) {
#pragma unroll
        for (int m = 0; m < 2; ++m)
#pragma unroll
          for (int k16 = 0; k16 < 4; ++k16)
#pragma unroll
            for (int r = 0; r < 4; ++r) {
              const int di = qpos + 80 - (64 * kt + 32 * (k16 >> 1) + 8 * g + 4 * (k16 & 1) + r);
              S[m][k16][r] += tab[di < 207 ? di : 207];
            }
      }
      bf16x8 pb[2][2];
#pragma unroll
      for (int m = 0; m < 2; ++m) {
        float mx = fmaxf(fmaxf(S[m][0][0], S[m][0][1]), fmaxf(S[m][0][2], S[m][0][3]));
#pragma unroll
        for (int k16 = 1; k16 < 4; ++k16) mx = fmaxf(fmaxf(mx, fmaxf(S[m][k16][0], S[m][k16][1])), fmaxf(S[m][k16][2], S[m][k16][3]));
        mx = fmaxf(mx, shx16(mx));
        mx = fmaxf(mx, shx32(mx, idx32));
        if (kt == 0 || __builtin_amdgcn_ballot_w64(mx > 8.0f) != 0ull) {
          const float dlt = kt == 0 ? mx : fmaxf(mx, 0.f);
          const float alpha = fast_exp2(-dlt);
          mrun[m] += dlt;
#pragma unroll
          for (int dt = 0; dt < 8; ++dt) { O[m][dt][0] *= alpha; O[m][dt][1] *= alpha; O[m][dt][2] *= alpha; O[m][dt][3] *= alpha; }
          Osum[m][0] *= alpha; Osum[m][1] *= alpha; Osum[m][2] *= alpha; Osum[m][3] *= alpha;
#pragma unroll
          for (int k16 = 0; k16 < 4; ++k16)
#pragma unroll
            for (int r = 0; r < 4; ++r) S[m][k16][r] -= dlt;
        }
#pragma unroll
        for (int k16 = 0; k16 < 4; ++k16)
#pragma unroll
          for (int r = 0; r < 4; ++r) S[m][k16][r] = fast_exp2(S[m][k16][r]);
#pragma unroll
        for (int kk = 0; kk < 2; ++kk) {
          u32x4 t;
          t[0] = pack2(S[m][2 * kk][0], S[m][2 * kk][1]); t[1] = pack2(S[m][2 * kk][2], S[m][2 * kk][3]);
          t[2] = pack2(S[m][2 * kk + 1][0], S[m][2 * kk + 1][1]); t[3] = pack2(S[m][2 * kk + 1][2], S[m][2 * kk + 1][3]);
          pb[m][kk] = __builtin_bit_cast(bf16x8, t);
          Osum[m] = mfma16(ones, pb[m][kk], Osum[m]);
        }
      }
#pragma unroll
      for (int kk = 0; kk < 2; ++kk) {
        bf16x8 vf[8];
#pragma unroll
        for (int dt = 0; dt < 8; ++dt) vf[dt] = *(const LAS bf16x8*)(vb + dt * 2048 + voff[kk]);
        SCHED;
#pragma unroll
        for (int dt = 0; dt < 8; ++dt) {
          O[0][dt] = mfma16(vf[dt], pb[0][kk], O[0][dt]);
          O[1][dt] = mfma16(vf[dt], pb[1][kk], O[1][dt]);
        }
      }
    }
  }
  WAIT_V(0);
#undef ATT_ISSUE
  float l0 = g == 0 ? Osum[0][0] : 0.f, l1 = g == 0 ? Osum[1][0] : 0.f;
  l0 += shx16(l0); l0 += shx32(l0, idx32);
  l1 += shx16(l1); l1 += shx32(l1, idx32);
  const float c1 = 1.0f / l0, c2 = lam / l1;
  float ss = 0.f;
#pragma unroll
  for (int dt = 0; dt < 8; ++dt)
#pragma unroll
    for (int r = 0; r < 4; ++r) { const float o = O[0][dt][r] * c1 - O[1][dt][r] * c2; O[0][dt][r] = o; ss += o * o; }
  ss += shx16(ss); ss += shx32(ss, idx32);
  const float rinv = rsqrtf(ss * (1.0f / 128.0f) + 1e-5f);
  if (qpos < LSEQ) {
    u16* dst = W_MIX(p) + (size_t)(b * LSEQ + qpos) * DM + hh * 128 + 4 * g;
#pragma unroll
    for (int dt = 0; dt < 8; ++dt) {
      const int dv0 = 16 * dt + 4 * g;
      u32x2 o;
      o[0] = pack2(O[0][dt][0] * rinv * sg[dv0 + 0], O[0][dt][1] * rinv * sg[dv0 + 1]);
      o[1] = pack2(O[0][dt][2] * rinv * sg[dv0 + 2], O[0][dt][3] * rinv * sg[dv0 + 3]);
      *(u32x2*)(dst + 16 * dt) = o;
    }
  }
}

DI void conv_item(const Params& p, int layer, int item, int tid) {
  const int ch = (tid & 63) * 8, t0 = item * 16 + 4 * (tid >> 6);
  const int pos0 = t0 % LSEQ;
  const bool head = pos0 == 0;
  const u16* row0 = W_PROJ(p) + (size_t)t0 * INC;
  u32x4 gc[6], zz[6], gb[4];
#pragma unroll
  for (int j = 0; j < 6; ++j) {
    const u16* r2 = row0 + (ptrdiff_t)((head && j < 2) ? 0 : (j - 2)) * INC;
    gc[j] = *(const u32x4*)(r2 + 2048 + ch); zz[j] = *(const u32x4*)(r2 + 2560 + ch);
  }
#pragma unroll
  for (int i = 0; i < 4; ++i) gb[i] = *(const u32x4*)(row0 + (size_t)i * INC + 1536 + ch);
  const float* cw = P_CONV_W(p) + (size_t)layer * 3 * 512 + ch;
  float w0[8], w1[8], w2[8];
#pragma unroll
  for (int e = 0; e < 8; ++e) { w0[e] = cw[e]; w1[e] = cw[512 + e]; w2[e] = cw[1024 + e]; }
  float pr[6][8];
#pragma unroll
  for (int j = 0; j < 6; ++j) {
    const float keep = (head && j < 2) ? 0.f : 1.f;
#pragma unroll
    for (int e = 0; e < 4; ++e) { pr[j][2 * e] = keep * bflo(gc[j][e]) * bflo(zz[j][e]); pr[j][2 * e + 1] = keep * bfhi(gc[j][e]) * bfhi(zz[j][e]); }
  }
#pragma unroll
  for (int i = 0; i < 4; ++i) {
    u32x4 o;
#pragma unroll
    for (int e = 0; e < 4; ++e) {
      const float a0 = w0[2 * e] * pr[i][2 * e] + w1[2 * e] * pr[i + 1][2 * e] + w2[2 * e] * pr[i + 2][2 * e];
      const float a1 = w0[2 * e + 1] * pr[i][2 * e + 1] + w1[2 * e + 1] * pr[i + 1][2 * e + 1] + w2[2 * e + 1] * pr[i + 2][2 * e + 1];
      o[e] = pack2(bflo(gb[i][e]) * a0, bfhi(gb[i][e]) * a1);
    }
    *(u32x4*)(W_MIX(p) + (size_t)(t0 + i) * DM + 512 + ch) = o;
  }
}

DI void phase_prologue(const Params& p, char* smem, int wave) {
  const int tid = otid_w(wave), lane = tid & 63, wid = tid >> 6, hb = tid >> 8, htid = tid & 255;
  const int nblk = gridDim.x, bid = blockIdx.x;
  const size_t gtid = (size_t)bid * NTHREADS + tid, gthreads = (size_t)nblk * NTHREADS;
  float* sm = (float*)(smem + hb * LDS_HALF);
  for (int it0 = bid; it0 < 2048; it0 += nblk) {
    const int it = it0 * 2 + hb;
    if (it < 3072) {
      const int l = it / 768, r = it % 768, kb = r / 48, nb = r % 48;
      transpose_tile(P_W_IN(p) + (size_t)l * 1024 * 3072, 3072, W_WIN(p) + (size_t)l * 3072 * 1024, 1024, kb * 64, nb * 64, sm, htid);
    } else {
      const int i2 = it - 3072, l = i2 / 256, r = i2 % 256, kb = r / 16, nb = r % 16;
      transpose_tile(P_W_OUT(p) + (size_t)l * 1024 * 1024, 1024, W_WOUT(p) + (size_t)l * 1024 * 1024, 1024, kb * 64, nb * 64, sm, htid);
    }
  }
  convert_straight(P_W_Q(p), W_WQB(p), (size_t)4 * 1024 * 2048 / 8, gtid, gthreads);
  convert_straight(P_SUB_KEYS(p), W_SKB(p), (size_t)4 * 16 * 128 * 128 / 8, gtid, gthreads);
  for (int t = bid * 8 + wid; t < TTOK; t += nblk * 8) {
    const int b = t / LSEQ, pos = t - b * LSEQ;
    const float* src = pos < NMETA ? P_META(p) + (size_t)pos * DM : P_X(p) + ((size_t)b * SEQ + pos - NMETA) * DM;
    float v[16];
    load_row_f32<0>(src, v, lane);
    ln_row<0>(v, P_LN_IN_G(p), P_LN_IN_B(p), lane);
    store_row_bf16<0>(W_H(p) + (size_t)t * DM, v, lane);
  }
}

DI void phase_fold(const Params& p, char* smem, int wave) {
  const int tid = otid_w(wave), hb = tid >> 8, htid = tid & 255;
  for (int it0 = blockIdx.x; it0 < 256; it0 += gridDim.x) {
    const int it = it0 * 2 + hb;
    const int l = it >> 7, hp = (it >> 3) & 15, mt = it & 7;
    gemm_tile_fold(W_WQB(p) + (size_t)l * 1024 * 2048 + hp * 128, 2048, W_SKB(p) + ((size_t)l * 16 + hp) * 128 * 128, 128, 128, mt * 128, smem + hb * 65536,
                   W_WSC(p) + (size_t)l * 2048 * 1024 + (size_t)hp * 128 * 1024, htid);
  }
}

DI bool tile_order(int i, int nM, int nN, int& pm, int& pn) {
  const int nwg = nM * nN;
  const long L = (long)i * gridDim.x + blockIdx.x;
  if (L >= nwg) return false;
  int wgid = (int)L;
  { const int q = nwg / 8, r = nwg % 8, xcd = wgid % 8, off = wgid / 8; wgid = (xcd < r ? xcd * (q + 1) : r * (q + 1) + (xcd - r) * q) + off; }
  const int nig = 8 * nN, gid = wgid / nig, fm = gid * 8, gsz = (nM - fm) < 8 ? (nM - fm) : 8;
  pm = fm + ((wgid % nig) % gsz); pn = (wgid % nig) / gsz;
  return true;
}

DI void phase_gemm(const Params& p, int layer, int which, char* smem, int wave) {
  const int tid0 = otid_w(wave);
  const u16* W = which == 0 ? W_WIN(p) + (size_t)layer * 3072 * 1024 : (which == 1 ? W_WOUT(p) + (size_t)layer * 1024 * 1024 : W_WSC(p) + (size_t)layer * 2048 * 1024);
  const u16* X = which == 1 ? W_MIX(p) : W_H(p);
  const int nN = which == 0 ? 12 : (which == 1 ? 4 : 8);
  int pm, pn;
  for (int i = 0; tile_order(i, 258, nN, pm, pn); ++i) {
    const bool vt = (which == 0) && (pn == 4 || pn == 5);
    const int mode = which == 0 ? (vt ? EPI_VT : EPI_PROJ) : (which == 1 ? EPI_OUT : EPI_TOPK);
    int tid = tid0;
    asm volatile("" : "+v"(tid));
    gemm256_tile(p, mode, layer, vt ? X : W, vt ? W : X, vt ? pm * 256 : pn * 256, vt ? pn * 256 : pm * 256, (lchar*)smem, tid);
  }
}

DI void phase_attn(const Params& p, int layer, char* smem, int wave) {
  const int tid = otid_w(wave), lane = tid & 63, hb = tid >> 8, htid = tid & 255;
  const float lam_init = 0.8f - 0.6f * expf(-0.3f * (float)layer);
  float d1 = P_LQ1(p)[layer * 64 + lane] * P_LK1(p)[layer * 64 + lane], d2 = P_LQ2(p)[layer * 64 + lane] * P_LK2(p)[layer * 64 + lane];
  d1 = wave_sum(d1); d2 = wave_sum(d2);
  const float lam = expf(d1) - expf(d2) + lam_init;
  for (int rd = 0; rd * (int)gridDim.x < 2176; ++rd) {
    const int o = rd * gridDim.x + ((rd & 1) ? (int)gridDim.x - 1 - (int)blockIdx.x : (int)blockIdx.x);
    if (o < 2176) { const int jq = 16 - (o >> 7), bh = o & 127; attn_item(p, layer, bh >> 2, bh & 3, jq, (lchar*)smem, lam, 1.0f - lam_init, tid); }
  }
  for (int it = blockIdx.x; it < 2064; it += gridDim.x) conv_item(p, layer, it * 2 + hb, htid);
}

DI void phase_ln(const Params& p, int layer, int which, int wave) {
  const int tid = otid_w(wave), lane = tid & 63, wid = tid >> 6;
  const int nblk = gridDim.x, bid = blockIdx.x;
  const float* lg = (which ? P_LN2_G(p) : P_LN1_G(p)) + layer * DM;
  const float* lb = (which ? P_LN2_B(p) : P_LN1_B(p)) + layer * DM;
  const bool final_out = which && (layer == DEPTH - 1);
  for (int t = bid * 8 + wid; t < TTOK; t += nblk * 8) {
    float v[16];
    load_row_bf16<0>(W_Y(p) + (size_t)t * DM, v, lane);
    ln_row<0>(v, lg, lb, lane);
    if (final_out) {
      const int b = t / LSEQ, pos = t - b * LSEQ;
      if (pos >= NMETA) {
        float* dst = p.out + ((size_t)b * SEQ + pos - NMETA) * DM;
#pragma unroll
        for (int hh = 0; hh < 2; ++hh) {
          *(f32x4*)(dst + hh * 512 + 8 * lane) = (f32x4){v[hh * 8], v[hh * 8 + 1], v[hh * 8 + 2], v[hh * 8 + 3]};
          *(f32x4*)(dst + hh * 512 + 8 * lane + 4) = (f32x4){v[hh * 8 + 4], v[hh * 8 + 5], v[hh * 8 + 6], v[hh * 8 + 7]};
        }
      }
    } else {
      store_row_bf16<0>(W_H(p) + (size_t)t * DM, v, lane);
    }
  }
  if (which) return;
  for (int r = bid * 8 + wid; r < 2 * PEER_N; r += nblk * 8) {
    const bool isv = r >= PEER_N;
    const int e = isv ? r - PEER_N : r;
    const float* src = (isv ? P_PEER_V(p) : P_PEER_U(p)) + ((size_t)layer * PEER_N + e) * DM + 16 * lane;
    f32x4 a[4];
#pragma unroll
    for (int k = 0; k < 4; ++k) a[k] = *(const f32x4*)(src + 4 * k);
    float am = 0.f;
#pragma unroll
    for (int k = 0; k < 4; ++k) am = fmaxf(am, fmaxf(fmaxf(fabsf(a[k][0]), fabsf(a[k][1])), fmaxf(fabsf(a[k][2]), fabsf(a[k][3]))));
    am = wave_max_nonneg(am);
    const float top = isv ? 224.0f : 127.0f;
    const float sc = am > 0.f ? top / am : 1.0f;
    if (lane == 0) (isv ? W_SV(p) : W_SU(p))[e] = am > 0.f ? am / top : 1.0f;
    u32x4 o;
#pragma unroll
    for (int k = 0; k < 4; ++k) {
      if (isv) {
        int w = 0;
        w = __builtin_amdgcn_cvt_pk_fp8_f32(a[k][0] * sc, a[k][1] * sc, w, false);
        w = __builtin_amdgcn_cvt_pk_fp8_f32(a[k][2] * sc, a[k][3] * sc, w, true);
        o[k] = (unsigned)w;
      } else {
        const int q0 = __float2int_rn(a[k][0] * sc), q1 = __float2int_rn(a[k][1] * sc), q2 = __float2int_rn(a[k][2] * sc), q3 = __float2int_rn(a[k][3] * sc);
        o[k] = ((unsigned)q0 & 255u) | (((unsigned)q1 & 255u) << 8) | (((unsigned)q2 & 255u) << 16) | ((unsigned)q3 << 24);
      }
    }
    *(u32x4*)((isv ? W_VB(p) : W_UB(p)) + (size_t)(lane >> 3) * (PEER_N * 128) + (size_t)e * 128 + 16 * (lane & 7)) = o;
  }
}

#define DPP_F(v, ctrl) __int_as_float(__builtin_amdgcn_update_dpp(0, __float_as_int(v), (ctrl), 0xf, 0xf, true))
#define PEER_META(T, IA, IB, HA, HB) do { const int _t = (T) < TTOK ? (T) : wslot; \
    IA = *(const u32x4*)(W_IDX(p) + (size_t)_t * 128 + r * 16); IB = *(const u32x4*)(W_IDX(p) + (size_t)_t * 128 + r * 16 + 8); \
    const u16* _hp = W_H(p) + (size_t)_t * DM + x * 128 + 16 * c; HA = *(const u32x4*)(_hp); HB = *(const u32x4*)(_hp + 8); } while (0)
#define PEER_GATHER(TAB, IA, IB, RR) do { _Pragma("unroll") for (int g = 0; g < 16; ++g) { \
    const unsigned _w = (g < 8 ? IA : IB)[(g >> 1) & 3]; const unsigned _e = (g & 1) ? (_w >> 16) : (_w & 0xffffu); RR[g] = *(const u32x4*)((TAB) + (_e * 128u + c16)); } } while (0)
#define PEER_UNPACK(XS, HA, HB) do { _Pragma("unroll") for (int e = 0; e < 4; ++e) { \
    XS[e] = (f32x2){bflo(HA[e]), bfhi(HA[e])}; XS[4 + e] = (f32x2){bflo(HB[e]), bfhi(HB[e])}; } } while (0)

#define DPP_I(v, ctrl) __builtin_amdgcn_update_dpp(0, (v), (ctrl), 0xf, 0xf, true)
DI int reduce_scatter8(int d0, int d1, int d2, int d3, int d4, int d5, int d6, int d7, int c) {
  const bool b2 = c >= 4, b1 = (c & 2) != 0, b0 = (c & 1) != 0;
  const int e0 = (b2 ? d4 : d0) + DPP_I(b2 ? d0 : d4, 0x141);
  const int e1 = (b2 ? d5 : d1) + DPP_I(b2 ? d1 : d5, 0x141);
  const int e2 = (b2 ? d6 : d2) + DPP_I(b2 ? d2 : d6, 0x141);
  const int e3 = (b2 ? d7 : d3) + DPP_I(b2 ? d3 : d7, 0x141);
  const int f0 = (b1 ? e2 : e0) + DPP_I(b1 ? e0 : e2, 0x4E);
  const int f1 = (b1 ? e3 : e1) + DPP_I(b1 ? e1 : e3, 0x4E);
  return (b0 ? f1 : f0) + DPP_I(b0 ? f0 : f1, 0xB1);
}
DI void phase_peer_dots(const Params& p, int layer, int wave) {
  const int tid = otid_w(wave), lane = tid & 63, wid = tid >> 6, c = lane & 7, r = lane >> 3;
  const int x = blockIdx.x & 7, wslot = (blockIdx.x >> 3) * 8 + wid, nslot = (gridDim.x >> 3) * 8;
  const unsigned char* ub = W_UB(p) + (size_t)x * (PEER_N * 128);
  const unsigned c16 = (unsigned)c * 16u;
  u16* pd = W_Y(p);
  u32x4 iAa, iBa, iAb, iBb;
  u32x4 hAa, hBa, hAb, hBb, rrA[16], rrB[16];
  int xq[4];
  float xscale;
#define DOTS_QUANT(HA, HB) do { float _xv[16]; \
    _Pragma("unroll") for (int e = 0; e < 4; ++e) { _xv[2 * e] = bflo(HA[e]); _xv[2 * e + 1] = bfhi(HA[e]); _xv[8 + 2 * e] = bflo(HB[e]); _xv[8 + 2 * e + 1] = bfhi(HB[e]); } \
    float _am = 0.f; _Pragma("unroll") for (int e = 0; e < 16; ++e) _am = fmaxf(_am, fabsf(_xv[e])); \
    _am = DPP_MAX(_am, 0xB1); _am = DPP_MAX(_am, 0x4E); _am = DPP_MAX(_am, 0x141); \
    const float _qs = _am > 0.f ? 127.0f / _am : 0.f; xscale = _am * (1.0f / 127.0f); \
    _Pragma("unroll") for (int k = 0; k < 4; ++k) { \
      const int q0 = __float2int_rn(_xv[4 * k] * _qs), q1 = __float2int_rn(_xv[4 * k + 1] * _qs), q2 = __float2int_rn(_xv[4 * k + 2] * _qs), q3 = __float2int_rn(_xv[4 * k + 3] * _qs); \
      xq[k] = (int)(((unsigned)q0 & 255u) | (((unsigned)q1 & 255u) << 8) | (((unsigned)q2 & 255u) << 16) | ((unsigned)q3 << 24)); } } while (0)
#define DOTS_COMPUTE(T, RR) do { if ((T) < TTOK) { int dd[16]; \
    _Pragma("unroll") for (int g = 0; g < 16; ++g) { int d = 0; \
      _Pragma("unroll") for (int k = 0; k < 4; ++k) d = __builtin_amdgcn_sdot4((int)RR[g][k], xq[k], d, false); \
      dd[g] = d; } \
    const int pA = reduce_scatter8(dd[0], dd[1], dd[2], dd[3], dd[4], dd[5], dd[6], dd[7], c); \
    const int pB = reduce_scatter8(dd[8], dd[9], dd[10], dd[11], dd[12], dd[13], dd[14], dd[15], c); \
    u16* _dst = pd + ((size_t)(T) * 8 + x) * 128 + r * 16 + c;        \
    _dst[0] = (u16)(pack2((float)pA * xscale, 0.f) & 0xffffu); _dst[8] = (u16)(pack2((float)pB * xscale, 0.f) & 0xffffu); } } while (0)
  int t = wslot;
  PEER_META(t, iAa, iBa, hAa, hBa);
  PEER_META(t + nslot, iAb, iBb, hAb, hBb);
  PEER_GATHER(ub, iAa, iBa, rrA);
  for (; t < TTOK; t += 2 * nslot) {
    DOTS_QUANT(hAa, hBa);
    PEER_META(t + 2 * nslot, iAa, iBa, hAa, hBa);
    PEER_GATHER(ub, iAb, iBb, rrB);
    DOTS_COMPUTE(t, rrA);
    DOTS_QUANT(hAb, hBb);
    PEER_META(t + 3 * nslot, iAb, iBb, hAb, hBb);
    PEER_GATHER(ub, iAa, iBa, rrA);
    DOTS_COMPUTE(t + nslot, rrB);
  }
#undef DOTS_COMPUTE
#undef DOTS_QUANT
}

DI void phase_peer_w(const Params& p, int layer, int wave) {
  const int tid = otid_w(wave), lane = tid & 63, wid = tid >> 6;
  const u16* pd = W_Y(p);
  for (int t = blockIdx.x * 8 + wid; t < TTOK; t += gridDim.x * 8) {
#pragma unroll
    for (int hf = 0; hf < 2; ++hf) {
      const int j = hf * 64 + lane;
      float sacc = 0.f;
#pragma unroll
      for (int xx = 0; xx < 8; ++xx) sacc += __uint_as_float(((unsigned)pd[((size_t)t * 8 + xx) * 128 + j]) << 16);
      const int e = W_IDX(p)[(size_t)t * 128 + j];
      const float act = sacc * W_SU(p)[e];
      const float wv = W_G(p)[(size_t)t * 128 + j] * (0.5f * act * (1.0f + erff(act * 0.7071067811865476f))) * W_SV(p)[e];
      W_W16(p)[(size_t)t * 128 + j] = (u16)(pack2(wv, 0.f) & 0xffffu);
    }
  }
}

#define PEER_META_V(T, IA, IB, WA, WB, HR) do { const int _t = (T) < TTOK ? (T) : wslot; \
    IA = *(const u32x4*)(W_IDX(p) + (size_t)_t * 128 + r * 16); IB = *(const u32x4*)(W_IDX(p) + (size_t)_t * 128 + r * 16 + 8); \
    WA = *(const u32x4*)(W_W16(p) + (size_t)_t * 128 + r * 16); WB = *(const u32x4*)(W_W16(p) + (size_t)_t * 128 + r * 16 + 8); \
    HR = *(const u32x2*)(W_H(p) + (size_t)_t * DM + ocol); } while (0)
DI float swap32_add(float a, float b) {
  const u32x2 r = __builtin_amdgcn_permlane32_swap(__float_as_uint(a), __float_as_uint(b), false, false);
  return __uint_as_float(r[0]) + __uint_as_float(r[1]);
}
DI float swap16_add(float a, float b) {
  const u32x2 r = __builtin_amdgcn_permlane16_swap(__float_as_uint(a), __float_as_uint(b), false, false);
  return __uint_as_float(r[0]) + __uint_as_float(r[1]);
}
DI void phase_peer_v(const Params& p, int layer, int wave) {
  const int tid = otid_w(wave), lane = tid & 63, wid = tid >> 6, c = lane & 7, r = lane >> 3;
  const int x = blockIdx.x & 7, wslot = (blockIdx.x >> 3) * 8 + wid, nslot = (gridDim.x >> 3) * 8;
  const unsigned char* vb = W_VB(p) + (size_t)x * (PEER_N * 128);
  const unsigned c16 = (unsigned)c * 16u;
  u16* y2 = W_Y(p);
  const int ocol = x * 128 + 16 * c + 4 * ((lane >> 4) & 1) + 8 * (lane >> 5);
  u32x4 iAa, iBa, iAb, iBb;
  u32x4 wAa, wBa, wAb, wBb, wA, wB;
  u32x2 hRa, hRb, hR;
  u32x4 rrA[16], rrB[16];
#define V_COMPUTE(T, RR) do { if ((T) < TTOK) { f32x2 acc[8]; \
    _Pragma("unroll") for (int i = 0; i < 8; ++i) acc[i] = (f32x2){0.f, 0.f}; \
    _Pragma("unroll") for (int g = 0; g < 16; ++g) { \
      const unsigned _ww = (g < 8 ? wA : wB)[(g >> 1) & 3]; const float wj = (g & 1) ? bfhi(_ww) : bflo(_ww); \
      const f32x2 wj2 = (f32x2){wj, wj}; \
      _Pragma("unroll") for (int k = 0; k < 4; ++k) { \
        const f32x2 lo = __builtin_amdgcn_cvt_pk_f32_fp8((int)RR[g][k], false), hi = __builtin_amdgcn_cvt_pk_f32_fp8((int)RR[g][k], true); \
        acc[2 * k] += wj2 * lo; acc[2 * k + 1] += wj2 * hi; } } \
    float P8[8], Q4[4]; \
    _Pragma("unroll") for (int i = 0; i < 8; ++i) P8[i] = swap32_add(acc[i >> 1][i & 1], acc[(i + 8) >> 1][i & 1]);     \
    _Pragma("unroll") for (int i = 0; i < 4; ++i) Q4[i] = swap16_add(P8[i], P8[i + 4]);                                 \
    _Pragma("unroll") for (int i = 0; i < 4; ++i) Q4[i] += DPP_F(Q4[i], 0x128);                                         \
    if ((lane & 8) == 0) { u32x2 _o; \
      _o[0] = pack2(ALPHA * bflo(hR[0]) + Q4[0], ALPHA * bfhi(hR[0]) + Q4[1]); \
      _o[1] = pack2(ALPHA * bflo(hR[1]) + Q4[2], ALPHA * bfhi(hR[1]) + Q4[3]); \
      *(u32x2*)(y2 + (size_t)(T) * DM + ocol) = _o; } } } while (0)
  int t = wslot;
  PEER_META_V(t, iAa, iBa, wAa, wBa, hRa);
  PEER_META_V(t + nslot, iAb, iBb, wAb, wBb, hRb);
  PEER_GATHER(vb, iAa, iBa, rrA);
  for (; t < TTOK; t += 2 * nslot) {
    wA = wAa; wB = wBa; hR = hRa;
    PEER_META_V(t + 2 * nslot, iAa, iBa, wAa, wBa, hRa);
    PEER_GATHER(vb, iAb, iBb, rrB);
    V_COMPUTE(t, rrA);
    wA = wAb; wB = wBb; hR = hRb;
    PEER_META_V(t + 3 * nslot, iAb, iBb, wAb, wBb, hRb);
    PEER_GATHER(vb, iAa, iBa, rrA);
    V_COMPUTE(t + nslot, rrB);
  }
#undef V_COMPUTE
}

#define XB_TMO      128
#define XB_XCNT(j)  (256  + 64 * (j))
#define XB_XSUB(j)  (1280 + 64 * (j))
#define XB_XGEN(j)  (2304 + 64 * (j))
#define XB_TOP      3328
#define XB_TOPGEN   3392
#define XCD_BAR_WORDS 3456
#define XB_SPIN_CAP (1u << 22)
DI unsigned xb_ld(unsigned* p)              { return __hip_atomic_load(p, __ATOMIC_RELAXED, __HIP_MEMORY_SCOPE_AGENT); }
DI unsigned xb_add(unsigned* p, unsigned v) { return __hip_atomic_fetch_add(p, v, __ATOMIC_RELAXED, __HIP_MEMORY_SCOPE_AGENT); }
DI unsigned xb_xcc_id() { return (unsigned)__builtin_amdgcn_s_getreg((3 << 11) | 20) & 0xFu; }
#define XB_SPIN(cond, bar) do { unsigned _sp = 0; while (cond) { __builtin_amdgcn_s_sleep(1); \
    if ((++_sp & 255u) == 0u) { if (xb_ld(&(bar)[XB_TMO])) break; if (_sp > XB_SPIN_CAP) { atomicAdd(&(bar)[XB_TMO], 1u); break; } } } } while (0)
DI bool is_thread0(int wave) { unsigned z = 0u; asm volatile("" : "+v"(z)); return wave == 0 && __builtin_amdgcn_mbcnt_hi(~0u, __builtin_amdgcn_mbcnt_lo(~0u, z)) == 0u; }
DI void xcd_barrier_complete(unsigned* bar, unsigned x, unsigned& nloc, unsigned& nx) {
  const unsigned G = gridDim.x;
  unsigned sum, cnt, mine, sp = 0u;
  for (;;) {
    sum = 0u; cnt = 0u; mine = 0u;
#pragma unroll
    for (unsigned j = 0; j < 16; ++j) { const unsigned c = xb_ld(&bar[XB_XCNT(j)]); sum += c; cnt += (c > 0u) ? 1u : 0u; mine = (j == x) ? c : mine; }
    if (sum == G) break;
    __builtin_amdgcn_s_sleep(1);
    if ((++sp & 255u) == 0u) { if (xb_ld(&bar[XB_TMO])) break; if (sp > XB_SPIN_CAP) { atomicAdd(&bar[XB_TMO], 1u); break; } }
  }
  nloc = mine > 0u ? mine : 1u; nx = cnt > 0u ? cnt : 1u;
}
DI void xcd_barrier(unsigned* bar, volatile LAS unsigned* st, int wave) {
  asm volatile("s_waitcnt vmcnt(0)" ::: "memory");
  __syncthreads();
  if (is_thread0(wave)) {
    const unsigned x = xb_xcc_id();
    __builtin_amdgcn_s_waitcnt(0);
    unsigned nloc = st[0], nx = st[1];
    if (nloc == 0u) { xcd_barrier_complete(bar, x, nloc, nx); st[0] = nloc; st[1] = nx; }
    const unsigned old = xb_add(&bar[XB_XSUB(x)], 1u);
    const unsigned gen = old / nloc;
    if (old + 1u == (gen + 1u) * nloc) {
      __builtin_amdgcn_fence(__ATOMIC_RELEASE, "agent");
      asm volatile("s_waitcnt vmcnt(0)" ::: "memory");
      const unsigned og = xb_add(&bar[XB_TOP], 1u);
      const unsigned tg = og / nx;
      if (og + 1u == (tg + 1u) * nx) xb_add(&bar[XB_TOPGEN], 1u);
      else XB_SPIN(xb_ld(&bar[XB_TOPGEN]) == tg, bar);
      __builtin_amdgcn_fence(__ATOMIC_ACQUIRE, "agent");
      xb_add(&bar[XB_XGEN(x)], 1u);
      asm volatile("s_waitcnt vmcnt(0)" ::: "memory");
    } else {
      XB_SPIN(xb_ld(&bar[XB_XGEN(x)]) == gen, bar);
      __builtin_amdgcn_fence(__ATOMIC_ACQUIRE, "agent");
      asm volatile("s_waitcnt vmcnt(0)" ::: "memory");
    }
  }
  __syncthreads();
}

__global__ void __launch_bounds__(NTHREADS, 2) mega(Params p) {
  extern __shared__ __attribute__((aligned(16))) char smem[];
  cg::grid_group grid = cg::this_grid();
  const int wave = __builtin_amdgcn_readfirstlane((int)(threadIdx.x >> 6));
  unsigned* bar = (unsigned*)(p.ws + WS_BAR);
  volatile LAS unsigned* st = (volatile LAS unsigned*)((lchar*)smem + LDS_XB);
  if (threadIdx.x == 0) { st[0] = 0u; st[1] = 0u; (void)xb_add(&bar[XB_XCNT(xb_xcc_id())], 1u); }
  __syncthreads();
  phase_prologue(p, smem, wave);
  grid.sync();
  phase_fold(p, smem, wave);
  xcd_barrier(bar, st, wave);
#pragma unroll 1
  for (int step = 0; step < DEPTH * 9; ++step) {
    const int layer = step / 9, ph = step - layer * 9;
    if (ph == 0 || ph == 2 || ph == 4) phase_gemm(p, layer, ph >> 1, smem, wave);
    else if (ph == 1) phase_attn(p, layer, smem, wave);
    else if (ph == 3 || ph == 8) phase_ln(p, layer, ph == 8, wave);
    else if (ph == 5) phase_peer_dots(p, layer, wave);
    else if (ph == 6) phase_peer_w(p, layer, wave);
    else phase_peer_v(p, layer, wave);
    if (step + 1 < DEPTH * 9) xcd_barrier(bar, st, wave);
  }
}

extern "C" void kernel_launch(void* const* d_in, const int* in_sizes, int n_in, void* d_out, int out_size, void* d_ws, size_t ws_size,
                              hipStream_t stream) {
  static int grid_blocks = 0;
  if (grid_blocks == 0) {
    if (ws_size < WS_END) { fprintf(stderr, "kernel_launch: workspace too small: need %zu, got %zu\n", (size_t)WS_END, ws_size); grid_blocks = -1; return; }
    int dev = 0, cus = 0, per_cu = 0;
    hipGetDevice(&dev);
    hipDeviceGetAttribute(&cus, hipDeviceAttributeMultiprocessorCount, dev);
    hipFuncSetAttribute((const void*)mega, hipFuncAttributeMaxDynamicSharedMemorySize, LDS_BYTES);
    hipOccupancyMaxActiveBlocksPerMultiprocessor(&per_cu, (const void*)mega, NTHREADS, LDS_BYTES);
    if (per_cu < 1) per_cu = 1;
    if (per_cu > 1) per_cu = 1;
    grid_blocks = cus * per_cu;
  }
  if (grid_blocks < 0) return;
  Params p{};
  for (int i = 0; i < 21; ++i) p.in[i] = (const float*)d_in[i];
  p.out = (float*)d_out;
  p.ws = (char*)d_ws;
  if (hipMemsetAsync((char*)d_ws + WS_BAR, 0, 16384, stream) != hipSuccess) { fprintf(stderr, "kernel_launch: memset of the barrier words failed\n"); return; }
  void* args[] = {&p};
  hipError_t e = hipLaunchCooperativeKernel((const void*)mega, dim3(grid_blocks), dim3(NTHREADS), args, LDS_BYTES, stream);
  if (e != hipSuccess) fprintf(stderr, "cooperative launch failed: %s (grid %d)\n", hipGetErrorString(e), grid_blocks);
}
```

```cpp
#include <hip/hip_runtime.h>
#include <hip/hip_cooperative_groups.h>
#include <cstdio>
#include <cstdint>
namespace cg = cooperative_groups;

typedef unsigned short u16;
typedef __attribute__((ext_vector_type(8))) short bf16x8;
typedef __attribute__((ext_vector_type(4))) float f32x4;
typedef __attribute__((ext_vector_type(4))) unsigned u32x4;
typedef __attribute__((ext_vector_type(2))) unsigned u32x2;
typedef __attribute__((ext_vector_type(2))) float f32x2;
#define DI __device__ __forceinline__
#define LAS __attribute__((address_space(3)))
typedef LAS char lchar;

#define DM 1024
#define NBATCH 32
#define SEQ 2048
#define NMETA 16
#define LSEQ 2064
#define TTOK 66048
#define DEPTH 4
#define INC 3072
#define LP 2112
#define PEER_N 16384
#define NTHREADS 512
#define LDS_MISC 69632
#define LDS_HALF 70656
#define LDS_XB 141312
#define LDS_BYTES 141328

#define ALPHA 1.681792830507429f
#define LOG2E 1.4426950408889634f

static constexpr size_t WS_WIN  = 0;
static constexpr size_t WS_WOUT = WS_WIN  + (size_t)4 * 3072 * 1024 * 2;
static constexpr size_t WS_WQB  = WS_WOUT + (size_t)4 * 1024 * 1024 * 2;
static constexpr size_t WS_SKB  = WS_WQB  + (size_t)4 * 1024 * 2048 * 2;
static constexpr size_t WS_WSC  = WS_SKB  + (size_t)4 * 16 * 128 * 128 * 2;
static constexpr size_t WS_UB   = WS_WSC  + (size_t)4 * 2048 * 1024 * 2;
static constexpr size_t WS_VB   = WS_UB   + (size_t)PEER_N * 1024;
static constexpr size_t WS_SU   = WS_VB   + (size_t)PEER_N * 1024;
static constexpr size_t WS_SV   = WS_SU   + (size_t)PEER_N * 4;
static constexpr size_t WS_H    = WS_SV   + (size_t)PEER_N * 4;
static constexpr size_t WS_MIX  = WS_H    + (size_t)TTOK * 1024 * 2;
static constexpr size_t WS_BIG  = WS_MIX  + (size_t)TTOK * 1024 * 2;
static constexpr size_t WS_VT   = WS_BIG  + (size_t)(TTOK + 64) * 3072 * 2;
static constexpr size_t WS_IDX  = WS_VT   + (size_t)NBATCH * 4 * 128 * LP * 2;
static constexpr size_t WS_G    = WS_IDX  + (size_t)TTOK * 128 * 4;
static constexpr size_t WS_W16  = WS_G    + (size_t)TTOK * 128 * 4;
static constexpr size_t WS_BAR  = WS_W16  + (size_t)TTOK * 128 * 2;
static constexpr size_t WS_END  = WS_BAR  + 16384;

struct Params {
  const float* in[21];
  float* out;
  char* ws;
};
#define P_X(p) ((p).in[0])
#define P_META(p) ((p).in[1])
#define P_LN_IN_G(p) ((p).in[2])
#define P_LN_IN_B(p) ((p).in[3])
#define P_REL_BIAS(p) ((p).in[4])
#define P_W_IN(p) ((p).in[5])
#define P_CONV_W(p) ((p).in[6])
#define P_LQ1(p) ((p).in[7])
#define P_LK1(p) ((p).in[8])
#define P_LQ2(p) ((p).in[9])
#define P_LK2(p) ((p).in[10])
#define P_SUBLN_G(p) ((p).in[11])
#define P_W_OUT(p) ((p).in[12])
#define P_LN1_G(p) ((p).in[13])
#define P_LN1_B(p) ((p).in[14])
#define P_W_Q(p) ((p).in[15])
#define P_SUB_KEYS(p) ((p).in[16])
#define P_PEER_U(p) ((p).in[17])
#define P_PEER_V(p) ((p).in[18])
#define P_LN2_G(p) ((p).in[19])
#define P_LN2_B(p) ((p).in[20])
#define W_WIN(p) ((u16*)((p).ws + WS_WIN))
#define W_WOUT(p) ((u16*)((p).ws + WS_WOUT))
#define W_WQB(p) ((u16*)((p).ws + WS_WQB))
#define W_SKB(p) ((u16*)((p).ws + WS_SKB))
#define W_WSC(p) ((u16*)((p).ws + WS_WSC))
#define W_UB(p) ((unsigned char*)((p).ws + WS_UB))
#define W_VB(p) ((unsigned char*)((p).ws + WS_VB))
#define W_SU(p) ((float*)((p).ws + WS_SU))
#define W_SV(p) ((float*)((p).ws + WS_SV))
#define W_H(p) ((u16*)((p).ws + WS_H))
#define W_MIX(p) ((u16*)((p).ws + WS_MIX))
#define W_PROJ(p) ((u16*)((p).ws + WS_BIG))
#define W_Y(p) ((u16*)((p).ws + WS_BIG))
#define W_VT(p) ((u16*)((p).ws + WS_VT))
#define W_IDX(p) ((u16*)((p).ws + WS_IDX))
#define W_W16(p) ((u16*)((p).ws + WS_W16))
#define W_G(p) ((float*)((p).ws + WS_G))

DI u16 f2bf(float x) { unsigned u = __float_as_uint(x); u += 0x7fffu + ((u >> 16) & 1u); return (u16)(u >> 16); }
typedef __attribute__((ext_vector_type(2))) __bf16 bf16x2_t;
DI unsigned pack2(float a, float b) { const bf16x2_t v = {(__bf16)a, (__bf16)b}; return __builtin_bit_cast(unsigned, v); }
DI float bflo(unsigned w) { return __uint_as_float(w << 16); }
DI float bfhi(unsigned w) { return __uint_as_float(w & 0xffff0000u); }
DI int otid_w(int wave) { unsigned z = 0u; asm volatile("" : "+v"(z)); int t = wave * 64 + (int)__builtin_amdgcn_mbcnt_hi(~0u, __builtin_amdgcn_mbcnt_lo(~0u, z)); asm volatile("" : "+v"(t)); return t; }
#define DPP_ADD(v, ctrl) ((v) + __int_as_float(__builtin_amdgcn_update_dpp(0, __float_as_int(v), (ctrl), 0xf, 0xf, true)))
DI float wave_sum(float v) {
  v = DPP_ADD(v, 0xB1);
  v = DPP_ADD(v, 0x4E);
  v = DPP_ADD(v, 0x141);
  v = DPP_ADD(v, 0x140);
  const int iv = __float_as_int(v);
  return __int_as_float(__builtin_amdgcn_readlane(iv, 0)) + __int_as_float(__builtin_amdgcn_readlane(iv, 16)) +
         __int_as_float(__builtin_amdgcn_readlane(iv, 32)) + __int_as_float(__builtin_amdgcn_readlane(iv, 48));
}
#define DPP_MAX(v, ctrl) fmaxf((v), __int_as_float(__builtin_amdgcn_update_dpp(0, __float_as_int(v), (ctrl), 0xf, 0xf, true)))
DI float wave_max_nonneg(float v) {
  v = DPP_MAX(v, 0xB1); v = DPP_MAX(v, 0x4E); v = DPP_MAX(v, 0x141); v = DPP_MAX(v, 0x140);
  const int iv = __float_as_int(v);
  return fmaxf(fmaxf(__int_as_float(__builtin_amdgcn_readlane(iv, 0)), __int_as_float(__builtin_amdgcn_readlane(iv, 16))),
               fmaxf(__int_as_float(__builtin_amdgcn_readlane(iv, 32)), __int_as_float(__builtin_amdgcn_readlane(iv, 48))));
}
DI float shx16(float v) { return __int_as_float(__builtin_amdgcn_ds_swizzle(__float_as_int(v), 0x401F)); }
DI float shx32(float v, int idx32) { return __int_as_float(__builtin_amdgcn_ds_bpermute(idx32, __float_as_int(v))); }
DI f32x4 mfma16(bf16x8 a, bf16x8 b, f32x4 c) { return __builtin_amdgcn_mfma_f32_16x16x32_bf16(a, b, c, 0, 0, 0); }
DI float fast_exp2(float x) { return __builtin_amdgcn_exp2f(x); }

DI void convert_straight(const float* __restrict__ src, u16* __restrict__ dst, size_t n8, size_t gtid, size_t gthreads) {
  for (size_t i = gtid; i < n8; i += gthreads) {
    const f32x4 a = *(const f32x4*)(src + i * 8), b = *(const f32x4*)(src + i * 8 + 4);
    u32x4 o; o[0] = pack2(a[0], a[1]); o[1] = pack2(a[2], a[3]); o[2] = pack2(b[0], b[1]); o[3] = pack2(b[2], b[3]);
    *(u32x4*)(dst + i * 8) = o;
  }
}

DI void transpose_tile(const float* __restrict__ src, int ldn, u16* __restrict__ dst, int ldk, int k0, int n0, float* sm, int tid) {
#pragma unroll
  for (int i = 0; i < 4; ++i) {
    const int r = (tid >> 4) + 16 * i, c4 = tid & 15;
    const f32x4 v = *(const f32x4*)(src + (size_t)(k0 + r) * ldn + n0 + 4 * c4);
    sm[r * 65 + 4 * c4 + 0] = v[0]; sm[r * 65 + 4 * c4 + 1] = v[1]; sm[r * 65 + 4 * c4 + 2] = v[2]; sm[r * 65 + 4 * c4 + 3] = v[3];
  }
  __syncthreads();
#pragma unroll
  for (int i = 0; i < 2; ++i) {
    const int n = (tid >> 3) + 32 * i, kc = tid & 7;
    u32x4 o;
#pragma unroll
    for (int e = 0; e < 4; ++e) o[e] = pack2(sm[(8 * kc + 2 * e) * 65 + n], sm[(8 * kc + 2 * e + 1) * 65 + n]);
    *(u32x4*)(dst + (size_t)(n0 + n) * ldk + k0 + 8 * kc) = o;
  }
  __syncthreads();
}

template <int LAYOUT> DI int col0(int lane, int hh) { return LAYOUT ? 16 * lane + 8 * hh : hh * 512 + 8 * lane; }
template <int LAYOUT>
DI void ln_row(float (&v)[16], const float* __restrict__ g, const float* __restrict__ b, int lane) {
  float s = 0.f;
#pragma unroll
  for (int i = 0; i < 16; ++i) s += v[i];
  const float mu = wave_sum(s) * (1.0f / 1024.0f);
  float q = 0.f;
#pragma unroll
  for (int i = 0; i < 16; ++i) { const float d = v[i] - mu; q += d * d; }
  const float rstd = rsqrtf(wave_sum(q) * (1.0f / 1024.0f) + 1e-5f);
#pragma unroll
  for (int hh = 0; hh < 2; ++hh) {
    const int c = col0<LAYOUT>(lane, hh);
    const f32x4 g0 = *(const f32x4*)(g + c), g1 = *(const f32x4*)(g + c + 4), b0 = *(const f32x4*)(b + c), b1 = *(const f32x4*)(b + c + 4);
#pragma unroll
    for (int e = 0; e < 4; ++e) {
      v[hh * 8 + e] = (v[hh * 8 + e] - mu) * rstd * g0[e] + b0[e];
      v[hh * 8 + 4 + e] = (v[hh * 8 + 4 + e] - mu) * rstd * g1[e] + b1[e];
    }
  }
}
template <int LAYOUT>
DI void store_row_bf16(u16* __restrict__ dst, const float (&v)[16], int lane) {
#pragma unroll
  for (int hh = 0; hh < 2; ++hh) {
    u32x4 o;
#pragma unroll
    for (int e = 0; e < 4; ++e) o[e] = pack2(v[hh * 8 + 2 * e], v[hh * 8 + 2 * e + 1]);
    *(u32x4*)(dst + col0<LAYOUT>(lane, hh)) = o;
  }
}
template <int LAYOUT>
DI void load_row_bf16(const u16* __restrict__ src, float (&v)[16], int lane) {
#pragma unroll
  for (int hh = 0; hh < 2; ++hh) {
    const u32x4 a = *(const u32x4*)(src + col0<LAYOUT>(lane, hh));
#pragma unroll
    for (int e = 0; e < 4; ++e) { v[hh * 8 + 2 * e] = bflo(a[e]); v[hh * 8 + 2 * e + 1] = bfhi(a[e]); }
  }
}
template <int LAYOUT>
DI void load_row_f32(const float* __restrict__ src, float (&v)[16], int lane) {
#pragma unroll
  for (int hh = 0; hh < 2; ++hh) {
    const int c = col0<LAYOUT>(lane, hh);
    const f32x4 a = *(const f32x4*)(src + c), b = *(const f32x4*)(src + c + 4);
#pragma unroll
    for (int e = 0; e < 4; ++e) { v[hh * 8 + e] = a[e]; v[hh * 8 + 4 + e] = b[e]; }
  }
}

enum { EPI_PROJ = 0, EPI_VT = 1, EPI_OUT = 2, EPI_TOPK = 3, EPI_FOLD = 4 };

template <bool SWAP>
DI void gemm_mainloop(const u16* __restrict__ A, int lda, const u16* __restrict__ Bt, int ldb, int K, int m0, int n0, char* smem,
                      f32x4 (&acc)[4][4], int tid) {
  const int lane = tid & 63, wid = tid >> 6, wm = wid >> 1, wn = wid & 1;
  const int srow = tid >> 3, skc = tid & 7;
  const u16* ap = A + (size_t)(m0 + srow) * lda + skc * 8;
  const u16* bp = Bt + (size_t)(n0 + srow) * ldb + skc * 8;
  const int dst0 = (((srow >> 4) * 2 + (skc >> 2)) * 1024) + (((skc & 3) * 16 + (srow & 15)) * 16);
#pragma unroll
  for (int i = 0; i < 4; ++i)
#pragma unroll
    for (int j = 0; j < 4; ++j) acc[i][j] = (f32x4){0.f, 0.f, 0.f, 0.f};
  u32x4 ra[4], rb[4];
#pragma unroll
  for (int j = 0; j < 4; ++j) { ra[j] = *(const u32x4*)(ap + (size_t)j * 32 * lda); rb[j] = *(const u32x4*)(bp + (size_t)j * 32 * ldb); }
#pragma unroll
  for (int j = 0; j < 4; ++j) { *(u32x4*)(smem + dst0 + j * 4096) = ra[j]; *(u32x4*)(smem + 16384 + dst0 + j * 4096) = rb[j]; }
  __syncthreads();
  const int KT = K >> 6;
  for (int kt = 0; kt < KT; ++kt) {
    char* cur = smem + (kt & 1) * 32768;
    char* nxt = smem + ((kt + 1) & 1) * 32768;
    const bool more = (kt + 1 < KT);
    if (more) {
      const u16* ap2 = ap + (kt + 1) * 64;
      const u16* bp2 = bp + (kt + 1) * 64;
#pragma unroll
      for (int j = 0; j < 4; ++j) { ra[j] = *(const u32x4*)(ap2 + (size_t)j * 32 * lda); rb[j] = *(const u32x4*)(bp2 + (size_t)j * 32 * ldb); }
    }
#pragma unroll
    for (int ks = 0; ks < 2; ++ks) {
      bf16x8 af[4], bfr[4];
#pragma unroll
      for (int i = 0; i < 4; ++i) af[i] = *(const bf16x8*)(cur + (((wm * 4 + i) * 2 + ks) * 1024) + lane * 16);
#pragma unroll
      for (int j = 0; j < 4; ++j) bfr[j] = *(const bf16x8*)(cur + 16384 + (((wn * 4 + j) * 2 + ks) * 1024) + lane * 16);
#pragma unroll
      for (int i = 0; i < 4; ++i)
#pragma unroll
        for (int j = 0; j < 4; ++j) acc[i][j] = SWAP ? mfma16(bfr[j], af[i], acc[i][j]) : mfma16(af[i], bfr[j], acc[i][j]);
    }
    if (more) {
#pragma unroll
      for (int j = 0; j < 4; ++j) { *(u32x4*)(nxt + dst0 + j * 4096) = ra[j]; *(u32x4*)(nxt + 16384 + dst0 + j * 4096) = rb[j]; }
    }
    __syncthreads();
  }
}

DI void ce_desc(float& hi, float& lo) { const float a = hi, b = lo; hi = fmaxf(a, b); lo = fminf(a, b); }
DI void bitonic_merge16(float (&v)[16]) {
#pragma unroll
  for (int j = 8; j > 0; j >>= 1)
#pragma unroll
    for (int i = 0; i < 16; ++i) if ((i & j) == 0) ce_desc(v[i], v[i | j]);
}
DI void bitonic_sort16(float (&v)[16]) {
#pragma unroll
  for (int k = 2; k <= 16; k <<= 1)
#pragma unroll
    for (int j = k >> 1; j > 0; j >>= 1)
#pragma unroll
      for (int i = 0; i < 16; ++i) {
        const int l = i ^ j;
        if (l > i) { if ((i & k) == 0 || k == 16) ce_desc(v[i], v[l]); else ce_desc(v[l], v[i]); }
      }
}
DI void merge_top16(float (&v)[16], const float (&w)[16]) {
#pragma unroll
  for (int i = 0; i < 16; ++i) v[i] = fmaxf(v[i], w[15 - i]);
  bitonic_merge16(v);
}
DI void insert16(float (&v)[16], float x) {
#pragma unroll
  for (int j = 0; j < 16; ++j) { const float hi = fmaxf(v[j], x); x = fminf(v[j], x); v[j] = hi; }
}

DI void gemm_tile_fold(const u16* A, int lda, const u16* Bt, int ldb, int K, int m0, char* smem, u16* dstT, int tid) {
  const int lane = tid & 63, wid = tid >> 6, wm = wid >> 1, wn = wid & 1, g = lane >> 4, l15 = lane & 15;
  f32x4 acc[4][4];
  gemm_mainloop<false>(A, lda, Bt, ldb, K, m0, 0, smem, acc, tid);
#pragma unroll
  for (int i = 0; i < 4; ++i)
#pragma unroll
    for (int j = 0; j < 4; ++j) {
      const int m = m0 + wm * 64 + 16 * i + 4 * g, n = wn * 64 + 16 * j + l15;
      u32x2 o; o[0] = pack2(acc[i][j][0], acc[i][j][1]); o[1] = pack2(acc[i][j][2], acc[i][j][3]);
      *(u32x2*)(dstT + (size_t)n * 1024 + m) = o;
    }
}

#define GK 1024
#define HTB 16384
DI int lds_byte(int r, int c) {
  const int st = (r >> 4) * 2 + (c >> 5), rr = r & 15, cc = c & 31, ob = rr * 64 + cc * 2;
  return st * 1024 + (ob ^ (((ob >> 9) & 1) << 5));
}
DI void stage_rc(int b, int& R, int& C) {
  const int st = b / 1024, sb = b % 1024, swz = sb ^ (((sb >> 9) & 1) << 5);
  R = (st >> 1) * 16 + swz / 64; C = (st & 1) * 32 + (swz % 64) / 2;
}
#define G_SA(b, h) (shm + ((b) * 2 + (h)) * HTB)
#define G_SB(b, h) (shm + (4 + (b) * 2 + (h)) * HTB)
#define G_STAGE(P, BASE, br, kt) do { const char* _g = (const char*)((BASE) + (size_t)(br) * GK + (kt) * 64); \
    __builtin_amdgcn_global_load_lds((const unsigned*)(_g + goff0), (LAS unsigned*)((P) + tid * 16), 16, 0, 0); \
    __builtin_amdgcn_global_load_lds((const unsigned*)(_g + goff1), (LAS unsigned*)((P) + tid * 16 + 8192), 16, 0, 0); } while (0)
#define G_LDA(dst, b, h) _Pragma("unroll") for (int m = 0; m < 4; ++m) _Pragma("unroll") for (int k = 0; k < 2; ++k) \
    dst[m][k] = *(const LAS bf16x8*)(G_SA(b, h) + lds_byte(wr * 64 + m * 16 + fr, k * 32 + fq * 8))
#define G_LDB(dst, b, h) _Pragma("unroll") for (int n = 0; n < 2; ++n) _Pragma("unroll") for (int k = 0; k < 2; ++k) \
    dst[n][k] = *(const LAS bf16x8*)(G_SB(b, h) + lds_byte(wc * 32 + n * 16 + fr, k * 32 + fq * 8))
#define G_MMA(ai, bj, At, Bx) do { __builtin_amdgcn_s_setprio(1); \
    _Pragma("unroll") for (int m = 0; m < 4; ++m) _Pragma("unroll") for (int n = 0; n < 2; ++n) _Pragma("unroll") for (int k = 0; k < 2; ++k) \
      acc[ai][bj][m][n] = __builtin_amdgcn_mfma_f32_16x16x32_bf16(At[m][k], Bx[n][k], acc[ai][bj][m][n], 0, 0, 0); \
    __builtin_amdgcn_s_setprio(0); } while (0)
#define WAIT_V(n) asm volatile("s_waitcnt vmcnt(" #n ")" ::: "memory")
#define WAIT_L(n) asm volatile("s_waitcnt lgkmcnt(" #n ")" ::: "memory")
#define BAR __builtin_amdgcn_s_barrier()
#define SCHED __builtin_amdgcn_sched_barrier(0)

DI void gemm256_core(const u16* __restrict__ A, const u16* __restrict__ Bt, int brow, int bcol, lchar* shm, int tid, f32x4 (&acc)[2][2][4][2]) {
  const int wid = tid >> 6, lane = tid & 63, wr = wid >> 2, wc = wid & 3, fr = lane & 15, fq = lane >> 4;
  int r0, c0, r1, c1;
  stage_rc(tid * 16, r0, c0); stage_rc(tid * 16 + 8192, r1, c1);
  const unsigned goff0 = (unsigned)(r0 * GK + c0) * 2u, goff1 = (unsigned)(r1 * GK + c1) * 2u;
#pragma unroll
  for (int ai = 0; ai < 2; ++ai)
#pragma unroll
    for (int bj = 0; bj < 2; ++bj)
#pragma unroll
      for (int m = 0; m < 4; ++m)
#pragma unroll
        for (int n = 0; n < 2; ++n) acc[ai][bj][m][n] = (f32x4){0.f, 0.f, 0.f, 0.f};
  bf16x8 At[4][2], B0[2][2], B1[2][2];
  const int nt = GK / 64;
  WAIT_V(0);
  __syncthreads();
  G_STAGE(G_SB(0, 0), Bt, bcol, 0); G_STAGE(G_SA(0, 0), A, brow, 0);
  G_STAGE(G_SB(0, 1), Bt, bcol + 128, 0); G_STAGE(G_SA(0, 1), A, brow + 128, 0);
  if (wr == 1) BAR;
  WAIT_V(4); BAR;
  G_STAGE(G_SB(1, 0), Bt, bcol, 1); G_STAGE(G_SA(1, 0), A, brow, 1); G_STAGE(G_SB(1, 1), Bt, bcol + 128, 1);
  WAIT_V(6); BAR;
  for (int t = 0; t < nt - 2; t += 2) {
    G_LDB(B0, 0, 0); SCHED; G_LDA(At, 0, 0); G_STAGE(G_SA(1, 1), A, brow + 128, t + 1);
    WAIT_L(8); BAR; WAIT_L(0); G_MMA(0, 0, At, B0); BAR; SCHED;
    G_LDB(B1, 0, 1); G_STAGE(G_SB(0, 0), Bt, bcol, t + 2);
    BAR; WAIT_L(0); G_MMA(0, 1, At, B1); BAR;
    G_LDA(At, 0, 1); G_STAGE(G_SA(0, 0), A, brow, t + 2);
    BAR; WAIT_L(0); G_MMA(1, 0, At, B0); BAR; SCHED;
    G_STAGE(G_SB(0, 1), Bt, bcol + 128, t + 2);
    WAIT_V(6); BAR; G_MMA(1, 1, At, B1); BAR;
    G_LDB(B0, 1, 0); SCHED; G_LDA(At, 1, 0); G_STAGE(G_SA(0, 1), A, brow + 128, t + 2);
    WAIT_L(8); BAR; WAIT_L(0); G_MMA(0, 0, At, B0); BAR; SCHED;
    G_LDB(B1, 1, 1); G_STAGE(G_SB(1, 0), Bt, bcol, t + 3);
    BAR; WAIT_L(0); G_MMA(0, 1, At, B1); BAR;
    G_LDA(At, 1, 1); G_STAGE(G_SA(1, 0), A, brow, t + 3);
    BAR; WAIT_L(0); G_MMA(1, 0, At, B0); BAR; SCHED;
    G_STAGE(G_SB(1, 1), Bt, bcol + 128, t + 3);
    WAIT_V(6); BAR; G_MMA(1, 1, At, B1); BAR;
  }
  { G_LDB(B0, 0, 0); G_LDA(At, 0, 0); G_STAGE(G_SA(1, 1), A, brow + 128, nt - 1);
    BAR; WAIT_L(0); G_MMA(0, 0, At, B0); BAR;
    G_LDB(B1, 0, 1); BAR; WAIT_L(0); G_MMA(0, 1, At, B1); BAR;
    G_LDA(At, 0, 1); WAIT_V(4); BAR; WAIT_L(0); G_MMA(1, 0, At, B0); G_MMA(1, 1, At, B1); BAR; }
  { G_LDB(B0, 1, 0); G_LDA(At, 1, 0); WAIT_V(2); BAR; WAIT_L(0); G_MMA(0, 0, At, B0); BAR;
    G_LDB(B1, 1, 1); WAIT_V(0); BAR; WAIT_L(0); G_MMA(0, 1, At, B1); BAR;
    G_LDA(At, 1, 1); BAR; WAIT_L(0); G_MMA(1, 0, At, B0); G_MMA(1, 1, At, B1); BAR; }
  if (wr == 0) BAR;
}

DI void gemm256_tile(const Params& p, int mode, int layer, const u16* R, const u16* Cc, int brow, int bcol, lchar* shm, int tid_in) {
  f32x4 acc[2][2][4][2];
  gemm256_core(R, Cc, brow, bcol, shm, tid_in, acc);
  int tid = tid_in;
  asm volatile("" : "+v"(tid));
  const int wid = tid >> 6, lane = tid & 63, wr = wid >> 2, wc = wid & 3, fr = lane & 15, fq = lane >> 4;
  if (mode == EPI_PROJ) {
#pragma unroll
    for (int ai = 0; ai < 2; ++ai)
#pragma unroll
      for (int bj = 0; bj < 2; ++bj)
#pragma unroll
        for (int m = 0; m < 4; ++m)
#pragma unroll
          for (int n = 0; n < 2; ++n) {
            const int nc = brow + ai * 128 + wr * 64 + m * 16 + fq * 4, tok = bcol + bj * 128 + wc * 32 + n * 16 + fr;
            const f32x4 v = acc[ai][bj][m][n];
            u32x2 o; o[0] = pack2(v[0], v[1]); o[1] = pack2(v[2], v[3]);
            *(u32x2*)(W_PROJ(p) + (size_t)tok * INC + nc) = o;
          }
  } else if (mode == EPI_VT) {
#pragma unroll
    for (int ai = 0; ai < 2; ++ai)
#pragma unroll
      for (int bj = 0; bj < 2; ++bj)
#pragma unroll
        for (int m = 0; m < 4; ++m)
#pragma unroll
          for (int n = 0; n < 2; ++n) {
            const int tok = brow + ai * 128 + wr * 64 + m * 16 + fq * 4, nn = bcol + bj * 128 + wc * 32 + n * 16 + fr - 1024;
            const int b = tok / LSEQ, pos = tok - b * LSEQ;
            const f32x4 v = acc[ai][bj][m][n];
            u32x2 o; o[0] = pack2(v[0], v[1]); o[1] = pack2(v[2], v[3]);
            *(u32x2*)(W_VT(p) + ((size_t)(b * 512 + nn)) * LP + pos) = o;
          }
  } else if (mode == EPI_OUT) {
#pragma unroll
    for (int ai = 0; ai < 2; ++ai)
#pragma unroll
      for (int bj = 0; bj < 2; ++bj) {
        u32x2 hv[4][2];
#pragma unroll
        for (int m = 0; m < 4; ++m)
#pragma unroll
          for (int n = 0; n < 2; ++n) {
            const int nc = brow + ai * 128 + wr * 64 + m * 16 + fq * 4, tok = bcol + bj * 128 + wc * 32 + n * 16 + fr;
            hv[m][n] = *(const u32x2*)(W_H(p) + (size_t)tok * DM + nc);
          }
#pragma unroll
        for (int m = 0; m < 4; ++m)
#pragma unroll
          for (int n = 0; n < 2; ++n) {
            const int nc = brow + ai * 128 + wr * 64 + m * 16 + fq * 4, tok = bcol + bj * 128 + wc * 32 + n * 16 + fr;
            const f32x4 v = acc[ai][bj][m][n];
            u32x2 o;
            o[0] = pack2(ALPHA * bflo(hv[m][n][0]) + v[0], ALPHA * bfhi(hv[m][n][0]) + v[1]);
            o[1] = pack2(ALPHA * bflo(hv[m][n][1]) + v[2], ALPHA * bfhi(hv[m][n][1]) + v[3]);
            *(u32x2*)(W_Y(p) + (size_t)tok * DM + nc) = o;
          }
      }
  } else {
    LAS float* S = (LAS float*)shm;
    const int tok = tid & 255, kh = tid >> 8;
    float L0[16], L1[16];
#pragma unroll
    for (int ai = 0; ai < 2; ++ai) {
      __syncthreads();
#pragma unroll
      for (int bj = 0; bj < 2; ++bj)
#pragma unroll
        for (int m = 0; m < 4; ++m)
#pragma unroll
          for (int n = 0; n < 2; ++n) {
            const int tk = bj * 128 + wc * 32 + n * 16 + fr, key = wr * 64 + m * 16 + fq * 4;
#pragma unroll
            for (int j = 0; j < 4; ++j) S[tk * 128 + ((key + j + tk) & 127)] = acc[ai][bj][m][n][j];
          }
      __syncthreads();
      float v[16];
#pragma unroll 1
      for (int ch = 0; ch < 4; ++ch) {
        float wk[16];
#pragma unroll
        for (int i = 0; i < 16; ++i) {
          const int key = kh * 64 + ch * 16 + i;
          const float x = S[tok * 128 + ((key + tok) & 127)];
          wk[i] = __uint_as_float((__float_as_uint(x) & ~127u) | (unsigned)key);
        }
        bitonic_sort16(wk);
        if (ch == 0) {
#pragma unroll
          for (int i = 0; i < 16; ++i) v[i] = wk[i];
        } else {
          merge_top16(v, wk);
        }
      }
      __syncthreads();
      if (kh == 1) {
#pragma unroll
        for (int j = 0; j < 16; ++j) S[tok * 16 + j] = v[j];
      }
      __syncthreads();
      if (kh == 0) {
        float wk[16];
#pragma unroll
        for (int j = 0; j < 16; ++j) wk[j] = S[tok * 16 + j];
        merge_top16(v, wk);
      }
#pragma unroll
      for (int j = 0; j < 16; ++j) { if (ai == 0) L0[j] = v[j]; else L1[j] = v[j]; }
    }
    __syncthreads();
    LAS unsigned* LL = (LAS unsigned*)shm;
    if (kh == 0) {
#pragma unroll
      for (int j = 0; j < 16; ++j) { LL[tok * 32 + ((j + tok) & 31)] = __float_as_uint(L0[j]); LL[tok * 32 + ((16 + j + tok) & 31)] = __float_as_uint(L1[j]); }
      float s1[16], s2[16], v[16];
#pragma unroll
      for (int j = 0; j < 16; ++j) { s1[j] = __uint_as_float(__float_as_uint(L0[j]) & ~127u); s2[j] = __uint_as_float(__float_as_uint(L1[j]) & ~127u); v[j] = -3.0e38f; }
#pragma unroll
      for (int ch = 0; ch < 4; ++ch) {
        float wk[16];
#pragma unroll
        for (int i = 0; i < 16; ++i) {
          constexpr unsigned char PAIRS[64] = {0, 1, 2, 3, 4, 5, 6, 7, 8, 9, 10, 11, 12, 13, 14, 15, 16, 17, 18, 19, 20, 21, 22, 23, 32, 33, 34, 35, 36, 48, 49, 50, 51, 64, 65, 66, 80, 81, 96, 97, 112, 113, 128, 144, 160, 176, 192, 208, 224, 240, 255, 255, 255, 255, 255, 255, 255, 255, 255, 255, 255, 255, 255, 255};
          const int code = PAIRS[ch * 16 + i];
          if (code == 255) { wk[i] = -3.0e38f; }
          else { const float sm = s1[code >> 4] + s2[code & 15]; wk[i] = __uint_as_float((__float_as_uint(sm) & ~255u) | (unsigned)code); }
        }
        if (ch == 0) {
#pragma unroll
          for (int i = 0; i < 16; ++i) v[i] = wk[i];
        } else {
          bitonic_sort16(wk);
          merge_top16(v, wk);
        }
      }
      float e[16], sum = 0.f;
      const float mx = __uint_as_float(__float_as_uint(v[0]) & ~255u);
#pragma unroll
      for (int j = 0; j < 16; ++j) { e[j] = fast_exp2((__uint_as_float(__float_as_uint(v[j]) & ~255u) - mx) * LOG2E); sum += e[j]; }
      const float inv = 1.0f / sum;
      const int hd = brow >> 8;
      u16* di = W_IDX(p) + (size_t)(bcol + tok) * 128 + hd * 16;
      float* dg = W_G(p) + (size_t)(bcol + tok) * 128 + hd * 16;
      unsigned eid[16];
#pragma unroll
      for (int k = 0; k < 16; ++k) {
        const unsigned code = __float_as_uint(v[k]) & 255u;
        const unsigned i1 = LL[tok * 32 + (((code >> 4) + tok) & 31)] & 127u, i2 = LL[tok * 32 + ((16 + (code & 15u) + tok) & 31)] & 127u;
        eid[k] = i1 * 128u + i2;
      }
#pragma unroll
      for (int q = 0; q < 4; ++q) *(f32x4*)(dg + 4 * q) = (f32x4){e[4 * q] * inv, e[4 * q + 1] * inv, e[4 * q + 2] * inv, e[4 * q + 3] * inv};
#pragma unroll
      for (int q = 0; q < 2; ++q)
        *(u32x4*)(di + 8 * q) = (u32x4){eid[8 * q] | (eid[8 * q + 1] << 16), eid[8 * q + 2] | (eid[8 * q + 3] << 16), eid[8 * q + 4] | (eid[8 * q + 5] << 16), eid[8 * q + 6] | (eid[8 * q + 7] << 16)};
    }
    __syncthreads();
  }
}

#define ATT_MISC 131072
DI void attn_item(const Params& p, int layer, int b, int hh, int jq, lchar* sm, float lam, float oml, int tid) {
  const int lane = tid & 63, w = tid >> 6, g = lane >> 4, l15 = lane & 15;
  const int idx32 = (lane ^ 32) << 2;
  LAS float* tab = (LAS float*)(sm + ATT_MISC);
  LAS float* sg = tab + 208;
  __syncthreads();
  if (tid < 208) {
    const int d = tid - 80;
    float tv = -1.0e30f;
    if (d >= 0) {
      int bucket = d;
      if (d >= 16) {
        int lg = 16 + (int)(logf((float)d * (1.0f / 16.0f)) / 2.0794415416798357f * 16.0f);
        bucket = lg < 31 ? lg : 31;
      }
      tv = P_REL_BIAS(p)[bucket * 4 + hh] * LOG2E;
    }
    tab[tid] = tv;
    if (tid < 128) sg[tid] = P_SUBLN_G(p)[layer * 128 + tid] * oml;
  }
  const int q0w = 128 * jq + 16 * w;
  const int qpos = q0w + l15;
  const int qrow = b * LSEQ + (qpos < LSEQ ? qpos : LSEQ - 1);
  bf16x8 qf[2][2];
  {
    const u16* qp = W_PROJ(p) + (size_t)qrow * INC + hh * 128 + g * 8;
#pragma unroll
    for (int m = 0; m < 2; ++m)
#pragma unroll
      for (int ks = 0; ks < 2; ++ks) {
        const u32x4 raw = *(const u32x4*)(qp + m * 64 + ks * 32);
        u32x4 sc;
#pragma unroll
        for (int e = 0; e < 4; ++e) sc[e] = pack2(bflo(raw[e]) * (0.125f * LOG2E), bfhi(raw[e]) * (0.125f * LOG2E));
        qf[m][ks] = __builtin_bit_cast(bf16x8, sc);
      }
  }
  const int nkt = (2 * jq + 2) < 33 ? (2 * jq + 2) : 33;
  const char* ksrc[2]; const char* vsrc[2];
#pragma unroll
  for (int i = 0; i < 2; ++i) {
    const int bk = 2 * w + i, k16 = bk >> 2, m = (bk >> 1) & 1, ks = bk & 1;
    const int krow = 32 * (k16 >> 1) + 8 * (l15 >> 2) + 4 * (k16 & 1) + (l15 & 3);
    ksrc[i] = (const char*)(W_PROJ(p) + (size_t)(b * LSEQ + krow) * INC + 512 + hh * 128 + m * 64 + ks * 32 + g * 8);
    const int dv = 8 * bk + (lane >> 3), c = (lane & 7) ^ ((dv >> 1) & 7);
    vsrc[i] = (const char*)(W_VT(p) + ((size_t)((b * 4 + hh) * 128 + dv)) * LP + c * 8);
  }
  lchar* dmak = sm + (2 * w) * 1024 + lane * 16;
#define ATT_ISSUE(KT, SLOT) do { const size_t _ko = (size_t)(KT) * (64 * INC * 2), _vo = (size_t)(KT) * 128; lchar* _d = dmak + (SLOT) * 32768; \
    __builtin_amdgcn_global_load_lds((const unsigned*)(ksrc[0] + _ko), (LAS unsigned*)(_d), 16, 0, 0); \
    __builtin_amdgcn_global_load_lds((const unsigned*)(ksrc[1] + _ko), (LAS unsigned*)(_d + 1024), 16, 0, 0); \
    __builtin_amdgcn_global_load_lds((const unsigned*)(vsrc[0] + _vo), (LAS unsigned*)(_d + 16384), 16, 0, 0); \
    __builtin_amdgcn_global_load_lds((const unsigned*)(vsrc[1] + _vo), (LAS unsigned*)(_d + 16384 + 1024), 16, 0, 0); } while (0)
  int voff[2];
#pragma unroll
  for (int kk = 0; kk < 2; ++kk) voff[kk] = l15 * 128 + (((4 * kk + g) ^ ((l15 >> 1) & 7)) * 16);

  f32x4 O[2][8];
#pragma unroll
  for (int m = 0; m < 2; ++m)
#pragma unroll
    for (int dt = 0; dt < 8; ++dt) O[m][dt] = (f32x4){0.f, 0.f, 0.f, 0.f};
  float mrun[2] = {0.f, 0.f};
  f32x4 Osum[2] = {(f32x4){0.f, 0.f, 0.f, 0.f}, (f32x4){0.f, 0.f, 0.f, 0.f}};
  bf16x8 ones;
  { const short o1 = (l15 == 0) ? (short)0x3f80 : (short)0; ones = (bf16x8){o1, o1, o1, o1, o1, o1, o1, o1}; }

  WAIT_V(0);
  __syncthreads();
  const float tfar = tab[207];
  ATT_ISSUE(0, 0);
  ATT_ISSUE((1 < nkt ? 1 : nkt - 1), 1);
  for (int kt = 0; kt < nkt; ++kt) {
    { const int kn = (kt + 2 < nkt) ? kt + 2 : nkt - 1; ATT_ISSUE(kn, (kt + 2) & 3); }
    WAIT_V(8); BAR;
    if (64 * kt <= q0w + 15) {
      const lchar* kb = sm + (kt & 3) * 32768;
      const lchar* vb = kb + 16384;
      const bool near = (q0w - 64 * kt) < 176;
      const float tadd = near ? 0.f : tfar;
      const float sinit[2] = {tadd - mrun[0], tadd - mrun[1]};
      f32x4 S[2][4];
#pragma unroll
      for (int kh = 0; kh < 2; ++kh) {
        bf16x8 kf[2][2][2];
#pragma unroll
        for (int q = 0; q < 2; ++q)
#pragma unroll
          for (int m = 0; m < 2; ++m)
#pragma unroll
            for (int ks = 0; ks < 2; ++ks) kf[q][m][ks] = *(const LAS bf16x8*)(kb + ((((2 * kh + q) * 2 + m) * 2 + ks) * 1024) + lane * 16);
        SCHED;
#pragma unroll
        for (int q = 0; q < 2; ++q)
#pragma unroll
          for (int m = 0; m < 2; ++m) {
            f32x4 sacc = (f32x4){sinit[m], sinit[m], sinit[m], sinit[m]};
            sacc = mfma16(kf[q][m][0], qf[m][0], sacc);
            sacc = mfma16(kf[q][m][1], qf[m][1], sacc);
            S[m][2 * kh + q] = sacc;
          }
      }
      if (near) {
#pragma unroll
        for (int m = 0; m < 2; ++m)
#pragma unroll
          for (int k16 = 0; k16 < 4; ++k16)
#pragma unroll
            for (int r = 0; r < 4; ++r) {
              const int di = qpos + 80 - (64 * kt + 32 * (k16 >> 1) + 8 * g + 4 * (k16 & 1) + r);
              S[m][k16][r] += tab[di < 207 ? di : 207];
            }
      }
      bf16x8 pb[2][2];
#pragma unroll
      for (int m = 0; m < 2; ++m) {
        float mx = fmaxf(fmaxf(S[m][0][0], S[m][0][1]), fmaxf(S[m][0][2], S[m][0][3]));
#pragma unroll
        for (int k16 = 1; k16 < 4; ++k16) mx = fmaxf(fmaxf(mx, fmaxf(S[m][k16][0], S[m][k16][1])), fmaxf(S[m][k16][2], S[m][k16][3]));
        mx = fmaxf(mx, shx16(mx));
        mx = fmaxf(mx, shx32(mx, idx32));
        if (kt == 0 || __builtin_amdgcn_ballot_w64(mx > 8.0f) != 0ull) {
          const float dlt = kt == 0 ? mx : fmaxf(mx, 0.f);
          const float alpha = fast_exp2(-dlt);
          mrun[m] += dlt;
#pragma unroll
          for (int dt = 0; dt < 8; ++dt) { O[m][dt][0] *= alpha; O[m][dt][1] *= alpha; O[m][dt][2] *= alpha; O[m][dt][3] *= alpha; }
          Osum[m][0] *= alpha; Osum[m][1] *= alpha; Osum[m][2] *= alpha; Osum[m][3] *= alpha;
#pragma unroll
          for (int k16 = 0; k16 < 4; ++k16)
#pragma unroll
            for (int r = 0; r < 4; ++r) S[m][k16][r] -= dlt;
        }
#pragma unroll
        for (int k16 = 0; k16 < 4; ++k16)
#pragma unroll
          for (int r = 0; r < 4; ++r) S[m][k16][r] = fast_exp2(S[m][k16][r]);
#pragma unroll
        for (int kk = 0; kk < 2; ++kk) {
          u32x4 t;
          t[0] = pack2(S[m][2 * kk][0], S[m][2 * kk][1]); t[1] = pack2(S[m][2 * kk][2], S[m][2 * kk][3]);
          t[2] = pack2(S[m][2 * kk + 1][0], S[m][2 * kk + 1][1]); t[3] = pack2(S[m][2 * kk + 1][2], S[m][2 * kk + 1][3]);
          pb[m][kk] = __builtin_bit_cast(bf16x8, t);
          Osum[m] = mfma16(ones, pb[m][kk], Osum[m]);
        }
      }
#pragma unroll
      for (int kk = 0; kk < 2; ++kk) {
        bf16x8 vf[8];
#pragma unroll
        for (int dt = 0; dt < 8; ++dt) vf[dt] = *(const LAS bf16x8*)(vb + dt * 2048 + voff[kk]);
        SCHED;
#pragma unroll
        for (int dt = 0; dt < 8; ++dt) {
          O[0][dt] = mfma16(vf[dt], pb[0][kk], O[0][dt]);
          O[1][dt] = mfma16(vf[dt], pb[1][kk], O[1][dt]);
        }
      }
    }
  }
  WAIT_V(0);
#undef ATT_ISSUE
  float l0 = g == 0 ? Osum[0][0] : 0.f, l1 = g == 0 ? Osum[1][0] : 0.f;
  l0 += shx16(l0); l0 += shx32(l0, idx32);
  l1 += shx16(l1); l1 += shx32(l1, idx32);
  const float c1 = 1.0f / l0, c2 = lam / l1;
  float ss = 0.f;
#pragma unroll
  for (int dt = 0; dt < 8; ++dt)
#pragma unroll
    for (int r = 0; r < 4; ++r) { const float o = O[0][dt][r] * c1 - O[1][dt][r] * c2; O[0][dt][r] = o; ss += o * o; }
  ss += shx16(ss); ss += shx32(ss, idx32);
  const float rinv = rsqrtf(ss * (1.0f / 128.0f) + 1e-5f);
  if (qpos < LSEQ) {
    u16* dst = W_MIX(p) + (size_t)(b * LSEQ + qpos) * DM + hh * 128 + 4 * g;
#pragma unroll
    for (int dt = 0; dt < 8; ++dt) {
      const int dv0 = 16 * dt + 4 * g;
      u32x2 o;
      o[0] = pack2(O[0][dt][0] * rinv * sg[dv0 + 0], O[0][dt][1] * rinv * sg[dv0 + 1]);
      o[1] = pack2(O[0][dt][2] * rinv * sg[dv0 + 2], O[0][dt][3] * rinv * sg[dv0 + 3]);
      *(u32x2*)(dst + 16 * dt) = o;
    }
  }
}

DI void conv_item(const Params& p, int layer, int item, int tid) {
  const int ch = (tid & 63) * 8, t0 = item * 16 + 4 * (tid >> 6);
  const int pos0 = t0 % LSEQ;
  const bool head = pos0 == 0;
  const u16* row0 = W_PROJ(p) + (size_t)t0 * INC;
  u32x4 gc[6], zz[6], gb[4];
#pragma unroll
  for (int j = 0; j < 6; ++j) {
    const u16* r2 = row0 + (ptrdiff_t)((head && j < 2) ? 0 : (j - 2)) * INC;
    gc[j] = *(const u32x4*)(r2 + 2048 + ch); zz[j] = *(const u32x4*)(r2 + 2560 + ch);
  }
#pragma unroll
  for (int i = 0; i < 4; ++i) gb[i] = *(const u32x4*)(row0 + (size_t)i * INC + 1536 + ch);
  const float* cw = P_CONV_W(p) + (size_t)layer * 3 * 512 + ch;
  float w0[8], w1[8], w2[8];
#pragma unroll
  for (int e = 0; e < 8; ++e) { w0[e] = cw[e]; w1[e] = cw[512 + e]; w2[e] = cw[1024 + e]; }
  float pr[6][8];
#pragma unroll
  for (int j = 0; j < 6; ++j) {
    const float keep = (head && j < 2) ? 0.f : 1.f;
#pragma unroll
    for (int e = 0; e < 4; ++e) { pr[j][2 * e] = keep * bflo(gc[j][e]) * bflo(zz[j][e]); pr[j][2 * e + 1] = keep * bfhi(gc[j][e]) * bfhi(zz[j][e]); }
  }
#pragma unroll
  for (int i = 0; i < 4; ++i) {
    u32x4 o;
#pragma unroll
    for (int e = 0; e < 4; ++e) {
      const float a0 = w0[2 * e] * pr[i][2 * e] + w1[2 * e] * pr[i + 1][2 * e] + w2[2 * e] * pr[i + 2][2 * e];
      const float a1 = w0[2 * e + 1] * pr[i][2 * e + 1] + w1[2 * e + 1] * pr[i + 1][2 * e + 1] + w2[2 * e + 1] * pr[i + 2][2 * e + 1];
      o[e] = pack2(bflo(gb[i][e]) * a0, bfhi(gb[i][e]) * a1);
    }
    *(u32x4*)(W_MIX(p) + (size_t)(t0 + i) * DM + 512 + ch) = o;
  }
}

DI void phase_prologue(const Params& p, char* smem, int wave) {
  const int tid = otid_w(wave), lane = tid & 63, wid = tid >> 6, hb = tid >> 8, htid = tid & 255;
  const int nblk = gridDim.x, bid = blockIdx.x;
  const size_t gtid = (size_t)bid * NTHREADS + tid, gthreads = (size_t)nblk * NTHREADS;
  float* sm = (float*)(smem + hb * LDS_HALF);
  for (int it0 = bid; it0 < 2048; it0 += nblk) {
    const int it = it0 * 2 + hb;
    if (it < 3072) {
      const int l = it / 768, r = it % 768, kb = r / 48, nb = r % 48;
      transpose_tile(P_W_IN(p) + (size_t)l * 1024 * 3072, 3072, W_WIN(p) + (size_t)l * 3072 * 1024, 1024, kb * 64, nb * 64, sm, htid);
    } else {
      const int i2 = it - 3072, l = i2 / 256, r = i2 % 256, kb = r / 16, nb = r % 16;
      transpose_tile(P_W_OUT(p) + (size_t)l * 1024 * 1024, 1024, W_WOUT(p) + (size_t)l * 1024 * 1024, 1024, kb * 64, nb * 64, sm, htid);
    }
  }
  convert_straight(P_W_Q(p), W_WQB(p), (size_t)4 * 1024 * 2048 / 8, gtid, gthreads);
  convert_straight(P_SUB_KEYS(p), W_SKB(p), (size_t)4 * 16 * 128 * 128 / 8, gtid, gthreads);
  for (int t = bid * 8 + wid; t < TTOK; t += nblk * 8) {
    const int b = t / LSEQ, pos = t - b * LSEQ;
    const float* src = pos < NMETA ? P_META(p) + (size_t)pos * DM : P_X(p) + ((size_t)b * SEQ + pos - NMETA) * DM;
    float v[16];
    load_row_f32<0>(src, v, lane);
    ln_row<0>(v, P_LN_IN_G(p), P_LN_IN_B(p), lane);
    store_row_bf16<0>(W_H(p) + (size_t)t * DM, v, lane);
  }
}

DI void phase_fold(const Params& p, char* smem, int wave) {
  const int tid = otid_w(wave), hb = tid >> 8, htid = tid & 255;
  for (int it0 = blockIdx.x; it0 < 256; it0 += gridDim.x) {
    const int it = it0 * 2 + hb;
    const int l = it >> 7, hp = (it >> 3) & 15, mt = it & 7;
    gemm_tile_fold(W_WQB(p) + (size_t)l * 1024 * 2048 + hp * 128, 2048, W_SKB(p) + ((size_t)l * 16 + hp) * 128 * 128, 128, 128, mt * 128, smem + hb * 65536,
                   W_WSC(p) + (size_t)l * 2048 * 1024 + (size_t)hp * 128 * 1024, htid);
  }
}

DI bool tile_order(int i, int nM, int nN, int& pm, int& pn) {
  const int nwg = nM * nN;
  const long L = (long)i * gridDim.x + blockIdx.x;
  if (L >= nwg) return false;
  int wgid = (int)L;
  { const int q = nwg / 8, r = nwg % 8, xcd = wgid % 8, off = wgid / 8; wgid = (xcd < r ? xcd * (q + 1) : r * (q + 1) + (xcd - r) * q) + off; }
  const int nig = 8 * nN, gid = wgid / nig, fm = gid * 8, gsz = (nM - fm) < 8 ? (nM - fm) : 8;
  pm = fm + ((wgid % nig) % gsz); pn = (wgid % nig) / gsz;
  return true;
}

DI void convert_tables(const Params& p, int layer, int lane, int slot, int nslots) {
  for (int r = slot; r < 2 * PEER_N; r += nslots) {

    const bool isv = r >= PEER_N;
    const int e = isv ? r - PEER_N : r;
    const float* src = (isv ? P_PEER_V(p) : P_PEER_U(p)) + ((size_t)layer * PEER_N + e) * DM + 16 * lane;
    f32x4 a[4];
#pragma unroll
    for (int k = 0; k < 4; ++k) a[k] = *(const f32x4*)(src + 4 * k);
    float am = 0.f;
#pragma unroll
    for (int k = 0; k < 4; ++k) am = fmaxf(am, fmaxf(fmaxf(fabsf(a[k][0]), fabsf(a[k][1])), fmaxf(fabsf(a[k][2]), fabsf(a[k][3]))));
    am = wave_max_nonneg(am);
    const float top = isv ? 224.0f : 127.0f;
    const float sc = am > 0.f ? top / am : 1.0f;
    if (lane == 0) (isv ? W_SV(p) : W_SU(p))[e] = am > 0.f ? am / top : 1.0f;
    u32x4 o;
#pragma unroll
    for (int k = 0; k < 4; ++k) {
      if (isv) {
        int w = 0;
        w = __builtin_amdgcn_cvt_pk_fp8_f32(a[k][0] * sc, a[k][1] * sc, w, false);
        w = __builtin_amdgcn_cvt_pk_fp8_f32(a[k][2] * sc, a[k][3] * sc, w, true);
        o[k] = (unsigned)w;
      } else {
        const int q0 = __float2int_rn(a[k][0] * sc), q1 = __float2int_rn(a[k][1] * sc), q2 = __float2int_rn(a[k][2] * sc), q3 = __float2int_rn(a[k][3] * sc);
        o[k] = ((unsigned)q0 & 255u) | (((unsigned)q1 & 255u) << 8) | (((unsigned)q2 & 255u) << 16) | ((unsigned)q3 << 24);
      }
    }
    *(u32x4*)((isv ? W_VB(p) : W_UB(p)) + (size_t)(lane >> 3) * (PEER_N * 128) + (size_t)e * 128 + 16 * (lane & 7)) = o;
  }
}

DI void phase_gemm(const Params& p, int layer, int which, char* smem, int wave) {
  const int tid0 = otid_w(wave);
  const u16* W = which == 0 ? W_WIN(p) + (size_t)layer * 3072 * 1024 : (which == 1 ? W_WOUT(p) + (size_t)layer * 1024 * 1024 : W_WSC(p) + (size_t)layer * 2048 * 1024);
  const u16* X = which == 1 ? W_MIX(p) : W_H(p);
  const int nN = which == 0 ? 12 : (which == 1 ? 4 : 8);
  int pm, pn;
  for (int i = 0; tile_order(i, 258, nN, pm, pn); ++i) {
    const bool vt = (which == 0) && (pn == 4 || pn == 5);
    const int mode = which == 0 ? (vt ? EPI_VT : EPI_PROJ) : (which == 1 ? EPI_OUT : EPI_TOPK);
    int tid = tid0;
    asm volatile("" : "+v"(tid));
    gemm256_tile(p, mode, layer, vt ? X : W, vt ? W : X, vt ? pm * 256 : pn * 256, vt ? pn * 256 : pm * 256, (lchar*)smem, tid);
  }
  if (which == 1) {
    const int rem = (258 * 4) % (int)gridDim.x, nidle = (int)gridDim.x - rem;
    if ((int)blockIdx.x >= rem) convert_tables(p, layer, tid0 & 63, ((int)blockIdx.x - rem) * 8 + (tid0 >> 6), nidle * 8);
  }
}

DI void phase_attn(const Params& p, int layer, char* smem, int wave) {
  const int tid = otid_w(wave), lane = tid & 63, hb = tid >> 8, htid = tid & 255;
  const float lam_init = 0.8f - 0.6f * expf(-0.3f * (float)layer);
  float d1 = P_LQ1(p)[layer * 64 + lane] * P_LK1(p)[layer * 64 + lane], d2 = P_LQ2(p)[layer * 64 + lane] * P_LK2(p)[layer * 64 + lane];
  d1 = wave_sum(d1); d2 = wave_sum(d2);
  const float lam = expf(d1) - expf(d2) + lam_init;
  for (int rd = 0; rd * (int)gridDim.x < 2176; ++rd) {
    const int o = rd * gridDim.x + ((rd & 1) ? (int)gridDim.x - 1 - (int)blockIdx.x : (int)blockIdx.x);
    if (o < 2176) { const int jq = 16 - (o >> 7), bh = o & 127; attn_item(p, layer, bh >> 2, bh & 3, jq, (lchar*)smem, lam, 1.0f - lam_init, tid); }
  }
  for (int it = blockIdx.x; it < 2064; it += gridDim.x) conv_item(p, layer, it * 2 + hb, htid);
}

DI void phase_ln(const Params& p, int layer, int which, int wave) {
  const int tid = otid_w(wave), lane = tid & 63, wid = tid >> 6;
  const int nblk = gridDim.x, bid = blockIdx.x;
  const float* lg = (which ? P_LN2_G(p) : P_LN1_G(p)) + layer * DM;
  const float* lb = (which ? P_LN2_B(p) : P_LN1_B(p)) + layer * DM;
  const bool final_out = which && (layer == DEPTH - 1);
  for (int t = bid * 8 + wid; t < TTOK; t += nblk * 8) {
    float v[16];
    load_row_bf16<0>(W_Y(p) + (size_t)t * DM, v, lane);
    ln_row<0>(v, lg, lb, lane);
    if (final_out) {
      const int b = t / LSEQ, pos = t - b * LSEQ;
      if (pos >= NMETA) {
        float* dst = p.out + ((size_t)b * SEQ + pos - NMETA) * DM;
#pragma unroll
        for (int hh = 0; hh < 2; ++hh) {
          *(f32x4*)(dst + hh * 512 + 8 * lane) = (f32x4){v[hh * 8], v[hh * 8 + 1], v[hh * 8 + 2], v[hh * 8 + 3]};
          *(f32x4*)(dst + hh * 512 + 8 * lane + 4) = (f32x4){v[hh * 8 + 4], v[hh * 8 + 5], v[hh * 8 + 6], v[hh * 8 + 7]};
        }
      }
    } else {
      store_row_bf16<0>(W_H(p) + (size_t)t * DM, v, lane);
    }
  }
}

#define DPP_F(v, ctrl) __int_as_float(__builtin_amdgcn_update_dpp(0, __float_as_int(v), (ctrl), 0xf, 0xf, true))
#define PEER_META(T, IA, IB, HA, HB) do { const int _t = (T) < TTOK ? (T) : wslot; \
    IA = *(const u32x4*)(W_IDX(p) + (size_t)_t * 128 + r * 16); IB = *(const u32x4*)(W_IDX(p) + (size_t)_t * 128 + r * 16 + 8); \
    const u16* _hp = W_H(p) + (size_t)_t * DM + x * 128 + 16 * c; HA = *(const u32x4*)(_hp); HB = *(const u32x4*)(_hp + 8); } while (0)
#define PEER_GATHER(TAB, IA, IB, RR) do { _Pragma("unroll") for (int g = 0; g < 16; ++g) { \
    const unsigned _w = (g < 8 ? IA : IB)[(g >> 1) & 3]; const unsigned _e = (g & 1) ? (_w >> 16) : (_w & 0xffffu); RR[g] = *(const u32x4*)((TAB) + (_e * 128u + c16)); } } while (0)
#define PEER_UNPACK(XS, HA, HB) do { _Pragma("unroll") for (int e = 0; e < 4; ++e) { \
    XS[e] = (f32x2){bflo(HA[e]), bfhi(HA[e])}; XS[4 + e] = (f32x2){bflo(HB[e]), bfhi(HB[e])}; } } while (0)

#define DPP_I(v, ctrl) __builtin_amdgcn_update_dpp(0, (v), (ctrl), 0xf, 0xf, true)
DI int reduce_scatter8(int d0, int d1, int d2, int d3, int d4, int d5, int d6, int d7, int c) {
  const bool b2 = c >= 4, b1 = (c & 2) != 0, b0 = (c & 1) != 0;
  const int e0 = (b2 ? d4 : d0) + DPP_I(b2 ? d0 : d4, 0x141);
  const int e1 = (b2 ? d5 : d1) + DPP_I(b2 ? d1 : d5, 0x141);
  const int e2 = (b2 ? d6 : d2) + DPP_I(b2 ? d2 : d6, 0x141);
  const int e3 = (b2 ? d7 : d3) + DPP_I(b2 ? d3 : d7, 0x141);
  const int f0 = (b1 ? e2 : e0) + DPP_I(b1 ? e0 : e2, 0x4E);
  const int f1 = (b1 ? e3 : e1) + DPP_I(b1 ? e1 : e3, 0x4E);
  return (b0 ? f1 : f0) + DPP_I(b0 ? f0 : f1, 0xB1);
}
DI void phase_peer_dots(const Params& p, int layer, int wave) {
  const int tid = otid_w(wave), lane = tid & 63, wid = tid >> 6, c = lane & 7, r = lane >> 3;
  const int x = blockIdx.x & 7, wslot = (blockIdx.x >> 3) * 8 + wid, nslot = (gridDim.x >> 3) * 8;
  const unsigned char* ub = W_UB(p) + (size_t)x * (PEER_N * 128);
  const unsigned c16 = (unsigned)c * 16u;
  u16* pd = W_Y(p);
  u32x4 iAa, iBa, iAb, iBb;
  u32x4 hAa, hBa, hAb, hBb, rrA[16], rrB[16];
  int xq[4];
  float xscale;
#define DOTS_QUANT(HA, HB) do { float _xv[16]; \
    _Pragma("unroll") for (int e = 0; e < 4; ++e) { _xv[2 * e] = bflo(HA[e]); _xv[2 * e + 1] = bfhi(HA[e]); _xv[8 + 2 * e] = bflo(HB[e]); _xv[8 + 2 * e + 1] = bfhi(HB[e]); } \
    float _am = 0.f; _Pragma("unroll") for (int e = 0; e < 16; ++e) _am = fmaxf(_am, fabsf(_xv[e])); \
    _am = DPP_MAX(_am, 0xB1); _am = DPP_MAX(_am, 0x4E); _am = DPP_MAX(_am, 0x141); \
    const float _qs = _am > 0.f ? 127.0f / _am : 0.f; xscale = _am * (1.0f / 127.0f); \
    _Pragma("unroll") for (int k = 0; k < 4; ++k) { \
      const int q0 = __float2int_rn(_xv[4 * k] * _qs), q1 = __float2int_rn(_xv[4 * k + 1] * _qs), q2 = __float2int_rn(_xv[4 * k + 2] * _qs), q3 = __float2int_rn(_xv[4 * k + 3] * _qs); \
      xq[k] = (int)(((unsigned)q0 & 255u) | (((unsigned)q1 & 255u) << 8) | (((unsigned)q2 & 255u) << 16) | ((unsigned)q3 << 24)); } } while (0)
#define DOTS_COMPUTE(T, RR) do { if ((T) < TTOK) { int dd[16]; \
    _Pragma("unroll") for (int g = 0; g < 16; ++g) { int d = 0; \
      _Pragma("unroll") for (int k = 0; k < 4; ++k) d = __builtin_amdgcn_sdot4((int)RR[g][k], xq[k], d, false); \
      dd[g] = d; } \
    const int pA = reduce_scatter8(dd[0], dd[1], dd[2], dd[3], dd[4], dd[5], dd[6], dd[7], c); \
    const int pB = reduce_scatter8(dd[8], dd[9], dd[10], dd[11], dd[12], dd[13], dd[14], dd[15], c); \
    u16* _dst = pd + ((size_t)(T) * 8 + x) * 128 + r * 16 + c;        \
    _dst[0] = (u16)(pack2((float)pA * xscale, 0.f) & 0xffffu); _dst[8] = (u16)(pack2((float)pB * xscale, 0.f) & 0xffffu); } } while (0)
  int t = wslot;
  PEER_META(t, iAa, iBa, hAa, hBa);
  PEER_META(t + nslot, iAb, iBb, hAb, hBb);
  PEER_GATHER(ub, iAa, iBa, rrA);
  for (; t < TTOK; t += 2 * nslot) {
    DOTS_QUANT(hAa, hBa);
    PEER_META(t + 2 * nslot, iAa, iBa, hAa, hBa);
    PEER_GATHER(ub, iAb, iBb, rrB);
    DOTS_COMPUTE(t, rrA);
    DOTS_QUANT(hAb, hBb);
    PEER_META(t + 3 * nslot, iAb, iBb, hAb, hBb);
    PEER_GATHER(ub, iAa, iBa, rrA);
    DOTS_COMPUTE(t + nslot, rrB);
  }
#undef DOTS_COMPUTE
#undef DOTS_QUANT
}

DI void phase_peer_w(const Params& p, int layer, int wave) {
  const int tid = otid_w(wave), lane = tid & 63, wid = tid >> 6;
  const u16* pd = W_Y(p);
  for (int t = blockIdx.x * 8 + wid; t < TTOK; t += gridDim.x * 8) {
#pragma unroll
    for (int hf = 0; hf < 2; ++hf) {
      const int j = hf * 64 + lane;
      float sacc = 0.f;
#pragma unroll
      for (int xx = 0; xx < 8; ++xx) sacc += __uint_as_float(((unsigned)pd[((size_t)t * 8 + xx) * 128 + j]) << 16);
      const int e = W_IDX(p)[(size_t)t * 128 + j];
      const float act = sacc * W_SU(p)[e];
      const float wv = W_G(p)[(size_t)t * 128 + j] * (0.5f * act * (1.0f + erff(act * 0.7071067811865476f))) * W_SV(p)[e];
      W_W16(p)[(size_t)t * 128 + j] = (u16)(pack2(wv, 0.f) & 0xffffu);
    }
  }
}

#define PEER_META_V(T, IA, IB, WA, WB, HR) do { const int _t = (T) < TTOK ? (T) : wslot; \
    IA = *(const u32x4*)(W_IDX(p) + (size_t)_t * 128 + r * 16); IB = *(const u32x4*)(W_IDX(p) + (size_t)_t * 128 + r * 16 + 8); \
    WA = *(const u32x4*)(W_W16(p) + (size_t)_t * 128 + r * 16); WB = *(const u32x4*)(W_W16(p) + (size_t)_t * 128 + r * 16 + 8); \
    HR = *(const u32x2*)(W_H(p) + (size_t)_t * DM + ocol); } while (0)
DI float swap32_add(float a, float b) {
  const u32x2 r = __builtin_amdgcn_permlane32_swap(__float_as_uint(a), __float_as_uint(b), false, false);
  return __uint_as_float(r[0]) + __uint_as_float(r[1]);
}
DI float swap16_add(float a, float b) {
  const u32x2 r = __builtin_amdgcn_permlane16_swap(__float_as_uint(a), __float_as_uint(b), false, false);
  return __uint_as_float(r[0]) + __uint_as_float(r[1]);
}
DI void phase_peer_v(const Params& p, int layer, int wave) {
  const int tid = otid_w(wave), lane = tid & 63, wid = tid >> 6, c = lane & 7, r = lane >> 3;
  const int x = blockIdx.x & 7, wslot = (blockIdx.x >> 3) * 8 + wid, nslot = (gridDim.x >> 3) * 8;
  const unsigned char* vb = W_VB(p) + (size_t)x * (PEER_N * 128);
  const unsigned c16 = (unsigned)c * 16u;
  u16* y2 = W_Y(p);
  const int ocol = x * 128 + 16 * c + 4 * ((lane >> 4) & 1) + 8 * (lane >> 5);
  u32x4 iAa, iBa, iAb, iBb;
  u32x4 wAa, wBa, wAb, wBb, wA, wB;
  u32x2 hRa, hRb, hR;
  u32x4 rrA[16], rrB[16];
#define V_COMPUTE(T, RR) do { if ((T) < TTOK) { f32x2 acc[8]; \
    _Pragma("unroll") for (int i = 0; i < 8; ++i) acc[i] = (f32x2){0.f, 0.f}; \
    _Pragma("unroll") for (int g = 0; g < 16; ++g) { \
      const unsigned _ww = (g < 8 ? wA : wB)[(g >> 1) & 3]; const float wj = (g & 1) ? bfhi(_ww) : bflo(_ww); \
      const f32x2 wj2 = (f32x2){wj, wj}; \
      _Pragma("unroll") for (int k = 0; k < 4; ++k) { \
        const f32x2 lo = __builtin_amdgcn_cvt_pk_f32_fp8((int)RR[g][k], false), hi = __builtin_amdgcn_cvt_pk_f32_fp8((int)RR[g][k], true); \
        acc[2 * k] += wj2 * lo; acc[2 * k + 1] += wj2 * hi; } } \
    float P8[8], Q4[4]; \
    _Pragma("unroll") for (int i = 0; i < 8; ++i) P8[i] = swap32_add(acc[i >> 1][i & 1], acc[(i + 8) >> 1][i & 1]);     \
    _Pragma("unroll") for (int i = 0; i < 4; ++i) Q4[i] = swap16_add(P8[i], P8[i + 4]);                                 \
    _Pragma("unroll") for (int i = 0; i < 4; ++i) Q4[i] += DPP_F(Q4[i], 0x128);                                         \
    if ((lane & 8) == 0) { u32x2 _o; \
      _o[0] = pack2(ALPHA * bflo(hR[0]) + Q4[0], ALPHA * bfhi(hR[0]) + Q4[1]); \
      _o[1] = pack2(ALPHA * bflo(hR[1]) + Q4[2], ALPHA * bfhi(hR[1]) + Q4[3]); \
      *(u32x2*)(y2 + (size_t)(T) * DM + ocol) = _o; } } } while (0)
  int t = wslot;
  PEER_META_V(t, iAa, iBa, wAa, wBa, hRa);
  PEER_META_V(t + nslot, iAb, iBb, wAb, wBb, hRb);
  PEER_GATHER(vb, iAa, iBa, rrA);
  for (; t < TTOK; t += 2 * nslot) {
    wA = wAa; wB = wBa; hR = hRa;
    PEER_META_V(t + 2 * nslot, iAa, iBa, wAa, wBa, hRa);
    PEER_GATHER(vb, iAb, iBb, rrB);
    V_COMPUTE(t, rrA);
    wA = wAb; wB = wBb; hR = hRb;
    PEER_META_V(t + 3 * nslot, iAb, iBb, wAb, wBb, hRb);
    PEER_GATHER(vb, iAa, iBa, rrA);
    V_COMPUTE(t + nslot, rrB);
  }
#undef V_COMPUTE
}

#define XB_TMO      128
#define XB_XCNT(j)  (256  + 64 * (j))
#define XB_XSUB(j)  (1280 + 64 * (j))
#define XB_XGEN(j)  (2304 + 64 * (j))
#define XB_TOP      3328
#define XB_TOPGEN   3392
#define XCD_BAR_WORDS 3456
#define XB_SPIN_CAP (1u << 22)
DI unsigned xb_ld(unsigned* p)              { return __hip_atomic_load(p, __ATOMIC_RELAXED, __HIP_MEMORY_SCOPE_AGENT); }
DI unsigned xb_add(unsigned* p, unsigned v) { return __hip_atomic_fetch_add(p, v, __ATOMIC_RELAXED, __HIP_MEMORY_SCOPE_AGENT); }
DI unsigned xb_xcc_id() { return (unsigned)__builtin_amdgcn_s_getreg((3 << 11) | 20) & 0xFu; }
#define XB_SPIN(cond, bar) do { unsigned _sp = 0; while (cond) { __builtin_amdgcn_s_sleep(1); \
    if ((++_sp & 255u) == 0u) { if (xb_ld(&(bar)[XB_TMO])) break; if (_sp > XB_SPIN_CAP) { atomicAdd(&(bar)[XB_TMO], 1u); break; } } } } while (0)
DI bool is_thread0(int wave) { unsigned z = 0u; asm volatile("" : "+v"(z)); return wave == 0 && __builtin_amdgcn_mbcnt_hi(~0u, __builtin_amdgcn_mbcnt_lo(~0u, z)) == 0u; }
DI void xcd_barrier_complete(unsigned* bar, unsigned x, unsigned& nloc, unsigned& nx) {
  const unsigned G = gridDim.x;
  unsigned sum, cnt, mine, sp = 0u;
  for (;;) {
    sum = 0u; cnt = 0u; mine = 0u;
#pragma unroll
    for (unsigned j = 0; j < 16; ++j) { const unsigned c = xb_ld(&bar[XB_XCNT(j)]); sum += c; cnt += (c > 0u) ? 1u : 0u; mine = (j == x) ? c : mine; }
    if (sum == G) break;
    __builtin_amdgcn_s_sleep(1);
    if ((++sp & 255u) == 0u) { if (xb_ld(&bar[XB_TMO])) break; if (sp > XB_SPIN_CAP) { atomicAdd(&bar[XB_TMO], 1u); break; } }
  }
  nloc = mine > 0u ? mine : 1u; nx = cnt > 0u ? cnt : 1u;
}
DI void xcd_barrier(unsigned* bar, volatile LAS unsigned* st, int wave) {
  asm volatile("s_waitcnt vmcnt(0)" ::: "memory");
  __syncthreads();
  if (is_thread0(wave)) {
    const unsigned x = xb_xcc_id();
    __builtin_amdgcn_s_waitcnt(0);
    unsigned nloc = st[0], nx = st[1];
    if (nloc == 0u) { xcd_barrier_complete(bar, x, nloc, nx); st[0] = nloc; st[1] = nx; }
    const unsigned old = xb_add(&bar[XB_XSUB(x)], 1u);
    const unsigned gen = old / nloc;
    if (old + 1u == (gen + 1u) * nloc) {
      __builtin_amdgcn_fence(__ATOMIC_RELEASE, "agent");
      asm volatile("s_waitcnt vmcnt(0)" ::: "memory");
      const unsigned og = xb_add(&bar[XB_TOP], 1u);
      const unsigned tg = og / nx;
      if (og + 1u == (tg + 1u) * nx) xb_add(&bar[XB_TOPGEN], 1u);
      else XB_SPIN(xb_ld(&bar[XB_TOPGEN]) == tg, bar);
      __builtin_amdgcn_fence(__ATOMIC_ACQUIRE, "agent");
      xb_add(&bar[XB_XGEN(x)], 1u);
      asm volatile("s_waitcnt vmcnt(0)" ::: "memory");
    } else {
      XB_SPIN(xb_ld(&bar[XB_XGEN(x)]) == gen, bar);
      __builtin_amdgcn_fence(__ATOMIC_ACQUIRE, "agent");
      asm volatile("s_waitcnt vmcnt(0)" ::: "memory");
    }
  }
  __syncthreads();
}

__global__ void __launch_bounds__(NTHREADS, 2) mega(Params p) {
  extern __shared__ __attribute__((aligned(16))) char smem[];
  cg::grid_group grid = cg::this_grid();
  const int wave = __builtin_amdgcn_readfirstlane((int)(threadIdx.x >> 6));
  unsigned* bar = (unsigned*)(p.ws + WS_BAR);
  volatile LAS unsigned* st = (volatile LAS unsigned*)((lchar*)smem + LDS_XB);
  if (threadIdx.x == 0) { st[0] = 0u; st[1] = 0u; (void)xb_add(&bar[XB_XCNT(xb_xcc_id())], 1u); }
  __syncthreads();
  phase_prologue(p, smem, wave);
  grid.sync();
  phase_fold(p, smem, wave);
  xcd_barrier(bar, st, wave);
#pragma unroll 1
  for (int step = 0; step < DEPTH * 9; ++step) {
    const int layer = step / 9, ph = step - layer * 9;
    if (ph == 0 || ph == 2 || ph == 4) phase_gemm(p, layer, ph >> 1, smem, wave);
    else if (ph == 1) phase_attn(p, layer, smem, wave);
    else if (ph == 3 || ph == 8) phase_ln(p, layer, ph == 8, wave);
    else if (ph == 5) phase_peer_dots(p, layer, wave);
    else if (ph == 6) phase_peer_w(p, layer, wave);
    else phase_peer_v(p, layer, wave);
    if (step + 1 < DEPTH * 9) xcd_barrier(bar, st, wave);
  }
}

extern "C" void kernel_launch(void* const* d_in, const int* in_sizes, int n_in, void* d_out, int out_size, void* d_ws, size_t ws_size,
                              hipStream_t stream) {
  static int grid_blocks = 0;
  if (grid_blocks == 0) {
    if (ws_size < WS_END) { fprintf(stderr, "kernel_launch: workspace too small: need %zu, got %zu\n", (size_t)WS_END, ws_size); grid_blocks = -1; return; }
    int dev = 0, cus = 0, per_cu = 0;
    hipGetDevice(&dev);
    hipDeviceGetAttribute(&cus, hipDeviceAttributeMultiprocessorCount, dev);
    hipFuncSetAttribute((const void*)mega, hipFuncAttributeMaxDynamicSharedMemorySize, LDS_BYTES);
    hipOccupancyMaxActiveBlocksPerMultiprocessor(&per_cu, (const void*)mega, NTHREADS, LDS_BYTES);
    if (per_cu < 1) per_cu = 1;
    if (per_cu > 1) per_cu = 1;
    grid_blocks = cus * per_cu;
  }
  if (grid_blocks < 0) return;
  Params p{};
  for (int i = 0; i < 21; ++i) p.in[i] = (const float*)d_in[i];
  p.out = (float*)d_out;
  p.ws = (char*)d_ws;
  if (hipMemsetAsync((char*)d_ws + WS_BAR, 0, 16384, stream) != hipSuccess) { fprintf(stderr, "kernel_launch: memset of the barrier words failed\n"); return; }
  void* args[] = {&p};
  hipError_t e = hipLaunchCooperativeKernel((const void*)mega, dim3(grid_blocks), dim3(NTHREADS), args, LDS_BYTES, stream);
  if (e != hipSuccess) fprintf(stderr, "cooperative launch failed: %s (grid %d)\n", hipGetErrorString(e), grid_blocks);
}
```

```cpp
#include <hip/hip_runtime.h>
#include <hip/hip_cooperative_groups.h>
#include <cstdio>
#include <cstdint>
namespace cg = cooperative_groups;

typedef unsigned short u16;
typedef __attribute__((ext_vector_type(8))) short bf16x8;
typedef __attribute__((ext_vector_type(4))) float f32x4;
typedef __attribute__((ext_vector_type(4))) unsigned u32x4;
typedef __attribute__((ext_vector_type(2))) unsigned u32x2;
typedef __attribute__((ext_vector_type(2))) float f32x2;
#define DI __device__ __forceinline__
#define LAS __attribute__((address_space(3)))
typedef LAS char lchar;

#define DM 1024
#define NBATCH 32
#define SEQ 2048
#define NMETA 16
#define LSEQ 2064
#define TTOK 66048
#define DEPTH 4
#define INC 3072
#define LP 2112
#define PEER_N 16384
#define NTHREADS 512
#define LDS_MISC 69632
#define LDS_HALF 70656
#define LDS_XB 141312
#define LDS_BYTES 141328

#define ALPHA 1.681792830507429f
#define LOG2E 1.4426950408889634f

static constexpr size_t WS_WIN  = 0;
static constexpr size_t WS_WOUT = WS_WIN  + (size_t)4 * 3072 * 1024 * 2;
static constexpr size_t WS_WQB  = WS_WOUT + (size_t)4 * 1024 * 1024 * 2;
static constexpr size_t WS_SKB  = WS_WQB  + (size_t)4 * 1024 * 2048 * 2;
static constexpr size_t WS_WSC  = WS_SKB  + (size_t)4 * 16 * 128 * 128 * 2;
static constexpr size_t WS_UB   = WS_WSC  + (size_t)4 * 2048 * 1024 * 2;
static constexpr size_t WS_VB   = WS_UB   + (size_t)PEER_N * 1024;
static constexpr size_t WS_SU   = WS_VB   + (size_t)PEER_N * 1024;
static constexpr size_t WS_SV   = WS_SU   + (size_t)PEER_N * 4;
static constexpr size_t WS_H    = WS_SV   + (size_t)PEER_N * 4;
static constexpr size_t WS_MIX  = WS_H    + (size_t)TTOK * 1024 * 2;
static constexpr size_t WS_BIG  = WS_MIX  + (size_t)TTOK * 1024 * 2;
static constexpr size_t WS_VT   = WS_BIG  + (size_t)(TTOK + 64) * 3072 * 2;
static constexpr size_t WS_IDX  = WS_VT   + (size_t)NBATCH * 4 * 128 * LP * 2;
static constexpr size_t WS_G    = WS_IDX  + (size_t)TTOK * 128 * 4;
static constexpr size_t WS_W16  = WS_G    + (size_t)TTOK * 128 * 4;
static constexpr size_t WS_BAR  = WS_W16  + (size_t)TTOK * 128 * 2;
static constexpr size_t WS_END  = WS_BAR  + 16384;

struct Params {
  const float* in[21];
  float* out;
  char* ws;
};
#define P_X(p) ((p).in[0])
#define P_META(p) ((p).in[1])
#define P_LN_IN_G(p) ((p).in[2])
#define P_LN_IN_B(p) ((p).in[3])
#define P_REL_BIAS(p) ((p).in[4])
#define P_W_IN(p) ((p).in[5])
#define P_CONV_W(p) ((p).in[6])
#define P_LQ1(p) ((p).in[7])
#define P_LK1(p) ((p).in[8])
#define P_LQ2(p) ((p).in[9])
#define P_LK2(p) ((p).in[10])
#define P_SUBLN_G(p) ((p).in[11])
#define P_W_OUT(p) ((p).in[12])
#define P_LN1_G(p) ((p).in[13])
#define P_LN1_B(p) ((p).in[14])
#define P_W_Q(p) ((p).in[15])
#define P_SUB_KEYS(p) ((p).in[16])
#define P_PEER_U(p) ((p).in[17])
#define P_PEER_V(p) ((p).in[18])
#define P_LN2_G(p) ((p).in[19])
#define P_LN2_B(p) ((p).in[20])
#define W_WIN(p) ((u16*)((p).ws + WS_WIN))
#define W_WOUT(p) ((u16*)((p).ws + WS_WOUT))
#define W_WQB(p) ((u16*)((p).ws + WS_WQB))
#define W_SKB(p) ((u16*)((p).ws + WS_SKB))
#define W_WSC(p) ((u16*)((p).ws + WS_WSC))
#define W_UB(p) ((unsigned char*)((p).ws + WS_UB))
#define W_VB(p) ((unsigned char*)((p).ws + WS_VB))
#define W_SU(p) ((float*)((p).ws + WS_SU))
#define W_SV(p) ((float*)((p).ws + WS_SV))
#define W_H(p) ((u16*)((p).ws + WS_H))
#define W_MIX(p) ((u16*)((p).ws + WS_MIX))
#define W_PROJ(p) ((u16*)((p).ws + WS_BIG))
#define W_Y(p) ((u16*)((p).ws + WS_BIG))
#define W_VT(p) ((u16*)((p).ws + WS_VT))
#define W_IDX(p) ((u16*)((p).ws + WS_IDX))
#define W_W16(p) ((u16*)((p).ws + WS_W16))
#define W_G(p) ((float*)((p).ws + WS_G))

DI u16 f2bf(float x) { unsigned u = __float_as_uint(x); u += 0x7fffu + ((u >> 16) & 1u); return (u16)(u >> 16); }
typedef __attribute__((ext_vector_type(2))) __bf16 bf16x2_t;
DI unsigned pack2(float a, float b) { const bf16x2_t v = {(__bf16)a, (__bf16)b}; return __builtin_bit_cast(unsigned, v); }
DI float bflo(unsigned w) { return __uint_as_float(w << 16); }
DI float bfhi(unsigned w) { return __uint_as_float(w & 0xffff0000u); }
DI int otid_w(int wave) { unsigned z = 0u; asm volatile("" : "+v"(z)); int t = wave * 64 + (int)__builtin_amdgcn_mbcnt_hi(~0u, __builtin_amdgcn_mbcnt_lo(~0u, z)); asm volatile("" : "+v"(t)); return t; }
#define DPP_ADD(v, ctrl) ((v) + __int_as_float(__builtin_amdgcn_update_dpp(0, __float_as_int(v), (ctrl), 0xf, 0xf, true)))
DI float wave_sum(float v) {
  v = DPP_ADD(v, 0xB1);
  v = DPP_ADD(v, 0x4E);
  v = DPP_ADD(v, 0x141);
  v = DPP_ADD(v, 0x140);
  const int iv = __float_as_int(v);
  return __int_as_float(__builtin_amdgcn_readlane(iv, 0)) + __int_as_float(__builtin_amdgcn_readlane(iv, 16)) +
         __int_as_float(__builtin_amdgcn_readlane(iv, 32)) + __int_as_float(__builtin_amdgcn_readlane(iv, 48));
}
#define DPP_MAX(v, ctrl) fmaxf((v), __int_as_float(__builtin_amdgcn_update_dpp(0, __float_as_int(v), (ctrl), 0xf, 0xf, true)))
DI float wave_max_nonneg(float v) {
  v = DPP_MAX(v, 0xB1); v = DPP_MAX(v, 0x4E); v = DPP_MAX(v, 0x141); v = DPP_MAX(v, 0x140);
  const int iv = __float_as_int(v);
  return fmaxf(fmaxf(__int_as_float(__builtin_amdgcn_readlane(iv, 0)), __int_as_float(__builtin_amdgcn_readlane(iv, 16))),
               fmaxf(__int_as_float(__builtin_amdgcn_readlane(iv, 32)), __int_as_float(__builtin_amdgcn_readlane(iv, 48))));
}
DI float shx16(float v) { return __int_as_float(__builtin_amdgcn_ds_swizzle(__float_as_int(v), 0x401F)); }
DI float shx32(float v, int idx32) { return __int_as_float(__builtin_amdgcn_ds_bpermute(idx32, __float_as_int(v))); }
DI f32x4 mfma16(bf16x8 a, bf16x8 b, f32x4 c) { return __builtin_amdgcn_mfma_f32_16x16x32_bf16(a, b, c, 0, 0, 0); }
DI float fast_exp2(float x) { return __builtin_amdgcn_exp2f(x); }

DI void convert_straight(const float* __restrict__ src, u16* __restrict__ dst, size_t n8, size_t gtid, size_t gthreads) {
  for (size_t i = gtid; i < n8; i += gthreads) {
    const f32x4 a = *(const f32x4*)(src + i * 8), b = *(const f32x4*)(src + i * 8 + 4);
    u32x4 o; o[0] = pack2(a[0], a[1]); o[1] = pack2(a[2], a[3]); o[2] = pack2(b[0], b[1]); o[3] = pack2(b[2], b[3]);
    *(u32x4*)(dst + i * 8) = o;
  }
}

DI void transpose_tile(const float* __restrict__ src, int ldn, u16* __restrict__ dst, int ldk, int k0, int n0, float* sm, int tid) {
#pragma unroll
  for (int i = 0; i < 4; ++i) {
    const int r = (tid >> 4) + 16 * i, c4 = tid & 15;
    const f32x4 v = *(const f32x4*)(src + (size_t)(k0 + r) * ldn + n0 + 4 * c4);
    sm[r * 65 + 4 * c4 + 0] = v[0]; sm[r * 65 + 4 * c4 + 1] = v[1]; sm[r * 65 + 4 * c4 + 2] = v[2]; sm[r * 65 + 4 * c4 + 3] = v[3];
  }
  __syncthreads();
#pragma unroll
  for (int i = 0; i < 2; ++i) {
    const int n = (tid >> 3) + 32 * i, kc = tid & 7;
    u32x4 o;
#pragma unroll
    for (int e = 0; e < 4; ++e) o[e] = pack2(sm[(8 * kc + 2 * e) * 65 + n], sm[(8 * kc + 2 * e + 1) * 65 + n]);
    *(u32x4*)(dst + (size_t)(n0 + n) * ldk + k0 + 8 * kc) = o;
  }
  __syncthreads();
}

template <int LAYOUT> DI int col0(int lane, int hh) { return LAYOUT ? 16 * lane + 8 * hh : hh * 512 + 8 * lane; }
template <int LAYOUT>
DI void ln_row(float (&v)[16], const float* __restrict__ g, const float* __restrict__ b, int lane) {
  float s = 0.f;
#pragma unroll
  for (int i = 0; i < 16; ++i) s += v[i];
  const float mu = wave_sum(s) * (1.0f / 1024.0f);
  float q = 0.f;
#pragma unroll
  for (int i = 0; i < 16; ++i) { const float d = v[i] - mu; q += d * d; }
  const float rstd = rsqrtf(wave_sum(q) * (1.0f / 1024.0f) + 1e-5f);
#pragma unroll
  for (int hh = 0; hh < 2; ++hh) {
    const int c = col0<LAYOUT>(lane, hh);
    const f32x4 g0 = *(const f32x4*)(g + c), g1 = *(const f32x4*)(g + c + 4), b0 = *(const f32x4*)(b + c), b1 = *(const f32x4*)(b + c + 4);
#pragma unroll
    for (int e = 0; e < 4; ++e) {
      v[hh * 8 + e] = (v[hh * 8 + e] - mu) * rstd * g0[e] + b0[e];
      v[hh * 8 + 4 + e] = (v[hh * 8 + 4 + e] - mu) * rstd * g1[e] + b1[e];
    }
  }
}
template <int LAYOUT>
DI void store_row_bf16(u16* __restrict__ dst, const float (&v)[16], int lane) {
#pragma unroll
  for (int hh = 0; hh < 2; ++hh) {
    u32x4 o;
#pragma unroll
    for (int e = 0; e < 4; ++e) o[e] = pack2(v[hh * 8 + 2 * e], v[hh * 8 + 2 * e + 1]);
    *(u32x4*)(dst + col0<LAYOUT>(lane, hh)) = o;
  }
}
template <int LAYOUT>
DI void load_row_bf16(const u16* __restrict__ src, float (&v)[16], int lane) {
#pragma unroll
  for (int hh = 0; hh < 2; ++hh) {
    const u32x4 a = *(const u32x4*)(src + col0<LAYOUT>(lane, hh));
#pragma unroll
    for (int e = 0; e < 4; ++e) { v[hh * 8 + 2 * e] = bflo(a[e]); v[hh * 8 + 2 * e + 1] = bfhi(a[e]); }
  }
}
template <int LAYOUT>
DI void load_row_f32(const float* __restrict__ src, float (&v)[16], int lane) {
#pragma unroll
  for (int hh = 0; hh < 2; ++hh) {
    const int c = col0<LAYOUT>(lane, hh);
    const f32x4 a = *(const f32x4*)(src + c), b = *(const f32x4*)(src + c + 4);
#pragma unroll
    for (int e = 0; e < 4; ++e) { v[hh * 8 + e] = a[e]; v[hh * 8 + 4 + e] = b[e]; }
  }
}

enum { EPI_PROJ = 0, EPI_VT = 1, EPI_OUT = 2, EPI_TOPK = 3, EPI_FOLD = 4 };

template <bool SWAP>
DI void gemm_mainloop(const u16* __restrict__ A, int lda, const u16* __restrict__ Bt, int ldb, int K, int m0, int n0, char* smem,
                      f32x4 (&acc)[4][4], int tid) {
  const int lane = tid & 63, wid = tid >> 6, wm = wid >> 1, wn = wid & 1;
  const int srow = tid >> 3, skc = tid & 7;
  const u16* ap = A + (size_t)(m0 + srow) * lda + skc * 8;
  const u16* bp = Bt + (size_t)(n0 + srow) * ldb + skc * 8;
  const int dst0 = (((srow >> 4) * 2 + (skc >> 2)) * 1024) + (((skc & 3) * 16 + (srow & 15)) * 16);
#pragma unroll
  for (int i = 0; i < 4; ++i)
#pragma unroll
    for (int j = 0; j < 4; ++j) acc[i][j] = (f32x4){0.f, 0.f, 0.f, 0.f};
  u32x4 ra[4], rb[4];
#pragma unroll
  for (int j = 0; j < 4; ++j) { ra[j] = *(const u32x4*)(ap + (size_t)j * 32 * lda); rb[j] = *(const u32x4*)(bp + (size_t)j * 32 * ldb); }
#pragma unroll
  for (int j = 0; j < 4; ++j) { *(u32x4*)(smem + dst0 + j * 4096) = ra[j]; *(u32x4*)(smem + 16384 + dst0 + j * 4096) = rb[j]; }
  __syncthreads();
  const int KT = K >> 6;
  for (int kt = 0; kt < KT; ++kt) {
    char* cur = smem + (kt & 1) * 32768;
    char* nxt = smem + ((kt + 1) & 1) * 32768;
    const bool more = (kt + 1 < KT);
    if (more) {
      const u16* ap2 = ap + (kt + 1) * 64;
      const u16* bp2 = bp + (kt + 1) * 64;
#pragma unroll
      for (int j = 0; j < 4; ++j) { ra[j] = *(const u32x4*)(ap2 + (size_t)j * 32 * lda); rb[j] = *(const u32x4*)(bp2 + (size_t)j * 32 * ldb); }
    }
#pragma unroll
    for (int ks = 0; ks < 2; ++ks) {
      bf16x8 af[4], bfr[4];
#pragma unroll
      for (int i = 0; i < 4; ++i) af[i] = *(const bf16x8*)(cur + (((wm * 4 + i) * 2 + ks) * 1024) + lane * 16);
#pragma unroll
      for (int j = 0; j < 4; ++j) bfr[j] = *(const bf16x8*)(cur + 16384 + (((wn * 4 + j) * 2 + ks) * 1024) + lane * 16);
#pragma unroll
      for (int i = 0; i < 4; ++i)
#pragma unroll
        for (int j = 0; j < 4; ++j) acc[i][j] = SWAP ? mfma16(bfr[j], af[i], acc[i][j]) : mfma16(af[i], bfr[j], acc[i][j]);
    }
    if (more) {
#pragma unroll
      for (int j = 0; j < 4; ++j) { *(u32x4*)(nxt + dst0 + j * 4096) = ra[j]; *(u32x4*)(nxt + 16384 + dst0 + j * 4096) = rb[j]; }
    }
    __syncthreads();
  }
}

DI void ce_desc(float& hi, float& lo) { const float a = hi, b = lo; hi = fmaxf(a, b); lo = fminf(a, b); }
DI void bitonic_merge16(float (&v)[16]) {
#pragma unroll
  for (int j = 8; j > 0; j >>= 1)
#pragma unroll
    for (int i = 0; i < 16; ++i) if ((i & j) == 0) ce_desc(v[i], v[i | j]);
}
DI void bitonic_sort16(float (&v)[16]) {
#pragma unroll
  for (int k = 2; k <= 16; k <<= 1)
#pragma unroll
    for (int j = k >> 1; j > 0; j >>= 1)
#pragma unroll
      for (int i = 0; i < 16; ++i) {
        const int l = i ^ j;
        if (l > i) { if ((i & k) == 0 || k == 16) ce_desc(v[i], v[l]); else ce_desc(v[l], v[i]); }
      }
}
DI void merge_top16(float (&v)[16], const float (&w)[16]) {
#pragma unroll
  for (int i = 0; i < 16; ++i) v[i] = fmaxf(v[i], w[15 - i]);
  bitonic_merge16(v);
}
DI void insert16(float (&v)[16], float x) {
#pragma unroll
  for (int j = 0; j < 16; ++j) { const float hi = fmaxf(v[j], x); x = fminf(v[j], x); v[j] = hi; }
}

DI void gemm_tile_fold(const u16* A, int lda, const u16* Bt, int ldb, int K, int m0, char* smem, u16* dstT, int tid) {
  const int lane = tid & 63, wid = tid >> 6, wm = wid >> 1, wn = wid & 1, g = lane >> 4, l15 = lane & 15;
  f32x4 acc[4][4];
  gemm_mainloop<false>(A, lda, Bt, ldb, K, m0, 0, smem, acc, tid);
#pragma unroll
  for (int i = 0; i < 4; ++i)
#pragma unroll
    for (int j = 0; j < 4; ++j) {
      const int m = m0 + wm * 64 + 16 * i + 4 * g, n = wn * 64 + 16 * j + l15;
      u32x2 o; o[0] = pack2(acc[i][j][0], acc[i][j][1]); o[1] = pack2(acc[i][j][2], acc[i][j][3]);
      *(u32x2*)(dstT + (size_t)n * 1024 + m) = o;
    }
}

#define GK 1024
#define HTB 16384
DI int lds_byte(int r, int c) {
  const int st = (r >> 4) * 2 + (c >> 5), rr = r & 15, cc = c & 31, ob = rr * 64 + cc * 2;
  return st * 1024 + (ob ^ (((ob >> 9) & 1) << 5));
}
DI void stage_rc(int b, int& R, int& C) {
  const int st = b / 1024, sb = b % 1024, swz = sb ^ (((sb >> 9) & 1) << 5);
  R = (st >> 1) * 16 + swz / 64; C = (st & 1) * 32 + (swz % 64) / 2;
}
#define G_SA(b, h) (shm + ((b) * 2 + (h)) * HTB)
#define G_SB(b, h) (shm + (4 + (b) * 2 + (h)) * HTB)
#define G_STAGE(P, BASE, br, kt) do { const char* _g = (const char*)((BASE) + (size_t)(br) * GK + (kt) * 64); \
    __builtin_amdgcn_global_load_lds((const unsigned*)(_g + goff0), (LAS unsigned*)((P) + tid * 16), 16, 0, 0); \
    __builtin_amdgcn_global_load_lds((const unsigned*)(_g + goff1), (LAS unsigned*)((P) + tid * 16 + 8192), 16, 0, 0); } while (0)
#define G_LDA(dst, b, h) _Pragma("unroll") for (int m = 0; m < 4; ++m) _Pragma("unroll") for (int k = 0; k < 2; ++k) \
    dst[m][k] = *(const LAS bf16x8*)(G_SA(b, h) + lds_byte(wr * 64 + m * 16 + fr, k * 32 + fq * 8))
#define G_LDB(dst, b, h) _Pragma("unroll") for (int n = 0; n < 2; ++n) _Pragma("unroll") for (int k = 0; k < 2; ++k) \
    dst[n][k] = *(const LAS bf16x8*)(G_SB(b, h) + lds_byte(wc * 32 + n * 16 + fr, k * 32 + fq * 8))
#define G_MMA(ai, bj, At, Bx) do { __builtin_amdgcn_s_setprio(1); \
    _Pragma("unroll") for (int m = 0; m < 4; ++m) _Pragma("unroll") for (int n = 0; n < 2; ++n) _Pragma("unroll") for (int k = 0; k < 2; ++k) \
      acc[ai][bj][m][n] = __builtin_amdgcn_mfma_f32_16x16x32_bf16(At[m][k], Bx[n][k], acc[ai][bj][m][n], 0, 0, 0); \
    __builtin_amdgcn_s_setprio(0); } while (0)
#define WAIT_V(n) asm volatile("s_waitcnt vmcnt(" #n ")" ::: "memory")
#define WAIT_L(n) asm volatile("s_waitcnt lgkmcnt(" #n ")" ::: "memory")
#define BAR __builtin_amdgcn_s_barrier()
#define SCHED __builtin_amdgcn_sched_barrier(0)

DI void gemm256_core(const u16* __restrict__ A, const u16* __restrict__ Bt, int brow, int bcol, lchar* shm, int tid, f32x4 (&acc)[2][2][4][2]) {
  const int wid = tid >> 6, lane = tid & 63, wr = wid >> 2, wc = wid & 3, fr = lane & 15, fq = lane >> 4;
  int r0, c0, r1, c1;
  stage_rc(tid * 16, r0, c0); stage_rc(tid * 16 + 8192, r1, c1);
  const unsigned goff0 = (unsigned)(r0 * GK + c0) * 2u, goff1 = (unsigned)(r1 * GK + c1) * 2u;
#pragma unroll
  for (int ai = 0; ai < 2; ++ai)
#pragma unroll
    for (int bj = 0; bj < 2; ++bj)
#pragma unroll
      for (int m = 0; m < 4; ++m)
#pragma unroll
        for (int n = 0; n < 2; ++n) acc[ai][bj][m][n] = (f32x4){0.f, 0.f, 0.f, 0.f};
  bf16x8 At[4][2], B0[2][2], B1[2][2];
  const int nt = GK / 64;
  WAIT_V(0);
  __syncthreads();
  G_STAGE(G_SB(0, 0), Bt, bcol, 0); G_STAGE(G_SA(0, 0), A, brow, 0);
  G_STAGE(G_SB(0, 1), Bt, bcol + 128, 0); G_STAGE(G_SA(0, 1), A, brow + 128, 0);
  if (wr == 1) BAR;
  WAIT_V(4); BAR;
  G_STAGE(G_SB(1, 0), Bt, bcol, 1); G_STAGE(G_SA(1, 0), A, brow, 1); G_STAGE(G_SB(1, 1), Bt, bcol + 128, 1);
  WAIT_V(6); BAR;
  for (int t = 0; t < nt - 2; t += 2) {
    G_LDB(B0, 0, 0); SCHED; G_LDA(At, 0, 0); G_STAGE(G_SA(1, 1), A, brow + 128, t + 1);
    WAIT_L(8); BAR; WAIT_L(0); G_MMA(0, 0, At, B0); BAR; SCHED;
    G_LDB(B1, 0, 1); G_STAGE(G_SB(0, 0), Bt, bcol, t + 2);
    BAR; WAIT_L(0); G_MMA(0, 1, At, B1); BAR;
    G_LDA(At, 0, 1); G_STAGE(G_SA(0, 0), A, brow, t + 2);
    BAR; WAIT_L(0); G_MMA(1, 0, At, B0); BAR; SCHED;
    G_STAGE(G_SB(0, 1), Bt, bcol + 128, t + 2);
    WAIT_V(6); BAR; G_MMA(1, 1, At, B1); BAR;
    G_LDB(B0, 1, 0); SCHED; G_LDA(At, 1, 0); G_STAGE(G_SA(0, 1), A, brow + 128, t + 2);
    WAIT_L(8); BAR; WAIT_L(0); G_MMA(0, 0, At, B0); BAR; SCHED;
    G_LDB(B1, 1, 1); G_STAGE(G_SB(1, 0), Bt, bcol, t + 3);
    BAR; WAIT_L(0); G_MMA(0, 1, At, B1); BAR;
    G_LDA(At, 1, 1); G_STAGE(G_SA(1, 0), A, brow, t + 3);
    BAR; WAIT_L(0); G_MMA(1, 0, At, B0); BAR; SCHED;
    G_STAGE(G_SB(1, 1), Bt, bcol + 128, t + 3);
    WAIT_V(6); BAR; G_MMA(1, 1, At, B1); BAR;
  }
  { G_LDB(B0, 0, 0); G_LDA(At, 0, 0); G_STAGE(G_SA(1, 1), A, brow + 128, nt - 1);
    BAR; WAIT_L(0); G_MMA(0, 0, At, B0); BAR;
    G_LDB(B1, 0, 1); BAR; WAIT_L(0); G_MMA(0, 1, At, B1); BAR;
    G_LDA(At, 0, 1); WAIT_V(4); BAR; WAIT_L(0); G_MMA(1, 0, At, B0); G_MMA(1, 1, At, B1); BAR; }
  { G_LDB(B0, 1, 0); G_LDA(At, 1, 0); WAIT_V(2); BAR; WAIT_L(0); G_MMA(0, 0, At, B0); BAR;
    G_LDB(B1, 1, 1); WAIT_V(0); BAR; WAIT_L(0); G_MMA(0, 1, At, B1); BAR;
    G_LDA(At, 1, 1); BAR; WAIT_L(0); G_MMA(1, 0, At, B0); G_MMA(1, 1, At, B1); BAR; }
  if (wr == 0) BAR;
}

DI void gemm256_tile(const Params& p, int mode, int layer, const u16* R, const u16* Cc, int brow, int bcol, lchar* shm, int tid_in) {
  f32x4 acc[2][2][4][2];
  gemm256_core(R, Cc, brow, bcol, shm, tid_in, acc);
  int tid = tid_in;
  asm volatile("" : "+v"(tid));
  const int wid = tid >> 6, lane = tid & 63, wr = wid >> 2, wc = wid & 3, fr = lane & 15, fq = lane >> 4;
  if (mode == EPI_PROJ) {
#pragma unroll
    for (int ai = 0; ai < 2; ++ai)
#pragma unroll
      for (int bj = 0; bj < 2; ++bj)
#pragma unroll
        for (int m = 0; m < 4; ++m)
#pragma unroll
          for (int n = 0; n < 2; ++n) {
            const int nc = brow + ai * 128 + wr * 64 + m * 16 + fq * 4, tok = bcol + bj * 128 + wc * 32 + n * 16 + fr;
            const f32x4 v = acc[ai][bj][m][n];
            u32x2 o; o[0] = pack2(v[0], v[1]); o[1] = pack2(v[2], v[3]);
            *(u32x2*)(W_PROJ(p) + (size_t)tok * INC + nc) = o;
          }
  } else if (mode == EPI_VT) {
#pragma unroll
    for (int ai = 0; ai < 2; ++ai)
#pragma unroll
      for (int bj = 0; bj < 2; ++bj)
#pragma unroll
        for (int m = 0; m < 4; ++m)
#pragma unroll
          for (int n = 0; n < 2; ++n) {
            const int tok = brow + ai * 128 + wr * 64 + m * 16 + fq * 4, nn = bcol + bj * 128 + wc * 32 + n * 16 + fr - 1024;
            const int b = tok / LSEQ, pos = tok - b * LSEQ;
            const f32x4 v = acc[ai][bj][m][n];
            u32x2 o; o[0] = pack2(v[0], v[1]); o[1] = pack2(v[2], v[3]);
            *(u32x2*)(W_VT(p) + ((size_t)(b * 512 + nn)) * LP + pos) = o;
          }
  } else if (mode == EPI_OUT) {
#pragma unroll
    for (int ai = 0; ai < 2; ++ai)
#pragma unroll
      for (int bj = 0; bj < 2; ++bj) {
        u32x2 hv[4][2];
#pragma unroll
        for (int m = 0; m < 4; ++m)
#pragma unroll
          for (int n = 0; n < 2; ++n) {
            const int nc = brow + ai * 128 + wr * 64 + m * 16 + fq * 4, tok = bcol + bj * 128 + wc * 32 + n * 16 + fr;
            hv[m][n] = *(const u32x2*)(W_H(p) + (size_t)tok * DM + nc);
          }
#pragma unroll
        for (int m = 0; m < 4; ++m)
#pragma unroll
          for (int n = 0; n < 2; ++n) {
            const int nc = brow + ai * 128 + wr * 64 + m * 16 + fq * 4, tok = bcol + bj * 128 + wc * 32 + n * 16 + fr;
            const f32x4 v = acc[ai][bj][m][n];
            u32x2 o;
            o[0] = pack2(ALPHA * bflo(hv[m][n][0]) + v[0], ALPHA * bfhi(hv[m][n][0]) + v[1]);
            o[1] = pack2(ALPHA * bflo(hv[m][n][1]) + v[2], ALPHA * bfhi(hv[m][n][1]) + v[3]);
            *(u32x2*)(W_Y(p) + (size_t)tok * DM + nc) = o;
          }
      }
  } else {
    LAS float* S = (LAS float*)shm;
    const int tok = tid & 255, kh = tid >> 8;
    float L0[16], L1[16];
#pragma unroll
    for (int ai = 0; ai < 2; ++ai) {
      __syncthreads();
#pragma unroll
      for (int bj = 0; bj < 2; ++bj)
#pragma unroll
        for (int m = 0; m < 4; ++m)
#pragma unroll
          for (int n = 0; n < 2; ++n) {
            const int tk = bj * 128 + wc * 32 + n * 16 + fr, key = wr * 64 + m * 16 + fq * 4;
            *(LAS f32x4*)((lchar*)S + tk * 528 + key * 4) = acc[ai][bj][m][n];
          }
      __syncthreads();
      float v[16];
#pragma unroll 1
      for (int ch = 0; ch < 4; ++ch) {
        float wk[16];
#pragma unroll
        for (int q = 0; q < 4; ++q) {
          const int key = kh * 64 + ch * 16 + 4 * q;
          const f32x4 xv = *(const LAS f32x4*)((lchar*)S + tok * 528 + key * 4);
#pragma unroll
          for (int e = 0; e < 4; ++e) wk[4 * q + e] = __uint_as_float((__float_as_uint(xv[e]) & ~127u) | (unsigned)(key + e));
        }
        bitonic_sort16(wk);
        if (ch == 0) {
#pragma unroll
          for (int i = 0; i < 16; ++i) v[i] = wk[i];
        } else {
          merge_top16(v, wk);
        }
      }
      __syncthreads();
      if (kh == 1) {
#pragma unroll
        for (int q = 0; q < 4; ++q) *(LAS f32x4*)((lchar*)S + tok * 80 + 16 * q) = (f32x4){v[4 * q], v[4 * q + 1], v[4 * q + 2], v[4 * q + 3]};
      }
      __syncthreads();
      if (kh == 0) {
        float wk[16];
#pragma unroll
        for (int q = 0; q < 4; ++q) {
          const f32x4 xv = *(const LAS f32x4*)((lchar*)S + tok * 80 + 16 * q);
          wk[4 * q] = xv[0]; wk[4 * q + 1] = xv[1]; wk[4 * q + 2] = xv[2]; wk[4 * q + 3] = xv[3];
        }
        merge_top16(v, wk);
      }
#pragma unroll
      for (int j = 0; j < 16; ++j) { if (ai == 0) L0[j] = v[j]; else L1[j] = v[j]; }
    }
    __syncthreads();
    LAS unsigned* LL = (LAS unsigned*)shm;
    if (kh == 0) {
#pragma unroll
      for (int j = 0; j < 16; ++j) { LL[tok * 32 + ((j + tok) & 31)] = __float_as_uint(L0[j]); LL[tok * 32 + ((16 + j + tok) & 31)] = __float_as_uint(L1[j]); }
      float s1[16], s2[16], v[16];
#pragma unroll
      for (int j = 0; j < 16; ++j) { s1[j] = __uint_as_float(__float_as_uint(L0[j]) & ~127u); s2[j] = __uint_as_float(__float_as_uint(L1[j]) & ~127u); v[j] = -3.0e38f; }
#pragma unroll
      for (int ch = 0; ch < 4; ++ch) {
        float wk[16];
#pragma unroll
        for (int i = 0; i < 16; ++i) {
          constexpr unsigned char PAIRS[64] = {0, 1, 2, 3, 4, 5, 6, 7, 8, 9, 10, 11, 12, 13, 14, 15, 16, 17, 18, 19, 20, 21, 22, 23, 32, 33, 34, 35, 36, 48, 49, 50, 51, 64, 65, 66, 80, 81, 96, 97, 112, 113, 128, 144, 160, 176, 192, 208, 224, 240, 255, 255, 255, 255, 255, 255, 255, 255, 255, 255, 255, 255, 255, 255};
          const int code = PAIRS[ch * 16 + i];
          if (code == 255) { wk[i] = -3.0e38f; }
          else { const float sm = s1[code >> 4] + s2[code & 15]; wk[i] = __uint_as_float((__float_as_uint(sm) & ~255u) | (unsigned)code); }
        }
        if (ch == 0) {
#pragma unroll
          for (int i = 0; i < 16; ++i) v[i] = wk[i];
        } else {
          bitonic_sort16(wk);
          merge_top16(v, wk);
        }
      }
      float e[16], sum = 0.f;
      const float mx = __uint_as_float(__float_as_uint(v[0]) & ~255u);
#pragma unroll
      for (int j = 0; j < 16; ++j) { e[j] = fast_exp2((__uint_as_float(__float_as_uint(v[j]) & ~255u) - mx) * LOG2E); sum += e[j]; }
      const float inv = 1.0f / sum;
      const int hd = brow >> 8;
      u16* di = W_IDX(p) + (size_t)(bcol + tok) * 128 + hd * 16;
      float* dg = W_G(p) + (size_t)(bcol + tok) * 128 + hd * 16;
      unsigned eid[16];
#pragma unroll
      for (int k = 0; k < 16; ++k) {
        const unsigned code = __float_as_uint(v[k]) & 255u;
        const unsigned i1 = LL[tok * 32 + (((code >> 4) + tok) & 31)] & 127u, i2 = LL[tok * 32 + ((16 + (code & 15u) + tok) & 31)] & 127u;
        eid[k] = i1 * 128u + i2;
      }
#pragma unroll
      for (int q = 0; q < 4; ++q) *(f32x4*)(dg + 4 * q) = (f32x4){e[4 * q] * inv, e[4 * q + 1] * inv, e[4 * q + 2] * inv, e[4 * q + 3] * inv};
#pragma unroll
      for (int q = 0; q < 2; ++q)
        *(u32x4*)(di + 8 * q) = (u32x4){eid[8 * q] | (eid[8 * q + 1] << 16), eid[8 * q + 2] | (eid[8 * q + 3] << 16), eid[8 * q + 4] | (eid[8 * q + 5] << 16), eid[8 * q + 6] | (eid[8 * q + 7] << 16)};
    }
    __syncthreads();
  }
}

#define ATT_MISC 131072
DI void attn_item(const Params& p, int layer, int b, int hh, int jq, lchar* sm, float lam, float oml, int tid) {
  const int lane = tid & 63, w = tid >> 6, g = lane >> 4, l15 = lane & 15;
  const int idx32 = (lane ^ 32) << 2;
  LAS float* tab = (LAS float*)(sm + ATT_MISC);
  LAS float* sg = tab + 208;
  __syncthreads();
  if (tid < 208) {
    const int d = tid - 80;
    float tv = -1.0e30f;
    if (d >= 0) {
      int bucket = d;
      if (d >= 16) {
        int lg = 16 + (int)(logf((float)d * (1.0f / 16.0f)) / 2.0794415416798357f * 16.0f);
        bucket = lg < 31 ? lg : 31;
      }
      tv = P_REL_BIAS(p)[bucket * 4 + hh] * LOG2E;
    }
    tab[tid] = tv;
    if (tid < 128) sg[tid] = P_SUBLN_G(p)[layer * 128 + tid] * oml;
  }
  const int q0w = 128 * jq + 16 * w;
  const int qpos = q0w + l15;
  const int qrow = b * LSEQ + (qpos < LSEQ ? qpos : LSEQ - 1);
  bf16x8 qf[2][2];
  {
    const u16* qp = W_PROJ(p) + (size_t)qrow * INC + hh * 128 + g * 8;
#pragma unroll
    for (int m = 0; m < 2; ++m)
#pragma unroll
      for (int ks = 0; ks < 2; ++ks) {
        const u32x4 raw = *(const u32x4*)(qp + m * 64 + ks * 32);
        u32x4 sc;
#pragma unroll
        for (int e = 0; e < 4; ++e) sc[e] = pack2(bflo(raw[e]) * (0.125f * LOG2E), bfhi(raw[e]) * (0.125f * LOG2E));
        qf[m][ks] = __builtin_bit_cast(bf16x8, sc);
      }
  }
  const int nkt = (2 * jq + 2) < 33 ? (2 * jq + 2) : 33;
  const char* ksrc[2]; const char* vsrc[2];
#pragma unroll
  for (int i = 0; i < 2; ++i) {
    const int bk = 2 * w + i, k16 = bk >> 2, m = (bk >> 1) & 1, ks = bk & 1;
    const int krow = 32 * (k16 >> 1) + 8 * (l15 >> 2) + 4 * (k16 & 1) + (l15 & 3);
    ksrc[i] = (const char*)(W_PROJ(p) + (size_t)(b * LSEQ + krow) * INC + 512 + hh * 128 + m * 64 + ks * 32 + g * 8);
    const int dv = 8 * bk + (lane >> 3), c = (lane & 7) ^ ((dv >> 1) & 7);
    vsrc[i] = (const char*)(W_VT(p) + ((size_t)((b * 4 + hh) * 128 + dv)) * LP + c * 8);
  }
  lchar* dmak = sm + (2 * w) * 1024 + lane * 16;
#define ATT_ISSUE(KT, SLOT) do { const size_t _ko = (size_t)(KT) * (64 * INC * 2), _vo = (size_t)(KT) * 128; lchar* _d = dmak + (SLOT) * 32768; \
    __builtin_amdgcn_global_load_lds((const unsigned*)(ksrc[0] + _ko), (LAS unsigned*)(_d), 16, 0, 0); \
    __builtin_amdgcn_global_load_lds((const unsigned*)(ksrc[1] + _ko), (LAS unsigned*)(_d + 1024), 16, 0, 0); \
    __builtin_amdgcn_global_load_lds((const unsigned*)(vsrc[0] + _vo), (LAS unsigned*)(_d + 16384), 16, 0, 0); \
    __builtin_amdgcn_global_load_lds((const unsigned*)(vsrc[1] + _vo), (LAS unsigned*)(_d + 16384 + 1024), 16, 0, 0); } while (0)
  int voff[2];
#pragma unroll
  for (int kk = 0; kk < 2; ++kk) voff[kk] = l15 * 128 + (((4 * kk + g) ^ ((l15 >> 1) & 7)) * 16);

  f32x4 O[2][8];
#pragma unroll
  for (int m = 0; m < 2; ++m)
#pragma unroll
    for (int dt = 0; dt < 8; ++dt) O[m][dt] = (f32x4){0.f, 0.f, 0.f, 0.f};
  float mrun[2] = {0.f, 0.f};
  f32x4 Osum[2] = {(f32x4){0.f, 0.f, 0.f, 0.f}, (f32x4){0.f, 0.f, 0.f, 0.f}};
  bf16x8 ones;
  { const short o1 = (l15 == 0) ? (short)0x3f80 : (short)0; ones = (bf16x8){o1, o1, o1, o1, o1, o1, o1, o1}; }

  WAIT_V(0);
  __syncthreads();
  const float tfar = tab[207];
  ATT_ISSUE(0, 0);
  ATT_ISSUE((1 < nkt ? 1 : nkt - 1), 1);
  for (int kt = 0; kt < nkt; ++kt) {
    { const int kn = (kt + 2 < nkt) ? kt + 2 : nkt - 1; ATT_ISSUE(kn, (kt + 2) & 3); }
    WAIT_V(8); BAR;
    if (64 * kt <= q0w + 15) {
      const lchar* kb = sm + (kt & 3) * 32768;
      const lchar* vb = kb + 16384;
      const bool near = (q0w - 64 * kt) < 176;
      const float tadd = near ? 0.f : tfar;
      const float sinit[2] = {tadd - mrun[0], tadd - mrun[1]};
      f32x4 S[2][4];
#pragma unroll
      for (int kh = 0; kh < 2; ++kh) {
        bf16x8 kf[2][2][2];
#pragma unroll
        for (int q = 0; q < 2; ++q)
#pragma unroll
          for (int m = 0; m < 2; ++m)
#pragma unroll
            for (int ks = 0; ks < 2; ++ks) kf[q][m][ks] = *(const LAS bf16x8*)(kb + ((((2 * kh + q) * 2 + m) * 2 + ks) * 1024) + lane * 16);
        SCHED;
#pragma unroll
        for (int q = 0; q < 2; ++q)
#pragma unroll
          for (int m = 0; m < 2; ++m) {
            f32x4 sacc = (f32x4){sinit[m], sinit[m], sinit[m], sinit[m]};
            sacc = mfma16(kf[q][m][0], qf[m][0], sacc);
            sacc = mfma16(kf[q][m][1], qf[m][1], sacc);
            S[m][2 * kh + q] = sacc;
          }
      }
      if (near) {
#pragma unroll
        for (int m = 0; m < 2; ++m)
#pragma unroll
          for (int k16 = 0; k16 < 4; ++k16)
#pragma unroll
            for (int r = 0; r < 4; ++r) {
              const int di = qpos + 80 - (64 * kt + 32 * (k16 >> 1) + 8 * g + 4 * (k16 & 1) + r);
              S[m][k16][r] += tab[di < 207 ? di : 207];
            }
      }
      bf16x8 pb[2][2];
#pragma unroll
      for (int m = 0; m < 2; ++m) {
        float mx = fmaxf(fmaxf(S[m][0][0], S[m][0][1]), fmaxf(S[m][0][2], S[m][0][3]));
#pragma unroll
        for (int k16 = 1; k16 < 4; ++k16) mx = fmaxf(fmaxf(mx, fmaxf(S[m][k16][0], S[m][k16][1])), fmaxf(S[m][k16][2], S[m][k16][3]));
        mx = fmaxf(mx, shx16(mx));
        mx = fmaxf(mx, shx32(mx, idx32));
        if (kt == 0 || __builtin_amdgcn_ballot_w64(mx > 8.0f) != 0ull) {
          const float dlt = kt == 0 ? mx : fmaxf(mx, 0.f);
          const float alpha = fast_exp2(-dlt);
          mrun[m] += dlt;
#pragma unroll
          for (int dt = 0; dt < 8; ++dt) { O[m][dt][0] *= alpha; O[m][dt][1] *= alpha; O[m][dt][2] *= alpha; O[m][dt][3] *= alpha; }
          Osum[m][0] *= alpha; Osum[m][1] *= alpha; Osum[m][2] *= alpha; Osum[m][3] *= alpha;
#pragma unroll
          for (int k16 = 0; k16 < 4; ++k16)
#pragma unroll
            for (int r = 0; r < 4; ++r) S[m][k16][r] -= dlt;
        }
#pragma unroll
        for (int k16 = 0; k16 < 4; ++k16)
#pragma unroll
          for (int r = 0; r < 4; ++r) S[m][k16][r] = fast_exp2(S[m][k16][r]);
#pragma unroll
        for (int kk = 0; kk < 2; ++kk) {
          u32x4 t;
          t[0] = pack2(S[m][2 * kk][0], S[m][2 * kk][1]); t[1] = pack2(S[m][2 * kk][2], S[m][2 * kk][3]);
          t[2] = pack2(S[m][2 * kk + 1][0], S[m][2 * kk + 1][1]); t[3] = pack2(S[m][2 * kk + 1][2], S[m][2 * kk + 1][3]);
          pb[m][kk] = __builtin_bit_cast(bf16x8, t);
          Osum[m] = mfma16(ones, pb[m][kk], Osum[m]);
        }
      }
#pragma unroll
      for (int kk = 0; kk < 2; ++kk) {
        bf16x8 vf[8];
#pragma unroll
        for (int dt = 0; dt < 8; ++dt) vf[dt] = *(const LAS bf16x8*)(vb + dt * 2048 + voff[kk]);
        SCHED;
#pragma unroll
        for (int dt = 0; dt < 8; ++dt) {
          O[0][dt] = mfma16(vf[dt], pb[0][kk], O[0][dt]);
          O[1][dt] = mfma16(vf[dt], pb[1][kk], O[1][dt]);
        }
      }
    }
  }
  WAIT_V(0);
#undef ATT_ISSUE
  float l0 = g == 0 ? Osum[0][0] : 0.f, l1 = g == 0 ? Osum[1][0] : 0.f;
  l0 += shx16(l0); l0 += shx32(l0, idx32);
  l1 += shx16(l1); l1 += shx32(l1, idx32);
  const float c1 = 1.0f / l0, c2 = lam / l1;
  float ss = 0.f;
#pragma unroll
  for (int dt = 0; dt < 8; ++dt)
#pragma unroll
    for (int r = 0; r < 4; ++r) { const float o = O[0][dt][r] * c1 - O[1][dt][r] * c2; O[0][dt][r] = o; ss += o * o; }
  ss += shx16(ss); ss += shx32(ss, idx32);
  const float rinv = rsqrtf(ss * (1.0f / 128.0f) + 1e-5f);
  if (qpos < LSEQ) {
    u16* dst = W_MIX(p) + (size_t)(b * LSEQ + qpos) * DM + hh * 128 + 4 * g;
#pragma unroll
    for (int dt = 0; dt < 8; ++dt) {
      const int dv0 = 16 * dt + 4 * g;
      u32x2 o;
      o[0] = pack2(O[0][dt][0] * rinv * sg[dv0 + 0], O[0][dt][1] * rinv * sg[dv0 + 1]);
      o[1] = pack2(O[0][dt][2] * rinv * sg[dv0 + 2], O[0][dt][3] * rinv * sg[dv0 + 3]);
      *(u32x2*)(dst + 16 * dt) = o;
    }
  }
}

DI void conv_item(const Params& p, int layer, int item, int tid) {
  const int ch = (tid & 63) * 8, t0 = item * 16 + 4 * (tid >> 6);
  const int pos0 = t0 % LSEQ;
  const bool head = pos0 == 0;
  const u16* row0 = W_PROJ(p) + (size_t)t0 * INC;
  u32x4 gc[6], zz[6], gb[4];
#pragma unroll
  for (int j = 0; j < 6; ++j) {
    const u16* r2 = row0 + (ptrdiff_t)((head && j < 2) ? 0 : (j - 2)) * INC;
    gc[j] = *(const u32x4*)(r2 + 2048 + ch); zz[j] = *(const u32x4*)(r2 + 2560 + ch);
  }
#pragma unroll
  for (int i = 0; i < 4; ++i) gb[i] = *(const u32x4*)(row0 + (size_t)i * INC + 1536 + ch);
  const float* cw = P_CONV_W(p) + (size_t)layer * 3 * 512 + ch;
  float w0[8], w1[8], w2[8];
#pragma unroll
  for (int e = 0; e < 8; ++e) { w0[e] = cw[e]; w1[e] = cw[512 + e]; w2[e] = cw[1024 + e]; }
  float pr[6][8];
#pragma unroll
  for (int j = 0; j < 6; ++j) {
    const float keep = (head && j < 2) ? 0.f : 1.f;
#pragma unroll
    for (int e = 0; e < 4; ++e) { pr[j][2 * e] = keep * bflo(gc[j][e]) * bflo(zz[j][e]); pr[j][2 * e + 1] = keep * bfhi(gc[j][e]) * bfhi(zz[j][e]); }
  }
#pragma unroll
  for (int i = 0; i < 4; ++i) {
    u32x4 o;
#pragma unroll
    for (int e = 0; e < 4; ++e) {
      const float a0 = w0[2 * e] * pr[i][2 * e] + w1[2 * e] * pr[i + 1][2 * e] + w2[2 * e] * pr[i + 2][2 * e];
      const float a1 = w0[2 * e + 1] * pr[i][2 * e + 1] + w1[2 * e + 1] * pr[i + 1][2 * e + 1] + w2[2 * e + 1] * pr[i + 2][2 * e + 1];
      o[e] = pack2(bflo(gb[i][e]) * a0, bfhi(gb[i][e]) * a1);
    }
    *(u32x4*)(W_MIX(p) + (size_t)(t0 + i) * DM + 512 + ch) = o;
  }
}

DI void phase_prologue(const Params& p, char* smem, int wave) {
  const int tid = otid_w(wave), lane = tid & 63, wid = tid >> 6, hb = tid >> 8, htid = tid & 255;
  const int nblk = gridDim.x, bid = blockIdx.x;
  const size_t gtid = (size_t)bid * NTHREADS + tid, gthreads = (size_t)nblk * NTHREADS;
  float* sm = (float*)(smem + hb * LDS_HALF);
  for (int it0 = bid; it0 < 2048; it0 += nblk) {
    const int it = it0 * 2 + hb;
    if (it < 3072) {
      const int l = it / 768, r = it % 768, kb = r / 48, nb = r % 48;
      transpose_tile(P_W_IN(p) + (size_t)l * 1024 * 3072, 3072, W_WIN(p) + (size_t)l * 3072 * 1024, 1024, kb * 64, nb * 64, sm, htid);
    } else {
      const int i2 = it - 3072, l = i2 / 256, r = i2 % 256, kb = r / 16, nb = r % 16;
      transpose_tile(P_W_OUT(p) + (size_t)l * 1024 * 1024, 1024, W_WOUT(p) + (size_t)l * 1024 * 1024, 1024, kb * 64, nb * 64, sm, htid);
    }
  }
  convert_straight(P_W_Q(p), W_WQB(p), (size_t)4 * 1024 * 2048 / 8, gtid, gthreads);
  convert_straight(P_SUB_KEYS(p), W_SKB(p), (size_t)4 * 16 * 128 * 128 / 8, gtid, gthreads);
  for (int t = bid * 8 + wid; t < TTOK; t += nblk * 8) {
    const int b = t / LSEQ, pos = t - b * LSEQ;
    const float* src = pos < NMETA ? P_META(p) + (size_t)pos * DM : P_X(p) + ((size_t)b * SEQ + pos - NMETA) * DM;
    float v[16];
    load_row_f32<0>(src, v, lane);
    ln_row<0>(v, P_LN_IN_G(p), P_LN_IN_B(p), lane);
    store_row_bf16<0>(W_H(p) + (size_t)t * DM, v, lane);
  }
}

DI void phase_fold(const Params& p, char* smem, int wave) {
  const int tid = otid_w(wave), hb = tid >> 8, htid = tid & 255;
  for (int it0 = blockIdx.x; it0 < 256; it0 += gridDim.x) {
    const int it = it0 * 2 + hb;
    const int l = it >> 7, hp = (it >> 3) & 15, mt = it & 7;
    gemm_tile_fold(W_WQB(p) + (size_t)l * 1024 * 2048 + hp * 128, 2048, W_SKB(p) + ((size_t)l * 16 + hp) * 128 * 128, 128, 128, mt * 128, smem + hb * 65536,
                   W_WSC(p) + (size_t)l * 2048 * 1024 + (size_t)hp * 128 * 1024, htid);
  }
}

DI bool tile_order(int i, int nM, int nN, int& pm, int& pn) {
  const int nwg = nM * nN;
  const long L = (long)i * gridDim.x + blockIdx.x;
  if (L >= nwg) return false;
  int wgid = (int)L;
  { const int q = nwg / 8, r = nwg % 8, xcd = wgid % 8, off = wgid / 8; wgid = (xcd < r ? xcd * (q + 1) : r * (q + 1) + (xcd - r) * q) + off; }
  const int nig = 8 * nN, gid = wgid / nig, fm = gid * 8, gsz = (nM - fm) < 8 ? (nM - fm) : 8;
  pm = fm + ((wgid % nig) % gsz); pn = (wgid % nig) / gsz;
  return true;
}

DI void convert_tables(const Params& p, int layer, int lane, int slot, int nslots) {
  for (int r = slot; r < 2 * PEER_N; r += nslots) {

    const bool isv = r >= PEER_N;
    const int e = isv ? r - PEER_N : r;
    const float* src = (isv ? P_PEER_V(p) : P_PEER_U(p)) + ((size_t)layer * PEER_N + e) * DM + 16 * lane;
    f32x4 a[4];
#pragma unroll
    for (int k = 0; k < 4; ++k) a[k] = *(const f32x4*)(src + 4 * k);
    float am = 0.f;
#pragma unroll
    for (int k = 0; k < 4; ++k) am = fmaxf(am, fmaxf(fmaxf(fabsf(a[k][0]), fabsf(a[k][1])), fmaxf(fabsf(a[k][2]), fabsf(a[k][3]))));
    am = wave_max_nonneg(am);
    const float top = isv ? 224.0f : 127.0f;
    const float sc = am > 0.f ? top / am : 1.0f;
    if (lane == 0) (isv ? W_SV(p) : W_SU(p))[e] = am > 0.f ? am / top : 1.0f;
    u32x4 o;
#pragma unroll
    for (int k = 0; k < 4; ++k) {
      if (isv) {
        int w = 0;
        w = __builtin_amdgcn_cvt_pk_fp8_f32(a[k][0] * sc, a[k][1] * sc, w, false);
        w = __builtin_amdgcn_cvt_pk_fp8_f32(a[k][2] * sc, a[k][3] * sc, w, true);
        o[k] = (unsigned)w;
      } else {
        const int q0 = __float2int_rn(a[k][0] * sc), q1 = __float2int_rn(a[k][1] * sc), q2 = __float2int_rn(a[k][2] * sc), q3 = __float2int_rn(a[k][3] * sc);
        o[k] = ((unsigned)q0 & 255u) | (((unsigned)q1 & 255u) << 8) | (((unsigned)q2 & 255u) << 16) | ((unsigned)q3 << 24);
      }
    }
    *(u32x4*)((isv ? W_VB(p) : W_UB(p)) + (size_t)(lane >> 3) * (PEER_N * 128) + (size_t)e * 128 + 16 * (lane & 7)) = o;
  }
}

DI void phase_gemm(const Params& p, int layer, int which, char* smem, int wave) {
  const int tid0 = otid_w(wave);
  const u16* W = which == 0 ? W_WIN(p) + (size_t)layer * 3072 * 1024 : (which == 1 ? W_WOUT(p) + (size_t)layer * 1024 * 1024 : W_WSC(p) + (size_t)layer * 2048 * 1024);
  const u16* X = which == 1 ? W_MIX(p) : W_H(p);
  const int nN = which == 0 ? 12 : (which == 1 ? 4 : 8);
  int pm, pn;
  for (int i = 0; tile_order(i, 258, nN, pm, pn); ++i) {
    const bool vt = (which == 0) && (pn == 4 || pn == 5);
    const int mode = which == 0 ? (vt ? EPI_VT : EPI_PROJ) : (which == 1 ? EPI_OUT : EPI_TOPK);
    int tid = tid0;
    asm volatile("" : "+v"(tid));
    gemm256_tile(p, mode, layer, vt ? X : W, vt ? W : X, vt ? pm * 256 : pn * 256, vt ? pn * 256 : pm * 256, (lchar*)smem, tid);
  }
  if (which == 1) {
    const int rem = (258 * 4) % (int)gridDim.x, nidle = (int)gridDim.x - rem;
    if ((int)blockIdx.x >= rem) convert_tables(p, layer, tid0 & 63, ((int)blockIdx.x - rem) * 8 + (tid0 >> 6), nidle * 8);
  }
}

DI void phase_attn(const Params& p, int layer, char* smem, int wave) {
  const int tid = otid_w(wave), lane = tid & 63, hb = tid >> 8, htid = tid & 255;
  const float lam_init = 0.8f - 0.6f * expf(-0.3f * (float)layer);
  float d1 = P_LQ1(p)[layer * 64 + lane] * P_LK1(p)[layer * 64 + lane], d2 = P_LQ2(p)[layer * 64 + lane] * P_LK2(p)[layer * 64 + lane];
  d1 = wave_sum(d1); d2 = wave_sum(d2);
  const float lam = expf(d1) - expf(d2) + lam_init;
  for (int rd = 0; rd * (int)gridDim.x < 2176; ++rd) {
    const int o = rd * gridDim.x + ((rd & 1) ? (int)gridDim.x - 1 - (int)blockIdx.x : (int)blockIdx.x);
    if (o < 2176) { const int jq = 16 - (o >> 7), bh = o & 127; attn_item(p, layer, bh >> 2, bh & 3, jq, (lchar*)smem, lam, 1.0f - lam_init, tid); }
  }
  for (int it = blockIdx.x; it < 2064; it += gridDim.x) conv_item(p, layer, it * 2 + hb, htid);
}

DI void phase_ln(const Params& p, int layer, int which, int wave) {
  const int tid = otid_w(wave), lane = tid & 63, wid = tid >> 6;
  const int nblk = gridDim.x, bid = blockIdx.x;
  const float* lg = (which ? P_LN2_G(p) : P_LN1_G(p)) + layer * DM;
  const float* lb = (which ? P_LN2_B(p) : P_LN1_B(p)) + layer * DM;
  const bool final_out = which && (layer == DEPTH - 1);
  for (int t = bid * 8 + wid; t < TTOK; t += nblk * 8) {
    float v[16];
    load_row_bf16<0>(W_Y(p) + (size_t)t * DM, v, lane);
    ln_row<0>(v, lg, lb, lane);
    if (final_out) {
      const int b = t / LSEQ, pos = t - b * LSEQ;
      if (pos >= NMETA) {
        float* dst = p.out + ((size_t)b * SEQ + pos - NMETA) * DM;
#pragma unroll
        for (int hh = 0; hh < 2; ++hh) {
          *(f32x4*)(dst + hh * 512 + 8 * lane) = (f32x4){v[hh * 8], v[hh * 8 + 1], v[hh * 8 + 2], v[hh * 8 + 3]};
          *(f32x4*)(dst + hh * 512 + 8 * lane + 4) = (f32x4){v[hh * 8 + 4], v[hh * 8 + 5], v[hh * 8 + 6], v[hh * 8 + 7]};
        }
      }
    } else {
      store_row_bf16<0>(W_H(p) + (size_t)t * DM, v, lane);
    }
  }
}

#define DPP_F(v, ctrl) __int_as_float(__builtin_amdgcn_update_dpp(0, __float_as_int(v), (ctrl), 0xf, 0xf, true))
#define PEER_META(T, IA, IB, HA, HB) do { const int _t = (T) < TTOK ? (T) : wslot; \
    IA = *(const u32x4*)(W_IDX(p) + (size_t)_t * 128 + r * 16); IB = *(const u32x4*)(W_IDX(p) + (size_t)_t * 128 + r * 16 + 8); \
    const u16* _hp = W_H(p) + (size_t)_t * DM + x * 128 + 16 * c; HA = *(const u32x4*)(_hp); HB = *(const u32x4*)(_hp + 8); } while (0)
#define PEER_GATHER(TAB, IA, IB, RR) do { _Pragma("unroll") for (int g = 0; g < 16; ++g) { \
    const unsigned _w = (g < 8 ? IA : IB)[(g >> 1) & 3]; const unsigned _e = (g & 1) ? (_w >> 16) : (_w & 0xffffu); RR[g] = *(const u32x4*)((TAB) + (_e * 128u + c16)); } } while (0)
#define PEER_UNPACK(XS, HA, HB) do { _Pragma("unroll") for (int e = 0; e < 4; ++e) { \
    XS[e] = (f32x2){bflo(HA[e]), bfhi(HA[e])}; XS[4 + e] = (f32x2){bflo(HB[e]), bfhi(HB[e])}; } } while (0)

#define DPP_I(v, ctrl) __builtin_amdgcn_update_dpp(0, (v), (ctrl), 0xf, 0xf, true)
DI int reduce_scatter8(int d0, int d1, int d2, int d3, int d4, int d5, int d6, int d7, int c) {
  const bool b2 = c >= 4, b1 = (c & 2) != 0, b0 = (c & 1) != 0;
  const int e0 = (b2 ? d4 : d0) + DPP_I(b2 ? d0 : d4, 0x141);
  const int e1 = (b2 ? d5 : d1) + DPP_I(b2 ? d1 : d5, 0x141);
  const int e2 = (b2 ? d6 : d2) + DPP_I(b2 ? d2 : d6, 0x141);
  const int e3 = (b2 ? d7 : d3) + DPP_I(b2 ? d3 : d7, 0x141);
  const int f0 = (b1 ? e2 : e0) + DPP_I(b1 ? e0 : e2, 0x4E);
  const int f1 = (b1 ? e3 : e1) + DPP_I(b1 ? e1 : e3, 0x4E);
  return (b0 ? f1 : f0) + DPP_I(b0 ? f0 : f1, 0xB1);
}
DI void phase_peer_dots(const Params& p, int layer, int wave) {
  const int tid = otid_w(wave), lane = tid & 63, wid = tid >> 6, c = lane & 7, r = lane >> 3;
  const int x = blockIdx.x & 7, wslot = (blockIdx.x >> 3) * 8 + wid, nslot = (gridDim.x >> 3) * 8;
  const unsigned char* ub = W_UB(p) + (size_t)x * (PEER_N * 128);
  const unsigned c16 = (unsigned)c * 16u;
  u16* pd = W_Y(p);
  u32x4 iAa, iBa, iAb, iBb;
  u32x4 hAa, hBa, hAb, hBb, rrA[16], rrB[16];
  int xq[4];
  float xscale;
#define DOTS_QUANT(HA, HB) do { float _xv[16]; \
    _Pragma("unroll") for (int e = 0; e < 4; ++e) { _xv[2 * e] = bflo(HA[e]); _xv[2 * e + 1] = bfhi(HA[e]); _xv[8 + 2 * e] = bflo(HB[e]); _xv[8 + 2 * e + 1] = bfhi(HB[e]); } \
    float _am = 0.f; _Pragma("unroll") for (int e = 0; e < 16; ++e) _am = fmaxf(_am, fabsf(_xv[e])); \
    _am = DPP_MAX(_am, 0xB1); _am = DPP_MAX(_am, 0x4E); _am = DPP_MAX(_am, 0x141); \
    const float _qs = _am > 0.f ? 127.0f / _am : 0.f; xscale = _am * (1.0f / 127.0f); \
    _Pragma("unroll") for (int k = 0; k < 4; ++k) { \
      const int q0 = __float2int_rn(_xv[4 * k] * _qs), q1 = __float2int_rn(_xv[4 * k + 1] * _qs), q2 = __float2int_rn(_xv[4 * k + 2] * _qs), q3 = __float2int_rn(_xv[4 * k + 3] * _qs); \
      xq[k] = (int)(((unsigned)q0 & 255u) | (((unsigned)q1 & 255u) << 8) | (((unsigned)q2 & 255u) << 16) | ((unsigned)q3 << 24)); } } while (0)
#define DOTS_COMPUTE(T, RR) do { if ((T) < TTOK) { int dd[16]; \
    _Pragma("unroll") for (int g = 0; g < 16; ++g) { int d = 0; \
      _Pragma("unroll") for (int k = 0; k < 4; ++k) d = __builtin_amdgcn_sdot4((int)RR[g][k], xq[k], d, false); \
      dd[g] = d; } \
    const int pA = reduce_scatter8(dd[0], dd[1], dd[2], dd[3], dd[4], dd[5], dd[6], dd[7], c); \
    const int pB = reduce_scatter8(dd[8], dd[9], dd[10], dd[11], dd[12], dd[13], dd[14], dd[15], c); \
    u16* _dst = pd + ((size_t)(T) * 8 + x) * 128 + r * 16 + c;        \
    _dst[0] = (u16)(pack2((float)pA * xscale, 0.f) & 0xffffu); _dst[8] = (u16)(pack2((float)pB * xscale, 0.f) & 0xffffu); } } while (0)
  int t = wslot;
  PEER_META(t, iAa, iBa, hAa, hBa);
  PEER_META(t + nslot, iAb, iBb, hAb, hBb);
  PEER_GATHER(ub, iAa, iBa, rrA);
  for (; t < TTOK; t += 2 * nslot) {
    DOTS_QUANT(hAa, hBa);
    PEER_META(t + 2 * nslot, iAa, iBa, hAa, hBa);
    PEER_GATHER(ub, iAb, iBb, rrB);
    DOTS_COMPUTE(t, rrA);
    DOTS_QUANT(hAb, hBb);
    PEER_META(t + 3 * nslot, iAb, iBb, hAb, hBb);
    PEER_GATHER(ub, iAa, iBa, rrA);
    DOTS_COMPUTE(t + nslot, rrB);
  }
#undef DOTS_COMPUTE
#undef DOTS_QUANT
}

DI void phase_peer_w(const Params& p, int layer, int wave) {
  const int tid = otid_w(wave), lane = tid & 63, wid = tid >> 6;
  const u16* pd = W_Y(p);
  for (int t = blockIdx.x * 8 + wid; t < TTOK; t += gridDim.x * 8) {
#pragma unroll
    for (int hf = 0; hf < 2; ++hf) {
      const int j = hf * 64 + lane;
      float sacc = 0.f;
#pragma unroll
      for (int xx = 0; xx < 8; ++xx) sacc += __uint_as_float(((unsigned)pd[((size_t)t * 8 + xx) * 128 + j]) << 16);
      const int e = W_IDX(p)[(size_t)t * 128 + j];
      const float act = sacc * W_SU(p)[e];
      const float wv = W_G(p)[(size_t)t * 128 + j] * (0.5f * act * (1.0f + erff(act * 0.7071067811865476f))) * W_SV(p)[e];
      W_W16(p)[(size_t)t * 128 + j] = (u16)(pack2(wv, 0.f) & 0xffffu);
    }
  }
}

#define PEER_META_V(T, IA, IB, WA, WB, HR) do { const int _t = (T) < TTOK ? (T) : wslot; \
    IA = *(const u32x4*)(W_IDX(p) + (size_t)_t * 128 + r * 16); IB = *(const u32x4*)(W_IDX(p) + (size_t)_t * 128 + r * 16 + 8); \
    WA = *(const u32x4*)(W_W16(p) + (size_t)_t * 128 + r * 16); WB = *(const u32x4*)(W_W16(p) + (size_t)_t * 128 + r * 16 + 8); \
    HR = *(const u32x2*)(W_H(p) + (size_t)_t * DM + ocol); } while (0)
DI float swap32_add(float a, float b) {
  const u32x2 r = __builtin_amdgcn_permlane32_swap(__float_as_uint(a), __float_as_uint(b), false, false);
  return __uint_as_float(r[0]) + __uint_as_float(r[1]);
}
DI float swap16_add(float a, float b) {
  const u32x2 r = __builtin_amdgcn_permlane16_swap(__float_as_uint(a), __float_as_uint(b), false, false);
  return __uint_as_float(r[0]) + __uint_as_float(r[1]);
}
DI void phase_peer_v(const Params& p, int layer, int wave) {
  const int tid = otid_w(wave), lane = tid & 63, wid = tid >> 6, c = lane & 7, r = lane >> 3;
  const int x = blockIdx.x & 7, wslot = (blockIdx.x >> 3) * 8 + wid, nslot = (gridDim.x >> 3) * 8;
  const unsigned char* vb = W_VB(p) + (size_t)x * (PEER_N * 128);
  const unsigned c16 = (unsigned)c * 16u;
  u16* y2 = W_Y(p);
  const int ocol = x * 128 + 16 * c + 4 * ((lane >> 4) & 1) + 8 * (lane >> 5);
  u32x4 iAa, iBa, iAb, iBb;
  u32x4 wAa, wBa, wAb, wBb, wA, wB;
  u32x2 hRa, hRb, hR;
  u32x4 rrA[16], rrB[16];
#define V_COMPUTE(T, RR) do { if ((T) < TTOK) { f32x2 acc[8]; \
    _Pragma("unroll") for (int i = 0; i < 8; ++i) acc[i] = (f32x2){0.f, 0.f}; \
    _Pragma("unroll") for (int g = 0; g < 16; ++g) { \
      const unsigned _ww = (g < 8 ? wA : wB)[(g >> 1) & 3]; const float wj = (g & 1) ? bfhi(_ww) : bflo(_ww); \
      const f32x2 wj2 = (f32x2){wj, wj}; \
      _Pragma("unroll") for (int k = 0; k < 4; ++k) { \
        const f32x2 lo = __builtin_amdgcn_cvt_pk_f32_fp8((int)RR[g][k], false), hi = __builtin_amdgcn_cvt_pk_f32_fp8((int)RR[g][k], true); \
        acc[2 * k] += wj2 * lo; acc[2 * k + 1] += wj2 * hi; } } \
    float P8[8], Q4[4]; \
    _Pragma("unroll") for (int i = 0; i < 8; ++i) P8[i] = swap32_add(acc[i >> 1][i & 1], acc[(i + 8) >> 1][i & 1]);     \
    _Pragma("unroll") for (int i = 0; i < 4; ++i) Q4[i] = swap16_add(P8[i], P8[i + 4]);                                 \
    _Pragma("unroll") for (int i = 0; i < 4; ++i) Q4[i] += DPP_F(Q4[i], 0x128);                                         \
    if ((lane & 8) == 0) { u32x2 _o; \
      _o[0] = pack2(ALPHA * bflo(hR[0]) + Q4[0], ALPHA * bfhi(hR[0]) + Q4[1]); \
      _o[1] = pack2(ALPHA * bflo(hR[1]) + Q4[2], ALPHA * bfhi(hR[1]) + Q4[3]); \
      *(u32x2*)(y2 + (size_t)(T) * DM + ocol) = _o; } } } while (0)
  int t = wslot;
  PEER_META_V(t, iAa, iBa, wAa, wBa, hRa);
  PEER_META_V(t + nslot, iAb, iBb, wAb, wBb, hRb);
  PEER_GATHER(vb, iAa, iBa, rrA);
  for (; t < TTOK; t += 2 * nslot) {
    wA = wAa; wB = wBa; hR = hRa;
    PEER_META_V(t + 2 * nslot, iAa, iBa, wAa, wBa, hRa);
    PEER_GATHER(vb, iAb, iBb, rrB);
    V_COMPUTE(t, rrA);
    wA = wAb; wB = wBb; hR = hRb;
    PEER_META_V(t + 3 * nslot, iAb, iBb, wAb, wBb, hRb);
    PEER_GATHER(vb, iAa, iBa, rrA);
    V_COMPUTE(t + nslot, rrB);
  }
#undef V_COMPUTE
}

#define XB_TMO      128
#define XB_XCNT(j)  (256  + 64 * (j))
#define XB_XSUB(j)  (1280 + 64 * (j))
#define XB_XGEN(j)  (2304 + 64 * (j))
#define XB_TOP      3328
#define XB_TOPGEN   3392
#define XCD_BAR_WORDS 3456
#define XB_SPIN_CAP (1u << 22)
DI unsigned xb_ld(unsigned* p)              { return __hip_atomic_load(p, __ATOMIC_RELAXED, __HIP_MEMORY_SCOPE_AGENT); }
DI unsigned xb_add(unsigned* p, unsigned v) { return __hip_atomic_fetch_add(p, v, __ATOMIC_RELAXED, __HIP_MEMORY_SCOPE_AGENT); }
DI unsigned xb_xcc_id() { return (unsigned)__builtin_amdgcn_s_getreg((3 << 11) | 20) & 0xFu; }
#define XB_SPIN(cond, bar) do { unsigned _sp = 0; while (cond) { __builtin_amdgcn_s_sleep(1); \
    if ((++_sp & 255u) == 0u) { if (xb_ld(&(bar)[XB_TMO])) break; if (_sp > XB_SPIN_CAP) { atomicAdd(&(bar)[XB_TMO], 1u); break; } } } } while (0)
DI bool is_thread0(int wave) { unsigned z = 0u; asm volatile("" : "+v"(z)); return wave == 0 && __builtin_amdgcn_mbcnt_hi(~0u, __builtin_amdgcn_mbcnt_lo(~0u, z)) == 0u; }
DI void xcd_barrier_complete(unsigned* bar, unsigned x, unsigned& nloc, unsigned& nx) {
  const unsigned G = gridDim.x;
  unsigned sum, cnt, mine, sp = 0u;
  for (;;) {
    sum = 0u; cnt = 0u; mine = 0u;
#pragma unroll
    for (unsigned j = 0; j < 16; ++j) { const unsigned c = xb_ld(&bar[XB_XCNT(j)]); sum += c; cnt += (c > 0u) ? 1u : 0u; mine = (j == x) ? c : mine; }
    if (sum == G) break;
    __builtin_amdgcn_s_sleep(1);
    if ((++sp & 255u) == 0u) { if (xb_ld(&bar[XB_TMO])) break; if (sp > XB_SPIN_CAP) { atomicAdd(&bar[XB_TMO], 1u); break; } }
  }
  nloc = mine > 0u ? mine : 1u; nx = cnt > 0u ? cnt : 1u;
}
DI void xcd_barrier(unsigned* bar, volatile LAS unsigned* st, int wave) {
  asm volatile("s_waitcnt vmcnt(0)" ::: "memory");
  __syncthreads();
  if (is_thread0(wave)) {
    const unsigned x = xb_xcc_id();
    __builtin_amdgcn_s_waitcnt(0);
    unsigned nloc = st[0], nx = st[1];
    if (nloc == 0u) { xcd_barrier_complete(bar, x, nloc, nx); st[0] = nloc; st[1] = nx; }
    const unsigned old = xb_add(&bar[XB_XSUB(x)], 1u);
    const unsigned gen = old / nloc;
    if (old + 1u == (gen + 1u) * nloc) {
      __builtin_amdgcn_fence(__ATOMIC_RELEASE, "agent");
      asm volatile("s_waitcnt vmcnt(0)" ::: "memory");
      const unsigned og = xb_add(&bar[XB_TOP], 1u);
      const unsigned tg = og / nx;
      if (og + 1u == (tg + 1u) * nx) xb_add(&bar[XB_TOPGEN], 1u);
      else XB_SPIN(xb_ld(&bar[XB_TOPGEN]) == tg, bar);
      __builtin_amdgcn_fence(__ATOMIC_ACQUIRE, "agent");
      xb_add(&bar[XB_XGEN(x)], 1u);
      asm volatile("s_waitcnt vmcnt(0)" ::: "memory");
    } else {
      XB_SPIN(xb_ld(&bar[XB_XGEN(x)]) == gen, bar);
      __builtin_amdgcn_fence(__ATOMIC_ACQUIRE, "agent");
      asm volatile("s_waitcnt vmcnt(0)" ::: "memory");
    }
  }
  __syncthreads();
}

__global__ void __launch_bounds__(NTHREADS, 2) mega(Params p) {
  extern __shared__ __attribute__((aligned(16))) char smem[];
  cg::grid_group grid = cg::this_grid();
  const int wave = __builtin_amdgcn_readfirstlane((int)(threadIdx.x >> 6));
  unsigned* bar = (unsigned*)(p.ws + WS_BAR);
  volatile LAS unsigned* st = (volatile LAS unsigned*)((lchar*)smem + LDS_XB);
  if (threadIdx.x == 0) { st[0] = 0u; st[1] = 0u; (void)xb_add(&bar[XB_XCNT(xb_xcc_id())], 1u); }
  __syncthreads();
  phase_prologue(p, smem, wave);
  grid.sync();
  phase_fold(p, smem, wave);
  xcd_barrier(bar, st, wave);
#pragma unroll 1
  for (int step = 0; step < DEPTH * 9; ++step) {
    const int layer = step / 9, ph = step - layer * 9;
    if (ph == 0 || ph == 2 || ph == 4) phase_gemm(p, layer, ph >> 1, smem, wave);
    else if (ph == 1) phase_attn(p, layer, smem, wave);
    else if (ph == 3 || ph == 8) phase_ln(p, layer, ph == 8, wave);
    else if (ph == 5) phase_peer_dots(p, layer, wave);
    else if (ph == 6) phase_peer_w(p, layer, wave);
    else phase_peer_v(p, layer, wave);
    if (step + 1 < DEPTH * 9) xcd_barrier(bar, st, wave);
  }
}

extern "C" void kernel_launch(void* const* d_in, const int* in_sizes, int n_in, void* d_out, int out_size, void* d_ws, size_t ws_size,
                              hipStream_t stream) {
  static int grid_blocks = 0;
  if (grid_blocks == 0) {
    if (ws_size < WS_END) { fprintf(stderr, "kernel_launch: workspace too small: need %zu, got %zu\n", (size_t)WS_END, ws_size); grid_blocks = -1; return; }
    int dev = 0, cus = 0, per_cu = 0;
    hipGetDevice(&dev);
    hipDeviceGetAttribute(&cus, hipDeviceAttributeMultiprocessorCount, dev);
    hipFuncSetAttribute((const void*)mega, hipFuncAttributeMaxDynamicSharedMemorySize, LDS_BYTES);
    hipOccupancyMaxActiveBlocksPerMultiprocessor(&per_cu, (const void*)mega, NTHREADS, LDS_BYTES);
    if (per_cu < 1) per_cu = 1;
    if (per_cu > 1) per_cu = 1;
    grid_blocks = cus * per_cu;
  }
  if (grid_blocks < 0) return;
  Params p{};
  for (int i = 0; i < 21; ++i) p.in[i] = (const float*)d_in[i];
  p.out = (float*)d_out;
  p.ws = (char*)d_ws;
  if (hipMemsetAsync((char*)d_ws + WS_BAR, 0, 16384, stream) != hipSuccess) { fprintf(stderr, "kernel_launch: memset of the barrier words failed\n"); return; }
  void* args[] = {&p};
  hipError_t e = hipLaunchCooperativeKernel((const void*)mega, dim3(grid_blocks), dim3(NTHREADS), args, LDS_BYTES, stream);
  if (e != hipSuccess) fprintf(stderr, "cooperative launch failed: %s (grid %d)\n", hipGetErrorString(e), grid_blocks);
}
```

```cpp
#include <hip/hip_runtime.h>
#include <hip/hip_cooperative_groups.h>
#include <cstdio>
#include <cstdint>
namespace cg = cooperative_groups;

typedef unsigned short u16;
typedef __attribute__((ext_vector_type(8))) short bf16x8;
typedef __attribute__((ext_vector_type(4))) float f32x4;
typedef __attribute__((ext_vector_type(4))) unsigned u32x4;
typedef __attribute__((ext_vector_type(2))) unsigned u32x2;
typedef __attribute__((ext_vector_type(2))) float f32x2;
#define DI __device__ __forceinline__
#define LAS __attribute__((address_space(3)))
typedef LAS char lchar;

#define DM 1024
#define NBATCH 32
#define SEQ 2048
#define NMETA 16
#define LSEQ 2064
#define TTOK 66048
#define DEPTH 4
#define INC 3072
#define LP 2112
#define PEER_N 16384
#define NTHREADS 512
#define LDS_MISC 69632
#define LDS_HALF 70656
#define LDS_XB 141312
#define LDS_BYTES 141328

#define ALPHA 1.681792830507429f
#define LOG2E 1.4426950408889634f

static constexpr size_t WS_WIN  = 0;
static constexpr size_t WS_WOUT = WS_WIN  + (size_t)4 * 3072 * 1024 * 2;
static constexpr size_t WS_WQB  = WS_WOUT + (size_t)4 * 1024 * 1024 * 2;
static constexpr size_t WS_SKB  = WS_WQB  + (size_t)4 * 1024 * 2048 * 2;
static constexpr size_t WS_WSC  = WS_SKB  + (size_t)4 * 16 * 128 * 128 * 2;
static constexpr size_t WS_UB   = WS_WSC  + (size_t)4 * 2048 * 1024 * 2;
static constexpr size_t WS_VB   = WS_UB   + (size_t)PEER_N * 1024;
static constexpr size_t WS_SU   = WS_VB   + (size_t)PEER_N * 1024;
static constexpr size_t WS_SV   = WS_SU   + (size_t)PEER_N * 4;
static constexpr size_t WS_H    = WS_SV   + (size_t)PEER_N * 4;
static constexpr size_t WS_MIX  = WS_H    + (size_t)TTOK * 1024 * 2;
static constexpr size_t WS_BIG  = WS_MIX  + (size_t)TTOK * 1024 * 2;
static constexpr size_t WS_VT   = WS_BIG  + (size_t)(TTOK + 64) * 3072 * 2;
static constexpr size_t WS_IDX  = WS_VT   + (size_t)NBATCH * 4 * 128 * LP * 2;
static constexpr size_t WS_G    = WS_IDX  + (size_t)TTOK * 128 * 4;
static constexpr size_t WS_W16  = WS_G    + (size_t)TTOK * 128 * 4;
static constexpr size_t WS_BAR  = WS_W16  + (size_t)TTOK * 128 * 2;
static constexpr size_t WS_END  = WS_BAR  + 16384;

struct Params {
  const float* in[21];
  float* out;
  char* ws;
};
#define P_X(p) ((p).in[0])
#define P_META(p) ((p).in[1])
#define P_LN_IN_G(p) ((p).in[2])
#define P_LN_IN_B(p) ((p).in[3])
#define P_REL_BIAS(p) ((p).in[4])
#define P_W_IN(p) ((p).in[5])
#define P_CONV_W(p) ((p).in[6])
#define P_LQ1(p) ((p).in[7])
#define P_LK1(p) ((p).in[8])
#define P_LQ2(p) ((p).in[9])
#define P_LK2(p) ((p).in[10])
#define P_SUBLN_G(p) ((p).in[11])
#define P_W_OUT(p) ((p).in[12])
#define P_LN1_G(p) ((p).in[13])
#define P_LN1_B(p) ((p).in[14])
#define P_W_Q(p) ((p).in[15])
#define P_SUB_KEYS(p) ((p).in[16])
#define P_PEER_U(p) ((p).in[17])
#define P_PEER_V(p) ((p).in[18])
#define P_LN2_G(p) ((p).in[19])
#define P_LN2_B(p) ((p).in[20])
#define W_WIN(p) ((u16*)((p).ws + WS_WIN))
#define W_WOUT(p) ((u16*)((p).ws + WS_WOUT))
#define W_WQB(p) ((u16*)((p).ws + WS_WQB))
#define W_SKB(p) ((u16*)((p).ws + WS_SKB))
#define W_WSC(p) ((u16*)((p).ws + WS_WSC))
#define W_UB(p) ((unsigned char*)((p).ws + WS_UB))
#define W_VB(p) ((unsigned char*)((p).ws + WS_VB))
#define W_SU(p) ((float*)((p).ws + WS_SU))
#define W_SV(p) ((float*)((p).ws + WS_SV))
#define W_H(p) ((u16*)((p).ws + WS_H))
#define W_MIX(p) ((u16*)((p).ws + WS_MIX))
#define W_PROJ(p) ((u16*)((p).ws + WS_BIG))
#define W_Y(p) ((u16*)((p).ws + WS_BIG))
#define W_VT(p) ((u16*)((p).ws + WS_VT))
#define W_IDX(p) ((u16*)((p).ws + WS_IDX))
#define W_W16(p) ((u16*)((p).ws + WS_W16))
#define W_G(p) ((float*)((p).ws + WS_G))

DI u16 f2bf(float x) { unsigned u = __float_as_uint(x); u += 0x7fffu + ((u >> 16) & 1u); return (u16)(u >> 16); }
typedef __attribute__((ext_vector_type(2))) __bf16 bf16x2_t;
DI unsigned pack2(float a, float b) { const bf16x2_t v = {(__bf16)a, (__bf16)b}; return __builtin_bit_cast(unsigned, v); }
DI float bflo(unsigned w) { return __uint_as_float(w << 16); }
DI float bfhi(unsigned w) { return __uint_as_float(w & 0xffff0000u); }
DI int otid_w(int wave) { unsigned z = 0u; asm volatile("" : "+v"(z)); int t = wave * 64 + (int)__builtin_amdgcn_mbcnt_hi(~0u, __builtin_amdgcn_mbcnt_lo(~0u, z)); asm volatile("" : "+v"(t)); return t; }
#define DPP_ADD(v, ctrl) ((v) + __int_as_float(__builtin_amdgcn_update_dpp(0, __float_as_int(v), (ctrl), 0xf, 0xf, true)))
DI float wave_sum(float v) {
  v = DPP_ADD(v, 0xB1);
  v = DPP_ADD(v, 0x4E);
  v = DPP_ADD(v, 0x141);
  v = DPP_ADD(v, 0x140);
  const int iv = __float_as_int(v);
  return __int_as_float(__builtin_amdgcn_readlane(iv, 0)) + __int_as_float(__builtin_amdgcn_readlane(iv, 16)) +
         __int_as_float(__builtin_amdgcn_readlane(iv, 32)) + __int_as_float(__builtin_amdgcn_readlane(iv, 48));
}
#define DPP_MAX(v, ctrl) fmaxf((v), __int_as_float(__builtin_amdgcn_update_dpp(0, __float_as_int(v), (ctrl), 0xf, 0xf, true)))
DI float wave_max_nonneg(float v) {
  v = DPP_MAX(v, 0xB1); v = DPP_MAX(v, 0x4E); v = DPP_MAX(v, 0x141); v = DPP_MAX(v, 0x140);
  const int iv = __float_as_int(v);
  return fmaxf(fmaxf(__int_as_float(__builtin_amdgcn_readlane(iv, 0)), __int_as_float(__builtin_amdgcn_readlane(iv, 16))),
               fmaxf(__int_as_float(__builtin_amdgcn_readlane(iv, 32)), __int_as_float(__builtin_amdgcn_readlane(iv, 48))));
}
DI float shx16(float v) { return __int_as_float(__builtin_amdgcn_ds_swizzle(__float_as_int(v), 0x401F)); }
DI float shx32(float v, int idx32) { return __int_as_float(__builtin_amdgcn_ds_bpermute(idx32, __float_as_int(v))); }
DI f32x4 mfma16(bf16x8 a, bf16x8 b, f32x4 c) { return __builtin_amdgcn_mfma_f32_16x16x32_bf16(a, b, c, 0, 0, 0); }
DI float fast_exp2(float x) { return __builtin_amdgcn_exp2f(x); }

DI void convert_straight(const float* __restrict__ src, u16* __restrict__ dst, size_t n8, size_t gtid, size_t gthreads) {
  for (size_t i = gtid; i < n8; i += gthreads) {
    const f32x4 a = *(const f32x4*)(src + i * 8), b = *(const f32x4*)(src + i * 8 + 4);
    u32x4 o; o[0] = pack2(a[0], a[1]); o[1] = pack2(a[2], a[3]); o[2] = pack2(b[0], b[1]); o[3] = pack2(b[2], b[3]);
    *(u32x4*)(dst + i * 8) = o;
  }
}

DI void transpose_tile(const float* __restrict__ src, int ldn, u16* __restrict__ dst, int ldk, int k0, int n0, float* sm, int tid) {
#pragma unroll
  for (int i = 0; i < 4; ++i) {
    const int r = (tid >> 4) + 16 * i, c4 = tid & 15;
    const f32x4 v = *(const f32x4*)(src + (size_t)(k0 + r) * ldn + n0 + 4 * c4);
    sm[r * 65 + 4 * c4 + 0] = v[0]; sm[r * 65 + 4 * c4 + 1] = v[1]; sm[r * 65 + 4 * c4 + 2] = v[2]; sm[r * 65 + 4 * c4 + 3] = v[3];
  }
  __syncthreads();
#pragma unroll
  for (int i = 0; i < 2; ++i) {
    const int n = (tid >> 3) + 32 * i, kc = tid & 7;
    u32x4 o;
#pragma unroll
    for (int e = 0; e < 4; ++e) o[e] = pack2(sm[(8 * kc + 2 * e) * 65 + n], sm[(8 * kc + 2 * e + 1) * 65 + n]);
    *(u32x4*)(dst + (size_t)(n0 + n) * ldk + k0 + 8 * kc) = o;
  }
  __syncthreads();
}

template <int LAYOUT> DI int col0(int lane, int hh) { return LAYOUT ? 16 * lane + 8 * hh : hh * 512 + 8 * lane; }
template <int LAYOUT>
DI void ln_row(float (&v)[16], const float* __restrict__ g, const float* __restrict__ b, int lane) {
  float s = 0.f;
#pragma unroll
  for (int i = 0; i < 16; ++i) s += v[i];
  const float mu = wave_sum(s) * (1.0f / 1024.0f);
  float q = 0.f;
#pragma unroll
  for (int i = 0; i < 16; ++i) { const float d = v[i] - mu; q += d * d; }
  const float rstd = rsqrtf(wave_sum(q) * (1.0f / 1024.0f) + 1e-5f);
#pragma unroll
  for (int hh = 0; hh < 2; ++hh) {
    const int c = col0<LAYOUT>(lane, hh);
    const f32x4 g0 = *(const f32x4*)(g + c), g1 = *(const f32x4*)(g + c + 4), b0 = *(const f32x4*)(b + c), b1 = *(const f32x4*)(b + c + 4);
#pragma unroll
    for (int e = 0; e < 4; ++e) {
      v[hh * 8 + e] = (v[hh * 8 + e] - mu) * rstd * g0[e] + b0[e];
      v[hh * 8 + 4 + e] = (v[hh * 8 + 4 + e] - mu) * rstd * g1[e] + b1[e];
    }
  }
}
template <int LAYOUT>
DI void store_row_bf16(u16* __restrict__ dst, const float (&v)[16], int lane) {
#pragma unroll
  for (int hh = 0; hh < 2; ++hh) {
    u32x4 o;
#pragma unroll
    for (int e = 0; e < 4; ++e) o[e] = pack2(v[hh * 8 + 2 * e], v[hh * 8 + 2 * e + 1]);
    *(u32x4*)(dst + col0<LAYOUT>(lane, hh)) = o;
  }
}
template <int LAYOUT>
DI void load_row_bf16(const u16* __restrict__ src, float (&v)[16], int lane) {
#pragma unroll
  for (int hh = 0; hh < 2; ++hh) {
    const u32x4 a = *(const u32x4*)(src + col0<LAYOUT>(lane, hh));
#pragma unroll
    for (int e = 0; e < 4; ++e) { v[hh * 8 + 2 * e] = bflo(a[e]); v[hh * 8 + 2 * e + 1] = bfhi(a[e]); }
  }
}
template <int LAYOUT>
DI void load_row_f32(const float* __restrict__ src, float (&v)[16], int lane) {
#pragma unroll
  for (int hh = 0; hh < 2; ++hh) {
    const int c = col0<LAYOUT>(lane, hh);
    const f32x4 a = *(const f32x4*)(src + c), b = *(const f32x4*)(src + c + 4);
#pragma unroll
    for (int e = 0; e < 4; ++e) { v[hh * 8 + e] = a[e]; v[hh * 8 + 4 + e] = b[e]; }
  }
}

enum { EPI_PROJ = 0, EPI_VT = 1, EPI_OUT = 2, EPI_TOPK = 3, EPI_FOLD = 4 };

template <bool SWAP>
DI void gemm_mainloop(const u16* __restrict__ A, int lda, const u16* __restrict__ Bt, int ldb, int K, int m0, int n0, char* smem,
                      f32x4 (&acc)[4][4], int tid) {
  const int lane = tid & 63, wid = tid >> 6, wm = wid >> 1, wn = wid & 1;
  const int srow = tid >> 3, skc = tid & 7;
  const u16* ap = A + (size_t)(m0 + srow) * lda + skc * 8;
  const u16* bp = Bt + (size_t)(n0 + srow) * ldb + skc * 8;
  const int dst0 = (((srow >> 4) * 2 + (skc >> 2)) * 1024) + (((skc & 3) * 16 + (srow & 15)) * 16);
#pragma unroll
  for (int i = 0; i < 4; ++i)
#pragma unroll
    for (int j = 0; j < 4; ++j) acc[i][j] = (f32x4){0.f, 0.f, 0.f, 0.f};
  u32x4 ra[4], rb[4];
#pragma unroll
  for (int j = 0; j < 4; ++j) { ra[j] = *(const u32x4*)(ap + (size_t)j * 32 * lda); rb[j] = *(const u32x4*)(bp + (size_t)j * 32 * ldb); }
#pragma unroll
  for (int j = 0; j < 4; ++j) { *(u32x4*)(smem + dst0 + j * 4096) = ra[j]; *(u32x4*)(smem + 16384 + dst0 + j * 4096) = rb[j]; }
  __syncthreads();
  const int KT = K >> 6;
  for (int kt = 0; kt < KT; ++kt) {
    char* cur = smem + (kt & 1) * 32768;
    char* nxt = smem + ((kt + 1) & 1) * 32768;
    const bool more = (kt + 1 < KT);
    if (more) {
      const u16* ap2 = ap + (kt + 1) * 64;
      const u16* bp2 = bp + (kt + 1) * 64;
#pragma unroll
      for (int j = 0; j < 4; ++j) { ra[j] = *(const u32x4*)(ap2 + (size_t)j * 32 * lda); rb[j] = *(const u32x4*)(bp2 + (size_t)j * 32 * ldb); }
    }
#pragma unroll
    for (int ks = 0; ks < 2; ++ks) {
      bf16x8 af[4], bfr[4];
#pragma unroll
      for (int i = 0; i < 4; ++i) af[i] = *(const bf16x8*)(cur + (((wm * 4 + i) * 2 + ks) * 1024) + lane * 16);
#pragma unroll
      for (int j = 0; j < 4; ++j) bfr[j] = *(const bf16x8*)(cur + 16384 + (((wn * 4 + j) * 2 + ks) * 1024) + lane * 16);
#pragma unroll
      for (int i = 0; i < 4; ++i)
#pragma unroll
        for (int j = 0; j < 4; ++j) acc[i][j] = SWAP ? mfma16(bfr[j], af[i], acc[i][j]) : mfma16(af[i], bfr[j], acc[i][j]);
    }
    if (more) {
#pragma unroll
      for (int j = 0; j < 4; ++j) { *(u32x4*)(nxt + dst0 + j * 4096) = ra[j]; *(u32x4*)(nxt + 16384 + dst0 + j * 4096) = rb[j]; }
    }
    __syncthreads();
  }
}

DI void ce_desc(float& hi, float& lo) { const float a = hi, b = lo; hi = fmaxf(a, b); lo = fminf(a, b); }
DI void bitonic_merge16(float (&v)[16]) {
#pragma unroll
  for (int j = 8; j > 0; j >>= 1)
#pragma unroll
    for (int i = 0; i < 16; ++i) if ((i & j) == 0) ce_desc(v[i], v[i | j]);
}
DI void bitonic_sort16(float (&v)[16]) {
#pragma unroll
  for (int k = 2; k <= 16; k <<= 1)
#pragma unroll
    for (int j = k >> 1; j > 0; j >>= 1)
#pragma unroll
      for (int i = 0; i < 16; ++i) {
        const int l = i ^ j;
        if (l > i) { if ((i & k) == 0 || k == 16) ce_desc(v[i], v[l]); else ce_desc(v[l], v[i]); }
      }
}
DI void merge_top16(float (&v)[16], const float (&w)[16]) {
#pragma unroll
  for (int i = 0; i < 16; ++i) v[i] = fmaxf(v[i], w[15 - i]);
  bitonic_merge16(v);
}
DI void insert16(float (&v)[16], float x) {
#pragma unroll
  for (int j = 0; j < 16; ++j) { const float hi = fmaxf(v[j], x); x = fminf(v[j], x); v[j] = hi; }
}

DI void gemm_tile_fold(const u16* A, int lda, const u16* Bt, int ldb, int K, int m0, char* smem, u16* dstT, int tid) {
  const int lane = tid & 63, wid = tid >> 6, wm = wid >> 1, wn = wid & 1, g = lane >> 4, l15 = lane & 15;
  f32x4 acc[4][4];
  gemm_mainloop<false>(A, lda, Bt, ldb, K, m0, 0, smem, acc, tid);
#pragma unroll
  for (int i = 0; i < 4; ++i)
#pragma unroll
    for (int j = 0; j < 4; ++j) {
      const int m = m0 + wm * 64 + 16 * i + 4 * g, n = wn * 64 + 16 * j + l15;
      u32x2 o; o[0] = pack2(acc[i][j][0], acc[i][j][1]); o[1] = pack2(acc[i][j][2], acc[i][j][3]);
      *(u32x2*)(dstT + (size_t)n * 1024 + m) = o;
    }
}

#define GK 1024
#define HTB 16384
DI int lds_byte(int r, int c) {
  const int st = (r >> 4) * 2 + (c >> 5), rr = r & 15, cc = c & 31, ob = rr * 64 + cc * 2;
  return st * 1024 + (ob ^ (((ob >> 9) & 1) << 5));
}
DI void stage_rc(int b, int& R, int& C) {
  const int st = b / 1024, sb = b % 1024, swz = sb ^ (((sb >> 9) & 1) << 5);
  R = (st >> 1) * 16 + swz / 64; C = (st & 1) * 32 + (swz % 64) / 2;
}
#define G_SA(b, h) (shm + ((b) * 2 + (h)) * HTB)
#define G_SB(b, h) (shm + (4 + (b) * 2 + (h)) * HTB)
#define G_STAGE_(P, BASE, br, kt, O0, O1) do { const char* _g = (const char*)((BASE) + (size_t)(br) * GK + (kt) * 64); \
    __builtin_amdgcn_global_load_lds((const unsigned*)(_g + (O0)), (LAS unsigned*)((P) + tid * 16), 16, 0, 0); \
    __builtin_amdgcn_global_load_lds((const unsigned*)(_g + (O1)), (LAS unsigned*)((P) + tid * 16 + 8192), 16, 0, 0); } while (0)
#define G_STAGEA(P, BASE, br, kt) G_STAGE_(P, BASE, br, kt, goffA0, goffA1)
#define G_STAGEB(P, BASE, br, kt) G_STAGE_(P, BASE, br, kt, goff0, goff1)
#define G_LDA(dst, b, h) _Pragma("unroll") for (int m = 0; m < 4; ++m) _Pragma("unroll") for (int k = 0; k < 2; ++k) \
    dst[m][k] = *(const LAS bf16x8*)(G_SA(b, h) + lds_byte(wr * 64 + m * 16 + fr, k * 32 + fq * 8))
#define G_LDB(dst, b, h) _Pragma("unroll") for (int n = 0; n < 2; ++n) _Pragma("unroll") for (int k = 0; k < 2; ++k) \
    dst[n][k] = *(const LAS bf16x8*)(G_SB(b, h) + lds_byte(wc * 32 + n * 16 + fr, k * 32 + fq * 8))
#define G_MMA(ai, bj, At, Bx) do { __builtin_amdgcn_s_setprio(1); \
    _Pragma("unroll") for (int m = 0; m < 4; ++m) _Pragma("unroll") for (int n = 0; n < 2; ++n) _Pragma("unroll") for (int k = 0; k < 2; ++k) \
      acc[ai][bj][m][n] = __builtin_amdgcn_mfma_f32_16x16x32_bf16(At[m][k], Bx[n][k], acc[ai][bj][m][n], 0, 0, 0); \
    __builtin_amdgcn_s_setprio(0); } while (0)
#define WAIT_V(n) asm volatile("s_waitcnt vmcnt(" #n ")" ::: "memory")
#define WAIT_L(n) asm volatile("s_waitcnt lgkmcnt(" #n ")" ::: "memory")
#define BAR __builtin_amdgcn_s_barrier()
#define SCHED __builtin_amdgcn_sched_barrier(0)

DI int perm64(int rho) { return ((rho >> 2) & 3) * 16 + (rho >> 4) * 4 + (rho & 3); }
DI void gemm256_core(const u16* __restrict__ A, const u16* __restrict__ Bt, int brow, int bcol, lchar* shm, int tid, f32x4 (&acc)[2][2][4][2], bool permA) {
  const int wid = tid >> 6, lane = tid & 63, wr = wid >> 2, wc = wid & 3, fr = lane & 15, fq = lane >> 4;
  int r0, c0, r1, c1;
  stage_rc(tid * 16, r0, c0); stage_rc(tid * 16 + 8192, r1, c1);
  const unsigned goff0 = (unsigned)(r0 * GK + c0) * 2u, goff1 = (unsigned)(r1 * GK + c1) * 2u;
  const int pr0 = permA ? ((r0 & 64) | perm64(r0 & 63)) : r0, pr1 = permA ? ((r1 & 64) | perm64(r1 & 63)) : r1;
  const unsigned goffA0 = (unsigned)(pr0 * GK + c0) * 2u, goffA1 = (unsigned)(pr1 * GK + c1) * 2u;
#pragma unroll
  for (int ai = 0; ai < 2; ++ai)
#pragma unroll
    for (int bj = 0; bj < 2; ++bj)
#pragma unroll
      for (int m = 0; m < 4; ++m)
#pragma unroll
        for (int n = 0; n < 2; ++n) acc[ai][bj][m][n] = (f32x4){0.f, 0.f, 0.f, 0.f};
  bf16x8 At[4][2], B0[2][2], B1[2][2];
  const int nt = GK / 64;
  WAIT_V(0);
  __syncthreads();
  G_STAGEB(G_SB(0, 0), Bt, bcol, 0); G_STAGEA(G_SA(0, 0), A, brow, 0);
  G_STAGEB(G_SB(0, 1), Bt, bcol + 128, 0); G_STAGEA(G_SA(0, 1), A, brow + 128, 0);
  if (wr == 1) BAR;
  WAIT_V(4); BAR;
  G_STAGEB(G_SB(1, 0), Bt, bcol, 1); G_STAGEA(G_SA(1, 0), A, brow, 1); G_STAGEB(G_SB(1, 1), Bt, bcol + 128, 1);
  WAIT_V(6); BAR;
  for (int t = 0; t < nt - 2; t += 2) {
    G_LDB(B0, 0, 0); SCHED; G_LDA(At, 0, 0); G_STAGEA(G_SA(1, 1), A, brow + 128, t + 1);
    WAIT_L(8); BAR; WAIT_L(0); G_MMA(0, 0, At, B0); BAR; SCHED;
    G_LDB(B1, 0, 1); G_STAGEB(G_SB(0, 0), Bt, bcol, t + 2);
    BAR; WAIT_L(0); G_MMA(0, 1, At, B1); BAR;
    G_LDA(At, 0, 1); G_STAGEA(G_SA(0, 0), A, brow, t + 2);
    BAR; WAIT_L(0); G_MMA(1, 0, At, B0); BAR; SCHED;
    G_STAGEB(G_SB(0, 1), Bt, bcol + 128, t + 2);
    WAIT_V(6); BAR; G_MMA(1, 1, At, B1); BAR;
    G_LDB(B0, 1, 0); SCHED; G_LDA(At, 1, 0); G_STAGEA(G_SA(0, 1), A, brow + 128, t + 2);
    WAIT_L(8); BAR; WAIT_L(0); G_MMA(0, 0, At, B0); BAR; SCHED;
    G_LDB(B1, 1, 1); G_STAGEB(G_SB(1, 0), Bt, bcol, t + 3);
    BAR; WAIT_L(0); G_MMA(0, 1, At, B1); BAR;
    G_LDA(At, 1, 1); G_STAGEA(G_SA(1, 0), A, brow, t + 3);
    BAR; WAIT_L(0); G_MMA(1, 0, At, B0); BAR; SCHED;
    G_STAGEB(G_SB(1, 1), Bt, bcol + 128, t + 3);
    WAIT_V(6); BAR; G_MMA(1, 1, At, B1); BAR;
  }
  { G_LDB(B0, 0, 0); G_LDA(At, 0, 0); G_STAGEA(G_SA(1, 1), A, brow + 128, nt - 1);
    BAR; WAIT_L(0); G_MMA(0, 0, At, B0); BAR;
    G_LDB(B1, 0, 1); BAR; WAIT_L(0); G_MMA(0, 1, At, B1); BAR;
    G_LDA(At, 0, 1); WAIT_V(4); BAR; WAIT_L(0); G_MMA(1, 0, At, B0); G_MMA(1, 1, At, B1); BAR; }
  { G_LDB(B0, 1, 0); G_LDA(At, 1, 0); WAIT_V(2); BAR; WAIT_L(0); G_MMA(0, 0, At, B0); BAR;
    G_LDB(B1, 1, 1); WAIT_V(0); BAR; WAIT_L(0); G_MMA(0, 1, At, B1); BAR;
    G_LDA(At, 1, 1); BAR; WAIT_L(0); G_MMA(1, 0, At, B0); G_MMA(1, 1, At, B1); BAR; }
  if (wr == 0) BAR;
}

DI void gemm256_tile(const Params& p, int mode, int layer, const u16* R, const u16* Cc, int brow, int bcol, lchar* shm, int tid_in) {
  f32x4 acc[2][2][4][2];
  gemm256_core(R, Cc, brow, bcol, shm, tid_in, acc, true);
  int tid = tid_in;
  asm volatile("" : "+v"(tid));
  const int wid = tid >> 6, lane = tid & 63, wr = wid >> 2, wc = wid & 3, fr = lane & 15, fq = lane >> 4;
  if (mode == EPI_PROJ) {
#pragma unroll
    for (int ai = 0; ai < 2; ++ai)
#pragma unroll
      for (int bj = 0; bj < 2; ++bj)
#pragma unroll
        for (int n = 0; n < 2; ++n) {
          const int nc = brow + ai * 128 + wr * 64 + fq * 16, tok = bcol + bj * 128 + wc * 32 + n * 16 + fr;
          u16* dst = W_PROJ(p) + (size_t)tok * INC + nc;
#pragma unroll
          for (int q = 0; q < 2; ++q) {
            const f32x4 va = acc[ai][bj][2 * q][n], vb2 = acc[ai][bj][2 * q + 1][n];
            *(u32x4*)(dst + 8 * q) = (u32x4){pack2(va[0], va[1]), pack2(va[2], va[3]), pack2(vb2[0], vb2[1]), pack2(vb2[2], vb2[3])};
          }
        }
  } else if (mode == EPI_VT) {
#pragma unroll
    for (int ai = 0; ai < 2; ++ai)
#pragma unroll
      for (int bj = 0; bj < 2; ++bj)
#pragma unroll
        for (int n = 0; n < 2; ++n) {
          const int tok = brow + ai * 128 + wr * 64 + fq * 16, nn = bcol + bj * 128 + wc * 32 + n * 16 + fr - 1024;
          const int b = tok / LSEQ, pos = tok - b * LSEQ;
          u16* dst = W_VT(p) + ((size_t)(b * 512 + nn)) * LP + pos;
#pragma unroll
          for (int q = 0; q < 2; ++q) {
            const f32x4 va = acc[ai][bj][2 * q][n], vb2 = acc[ai][bj][2 * q + 1][n];
            *(u32x4*)(dst + 8 * q) = (u32x4){pack2(va[0], va[1]), pack2(va[2], va[3]), pack2(vb2[0], vb2[1]), pack2(vb2[2], vb2[3])};
          }
        }
  } else if (mode == EPI_OUT) {
#pragma unroll
    for (int ai = 0; ai < 2; ++ai)
#pragma unroll
      for (int bj = 0; bj < 2; ++bj) {
        u32x4 hv[2][2];
#pragma unroll
        for (int n = 0; n < 2; ++n) {
          const int nc = brow + ai * 128 + wr * 64 + fq * 16, tok = bcol + bj * 128 + wc * 32 + n * 16 + fr;
          hv[n][0] = *(const u32x4*)(W_H(p) + (size_t)tok * DM + nc); hv[n][1] = *(const u32x4*)(W_H(p) + (size_t)tok * DM + nc + 8);
        }
#pragma unroll
        for (int n = 0; n < 2; ++n) {
          const int nc = brow + ai * 128 + wr * 64 + fq * 16, tok = bcol + bj * 128 + wc * 32 + n * 16 + fr;
          u16* dst = W_Y(p) + (size_t)tok * DM + nc;
#pragma unroll
          for (int q = 0; q < 2; ++q) {
            const f32x4 va = acc[ai][bj][2 * q][n], vb2 = acc[ai][bj][2 * q + 1][n];
            const u32x4 hh = hv[n][q];
            *(u32x4*)(dst + 8 * q) = (u32x4){pack2(ALPHA * bflo(hh[0]) + va[0], ALPHA * bfhi(hh[0]) + va[1]), pack2(ALPHA * bflo(hh[1]) + va[2], ALPHA * bfhi(hh[1]) + va[3]),
                                            pack2(ALPHA * bflo(hh[2]) + vb2[0], ALPHA * bfhi(hh[2]) + vb2[1]), pack2(ALPHA * bflo(hh[3]) + vb2[2], ALPHA * bfhi(hh[3]) + vb2[3])};
          }
        }
      }
  } else {
    LAS float* S = (LAS float*)shm;
    const int tok = tid & 255, kh = tid >> 8;
    float L0[16], L1[16];
#pragma unroll
    for (int ai = 0; ai < 2; ++ai) {
      __syncthreads();
#pragma unroll
      for (int bj = 0; bj < 2; ++bj)
#pragma unroll
        for (int m = 0; m < 4; ++m)
#pragma unroll
          for (int n = 0; n < 2; ++n) {
            const int tk = bj * 128 + wc * 32 + n * 16 + fr, key = wr * 64 + fq * 16 + m * 4;
            *(LAS f32x4*)((lchar*)S + tk * 528 + key * 4) = acc[ai][bj][m][n];
          }
      __syncthreads();
      float v[16];
#pragma unroll 1
      for (int ch = 0; ch < 4; ++ch) {
        float wk[16];
#pragma unroll
        for (int q = 0; q < 4; ++q) {
          const int key = kh * 64 + ch * 16 + 4 * q;
          const f32x4 xv = *(const LAS f32x4*)((lchar*)S + tok * 528 + key * 4);
#pragma unroll
          for (int e = 0; e < 4; ++e) wk[4 * q + e] = __uint_as_float((__float_as_uint(xv[e]) & ~127u) | (unsigned)(key + e));
        }
        bitonic_sort16(wk);
        if (ch == 0) {
#pragma unroll
          for (int i = 0; i < 16; ++i) v[i] = wk[i];
        } else {
          merge_top16(v, wk);
        }
      }
      __syncthreads();
      if (kh == 1) {
#pragma unroll
        for (int q = 0; q < 4; ++q) *(LAS f32x4*)((lchar*)S + tok * 80 + 16 * q) = (f32x4){v[4 * q], v[4 * q + 1], v[4 * q + 2], v[4 * q + 3]};
      }
      __syncthreads();
      if (kh == 0) {
        float wk[16];
#pragma unroll
        for (int q = 0; q < 4; ++q) {
          const f32x4 xv = *(const LAS f32x4*)((lchar*)S + tok * 80 + 16 * q);
          wk[4 * q] = xv[0]; wk[4 * q + 1] = xv[1]; wk[4 * q + 2] = xv[2]; wk[4 * q + 3] = xv[3];
        }
        merge_top16(v, wk);
      }
#pragma unroll
      for (int j = 0; j < 16; ++j) { if (ai == 0) L0[j] = v[j]; else L1[j] = v[j]; }
    }
    __syncthreads();
    LAS unsigned* LL = (LAS unsigned*)shm;
    if (kh == 0) {
#pragma unroll
      for (int j = 0; j < 16; ++j) { LL[tok * 32 + ((j + tok) & 31)] = __float_as_uint(L0[j]); LL[tok * 32 + ((16 + j + tok) & 31)] = __float_as_uint(L1[j]); }
      float s1[16], s2[16], v[16];
#pragma unroll
      for (int j = 0; j < 16; ++j) { s1[j] = __uint_as_float(__float_as_uint(L0[j]) & ~127u); s2[j] = __uint_as_float(__float_as_uint(L1[j]) & ~127u); v[j] = -3.0e38f; }
#pragma unroll
      for (int ch = 0; ch < 4; ++ch) {
        float wk[16];
#pragma unroll
        for (int i = 0; i < 16; ++i) {
          constexpr unsigned char PAIRS[64] = {0, 1, 2, 3, 4, 5, 6, 7, 8, 9, 10, 11, 12, 13, 14, 15, 16, 17, 18, 19, 20, 21, 22, 23, 32, 33, 34, 35, 36, 48, 49, 50, 51, 64, 65, 66, 80, 81, 96, 97, 112, 113, 128, 144, 160, 176, 192, 208, 224, 240, 255, 255, 255, 255, 255, 255, 255, 255, 255, 255, 255, 255, 255, 255};
          const int code = PAIRS[ch * 16 + i];
          if (code == 255) { wk[i] = -3.0e38f; }
          else { const float sm = s1[code >> 4] + s2[code & 15]; wk[i] = __uint_as_float((__float_as_uint(sm) & ~255u) | (unsigned)code); }
        }
        if (ch == 0) {
#pragma unroll
          for (int i = 0; i < 16; ++i) v[i] = wk[i];
        } else {
          bitonic_sort16(wk);
          merge_top16(v, wk);
        }
      }
      float e[16], sum = 0.f;
      const float mx = __uint_as_float(__float_as_uint(v[0]) & ~255u);
#pragma unroll
      for (int j = 0; j < 16; ++j) { e[j] = fast_exp2((__uint_as_float(__float_as_uint(v[j]) & ~255u) - mx) * LOG2E); sum += e[j]; }
      const float inv = 1.0f / sum;
      const int hd = brow >> 8;
      u16* di = W_IDX(p) + (size_t)(bcol + tok) * 128 + hd * 16;
      float* dg = W_G(p) + (size_t)(bcol + tok) * 128 + hd * 16;
      unsigned eid[16];
#pragma unroll
      for (int k = 0; k < 16; ++k) {
        const unsigned code = __float_as_uint(v[k]) & 255u;
        const unsigned i1 = LL[tok * 32 + (((code >> 4) + tok) & 31)] & 127u, i2 = LL[tok * 32 + ((16 + (code & 15u) + tok) & 31)] & 127u;
        eid[k] = i1 * 128u + i2;
      }
#pragma unroll
      for (int q = 0; q < 4; ++q) *(f32x4*)(dg + 4 * q) = (f32x4){e[4 * q] * inv, e[4 * q + 1] * inv, e[4 * q + 2] * inv, e[4 * q + 3] * inv};
#pragma unroll
      for (int q = 0; q < 2; ++q)
        *(u32x4*)(di + 8 * q) = (u32x4){eid[8 * q] | (eid[8 * q + 1] << 16), eid[8 * q + 2] | (eid[8 * q + 3] << 16), eid[8 * q + 4] | (eid[8 * q + 5] << 16), eid[8 * q + 6] | (eid[8 * q + 7] << 16)};
    }
    __syncthreads();
  }
}

#define ATT_MISC 131072
DI void attn_item(const Params& p, int layer, int b, int hh, int jq, lchar* sm, float lam, float oml, int tid) {
  const int lane = tid & 63, w = tid >> 6, g = lane >> 4, l15 = lane & 15;
  const int idx32 = (lane ^ 32) << 2;
  LAS float* tab = (LAS float*)(sm + ATT_MISC);
  LAS float* sg = tab + 208;
  __syncthreads();
  if (tid < 208) {
    const int d = tid - 80;
    float tv = -1.0e30f;
    if (d >= 0) {
      int bucket = d;
      if (d >= 16) {
        int lg = 16 + (int)(logf((float)d * (1.0f / 16.0f)) / 2.0794415416798357f * 16.0f);
        bucket = lg < 31 ? lg : 31;
      }
      tv = P_REL_BIAS(p)[bucket * 4 + hh] * LOG2E;
    }
    tab[tid] = tv;
    if (tid < 128) sg[tid] = P_SUBLN_G(p)[layer * 128 + tid] * oml;
  }
  const int q0w = 128 * jq + 16 * w;
  const int qpos = q0w + l15;
  const int qrow = b * LSEQ + (qpos < LSEQ ? qpos : LSEQ - 1);
  bf16x8 qf[2][2];
  {
    const u16* qp = W_PROJ(p) + (size_t)qrow * INC + hh * 128 + g * 8;
#pragma unroll
    for (int m = 0; m < 2; ++m)
#pragma unroll
      for (int ks = 0; ks < 2; ++ks) {
        const u32x4 raw = *(const u32x4*)(qp + m * 64 + ks * 32);
        u32x4 sc;
#pragma unroll
        for (int e = 0; e < 4; ++e) sc[e] = pack2(bflo(raw[e]) * (0.125f * LOG2E), bfhi(raw[e]) * (0.125f * LOG2E));
        qf[m][ks] = __builtin_bit_cast(bf16x8, sc);
      }
  }
  const int nkt = (2 * jq + 2) < 33 ? (2 * jq + 2) : 33;
  const char* ksrc[2]; const char* vsrc[2];
#pragma unroll
  for (int i = 0; i < 2; ++i) {
    const int bk = 2 * w + i, k16 = bk >> 2, m = (bk >> 1) & 1, ks = bk & 1;
    const int krow = 32 * (k16 >> 1) + 8 * (l15 >> 2) + 4 * (k16 & 1) + (l15 & 3);
    ksrc[i] = (const char*)(W_PROJ(p) + (size_t)(b * LSEQ + krow) * INC + 512 + hh * 128 + m * 64 + ks * 32 + g * 8);
    const int dv = 8 * bk + (lane >> 3), c = (lane & 7) ^ ((dv >> 1) & 7);
    vsrc[i] = (const char*)(W_VT(p) + ((size_t)((b * 4 + hh) * 128 + dv)) * LP + c * 8);
  }
  lchar* dmak = sm + (2 * w) * 1024 + lane * 16;
#define ATT_ISSUE(KT, SLOT) do { const size_t _ko = (size_t)(KT) * (64 * INC * 2), _vo = (size_t)(KT) * 128; lchar* _d = dmak + (SLOT) * 32768; \
    __builtin_amdgcn_global_load_lds((const unsigned*)(ksrc[0] + _ko), (LAS unsigned*)(_d), 16, 0, 0); \
    __builtin_amdgcn_global_load_lds((const unsigned*)(ksrc[1] + _ko), (LAS unsigned*)(_d + 1024), 16, 0, 0); \
    __builtin_amdgcn_global_load_lds((const unsigned*)(vsrc[0] + _vo), (LAS unsigned*)(_d + 16384), 16, 0, 0); \
    __builtin_amdgcn_global_load_lds((const unsigned*)(vsrc[1] + _vo), (LAS unsigned*)(_d + 16384 + 1024), 16, 0, 0); } while (0)
  int voff[2];
#pragma unroll
  for (int kk = 0; kk < 2; ++kk) voff[kk] = l15 * 128 + (((4 * kk + g) ^ ((l15 >> 1) & 7)) * 16);

  f32x4 O[2][8];
#pragma unroll
  for (int m = 0; m < 2; ++m)
#pragma unroll
    for (int dt = 0; dt < 8; ++dt) O[m][dt] = (f32x4){0.f, 0.f, 0.f, 0.f};
  float mrun[2] = {0.f, 0.f};
  f32x4 Osum[2] = {(f32x4){0.f, 0.f, 0.f, 0.f}, (f32x4){0.f, 0.f, 0.f, 0.f}};
  bf16x8 ones;
  { const short o1 = (l15 == 0) ? (short)0x3f80 : (short)0; ones = (bf16x8){o1, o1, o1, o1, o1, o1, o1, o1}; }

  WAIT_V(0);
  __syncthreads();
  const float tfar = tab[207];
  ATT_ISSUE(0, 0);
  ATT_ISSUE((1 < nkt ? 1 : nkt - 1), 1);
  for (int kt = 0; kt < nkt; ++kt) {
    { const int kn = (kt + 2 < nkt) ? kt + 2 : nkt - 1; ATT_ISSUE(kn, (kt + 2) & 3); }
    WAIT_V(8); BAR;
    if (64 * kt <= q0w + 15) {
      const lchar* kb = sm + (kt & 3) * 32768;
      const lchar* vb = kb + 16384;
      const bool near = (q0w - 64 * kt) < 176;
      const float tadd = near ? 0.f : tfar;
      const float sinit[2] = {tadd - mrun[0], tadd - mrun[1]};
      f32x4 S[2][4];
#pragma unroll
      for (int kh = 0; kh < 2; ++kh) {
        bf16x8 kf[2][2][2];
#pragma unroll
        for (int q = 0; q < 2; ++q)
#pragma unroll
          for (int m = 0; m < 2; ++m)
#pragma unroll
            for (int ks = 0; ks < 2; ++ks) kf[q][m][ks] = *(const LAS bf16x8*)(kb + ((((2 * kh + q) * 2 + m) * 2 + ks) * 1024) + lane * 16);
        SCHED;
#pragma unroll
        for (int q = 0; q < 2; ++q)
#pragma unroll
          for (int m = 0; m < 2; ++m) {
            f32x4 sacc = (f32x4){sinit[m], sinit[m], sinit[m], sinit[m]};
            sacc = mfma16(kf[q][m][0], qf[m][0], sacc);
            sacc = mfma16(kf[q][m][1], qf[m][1], sacc);
            S[m][2 * kh + q] = sacc;
          }
      }
      if (near) {
#pragma unroll
        for (int m = 0; m < 2; ++m)
#pragma unroll
          for (int k16 = 0; k16 < 4; ++k16)
#pragma unroll
            for (int r = 0; r < 4; ++r) {
              const int di = qpos + 80 - (64 * kt + 32 * (k16 >> 1) + 8 * g + 4 * (k16 & 1) + r);
              S[m][k16][r] += tab[di < 207 ? di : 207];
            }
      }
      bf16x8 pb[2][2];
#pragma unroll
      for (int m = 0; m < 2; ++m) {
        float mx = fmaxf(fmaxf(S[m][0][0], S[m][0][1]), fmaxf(S[m][0][2], S[m][0][3]));
#pragma unroll
        for (int k16 = 1; k16 < 4; ++k16) mx = fmaxf(fmaxf(mx, fmaxf(S[m][k16][0], S[m][k16][1])), fmaxf(S[m][k16][2], S[m][k16][3]));
        mx = fmaxf(mx, shx16(mx));
        mx = fmaxf(mx, shx32(mx, idx32));
        if (kt == 0 || __builtin_amdgcn_ballot_w64(mx > 8.0f) != 0ull) {
          const float dlt = kt == 0 ? mx : fmaxf(mx, 0.f);
          const float alpha = fast_exp2(-dlt);
          mrun[m] += dlt;
#pragma unroll
          for (int dt = 0; dt < 8; ++dt) { O[m][dt][0] *= alpha; O[m][dt][1] *= alpha; O[m][dt][2] *= alpha; O[m][dt][3] *= alpha; }
          Osum[m][0] *= alpha; Osum[m][1] *= alpha; Osum[m][2] *= alpha; Osum[m][3] *= alpha;
#pragma unroll
          for (int k16 = 0; k16 < 4; ++k16)
#pragma unroll
            for (int r = 0; r < 4; ++r) S[m][k16][r] -= dlt;
        }
#pragma unroll
        for (int k16 = 0; k16 < 4; ++k16)
#pragma unroll
          for (int r = 0; r < 4; ++r) S[m][k16][r] = fast_exp2(S[m][k16][r]);
#pragma unroll
        for (int kk = 0; kk < 2; ++kk) {
          u32x4 t;
          t[0] = pack2(S[m][2 * kk][0], S[m][2 * kk][1]); t[1] = pack2(S[m][2 * kk][2], S[m][2 * kk][3]);
          t[2] = pack2(S[m][2 * kk + 1][0], S[m][2 * kk + 1][1]); t[3] = pack2(S[m][2 * kk + 1][2], S[m][2 * kk + 1][3]);
          pb[m][kk] = __builtin_bit_cast(bf16x8, t);
          Osum[m] = mfma16(ones, pb[m][kk], Osum[m]);
        }
      }
#pragma unroll
      for (int kk = 0; kk < 2; ++kk) {
        bf16x8 vf[8];
#pragma unroll
        for (int dt = 0; dt < 8; ++dt) vf[dt] = *(const LAS bf16x8*)(vb + dt * 2048 + voff[kk]);
        SCHED;
#pragma unroll
        for (int dt = 0; dt < 8; ++dt) {
          O[0][dt] = mfma16(vf[dt], pb[0][kk], O[0][dt]);
          O[1][dt] = mfma16(vf[dt], pb[1][kk], O[1][dt]);
        }
      }
    }
  }
  WAIT_V(0);
#undef ATT_ISSUE
  float l0 = g == 0 ? Osum[0][0] : 0.f, l1 = g == 0 ? Osum[1][0] : 0.f;
  l0 += shx16(l0); l0 += shx32(l0, idx32);
  l1 += shx16(l1); l1 += shx32(l1, idx32);
  const float c1 = 1.0f / l0, c2 = lam / l1;
  float ss = 0.f;
#pragma unroll
  for (int dt = 0; dt < 8; ++dt)
#pragma unroll
    for (int r = 0; r < 4; ++r) { const float o = O[0][dt][r] * c1 - O[1][dt][r] * c2; O[0][dt][r] = o; ss += o * o; }
  ss += shx16(ss); ss += shx32(ss, idx32);
  const float rinv = rsqrtf(ss * (1.0f / 128.0f) + 1e-5f);
  if (qpos < LSEQ) {
    u16* dst = W_MIX(p) + (size_t)(b * LSEQ + qpos) * DM + hh * 128 + 4 * g;
#pragma unroll
    for (int dt = 0; dt < 8; ++dt) {
      const int dv0 = 16 * dt + 4 * g;
      u32x2 o;
      o[0] = pack2(O[0][dt][0] * rinv * sg[dv0 + 0], O[0][dt][1] * rinv * sg[dv0 + 1]);
      o[1] = pack2(O[0][dt][2] * rinv * sg[dv0 + 2], O[0][dt][3] * rinv * sg[dv0 + 3]);
      *(u32x2*)(dst + 16 * dt) = o;
    }
  }
}

DI void conv_item(const Params& p, int layer, int item, int tid) {
  const int ch = (tid & 63) * 8, t0 = item * 16 + 4 * (tid >> 6);
  const int pos0 = t0 % LSEQ;
  const bool head = pos0 == 0;
  const u16* row0 = W_PROJ(p) + (size_t)t0 * INC;
  u32x4 gc[6], zz[6], gb[4];
#pragma unroll
  for (int j = 0; j < 6; ++j) {
    const u16* r2 = row0 + (ptrdiff_t)((head && j < 2) ? 0 : (j - 2)) * INC;
    gc[j] = *(const u32x4*)(r2 + 2048 + ch); zz[j] = *(const u32x4*)(r2 + 2560 + ch);
  }
#pragma unroll
  for (int i = 0; i < 4; ++i) gb[i] = *(const u32x4*)(row0 + (size_t)i * INC + 1536 + ch);
  const float* cw = P_CONV_W(p) + (size_t)layer * 3 * 512 + ch;
  float w0[8], w1[8], w2[8];
#pragma unroll
  for (int e = 0; e < 8; ++e) { w0[e] = cw[e]; w1[e] = cw[512 + e]; w2[e] = cw[1024 + e]; }
  float pr[6][8];
#pragma unroll
  for (int j = 0; j < 6; ++j) {
    const float keep = (head && j < 2) ? 0.f : 1.f;
#pragma unroll
    for (int e = 0; e < 4; ++e) { pr[j][2 * e] = keep * bflo(gc[j][e]) * bflo(zz[j][e]); pr[j][2 * e + 1] = keep * bfhi(gc[j][e]) * bfhi(zz[j][e]); }
  }
#pragma unroll
  for (int i = 0; i < 4; ++i) {
    u32x4 o;
#pragma unroll
    for (int e = 0; e < 4; ++e) {
      const float a0 = w0[2 * e] * pr[i][2 * e] + w1[2 * e] * pr[i + 1][2 * e] + w2[2 * e] * pr[i + 2][2 * e];
      const float a1 = w0[2 * e + 1] * pr[i][2 * e + 1] + w1[2 * e + 1] * pr[i + 1][2 * e + 1] + w2[2 * e + 1] * pr[i + 2][2 * e + 1];
      o[e] = pack2(bflo(gb[i][e]) * a0, bfhi(gb[i][e]) * a1);
    }
    *(u32x4*)(W_MIX(p) + (size_t)(t0 + i) * DM + 512 + ch) = o;
  }
}

DI void phase_prologue(const Params& p, char* smem, int wave) {
  const int tid = otid_w(wave), lane = tid & 63, wid = tid >> 6, hb = tid >> 8, htid = tid & 255;
  const int nblk = gridDim.x, bid = blockIdx.x;
  const size_t gtid = (size_t)bid * NTHREADS + tid, gthreads = (size_t)nblk * NTHREADS;
  float* sm = (float*)(smem + hb * LDS_HALF);
  for (int it0 = bid; it0 < 2048; it0 += nblk) {
    const int it = it0 * 2 + hb;
    if (it < 3072) {
      const int l = it / 768, r = it % 768, kb = r / 48, nb = r % 48;
      transpose_tile(P_W_IN(p) + (size_t)l * 1024 * 3072, 3072, W_WIN(p) + (size_t)l * 3072 * 1024, 1024, kb * 64, nb * 64, sm, htid);
    } else {
      const int i2 = it - 3072, l = i2 / 256, r = i2 % 256, kb = r / 16, nb = r % 16;
      transpose_tile(P_W_OUT(p) + (size_t)l * 1024 * 1024, 1024, W_WOUT(p) + (size_t)l * 1024 * 1024, 1024, kb * 64, nb * 64, sm, htid);
    }
  }
  convert_straight(P_W_Q(p), W_WQB(p), (size_t)4 * 1024 * 2048 / 8, gtid, gthreads);
  convert_straight(P_SUB_KEYS(p), W_SKB(p), (size_t)4 * 16 * 128 * 128 / 8, gtid, gthreads);
  for (int t = bid * 8 + wid; t < TTOK; t += nblk * 8) {
    const int b = t / LSEQ, pos = t - b * LSEQ;
    const float* src = pos < NMETA ? P_META(p) + (size_t)pos * DM : P_X(p) + ((size_t)b * SEQ + pos - NMETA) * DM;
    float v[16];
    load_row_f32<0>(src, v, lane);
    ln_row<0>(v, P_LN_IN_G(p), P_LN_IN_B(p), lane);
    store_row_bf16<0>(W_H(p) + (size_t)t * DM, v, lane);
  }
}

DI void phase_fold(const Params& p, char* smem, int wave) {
  const int tid = otid_w(wave), hb = tid >> 8, htid = tid & 255;
  for (int it0 = blockIdx.x; it0 < 256; it0 += gridDim.x) {
    const int it = it0 * 2 + hb;
    const int l = it >> 7, hp = (it >> 3) & 15, mt = it & 7;
    gemm_tile_fold(W_WQB(p) + (size_t)l * 1024 * 2048 + hp * 128, 2048, W_SKB(p) + ((size_t)l * 16 + hp) * 128 * 128, 128, 128, mt * 128, smem + hb * 65536,
                   W_WSC(p) + (size_t)l * 2048 * 1024 + (size_t)hp * 128 * 1024, htid);
  }
}

DI bool tile_order(int i, int nM, int nN, int& pm, int& pn) {
  const int nwg = nM * nN;
  const long L = (long)i * gridDim.x + blockIdx.x;
  if (L >= nwg) return false;
  int wgid = (int)L;
  { const int q = nwg / 8, r = nwg % 8, xcd = wgid % 8, off = wgid / 8; wgid = (xcd < r ? xcd * (q + 1) : r * (q + 1) + (xcd - r) * q) + off; }
  const int nig = 8 * nN, gid = wgid / nig, fm = gid * 8, gsz = (nM - fm) < 8 ? (nM - fm) : 8;
  pm = fm + ((wgid % nig) % gsz); pn = (wgid % nig) / gsz;
  return true;
}

DI void convert_tables(const Params& p, int layer, int lane, int slot, int nslots) {
  for (int r = slot; r < 2 * PEER_N; r += nslots) {

    const bool isv = r >= PEER_N;
    const int e = isv ? r - PEER_N : r;
    const float* src = (isv ? P_PEER_V(p) : P_PEER_U(p)) + ((size_t)layer * PEER_N + e) * DM + 16 * lane;
    f32x4 a[4];
#pragma unroll
    for (int k = 0; k < 4; ++k) a[k] = *(const f32x4*)(src + 4 * k);
    float am = 0.f;
#pragma unroll
    for (int k = 0; k < 4; ++k) am = fmaxf(am, fmaxf(fmaxf(fabsf(a[k][0]), fabsf(a[k][1])), fmaxf(fabsf(a[k][2]), fabsf(a[k][3]))));
    am = wave_max_nonneg(am);
    const float top = isv ? 224.0f : 127.0f;
    const float sc = am > 0.f ? top / am : 1.0f;
    if (lane == 0) (isv ? W_SV(p) : W_SU(p))[e] = am > 0.f ? am / top : 1.0f;
    u32x4 o;
#pragma unroll
    for (int k = 0; k < 4; ++k) {
      if (isv) {
        int w = 0;
        w = __builtin_amdgcn_cvt_pk_fp8_f32(a[k][0] * sc, a[k][1] * sc, w, false);
        w = __builtin_amdgcn_cvt_pk_fp8_f32(a[k][2] * sc, a[k][3] * sc, w, true);
        o[k] = (unsigned)w;
      } else {
        const int q0 = __float2int_rn(a[k][0] * sc), q1 = __float2int_rn(a[k][1] * sc), q2 = __float2int_rn(a[k][2] * sc), q3 = __float2int_rn(a[k][3] * sc);
        o[k] = ((unsigned)q0 & 255u) | (((unsigned)q1 & 255u) << 8) | (((unsigned)q2 & 255u) << 16) | ((unsigned)q3 << 24);
      }
    }
    *(u32x4*)((isv ? W_VB(p) : W_UB(p)) + (size_t)(lane >> 3) * (PEER_N * 128) + (size_t)e * 128 + 16 * (lane & 7)) = o;
  }
}

DI void phase_gemm(const Params& p, int layer, int which, char* smem, int wave) {
  const int tid0 = otid_w(wave);
  const u16* W = which == 0 ? W_WIN(p) + (size_t)layer * 3072 * 1024 : (which == 1 ? W_WOUT(p) + (size_t)layer * 1024 * 1024 : W_WSC(p) + (size_t)layer * 2048 * 1024);
  const u16* X = which == 1 ? W_MIX(p) : W_H(p);
  const int nN = which == 0 ? 12 : (which == 1 ? 4 : 8);
  int pm, pn;
  for (int i = 0; tile_order(i, 258, nN, pm, pn); ++i) {
    const bool vt = (which == 0) && (pn == 4 || pn == 5);
    const int mode = which == 0 ? (vt ? EPI_VT : EPI_PROJ) : (which == 1 ? EPI_OUT : EPI_TOPK);
    int tid = tid0;
    asm volatile("" : "+v"(tid));
    gemm256_tile(p, mode, layer, vt ? X : W, vt ? W : X, vt ? pm * 256 : pn * 256, vt ? pn * 256 : pm * 256, (lchar*)smem, tid);
  }
  if (which == 1) {
    const int rem = (258 * 4) % (int)gridDim.x, nidle = (int)gridDim.x - rem;
    if ((int)blockIdx.x >= rem) convert_tables(p, layer, tid0 & 63, ((int)blockIdx.x - rem) * 8 + (tid0 >> 6), nidle * 8);
  }
}

DI void phase_attn(const Params& p, int layer, char* smem, int wave) {
  const int tid = otid_w(wave), lane = tid & 63, hb = tid >> 8, htid = tid & 255;
  const float lam_init = 0.8f - 0.6f * expf(-0.3f * (float)layer);
  float d1 = P_LQ1(p)[layer * 64 + lane] * P_LK1(p)[layer * 64 + lane], d2 = P_LQ2(p)[layer * 64 + lane] * P_LK2(p)[layer * 64 + lane];
  d1 = wave_sum(d1); d2 = wave_sum(d2);
  const float lam = expf(d1) - expf(d2) + lam_init;
  for (int rd = 0; rd * (int)gridDim.x < 2176; ++rd) {
    const int o = rd * gridDim.x + ((rd & 1) ? (int)gridDim.x - 1 - (int)blockIdx.x : (int)blockIdx.x);
    if (o < 2176) { const int jq = 16 - (o >> 7), bh = o & 127; attn_item(p, layer, bh >> 2, bh & 3, jq, (lchar*)smem, lam, 1.0f - lam_init, tid); }
  }
  for (int it = blockIdx.x; it < 2064; it += gridDim.x) conv_item(p, layer, it * 2 + hb, htid);
}

DI void phase_ln(const Params& p, int layer, int which, int wave) {
  const int tid = otid_w(wave), lane = tid & 63, wid = tid >> 6;
  const int nblk = gridDim.x, bid = blockIdx.x;
  const float* lg = (which ? P_LN2_G(p) : P_LN1_G(p)) + layer * DM;
  const float* lb = (which ? P_LN2_B(p) : P_LN1_B(p)) + layer * DM;
  const bool final_out = which && (layer == DEPTH - 1);
  for (int t = bid * 8 + wid; t < TTOK; t += nblk * 8) {
    float v[16];
    load_row_bf16<0>(W_Y(p) + (size_t)t * DM, v, lane);
    ln_row<0>(v, lg, lb, lane);
    if (final_out) {
      const int b = t / LSEQ, pos = t - b * LSEQ;
      if (pos >= NMETA) {
        float* dst = p.out + ((size_t)b * SEQ + pos - NMETA) * DM;
#pragma unroll
        for (int hh = 0; hh < 2; ++hh) {
          *(f32x4*)(dst + hh * 512 + 8 * lane) = (f32x4){v[hh * 8], v[hh * 8 + 1], v[hh * 8 + 2], v[hh * 8 + 3]};
          *(f32x4*)(dst + hh * 512 + 8 * lane + 4) = (f32x4){v[hh * 8 + 4], v[hh * 8 + 5], v[hh * 8 + 6], v[hh * 8 + 7]};
        }
      }
    } else {
      store_row_bf16<0>(W_H(p) + (size_t)t * DM, v, lane);
    }
  }
}

#define DPP_F(v, ctrl) __int_as_float(__builtin_amdgcn_update_dpp(0, __float_as_int(v), (ctrl), 0xf, 0xf, true))
#define PEER_META(T, IA, IB, HA, HB) do { const int _t = (T) < TTOK ? (T) : wslot; \
    IA = *(const u32x4*)(W_IDX(p) + (size_t)_t * 128 + r * 16); IB = *(const u32x4*)(W_IDX(p) + (size_t)_t * 128 + r * 16 + 8); \
    const u16* _hp = W_H(p) + (size_t)_t * DM + x * 128 + 16 * c; HA = *(const u32x4*)(_hp); HB = *(const u32x4*)(_hp + 8); } while (0)
#define PEER_GATHER(TAB, IA, IB, RR) do { _Pragma("unroll") for (int g = 0; g < 16; ++g) { \
    const unsigned _w = (g < 8 ? IA : IB)[(g >> 1) & 3]; const unsigned _e = (g & 1) ? (_w >> 16) : (_w & 0xffffu); RR[g] = *(const u32x4*)((TAB) + (_e * 128u + c16)); } } while (0)
#define PEER_UNPACK(XS, HA, HB) do { _Pragma("unroll") for (int e = 0; e < 4; ++e) { \
    XS[e] = (f32x2){bflo(HA[e]), bfhi(HA[e])}; XS[4 + e] = (f32x2){bflo(HB[e]), bfhi(HB[e])}; } } while (0)

#define DPP_I(v, ctrl) __builtin_amdgcn_update_dpp(0, (v), (ctrl), 0xf, 0xf, true)
DI int reduce_scatter8(int d0, int d1, int d2, int d3, int d4, int d5, int d6, int d7, int c) {
  const bool b2 = c >= 4, b1 = (c & 2) != 0, b0 = (c & 1) != 0;
  const int e0 = (b2 ? d4 : d0) + DPP_I(b2 ? d0 : d4, 0x141);
  const int e1 = (b2 ? d5 : d1) + DPP_I(b2 ? d1 : d5, 0x141);
  const int e2 = (b2 ? d6 : d2) + DPP_I(b2 ? d2 : d6, 0x141);
  const int e3 = (b2 ? d7 : d3) + DPP_I(b2 ? d3 : d7, 0x141);
  const int f0 = (b1 ? e2 : e0) + DPP_I(b1 ? e0 : e2, 0x4E);
  const int f1 = (b1 ? e3 : e1) + DPP_I(b1 ? e1 : e3, 0x4E);
  return (b0 ? f1 : f0) + DPP_I(b0 ? f0 : f1, 0xB1);
}
DI void phase_peer_dots(const Params& p, int layer, int wave) {
  const int tid = otid_w(wave), lane = tid & 63, wid = tid >> 6, c = lane & 7, r = lane >> 3;
  const int x = blockIdx.x & 7, wslot = (blockIdx.x >> 3) * 8 + wid, nslot = (gridDim.x >> 3) * 8;
  const unsigned char* ub = W_UB(p) + (size_t)x * (PEER_N * 128);
  const unsigned c16 = (unsigned)c * 16u;
  u16* pd = W_Y(p);
  u32x4 iAa, iBa, iAb, iBb;
  u32x4 hAa, hBa, hAb, hBb, rrA[16], rrB[16];
  int xq[4];
  float xscale;
#define DOTS_QUANT(HA, HB) do { float _xv[16]; \
    _Pragma("unroll") for (int e = 0; e < 4; ++e) { _xv[2 * e] = bflo(HA[e]); _xv[2 * e + 1] = bfhi(HA[e]); _xv[8 + 2 * e] = bflo(HB[e]); _xv[8 + 2 * e + 1] = bfhi(HB[e]); } \
    float _am = 0.f; _Pragma("unroll") for (int e = 0; e < 16; ++e) _am = fmaxf(_am, fabsf(_xv[e])); \
    _am = DPP_MAX(_am, 0xB1); _am = DPP_MAX(_am, 0x4E); _am = DPP_MAX(_am, 0x141); \
    const float _qs = _am > 0.f ? 127.0f / _am : 0.f; xscale = _am * (1.0f / 127.0f); \
    _Pragma("unroll") for (int k = 0; k < 4; ++k) { \
      const int q0 = __float2int_rn(_xv[4 * k] * _qs), q1 = __float2int_rn(_xv[4 * k + 1] * _qs), q2 = __float2int_rn(_xv[4 * k + 2] * _qs), q3 = __float2int_rn(_xv[4 * k + 3] * _qs); \
      xq[k] = (int)(((unsigned)q0 & 255u) | (((unsigned)q1 & 255u) << 8) | (((unsigned)q2 & 255u) << 16) | ((unsigned)q3 << 24)); } } while (0)
#define DOTS_COMPUTE(T, RR) do { if ((T) < TTOK) { int dd[16]; \
    _Pragma("unroll") for (int g = 0; g < 16; ++g) { int d = 0; \
      _Pragma("unroll") for (int k = 0; k < 4; ++k) d = __builtin_amdgcn_sdot4((int)RR[g][k], xq[k], d, false); \
      dd[g] = d; } \
    const int pA = reduce_scatter8(dd[0], dd[1], dd[2], dd[3], dd[4], dd[5], dd[6], dd[7], c); \
    const int pB = reduce_scatter8(dd[8], dd[9], dd[10], dd[11], dd[12], dd[13], dd[14], dd[15], c); \
    u16* _dst = pd + ((size_t)(T) * 8 + x) * 128 + r * 16 + c;        \
    _dst[0] = (u16)(pack2((float)pA * xscale, 0.f) & 0xffffu); _dst[8] = (u16)(pack2((float)pB * xscale, 0.f) & 0xffffu); } } while (0)
  int t = wslot;
  PEER_META(t, iAa, iBa, hAa, hBa);
  PEER_META(t + nslot, iAb, iBb, hAb, hBb);
  PEER_GATHER(ub, iAa, iBa, rrA);
  for (; t < TTOK; t += 2 * nslot) {
    DOTS_QUANT(hAa, hBa);
    PEER_META(t + 2 * nslot, iAa, iBa, hAa, hBa);
    PEER_GATHER(ub, iAb, iBb, rrB);
    DOTS_COMPUTE(t, rrA);
    DOTS_QUANT(hAb, hBb);
    PEER_META(t + 3 * nslot, iAb, iBb, hAb, hBb);
    PEER_GATHER(ub, iAa, iBa, rrA);
    DOTS_COMPUTE(t + nslot, rrB);
  }
#undef DOTS_COMPUTE
#undef DOTS_QUANT
}

DI void phase_peer_w(const Params& p, int layer, int wave) {
  const int tid = otid_w(wave), lane = tid & 63, wid = tid >> 6;
  const u16* pd = W_Y(p);
  for (int t = blockIdx.x * 8 + wid; t < TTOK; t += gridDim.x * 8) {
#pragma unroll
    for (int hf = 0; hf < 2; ++hf) {
      const int j = hf * 64 + lane;
      float sacc = 0.f;
#pragma unroll
      for (int xx = 0; xx < 8; ++xx) sacc += __uint_as_float(((unsigned)pd[((size_t)t * 8 + xx) * 128 + j]) << 16);
      const int e = W_IDX(p)[(size_t)t * 128 + j];
      const float act = sacc * W_SU(p)[e];
      const float wv = W_G(p)[(size_t)t * 128 + j] * (0.5f * act * (1.0f + erff(act * 0.7071067811865476f))) * W_SV(p)[e];
      W_W16(p)[(size_t)t * 128 + j] = (u16)(pack2(wv, 0.f) & 0xffffu);
    }
  }
}

#define PEER_META_V(T, IA, IB, WA, WB, HR) do { const int _t = (T) < TTOK ? (T) : wslot; \
    IA = *(const u32x4*)(W_IDX(p) + (size_t)_t * 128 + r * 16); IB = *(const u32x4*)(W_IDX(p) + (size_t)_t * 128 + r * 16 + 8); \
    WA = *(const u32x4*)(W_W16(p) + (size_t)_t * 128 + r * 16); WB = *(const u32x4*)(W_W16(p) + (size_t)_t * 128 + r * 16 + 8); \
    HR = *(const u32x2*)(W_H(p) + (size_t)_t * DM + ocol); } while (0)
DI float swap32_add(float a, float b) {
  const u32x2 r = __builtin_amdgcn_permlane32_swap(__float_as_uint(a), __float_as_uint(b), false, false);
  return __uint_as_float(r[0]) + __uint_as_float(r[1]);
}
DI float swap16_add(float a, float b) {
  const u32x2 r = __builtin_amdgcn_permlane16_swap(__float_as_uint(a), __float_as_uint(b), false, false);
  return __uint_as_float(r[0]) + __uint_as_float(r[1]);
}
DI void phase_peer_v(const Params& p, int layer, int wave) {
  const int tid = otid_w(wave), lane = tid & 63, wid = tid >> 6, c = lane & 7, r = lane >> 3;
  const int x = blockIdx.x & 7, wslot = (blockIdx.x >> 3) * 8 + wid, nslot = (gridDim.x >> 3) * 8;
  const unsigned char* vb = W_VB(p) + (size_t)x * (PEER_N * 128);
  const unsigned c16 = (unsigned)c * 16u;
  u16* y2 = W_Y(p);
  const int ocol = x * 128 + 16 * c + 4 * ((lane >> 4) & 1) + 8 * (lane >> 5);
  u32x4 iAa, iBa, iAb, iBb;
  u32x4 wAa, wBa, wAb, wBb, wA, wB;
  u32x2 hRa, hRb, hR;
  u32x4 rrA[16], rrB[16];
#define V_COMPUTE(T, RR) do { if ((T) < TTOK) { f32x2 acc[8]; \
    _Pragma("unroll") for (int i = 0; i < 8; ++i) acc[i] = (f32x2){0.f, 0.f}; \
    _Pragma("unroll") for (int g = 0; g < 16; ++g) { \
      const unsigned _ww = (g < 8 ? wA : wB)[(g >> 1) & 3]; const float wj = (g & 1) ? bfhi(_ww) : bflo(_ww); \
      const f32x2 wj2 = (f32x2){wj, wj}; \
      _Pragma("unroll") for (int k = 0; k < 4; ++k) { \
        const f32x2 lo = __builtin_amdgcn_cvt_pk_f32_fp8((int)RR[g][k], false), hi = __builtin_amdgcn_cvt_pk_f32_fp8((int)RR[g][k], true); \
        acc[2 * k] += wj2 * lo; acc[2 * k + 1] += wj2 * hi; } } \
    float P8[8], Q4[4]; \
    _Pragma("unroll") for (int i = 0; i < 8; ++i) P8[i] = swap32_add(acc[i >> 1][i & 1], acc[(i + 8) >> 1][i & 1]);     \
    _Pragma("unroll") for (int i = 0; i < 4; ++i) Q4[i] = swap16_add(P8[i], P8[i + 4]);                                 \
    _Pragma("unroll") for (int i = 0; i < 4; ++i) Q4[i] += DPP_F(Q4[i], 0x128);                                         \
    if ((lane & 8) == 0) { u32x2 _o; \
      _o[0] = pack2(ALPHA * bflo(hR[0]) + Q4[0], ALPHA * bfhi(hR[0]) + Q4[1]); \
      _o[1] = pack2(ALPHA * bflo(hR[1]) + Q4[2], ALPHA * bfhi(hR[1]) + Q4[3]); \
      *(u32x2*)(y2 + (size_t)(T) * DM + ocol) = _o; } } } while (0)
  int t = wslot;
  PEER_META_V(t, iAa, iBa, wAa, wBa, hRa);
  PEER_META_V(t + nslot, iAb, iBb, wAb, wBb, hRb);
  PEER_GATHER(vb, iAa, iBa, rrA);
  for (; t < TTOK; t += 2 * nslot) {
    wA = wAa; wB = wBa; hR = hRa;
    PEER_META_V(t + 2 * nslot, iAa, iBa, wAa, wBa, hRa);
    PEER_GATHER(vb, iAb, iBb, rrB);
    V_COMPUTE(t, rrA);
    wA = wAb; wB = wBb; hR = hRb;
    PEER_META_V(t + 3 * nslot, iAb, iBb, wAb, wBb, hRb);
    PEER_GATHER(vb, iAa, iBa, rrA);
    V_COMPUTE(t + nslot, rrB);
  }
#undef V_COMPUTE
}

#define XB_TMO      128
#define XB_XCNT(j)  (256  + 64 * (j))
#define XB_XSUB(j)  (1280 + 64 * (j))
#define XB_XGEN(j)  (2304 + 64 * (j))
#define XB_TOP      3328
#define XB_TOPGEN   3392
#define XCD_BAR_WORDS 3456
#define XB_SPIN_CAP (1u << 22)
DI unsigned xb_ld(unsigned* p)              { return __hip_atomic_load(p, __ATOMIC_RELAXED, __HIP_MEMORY_SCOPE_AGENT); }
DI unsigned xb_add(unsigned* p, unsigned v) { return __hip_atomic_fetch_add(p, v, __ATOMIC_RELAXED, __HIP_MEMORY_SCOPE_AGENT); }
DI unsigned xb_xcc_id() { return (unsigned)__builtin_amdgcn_s_getreg((3 << 11) | 20) & 0xFu; }
#define XB_SPIN(cond, bar) do { unsigned _sp = 0; while (cond) { __builtin_amdgcn_s_sleep(1); \
    if ((++_sp & 255u) == 0u) { if (xb_ld(&(bar)[XB_TMO])) break; if (_sp > XB_SPIN_CAP) { atomicAdd(&(bar)[XB_TMO], 1u); break; } } } } while (0)
DI bool is_thread0(int wave) { unsigned z = 0u; asm volatile("" : "+v"(z)); return wave == 0 && __builtin_amdgcn_mbcnt_hi(~0u, __builtin_amdgcn_mbcnt_lo(~0u, z)) == 0u; }
DI void xcd_barrier_complete(unsigned* bar, unsigned x, unsigned& nloc, unsigned& nx) {
  const unsigned G = gridDim.x;
  unsigned sum, cnt, mine, sp = 0u;
  for (;;) {
    sum = 0u; cnt = 0u; mine = 0u;
#pragma unroll
    for (unsigned j = 0; j < 16; ++j) { const unsigned c = xb_ld(&bar[XB_XCNT(j)]); sum += c; cnt += (c > 0u) ? 1u : 0u; mine = (j == x) ? c : mine; }
    if (sum == G) break;
    __builtin_amdgcn_s_sleep(1);
    if ((++sp & 255u) == 0u) { if (xb_ld(&bar[XB_TMO])) break; if (sp > XB_SPIN_CAP) { atomicAdd(&bar[XB_TMO], 1u); break; } }
  }
  nloc = mine > 0u ? mine : 1u; nx = cnt > 0u ? cnt : 1u;
}
DI void xcd_barrier(unsigned* bar, volatile LAS unsigned* st, int wave) {
  asm volatile("s_waitcnt vmcnt(0)" ::: "memory");
  __syncthreads();
  if (is_thread0(wave)) {
    const unsigned x = xb_xcc_id();
    __builtin_amdgcn_s_waitcnt(0);
    unsigned nloc = st[0], nx = st[1];
    if (nloc == 0u) { xcd_barrier_complete(bar, x, nloc, nx); st[0] = nloc; st[1] = nx; }
    const unsigned old = xb_add(&bar[XB_XSUB(x)], 1u);
    const unsigned gen = old / nloc;
    if (old + 1u == (gen + 1u) * nloc) {
      __builtin_amdgcn_fence(__ATOMIC_RELEASE, "agent");
      asm volatile("s_waitcnt vmcnt(0)" ::: "memory");
      const unsigned og = xb_add(&bar[XB_TOP], 1u);
      const unsigned tg = og / nx;
      if (og + 1u == (tg + 1u) * nx) xb_add(&bar[XB_TOPGEN], 1u);
      else XB_SPIN(xb_ld(&bar[XB_TOPGEN]) == tg, bar);
      __builtin_amdgcn_fence(__ATOMIC_ACQUIRE, "agent");
      xb_add(&bar[XB_XGEN(x)], 1u);
      asm volatile("s_waitcnt vmcnt(0)" ::: "memory");
    } else {
      XB_SPIN(xb_ld(&bar[XB_XGEN(x)]) == gen, bar);
      __builtin_amdgcn_fence(__ATOMIC_ACQUIRE, "agent");
      asm volatile("s_waitcnt vmcnt(0)" ::: "memory");
    }
  }
  __syncthreads();
}

__global__ void __launch_bounds__(NTHREADS, 2) mega(Params p) {
  extern __shared__ __attribute__((aligned(16))) char smem[];
  cg::grid_group grid = cg::this_grid();
  const int wave = __builtin_amdgcn_readfirstlane((int)(threadIdx.x >> 6));
  unsigned* bar = (unsigned*)(p.ws + WS_BAR);
  volatile LAS unsigned* st = (volatile LAS unsigned*)((lchar*)smem + LDS_XB);
  if (threadIdx.x == 0) { st[0] = 0u; st[1] = 0u; (void)xb_add(&bar[XB_XCNT(xb_xcc_id())], 1u); }
  __syncthreads();
  phase_prologue(p, smem, wave);
  grid.sync();
  phase_fold(p, smem, wave);
  xcd_barrier(bar, st, wave);
#pragma unroll 1
  for (int step = 0; step < DEPTH * 9; ++step) {
    const int layer = step / 9, ph = step - layer * 9;
    if (ph == 0 || ph == 2 || ph == 4) phase_gemm(p, layer, ph >> 1, smem, wave);
    else if (ph == 1) phase_attn(p, layer, smem, wave);
    else if (ph == 3 || ph == 8) phase_ln(p, layer, ph == 8, wave);
    else if (ph == 5) phase_peer_dots(p, layer, wave);
    else if (ph == 6) phase_peer_w(p, layer, wave);
    else phase_peer_v(p, layer, wave);
    if (step + 1 < DEPTH * 9) xcd_barrier(bar, st, wave);
  }
}

extern "C" void kernel_launch(void* const* d_in, const int* in_sizes, int n_in, void* d_out, int out_size, void* d_ws, size_t ws_size,
                              hipStream_t stream) {
  static int grid_blocks = 0;
  if (grid_blocks == 0) {
    if (ws_size < WS_END) { fprintf(stderr, "kernel_launch: workspace too small: need %zu, got %zu\n", (size_t)WS_END, ws_size); grid_blocks = -1; return; }
    int dev = 0, cus = 0, per_cu = 0;
    hipGetDevice(&dev);
    hipDeviceGetAttribute(&cus, hipDeviceAttributeMultiprocessorCount, dev);
    hipFuncSetAttribute((const void*)mega, hipFuncAttributeMaxDynamicSharedMemorySize, LDS_BYTES);
    hipOccupancyMaxActiveBlocksPerMultiprocessor(&per_cu, (const void*)mega, NTHREADS, LDS_BYTES);
    if (per_cu < 1) per_cu = 1;
    if (per_cu > 1) per_cu = 1;
    grid_blocks = cus * per_cu;
  }
  if (grid_blocks < 0) return;
  Params p{};
  for (int i = 0; i < 21; ++i) p.in[i] = (const float*)d_in[i];
  p.out = (float*)d_out;
  p.ws = (char*)d_ws;
  if (hipMemsetAsync((char*)d_ws + WS_BAR, 0, 16384, stream) != hipSuccess) { fprintf(stderr, "kernel_launch: memset of the barrier words failed\n"); return; }
  void* args[] = {&p};
  hipError_t e = hipLaunchCooperativeKernel((const void*)mega, dim3(grid_blocks), dim3(NTHREADS), args, LDS_BYTES, stream);
  if (e != hipSuccess) fprintf(stderr, "cooperative launch failed: %s (grid %d)\n", hipGetErrorString(e), grid_blocks);
}
```

```cpp
#include <hip/hip_runtime.h>
#include <hip/hip_cooperative_groups.h>
#include <cstdio>
#include <cstdint>
namespace cg = cooperative_groups;

typedef unsigned short u16;
typedef __attribute__((ext_vector_type(8))) short bf16x8;
typedef __attribute__((ext_vector_type(4))) float f32x4;
typedef __attribute__((ext_vector_type(4))) unsigned u32x4;
typedef __attribute__((ext_vector_type(2))) unsigned u32x2;
typedef __attribute__((ext_vector_type(2))) float f32x2;
#define DI __device__ __forceinline__
#define LAS __attribute__((address_space(3)))
typedef LAS char lchar;

#define DM 1024
#define NBATCH 32
#define SEQ 2048
#define NMETA 16
#define LSEQ 2064
#define TTOK 66048
#define DEPTH 4
#define INC 3072
#define LP 2112
#define PEER_N 16384
#define NTHREADS 512
#define LDS_MISC 69632
#define LDS_HALF 70656
#define LDS_XB 141312
#define LDS_BYTES 141328

#define ALPHA 1.681792830507429f
#define LOG2E 1.4426950408889634f

static constexpr size_t WS_WIN  = 0;
static constexpr size_t WS_WOUT = WS_WIN  + (size_t)4 * 3072 * 1024 * 2;
static constexpr size_t WS_WQB  = WS_WOUT + (size_t)4 * 1024 * 1024 * 2;
static constexpr size_t WS_SKB  = WS_WQB  + (size_t)4 * 1024 * 2048 * 2;
static constexpr size_t WS_WSC  = WS_SKB  + (size_t)4 * 16 * 128 * 128 * 2;
static constexpr size_t WS_UB   = WS_WSC  + (size_t)4 * 2048 * 1024 * 2;
static constexpr size_t WS_VB   = WS_UB   + (size_t)PEER_N * 1024;
static constexpr size_t WS_SU   = WS_VB   + (size_t)PEER_N * 1024;
static constexpr size_t WS_SV   = WS_SU   + (size_t)PEER_N * 4;
static constexpr size_t WS_H    = WS_SV   + (size_t)PEER_N * 4;
static constexpr size_t WS_MIX  = WS_H    + (size_t)TTOK * 1024 * 2;
static constexpr size_t WS_BIG  = WS_MIX  + (size_t)TTOK * 1024 * 2;
static constexpr size_t WS_VT   = WS_BIG  + (size_t)(TTOK + 64) * 3072 * 2;
static constexpr size_t WS_IDX  = WS_VT   + (size_t)NBATCH * 4 * 128 * LP * 2;
static constexpr size_t WS_G    = WS_IDX  + (size_t)TTOK * 128 * 4;
static constexpr size_t WS_W16  = WS_G    + (size_t)TTOK * 128 * 4;
static constexpr size_t WS_BAR  = WS_W16  + (size_t)TTOK * 128 * 2;
static constexpr size_t WS_END  = WS_BAR  + 16384;

struct Params {
  const float* in[21];
  float* out;
  char* ws;
};
#define P_X(p) ((p).in[0])
#define P_META(p) ((p).in[1])
#define P_LN_IN_G(p) ((p).in[2])
#define P_LN_IN_B(p) ((p).in[3])
#define P_REL_BIAS(p) ((p).in[4])
#define P_W_IN(p) ((p).in[5])
#define P_CONV_W(p) ((p).in[6])
#define P_LQ1(p) ((p).in[7])
#define P_LK1(p) ((p).in[8])
#define P_LQ2(p) ((p).in[9])
#define P_LK2(p) ((p).in[10])
#define P_SUBLN_G(p) ((p).in[11])
#define P_W_OUT(p) ((p).in[12])
#define P_LN1_G(p) ((p).in[13])
#define P_LN1_B(p) ((p).in[14])
#define P_W_Q(p) ((p).in[15])
#define P_SUB_KEYS(p) ((p).in[16])
#define P_PEER_U(p) ((p).in[17])
#define P_PEER_V(p) ((p).in[18])
#define P_LN2_G(p) ((p).in[19])
#define P_LN2_B(p) ((p).in[20])
#define W_WIN(p) ((u16*)((p).ws + WS_WIN))
#define W_WOUT(p) ((u16*)((p).ws + WS_WOUT))
#define W_WQB(p) ((u16*)((p).ws + WS_WQB))
#define W_SKB(p) ((u16*)((p).ws + WS_SKB))
#define W_WSC(p) ((u16*)((p).ws + WS_WSC))
#define W_UB(p) ((unsigned char*)((p).ws + WS_UB))
#define W_VB(p) ((unsigned char*)((p).ws + WS_VB))
#define W_SU(p) ((float*)((p).ws + WS_SU))
#define W_SV(p) ((float*)((p).ws + WS_SV))
#define W_H(p) ((u16*)((p).ws + WS_H))
#define W_MIX(p) ((u16*)((p).ws + WS_MIX))
#define W_PROJ(p) ((u16*)((p).ws + WS_BIG))
#define W_Y(p) ((u16*)((p).ws + WS_BIG))
#define W_VT(p) ((u16*)((p).ws + WS_VT))
#define W_IDX(p) ((u16*)((p).ws + WS_IDX))
#define W_W16(p) ((u16*)((p).ws + WS_W16))
#define W_G(p) ((float*)((p).ws + WS_G))

DI u16 f2bf(float x) { unsigned u = __float_as_uint(x); u += 0x7fffu + ((u >> 16) & 1u); return (u16)(u >> 16); }
typedef __attribute__((ext_vector_type(2))) __bf16 bf16x2_t;
DI unsigned pack2(float a, float b) { const bf16x2_t v = {(__bf16)a, (__bf16)b}; return __builtin_bit_cast(unsigned, v); }
DI float bflo(unsigned w) { return __uint_as_float(w << 16); }
DI float bfhi(unsigned w) { return __uint_as_float(w & 0xffff0000u); }
DI int otid_w(int wave) { unsigned z = 0u; asm volatile("" : "+v"(z)); int t = wave * 64 + (int)__builtin_amdgcn_mbcnt_hi(~0u, __builtin_amdgcn_mbcnt_lo(~0u, z)); asm volatile("" : "+v"(t)); return t; }
#define DPP_ADD(v, ctrl) ((v) + __int_as_float(__builtin_amdgcn_update_dpp(0, __float_as_int(v), (ctrl), 0xf, 0xf, true)))
DI float wave_sum(float v) {
  v = DPP_ADD(v, 0xB1);
  v = DPP_ADD(v, 0x4E);
  v = DPP_ADD(v, 0x141);
  v = DPP_ADD(v, 0x140);
  const int iv = __float_as_int(v);
  return __int_as_float(__builtin_amdgcn_readlane(iv, 0)) + __int_as_float(__builtin_amdgcn_readlane(iv, 16)) +
         __int_as_float(__builtin_amdgcn_readlane(iv, 32)) + __int_as_float(__builtin_amdgcn_readlane(iv, 48));
}
#define DPP_MAX(v, ctrl) fmaxf((v), __int_as_float(__builtin_amdgcn_update_dpp(0, __float_as_int(v), (ctrl), 0xf, 0xf, true)))
DI float wave_max_nonneg(float v) {
  v = DPP_MAX(v, 0xB1); v = DPP_MAX(v, 0x4E); v = DPP_MAX(v, 0x141); v = DPP_MAX(v, 0x140);
  const int iv = __float_as_int(v);
  return fmaxf(fmaxf(__int_as_float(__builtin_amdgcn_readlane(iv, 0)), __int_as_float(__builtin_amdgcn_readlane(iv, 16))),
               fmaxf(__int_as_float(__builtin_amdgcn_readlane(iv, 32)), __int_as_float(__builtin_amdgcn_readlane(iv, 48))));
}
DI float shx16(float v) { return __int_as_float(__builtin_amdgcn_ds_swizzle(__float_as_int(v), 0x401F)); }
DI float shx32(float v, int idx32) { return __int_as_float(__builtin_amdgcn_ds_bpermute(idx32, __float_as_int(v))); }
DI f32x4 mfma16(bf16x8 a, bf16x8 b, f32x4 c) { return __builtin_amdgcn_mfma_f32_16x16x32_bf16(a, b, c, 0, 0, 0); }
DI float fast_exp2(float x) { return __builtin_amdgcn_exp2f(x); }

DI void convert_straight(const float* __restrict__ src, u16* __restrict__ dst, size_t n8, size_t gtid, size_t gthreads) {
  for (size_t i = gtid; i < n8; i += gthreads) {
    const f32x4 a = *(const f32x4*)(src + i * 8), b = *(const f32x4*)(src + i * 8 + 4);
    u32x4 o; o[0] = pack2(a[0], a[1]); o[1] = pack2(a[2], a[3]); o[2] = pack2(b[0], b[1]); o[3] = pack2(b[2], b[3]);
    *(u32x4*)(dst + i * 8) = o;
  }
}

DI void transpose_tile(const float* __restrict__ src, int ldn, u16* __restrict__ dst, int ldk, int k0, int n0, float* sm, int tid) {
#pragma unroll
  for (int i = 0; i < 4; ++i) {
    const int r = (tid >> 4) + 16 * i, c4 = tid & 15;
    const f32x4 v = *(const f32x4*)(src + (size_t)(k0 + r) * ldn + n0 + 4 * c4);
    sm[r * 65 + 4 * c4 + 0] = v[0]; sm[r * 65 + 4 * c4 + 1] = v[1]; sm[r * 65 + 4 * c4 + 2] = v[2]; sm[r * 65 + 4 * c4 + 3] = v[3];
  }
  __syncthreads();
#pragma unroll
  for (int i = 0; i < 2; ++i) {
    const int n = (tid >> 3) + 32 * i, kc = tid & 7;
    u32x4 o;
#pragma unroll
    for (int e = 0; e < 4; ++e) o[e] = pack2(sm[(8 * kc + 2 * e) * 65 + n], sm[(8 * kc + 2 * e + 1) * 65 + n]);
    *(u32x4*)(dst + (size_t)(n0 + n) * ldk + k0 + 8 * kc) = o;
  }
  __syncthreads();
}

template <int LAYOUT> DI int col0(int lane, int hh) { return LAYOUT ? 16 * lane + 8 * hh : hh * 512 + 8 * lane; }
template <int LAYOUT>
DI void ln_row(float (&v)[16], const float* __restrict__ g, const float* __restrict__ b, int lane) {
  float s = 0.f;
#pragma unroll
  for (int i = 0; i < 16; ++i) s += v[i];
  const float mu = wave_sum(s) * (1.0f / 1024.0f);
  float q = 0.f;
#pragma unroll
  for (int i = 0; i < 16; ++i) { const float d = v[i] - mu; q += d * d; }
  const float rstd = rsqrtf(wave_sum(q) * (1.0f / 1024.0f) + 1e-5f);
#pragma unroll
  for (int hh = 0; hh < 2; ++hh) {
    const int c = col0<LAYOUT>(lane, hh);
    const f32x4 g0 = *(const f32x4*)(g + c), g1 = *(const f32x4*)(g + c + 4), b0 = *(const f32x4*)(b + c), b1 = *(const f32x4*)(b + c + 4);
#pragma unroll
    for (int e = 0; e < 4; ++e) {
      v[hh * 8 + e] = (v[hh * 8 + e] - mu) * rstd * g0[e] + b0[e];
      v[hh * 8 + 4 + e] = (v[hh * 8 + 4 + e] - mu) * rstd * g1[e] + b1[e];
    }
  }
}
template <int LAYOUT>
DI void store_row_bf16(u16* __restrict__ dst, const float (&v)[16], int lane) {
#pragma unroll
  for (int hh = 0; hh < 2; ++hh) {
    u32x4 o;
#pragma unroll
    for (int e = 0; e < 4; ++e) o[e] = pack2(v[hh * 8 + 2 * e], v[hh * 8 + 2 * e + 1]);
    *(u32x4*)(dst + col0<LAYOUT>(lane, hh)) = o;
  }
}
template <int LAYOUT>
DI void load_row_bf16(const u16* __restrict__ src, float (&v)[16], int lane) {
#pragma unroll
  for (int hh = 0; hh < 2; ++hh) {
    const u32x4 a = *(const u32x4*)(src + col0<LAYOUT>(lane, hh));
#pragma unroll
    for (int e = 0; e < 4; ++e) { v[hh * 8 + 2 * e] = bflo(a[e]); v[hh * 8 + 2 * e + 1] = bfhi(a[e]); }
  }
}
template <int LAYOUT>
DI void load_row_f32(const float* __restrict__ src, float (&v)[16], int lane) {
#pragma unroll
  for (int hh = 0; hh < 2; ++hh) {
    const int c = col0<LAYOUT>(lane, hh);
    const f32x4 a = *(const f32x4*)(src + c), b = *(const f32x4*)(src + c + 4);
#pragma unroll
    for (int e = 0; e < 4; ++e) { v[hh * 8 + e] = a[e]; v[hh * 8 + 4 + e] = b[e]; }
  }
}

enum { EPI_PROJ = 0, EPI_VT = 1, EPI_OUT = 2, EPI_TOPK = 3, EPI_FOLD = 4 };

template <bool SWAP>
DI void gemm_mainloop(const u16* __restrict__ A, int lda, const u16* __restrict__ Bt, int ldb, int K, int m0, int n0, char* smem,
                      f32x4 (&acc)[4][4], int tid) {
  const int lane = tid & 63, wid = tid >> 6, wm = wid >> 1, wn = wid & 1;
  const int srow = tid >> 3, skc = tid & 7;
  const u16* ap = A + (size_t)(m0 + srow) * lda + skc * 8;
  const u16* bp = Bt + (size_t)(n0 + srow) * ldb + skc * 8;
  const int dst0 = (((srow >> 4) * 2 + (skc >> 2)) * 1024) + (((skc & 3) * 16 + (srow & 15)) * 16);
#pragma unroll
  for (int i = 0; i < 4; ++i)
#pragma unroll
    for (int j = 0; j < 4; ++j) acc[i][j] = (f32x4){0.f, 0.f, 0.f, 0.f};
  u32x4 ra[4], rb[4];
#pragma unroll
  for (int j = 0; j < 4; ++j) { ra[j] = *(const u32x4*)(ap + (size_t)j * 32 * lda); rb[j] = *(const u32x4*)(bp + (size_t)j * 32 * ldb); }
#pragma unroll
  for (int j = 0; j < 4; ++j) { *(u32x4*)(smem + dst0 + j * 4096) = ra[j]; *(u32x4*)(smem + 16384 + dst0 + j * 4096) = rb[j]; }
  __syncthreads();
  const int KT = K >> 6;
  for (int kt = 0; kt < KT; ++kt) {
    char* cur = smem + (kt & 1) * 32768;
    char* nxt = smem + ((kt + 1) & 1) * 32768;
    const bool more = (kt + 1 < KT);
    if (more) {
      const u16* ap2 = ap + (kt + 1) * 64;
      const u16* bp2 = bp + (kt + 1) * 64;
#pragma unroll
      for (int j = 0; j < 4; ++j) { ra[j] = *(const u32x4*)(ap2 + (size_t)j * 32 * lda); rb[j] = *(const u32x4*)(bp2 + (size_t)j * 32 * ldb); }
    }
#pragma unroll
    for (int ks = 0; ks < 2; ++ks) {
      bf16x8 af[4], bfr[4];
#pragma unroll
      for (int i = 0; i < 4; ++i) af[i] = *(const bf16x8*)(cur + (((wm * 4 + i) * 2 + ks) * 1024) + lane * 16);
#pragma unroll
      for (int j = 0; j < 4; ++j) bfr[j] = *(const bf16x8*)(cur + 16384 + (((wn * 4 + j) * 2 + ks) * 1024) + lane * 16);
#pragma unroll
      for (int i = 0; i < 4; ++i)
#pragma unroll
        for (int j = 0; j < 4; ++j) acc[i][j] = SWAP ? mfma16(bfr[j], af[i], acc[i][j]) : mfma16(af[i], bfr[j], acc[i][j]);
    }
    if (more) {
#pragma unroll
      for (int j = 0; j < 4; ++j) { *(u32x4*)(nxt + dst0 + j * 4096) = ra[j]; *(u32x4*)(nxt + 16384 + dst0 + j * 4096) = rb[j]; }
    }
    __syncthreads();
  }
}

DI void ce_desc(float& hi, float& lo) { const float a = hi, b = lo; hi = fmaxf(a, b); lo = fminf(a, b); }
DI void bitonic_merge16(float (&v)[16]) {
#pragma unroll
  for (int j = 8; j > 0; j >>= 1)
#pragma unroll
    for (int i = 0; i < 16; ++i) if ((i & j) == 0) ce_desc(v[i], v[i | j]);
}
DI void bitonic_sort16(float (&v)[16]) {
#pragma unroll
  for (int k = 2; k <= 16; k <<= 1)
#pragma unroll
    for (int j = k >> 1; j > 0; j >>= 1)
#pragma unroll
      for (int i = 0; i < 16; ++i) {
        const int l = i ^ j;
        if (l > i) { if ((i & k) == 0 || k == 16) ce_desc(v[i], v[l]); else ce_desc(v[l], v[i]); }
      }
}
DI void merge_top16(float (&v)[16], const float (&w)[16]) {
#pragma unroll
  for (int i = 0; i < 16; ++i) v[i] = fmaxf(v[i], w[15 - i]);
  bitonic_merge16(v);
}
DI void insert16(float (&v)[16], float x) {
#pragma unroll
  for (int j = 0; j < 16; ++j) { const float hi = fmaxf(v[j], x); x = fminf(v[j], x); v[j] = hi; }
}

DI void gemm_tile_fold(const u16* A, int lda, const u16* Bt, int ldb, int K, int m0, char* smem, u16* dstT, int tid) {
  const int lane = tid & 63, wid = tid >> 6, wm = wid >> 1, wn = wid & 1, g = lane >> 4, l15 = lane & 15;
  f32x4 acc[4][4];
  gemm_mainloop<false>(A, lda, Bt, ldb, K, m0, 0, smem, acc, tid);
#pragma unroll
  for (int i = 0; i < 4; ++i)
#pragma unroll
    for (int j = 0; j < 4; ++j) {
      const int m = m0 + wm * 64 + 16 * i + 4 * g, n = wn * 64 + 16 * j + l15;
      u32x2 o; o[0] = pack2(acc[i][j][0], acc[i][j][1]); o[1] = pack2(acc[i][j][2], acc[i][j][3]);
      *(u32x2*)(dstT + (size_t)n * 1024 + m) = o;
    }
}

#define GK 1024
#define HTB 16384
DI int lds_byte(int r, int c) {
  const int st = (r >> 4) * 2 + (c >> 5), rr = r & 15, cc = c & 31, ob = rr * 64 + cc * 2;
  return st * 1024 + (ob ^ (((ob >> 9) & 1) << 5));
}
DI void stage_rc(int b, int& R, int& C) {
  const int st = b / 1024, sb = b % 1024, swz = sb ^ (((sb >> 9) & 1) << 5);
  R = (st >> 1) * 16 + swz / 64; C = (st & 1) * 32 + (swz % 64) / 2;
}
#define G_SA(b, h) (shm + ((b) * 2 + (h)) * HTB)
#define G_SB(b, h) (shm + (4 + (b) * 2 + (h)) * HTB)
#define G_STAGE_(P, BASE, br, kt, O0, O1) do { const char* _g = (const char*)((BASE) + (size_t)(br) * GK + (kt) * 64); \
    __builtin_amdgcn_global_load_lds((const unsigned*)(_g + (O0)), (LAS unsigned*)((P) + tid * 16), 16, 0, 0); \
    __builtin_amdgcn_global_load_lds((const unsigned*)(_g + (O1)), (LAS unsigned*)((P) + tid * 16 + 8192), 16, 0, 0); } while (0)
#define G_STAGEA(P, BASE, br, kt) G_STAGE_(P, BASE, br, kt, goffA0, goffA1)
#define G_STAGEB(P, BASE, br, kt) G_STAGE_(P, BASE, br, kt, goff0, goff1)
#define G_LDA(dst, b, h) _Pragma("unroll") for (int m = 0; m < 4; ++m) _Pragma("unroll") for (int k = 0; k < 2; ++k) \
    dst[m][k] = *(const LAS bf16x8*)(G_SA(b, h) + lds_byte(wr * 64 + m * 16 + fr, k * 32 + fq * 8))
#define G_LDB(dst, b, h) _Pragma("unroll") for (int n = 0; n < 2; ++n) _Pragma("unroll") for (int k = 0; k < 2; ++k) \
    dst[n][k] = *(const LAS bf16x8*)(G_SB(b, h) + lds_byte(wc * 32 + n * 16 + fr, k * 32 + fq * 8))
#define G_MMA(ai, bj, At, Bx) do { __builtin_amdgcn_s_setprio(1); \
    _Pragma("unroll") for (int m = 0; m < 4; ++m) _Pragma("unroll") for (int n = 0; n < 2; ++n) _Pragma("unroll") for (int k = 0; k < 2; ++k) \
      acc[ai][bj][m][n] = __builtin_amdgcn_mfma_f32_16x16x32_bf16(At[m][k], Bx[n][k], acc[ai][bj][m][n], 0, 0, 0); \
    __builtin_amdgcn_s_setprio(0); } while (0)
#define WAIT_V(n) asm volatile("s_waitcnt vmcnt(" #n ")" ::: "memory")
#define WAIT_L(n) asm volatile("s_waitcnt lgkmcnt(" #n ")" ::: "memory")
#define BAR __builtin_amdgcn_s_barrier()
#define SCHED __builtin_amdgcn_sched_barrier(0)

DI int perm64(int rho) { return ((rho >> 2) & 3) * 16 + (rho >> 4) * 4 + (rho & 3); }
DI void gemm256_core(const u16* __restrict__ A, const u16* __restrict__ Bt, int brow, int bcol, lchar* shm, int tid, f32x4 (&acc)[2][2][4][2], bool permA) {
  const int wid = tid >> 6, lane = tid & 63, wr = wid >> 2, wc = wid & 3, fr = lane & 15, fq = lane >> 4;
  int r0, c0, r1, c1;
  stage_rc(tid * 16, r0, c0); stage_rc(tid * 16 + 8192, r1, c1);
  const unsigned goff0 = (unsigned)(r0 * GK + c0) * 2u, goff1 = (unsigned)(r1 * GK + c1) * 2u;
  const int pr0 = permA ? ((r0 & 64) | perm64(r0 & 63)) : r0, pr1 = permA ? ((r1 & 64) | perm64(r1 & 63)) : r1;
  const unsigned goffA0 = (unsigned)(pr0 * GK + c0) * 2u, goffA1 = (unsigned)(pr1 * GK + c1) * 2u;
#pragma unroll
  for (int ai = 0; ai < 2; ++ai)
#pragma unroll
    for (int bj = 0; bj < 2; ++bj)
#pragma unroll
      for (int m = 0; m < 4; ++m)
#pragma unroll
        for (int n = 0; n < 2; ++n) acc[ai][bj][m][n] = (f32x4){0.f, 0.f, 0.f, 0.f};
  bf16x8 At[4][2], B0[2][2], B1[2][2];
  const int nt = GK / 64;
  WAIT_V(0);
  __syncthreads();
  G_STAGEB(G_SB(0, 0), Bt, bcol, 0); G_STAGEA(G_SA(0, 0), A, brow, 0);
  G_STAGEB(G_SB(0, 1), Bt, bcol + 128, 0); G_STAGEA(G_SA(0, 1), A, brow + 128, 0);
  if (wr == 1) BAR;
  WAIT_V(4); BAR;
  G_STAGEB(G_SB(1, 0), Bt, bcol, 1); G_STAGEA(G_SA(1, 0), A, brow, 1); G_STAGEB(G_SB(1, 1), Bt, bcol + 128, 1);
  WAIT_V(6); BAR;
  for (int t = 0; t < nt - 2; t += 2) {
    G_LDB(B0, 0, 0); SCHED; G_LDA(At, 0, 0); G_STAGEA(G_SA(1, 1), A, brow + 128, t + 1);
    WAIT_L(8); BAR; WAIT_L(0); G_MMA(0, 0, At, B0); BAR; SCHED;
    G_LDB(B1, 0, 1); G_STAGEB(G_SB(0, 0), Bt, bcol, t + 2);
    BAR; WAIT_L(0); G_MMA(0, 1, At, B1); BAR;
    G_LDA(At, 0, 1); G_STAGEA(G_SA(0, 0), A, brow, t + 2);
    BAR; WAIT_L(0); G_MMA(1, 0, At, B0); BAR; SCHED;
    G_STAGEB(G_SB(0, 1), Bt, bcol + 128, t + 2);
    WAIT_V(6); BAR; G_MMA(1, 1, At, B1); BAR;
    G_LDB(B0, 1, 0); SCHED; G_LDA(At, 1, 0); G_STAGEA(G_SA(0, 1), A, brow + 128, t + 2);
    WAIT_L(8); BAR; WAIT_L(0); G_MMA(0, 0, At, B0); BAR; SCHED;
    G_LDB(B1, 1, 1); G_STAGEB(G_SB(1, 0), Bt, bcol, t + 3);
    BAR; WAIT_L(0); G_MMA(0, 1, At, B1); BAR;
    G_LDA(At, 1, 1); G_STAGEA(G_SA(1, 0), A, brow, t + 3);
    BAR; WAIT_L(0); G_MMA(1, 0, At, B0); BAR; SCHED;
    G_STAGEB(G_SB(1, 1), Bt, bcol + 128, t + 3);
    WAIT_V(6); BAR; G_MMA(1, 1, At, B1); BAR;
  }
  { G_LDB(B0, 0, 0); G_LDA(At, 0, 0); G_STAGEA(G_SA(1, 1), A, brow + 128, nt - 1);
    BAR; WAIT_L(0); G_MMA(0, 0, At, B0); BAR;
    G_LDB(B1, 0, 1); BAR; WAIT_L(0); G_MMA(0, 1, At, B1); BAR;
    G_LDA(At, 0, 1); WAIT_V(4); BAR; WAIT_L(0); G_MMA(1, 0, At, B0); G_MMA(1, 1, At, B1); BAR; }
  { G_LDB(B0, 1, 0); G_LDA(At, 1, 0); WAIT_V(2); BAR; WAIT_L(0); G_MMA(0, 0, At, B0); BAR;
    G_LDB(B1, 1, 1); WAIT_V(0); BAR; WAIT_L(0); G_MMA(0, 1, At, B1); BAR;
    G_LDA(At, 1, 1); BAR; WAIT_L(0); G_MMA(1, 0, At, B0); G_MMA(1, 1, At, B1); BAR; }
  if (wr == 0) BAR;
}

DI void gemm256_tile(const Params& p, int mode, int layer, const u16* R, const u16* Cc, int brow, int bcol, lchar* shm, int tid_in) {
  f32x4 acc[2][2][4][2];
  gemm256_core(R, Cc, brow, bcol, shm, tid_in, acc, true);
  int tid = tid_in;
  asm volatile("" : "+v"(tid));
  const int wid = tid >> 6, lane = tid & 63, wr = wid >> 2, wc = wid & 3, fr = lane & 15, fq = lane >> 4;
  if (mode == EPI_PROJ) {
#pragma unroll
    for (int ai = 0; ai < 2; ++ai)
#pragma unroll
      for (int bj = 0; bj < 2; ++bj)
#pragma unroll
        for (int n = 0; n < 2; ++n) {
          const int nc = brow + ai * 128 + wr * 64 + fq * 16, tok = bcol + bj * 128 + wc * 32 + n * 16 + fr;
          u16* dst = W_PROJ(p) + (size_t)tok * INC + nc;
#pragma unroll
          for (int q = 0; q < 2; ++q) {
            const f32x4 va = acc[ai][bj][2 * q][n], vb2 = acc[ai][bj][2 * q + 1][n];
            *(u32x4*)(dst + 8 * q) = (u32x4){pack2(va[0], va[1]), pack2(va[2], va[3]), pack2(vb2[0], vb2[1]), pack2(vb2[2], vb2[3])};
          }
        }
  } else if (mode == EPI_VT) {
#pragma unroll
    for (int ai = 0; ai < 2; ++ai)
#pragma unroll
      for (int bj = 0; bj < 2; ++bj)
#pragma unroll
        for (int n = 0; n < 2; ++n) {
          const int tok = brow + ai * 128 + wr * 64 + fq * 16, nn = bcol + bj * 128 + wc * 32 + n * 16 + fr - 1024;
          const int b = tok / LSEQ, pos = tok - b * LSEQ;
          u16* dst = W_VT(p) + ((size_t)(b * 512 + nn)) * LP + pos;
#pragma unroll
          for (int q = 0; q < 2; ++q) {
            const f32x4 va = acc[ai][bj][2 * q][n], vb2 = acc[ai][bj][2 * q + 1][n];
            *(u32x4*)(dst + 8 * q) = (u32x4){pack2(va[0], va[1]), pack2(va[2], va[3]), pack2(vb2[0], vb2[1]), pack2(vb2[2], vb2[3])};
          }
        }
  } else if (mode == EPI_OUT) {
#pragma unroll
    for (int ai = 0; ai < 2; ++ai)
#pragma unroll
      for (int bj = 0; bj < 2; ++bj) {
        u32x4 hv[2][2];
#pragma unroll
        for (int n = 0; n < 2; ++n) {
          const int nc = brow + ai * 128 + wr * 64 + fq * 16, tok = bcol + bj * 128 + wc * 32 + n * 16 + fr;
          hv[n][0] = *(const u32x4*)(W_H(p) + (size_t)tok * DM + nc); hv[n][1] = *(const u32x4*)(W_H(p) + (size_t)tok * DM + nc + 8);
        }
#pragma unroll
        for (int n = 0; n < 2; ++n) {
          const int nc = brow + ai * 128 + wr * 64 + fq * 16, tok = bcol + bj * 128 + wc * 32 + n * 16 + fr;
          u16* dst = W_Y(p) + (size_t)tok * DM + nc;
#pragma unroll
          for (int q = 0; q < 2; ++q) {
            const f32x4 va = acc[ai][bj][2 * q][n], vb2 = acc[ai][bj][2 * q + 1][n];
            const u32x4 hh = hv[n][q];
            *(u32x4*)(dst + 8 * q) = (u32x4){pack2(ALPHA * bflo(hh[0]) + va[0], ALPHA * bfhi(hh[0]) + va[1]), pack2(ALPHA * bflo(hh[1]) + va[2], ALPHA * bfhi(hh[1]) + va[3]),
                                            pack2(ALPHA * bflo(hh[2]) + vb2[0], ALPHA * bfhi(hh[2]) + vb2[1]), pack2(ALPHA * bflo(hh[3]) + vb2[2], ALPHA * bfhi(hh[3]) + vb2[3])};
          }
        }
      }
  } else {
    LAS float* S = (LAS float*)shm;
    const int tok = tid & 255, kh = tid >> 8;
    float L0[16], L1[16];
#pragma unroll
    for (int ai = 0; ai < 2; ++ai) {
      __syncthreads();
#pragma unroll
      for (int bj = 0; bj < 2; ++bj)
#pragma unroll
        for (int m = 0; m < 4; ++m)
#pragma unroll
          for (int n = 0; n < 2; ++n) {
            const int tk = bj * 128 + wc * 32 + n * 16 + fr, key = wr * 64 + fq * 16 + m * 4;
            *(LAS f32x4*)((lchar*)S + tk * 528 + key * 4) = acc[ai][bj][m][n];
          }
      __syncthreads();
      float v[16];
#pragma unroll 1
      for (int ch = 0; ch < 4; ++ch) {
        float wk[16];
#pragma unroll
        for (int q = 0; q < 4; ++q) {
          const int key = kh * 64 + ch * 16 + 4 * q;
          const f32x4 xv = *(const LAS f32x4*)((lchar*)S + tok * 528 + key * 4);
#pragma unroll
          for (int e = 0; e < 4; ++e) wk[4 * q + e] = __uint_as_float((__float_as_uint(xv[e]) & ~127u) | (unsigned)(key + e));
        }
        bitonic_sort16(wk);
        if (ch == 0) {
#pragma unroll
          for (int i = 0; i < 16; ++i) v[i] = wk[i];
        } else {
          merge_top16(v, wk);
        }
      }
      __syncthreads();
      if (kh == 1) {
#pragma unroll
        for (int q = 0; q < 4; ++q) *(LAS f32x4*)((lchar*)S + tok * 80 + 16 * q) = (f32x4){v[4 * q], v[4 * q + 1], v[4 * q + 2], v[4 * q + 3]};
      }
      __syncthreads();
      if (kh == 0) {
        float wk[16];
#pragma unroll
        for (int q = 0; q < 4; ++q) {
          const f32x4 xv = *(const LAS f32x4*)((lchar*)S + tok * 80 + 16 * q);
          wk[4 * q] = xv[0]; wk[4 * q + 1] = xv[1]; wk[4 * q + 2] = xv[2]; wk[4 * q + 3] = xv[3];
        }
        merge_top16(v, wk);
      }
#pragma unroll
      for (int j = 0; j < 16; ++j) { if (ai == 0) L0[j] = v[j]; else L1[j] = v[j]; }
    }
    __syncthreads();
    LAS unsigned* LL = (LAS unsigned*)shm;
    if (kh == 0) {
#pragma unroll
      for (int j = 0; j < 16; ++j) { LL[tok * 32 + ((j + tok) & 31)] = __float_as_uint(L0[j]); LL[tok * 32 + ((16 + j + tok) & 31)] = __float_as_uint(L1[j]); }
      float s1[16], s2[16], v[16];
#pragma unroll
      for (int j = 0; j < 16; ++j) { s1[j] = __uint_as_float(__float_as_uint(L0[j]) & ~127u); s2[j] = __uint_as_float(__float_as_uint(L1[j]) & ~127u); v[j] = -3.0e38f; }
#pragma unroll
      for (int ch = 0; ch < 4; ++ch) {
        float wk[16];
#pragma unroll
        for (int i = 0; i < 16; ++i) {
          constexpr unsigned char PAIRS[64] = {0, 1, 2, 3, 4, 5, 6, 7, 8, 9, 10, 11, 12, 13, 14, 15, 16, 17, 18, 19, 20, 21, 22, 23, 32, 33, 34, 35, 36, 48, 49, 50, 51, 64, 65, 66, 80, 81, 96, 97, 112, 113, 128, 144, 160, 176, 192, 208, 224, 240, 255, 255, 255, 255, 255, 255, 255, 255, 255, 255, 255, 255, 255, 255};
          const int code = PAIRS[ch * 16 + i];
          if (code == 255) { wk[i] = -3.0e38f; }
          else { const float sm = s1[code >> 4] + s2[code & 15]; wk[i] = __uint_as_float((__float_as_uint(sm) & ~255u) | (unsigned)code); }
        }
        if (ch == 0) {
#pragma unroll
          for (int i = 0; i < 16; ++i) v[i] = wk[i];
        } else {
          bitonic_sort16(wk);
          merge_top16(v, wk);
        }
      }
      float e[16], sum = 0.f;
      const float mx = __uint_as_float(__float_as_uint(v[0]) & ~255u);
#pragma unroll
      for (int j = 0; j < 16; ++j) { e[j] = fast_exp2((__uint_as_float(__float_as_uint(v[j]) & ~255u) - mx) * LOG2E); sum += e[j]; }
      const float inv = 1.0f / sum;
      const int hd = brow >> 8;
      u16* di = W_IDX(p) + (size_t)(bcol + tok) * 128 + hd * 16;
      float* dg = W_G(p) + (size_t)(bcol + tok) * 128 + hd * 16;
      unsigned eid[16];
#pragma unroll
      for (int k = 0; k < 16; ++k) {
        const unsigned code = __float_as_uint(v[k]) & 255u;
        const unsigned i1 = LL[tok * 32 + (((code >> 4) + tok) & 31)] & 127u, i2 = LL[tok * 32 + ((16 + (code & 15u) + tok) & 31)] & 127u;
        eid[k] = i1 * 128u + i2;
      }
#pragma unroll
      for (int q = 0; q < 4; ++q) *(f32x4*)(dg + 4 * q) = (f32x4){e[4 * q] * inv, e[4 * q + 1] * inv, e[4 * q + 2] * inv, e[4 * q + 3] * inv};
#pragma unroll
      for (int q = 0; q < 2; ++q)
        *(u32x4*)(di + 8 * q) = (u32x4){eid[8 * q] | (eid[8 * q + 1] << 16), eid[8 * q + 2] | (eid[8 * q + 3] << 16), eid[8 * q + 4] | (eid[8 * q + 5] << 16), eid[8 * q + 6] | (eid[8 * q + 7] << 16)};
    }
    __syncthreads();
  }
}

#define ATT_MISC 131072
DI void attn_item(const Params& p, int layer, int b, int hh, int jq, lchar* sm, float lam, float oml, int tid) {
  const int lane = tid & 63, w = tid >> 6, g = lane >> 4, l15 = lane & 15;
  const int idx32 = (lane ^ 32) << 2;
  LAS float* tab = (LAS float*)(sm + ATT_MISC);
  LAS float* sg = tab + 208;
  __syncthreads();
  if (tid < 208) {
    const int d = tid - 80;
    float tv = -1.0e30f;
    if (d >= 0) {
      int bucket = d;
      if (d >= 16) {
        int lg = 16 + (int)(logf((float)d * (1.0f / 16.0f)) / 2.0794415416798357f * 16.0f);
        bucket = lg < 31 ? lg : 31;
      }
      tv = P_REL_BIAS(p)[bucket * 4 + hh] * LOG2E;
    }
    tab[tid] = tv;
    if (tid < 128) sg[tid] = P_SUBLN_G(p)[layer * 128 + tid] * oml;
  }
  const int q0w = 128 * jq + 16 * w;
  const int qpos = q0w + l15;
  const int qrow = b * LSEQ + (qpos < LSEQ ? qpos : LSEQ - 1);
  bf16x8 qf[2][2];
  {
    const u16* qp = W_PROJ(p) + (size_t)qrow * INC + hh * 128 + g * 8;
#pragma unroll
    for (int m = 0; m < 2; ++m)
#pragma unroll
      for (int ks = 0; ks < 2; ++ks) {
        const u32x4 raw = *(const u32x4*)(qp + m * 64 + ks * 32);
        u32x4 sc;
#pragma unroll
        for (int e = 0; e < 4; ++e) sc[e] = pack2(bflo(raw[e]) * (0.125f * LOG2E), bfhi(raw[e]) * (0.125f * LOG2E));
        qf[m][ks] = __builtin_bit_cast(bf16x8, sc);
      }
  }
  const int nkt = (2 * jq + 2) < 33 ? (2 * jq + 2) : 33;
  const char* ksrc[2]; const char* vsrc[2];
#pragma unroll
  for (int i = 0; i < 2; ++i) {
    const int bk = 2 * w + i, k16 = bk >> 2, m = (bk >> 1) & 1, ks = bk & 1;
    const int krow = 32 * (k16 >> 1) + 8 * (l15 >> 2) + 4 * (k16 & 1) + (l15 & 3);
    ksrc[i] = (const char*)(W_PROJ(p) + (size_t)(b * LSEQ + krow) * INC + 512 + hh * 128 + m * 64 + ks * 32 + g * 8);
    const int dv = 8 * bk + (lane >> 3), c = (lane & 7) ^ ((dv >> 1) & 7);
    vsrc[i] = (const char*)(W_VT(p) + ((size_t)((b * 4 + hh) * 128 + dv)) * LP + c * 8);
  }
  lchar* dmak = sm + (2 * w) * 1024 + lane * 16;
#define ATT_ISSUE(KT, SLOT) do { const size_t _ko = (size_t)(KT) * (64 * INC * 2), _vo = (size_t)(KT) * 128; lchar* _d = dmak + (SLOT) * 32768; \
    __builtin_amdgcn_global_load_lds((const unsigned*)(ksrc[0] + _ko), (LAS unsigned*)(_d), 16, 0, 0); \
    __builtin_amdgcn_global_load_lds((const unsigned*)(ksrc[1] + _ko), (LAS unsigned*)(_d + 1024), 16, 0, 0); \
    __builtin_amdgcn_global_load_lds((const unsigned*)(vsrc[0] + _vo), (LAS unsigned*)(_d + 16384), 16, 0, 0); \
    __builtin_amdgcn_global_load_lds((const unsigned*)(vsrc[1] + _vo), (LAS unsigned*)(_d + 16384 + 1024), 16, 0, 0); } while (0)
  int voff[2];
#pragma unroll
  for (int kk = 0; kk < 2; ++kk) voff[kk] = l15 * 128 + (((4 * kk + g) ^ ((l15 >> 1) & 7)) * 16);

  f32x4 O[2][8];
#pragma unroll
  for (int m = 0; m < 2; ++m)
#pragma unroll
    for (int dt = 0; dt < 8; ++dt) O[m][dt] = (f32x4){0.f, 0.f, 0.f, 0.f};
  float mrun[2] = {0.f, 0.f};
  f32x4 Osum[2] = {(f32x4){0.f, 0.f, 0.f, 0.f}, (f32x4){0.f, 0.f, 0.f, 0.f}};
  bf16x8 ones;
  { const short o1 = (l15 == 0) ? (short)0x3f80 : (short)0; ones = (bf16x8){o1, o1, o1, o1, o1, o1, o1, o1}; }

  WAIT_V(0);
  __syncthreads();
  const float tfar = tab[207];
  ATT_ISSUE(0, 0);
  ATT_ISSUE((1 < nkt ? 1 : nkt - 1), 1);
  for (int kt = 0; kt < nkt; ++kt) {
    { const int kn = (kt + 2 < nkt) ? kt + 2 : nkt - 1; ATT_ISSUE(kn, (kt + 2) & 3); }
    WAIT_V(8); BAR;
    if (64 * kt <= q0w + 15) {
      const lchar* kb = sm + (kt & 3) * 32768;
      const lchar* vb = kb + 16384;
      const bool near = (q0w - 64 * kt) < 176;
      const float tadd = near ? 0.f : tfar;
      const float sinit[2] = {tadd - mrun[0], tadd - mrun[1]};
      f32x4 S[2][4];
#pragma unroll
      for (int kh = 0; kh < 2; ++kh) {
        bf16x8 kf[2][2][2];
#pragma unroll
        for (int q = 0; q < 2; ++q)
#pragma unroll
          for (int m = 0; m < 2; ++m)
#pragma unroll
            for (int ks = 0; ks < 2; ++ks) kf[q][m][ks] = *(const LAS bf16x8*)(kb + ((((2 * kh + q) * 2 + m) * 2 + ks) * 1024) + lane * 16);
        SCHED;
#pragma unroll
        for (int q = 0; q < 2; ++q)
#pragma unroll
          for (int m = 0; m < 2; ++m) {
            f32x4 sacc = (f32x4){sinit[m], sinit[m], sinit[m], sinit[m]};
            sacc = mfma16(kf[q][m][0], qf[m][0], sacc);
            sacc = mfma16(kf[q][m][1], qf[m][1], sacc);
            S[m][2 * kh + q] = sacc;
          }
      }
      if (near) {
#pragma unroll
        for (int m = 0; m < 2; ++m)
#pragma unroll
          for (int k16 = 0; k16 < 4; ++k16)
#pragma unroll
            for (int r = 0; r < 4; ++r) {
              const int di = qpos + 80 - (64 * kt + 32 * (k16 >> 1) + 8 * g + 4 * (k16 & 1) + r);
              S[m][k16][r] += tab[di < 207 ? di : 207];
            }
      }
      bf16x8 pb[2][2];
#pragma unroll
      for (int m = 0; m < 2; ++m) {
        float mx = fmaxf(fmaxf(S[m][0][0], S[m][0][1]), fmaxf(S[m][0][2], S[m][0][3]));
#pragma unroll
        for (int k16 = 1; k16 < 4; ++k16) mx = fmaxf(fmaxf(mx, fmaxf(S[m][k16][0], S[m][k16][1])), fmaxf(S[m][k16][2], S[m][k16][3]));
        mx = fmaxf(mx, shx16(mx));
        mx = fmaxf(mx, shx32(mx, idx32));
        if (kt == 0 || __builtin_amdgcn_ballot_w64(mx > 8.0f) != 0ull) {
          const float dlt = kt == 0 ? mx : fmaxf(mx, 0.f);
          const float alpha = fast_exp2(-dlt);
          mrun[m] += dlt;
#pragma unroll
          for (int dt = 0; dt < 8; ++dt) { O[m][dt][0] *= alpha; O[m][dt][1] *= alpha; O[m][dt][2] *= alpha; O[m][dt][3] *= alpha; }
          Osum[m][0] *= alpha; Osum[m][1] *= alpha; Osum[m][2] *= alpha; Osum[m][3] *= alpha;
#pragma unroll
          for (int k16 = 0; k16 < 4; ++k16)
#pragma unroll
            for (int r = 0; r < 4; ++r) S[m][k16][r] -= dlt;
        }
#pragma unroll
        for (int k16 = 0; k16 < 4; ++k16)
#pragma unroll
          for (int r = 0; r < 4; ++r) S[m][k16][r] = fast_exp2(S[m][k16][r]);
#pragma unroll
        for (int kk = 0; kk < 2; ++kk) {
          u32x4 t;
          t[0] = pack2(S[m][2 * kk][0], S[m][2 * kk][1]); t[1] = pack2(S[m][2 * kk][2], S[m][2 * kk][3]);
          t[2] = pack2(S[m][2 * kk + 1][0], S[m][2 * kk + 1][1]); t[3] = pack2(S[m][2 * kk + 1][2], S[m][2 * kk + 1][3]);
          pb[m][kk] = __builtin_bit_cast(bf16x8, t);
          Osum[m] = mfma16(ones, pb[m][kk], Osum[m]);
        }
      }
#pragma unroll
      for (int kk = 0; kk < 2; ++kk) {
        bf16x8 vf[8];
#pragma unroll
        for (int dt = 0; dt < 8; ++dt) vf[dt] = *(const LAS bf16x8*)(vb + dt * 2048 + voff[kk]);
        SCHED;
#pragma unroll
        for (int dt = 0; dt < 8; ++dt) {
          O[0][dt] = mfma16(vf[dt], pb[0][kk], O[0][dt]);
          O[1][dt] = mfma16(vf[dt], pb[1][kk], O[1][dt]);
        }
      }
    }
  }
  WAIT_V(0);
#undef ATT_ISSUE
  float l0 = g == 0 ? Osum[0][0] : 0.f, l1 = g == 0 ? Osum[1][0] : 0.f;
  l0 += shx16(l0); l0 += shx32(l0, idx32);
  l1 += shx16(l1); l1 += shx32(l1, idx32);
  const float c1 = 1.0f / l0, c2 = lam / l1;
  float ss = 0.f;
#pragma unroll
  for (int dt = 0; dt < 8; ++dt)
#pragma unroll
    for (int r = 0; r < 4; ++r) { const float o = O[0][dt][r] * c1 - O[1][dt][r] * c2; O[0][dt][r] = o; ss += o * o; }
  ss += shx16(ss); ss += shx32(ss, idx32);
  const float rinv = rsqrtf(ss * (1.0f / 128.0f) + 1e-5f);
  if (qpos < LSEQ) {
    u16* dst = W_MIX(p) + (size_t)(b * LSEQ + qpos) * DM + hh * 128 + 4 * g;
#pragma unroll
    for (int dt = 0; dt < 8; ++dt) {
      const int dv0 = 16 * dt + 4 * g;
      u32x2 o;
      o[0] = pack2(O[0][dt][0] * rinv * sg[dv0 + 0], O[0][dt][1] * rinv * sg[dv0 + 1]);
      o[1] = pack2(O[0][dt][2] * rinv * sg[dv0 + 2], O[0][dt][3] * rinv * sg[dv0 + 3]);
      *(u32x2*)(dst + 16 * dt) = o;
    }
  }
}

DI void conv_item(const Params& p, int layer, int item, int tid) {
  const int ch = (tid & 63) * 8, t0 = item * 16 + 4 * (tid >> 6);
  const int pos0 = t0 % LSEQ;
  const bool head = pos0 == 0;
  const u16* row0 = W_PROJ(p) + (size_t)t0 * INC;
  u32x4 gc[6], zz[6], gb[4];
#pragma unroll
  for (int j = 0; j < 6; ++j) {
    const u16* r2 = row0 + (ptrdiff_t)((head && j < 2) ? 0 : (j - 2)) * INC;
    gc[j] = *(const u32x4*)(r2 + 2048 + ch); zz[j] = *(const u32x4*)(r2 + 2560 + ch);
  }
#pragma unroll
  for (int i = 0; i < 4; ++i) gb[i] = *(const u32x4*)(row0 + (size_t)i * INC + 1536 + ch);
  const float* cw = P_CONV_W(p) + (size_t)layer * 3 * 512 + ch;
  float w0[8], w1[8], w2[8];
#pragma unroll
  for (int e = 0; e < 8; ++e) { w0[e] = cw[e]; w1[e] = cw[512 + e]; w2[e] = cw[1024 + e]; }
  float pr[6][8];
#pragma unroll
  for (int j = 0; j < 6; ++j) {
    const float keep = (head && j < 2) ? 0.f : 1.f;
#pragma unroll
    for (int e = 0; e < 4; ++e) { pr[j][2 * e] = keep * bflo(gc[j][e]) * bflo(zz[j][e]); pr[j][2 * e + 1] = keep * bfhi(gc[j][e]) * bfhi(zz[j][e]); }
  }
#pragma unroll
  for (int i = 0; i < 4; ++i) {
    u32x4 o;
#pragma unroll
    for (int e = 0; e < 4; ++e) {
      const float a0 = w0[2 * e] * pr[i][2 * e] + w1[2 * e] * pr[i + 1][2 * e] + w2[2 * e] * pr[i + 2][2 * e];
      const float a1 = w0[2 * e + 1] * pr[i][2 * e + 1] + w1[2 * e + 1] * pr[i + 1][2 * e + 1] + w2[2 * e + 1] * pr[i + 2][2 * e + 1];
      o[e] = pack2(bflo(gb[i][e]) * a0, bfhi(gb[i][e]) * a1);
    }
    *(u32x4*)(W_MIX(p) + (size_t)(t0 + i) * DM + 512 + ch) = o;
  }
}

DI void phase_prologue(const Params& p, char* smem, int wave) {
  const int tid = otid_w(wave), lane = tid & 63, wid = tid >> 6, hb = tid >> 8, htid = tid & 255;
  const int nblk = gridDim.x, bid = blockIdx.x;
  const size_t gtid = (size_t)bid * NTHREADS + tid, gthreads = (size_t)nblk * NTHREADS;
  float* sm = (float*)(smem + hb * LDS_HALF);
  for (int it0 = bid; it0 < 2048; it0 += nblk) {
    const int it = it0 * 2 + hb;
    if (it < 3072) {
      const int l = it / 768, r = it % 768, kb = r / 48, nb = r % 48;
      transpose_tile(P_W_IN(p) + (size_t)l * 1024 * 3072, 3072, W_WIN(p) + (size_t)l * 3072 * 1024, 1024, kb * 64, nb * 64, sm, htid);
    } else {
      const int i2 = it - 3072, l = i2 / 256, r = i2 % 256, kb = r / 16, nb = r % 16;
      transpose_tile(P_W_OUT(p) + (size_t)l * 1024 * 1024, 1024, W_WOUT(p) + (size_t)l * 1024 * 1024, 1024, kb * 64, nb * 64, sm, htid);
    }
  }
  convert_straight(P_W_Q(p), W_WQB(p), (size_t)4 * 1024 * 2048 / 8, gtid, gthreads);
  convert_straight(P_SUB_KEYS(p), W_SKB(p), (size_t)4 * 16 * 128 * 128 / 8, gtid, gthreads);
  for (int t = bid * 8 + wid; t < TTOK; t += nblk * 8) {
    const int b = t / LSEQ, pos = t - b * LSEQ;
    const float* src = pos < NMETA ? P_META(p) + (size_t)pos * DM : P_X(p) + ((size_t)b * SEQ + pos - NMETA) * DM;
    float v[16];
    load_row_f32<0>(src, v, lane);
    ln_row<0>(v, P_LN_IN_G(p), P_LN_IN_B(p), lane);
    store_row_bf16<0>(W_H(p) + (size_t)t * DM, v, lane);
  }
}

DI void phase_fold(const Params& p, char* smem, int wave) {
  const int tid = otid_w(wave), hb = tid >> 8, htid = tid & 255;
  for (int it0 = blockIdx.x; it0 < 256; it0 += gridDim.x) {
    const int it = it0 * 2 + hb;
    const int l = it >> 7, hp = (it >> 3) & 15, mt = it & 7;
    gemm_tile_fold(W_WQB(p) + (size_t)l * 1024 * 2048 + hp * 128, 2048, W_SKB(p) + ((size_t)l * 16 + hp) * 128 * 128, 128, 128, mt * 128, smem + hb * 65536,
                   W_WSC(p) + (size_t)l * 2048 * 1024 + (size_t)hp * 128 * 1024, htid);
  }
}

DI bool tile_order(int i, int nM, int nN, int& pm, int& pn) {
  const int nwg = nM * nN;
  const long L = (long)i * gridDim.x + blockIdx.x;
  if (L >= nwg) return false;
  int wgid = (int)L;
  { const int q = nwg / 8, r = nwg % 8, xcd = wgid % 8, off = wgid / 8; wgid = (xcd < r ? xcd * (q + 1) : r * (q + 1) + (xcd - r) * q) + off; }
  const int nig = 8 * nN, gid = wgid / nig, fm = gid * 8, gsz = (nM - fm) < 8 ? (nM - fm) : 8;
  pm = fm + ((wgid % nig) % gsz); pn = (wgid % nig) / gsz;
  return true;
}

DI void convert_tables(const Params& p, int layer, int lane, int slot, int nslots) {
  for (int r = slot; r < 2 * PEER_N; r += nslots) {

    const bool isv = r >= PEER_N;
    const int e = isv ? r - PEER_N : r;
    const float* src = (isv ? P_PEER_V(p) : P_PEER_U(p)) + ((size_t)layer * PEER_N + e) * DM + 16 * lane;
    f32x4 a[4];
#pragma unroll
    for (int k = 0; k < 4; ++k) a[k] = *(const f32x4*)(src + 4 * k);
    float am = 0.f;
#pragma unroll
    for (int k = 0; k < 4; ++k) am = fmaxf(am, fmaxf(fmaxf(fabsf(a[k][0]), fabsf(a[k][1])), fmaxf(fabsf(a[k][2]), fabsf(a[k][3]))));
    am = wave_max_nonneg(am);
    const float top = isv ? 224.0f : 127.0f;
    const float sc = am > 0.f ? top / am : 1.0f;
    if (lane == 0) (isv ? W_SV(p) : W_SU(p))[e] = am > 0.f ? am / top : 1.0f;
    u32x4 o;
#pragma unroll
    for (int k = 0; k < 4; ++k) {
      if (isv) {
        int w = 0;
        w = __builtin_amdgcn_cvt_pk_fp8_f32(a[k][0] * sc, a[k][1] * sc, w, false);
        w = __builtin_amdgcn_cvt_pk_fp8_f32(a[k][2] * sc, a[k][3] * sc, w, true);
        o[k] = (unsigned)w;
      } else {
        const int q0 = __float2int_rn(a[k][0] * sc), q1 = __float2int_rn(a[k][1] * sc), q2 = __float2int_rn(a[k][2] * sc), q3 = __float2int_rn(a[k][3] * sc);
        o[k] = ((unsigned)q0 & 255u) | (((unsigned)q1 & 255u) << 8) | (((unsigned)q2 & 255u) << 16) | ((unsigned)q3 << 24);
      }
    }
    *(u32x4*)((isv ? W_VB(p) : W_UB(p)) + (size_t)(lane >> 3) * (PEER_N * 128) + (size_t)e * 128 + 16 * (lane & 7)) = o;
  }
}

DI void phase_gemm(const Params& p, int layer, int which, char* smem, int wave) {
  const int tid0 = otid_w(wave);
  const u16* W = which == 0 ? W_WIN(p) + (size_t)layer * 3072 * 1024 : (which == 1 ? W_WOUT(p) + (size_t)layer * 1024 * 1024 : W_WSC(p) + (size_t)layer * 2048 * 1024);
  const u16* X = which == 1 ? W_MIX(p) : W_H(p);
  const int nN = which == 0 ? 12 : (which == 1 ? 4 : 8);
  int pm, pn;
  for (int i = 0; tile_order(i, 258, nN, pm, pn); ++i) {
    const bool vt = (which == 0) && (pn == 4 || pn == 5);
    const int mode = which == 0 ? (vt ? EPI_VT : EPI_PROJ) : (which == 1 ? EPI_OUT : EPI_TOPK);
    int tid = tid0;
    asm volatile("" : "+v"(tid));
    gemm256_tile(p, mode, layer, vt ? X : W, vt ? W : X, vt ? pm * 256 : pn * 256, vt ? pn * 256 : pm * 256, (lchar*)smem, tid);
  }
  if (which == 1) {
    const int rem = (258 * 4) % (int)gridDim.x, nidle = (int)gridDim.x - rem;
    if ((int)blockIdx.x >= rem) convert_tables(p, layer, tid0 & 63, ((int)blockIdx.x - rem) * 8 + (tid0 >> 6), nidle * 8);
  }
}

DI void phase_attn(const Params& p, int layer, char* smem, int wave) {
  const int tid = otid_w(wave), lane = tid & 63, hb = tid >> 8, htid = tid & 255;
  const float lam_init = 0.8f - 0.6f * expf(-0.3f * (float)layer);
  float d1 = P_LQ1(p)[layer * 64 + lane] * P_LK1(p)[layer * 64 + lane], d2 = P_LQ2(p)[layer * 64 + lane] * P_LK2(p)[layer * 64 + lane];
  d1 = wave_sum(d1); d2 = wave_sum(d2);
  const float lam = expf(d1) - expf(d2) + lam_init;
  for (int rd = 0; rd * (int)gridDim.x < 2176; ++rd) {
    const int o = rd * gridDim.x + ((rd & 1) ? (int)gridDim.x - 1 - (int)blockIdx.x : (int)blockIdx.x);
    if (o < 2176) { const int jq = 16 - (o >> 7), bh = o & 127; attn_item(p, layer, bh >> 2, bh & 3, jq, (lchar*)smem, lam, 1.0f - lam_init, tid); }
  }
  for (int it = blockIdx.x; it < 2064; it += gridDim.x) conv_item(p, layer, it * 2 + hb, htid);
}

DI void phase_ln(const Params& p, int layer, int which, int wave) {
  const int tid = otid_w(wave), lane = tid & 63, wid = tid >> 6;
  const int stride = gridDim.x * 8;
  const float* lg = (which ? P_LN2_G(p) : P_LN1_G(p)) + layer * DM;
  const float* lb = (which ? P_LN2_B(p) : P_LN1_B(p)) + layer * DM;
  const bool final_out = which && (layer == DEPTH - 1);
  float gg[16], bb[16];
#pragma unroll
  for (int hh = 0; hh < 2; ++hh) {
    const int c = hh * 512 + 8 * lane;
    const f32x4 g0 = *(const f32x4*)(lg + c), g1 = *(const f32x4*)(lg + c + 4), b0 = *(const f32x4*)(lb + c), b1 = *(const f32x4*)(lb + c + 4);
#pragma unroll
    for (int e = 0; e < 4; ++e) { gg[hh * 8 + e] = g0[e]; gg[hh * 8 + 4 + e] = g1[e]; bb[hh * 8 + e] = b0[e]; bb[hh * 8 + 4 + e] = b1[e]; }
  }
  const int t0 = blockIdx.x * 8 + wid;
#define LN_LOAD(T, RA, RB) do { const int _t = (T) < TTOK ? (T) : t0; const u16* _s = W_Y(p) + (size_t)_t * DM + 8 * lane; \
    RA = *(const u32x4*)(_s); RB = *(const u32x4*)(_s + 512); } while (0)
#define LN_ROW(T, RA, RB) do { if ((T) < TTOK) { float v[16]; \
    _Pragma("unroll") for (int e = 0; e < 4; ++e) { v[2 * e] = bflo(RA[e]); v[2 * e + 1] = bfhi(RA[e]); v[8 + 2 * e] = bflo(RB[e]); v[8 + 2 * e + 1] = bfhi(RB[e]); } \
    float sm = 0.f; _Pragma("unroll") for (int i = 0; i < 16; ++i) sm += v[i]; \
    const float mu = wave_sum(sm) * (1.0f / 1024.0f); \
    float q = 0.f; _Pragma("unroll") for (int i = 0; i < 16; ++i) { const float d = v[i] - mu; q += d * d; } \
    const float rstd = rsqrtf(wave_sum(q) * (1.0f / 1024.0f) + 1e-5f); \
    _Pragma("unroll") for (int i = 0; i < 16; ++i) v[i] = (v[i] - mu) * rstd * gg[i] + bb[i]; \
    if (final_out) { const int b = (T) / LSEQ, pos = (T) - b * LSEQ; \
      if (pos >= NMETA) { float* dst = p.out + ((size_t)b * SEQ + pos - NMETA) * DM; \
        _Pragma("unroll") for (int hh = 0; hh < 2; ++hh) { \
          *(f32x4*)(dst + hh * 512 + 8 * lane) = (f32x4){v[hh * 8], v[hh * 8 + 1], v[hh * 8 + 2], v[hh * 8 + 3]}; \
          *(f32x4*)(dst + hh * 512 + 8 * lane + 4) = (f32x4){v[hh * 8 + 4], v[hh * 8 + 5], v[hh * 8 + 6], v[hh * 8 + 7]}; } } \
    } else { store_row_bf16<0>(W_H(p) + (size_t)(T) * DM, v, lane); } } } while (0)
  u32x4 rAa, rAb, rBa, rBb;
  LN_LOAD(t0, rAa, rAb);
  for (int t = t0; t < TTOK; t += 2 * stride) {
    LN_LOAD(t + stride, rBa, rBb);
    LN_ROW(t, rAa, rAb);
    LN_LOAD(t + 2 * stride, rAa, rAb);
    LN_ROW(t + stride, rBa, rBb);
  }
#undef LN_LOAD
#undef LN_ROW
}

#define DPP_F(v, ctrl) __int_as_float(__builtin_amdgcn_update_dpp(0, __float_as_int(v), (ctrl), 0xf, 0xf, true))
#define PEER_META(T, IA, IB, HA, HB) do { const int _t = (T) < TTOK ? (T) : wslot; \
    IA = *(const u32x4*)(W_IDX(p) + (size_t)_t * 128 + r * 16); IB = *(const u32x4*)(W_IDX(p) + (size_t)_t * 128 + r * 16 + 8); \
    const u16* _hp = W_H(p) + (size_t)_t * DM + x * 128 + 16 * c; HA = *(const u32x4*)(_hp); HB = *(const u32x4*)(_hp + 8); } while (0)
#define PEER_GATHER(TAB, IA, IB, RR) do { _Pragma("unroll") for (int g = 0; g < 16; ++g) { \
    const unsigned _w = (g < 8 ? IA : IB)[(g >> 1) & 3]; const unsigned _e = (g & 1) ? (_w >> 16) : (_w & 0xffffu); RR[g] = *(const u32x4*)((TAB) + (_e * 128u + c16)); } } while (0)
#define PEER_UNPACK(XS, HA, HB) do { _Pragma("unroll") for (int e = 0; e < 4; ++e) { \
    XS[e] = (f32x2){bflo(HA[e]), bfhi(HA[e])}; XS[4 + e] = (f32x2){bflo(HB[e]), bfhi(HB[e])}; } } while (0)

#define DPP_I(v, ctrl) __builtin_amdgcn_update_dpp(0, (v), (ctrl), 0xf, 0xf, true)
DI int reduce_scatter8(int d0, int d1, int d2, int d3, int d4, int d5, int d6, int d7, int c) {
  const bool b2 = c >= 4, b1 = (c & 2) != 0, b0 = (c & 1) != 0;
  const int e0 = (b2 ? d4 : d0) + DPP_I(b2 ? d0 : d4, 0x141);
  const int e1 = (b2 ? d5 : d1) + DPP_I(b2 ? d1 : d5, 0x141);
  const int e2 = (b2 ? d6 : d2) + DPP_I(b2 ? d2 : d6, 0x141);
  const int e3 = (b2 ? d7 : d3) + DPP_I(b2 ? d3 : d7, 0x141);
  const int f0 = (b1 ? e2 : e0) + DPP_I(b1 ? e0 : e2, 0x4E);
  const int f1 = (b1 ? e3 : e1) + DPP_I(b1 ? e1 : e3, 0x4E);
  return (b0 ? f1 : f0) + DPP_I(b0 ? f0 : f1, 0xB1);
}
DI void phase_peer_dots(const Params& p, int layer, int wave) {
  const int tid = otid_w(wave), lane = tid & 63, wid = tid >> 6, c = lane & 7, r = lane >> 3;
  const int x = blockIdx.x & 7, wslot = (blockIdx.x >> 3) * 8 + wid, nslot = (gridDim.x >> 3) * 8;
  const unsigned char* ub = W_UB(p) + (size_t)x * (PEER_N * 128);
  const unsigned c16 = (unsigned)c * 16u;
  u16* pd = W_Y(p);
  u32x4 iAa, iBa, iAb, iBb;
  u32x4 hAa, hBa, hAb, hBb, rrA[16], rrB[16];
  int xq[4];
  float xscale;
#define DOTS_QUANT(HA, HB) do { float _xv[16]; \
    _Pragma("unroll") for (int e = 0; e < 4; ++e) { _xv[2 * e] = bflo(HA[e]); _xv[2 * e + 1] = bfhi(HA[e]); _xv[8 + 2 * e] = bflo(HB[e]); _xv[8 + 2 * e + 1] = bfhi(HB[e]); } \
    float _am = 0.f; _Pragma("unroll") for (int e = 0; e < 16; ++e) _am = fmaxf(_am, fabsf(_xv[e])); \
    _am = DPP_MAX(_am, 0xB1); _am = DPP_MAX(_am, 0x4E); _am = DPP_MAX(_am, 0x141); \
    const float _qs = _am > 0.f ? 127.0f / _am : 0.f; xscale = _am * (1.0f / 127.0f); \
    _Pragma("unroll") for (int k = 0; k < 4; ++k) { \
      const int q0 = __float2int_rn(_xv[4 * k] * _qs), q1 = __float2int_rn(_xv[4 * k + 1] * _qs), q2 = __float2int_rn(_xv[4 * k + 2] * _qs), q3 = __float2int_rn(_xv[4 * k + 3] * _qs); \
      xq[k] = (int)(((unsigned)q0 & 255u) | (((unsigned)q1 & 255u) << 8) | (((unsigned)q2 & 255u) << 16) | ((unsigned)q3 << 24)); } } while (0)
#define DOTS_COMPUTE(T, RR) do { if ((T) < TTOK) { int dd[16]; \
    _Pragma("unroll") for (int g = 0; g < 16; ++g) { int d = 0; \
      _Pragma("unroll") for (int k = 0; k < 4; ++k) d = __builtin_amdgcn_sdot4((int)RR[g][k], xq[k], d, false); \
      dd[g] = d; } \
    const int pA = reduce_scatter8(dd[0], dd[1], dd[2], dd[3], dd[4], dd[5], dd[6], dd[7], c); \
    const int pB = reduce_scatter8(dd[8], dd[9], dd[10], dd[11], dd[12], dd[13], dd[14], dd[15], c); \
    u16* _dst = pd + ((size_t)(T) * 8 + x) * 128 + r * 16 + c;        \
    _dst[0] = (u16)(pack2((float)pA * xscale, 0.f) & 0xffffu); _dst[8] = (u16)(pack2((float)pB * xscale, 0.f) & 0xffffu); } } while (0)
  int t = wslot;
  PEER_META(t, iAa, iBa, hAa, hBa);
  PEER_META(t + nslot, iAb, iBb, hAb, hBb);
  PEER_GATHER(ub, iAa, iBa, rrA);
  for (; t < TTOK; t += 2 * nslot) {
    DOTS_QUANT(hAa, hBa);
    PEER_META(t + 2 * nslot, iAa, iBa, hAa, hBa);
    PEER_GATHER(ub, iAb, iBb, rrB);
    DOTS_COMPUTE(t, rrA);
    DOTS_QUANT(hAb, hBb);
    PEER_META(t + 3 * nslot, iAb, iBb, hAb, hBb);
    PEER_GATHER(ub, iAa, iBa, rrA);
    DOTS_COMPUTE(t + nslot, rrB);
  }
#undef DOTS_COMPUTE
#undef DOTS_QUANT
}

DI void phase_peer_w(const Params& p, int layer, int wave) {
  const int tid = otid_w(wave), lane = tid & 63, wid = tid >> 6;
  const u16* pd = W_Y(p);
  const int stride = gridDim.x * 8, t0 = blockIdx.x * 8 + wid;
  for (int t = t0; t < TTOK; t += 2 * stride) {
    unsigned pv[2][8], iv[2];
    f32x2 gv[2];
#pragma unroll
    for (int u = 0; u < 2; ++u) {
      const int tu = (t + u * stride) < TTOK ? (t + u * stride) : t0;
#pragma unroll
      for (int xx = 0; xx < 8; ++xx) pv[u][xx] = *(const unsigned*)(pd + ((size_t)tu * 8 + xx) * 128 + 2 * lane);
      iv[u] = *(const unsigned*)(W_IDX(p) + (size_t)tu * 128 + 2 * lane);
      gv[u] = *(const f32x2*)(W_G(p) + (size_t)tu * 128 + 2 * lane);
    }
#pragma unroll
    for (int u = 0; u < 2; ++u) {
      const int tu = t + u * stride;
      if (tu < TTOK) {
        float s0 = 0.f, s1 = 0.f;
#pragma unroll
        for (int xx = 0; xx < 8; ++xx) { s0 += bflo(pv[u][xx]); s1 += bfhi(pv[u][xx]); }
        const int e0 = (int)(iv[u] & 0xffffu), e1 = (int)(iv[u] >> 16);
        const float a0 = s0 * W_SU(p)[e0], a1 = s1 * W_SU(p)[e1];
        const float w0 = gv[u][0] * (0.5f * a0 * (1.0f + erff(a0 * 0.7071067811865476f))) * W_SV(p)[e0];
        const float w1 = gv[u][1] * (0.5f * a1 * (1.0f + erff(a1 * 0.7071067811865476f))) * W_SV(p)[e1];
        *(unsigned*)(W_W16(p) + (size_t)tu * 128 + 2 * lane) = pack2(w0, w1);
      }
    }
  }
}

#define PEER_META_V(T, IA, IB, WA, WB, HR) do { const int _t = (T) < TTOK ? (T) : wslot; \
    IA = *(const u32x4*)(W_IDX(p) + (size_t)_t * 128 + r * 16); IB = *(const u32x4*)(W_IDX(p) + (size_t)_t * 128 + r * 16 + 8); \
    WA = *(const u32x4*)(W_W16(p) + (size_t)_t * 128 + r * 16); WB = *(const u32x4*)(W_W16(p) + (size_t)_t * 128 + r * 16 + 8); \
    HR = *(const u32x2*)(W_H(p) + (size_t)_t * DM + ocol); } while (0)
DI float swap32_add(float a, float b) {
  const u32x2 r = __builtin_amdgcn_permlane32_swap(__float_as_uint(a), __float_as_uint(b), false, false);
  return __uint_as_float(r[0]) + __uint_as_float(r[1]);
}
DI float swap16_add(float a, float b) {
  const u32x2 r = __builtin_amdgcn_permlane16_swap(__float_as_uint(a), __float_as_uint(b), false, false);
  return __uint_as_float(r[0]) + __uint_as_float(r[1]);
}
DI void phase_peer_v(const Params& p, int layer, int wave) {
  const int tid = otid_w(wave), lane = tid & 63, wid = tid >> 6, c = lane & 7, r = lane >> 3;
  const int x = blockIdx.x & 7, wslot = (blockIdx.x >> 3) * 8 + wid, nslot = (gridDim.x >> 3) * 8;
  const unsigned char* vb = W_VB(p) + (size_t)x * (PEER_N * 128);
  const unsigned c16 = (unsigned)c * 16u;
  u16* y2 = W_Y(p);
  const int ocol = x * 128 + 16 * c + 4 * ((lane >> 4) & 1) + 8 * (lane >> 5);
  u32x4 iAa, iBa, iAb, iBb;
  u32x4 wAa, wBa, wAb, wBb, wA, wB;
  u32x2 hRa, hRb, hR;
  u32x4 rrA[16], rrB[16];
#define V_COMPUTE(T, RR) do { if ((T) < TTOK) { f32x2 acc[8]; \
    _Pragma("unroll") for (int i = 0; i < 8; ++i) acc[i] = (f32x2){0.f, 0.f}; \
    _Pragma("unroll") for (int g = 0; g < 16; ++g) { \
      const unsigned _ww = (g < 8 ? wA : wB)[(g >> 1) & 3]; const float wj = (g & 1) ? bfhi(_ww) : bflo(_ww); \
      const f32x2 wj2 = (f32x2){wj, wj}; \
      _Pragma("unroll") for (int k = 0; k < 4; ++k) { \
        const f32x2 lo = __builtin_amdgcn_cvt_pk_f32_fp8((int)RR[g][k], false), hi = __builtin_amdgcn_cvt_pk_f32_fp8((int)RR[g][k], true); \
        acc[2 * k] += wj2 * lo; acc[2 * k + 1] += wj2 * hi; } } \
    float P8[8], Q4[4]; \
    _Pragma("unroll") for (int i = 0; i < 8; ++i) P8[i] = swap32_add(acc[i >> 1][i & 1], acc[(i + 8) >> 1][i & 1]);     \
    _Pragma("unroll") for (int i = 0; i < 4; ++i) Q4[i] = swap16_add(P8[i], P8[i + 4]);                                 \
    _Pragma("unroll") for (int i = 0; i < 4; ++i) Q4[i] += DPP_F(Q4[i], 0x128);                                         \
    if ((lane & 8) == 0) { u32x2 _o; \
      _o[0] = pack2(ALPHA * bflo(hR[0]) + Q4[0], ALPHA * bfhi(hR[0]) + Q4[1]); \
      _o[1] = pack2(ALPHA * bflo(hR[1]) + Q4[2], ALPHA * bfhi(hR[1]) + Q4[3]); \
      *(u32x2*)(y2 + (size_t)(T) * DM + ocol) = _o; } } } while (0)
  int t = wslot;
  PEER_META_V(t, iAa, iBa, wAa, wBa, hRa);
  PEER_META_V(t + nslot, iAb, iBb, wAb, wBb, hRb);
  PEER_GATHER(vb, iAa, iBa, rrA);
  for (; t < TTOK; t += 2 * nslot) {
    wA = wAa; wB = wBa; hR = hRa;
    PEER_META_V(t + 2 * nslot, iAa, iBa, wAa, wBa, hRa);
    PEER_GATHER(vb, iAb, iBb, rrB);
    V_COMPUTE(t, rrA);
    wA = wAb; wB = wBb; hR = hRb;
    PEER_META_V(t + 3 * nslot, iAb, iBb, wAb, wBb, hRb);
    PEER_GATHER(vb, iAa, iBa, rrA);
    V_COMPUTE(t + nslot, rrB);
  }
#undef V_COMPUTE
}

#define XB_TMO      128
#define XB_XCNT(j)  (256  + 64 * (j))
#define XB_XSUB(j)  (1280 + 64 * (j))
#define XB_XGEN(j)  (2304 + 64 * (j))
#define XB_TOP      3328
#define XB_TOPGEN   3392
#define XCD_BAR_WORDS 3456
#define XB_SPIN_CAP (1u << 22)
DI unsigned xb_ld(unsigned* p)              { return __hip_atomic_load(p, __ATOMIC_RELAXED, __HIP_MEMORY_SCOPE_AGENT); }
DI unsigned xb_add(unsigned* p, unsigned v) { return __hip_atomic_fetch_add(p, v, __ATOMIC_RELAXED, __HIP_MEMORY_SCOPE_AGENT); }
DI unsigned xb_xcc_id() { return (unsigned)__builtin_amdgcn_s_getreg((3 << 11) | 20) & 0xFu; }
#define XB_SPIN(cond, bar) do { unsigned _sp = 0; while (cond) { __builtin_amdgcn_s_sleep(1); \
    if ((++_sp & 255u) == 0u) { if (xb_ld(&(bar)[XB_TMO])) break; if (_sp > XB_SPIN_CAP) { atomicAdd(&(bar)[XB_TMO], 1u); break; } } } } while (0)
DI bool is_thread0(int wave) { unsigned z = 0u; asm volatile("" : "+v"(z)); return wave == 0 && __builtin_amdgcn_mbcnt_hi(~0u, __builtin_amdgcn_mbcnt_lo(~0u, z)) == 0u; }
DI void xcd_barrier_complete(unsigned* bar, unsigned x, unsigned& nloc, unsigned& nx) {
  const unsigned G = gridDim.x;
  unsigned sum, cnt, mine, sp = 0u;
  for (;;) {
    sum = 0u; cnt = 0u; mine = 0u;
#pragma unroll
    for (unsigned j = 0; j < 16; ++j) { const unsigned c = xb_ld(&bar[XB_XCNT(j)]); sum += c; cnt += (c > 0u) ? 1u : 0u; mine = (j == x) ? c : mine; }
    if (sum == G) break;
    __builtin_amdgcn_s_sleep(1);
    if ((++sp & 255u) == 0u) { if (xb_ld(&bar[XB_TMO])) break; if (sp > XB_SPIN_CAP) { atomicAdd(&bar[XB_TMO], 1u); break; } }
  }
  nloc = mine > 0u ? mine : 1u; nx = cnt > 0u ? cnt : 1u;
}
DI void xcd_barrier(unsigned* bar, volatile LAS unsigned* st, int wave) {
  asm volatile("s_waitcnt vmcnt(0)" ::: "memory");
  __syncthreads();
  if (is_thread0(wave)) {
    const unsigned x = xb_xcc_id();
    __builtin_amdgcn_s_waitcnt(0);
    unsigned nloc = st[0], nx = st[1];
    if (nloc == 0u) { xcd_barrier_complete(bar, x, nloc, nx); st[0] = nloc; st[1] = nx; }
    const unsigned old = xb_add(&bar[XB_XSUB(x)], 1u);
    const unsigned gen = old / nloc;
    if (old + 1u == (gen + 1u) * nloc) {
      __builtin_amdgcn_fence(__ATOMIC_RELEASE, "agent");
      asm volatile("s_waitcnt vmcnt(0)" ::: "memory");
      const unsigned og = xb_add(&bar[XB_TOP], 1u);
      const unsigned tg = og / nx;
      if (og + 1u == (tg + 1u) * nx) xb_add(&bar[XB_TOPGEN], 1u);
      else XB_SPIN(xb_ld(&bar[XB_TOPGEN]) == tg, bar);
      __builtin_amdgcn_fence(__ATOMIC_ACQUIRE, "agent");
      xb_add(&bar[XB_XGEN(x)], 1u);
      asm volatile("s_waitcnt vmcnt(0)" ::: "memory");
    } else {
      XB_SPIN(xb_ld(&bar[XB_XGEN(x)]) == gen, bar);
      __builtin_amdgcn_fence(__ATOMIC_ACQUIRE, "agent");
      asm volatile("s_waitcnt vmcnt(0)" ::: "memory");
    }
  }
  __syncthreads();
}

__global__ void __launch_bounds__(NTHREADS, 2) mega(Params p) {
  extern __shared__ __attribute__((aligned(16))) char smem[];
  cg::grid_group grid = cg::this_grid();
  const int wave = __builtin_amdgcn_readfirstlane((int)(threadIdx.x >> 6));
  unsigned* bar = (unsigned*)(p.ws + WS_BAR);
  volatile LAS unsigned* st = (volatile LAS unsigned*)((lchar*)smem + LDS_XB);
  if (threadIdx.x == 0) { st[0] = 0u; st[1] = 0u; (void)xb_add(&bar[XB_XCNT(xb_xcc_id())], 1u); }
  __syncthreads();
  phase_prologue(p, smem, wave);
  grid.sync();
  phase_fold(p, smem, wave);
  xcd_barrier(bar, st, wave);
#pragma unroll 1
  for (int step = 0; step < DEPTH * 9; ++step) {
    const int layer = step / 9, ph = step - layer * 9;
    if (ph == 0 || ph == 2 || ph == 4) phase_gemm(p, layer, ph >> 1, smem, wave);
    else if (ph == 1) phase_attn(p, layer, smem, wave);
    else if (ph == 3 || ph == 8) phase_ln(p, layer, ph == 8, wave);
    else if (ph == 5) phase_peer_dots(p, layer, wave);
    else if (ph == 6) phase_peer_w(p, layer, wave);
    else phase_peer_v(p, layer, wave);
    if (step + 1 < DEPTH * 9) xcd_barrier(bar, st, wave);
  }
}

extern "C" void kernel_launch(void* const* d_in, const int* in_sizes, int n_in, void* d_out, int out_size, void* d_ws, size_t ws_size,
                              hipStream_t stream) {
  static int grid_blocks = 0;
  if (grid_blocks == 0) {
    if (ws_size < WS_END) { fprintf(stderr, "kernel_launch: workspace too small: need %zu, got %zu\n", (size_t)WS_END, ws_size); grid_blocks = -1; return; }
    int dev = 0, cus = 0, per_cu = 0;
    hipGetDevice(&dev);
    hipDeviceGetAttribute(&cus, hipDeviceAttributeMultiprocessorCount, dev);
    hipFuncSetAttribute((const void*)mega, hipFuncAttributeMaxDynamicSharedMemorySize, LDS_BYTES);
    hipOccupancyMaxActiveBlocksPerMultiprocessor(&per_cu, (const void*)mega, NTHREADS, LDS_BYTES);
    if (per_cu < 1) per_cu = 1;
    if (per_cu > 1) per_cu = 1;
    grid_blocks = cus * per_cu;
  }
  if (grid_blocks < 0) return;
  Params p{};
  for (int i = 0; i < 21; ++i) p.in[i] = (const float*)d_in[i];
  p.out = (float*)d_out;
  p.ws = (char*)d_ws;
  if (hipMemsetAsync((char*)d_ws + WS_BAR, 0, 16384, stream) != hipSuccess) { fprintf(stderr, "kernel_launch: memset of the barrier words failed\n"); return; }
  void* args[] = {&p};
  hipError_t e = hipLaunchCooperativeKernel((const void*)mega, dim3(grid_blocks), dim3(NTHREADS), args, LDS_BYTES, stream);
  if (e != hipSuccess) fprintf(stderr, "cooperative launch failed: %s (grid %d)\n", hipGetErrorString(e), grid_blocks);
}
```

```cpp
#include <hip/hip_runtime.h>
#include <hip/hip_cooperative_groups.h>
#include <cstdio>
#include <cstdint>
namespace cg = cooperative_groups;

typedef unsigned short u16;
typedef __attribute__((ext_vector_type(8))) short bf16x8;
typedef __attribute__((ext_vector_type(4))) float f32x4;
typedef __attribute__((ext_vector_type(4))) unsigned u32x4;
typedef __attribute__((ext_vector_type(2))) unsigned u32x2;
typedef __attribute__((ext_vector_type(2))) float f32x2;
#define DI __device__ __forceinline__
#define LAS __attribute__((address_space(3)))
typedef LAS char lchar;

#define DM 1024
#define NBATCH 32
#define SEQ 2048
#define NMETA 16
#define LSEQ 2064
#define TTOK 66048
#define DEPTH 4
#define INC 3072
#define LP 2112
#define PEER_N 16384
#define NTHREADS 512
#define LDS_MISC 69632
#define LDS_HALF 70656
#define LDS_XB 141312
#define LDS_BYTES 141328

#define ALPHA 1.681792830507429f
#define LOG2E 1.4426950408889634f

static constexpr size_t WS_WIN  = 0;
static constexpr size_t WS_WOUT = WS_WIN  + (size_t)4 * 3072 * 1024 * 2;
static constexpr size_t WS_WQB  = WS_WOUT + (size_t)4 * 1024 * 1024 * 2;
static constexpr size_t WS_SKB  = WS_WQB  + (size_t)4 * 1024 * 2048 * 2;
static constexpr size_t WS_WSC  = WS_SKB  + (size_t)4 * 16 * 128 * 128 * 2;
static constexpr size_t WS_UB   = WS_WSC  + (size_t)4 * 2048 * 1024 * 2;
static constexpr size_t WS_VB   = WS_UB   + (size_t)PEER_N * 1024;
static constexpr size_t WS_SU   = WS_VB   + (size_t)PEER_N * 1024;
static constexpr size_t WS_SV   = WS_SU   + (size_t)PEER_N * 4;
static constexpr size_t WS_H    = WS_SV   + (size_t)PEER_N * 4;
static constexpr size_t WS_MIX  = WS_H    + (size_t)TTOK * 1024 * 2;
static constexpr size_t WS_BIG  = WS_MIX  + (size_t)TTOK * 1024 * 2;
static constexpr size_t WS_VT   = WS_BIG  + (size_t)(TTOK + 64) * 3072 * 2;
static constexpr size_t WS_IDX  = WS_VT   + (size_t)NBATCH * 4 * 128 * LP * 2;
static constexpr size_t WS_G    = WS_IDX  + (size_t)TTOK * 128 * 4;
static constexpr size_t WS_W16  = WS_G    + (size_t)TTOK * 128 * 4;
static constexpr size_t WS_BAR  = WS_W16  + (size_t)TTOK * 128 * 2;
static constexpr size_t WS_END  = WS_BAR  + 16384;

struct Params {
  const float* in[21];
  float* out;
  char* ws;
};
#define P_X(p) ((p).in[0])
#define P_META(p) ((p).in[1])
#define P_LN_IN_G(p) ((p).in[2])
#define P_LN_IN_B(p) ((p).in[3])
#define P_REL_BIAS(p) ((p).in[4])
#define P_W_IN(p) ((p).in[5])
#define P_CONV_W(p) ((p).in[6])
#define P_LQ1(p) ((p).in[7])
#define P_LK1(p) ((p).in[8])
#define P_LQ2(p) ((p).in[9])
#define P_LK2(p) ((p).in[10])
#define P_SUBLN_G(p) ((p).in[11])
#define P_W_OUT(p) ((p).in[12])
#define P_LN1_G(p) ((p).in[13])
#define P_LN1_B(p) ((p).in[14])
#define P_W_Q(p) ((p).in[15])
#define P_SUB_KEYS(p) ((p).in[16])
#define P_PEER_U(p) ((p).in[17])
#define P_PEER_V(p) ((p).in[18])
#define P_LN2_G(p) ((p).in[19])
#define P_LN2_B(p) ((p).in[20])
#define W_WIN(p) ((u16*)((p).ws + WS_WIN))
#define W_WOUT(p) ((u16*)((p).ws + WS_WOUT))
#define W_WQB(p) ((u16*)((p).ws + WS_WQB))
#define W_SKB(p) ((u16*)((p).ws + WS_SKB))
#define W_WSC(p) ((u16*)((p).ws + WS_WSC))
#define W_UB(p) ((unsigned char*)((p).ws + WS_UB))
#define W_VB(p) ((unsigned char*)((p).ws + WS_VB))
#define W_SU(p) ((float*)((p).ws + WS_SU))
#define W_SV(p) ((float*)((p).ws + WS_SV))
#define W_H(p) ((u16*)((p).ws + WS_H))
#define W_MIX(p) ((u16*)((p).ws + WS_MIX))
#define W_PROJ(p) ((u16*)((p).ws + WS_BIG))
#define W_Y(p) ((u16*)((p).ws + WS_BIG))
#define W_VT(p) ((u16*)((p).ws + WS_VT))
#define W_IDX(p) ((u16*)((p).ws + WS_IDX))
#define W_W16(p) ((u16*)((p).ws + WS_W16))
#define W_G(p) ((float*)((p).ws + WS_G))

DI u16 f2bf(float x) { unsigned u = __float_as_uint(x); u += 0x7fffu + ((u >> 16) & 1u); return (u16)(u >> 16); }
typedef __attribute__((ext_vector_type(2))) __bf16 bf16x2_t;
DI unsigned pack2(float a, float b) { const bf16x2_t v = {(__bf16)a, (__bf16)b}; return __builtin_bit_cast(unsigned, v); }
DI float bflo(unsigned w) { return __uint_as_float(w << 16); }
DI float bfhi(unsigned w) { return __uint_as_float(w & 0xffff0000u); }
DI int otid_w(int wave) { unsigned z = 0u; asm volatile("" : "+v"(z)); int t = wave * 64 + (int)__builtin_amdgcn_mbcnt_hi(~0u, __builtin_amdgcn_mbcnt_lo(~0u, z)); asm volatile("" : "+v"(t)); return t; }
#define DPP_ADD(v, ctrl) ((v) + __int_as_float(__builtin_amdgcn_update_dpp(0, __float_as_int(v), (ctrl), 0xf, 0xf, true)))
DI float wave_sum(float v) {
  v = DPP_ADD(v, 0xB1);
  v = DPP_ADD(v, 0x4E);
  v = DPP_ADD(v, 0x141);
  v = DPP_ADD(v, 0x140);
  const int iv = __float_as_int(v);
  return __int_as_float(__builtin_amdgcn_readlane(iv, 0)) + __int_as_float(__builtin_amdgcn_readlane(iv, 16)) +
         __int_as_float(__builtin_amdgcn_readlane(iv, 32)) + __int_as_float(__builtin_amdgcn_readlane(iv, 48));
}
#define DPP_MAX(v, ctrl) fmaxf((v), __int_as_float(__builtin_amdgcn_update_dpp(0, __float_as_int(v), (ctrl), 0xf, 0xf, true)))
DI float wave_max_nonneg(float v) {
  v = DPP_MAX(v, 0xB1); v = DPP_MAX(v, 0x4E); v = DPP_MAX(v, 0x141); v = DPP_MAX(v, 0x140);
  const int iv = __float_as_int(v);
  return fmaxf(fmaxf(__int_as_float(__builtin_amdgcn_readlane(iv, 0)), __int_as_float(__builtin_amdgcn_readlane(iv, 16))),
               fmaxf(__int_as_float(__builtin_amdgcn_readlane(iv, 32)), __int_as_float(__builtin_amdgcn_readlane(iv, 48))));
}
DI float shx16(float v) { return __int_as_float(__builtin_amdgcn_ds_swizzle(__float_as_int(v), 0x401F)); }
DI float shx32(float v, int idx32) { return __int_as_float(__builtin_amdgcn_ds_bpermute(idx32, __float_as_int(v))); }
DI f32x4 mfma16(bf16x8 a, bf16x8 b, f32x4 c) { return __builtin_amdgcn_mfma_f32_16x16x32_bf16(a, b, c, 0, 0, 0); }
DI float fast_exp2(float x) { return __builtin_amdgcn_exp2f(x); }

DI void convert_straight(const float* __restrict__ src, u16* __restrict__ dst, size_t n8, size_t gtid, size_t gthreads) {
  for (size_t i = gtid; i < n8; i += gthreads) {
    const f32x4 a = *(const f32x4*)(src + i * 8), b = *(const f32x4*)(src + i * 8 + 4);
    u32x4 o; o[0] = pack2(a[0], a[1]); o[1] = pack2(a[2], a[3]); o[2] = pack2(b[0], b[1]); o[3] = pack2(b[2], b[3]);
    *(u32x4*)(dst + i * 8) = o;
  }
}

DI void transpose_tile(const float* __restrict__ src, int ldn, u16* __restrict__ dst, int ldk, int k0, int n0, float* sm, int tid) {
#pragma unroll
  for (int i = 0; i < 4; ++i) {
    const int r = (tid >> 4) + 16 * i, c4 = tid & 15;
    const f32x4 v = *(const f32x4*)(src + (size_t)(k0 + r) * ldn + n0 + 4 * c4);
    sm[r * 65 + 4 * c4 + 0] = v[0]; sm[r * 65 + 4 * c4 + 1] = v[1]; sm[r * 65 + 4 * c4 + 2] = v[2]; sm[r * 65 + 4 * c4 + 3] = v[3];
  }
  __syncthreads();
#pragma unroll
  for (int i = 0; i < 2; ++i) {
    const int n = (tid >> 3) + 32 * i, kc = tid & 7;
    u32x4 o;
#pragma unroll
    for (int e = 0; e < 4; ++e) o[e] = pack2(sm[(8 * kc + 2 * e) * 65 + n], sm[(8 * kc + 2 * e + 1) * 65 + n]);
    *(u32x4*)(dst + (size_t)(n0 + n) * ldk + k0 + 8 * kc) = o;
  }
  __syncthreads();
}

template <int LAYOUT> DI int col0(int lane, int hh) { return LAYOUT ? 16 * lane + 8 * hh : hh * 512 + 8 * lane; }
template <int LAYOUT>
DI void ln_row(float (&v)[16], const float* __restrict__ g, const float* __restrict__ b, int lane) {
  float s = 0.f;
#pragma unroll
  for (int i = 0; i < 16; ++i) s += v[i];
  const float mu = wave_sum(s) * (1.0f / 1024.0f);
  float q = 0.f;
#pragma unroll
  for (int i = 0; i < 16; ++i) { const float d = v[i] - mu; q += d * d; }
  const float rstd = rsqrtf(wave_sum(q) * (1.0f / 1024.0f) + 1e-5f);
#pragma unroll
  for (int hh = 0; hh < 2; ++hh) {
    const int c = col0<LAYOUT>(lane, hh);
    const f32x4 g0 = *(const f32x4*)(g + c), g1 = *(const f32x4*)(g + c + 4), b0 = *(const f32x4*)(b + c), b1 = *(const f32x4*)(b + c + 4);
#pragma unroll
    for (int e = 0; e < 4; ++e) {
      v[hh * 8 + e] = (v[hh * 8 + e] - mu) * rstd * g0[e] + b0[e];
      v[hh * 8 + 4 + e] = (v[hh * 8 + 4 + e] - mu) * rstd * g1[e] + b1[e];
    }
  }
}
template <int LAYOUT>
DI void store_row_bf16(u16* __restrict__ dst, const float (&v)[16], int lane) {
#pragma unroll
  for (int hh = 0; hh < 2; ++hh) {
    u32x4 o;
#pragma unroll
    for (int e = 0; e < 4; ++e) o[e] = pack2(v[hh * 8 + 2 * e], v[hh * 8 + 2 * e + 1]);
    *(u32x4*)(dst + col0<LAYOUT>(lane, hh)) = o;
  }
}
template <int LAYOUT>
DI void load_row_bf16(const u16* __restrict__ src, float (&v)[16], int lane) {
#pragma unroll
  for (int hh = 0; hh < 2; ++hh) {
    const u32x4 a = *(const u32x4*)(src + col0<LAYOUT>(lane, hh));
#pragma unroll
    for (int e = 0; e < 4; ++e) { v[hh * 8 + 2 * e] = bflo(a[e]); v[hh * 8 + 2 * e + 1] = bfhi(a[e]); }
  }
}
template <int LAYOUT>
DI void load_row_f32(const float* __restrict__ src, float (&v)[16], int lane) {
#pragma unroll
  for (int hh = 0; hh < 2; ++hh) {
    const int c = col0<LAYOUT>(lane, hh);
    const f32x4 a = *(const f32x4*)(src + c), b = *(const f32x4*)(src + c + 4);
#pragma unroll
    for (int e = 0; e < 4; ++e) { v[hh * 8 + e] = a[e]; v[hh * 8 + 4 + e] = b[e]; }
  }
}

enum { EPI_PROJ = 0, EPI_VT = 1, EPI_OUT = 2, EPI_TOPK = 3, EPI_FOLD = 4 };

template <bool SWAP>
DI void gemm_mainloop(const u16* __restrict__ A, int lda, const u16* __restrict__ Bt, int ldb, int K, int m0, int n0, char* smem,
                      f32x4 (&acc)[4][4], int tid) {
  const int lane = tid & 63, wid = tid >> 6, wm = wid >> 1, wn = wid & 1;
  const int srow = tid >> 3, skc = tid & 7;
  const u16* ap = A + (size_t)(m0 + srow) * lda + skc * 8;
  const u16* bp = Bt + (size_t)(n0 + srow) * ldb + skc * 8;
  const int dst0 = (((srow >> 4) * 2 + (skc >> 2)) * 1024) + (((skc & 3) * 16 + (srow & 15)) * 16);
#pragma unroll
  for (int i = 0; i < 4; ++i)
#pragma unroll
    for (int j = 0; j < 4; ++j) acc[i][j] = (f32x4){0.f, 0.f, 0.f, 0.f};
  u32x4 ra[4], rb[4];
#pragma unroll
  for (int j = 0; j < 4; ++j) { ra[j] = *(const u32x4*)(ap + (size_t)j * 32 * lda); rb[j] = *(const u32x4*)(bp + (size_t)j * 32 * ldb); }
#pragma unroll
  for (int j = 0; j < 4; ++j) { *(u32x4*)(smem + dst0 + j * 4096) = ra[j]; *(u32x4*)(smem + 16384 + dst0 + j * 4096) = rb[j]; }
  __syncthreads();
  const int KT = K >> 6;
  for (int kt = 0; kt < KT; ++kt) {
    char* cur = smem + (kt & 1) * 32768;
    char* nxt = smem + ((kt + 1) & 1) * 32768;
    const bool more = (kt + 1 < KT);
    if (more) {
      const u16* ap2 = ap + (kt + 1) * 64;
      const u16* bp2 = bp + (kt + 1) * 64;
#pragma unroll
      for (int j = 0; j < 4; ++j) { ra[j] = *(const u32x4*)(ap2 + (size_t)j * 32 * lda); rb[j] = *(const u32x4*)(bp2 + (size_t)j * 32 * ldb); }
    }
#pragma unroll
    for (int ks = 0; ks < 2; ++ks) {
      bf16x8 af[4], bfr[4];
#pragma unroll
      for (int i = 0; i < 4; ++i) af[i] = *(const bf16x8*)(cur + (((wm * 4 + i) * 2 + ks) * 1024) + lane * 16);
#pragma unroll
      for (int j = 0; j < 4; ++j) bfr[j] = *(const bf16x8*)(cur + 16384 + (((wn * 4 + j) * 2 + ks) * 1024) + lane * 16);
#pragma unroll
      for (int i = 0; i < 4; ++i)
#pragma unroll
        for (int j = 0; j < 4; ++j) acc[i][j] = SWAP ? mfma16(bfr[j], af[i], acc[i][j]) : mfma16(af[i], bfr[j], acc[i][j]);
    }
    if (more) {
#pragma unroll
      for (int j = 0; j < 4; ++j) { *(u32x4*)(nxt + dst0 + j * 4096) = ra[j]; *(u32x4*)(nxt + 16384 + dst0 + j * 4096) = rb[j]; }
    }
    __syncthreads();
  }
}

DI void ce_desc(float& hi, float& lo) { const float a = hi, b = lo; hi = fmaxf(a, b); lo = fminf(a, b); }
DI void bitonic_merge16(float (&v)[16]) {
#pragma unroll
  for (int j = 8; j > 0; j >>= 1)
#pragma unroll
    for (int i = 0; i < 16; ++i) if ((i & j) == 0) ce_desc(v[i], v[i | j]);
}
DI void bitonic_sort16(float (&v)[16]) {
#pragma unroll
  for (int k = 2; k <= 16; k <<= 1)
#pragma unroll
    for (int j = k >> 1; j > 0; j >>= 1)
#pragma unroll
      for (int i = 0; i < 16; ++i) {
        const int l = i ^ j;
        if (l > i) { if ((i & k) == 0 || k == 16) ce_desc(v[i], v[l]); else ce_desc(v[l], v[i]); }
      }
}
DI void merge_top16(float (&v)[16], const float (&w)[16]) {
#pragma unroll
  for (int i = 0; i < 16; ++i) v[i] = fmaxf(v[i], w[15 - i]);
  bitonic_merge16(v);
}
DI void insert16(float (&v)[16], float x) {
#pragma unroll
  for (int j = 0; j < 16; ++j) { const float hi = fmaxf(v[j], x); x = fminf(v[j], x); v[j] = hi; }
}

DI void gemm_tile_fold(const u16* A, int lda, const u16* Bt, int ldb, int K, int m0, char* smem, u16* dstT, int tid) {
  const int lane = tid & 63, wid = tid >> 6, wm = wid >> 1, wn = wid & 1, g = lane >> 4, l15 = lane & 15;
  f32x4 acc[4][4];
  gemm_mainloop<false>(A, lda, Bt, ldb, K, m0, 0, smem, acc, tid);
#pragma unroll
  for (int i = 0; i < 4; ++i)
#pragma unroll
    for (int j = 0; j < 4; ++j) {
      const int m = m0 + wm * 64 + 16 * i + 4 * g, n = wn * 64 + 16 * j + l15;
      u32x2 o; o[0] = pack2(acc[i][j][0], acc[i][j][1]); o[1] = pack2(acc[i][j][2], acc[i][j][3]);
      *(u32x2*)(dstT + (size_t)n * 1024 + m) = o;
    }
}

#define GK 1024
#define HTB 16384
DI int lds_byte(int r, int c) {
  const int st = (r >> 4) * 2 + (c >> 5), rr = r & 15, cc = c & 31, ob = rr * 64 + cc * 2;
  return st * 1024 + (ob ^ (((ob >> 9) & 1) << 5));
}
DI void stage_rc(int b, int& R, int& C) {
  const int st = b / 1024, sb = b % 1024, swz = sb ^ (((sb >> 9) & 1) << 5);
  R = (st >> 1) * 16 + swz / 64; C = (st & 1) * 32 + (swz % 64) / 2;
}
#define G_SA(b, h) (shm + ((b) * 2 + (h)) * HTB)
#define G_SB(b, h) (shm + (4 + (b) * 2 + (h)) * HTB)
#define G_STAGE_(P, BASE, br, kt, O0, O1) do { const char* _g = (const char*)((BASE) + (size_t)(br) * GK + (kt) * 64); \
    __builtin_amdgcn_global_load_lds((const unsigned*)(_g + (O0)), (LAS unsigned*)((P) + tid * 16), 16, 0, 0); \
    __builtin_amdgcn_global_load_lds((const unsigned*)(_g + (O1)), (LAS unsigned*)((P) + tid * 16 + 8192), 16, 0, 0); } while (0)
#define G_STAGEA(P, BASE, br, kt) G_STAGE_(P, BASE, br, kt, goffA0, goffA1)
#define G_STAGEB(P, BASE, br, kt) G_STAGE_(P, BASE, br, kt, goff0, goff1)
#define G_LDA(dst, b, h) _Pragma("unroll") for (int m = 0; m < 4; ++m) _Pragma("unroll") for (int k = 0; k < 2; ++k) \
    dst[m][k] = *(const LAS bf16x8*)(G_SA(b, h) + lds_byte(wr * 64 + m * 16 + fr, k * 32 + fq * 8))
#define G_LDB(dst, b, h) _Pragma("unroll") for (int n = 0; n < 2; ++n) _Pragma("unroll") for (int k = 0; k < 2; ++k) \
    dst[n][k] = *(const LAS bf16x8*)(G_SB(b, h) + lds_byte(wc * 32 + n * 16 + fr, k * 32 + fq * 8))
#define G_MMA(ai, bj, At, Bx) do { __builtin_amdgcn_s_setprio(1); \
    _Pragma("unroll") for (int m = 0; m < 4; ++m) _Pragma("unroll") for (int n = 0; n < 2; ++n) _Pragma("unroll") for (int k = 0; k < 2; ++k) \
      acc[ai][bj][m][n] = __builtin_amdgcn_mfma_f32_16x16x32_bf16(At[m][k], Bx[n][k], acc[ai][bj][m][n], 0, 0, 0); \
    __builtin_amdgcn_s_setprio(0); } while (0)
#define WAIT_V(n) asm volatile("s_waitcnt vmcnt(" #n ")" ::: "memory")
#define WAIT_L(n) asm volatile("s_waitcnt lgkmcnt(" #n ")" ::: "memory")
#define BAR __builtin_amdgcn_s_barrier()
#define SCHED __builtin_amdgcn_sched_barrier(0)

DI int perm64(int rho) { return ((rho >> 2) & 3) * 16 + (rho >> 4) * 4 + (rho & 3); }
DI void gemm256_core(const u16* __restrict__ A, const u16* __restrict__ Bt, int brow, int bcol, lchar* shm, int tid, f32x4 (&acc)[2][2][4][2], bool permA) {
  const int wid = tid >> 6, lane = tid & 63, wr = wid >> 2, wc = wid & 3, fr = lane & 15, fq = lane >> 4;
  int r0, c0, r1, c1;
  stage_rc(tid * 16, r0, c0); stage_rc(tid * 16 + 8192, r1, c1);
  const unsigned goff0 = (unsigned)(r0 * GK + c0) * 2u, goff1 = (unsigned)(r1 * GK + c1) * 2u;
  const int pr0 = permA ? ((r0 & 64) | perm64(r0 & 63)) : r0, pr1 = permA ? ((r1 & 64) | perm64(r1 & 63)) : r1;
  const unsigned goffA0 = (unsigned)(pr0 * GK + c0) * 2u, goffA1 = (unsigned)(pr1 * GK + c1) * 2u;
#pragma unroll
  for (int ai = 0; ai < 2; ++ai)
#pragma unroll
    for (int bj = 0; bj < 2; ++bj)
#pragma unroll
      for (int m = 0; m < 4; ++m)
#pragma unroll
        for (int n = 0; n < 2; ++n) acc[ai][bj][m][n] = (f32x4){0.f, 0.f, 0.f, 0.f};
  bf16x8 At[4][2], B0[2][2], B1[2][2];
  const int nt = GK / 64;
  WAIT_V(0);
  __syncthreads();
  G_STAGEB(G_SB(0, 0), Bt, bcol, 0); G_STAGEA(G_SA(0, 0), A, brow, 0);
  G_STAGEB(G_SB(0, 1), Bt, bcol + 128, 0); G_STAGEA(G_SA(0, 1), A, brow + 128, 0);
  if (wr == 1) BAR;
  WAIT_V(4); BAR;
  G_STAGEB(G_SB(1, 0), Bt, bcol, 1); G_STAGEA(G_SA(1, 0), A, brow, 1); G_STAGEB(G_SB(1, 1), Bt, bcol + 128, 1);
  WAIT_V(6); BAR;
  for (int t = 0; t < nt - 2; t += 2) {
    G_LDB(B0, 0, 0); SCHED; G_LDA(At, 0, 0); G_STAGEA(G_SA(1, 1), A, brow + 128, t + 1);
    WAIT_L(8); BAR; WAIT_L(0); G_MMA(0, 0, At, B0); BAR; SCHED;
    G_LDB(B1, 0, 1); G_STAGEB(G_SB(0, 0), Bt, bcol, t + 2);
    BAR; WAIT_L(0); G_MMA(0, 1, At, B1); BAR;
    G_LDA(At, 0, 1); G_STAGEA(G_SA(0, 0), A, brow, t + 2);
    BAR; WAIT_L(0); G_MMA(1, 0, At, B0); BAR; SCHED;
    G_STAGEB(G_SB(0, 1), Bt, bcol + 128, t + 2);
    WAIT_V(6); BAR; G_MMA(1, 1, At, B1); BAR;
    G_LDB(B0, 1, 0); SCHED; G_LDA(At, 1, 0); G_STAGEA(G_SA(0, 1), A, brow + 128, t + 2);
    WAIT_L(8); BAR; WAIT_L(0); G_MMA(0, 0, At, B0); BAR; SCHED;
    G_LDB(B1, 1, 1); G_STAGEB(G_SB(1, 0), Bt, bcol, t + 3);
    BAR; WAIT_L(0); G_MMA(0, 1, At, B1); BAR;
    G_LDA(At, 1, 1); G_STAGEA(G_SA(1, 0), A, brow, t + 3);
    BAR; WAIT_L(0); G_MMA(1, 0, At, B0); BAR; SCHED;
    G_STAGEB(G_SB(1, 1), Bt, bcol + 128, t + 3);
    WAIT_V(6); BAR; G_MMA(1, 1, At, B1); BAR;
  }
  { G_LDB(B0, 0, 0); G_LDA(At, 0, 0); G_STAGEA(G_SA(1, 1), A, brow + 128, nt - 1);
    BAR; WAIT_L(0); G_MMA(0, 0, At, B0); BAR;
    G_LDB(B1, 0, 1); BAR; WAIT_L(0); G_MMA(0, 1, At, B1); BAR;
    G_LDA(At, 0, 1); WAIT_V(4); BAR; WAIT_L(0); G_MMA(1, 0, At, B0); G_MMA(1, 1, At, B1); BAR; }
  { G_LDB(B0, 1, 0); G_LDA(At, 1, 0); WAIT_V(2); BAR; WAIT_L(0); G_MMA(0, 0, At, B0); BAR;
    G_LDB(B1, 1, 1); WAIT_V(0); BAR; WAIT_L(0); G_MMA(0, 1, At, B1); BAR;
    G_LDA(At, 1, 1); BAR; WAIT_L(0); G_MMA(1, 0, At, B0); G_MMA(1, 1, At, B1); BAR; }
  if (wr == 0) BAR;
}

DI void gemm256_tile(const Params& p, int mode, int layer, const u16* R, const u16* Cc, int brow, int bcol, lchar* shm, int tid_in) {
  f32x4 acc[2][2][4][2];
  gemm256_core(R, Cc, brow, bcol, shm, tid_in, acc, true);
  int tid = tid_in;
  asm volatile("" : "+v"(tid));
  const int wid = tid >> 6, lane = tid & 63, wr = wid >> 2, wc = wid & 3, fr = lane & 15, fq = lane >> 4;
  if (mode == EPI_PROJ) {
#pragma unroll
    for (int ai = 0; ai < 2; ++ai)
#pragma unroll
      for (int bj = 0; bj < 2; ++bj)
#pragma unroll
        for (int n = 0; n < 2; ++n) {
          const int nc = brow + ai * 128 + wr * 64 + fq * 16, tok = bcol + bj * 128 + wc * 32 + n * 16 + fr;
          u16* dst = W_PROJ(p) + (size_t)tok * INC + nc;
#pragma unroll
          for (int q = 0; q < 2; ++q) {
            const f32x4 va = acc[ai][bj][2 * q][n], vb2 = acc[ai][bj][2 * q + 1][n];
            *(u32x4*)(dst + 8 * q) = (u32x4){pack2(va[0], va[1]), pack2(va[2], va[3]), pack2(vb2[0], vb2[1]), pack2(vb2[2], vb2[3])};
          }
        }
  } else if (mode == EPI_VT) {
#pragma unroll
    for (int ai = 0; ai < 2; ++ai)
#pragma unroll
      for (int bj = 0; bj < 2; ++bj)
#pragma unroll
        for (int n = 0; n < 2; ++n) {
          const int tok = brow + ai * 128 + wr * 64 + fq * 16, nn = bcol + bj * 128 + wc * 32 + n * 16 + fr - 1024;
          const int b = tok / LSEQ, pos = tok - b * LSEQ;
          u16* dst = W_VT(p) + ((size_t)(b * 512 + nn)) * LP + pos;
#pragma unroll
          for (int q = 0; q < 2; ++q) {
            const f32x4 va = acc[ai][bj][2 * q][n], vb2 = acc[ai][bj][2 * q + 1][n];
            *(u32x4*)(dst + 8 * q) = (u32x4){pack2(va[0], va[1]), pack2(va[2], va[3]), pack2(vb2[0], vb2[1]), pack2(vb2[2], vb2[3])};
          }
        }
  } else if (mode == EPI_OUT) {
#pragma unroll
    for (int ai = 0; ai < 2; ++ai)
#pragma unroll
      for (int bj = 0; bj < 2; ++bj) {
        u32x4 hv[2][2];
#pragma unroll
        for (int n = 0; n < 2; ++n) {
          const int nc = brow + ai * 128 + wr * 64 + fq * 16, tok = bcol + bj * 128 + wc * 32 + n * 16 + fr;
          hv[n][0] = *(const u32x4*)(W_H(p) + (size_t)tok * DM + nc); hv[n][1] = *(const u32x4*)(W_H(p) + (size_t)tok * DM + nc + 8);
        }
#pragma unroll
        for (int n = 0; n < 2; ++n) {
          const int nc = brow + ai * 128 + wr * 64 + fq * 16, tok = bcol + bj * 128 + wc * 32 + n * 16 + fr;
          u16* dst = W_Y(p) + (size_t)tok * DM + nc;
#pragma unroll
          for (int q = 0; q < 2; ++q) {
            const f32x4 va = acc[ai][bj][2 * q][n], vb2 = acc[ai][bj][2 * q + 1][n];
            const u32x4 hh = hv[n][q];
            *(u32x4*)(dst + 8 * q) = (u32x4){pack2(ALPHA * bflo(hh[0]) + va[0], ALPHA * bfhi(hh[0]) + va[1]), pack2(ALPHA * bflo(hh[1]) + va[2], ALPHA * bfhi(hh[1]) + va[3]),
                                            pack2(ALPHA * bflo(hh[2]) + vb2[0], ALPHA * bfhi(hh[2]) + vb2[1]), pack2(ALPHA * bflo(hh[3]) + vb2[2], ALPHA * bfhi(hh[3]) + vb2[3])};
          }
        }
      }
  } else {
    LAS float* S = (LAS float*)shm;
    const int tok = tid & 255, kh = tid >> 8;
    float L0[16], L1[16];
#pragma unroll
    for (int ai = 0; ai < 2; ++ai) {
      __syncthreads();
#pragma unroll
      for (int bj = 0; bj < 2; ++bj)
#pragma unroll
        for (int m = 0; m < 4; ++m)
#pragma unroll
          for (int n = 0; n < 2; ++n) {
            const int tk = bj * 128 + wc * 32 + n * 16 + fr, key = wr * 64 + fq * 16 + m * 4;
            *(LAS f32x4*)((lchar*)S + tk * 528 + key * 4) = acc[ai][bj][m][n];
          }
      __syncthreads();
      float v[16];
#pragma unroll 1
      for (int ch = 0; ch < 4; ++ch) {
        float wk[16];
#pragma unroll
        for (int q = 0; q < 4; ++q) {
          const int key = kh * 64 + ch * 16 + 4 * q;
          const f32x4 xv = *(const LAS f32x4*)((lchar*)S + tok * 528 + key * 4);
#pragma unroll
          for (int e = 0; e < 4; ++e) wk[4 * q + e] = __uint_as_float((__float_as_uint(xv[e]) & ~127u) | (unsigned)(key + e));
        }
        bitonic_sort16(wk);
        if (ch == 0) {
#pragma unroll
          for (int i = 0; i < 16; ++i) v[i] = wk[i];
        } else {
          merge_top16(v, wk);
        }
      }
      __syncthreads();
      if (kh == 1) {
#pragma unroll
        for (int q = 0; q < 4; ++q) *(LAS f32x4*)((lchar*)S + tok * 80 + 16 * q) = (f32x4){v[4 * q], v[4 * q + 1], v[4 * q + 2], v[4 * q + 3]};
      }
      __syncthreads();
      if (kh == 0) {
        float wk[16];
#pragma unroll
        for (int q = 0; q < 4; ++q) {
          const f32x4 xv = *(const LAS f32x4*)((lchar*)S + tok * 80 + 16 * q);
          wk[4 * q] = xv[0]; wk[4 * q + 1] = xv[1]; wk[4 * q + 2] = xv[2]; wk[4 * q + 3] = xv[3];
        }
        merge_top16(v, wk);
      }
#pragma unroll
      for (int j = 0; j < 16; ++j) { if (ai == 0) L0[j] = v[j]; else L1[j] = v[j]; }
    }
    __syncthreads();
    LAS unsigned* LL = (LAS unsigned*)shm;
    if (kh == 0) {
#pragma unroll
      for (int j = 0; j < 16; ++j) { LL[tok * 32 + ((j + tok) & 31)] = __float_as_uint(L0[j]); LL[tok * 32 + ((16 + j + tok) & 31)] = __float_as_uint(L1[j]); }
      float s1[16], s2[16], v[16];
#pragma unroll
      for (int j = 0; j < 16; ++j) { s1[j] = __uint_as_float(__float_as_uint(L0[j]) & ~127u); s2[j] = __uint_as_float(__float_as_uint(L1[j]) & ~127u); v[j] = -3.0e38f; }
#pragma unroll
      for (int ch = 0; ch < 4; ++ch) {
        float wk[16];
#pragma unroll
        for (int i = 0; i < 16; ++i) {
          constexpr unsigned char PAIRS[64] = {0, 1, 2, 3, 4, 5, 6, 7, 8, 9, 10, 11, 12, 13, 14, 15, 16, 17, 18, 19, 20, 21, 22, 23, 32, 33, 34, 35, 36, 48, 49, 50, 51, 64, 65, 66, 80, 81, 96, 97, 112, 113, 128, 144, 160, 176, 192, 208, 224, 240, 255, 255, 255, 255, 255, 255, 255, 255, 255, 255, 255, 255, 255, 255};
          const int code = PAIRS[ch * 16 + i];
          if (code == 255) { wk[i] = -3.0e38f; }
          else { const float sm = s1[code >> 4] + s2[code & 15]; wk[i] = __uint_as_float((__float_as_uint(sm) & ~255u) | (unsigned)code); }
        }
        if (ch == 0) {
#pragma unroll
          for (int i = 0; i < 16; ++i) v[i] = wk[i];
        } else {
          bitonic_sort16(wk);
          merge_top16(v, wk);
        }
      }
      float e[16], sum = 0.f;
      const float mx = __uint_as_float(__float_as_uint(v[0]) & ~255u);
#pragma unroll
      for (int j = 0; j < 16; ++j) { e[j] = fast_exp2((__uint_as_float(__float_as_uint(v[j]) & ~255u) - mx) * LOG2E); sum += e[j]; }
      const float inv = 1.0f / sum;
      const int hd = brow >> 8;
      u16* di = W_IDX(p) + (size_t)(bcol + tok) * 128 + hd * 16;
      float* dg = W_G(p) + (size_t)(bcol + tok) * 128 + hd * 16;
      unsigned eid[16];
#pragma unroll
      for (int k = 0; k < 16; ++k) {
        const unsigned code = __float_as_uint(v[k]) & 255u;
        const unsigned i1 = LL[tok * 32 + (((code >> 4) + tok) & 31)] & 127u, i2 = LL[tok * 32 + ((16 + (code & 15u) + tok) & 31)] & 127u;
        eid[k] = i1 * 128u + i2;
      }
#pragma unroll
      for (int q = 0; q < 4; ++q) *(f32x4*)(dg + 4 * q) = (f32x4){e[4 * q] * inv, e[4 * q + 1] * inv, e[4 * q + 2] * inv, e[4 * q + 3] * inv};
#pragma unroll
      for (int q = 0; q < 2; ++q)
        *(u32x4*)(di + 8 * q) = (u32x4){eid[8 * q] | (eid[8 * q + 1] << 16), eid[8 * q + 2] | (eid[8 * q + 3] << 16), eid[8 * q + 4] | (eid[8 * q + 5] << 16), eid[8 * q + 6] | (eid[8 * q + 7] << 16)};
    }
    __syncthreads();
  }
}

#define ATT_MISC 131072
DI void attn_item(const Params& p, int layer, int b, int hh, int jq, lchar* sm, float lam, float oml, int tid) {
  const int lane = tid & 63, w = tid >> 6, g = lane >> 4, l15 = lane & 15;
  const int idx32 = (lane ^ 32) << 2;
  LAS float* tab = (LAS float*)(sm + ATT_MISC);
  LAS float* sg = tab + 208;
  __syncthreads();
  if (tid < 208) {
    const int d = tid - 80;
    float tv = -1.0e30f;
    if (d >= 0) {
      int bucket = d;
      if (d >= 16) {
        int lg = 16 + (int)(logf((float)d * (1.0f / 16.0f)) / 2.0794415416798357f * 16.0f);
        bucket = lg < 31 ? lg : 31;
      }
      tv = P_REL_BIAS(p)[bucket * 4 + hh] * LOG2E;
    }
    tab[tid] = tv;
    if (tid < 128) sg[tid] = P_SUBLN_G(p)[layer * 128 + tid] * oml;
  }
  const int q0w = 128 * jq + 16 * w;
  const int qpos = q0w + l15;
  const int qrow = b * LSEQ + (qpos < LSEQ ? qpos : LSEQ - 1);
  bf16x8 qf[2][2];
  {
    const u16* qp = W_PROJ(p) + (size_t)qrow * INC + hh * 128 + g * 8;
#pragma unroll
    for (int m = 0; m < 2; ++m)
#pragma unroll
      for (int ks = 0; ks < 2; ++ks) {
        const u32x4 raw = *(const u32x4*)(qp + m * 64 + ks * 32);
        u32x4 sc;
#pragma unroll
        for (int e = 0; e < 4; ++e) sc[e] = pack2(bflo(raw[e]) * (0.125f * LOG2E), bfhi(raw[e]) * (0.125f * LOG2E));
        qf[m][ks] = __builtin_bit_cast(bf16x8, sc);
      }
  }
  const int nkt = (2 * jq + 2) < 33 ? (2 * jq + 2) : 33;
  const char* ksrc[2]; const char* vsrc[2];
#pragma unroll
  for (int i = 0; i < 2; ++i) {
    const int bk = 2 * w + i, k16 = bk >> 2, m = (bk >> 1) & 1, ks = bk & 1;
    const int krow = 32 * (k16 >> 1) + 8 * (l15 >> 2) + 4 * (k16 & 1) + (l15 & 3);
    ksrc[i] = (const char*)(W_PROJ(p) + (size_t)(b * LSEQ + krow) * INC + 512 + hh * 128 + m * 64 + ks * 32 + g * 8);
    const int dv = 8 * bk + (lane >> 3), c = (lane & 7) ^ ((dv >> 1) & 7);
    vsrc[i] = (const char*)(W_VT(p) + ((size_t)((b * 4 + hh) * 128 + dv)) * LP + c * 8);
  }
  lchar* dmak = sm + (2 * w) * 1024 + lane * 16;
#define ATT_ISSUE(KT, SLOT) do { const size_t _ko = (size_t)(KT) * (64 * INC * 2), _vo = (size_t)(KT) * 128; lchar* _d = dmak + (SLOT) * 32768; \
    __builtin_amdgcn_global_load_lds((const unsigned*)(ksrc[0] + _ko), (LAS unsigned*)(_d), 16, 0, 0); \
    __builtin_amdgcn_global_load_lds((const unsigned*)(ksrc[1] + _ko), (LAS unsigned*)(_d + 1024), 16, 0, 0); \
    __builtin_amdgcn_global_load_lds((const unsigned*)(vsrc[0] + _vo), (LAS unsigned*)(_d + 16384), 16, 0, 0); \
    __builtin_amdgcn_global_load_lds((const unsigned*)(vsrc[1] + _vo), (LAS unsigned*)(_d + 16384 + 1024), 16, 0, 0); } while (0)
  int voff[2];
#pragma unroll
  for (int kk = 0; kk < 2; ++kk) voff[kk] = l15 * 128 + (((4 * kk + g) ^ ((l15 >> 1) & 7)) * 16);

  f32x4 O[2][8];
#pragma unroll
  for (int m = 0; m < 2; ++m)
#pragma unroll
    for (int dt = 0; dt < 8; ++dt) O[m][dt] = (f32x4){0.f, 0.f, 0.f, 0.f};
  float mrun[2] = {0.f, 0.f};
  f32x4 Osum[2] = {(f32x4){0.f, 0.f, 0.f, 0.f}, (f32x4){0.f, 0.f, 0.f, 0.f}};
  bf16x8 ones;
  { const short o1 = (l15 == 0) ? (short)0x3f80 : (short)0; ones = (bf16x8){o1, o1, o1, o1, o1, o1, o1, o1}; }

  WAIT_V(0);
  __syncthreads();
  const float tfar = tab[207];
  ATT_ISSUE(0, 0);
  ATT_ISSUE((1 < nkt ? 1 : nkt - 1), 1);
  for (int kt = 0; kt < nkt; ++kt) {
    { const int kn = (kt + 2 < nkt) ? kt + 2 : nkt - 1; ATT_ISSUE(kn, (kt + 2) & 3); }
    WAIT_V(8); BAR;
    if (64 * kt <= q0w + 15) {
      const lchar* kb = sm + (kt & 3) * 32768;
      const lchar* vb = kb + 16384;
      const bool near = (q0w - 64 * kt) < 176;
      const float tadd = near ? 0.f : tfar;
      const float sinit[2] = {tadd - mrun[0], tadd - mrun[1]};
      f32x4 S[2][4];
#pragma unroll
      for (int kh = 0; kh < 2; ++kh) {
        bf16x8 kf[2][2][2];
#pragma unroll
        for (int q = 0; q < 2; ++q)
#pragma unroll
          for (int m = 0; m < 2; ++m)
#pragma unroll
            for (int ks = 0; ks < 2; ++ks) kf[q][m][ks] = *(const LAS bf16x8*)(kb + ((((2 * kh + q) * 2 + m) * 2 + ks) * 1024) + lane * 16);
        SCHED;
#pragma unroll
        for (int q = 0; q < 2; ++q)
#pragma unroll
          for (int m = 0; m < 2; ++m) {
            f32x4 sacc = (f32x4){sinit[m], sinit[m], sinit[m], sinit[m]};
            sacc = mfma16(kf[q][m][0], qf[m][0], sacc);
            sacc = mfma16(kf[q][m][1], qf[m][1], sacc);
            S[m][2 * kh + q] = sacc;
          }
      }
      if (near) {
#pragma unroll
        for (int m = 0; m < 2; ++m)
#pragma unroll
          for (int k16 = 0; k16 < 4; ++k16)
#pragma unroll
            for (int r = 0; r < 4; ++r) {
              const int di = qpos + 80 - (64 * kt + 32 * (k16 >> 1) + 8 * g + 4 * (k16 & 1) + r);
              S[m][k16][r] += tab[di < 207 ? di : 207];
            }
      }
      bf16x8 pb[2][2];
#pragma unroll
      for (int m = 0; m < 2; ++m) {
        float mx = fmaxf(fmaxf(S[m][0][0], S[m][0][1]), fmaxf(S[m][0][2], S[m][0][3]));
#pragma unroll
        for (int k16 = 1; k16 < 4; ++k16) mx = fmaxf(fmaxf(mx, fmaxf(S[m][k16][0], S[m][k16][1])), fmaxf(S[m][k16][2], S[m][k16][3]));
        mx = fmaxf(mx, shx16(mx));
        mx = fmaxf(mx, shx32(mx, idx32));
        if (kt == 0 || __builtin_amdgcn_ballot_w64(mx > 8.0f) != 0ull) {
          const float dlt = kt == 0 ? mx : fmaxf(mx, 0.f);
          const float alpha = fast_exp2(-dlt);
          mrun[m] += dlt;
#pragma unroll
          for (int dt = 0; dt < 8; ++dt) { O[m][dt][0] *= alpha; O[m][dt][1] *= alpha; O[m][dt][2] *= alpha; O[m][dt][3] *= alpha; }
          Osum[m][0] *= alpha; Osum[m][1] *= alpha; Osum[m][2] *= alpha; Osum[m][3] *= alpha;
#pragma unroll
          for (int k16 = 0; k16 < 4; ++k16)
#pragma unroll
            for (int r = 0; r < 4; ++r) S[m][k16][r] -= dlt;
        }
#pragma unroll
        for (int k16 = 0; k16 < 4; ++k16)
#pragma unroll
          for (int r = 0; r < 4; ++r) S[m][k16][r] = fast_exp2(S[m][k16][r]);
#pragma unroll
        for (int kk = 0; kk < 2; ++kk) {
          u32x4 t;
          t[0] = pack2(S[m][2 * kk][0], S[m][2 * kk][1]); t[1] = pack2(S[m][2 * kk][2], S[m][2 * kk][3]);
          t[2] = pack2(S[m][2 * kk + 1][0], S[m][2 * kk + 1][1]); t[3] = pack2(S[m][2 * kk + 1][2], S[m][2 * kk + 1][3]);
          pb[m][kk] = __builtin_bit_cast(bf16x8, t);
          Osum[m] = mfma16(ones, pb[m][kk], Osum[m]);
        }
      }
#pragma unroll
      for (int kk = 0; kk < 2; ++kk) {
        bf16x8 vf[8];
#pragma unroll
        for (int dt = 0; dt < 8; ++dt) vf[dt] = *(const LAS bf16x8*)(vb + dt * 2048 + voff[kk]);
        SCHED;
#pragma unroll
        for (int dt = 0; dt < 8; ++dt) {
          O[0][dt] = mfma16(vf[dt], pb[0][kk], O[0][dt]);
          O[1][dt] = mfma16(vf[dt], pb[1][kk], O[1][dt]);
        }
      }
    }
  }
  WAIT_V(0);
#undef ATT_ISSUE
  float l0 = g == 0 ? Osum[0][0] : 0.f, l1 = g == 0 ? Osum[1][0] : 0.f;
  l0 += shx16(l0); l0 += shx32(l0, idx32);
  l1 += shx16(l1); l1 += shx32(l1, idx32);
  const float c1 = 1.0f / l0, c2 = lam / l1;
  float ss = 0.f;
#pragma unroll
  for (int dt = 0; dt < 8; ++dt)
#pragma unroll
    for (int r = 0; r < 4; ++r) { const float o = O[0][dt][r] * c1 - O[1][dt][r] * c2; O[0][dt][r] = o; ss += o * o; }
  ss += shx16(ss); ss += shx32(ss, idx32);
  const float rinv = rsqrtf(ss * (1.0f / 128.0f) + 1e-5f);
  if (qpos < LSEQ) {
    u16* dst = W_MIX(p) + (size_t)(b * LSEQ + qpos) * DM + hh * 128 + 4 * g;
#pragma unroll
    for (int dt = 0; dt < 8; ++dt) {
      const int dv0 = 16 * dt + 4 * g;
      u32x2 o;
      o[0] = pack2(O[0][dt][0] * rinv * sg[dv0 + 0], O[0][dt][1] * rinv * sg[dv0 + 1]);
      o[1] = pack2(O[0][dt][2] * rinv * sg[dv0 + 2], O[0][dt][3] * rinv * sg[dv0 + 3]);
      *(u32x2*)(dst + 16 * dt) = o;
    }
  }
}

DI void conv_item(const Params& p, int layer, int item, int tid) {
  const int ch = (tid & 63) * 8, t0 = item * 16 + 4 * (tid >> 6);
  const int pos0 = t0 % LSEQ;
  const bool head = pos0 == 0;
  const u16* row0 = W_PROJ(p) + (size_t)t0 * INC;
  u32x4 gc[6], zz[6], gb[4];
#pragma unroll
  for (int j = 0; j < 6; ++j) {
    const u16* r2 = row0 + (ptrdiff_t)((head && j < 2) ? 0 : (j - 2)) * INC;
    gc[j] = *(const u32x4*)(r2 + 2048 + ch); zz[j] = *(const u32x4*)(r2 + 2560 + ch);
  }
#pragma unroll
  for (int i = 0; i < 4; ++i) gb[i] = *(const u32x4*)(row0 + (size_t)i * INC + 1536 + ch);
  const float* cw = P_CONV_W(p) + (size_t)layer * 3 * 512 + ch;
  float w0[8], w1[8], w2[8];
#pragma unroll
  for (int e = 0; e < 8; ++e) { w0[e] = cw[e]; w1[e] = cw[512 + e]; w2[e] = cw[1024 + e]; }
  float pr[6][8];
#pragma unroll
  for (int j = 0; j < 6; ++j) {
    const float keep = (head && j < 2) ? 0.f : 1.f;
#pragma unroll
    for (int e = 0; e < 4; ++e) { pr[j][2 * e] = keep * bflo(gc[j][e]) * bflo(zz[j][e]); pr[j][2 * e + 1] = keep * bfhi(gc[j][e]) * bfhi(zz[j][e]); }
  }
#pragma unroll
  for (int i = 0; i < 4; ++i) {
    u32x4 o;
#pragma unroll
    for (int e = 0; e < 4; ++e) {
      const float a0 = w0[2 * e] * pr[i][2 * e] + w1[2 * e] * pr[i + 1][2 * e] + w2[2 * e] * pr[i + 2][2 * e];
      const float a1 = w0[2 * e + 1] * pr[i][2 * e + 1] + w1[2 * e + 1] * pr[i + 1][2 * e + 1] + w2[2 * e + 1] * pr[i + 2][2 * e + 1];
      o[e] = pack2(bflo(gb[i][e]) * a0, bfhi(gb[i][e]) * a1);
    }
    *(u32x4*)(W_MIX(p) + (size_t)(t0 + i) * DM + 512 + ch) = o;
  }
}

DI void phase_prologue(const Params& p, char* smem, int wave) {
  const int tid = otid_w(wave), lane = tid & 63, wid = tid >> 6, hb = tid >> 8, htid = tid & 255;
  const int nblk = gridDim.x, bid = blockIdx.x;
  const size_t gtid = (size_t)bid * NTHREADS + tid, gthreads = (size_t)nblk * NTHREADS;
  float* sm = (float*)(smem + hb * LDS_HALF);
  for (int it0 = bid; it0 < 2048; it0 += nblk) {
    const int it = it0 * 2 + hb;
    if (it < 3072) {
      const int l = it / 768, r = it % 768, kb = r / 48, nb = r % 48;
      transpose_tile(P_W_IN(p) + (size_t)l * 1024 * 3072, 3072, W_WIN(p) + (size_t)l * 3072 * 1024, 1024, kb * 64, nb * 64, sm, htid);
    } else {
      const int i2 = it - 3072, l = i2 / 256, r = i2 % 256, kb = r / 16, nb = r % 16;
      transpose_tile(P_W_OUT(p) + (size_t)l * 1024 * 1024, 1024, W_WOUT(p) + (size_t)l * 1024 * 1024, 1024, kb * 64, nb * 64, sm, htid);
    }
  }
  convert_straight(P_W_Q(p), W_WQB(p), (size_t)4 * 1024 * 2048 / 8, gtid, gthreads);
  convert_straight(P_SUB_KEYS(p), W_SKB(p), (size_t)4 * 16 * 128 * 128 / 8, gtid, gthreads);
  for (int t = bid * 8 + wid; t < TTOK; t += nblk * 8) {
    const int b = t / LSEQ, pos = t - b * LSEQ;
    const float* src = pos < NMETA ? P_META(p) + (size_t)pos * DM : P_X(p) + ((size_t)b * SEQ + pos - NMETA) * DM;
    float v[16];
    load_row_f32<0>(src, v, lane);
    ln_row<0>(v, P_LN_IN_G(p), P_LN_IN_B(p), lane);
    store_row_bf16<0>(W_H(p) + (size_t)t * DM, v, lane);
  }
}

DI void phase_fold(const Params& p, char* smem, int wave) {
  const int tid = otid_w(wave), hb = tid >> 8, htid = tid & 255;
  for (int it0 = blockIdx.x; it0 < 256; it0 += gridDim.x) {
    const int it = it0 * 2 + hb;
    const int l = it >> 7, hp = (it >> 3) & 15, mt = it & 7;
    gemm_tile_fold(W_WQB(p) + (size_t)l * 1024 * 2048 + hp * 128, 2048, W_SKB(p) + ((size_t)l * 16 + hp) * 128 * 128, 128, 128, mt * 128, smem + hb * 65536,
                   W_WSC(p) + (size_t)l * 2048 * 1024 + (size_t)hp * 128 * 1024, htid);
  }
}

DI bool tile_order(int i, int nM, int nN, int& pm, int& pn) {
  const int nwg = nM * nN;
  const long L = (long)i * gridDim.x + blockIdx.x;
  if (L >= nwg) return false;
  int wgid = (int)L;
  { const int q = nwg / 8, r = nwg % 8, xcd = wgid % 8, off = wgid / 8; wgid = (xcd < r ? xcd * (q + 1) : r * (q + 1) + (xcd - r) * q) + off; }
  const int nig = 8 * nN, gid = wgid / nig, fm = gid * 8, gsz = (nM - fm) < 8 ? (nM - fm) : 8;
  pm = fm + ((wgid % nig) % gsz); pn = (wgid % nig) / gsz;
  return true;
}

DI void convert_tables(const Params& p, int layer, int lane, int slot, int nslots) {
  for (int r = slot; r < 2 * PEER_N; r += nslots) {

    const bool isv = r >= PEER_N;
    const int e = isv ? r - PEER_N : r;
    const float* src = (isv ? P_PEER_V(p) : P_PEER_U(p)) + ((size_t)layer * PEER_N + e) * DM + 16 * lane;
    f32x4 a[4];
#pragma unroll
    for (int k = 0; k < 4; ++k) a[k] = *(const f32x4*)(src + 4 * k);
    float am = 0.f;
#pragma unroll
    for (int k = 0; k < 4; ++k) am = fmaxf(am, fmaxf(fmaxf(fabsf(a[k][0]), fabsf(a[k][1])), fmaxf(fabsf(a[k][2]), fabsf(a[k][3]))));
    am = wave_max_nonneg(am);
    const float top = isv ? 224.0f : 127.0f;
    const float sc = am > 0.f ? top / am : 1.0f;
    if (lane == 0) (isv ? W_SV(p) : W_SU(p))[e] = am > 0.f ? am / top : 1.0f;
    u32x4 o;
#pragma unroll
    for (int k = 0; k < 4; ++k) {
      if (isv) {
        int w = 0;
        w = __builtin_amdgcn_cvt_pk_fp8_f32(a[k][0] * sc, a[k][1] * sc, w, false);
        w = __builtin_amdgcn_cvt_pk_fp8_f32(a[k][2] * sc, a[k][3] * sc, w, true);
        o[k] = (unsigned)w;
      } else {
        const int q0 = __float2int_rn(a[k][0] * sc), q1 = __float2int_rn(a[k][1] * sc), q2 = __float2int_rn(a[k][2] * sc), q3 = __float2int_rn(a[k][3] * sc);
        o[k] = ((unsigned)q0 & 255u) | (((unsigned)q1 & 255u) << 8) | (((unsigned)q2 & 255u) << 16) | ((unsigned)q3 << 24);
      }
    }
    *(u32x4*)((isv ? W_VB(p) : W_UB(p)) + (size_t)(lane >> 3) * (PEER_N * 128) + (size_t)e * 128 + 16 * (lane & 7)) = o;
  }
}

DI void phase_gemm(const Params& p, int layer, int which, char* smem, int wave) {
  const int tid0 = otid_w(wave);
  const u16* W = which == 0 ? W_WIN(p) + (size_t)layer * 3072 * 1024 : (which == 1 ? W_WOUT(p) + (size_t)layer * 1024 * 1024 : W_WSC(p) + (size_t)layer * 2048 * 1024);
  const u16* X = which == 1 ? W_MIX(p) : W_H(p);
  const int nN = which == 0 ? 12 : (which == 1 ? 4 : 8);
  int pm, pn;
  for (int i = 0; tile_order(i, 258, nN, pm, pn); ++i) {
    const bool vt = (which == 0) && (pn == 4 || pn == 5);
    const int mode = which == 0 ? (vt ? EPI_VT : EPI_PROJ) : (which == 1 ? EPI_OUT : EPI_TOPK);
    int tid = tid0;
    asm volatile("" : "+v"(tid));
    gemm256_tile(p, mode, layer, vt ? X : W, vt ? W : X, vt ? pm * 256 : pn * 256, vt ? pn * 256 : pm * 256, (lchar*)smem, tid);
  }
  if (which == 1) {
    const int rem = (258 * 4) % (int)gridDim.x, nidle = (int)gridDim.x - rem;
    if ((int)blockIdx.x >= rem) convert_tables(p, layer, tid0 & 63, ((int)blockIdx.x - rem) * 8 + (tid0 >> 6), nidle * 8);
  }
}

DI void phase_attn(const Params& p, int layer, char* smem, int wave) {
  const int tid = otid_w(wave), lane = tid & 63, hb = tid >> 8, htid = tid & 255;
  const float lam_init = 0.8f - 0.6f * expf(-0.3f * (float)layer);
  float d1 = P_LQ1(p)[layer * 64 + lane] * P_LK1(p)[layer * 64 + lane], d2 = P_LQ2(p)[layer * 64 + lane] * P_LK2(p)[layer * 64 + lane];
  d1 = wave_sum(d1); d2 = wave_sum(d2);
  const float lam = expf(d1) - expf(d2) + lam_init;
  for (int rd = 0; rd * (int)gridDim.x < 2176; ++rd) {
    const int o = rd * gridDim.x + ((rd & 1) ? (int)gridDim.x - 1 - (int)blockIdx.x : (int)blockIdx.x);
    if (o < 2176) { const int jq = 16 - (o >> 7), bh = o & 127; attn_item(p, layer, bh >> 2, bh & 3, jq, (lchar*)smem, lam, 1.0f - lam_init, tid); }
  }
  for (int it = blockIdx.x; it < 2064; it += gridDim.x) conv_item(p, layer, it * 2 + hb, htid);
}

DI void phase_ln(const Params& p, int layer, int which, int wave) {
  const int tid = otid_w(wave), lane = tid & 63, wid = tid >> 6;
  const int stride = gridDim.x * 8;
  const float* lg = (which ? P_LN2_G(p) : P_LN1_G(p)) + layer * DM;
  const float* lb = (which ? P_LN2_B(p) : P_LN1_B(p)) + layer * DM;
  const bool final_out = which && (layer == DEPTH - 1);
  float gg[16], bb[16];
#pragma unroll
  for (int hh = 0; hh < 2; ++hh) {
    const int c = hh * 512 + 8 * lane;
    const f32x4 g0 = *(const f32x4*)(lg + c), g1 = *(const f32x4*)(lg + c + 4), b0 = *(const f32x4*)(lb + c), b1 = *(const f32x4*)(lb + c + 4);
#pragma unroll
    for (int e = 0; e < 4; ++e) { gg[hh * 8 + e] = g0[e]; gg[hh * 8 + 4 + e] = g1[e]; bb[hh * 8 + e] = b0[e]; bb[hh * 8 + 4 + e] = b1[e]; }
  }
  const int t0 = blockIdx.x * 8 + wid;
#define LN_LOAD(T, RA, RB) do { const int _t = (T) < TTOK ? (T) : t0; const u16* _s = W_Y(p) + (size_t)_t * DM + 8 * lane; \
    RA = *(const u32x4*)(_s); RB = *(const u32x4*)(_s + 512); } while (0)
#define LN_ROW(T, RA, RB) do { if ((T) < TTOK) { float v[16]; \
    _Pragma("unroll") for (int e = 0; e < 4; ++e) { v[2 * e] = bflo(RA[e]); v[2 * e + 1] = bfhi(RA[e]); v[8 + 2 * e] = bflo(RB[e]); v[8 + 2 * e + 1] = bfhi(RB[e]); } \
    float sm = 0.f; _Pragma("unroll") for (int i = 0; i < 16; ++i) sm += v[i]; \
    const float mu = wave_sum(sm) * (1.0f / 1024.0f); \
    float q = 0.f; _Pragma("unroll") for (int i = 0; i < 16; ++i) { const float d = v[i] - mu; q += d * d; } \
    const float rstd = rsqrtf(wave_sum(q) * (1.0f / 1024.0f) + 1e-5f); \
    _Pragma("unroll") for (int i = 0; i < 16; ++i) v[i] = (v[i] - mu) * rstd * gg[i] + bb[i]; \
    if (final_out) { const int b = (T) / LSEQ, pos = (T) - b * LSEQ; \
      if (pos >= NMETA) { float* dst = p.out + ((size_t)b * SEQ + pos - NMETA) * DM; \
        _Pragma("unroll") for (int hh = 0; hh < 2; ++hh) { \
          *(f32x4*)(dst + hh * 512 + 8 * lane) = (f32x4){v[hh * 8], v[hh * 8 + 1], v[hh * 8 + 2], v[hh * 8 + 3]}; \
          *(f32x4*)(dst + hh * 512 + 8 * lane + 4) = (f32x4){v[hh * 8 + 4], v[hh * 8 + 5], v[hh * 8 + 6], v[hh * 8 + 7]}; } } \
    } else { store_row_bf16<0>(W_H(p) + (size_t)(T) * DM, v, lane); } } } while (0)
  u32x4 rAa, rAb, rBa, rBb;
  LN_LOAD(t0, rAa, rAb);
  for (int t = t0; t < TTOK; t += 2 * stride) {
    LN_LOAD(t + stride, rBa, rBb);
    LN_ROW(t, rAa, rAb);
    LN_LOAD(t + 2 * stride, rAa, rAb);
    LN_ROW(t + stride, rBa, rBb);
  }
#undef LN_LOAD
#undef LN_ROW
}

#define DPP_F(v, ctrl) __int_as_float(__builtin_amdgcn_update_dpp(0, __float_as_int(v), (ctrl), 0xf, 0xf, true))
#define PEER_META(T, IA, IB, HA, HB) do { const int _t = (T) < TTOK ? (T) : wslot; \
    IA = *(const u32x4*)(W_IDX(p) + (size_t)_t * 128 + r * 16); IB = *(const u32x4*)(W_IDX(p) + (size_t)_t * 128 + r * 16 + 8); \
    const u16* _hp = W_H(p) + (size_t)_t * DM + x * 128 + 16 * c; HA = *(const u32x4*)(_hp); HB = *(const u32x4*)(_hp + 8); } while (0)
DI unsigned row_off(unsigned w, unsigned c16, bool hi) {
  unsigned r; const unsigned m = 128u;
  if (hi) asm("v_mad_u32_u16 %0, %1, %2, %3 op_sel:[1,0,0,0]" : "=v"(r) : "v"(w), "v"(m), "v"(c16));
  else asm("v_mad_u32_u16 %0, %1, %2, %3" : "=v"(r) : "v"(w), "v"(m), "v"(c16));
  return r;
}
#define PEER_GATHER(TAB, IA, IB, RR) do { _Pragma("unroll") for (int g = 0; g < 16; ++g) { \
    const unsigned _w = (g < 8 ? IA : IB)[(g >> 1) & 3]; RR[g] = *(const u32x4*)((TAB) + row_off(_w, c16, (g & 1) != 0)); } } while (0)
#define PEER_UNPACK(XS, HA, HB) do { _Pragma("unroll") for (int e = 0; e < 4; ++e) { \
    XS[e] = (f32x2){bflo(HA[e]), bfhi(HA[e])}; XS[4 + e] = (f32x2){bflo(HB[e]), bfhi(HB[e])}; } } while (0)

#define DPP_I(v, ctrl) __builtin_amdgcn_update_dpp(0, (v), (ctrl), 0xf, 0xf, true)
DI int reduce_scatter8(int d0, int d1, int d2, int d3, int d4, int d5, int d6, int d7, int c) {
  const bool b2 = c >= 4, b1 = (c & 2) != 0, b0 = (c & 1) != 0;
  const int e0 = (b2 ? d4 : d0) + DPP_I(b2 ? d0 : d4, 0x141);
  const int e1 = (b2 ? d5 : d1) + DPP_I(b2 ? d1 : d5, 0x141);
  const int e2 = (b2 ? d6 : d2) + DPP_I(b2 ? d2 : d6, 0x141);
  const int e3 = (b2 ? d7 : d3) + DPP_I(b2 ? d3 : d7, 0x141);
  const int f0 = (b1 ? e2 : e0) + DPP_I(b1 ? e0 : e2, 0x4E);
  const int f1 = (b1 ? e3 : e1) + DPP_I(b1 ? e1 : e3, 0x4E);
  return (b0 ? f1 : f0) + DPP_I(b0 ? f0 : f1, 0xB1);
}
DI void phase_peer_dots(const Params& p, int layer, int wave) {
  const int tid = otid_w(wave), lane = tid & 63, wid = tid >> 6, c = lane & 7, r = lane >> 3;
  const int x = blockIdx.x & 7, wslot = (blockIdx.x >> 3) * 8 + wid, nslot = (gridDim.x >> 3) * 8;
  const unsigned char* ub = W_UB(p) + (size_t)x * (PEER_N * 128);
  const unsigned c16 = (unsigned)c * 16u;
  u16* pd = W_Y(p);
  u32x4 iAa, iBa, iAb, iBb;
  u32x4 hAa, hBa, hAb, hBb, rrA[16], rrB[16];
  int xq[4];
  float xscale;
#define DOTS_QUANT(HA, HB) do { float _xv[16]; \
    _Pragma("unroll") for (int e = 0; e < 4; ++e) { _xv[2 * e] = bflo(HA[e]); _xv[2 * e + 1] = bfhi(HA[e]); _xv[8 + 2 * e] = bflo(HB[e]); _xv[8 + 2 * e + 1] = bfhi(HB[e]); } \
    float _am = 0.f; _Pragma("unroll") for (int e = 0; e < 16; ++e) _am = fmaxf(_am, fabsf(_xv[e])); \
    _am = DPP_MAX(_am, 0xB1); _am = DPP_MAX(_am, 0x4E); _am = DPP_MAX(_am, 0x141); \
    const float _qs = _am > 0.f ? 127.0f / _am : 0.f; xscale = _am * (1.0f / 127.0f); \
    _Pragma("unroll") for (int k = 0; k < 4; ++k) { \
      const int q0 = __float2int_rn(_xv[4 * k] * _qs), q1 = __float2int_rn(_xv[4 * k + 1] * _qs), q2 = __float2int_rn(_xv[4 * k + 2] * _qs), q3 = __float2int_rn(_xv[4 * k + 3] * _qs); \
      xq[k] = (int)(((unsigned)q0 & 255u) | (((unsigned)q1 & 255u) << 8) | (((unsigned)q2 & 255u) << 16) | ((unsigned)q3 << 24)); } } while (0)
#define DOTS_COMPUTE(T, RR) do { if ((T) < TTOK) { int dd[16]; \
    _Pragma("unroll") for (int g = 0; g < 16; ++g) { int d = 0; \
      _Pragma("unroll") for (int k = 0; k < 4; ++k) d = __builtin_amdgcn_sdot4((int)RR[g][k], xq[k], d, false); \
      dd[g] = d; } \
    const int pA = reduce_scatter8(dd[0], dd[1], dd[2], dd[3], dd[4], dd[5], dd[6], dd[7], c); \
    const int pB = reduce_scatter8(dd[8], dd[9], dd[10], dd[11], dd[12], dd[13], dd[14], dd[15], c); \
    u16* _dst = pd + ((size_t)(T) * 8 + x) * 128 + r * 16 + c;        \
    _dst[0] = (u16)(pack2((float)pA * xscale, 0.f) & 0xffffu); _dst[8] = (u16)(pack2((float)pB * xscale, 0.f) & 0xffffu); } } while (0)
  int t = wslot;
  PEER_META(t, iAa, iBa, hAa, hBa);
  PEER_META(t + nslot, iAb, iBb, hAb, hBb);
  PEER_GATHER(ub, iAa, iBa, rrA);
  for (; t < TTOK; t += 2 * nslot) {
    DOTS_QUANT(hAa, hBa);
    PEER_META(t + 2 * nslot, iAa, iBa, hAa, hBa);
    PEER_GATHER(ub, iAb, iBb, rrB);
    DOTS_COMPUTE(t, rrA);
    DOTS_QUANT(hAb, hBb);
    PEER_META(t + 3 * nslot, iAb, iBb, hAb, hBb);
    PEER_GATHER(ub, iAa, iBa, rrA);
    DOTS_COMPUTE(t + nslot, rrB);
  }
#undef DOTS_COMPUTE
#undef DOTS_QUANT
}

DI void phase_peer_w(const Params& p, int layer, int wave) {
  const int tid = otid_w(wave), lane = tid & 63, wid = tid >> 6;
  const u16* pd = W_Y(p);
  const int stride = gridDim.x * 8, t0 = blockIdx.x * 8 + wid;
  for (int t = t0; t < TTOK; t += 2 * stride) {
    unsigned pv[2][8], iv[2];
    f32x2 gv[2];
#pragma unroll
    for (int u = 0; u < 2; ++u) {
      const int tu = (t + u * stride) < TTOK ? (t + u * stride) : t0;
#pragma unroll
      for (int xx = 0; xx < 8; ++xx) pv[u][xx] = *(const unsigned*)(pd + ((size_t)tu * 8 + xx) * 128 + 2 * lane);
      iv[u] = *(const unsigned*)(W_IDX(p) + (size_t)tu * 128 + 2 * lane);
      gv[u] = *(const f32x2*)(W_G(p) + (size_t)tu * 128 + 2 * lane);
    }
#pragma unroll
    for (int u = 0; u < 2; ++u) {
      const int tu = t + u * stride;
      if (tu < TTOK) {
        float s0 = 0.f, s1 = 0.f;
#pragma unroll
        for (int xx = 0; xx < 8; ++xx) { s0 += bflo(pv[u][xx]); s1 += bfhi(pv[u][xx]); }
        const int e0 = (int)(iv[u] & 0xffffu), e1 = (int)(iv[u] >> 16);
        const float a0 = s0 * W_SU(p)[e0], a1 = s1 * W_SU(p)[e1];
        const float w0 = gv[u][0] * (0.5f * a0 * (1.0f + erff(a0 * 0.7071067811865476f))) * W_SV(p)[e0];
        const float w1 = gv[u][1] * (0.5f * a1 * (1.0f + erff(a1 * 0.7071067811865476f))) * W_SV(p)[e1];
        *(unsigned*)(W_W16(p) + (size_t)tu * 128 + 2 * lane) = pack2(w0, w1);
      }
    }
  }
}

#define PEER_META_V(T, IA, IB, WA, WB, HR) do { const int _t = (T) < TTOK ? (T) : wslot; \
    IA = *(const u32x4*)(W_IDX(p) + (size_t)_t * 128 + r * 16); IB = *(const u32x4*)(W_IDX(p) + (size_t)_t * 128 + r * 16 + 8); \
    WA = *(const u32x4*)(W_W16(p) + (size_t)_t * 128 + r * 16); WB = *(const u32x4*)(W_W16(p) + (size_t)_t * 128 + r * 16 + 8); \
    HR = *(const u32x2*)(W_H(p) + (size_t)_t * DM + ocol); } while (0)
DI float swap32_add(float a, float b) {
  const u32x2 r = __builtin_amdgcn_permlane32_swap(__float_as_uint(a), __float_as_uint(b), false, false);
  return __uint_as_float(r[0]) + __uint_as_float(r[1]);
}
DI float swap16_add(float a, float b) {
  const u32x2 r = __builtin_amdgcn_permlane16_swap(__float_as_uint(a), __float_as_uint(b), false, false);
  return __uint_as_float(r[0]) + __uint_as_float(r[1]);
}
DI void phase_peer_v(const Params& p, int layer, int wave) {
  const int tid = otid_w(wave), lane = tid & 63, wid = tid >> 6, c = lane & 7, r = lane >> 3;
  const int x = blockIdx.x & 7, wslot = (blockIdx.x >> 3) * 8 + wid, nslot = (gridDim.x >> 3) * 8;
  const unsigned char* vb = W_VB(p) + (size_t)x * (PEER_N * 128);
  const unsigned c16 = (unsigned)c * 16u;
  u16* y2 = W_Y(p);
  const int ocol = x * 128 + 16 * c + 4 * ((lane >> 4) & 1) + 8 * (lane >> 5);
  u32x4 iAa, iBa, iAb, iBb;
  u32x4 wAa, wBa, wAb, wBb, wA, wB;
  u32x2 hRa, hRb, hR;
  u32x4 rrA[16], rrB[16];
#define V_COMPUTE(T, RR) do { if ((T) < TTOK) { f32x2 acc[8]; \
    _Pragma("unroll") for (int i = 0; i < 8; ++i) acc[i] = (f32x2){0.f, 0.f}; \
    _Pragma("unroll") for (int g = 0; g < 16; ++g) { \
      const unsigned _ww = (g < 8 ? wA : wB)[(g >> 1) & 3]; const float wj = (g & 1) ? bfhi(_ww) : bflo(_ww); \
      const f32x2 wj2 = (f32x2){wj, wj}; \
      _Pragma("unroll") for (int k = 0; k < 4; ++k) { \
        const f32x2 lo = __builtin_amdgcn_cvt_pk_f32_fp8((int)RR[g][k], false), hi = __builtin_amdgcn_cvt_pk_f32_fp8((int)RR[g][k], true); \
        acc[2 * k] += wj2 * lo; acc[2 * k + 1] += wj2 * hi; } } \
    float P8[8], Q4[4]; \
    _Pragma("unroll") for (int i = 0; i < 8; ++i) P8[i] = swap32_add(acc[i >> 1][i & 1], acc[(i + 8) >> 1][i & 1]);     \
    _Pragma("unroll") for (int i = 0; i < 4; ++i) Q4[i] = swap16_add(P8[i], P8[i + 4]);                                 \
    _Pragma("unroll") for (int i = 0; i < 4; ++i) Q4[i] += DPP_F(Q4[i], 0x128);                                         \
    if ((lane & 8) == 0) { u32x2 _o; \
      _o[0] = pack2(ALPHA * bflo(hR[0]) + Q4[0], ALPHA * bfhi(hR[0]) + Q4[1]); \
      _o[1] = pack2(ALPHA * bflo(hR[1]) + Q4[2], ALPHA * bfhi(hR[1]) + Q4[3]); \
      *(u32x2*)(y2 + (size_t)(T) * DM + ocol) = _o; } } } while (0)
  int t = wslot;
  PEER_META_V(t, iAa, iBa, wAa, wBa, hRa);
  PEER_META_V(t + nslot, iAb, iBb, wAb, wBb, hRb);
  PEER_GATHER(vb, iAa, iBa, rrA);
  for (; t < TTOK; t += 2 * nslot) {
    wA = wAa; wB = wBa; hR = hRa;
    PEER_META_V(t + 2 * nslot, iAa, iBa, wAa, wBa, hRa);
    PEER_GATHER(vb, iAb, iBb, rrB);
    V_COMPUTE(t, rrA);
    wA = wAb; wB = wBb; hR = hRb;
    PEER_META_V(t + 3 * nslot, iAb, iBb, wAb, wBb, hRb);
    PEER_GATHER(vb, iAa, iBa, rrA);
    V_COMPUTE(t + nslot, rrB);
  }
#undef V_COMPUTE
}

#define XB_TMO      128
#define XB_XCNT(j)  (256  + 64 * (j))
#define XB_XSUB(j)  (1280 + 64 * (j))
#define XB_XGEN(j)  (2304 + 64 * (j))
#define XB_TOP      3328
#define XB_TOPGEN   3392
#define XCD_BAR_WORDS 3456
#define XB_SPIN_CAP (1u << 22)
DI unsigned xb_ld(unsigned* p)              { return __hip_atomic_load(p, __ATOMIC_RELAXED, __HIP_MEMORY_SCOPE_AGENT); }
DI unsigned xb_add(unsigned* p, unsigned v) { return __hip_atomic_fetch_add(p, v, __ATOMIC_RELAXED, __HIP_MEMORY_SCOPE_AGENT); }
DI unsigned xb_xcc_id() { return (unsigned)__builtin_amdgcn_s_getreg((3 << 11) | 20) & 0xFu; }
#define XB_SPIN(cond, bar) do { unsigned _sp = 0; while (cond) { __builtin_amdgcn_s_sleep(1); \
    if ((++_sp & 255u) == 0u) { if (xb_ld(&(bar)[XB_TMO])) break; if (_sp > XB_SPIN_CAP) { atomicAdd(&(bar)[XB_TMO], 1u); break; } } } } while (0)
DI bool is_thread0(int wave) { unsigned z = 0u; asm volatile("" : "+v"(z)); return wave == 0 && __builtin_amdgcn_mbcnt_hi(~0u, __builtin_amdgcn_mbcnt_lo(~0u, z)) == 0u; }
DI void xcd_barrier_complete(unsigned* bar, unsigned x, unsigned& nloc, unsigned& nx) {
  const unsigned G = gridDim.x;
  unsigned sum, cnt, mine, sp = 0u;
  for (;;) {
    sum = 0u; cnt = 0u; mine = 0u;
#pragma unroll
    for (unsigned j = 0; j < 16; ++j) { const unsigned c = xb_ld(&bar[XB_XCNT(j)]); sum += c; cnt += (c > 0u) ? 1u : 0u; mine = (j == x) ? c : mine; }
    if (sum == G) break;
    __builtin_amdgcn_s_sleep(1);
    if ((++sp & 255u) == 0u) { if (xb_ld(&bar[XB_TMO])) break; if (sp > XB_SPIN_CAP) { atomicAdd(&bar[XB_TMO], 1u); break; } }
  }
  nloc = mine > 0u ? mine : 1u; nx = cnt > 0u ? cnt : 1u;
}
DI void xcd_barrier(unsigned* bar, volatile LAS unsigned* st, int wave) {
  asm volatile("s_waitcnt vmcnt(0)" ::: "memory");
  __syncthreads();
  if (is_thread0(wave)) {
    const unsigned x = xb_xcc_id();
    __builtin_amdgcn_s_waitcnt(0);
    unsigned nloc = st[0], nx = st[1];
    if (nloc == 0u) { xcd_barrier_complete(bar, x, nloc, nx); st[0] = nloc; st[1] = nx; }
    const unsigned old = xb_add(&bar[XB_XSUB(x)], 1u);
    const unsigned gen = old / nloc;
    if (old + 1u == (gen + 1u) * nloc) {
      __builtin_amdgcn_fence(__ATOMIC_RELEASE, "agent");
      asm volatile("s_waitcnt vmcnt(0)" ::: "memory");
      const unsigned og = xb_add(&bar[XB_TOP], 1u);
      const unsigned tg = og / nx;
      if (og + 1u == (tg + 1u) * nx) xb_add(&bar[XB_TOPGEN], 1u);
      else XB_SPIN(xb_ld(&bar[XB_TOPGEN]) == tg, bar);
      __builtin_amdgcn_fence(__ATOMIC_ACQUIRE, "agent");
      xb_add(&bar[XB_XGEN(x)], 1u);
      asm volatile("s_waitcnt vmcnt(0)" ::: "memory");
    } else {
      XB_SPIN(xb_ld(&bar[XB_XGEN(x)]) == gen, bar);
      __builtin_amdgcn_fence(__ATOMIC_ACQUIRE, "agent");
      asm volatile("s_waitcnt vmcnt(0)" ::: "memory");
    }
  }
  __syncthreads();
}

__global__ void __launch_bounds__(NTHREADS, 2) mega(Params p) {
  extern __shared__ __attribute__((aligned(16))) char smem[];
  cg::grid_group grid = cg::this_grid();
  const int wave = __builtin_amdgcn_readfirstlane((int)(threadIdx.x >> 6));
  unsigned* bar = (unsigned*)(p.ws + WS_BAR);
  volatile LAS unsigned* st = (volatile LAS unsigned*)((lchar*)smem + LDS_XB);
  if (threadIdx.x == 0) { st[0] = 0u; st[1] = 0u; (void)xb_add(&bar[XB_XCNT(xb_xcc_id())], 1u); }
  __syncthreads();
  phase_prologue(p, smem, wave);
  grid.sync();
  phase_fold(p, smem, wave);
  xcd_barrier(bar, st, wave);
#pragma unroll 1
  for (int step = 0; step < DEPTH * 9; ++step) {
    const int layer = step / 9, ph = step - layer * 9;
    if (ph == 0 || ph == 2 || ph == 4) phase_gemm(p, layer, ph >> 1, smem, wave);
    else if (ph == 1) phase_attn(p, layer, smem, wave);
    else if (ph == 3 || ph == 8) phase_ln(p, layer, ph == 8, wave);
    else if (ph == 5) phase_peer_dots(p, layer, wave);
    else if (ph == 6) phase_peer_w(p, layer, wave);
    else phase_peer_v(p, layer, wave);
    if (step + 1 < DEPTH * 9) xcd_barrier(bar, st, wave);
  }
}

extern "C" void kernel_launch(void* const* d_in, const int* in_sizes, int n_in, void* d_out, int out_size, void* d_ws, size_t ws_size,
                              hipStream_t stream) {
  static int grid_blocks = 0;
  if (grid_blocks == 0) {
    if (ws_size < WS_END) { fprintf(stderr, "kernel_launch: workspace too small: need %zu, got %zu\n", (size_t)WS_END, ws_size); grid_blocks = -1; return; }
    int dev = 0, cus = 0, per_cu = 0;
    hipGetDevice(&dev);
    hipDeviceGetAttribute(&cus, hipDeviceAttributeMultiprocessorCount, dev);
    hipFuncSetAttribute((const void*)mega, hipFuncAttributeMaxDynamicSharedMemorySize, LDS_BYTES);
    hipOccupancyMaxActiveBlocksPerMultiprocessor(&per_cu, (const void*)mega, NTHREADS, LDS_BYTES);
    if (per_cu < 1) per_cu = 1;
    if (per_cu > 1) per_cu = 1;
    grid_blocks = cus * per_cu;
  }
  if (grid_blocks < 0) return;
  Params p{};
  for (int i = 0; i < 21; ++i) p.in[i] = (const float*)d_in[i];
  p.out = (float*)d_out;
  p.ws = (char*)d_ws;
  if (hipMemsetAsync((char*)d_ws + WS_BAR, 0, 16384, stream) != hipSuccess) { fprintf(stderr, "kernel_launch: memset of the barrier words failed\n"); return; }
  void* args[] = {&p};
  hipError_t e = hipLaunchCooperativeKernel((const void*)mega, dim3(grid_blocks), dim3(NTHREADS), args, LDS_BYTES, stream);
  if (e != hipSuccess) fprintf(stderr, "cooperative launch failed: %s (grid %d)\n", hipGetErrorString(e), grid_blocks);
}
```

```cpp
#include <hip/hip_runtime.h>
#include <hip/hip_cooperative_groups.h>
#include <cstdio>
#include <cstdint>
namespace cg = cooperative_groups;

typedef unsigned short u16;
typedef __attribute__((ext_vector_type(8))) short bf16x8;
typedef __attribute__((ext_vector_type(4))) float f32x4;
typedef __attribute__((ext_vector_type(4))) unsigned u32x4;
typedef __attribute__((ext_vector_type(2))) unsigned u32x2;
typedef __attribute__((ext_vector_type(2))) float f32x2;
#define DI __device__ __forceinline__
#define LAS __attribute__((address_space(3)))
typedef LAS char lchar;

#define DM 1024
#define NBATCH 32
#define SEQ 2048
#define NMETA 16
#define LSEQ 2064
#define TTOK 66048
#define DEPTH 4
#define INC 3072
#define LP 2112
#define PEER_N 16384
#define NTHREADS 512
#define LDS_MISC 69632
#define LDS_HALF 70656
#define LDS_XB 141312
#define LDS_BYTES 141328

#define ALPHA 1.681792830507429f
#define LOG2E 1.4426950408889634f

static constexpr size_t WS_WIN  = 0;
static constexpr size_t WS_WOUT = WS_WIN  + (size_t)4 * 3072 * 1024 * 2;
static constexpr size_t WS_WQB  = WS_WOUT + (size_t)4 * 1024 * 1024 * 2;
static constexpr size_t WS_SKB  = WS_WQB  + (size_t)4 * 1024 * 2048 * 2;
static constexpr size_t WS_WSC  = WS_SKB  + (size_t)4 * 16 * 128 * 128 * 2;
static constexpr size_t WS_UB   = WS_WSC  + (size_t)4 * 2048 * 1024 * 2;
static constexpr size_t WS_VB   = WS_UB   + (size_t)PEER_N * 1024;
static constexpr size_t WS_SU   = WS_VB   + (size_t)PEER_N * 1024;
static constexpr size_t WS_SV   = WS_SU   + (size_t)PEER_N * 4;
static constexpr size_t WS_H    = WS_SV   + (size_t)PEER_N * 4;
static constexpr size_t WS_MIX  = WS_H    + (size_t)TTOK * 1024 * 2;
static constexpr size_t WS_BIG  = WS_MIX  + (size_t)TTOK * 1024 * 2;
static constexpr size_t WS_VT   = WS_BIG  + (size_t)(TTOK + 64) * 3072 * 2;
static constexpr size_t WS_IDX  = WS_VT   + (size_t)NBATCH * 4 * 128 * LP * 2;
static constexpr size_t WS_G    = WS_IDX  + (size_t)TTOK * 128 * 4;
static constexpr size_t WS_W16  = WS_G    + (size_t)TTOK * 128 * 4;
static constexpr size_t WS_BAR  = WS_W16  + (size_t)TTOK * 128 * 2;
static constexpr size_t WS_END  = WS_BAR  + 16384;

struct Params {
  const float* in[21];
  float* out;
  char* ws;
};
#define P_X(p) ((p).in[0])
#define P_META(p) ((p).in[1])
#define P_LN_IN_G(p) ((p).in[2])
#define P_LN_IN_B(p) ((p).in[3])
#define P_REL_BIAS(p) ((p).in[4])
#define P_W_IN(p) ((p).in[5])
#define P_CONV_W(p) ((p).in[6])
#define P_LQ1(p) ((p).in[7])
#define P_LK1(p) ((p).in[8])
#define P_LQ2(p) ((p).in[9])
#define P_LK2(p) ((p).in[10])
#define P_SUBLN_G(p) ((p).in[11])
#define P_W_OUT(p) ((p).in[12])
#define P_LN1_G(p) ((p).in[13])
#define P_LN1_B(p) ((p).in[14])
#define P_W_Q(p) ((p).in[15])
#define P_SUB_KEYS(p) ((p).in[16])
#define P_PEER_U(p) ((p).in[17])
#define P_PEER_V(p) ((p).in[18])
#define P_LN2_G(p) ((p).in[19])
#define P_LN2_B(p) ((p).in[20])
#define W_WIN(p) ((u16*)((p).ws + WS_WIN))
#define W_WOUT(p) ((u16*)((p).ws + WS_WOUT))
#define W_WQB(p) ((u16*)((p).ws + WS_WQB))
#define W_SKB(p) ((u16*)((p).ws + WS_SKB))
#define W_WSC(p) ((u16*)((p).ws + WS_WSC))
#define W_UB(p) ((unsigned char*)((p).ws + WS_UB))
#define W_VB(p) ((unsigned char*)((p).ws + WS_VB))
#define W_SU(p) ((float*)((p).ws + WS_SU))
#define W_SV(p) ((float*)((p).ws + WS_SV))
#define W_H(p) ((u16*)((p).ws + WS_H))
#define W_MIX(p) ((u16*)((p).ws + WS_MIX))
#define W_PROJ(p) ((u16*)((p).ws + WS_BIG))
#define W_Y(p) ((u16*)((p).ws + WS_BIG))
#define W_VT(p) ((u16*)((p).ws + WS_VT))
#define W_IDX(p) ((u16*)((p).ws + WS_IDX))
#define W_W16(p) ((u16*)((p).ws + WS_W16))
#define W_G(p) ((float*)((p).ws + WS_G))

DI u16 f2bf(float x) { unsigned u = __float_as_uint(x); u += 0x7fffu + ((u >> 16) & 1u); return (u16)(u >> 16); }
typedef __attribute__((ext_vector_type(2))) __bf16 bf16x2_t;
DI unsigned pack2(float a, float b) { const bf16x2_t v = {(__bf16)a, (__bf16)b}; return __builtin_bit_cast(unsigned, v); }
DI float bflo(unsigned w) { return __uint_as_float(w << 16); }
DI float bfhi(unsigned w) { return __uint_as_float(w & 0xffff0000u); }
DI int otid_w(int wave) { unsigned z = 0u; asm volatile("" : "+v"(z)); int t = wave * 64 + (int)__builtin_amdgcn_mbcnt_hi(~0u, __builtin_amdgcn_mbcnt_lo(~0u, z)); asm volatile("" : "+v"(t)); return t; }
#define DPP_ADD(v, ctrl) ((v) + __int_as_float(__builtin_amdgcn_update_dpp(0, __float_as_int(v), (ctrl), 0xf, 0xf, true)))
DI float wave_sum(float v) {
  v = DPP_ADD(v, 0xB1);
  v = DPP_ADD(v, 0x4E);
  v = DPP_ADD(v, 0x141);
  v = DPP_ADD(v, 0x140);
  const int iv = __float_as_int(v);
  return __int_as_float(__builtin_amdgcn_readlane(iv, 0)) + __int_as_float(__builtin_amdgcn_readlane(iv, 16)) +
         __int_as_float(__builtin_amdgcn_readlane(iv, 32)) + __int_as_float(__builtin_amdgcn_readlane(iv, 48));
}
#define DPP_MAX(v, ctrl) fmaxf((v), __int_as_float(__builtin_amdgcn_update_dpp(0, __float_as_int(v), (ctrl), 0xf, 0xf, true)))
DI float wave_max_nonneg(float v) {
  v = DPP_MAX(v, 0xB1); v = DPP_MAX(v, 0x4E); v = DPP_MAX(v, 0x141); v = DPP_MAX(v, 0x140);
  const int iv = __float_as_int(v);
  return fmaxf(fmaxf(__int_as_float(__builtin_amdgcn_readlane(iv, 0)), __int_as_float(__builtin_amdgcn_readlane(iv, 16))),
               fmaxf(__int_as_float(__builtin_amdgcn_readlane(iv, 32)), __int_as_float(__builtin_amdgcn_readlane(iv, 48))));
}
DI float shx16(float v) { return __int_as_float(__builtin_amdgcn_ds_swizzle(__float_as_int(v), 0x401F)); }
DI float shx32(float v, int idx32) { return __int_as_float(__builtin_amdgcn_ds_bpermute(idx32, __float_as_int(v))); }
DI f32x4 mfma16(bf16x8 a, bf16x8 b, f32x4 c) { return __builtin_amdgcn_mfma_f32_16x16x32_bf16(a, b, c, 0, 0, 0); }
DI float fast_exp2(float x) { return __builtin_amdgcn_exp2f(x); }

DI void convert_straight(const float* __restrict__ src, u16* __restrict__ dst, size_t n8, size_t gtid, size_t gthreads) {
  for (size_t i = gtid; i < n8; i += gthreads) {
    const f32x4 a = *(const f32x4*)(src + i * 8), b = *(const f32x4*)(src + i * 8 + 4);
    u32x4 o; o[0] = pack2(a[0], a[1]); o[1] = pack2(a[2], a[3]); o[2] = pack2(b[0], b[1]); o[3] = pack2(b[2], b[3]);
    *(u32x4*)(dst + i * 8) = o;
  }
}

DI void transpose_tile(const float* __restrict__ src, int ldn, u16* __restrict__ dst, int ldk, int k0, int n0, float* sm, int tid) {
#pragma unroll
  for (int i = 0; i < 4; ++i) {
    const int r = (tid >> 4) + 16 * i, c4 = tid & 15;
    const f32x4 v = *(const f32x4*)(src + (size_t)(k0 + r) * ldn + n0 + 4 * c4);
    sm[r * 65 + 4 * c4 + 0] = v[0]; sm[r * 65 + 4 * c4 + 1] = v[1]; sm[r * 65 + 4 * c4 + 2] = v[2]; sm[r * 65 + 4 * c4 + 3] = v[3];
  }
  __syncthreads();
#pragma unroll
  for (int i = 0; i < 2; ++i) {
    const int n = (tid >> 3) + 32 * i, kc = tid & 7;
    u32x4 o;
#pragma unroll
    for (int e = 0; e < 4; ++e) o[e] = pack2(sm[(8 * kc + 2 * e) * 65 + n], sm[(8 * kc + 2 * e + 1) * 65 + n]);
    *(u32x4*)(dst + (size_t)(n0 + n) * ldk + k0 + 8 * kc) = o;
  }
  __syncthreads();
}

template <int LAYOUT> DI int col0(int lane, int hh) { return LAYOUT ? 16 * lane + 8 * hh : hh * 512 + 8 * lane; }
template <int LAYOUT>
DI void ln_row(float (&v)[16], const float* __restrict__ g, const float* __restrict__ b, int lane) {
  float s = 0.f;
#pragma unroll
  for (int i = 0; i < 16; ++i) s += v[i];
  const float mu = wave_sum(s) * (1.0f / 1024.0f);
  float q = 0.f;
#pragma unroll
  for (int i = 0; i < 16; ++i) { const float d = v[i] - mu; q += d * d; }
  const float rstd = rsqrtf(wave_sum(q) * (1.0f / 1024.0f) + 1e-5f);
#pragma unroll
  for (int hh = 0; hh < 2; ++hh) {
    const int c = col0<LAYOUT>(lane, hh);
    const f32x4 g0 = *(const f32x4*)(g + c), g1 = *(const f32x4*)(g + c + 4), b0 = *(const f32x4*)(b + c), b1 = *(const f32x4*)(b + c + 4);
#pragma unroll
    for (int e = 0; e < 4; ++e) {
      v[hh * 8 + e] = (v[hh * 8 + e] - mu) * rstd * g0[e] + b0[e];
      v[hh * 8 + 4 + e] = (v[hh * 8 + 4 + e] - mu) * rstd * g1[e] + b1[e];
    }
  }
}
template <int LAYOUT>
DI void store_row_bf16(u16* __restrict__ dst, const float (&v)[16], int lane) {
#pragma unroll
  for (int hh = 0; hh < 2; ++hh) {
    u32x4 o;
#pragma unroll
    for (int e = 0; e < 4; ++e) o[e] = pack2(v[hh * 8 + 2 * e], v[hh * 8 + 2 * e + 1]);
    *(u32x4*)(dst + col0<LAYOUT>(lane, hh)) = o;
  }
}
template <int LAYOUT>
DI void load_row_bf16(const u16* __restrict__ src, float (&v)[16], int lane) {
#pragma unroll
  for (int hh = 0; hh < 2; ++hh) {
    const u32x4 a = *(const u32x4*)(src + col0<LAYOUT>(lane, hh));
#pragma unroll
    for (int e = 0; e < 4; ++e) { v[hh * 8 + 2 * e] = bflo(a[e]); v[hh * 8 + 2 * e + 1] = bfhi(a[e]); }
  }
}
template <int LAYOUT>
DI void load_row_f32(const float* __restrict__ src, float (&v)[16], int lane) {
#pragma unroll
  for (int hh = 0; hh < 2; ++hh) {
    const int c = col0<LAYOUT>(lane, hh);
    const f32x4 a = *(const f32x4*)(src + c), b = *(const f32x4*)(src + c + 4);
#pragma unroll
    for (int e = 0; e < 4; ++e) { v[hh * 8 + e] = a[e]; v[hh * 8 + 4 + e] = b[e]; }
  }
}

enum { EPI_PROJ = 0, EPI_VT = 1, EPI_OUT = 2, EPI_TOPK = 3, EPI_FOLD = 4 };

template <bool SWAP>
DI void gemm_mainloop(const u16* __restrict__ A, int lda, const u16* __restrict__ Bt, int ldb, int K, int m0, int n0, char* smem,
                      f32x4 (&acc)[4][4], int tid) {
  const int lane = tid & 63, wid = tid >> 6, wm = wid >> 1, wn = wid & 1;
  const int srow = tid >> 3, skc = tid & 7;
  const u16* ap = A + (size_t)(m0 + srow) * lda + skc * 8;
  const u16* bp = Bt + (size_t)(n0 + srow) * ldb + skc * 8;
  const int dst0 = (((srow >> 4) * 2 + (skc >> 2)) * 1024) + (((skc & 3) * 16 + (srow & 15)) * 16);
#pragma unroll
  for (int i = 0; i < 4; ++i)
#pragma unroll
    for (int j = 0; j < 4; ++j) acc[i][j] = (f32x4){0.f, 0.f, 0.f, 0.f};
  u32x4 ra[4], rb[4];
#pragma unroll
  for (int j = 0; j < 4; ++j) { ra[j] = *(const u32x4*)(ap + (size_t)j * 32 * lda); rb[j] = *(const u32x4*)(bp + (size_t)j * 32 * ldb); }
#pragma unroll
  for (int j = 0; j < 4; ++j) { *(u32x4*)(smem + dst0 + j * 4096) = ra[j]; *(u32x4*)(smem + 16384 + dst0 + j * 4096) = rb[j]; }
  __syncthreads();
  const int KT = K >> 6;
  for (int kt = 0; kt < KT; ++kt) {
    char* cur = smem + (kt & 1) * 32768;
    char* nxt = smem + ((kt + 1) & 1) * 32768;
    const bool more = (kt + 1 < KT);
    if (more) {
      const u16* ap2 = ap + (kt + 1) * 64;
      const u16* bp2 = bp + (kt + 1) * 64;
#pragma unroll
      for (int j = 0; j < 4; ++j) { ra[j] = *(const u32x4*)(ap2 + (size_t)j * 32 * lda); rb[j] = *(const u32x4*)(bp2 + (size_t)j * 32 * ldb); }
    }
#pragma unroll
    for (int ks = 0; ks < 2; ++ks) {
      bf16x8 af[4], bfr[4];
#pragma unroll
      for (int i = 0; i < 4; ++i) af[i] = *(const bf16x8*)(cur + (((wm * 4 + i) * 2 + ks) * 1024) + lane * 16);
#pragma unroll
      for (int j = 0; j < 4; ++j) bfr[j] = *(const bf16x8*)(cur + 16384 + (((wn * 4 + j) * 2 + ks) * 1024) + lane * 16);
#pragma unroll
      for (int i = 0; i < 4; ++i)
#pragma unroll
        for (int j = 0; j < 4; ++j) acc[i][j] = SWAP ? mfma16(bfr[j], af[i], acc[i][j]) : mfma16(af[i], bfr[j], acc[i][j]);
    }
    if (more) {
#pragma unroll
      for (int j = 0; j < 4; ++j) { *(u32x4*)(nxt + dst0 + j * 4096) = ra[j]; *(u32x4*)(nxt + 16384 + dst0 + j * 4096) = rb[j]; }
    }
    __syncthreads();
  }
}

DI void ce_desc(float& hi, float& lo) { const float a = hi, b = lo; hi = fmaxf(a, b); lo = fminf(a, b); }
DI void bitonic_merge16(float (&v)[16]) {
#pragma unroll
  for (int j = 8; j > 0; j >>= 1)
#pragma unroll
    for (int i = 0; i < 16; ++i) if ((i & j) == 0) ce_desc(v[i], v[i | j]);
}
DI void bitonic_sort16(float (&v)[16]) {
#pragma unroll
  for (int k = 2; k <= 16; k <<= 1)
#pragma unroll
    for (int j = k >> 1; j > 0; j >>= 1)
#pragma unroll
      for (int i = 0; i < 16; ++i) {
        const int l = i ^ j;
        if (l > i) { if ((i & k) == 0 || k == 16) ce_desc(v[i], v[l]); else ce_desc(v[l], v[i]); }
      }
}
DI void merge_top16(float (&v)[16], const float (&w)[16]) {
#pragma unroll
  for (int i = 0; i < 16; ++i) v[i] = fmaxf(v[i], w[15 - i]);
  bitonic_merge16(v);
}
DI void insert16(float (&v)[16], float x) {
#pragma unroll
  for (int j = 0; j < 16; ++j) { const float hi = fmaxf(v[j], x); x = fminf(v[j], x); v[j] = hi; }
}

DI void gemm_tile_fold(const u16* A, int lda, const u16* Bt, int ldb, int K, int m0, char* smem, u16* dstT, int tid) {
  const int lane = tid & 63, wid = tid >> 6, wm = wid >> 1, wn = wid & 1, g = lane >> 4, l15 = lane & 15;
  f32x4 acc[4][4];
  gemm_mainloop<false>(A, lda, Bt, ldb, K, m0, 0, smem, acc, tid);
#pragma unroll
  for (int i = 0; i < 4; ++i)
#pragma unroll
    for (int j = 0; j < 4; ++j) {
      const int m = m0 + wm * 64 + 16 * i + 4 * g, n = wn * 64 + 16 * j + l15;
      u32x2 o; o[0] = pack2(acc[i][j][0], acc[i][j][1]); o[1] = pack2(acc[i][j][2], acc[i][j][3]);
      *(u32x2*)(dstT + (size_t)n * 1024 + m) = o;
    }
}

#define GK 1024
#define HTB 16384
DI int lds_byte(int r, int c) {
  const int st = (r >> 4) * 2 + (c >> 5), rr = r & 15, cc = c & 31, ob = rr * 64 + cc * 2;
  return st * 1024 + (ob ^ (((ob >> 9) & 1) << 5));
}
DI void stage_rc(int b, int& R, int& C) {
  const int st = b / 1024, sb = b % 1024, swz = sb ^ (((sb >> 9) & 1) << 5);
  R = (st >> 1) * 16 + swz / 64; C = (st & 1) * 32 + (swz % 64) / 2;
}
#define G_SA(b, h) (shm + ((b) * 2 + (h)) * HTB)
#define G_SB(b, h) (shm + (4 + (b) * 2 + (h)) * HTB)
#define G_STAGE_(P, BASE, br, kt, O0, O1) do { const char* _g = (const char*)((BASE) + (size_t)(br) * GK + (kt) * 64); \
    __builtin_amdgcn_global_load_lds((const unsigned*)(_g + (O0)), (LAS unsigned*)((P) + tid * 16), 16, 0, 0); \
    __builtin_amdgcn_global_load_lds((const unsigned*)(_g + (O1)), (LAS unsigned*)((P) + tid * 16 + 8192), 16, 0, 0); } while (0)
#define G_STAGEA(P, BASE, br, kt) G_STAGE_(P, BASE, br, kt, goffA0, goffA1)
#define G_STAGEB(P, BASE, br, kt) G_STAGE_(P, BASE, br, kt, goff0, goff1)
#define G_LDA(dst, b, h) _Pragma("unroll") for (int m = 0; m < 4; ++m) _Pragma("unroll") for (int k = 0; k < 2; ++k) \
    dst[m][k] = *(const LAS bf16x8*)(G_SA(b, h) + lds_byte(wr * 64 + m * 16 + fr, k * 32 + fq * 8))
#define G_LDB(dst, b, h) _Pragma("unroll") for (int n = 0; n < 2; ++n) _Pragma("unroll") for (int k = 0; k < 2; ++k) \
    dst[n][k] = *(const LAS bf16x8*)(G_SB(b, h) + lds_byte(wc * 32 + n * 16 + fr, k * 32 + fq * 8))
#define G_MMA(ai, bj, At, Bx) do { __builtin_amdgcn_s_setprio(1); \
    _Pragma("unroll") for (int m = 0; m < 4; ++m) _Pragma("unroll") for (int n = 0; n < 2; ++n) _Pragma("unroll") for (int k = 0; k < 2; ++k) \
      acc[ai][bj][m][n] = __builtin_amdgcn_mfma_f32_16x16x32_bf16(At[m][k], Bx[n][k], acc[ai][bj][m][n], 0, 0, 0); \
    __builtin_amdgcn_s_setprio(0); } while (0)
#define WAIT_V(n) asm volatile("s_waitcnt vmcnt(" #n ")" ::: "memory")
#define WAIT_L(n) asm volatile("s_waitcnt lgkmcnt(" #n ")" ::: "memory")
#define BAR __builtin_amdgcn_s_barrier()
#define SCHED __builtin_amdgcn_sched_barrier(0)

DI int perm64(int rho) { return ((rho >> 2) & 3) * 16 + (rho >> 4) * 4 + (rho & 3); }
DI void gemm256_core(const u16* __restrict__ A, const u16* __restrict__ Bt, int brow, int bcol, lchar* shm, int tid, f32x4 (&acc)[2][2][4][2], bool permA, int wid) {
  const int lane = tid & 63, wr = wid >> 2, wc = wid & 3, fr = lane & 15, fq = lane >> 4;
  int r0, c0, r1, c1;
  stage_rc(tid * 16, r0, c0); stage_rc(tid * 16 + 8192, r1, c1);
  const unsigned goff0 = (unsigned)(r0 * GK + c0) * 2u, goff1 = (unsigned)(r1 * GK + c1) * 2u;
  const int pr0 = permA ? ((r0 & 64) | perm64(r0 & 63)) : r0, pr1 = permA ? ((r1 & 64) | perm64(r1 & 63)) : r1;
  const unsigned goffA0 = (unsigned)(pr0 * GK + c0) * 2u, goffA1 = (unsigned)(pr1 * GK + c1) * 2u;
#pragma unroll
  for (int ai = 0; ai < 2; ++ai)
#pragma unroll
    for (int bj = 0; bj < 2; ++bj)
#pragma unroll
      for (int m = 0; m < 4; ++m)
#pragma unroll
        for (int n = 0; n < 2; ++n) acc[ai][bj][m][n] = (f32x4){0.f, 0.f, 0.f, 0.f};
  bf16x8 At[4][2], B0[2][2], B1[2][2];
  const int nt = GK / 64;
  WAIT_V(0);
  __syncthreads();
  G_STAGEB(G_SB(0, 0), Bt, bcol, 0); G_STAGEA(G_SA(0, 0), A, brow, 0);
  G_STAGEB(G_SB(0, 1), Bt, bcol + 128, 0); G_STAGEA(G_SA(0, 1), A, brow + 128, 0);
  if (wr == 1) BAR;
  WAIT_V(4); BAR;
  G_STAGEB(G_SB(1, 0), Bt, bcol, 1); G_STAGEA(G_SA(1, 0), A, brow, 1); G_STAGEB(G_SB(1, 1), Bt, bcol + 128, 1);
  WAIT_V(6); BAR;
  for (int t = 0; t < nt - 2; t += 2) {
    G_LDB(B0, 0, 0); SCHED; G_LDA(At, 0, 0); G_STAGEA(G_SA(1, 1), A, brow + 128, t + 1);
    WAIT_L(8); BAR; WAIT_L(0); G_MMA(0, 0, At, B0); BAR; SCHED;
    G_LDB(B1, 0, 1); G_STAGEB(G_SB(0, 0), Bt, bcol, t + 2);
    BAR; WAIT_L(0); G_MMA(0, 1, At, B1); BAR;
    G_LDA(At, 0, 1); G_STAGEA(G_SA(0, 0), A, brow, t + 2);
    BAR; WAIT_L(0); G_MMA(1, 0, At, B0); BAR; SCHED;
    G_STAGEB(G_SB(0, 1), Bt, bcol + 128, t + 2);
    WAIT_V(6); BAR; G_MMA(1, 1, At, B1); BAR;
    G_LDB(B0, 1, 0); SCHED; G_LDA(At, 1, 0); G_STAGEA(G_SA(0, 1), A, brow + 128, t + 2);
    WAIT_L(8); BAR; WAIT_L(0); G_MMA(0, 0, At, B0); BAR; SCHED;
    G_LDB(B1, 1, 1); G_STAGEB(G_SB(1, 0), Bt, bcol, t + 3);
    BAR; WAIT_L(0); G_MMA(0, 1, At, B1); BAR;
    G_LDA(At, 1, 1); G_STAGEA(G_SA(1, 0), A, brow, t + 3);
    BAR; WAIT_L(0); G_MMA(1, 0, At, B0); BAR; SCHED;
    G_STAGEB(G_SB(1, 1), Bt, bcol + 128, t + 3);
    WAIT_V(6); BAR; G_MMA(1, 1, At, B1); BAR;
  }
  { G_LDB(B0, 0, 0); G_LDA(At, 0, 0); G_STAGEA(G_SA(1, 1), A, brow + 128, nt - 1);
    BAR; WAIT_L(0); G_MMA(0, 0, At, B0); BAR;
    G_LDB(B1, 0, 1); BAR; WAIT_L(0); G_MMA(0, 1, At, B1); BAR;
    G_LDA(At, 0, 1); WAIT_V(4); BAR; WAIT_L(0); G_MMA(1, 0, At, B0); G_MMA(1, 1, At, B1); BAR; }
  { G_LDB(B0, 1, 0); G_LDA(At, 1, 0); WAIT_V(2); BAR; WAIT_L(0); G_MMA(0, 0, At, B0); BAR;
    G_LDB(B1, 1, 1); WAIT_V(0); BAR; WAIT_L(0); G_MMA(0, 1, At, B1); BAR;
    G_LDA(At, 1, 1); BAR; WAIT_L(0); G_MMA(1, 0, At, B0); G_MMA(1, 1, At, B1); BAR; }
  if (wr == 0) BAR;
}

DI void gemm256_tile(const Params& p, int mode, int layer, const u16* R, const u16* Cc, int brow, int bcol, lchar* shm, int tid_in, int wid) {
  f32x4 acc[2][2][4][2];
  gemm256_core(R, Cc, brow, bcol, shm, tid_in, acc, true, wid);
  int tid = tid_in;
  asm volatile("" : "+v"(tid));
  const int lane = tid & 63, wr = wid >> 2, wc = wid & 3, fr = lane & 15, fq = lane >> 4;
  if (mode == EPI_PROJ) {
#pragma unroll
    for (int ai = 0; ai < 2; ++ai)
#pragma unroll
      for (int bj = 0; bj < 2; ++bj)
#pragma unroll
        for (int n = 0; n < 2; ++n) {
          const int nc = brow + ai * 128 + wr * 64 + fq * 16, tok = bcol + bj * 128 + wc * 32 + n * 16 + fr;
          u16* dst = W_PROJ(p) + (size_t)tok * INC + nc;
#pragma unroll
          for (int q = 0; q < 2; ++q) {
            const f32x4 va = acc[ai][bj][2 * q][n], vb2 = acc[ai][bj][2 * q + 1][n];
            *(u32x4*)(dst + 8 * q) = (u32x4){pack2(va[0], va[1]), pack2(va[2], va[3]), pack2(vb2[0], vb2[1]), pack2(vb2[2], vb2[3])};
          }
        }
  } else if (mode == EPI_VT) {
#pragma unroll
    for (int ai = 0; ai < 2; ++ai)
#pragma unroll
      for (int bj = 0; bj < 2; ++bj)
#pragma unroll
        for (int n = 0; n < 2; ++n) {
          const int tok = brow + ai * 128 + wr * 64 + fq * 16, nn = bcol + bj * 128 + wc * 32 + n * 16 + fr - 1024;
          const int b = tok / LSEQ, pos = tok - b * LSEQ;
          u16* dst = W_VT(p) + ((size_t)(b * 512 + nn)) * LP + pos;
#pragma unroll
          for (int q = 0; q < 2; ++q) {
            const f32x4 va = acc[ai][bj][2 * q][n], vb2 = acc[ai][bj][2 * q + 1][n];
            *(u32x4*)(dst + 8 * q) = (u32x4){pack2(va[0], va[1]), pack2(va[2], va[3]), pack2(vb2[0], vb2[1]), pack2(vb2[2], vb2[3])};
          }
        }
  } else if (mode == EPI_OUT) {
#pragma unroll
    for (int ai = 0; ai < 2; ++ai)
#pragma unroll
      for (int bj = 0; bj < 2; ++bj) {
        u32x4 hv[2][2];
#pragma unroll
        for (int n = 0; n < 2; ++n) {
          const int nc = brow + ai * 128 + wr * 64 + fq * 16, tok = bcol + bj * 128 + wc * 32 + n * 16 + fr;
          hv[n][0] = *(const u32x4*)(W_H(p) + (size_t)tok * DM + nc); hv[n][1] = *(const u32x4*)(W_H(p) + (size_t)tok * DM + nc + 8);
        }
#pragma unroll
        for (int n = 0; n < 2; ++n) {
          const int nc = brow + ai * 128 + wr * 64 + fq * 16, tok = bcol + bj * 128 + wc * 32 + n * 16 + fr;
          u16* dst = W_Y(p) + (size_t)tok * DM + nc;
#pragma unroll
          for (int q = 0; q < 2; ++q) {
            const f32x4 va = acc[ai][bj][2 * q][n], vb2 = acc[ai][bj][2 * q + 1][n];
            const u32x4 hh = hv[n][q];
            *(u32x4*)(dst + 8 * q) = (u32x4){pack2(ALPHA * bflo(hh[0]) + va[0], ALPHA * bfhi(hh[0]) + va[1]), pack2(ALPHA * bflo(hh[1]) + va[2], ALPHA * bfhi(hh[1]) + va[3]),
                                            pack2(ALPHA * bflo(hh[2]) + vb2[0], ALPHA * bfhi(hh[2]) + vb2[1]), pack2(ALPHA * bflo(hh[3]) + vb2[2], ALPHA * bfhi(hh[3]) + vb2[3])};
          }
        }
      }
  } else {
    LAS float* S = (LAS float*)shm;
    const int tok = (wid & 3) * 64 + lane, kh = wid >> 2;
    float L0[16], L1[16];
#pragma unroll
    for (int ai = 0; ai < 2; ++ai) {
      __syncthreads();
#pragma unroll
      for (int bj = 0; bj < 2; ++bj)
#pragma unroll
        for (int m = 0; m < 4; ++m)
#pragma unroll
          for (int n = 0; n < 2; ++n) {
            const int tk = bj * 128 + wc * 32 + n * 16 + fr, key = wr * 64 + fq * 16 + m * 4;
            *(LAS f32x4*)((lchar*)S + tk * 528 + key * 4) = acc[ai][bj][m][n];
          }
      __syncthreads();
      float v[16];
#pragma unroll 1
      for (int ch = 0; ch < 4; ++ch) {
        float wk[16];
#pragma unroll
        for (int q = 0; q < 4; ++q) {
          const int key = kh * 64 + ch * 16 + 4 * q;
          const f32x4 xv = *(const LAS f32x4*)((lchar*)S + tok * 528 + key * 4);
#pragma unroll
          for (int e = 0; e < 4; ++e) wk[4 * q + e] = __uint_as_float((__float_as_uint(xv[e]) & ~127u) | (unsigned)(key + e));
        }
        bitonic_sort16(wk);
        if (ch == 0) {
#pragma unroll
          for (int i = 0; i < 16; ++i) v[i] = wk[i];
        } else {
          merge_top16(v, wk);
        }
      }
      __syncthreads();
      if (kh == 1) {
#pragma unroll
        for (int q = 0; q < 4; ++q) *(LAS f32x4*)((lchar*)S + tok * 80 + 16 * q) = (f32x4){v[4 * q], v[4 * q + 1], v[4 * q + 2], v[4 * q + 3]};
      }
      __syncthreads();
      if (kh == 0) {
        float wk[16];
#pragma unroll
        for (int q = 0; q < 4; ++q) {
          const f32x4 xv = *(const LAS f32x4*)((lchar*)S + tok * 80 + 16 * q);
          wk[4 * q] = xv[0]; wk[4 * q + 1] = xv[1]; wk[4 * q + 2] = xv[2]; wk[4 * q + 3] = xv[3];
        }
        merge_top16(v, wk);
      }
#pragma unroll
      for (int j = 0; j < 16; ++j) { if (ai == 0) L0[j] = v[j]; else L1[j] = v[j]; }
    }
    __syncthreads();
    LAS unsigned* LL = (LAS unsigned*)shm;
    if (kh == 0) {
#pragma unroll
      for (int j = 0; j < 16; ++j) { LL[tok * 32 + ((j + tok) & 31)] = __float_as_uint(L0[j]); LL[tok * 32 + ((16 + j + tok) & 31)] = __float_as_uint(L1[j]); }
      float s1[16], s2[16], v[16];
#pragma unroll
      for (int j = 0; j < 16; ++j) { s1[j] = __uint_as_float(__float_as_uint(L0[j]) & ~127u); s2[j] = __uint_as_float(__float_as_uint(L1[j]) & ~127u); v[j] = -3.0e38f; }
#pragma unroll
      for (int ch = 0; ch < 4; ++ch) {
        float wk[16];
#pragma unroll
        for (int i = 0; i < 16; ++i) {
          constexpr unsigned char PAIRS[64] = {0, 1, 2, 3, 4, 5, 6, 7, 8, 9, 10, 11, 12, 13, 14, 15, 16, 17, 18, 19, 20, 21, 22, 23, 32, 33, 34, 35, 36, 48, 49, 50, 51, 64, 65, 66, 80, 81, 96, 97, 112, 113, 128, 144, 160, 176, 192, 208, 224, 240, 255, 255, 255, 255, 255, 255, 255, 255, 255, 255, 255, 255, 255, 255};
          const int code = PAIRS[ch * 16 + i];
          if (code == 255) { wk[i] = -3.0e38f; }
          else { const float sm = s1[code >> 4] + s2[code & 15]; wk[i] = __uint_as_float((__float_as_uint(sm) & ~255u) | (unsigned)code); }
        }
        if (ch == 0) {
#pragma unroll
          for (int i = 0; i < 16; ++i) v[i] = wk[i];
        } else {
          bitonic_sort16(wk);
          merge_top16(v, wk);
        }
      }
      float e[16], sum = 0.f;
      const float mx = __uint_as_float(__float_as_uint(v[0]) & ~255u);
#pragma unroll
      for (int j = 0; j < 16; ++j) { e[j] = fast_exp2((__uint_as_float(__float_as_uint(v[j]) & ~255u) - mx) * LOG2E); sum += e[j]; }
      const float inv = 1.0f / sum;
      const int hd = brow >> 8;
      u16* di = W_IDX(p) + (size_t)(bcol + tok) * 128 + hd * 16;
      float* dg = W_G(p) + (size_t)(bcol + tok) * 128 + hd * 16;
      unsigned eid[16];
#pragma unroll
      for (int k = 0; k < 16; ++k) {
        const unsigned code = __float_as_uint(v[k]) & 255u;
        const unsigned i1 = LL[tok * 32 + (((code >> 4) + tok) & 31)] & 127u, i2 = LL[tok * 32 + ((16 + (code & 15u) + tok) & 31)] & 127u;
        eid[k] = i1 * 128u + i2;
      }
#pragma unroll
      for (int q = 0; q < 4; ++q) *(f32x4*)(dg + 4 * q) = (f32x4){e[4 * q] * inv, e[4 * q + 1] * inv, e[4 * q + 2] * inv, e[4 * q + 3] * inv};
#pragma unroll
      for (int q = 0; q < 2; ++q)
        *(u32x4*)(di + 8 * q) = (u32x4){eid[8 * q] | (eid[8 * q + 1] << 16), eid[8 * q + 2] | (eid[8 * q + 3] << 16), eid[8 * q + 4] | (eid[8 * q + 5] << 16), eid[8 * q + 6] | (eid[8 * q + 7] << 16)};
    }
    __syncthreads();
  }
}

#define ATT_MISC 131072
DI void attn_item(const Params& p, int layer, int b, int hh, int jq, lchar* sm, float lam, float oml, int tid, int w) {
  const int lane = tid & 63, g = lane >> 4, l15 = lane & 15;
  const int idx32 = (lane ^ 32) << 2;
  LAS float* tab = (LAS float*)(sm + ATT_MISC);
  LAS float* sg = tab + 208;
  __syncthreads();
  if (tid < 208) {
    const int d = tid - 80;
    float tv = -1.0e30f;
    if (d >= 0) {
      int bucket = d;
      if (d >= 16) {
        int lg = 16 + (int)(logf((float)d * (1.0f / 16.0f)) / 2.0794415416798357f * 16.0f);
        bucket = lg < 31 ? lg : 31;
      }
      tv = P_REL_BIAS(p)[bucket * 4 + hh] * LOG2E;
    }
    tab[tid] = tv;
    if (tid < 128) sg[tid] = P_SUBLN_G(p)[layer * 128 + tid] * oml;
  }
  const int q0w = 128 * jq + 16 * w;
  const int qpos = q0w + l15;
  const int qrow = b * LSEQ + (qpos < LSEQ ? qpos : LSEQ - 1);
  bf16x8 qf[2][2];
  {
    const u16* qp = W_PROJ(p) + (size_t)qrow * INC + hh * 128 + g * 8;
#pragma unroll
    for (int m = 0; m < 2; ++m)
#pragma unroll
      for (int ks = 0; ks < 2; ++ks) {
        const u32x4 raw = *(const u32x4*)(qp + m * 64 + ks * 32);
        u32x4 sc;
#pragma unroll
        for (int e = 0; e < 4; ++e) sc[e] = pack2(bflo(raw[e]) * (0.125f * LOG2E), bfhi(raw[e]) * (0.125f * LOG2E));
        qf[m][ks] = __builtin_bit_cast(bf16x8, sc);
      }
  }
  const int nkt = (2 * jq + 2) < 33 ? (2 * jq + 2) : 33;
  const char* ksrc[2]; const char* vsrc[2];
#pragma unroll
  for (int i = 0; i < 2; ++i) {
    const int bk = 2 * w + i, k16 = bk >> 2, m = (bk >> 1) & 1, ks = bk & 1;
    const int krow = 32 * (k16 >> 1) + 8 * (l15 >> 2) + 4 * (k16 & 1) + (l15 & 3);
    ksrc[i] = (const char*)(W_PROJ(p) + (size_t)(b * LSEQ + krow) * INC + 512 + hh * 128 + m * 64 + ks * 32 + g * 8);
    const int dv = 8 * bk + (lane >> 3), c = (lane & 7) ^ ((dv >> 1) & 7);
    vsrc[i] = (const char*)(W_VT(p) + ((size_t)((b * 4 + hh) * 128 + dv)) * LP + c * 8);
  }
  lchar* dmak = sm + (2 * w) * 1024 + lane * 16;
#define ATT_ISSUE(KT, SLOT) do { const size_t _ko = (size_t)(KT) * (64 * INC * 2), _vo = (size_t)(KT) * 128; lchar* _d = dmak + (SLOT) * 32768; \
    __builtin_amdgcn_global_load_lds((const unsigned*)(ksrc[0] + _ko), (LAS unsigned*)(_d), 16, 0, 0); \
    __builtin_amdgcn_global_load_lds((const unsigned*)(ksrc[1] + _ko), (LAS unsigned*)(_d + 1024), 16, 0, 0); \
    __builtin_amdgcn_global_load_lds((const unsigned*)(vsrc[0] + _vo), (LAS unsigned*)(_d + 16384), 16, 0, 0); \
    __builtin_amdgcn_global_load_lds((const unsigned*)(vsrc[1] + _vo), (LAS unsigned*)(_d + 16384 + 1024), 16, 0, 0); } while (0)
  int voff[2];
#pragma unroll
  for (int kk = 0; kk < 2; ++kk) voff[kk] = l15 * 128 + (((4 * kk + g) ^ ((l15 >> 1) & 7)) * 16);

  f32x4 O[2][8];
#pragma unroll
  for (int m = 0; m < 2; ++m)
#pragma unroll
    for (int dt = 0; dt < 8; ++dt) O[m][dt] = (f32x4){0.f, 0.f, 0.f, 0.f};
  float mrun[2] = {0.f, 0.f};
  f32x4 Osum[2] = {(f32x4){0.f, 0.f, 0.f, 0.f}, (f32x4){0.f, 0.f, 0.f, 0.f}};
  bf16x8 ones;
  { const short o1 = (l15 == 0) ? (short)0x3f80 : (short)0; ones = (bf16x8){o1, o1, o1, o1, o1, o1, o1, o1}; }

  WAIT_V(0);
  __syncthreads();
  const float tfar = tab[207];
  ATT_ISSUE(0, 0);
  ATT_ISSUE((1 < nkt ? 1 : nkt - 1), 1);
  for (int kt = 0; kt < nkt; ++kt) {
    { const int kn = (kt + 2 < nkt) ? kt + 2 : nkt - 1; ATT_ISSUE(kn, (kt + 2) & 3); }
    WAIT_V(8); BAR;
    if (64 * kt <= q0w + 15) {
      const lchar* kb = sm + (kt & 3) * 32768;
      const lchar* vb = kb + 16384;
      const bool near = (q0w - 64 * kt) < 176;
      const float tadd = near ? 0.f : tfar;
      const float sinit[2] = {tadd - mrun[0], tadd - mrun[1]};
      f32x4 S[2][4];
#pragma unroll
      for (int kh = 0; kh < 2; ++kh) {
        bf16x8 kf[2][2][2];
#pragma unroll
        for (int q = 0; q < 2; ++q)
#pragma unroll
          for (int m = 0; m < 2; ++m)
#pragma unroll
            for (int ks = 0; ks < 2; ++ks) kf[q][m][ks] = *(const LAS bf16x8*)(kb + ((((2 * kh + q) * 2 + m) * 2 + ks) * 1024) + lane * 16);
        SCHED;
#pragma unroll
        for (int q = 0; q < 2; ++q)
#pragma unroll
          for (int m = 0; m < 2; ++m) {
            f32x4 sacc = (f32x4){sinit[m], sinit[m], sinit[m], sinit[m]};
            sacc = mfma16(kf[q][m][0], qf[m][0], sacc);
            sacc = mfma16(kf[q][m][1], qf[m][1], sacc);
            S[m][2 * kh + q] = sacc;
          }
      }
      if (near) {
#pragma unroll
        for (int m = 0; m < 2; ++m)
#pragma unroll
          for (int k16 = 0; k16 < 4; ++k16)
#pragma unroll
            for (int r = 0; r < 4; ++r) {
              const int di = qpos + 80 - (64 * kt + 32 * (k16 >> 1) + 8 * g + 4 * (k16 & 1) + r);
              S[m][k16][r] += tab[di < 207 ? di : 207];
            }
      }
      bf16x8 pb[2][2];
#pragma unroll
      for (int m = 0; m < 2; ++m) {
        float mx = fmaxf(fmaxf(S[m][0][0], S[m][0][1]), fmaxf(S[m][0][2], S[m][0][3]));
#pragma unroll
        for (int k16 = 1; k16 < 4; ++k16) mx = fmaxf(fmaxf(mx, fmaxf(S[m][k16][0], S[m][k16][1])), fmaxf(S[m][k16][2], S[m][k16][3]));
        mx = fmaxf(mx, shx16(mx));
        mx = fmaxf(mx, shx32(mx, idx32));
        if (kt == 0 || __builtin_amdgcn_ballot_w64(mx > 8.0f) != 0ull) {
          const float dlt = kt == 0 ? mx : fmaxf(mx, 0.f);
          const float alpha = fast_exp2(-dlt);
          mrun[m] += dlt;
#pragma unroll
          for (int dt = 0; dt < 8; ++dt) { O[m][dt][0] *= alpha; O[m][dt][1] *= alpha; O[m][dt][2] *= alpha; O[m][dt][3] *= alpha; }
          Osum[m][0] *= alpha; Osum[m][1] *= alpha; Osum[m][2] *= alpha; Osum[m][3] *= alpha;
#pragma unroll
          for (int k16 = 0; k16 < 4; ++k16)
#pragma unroll
            for (int r = 0; r < 4; ++r) S[m][k16][r] -= dlt;
        }
#pragma unroll
        for (int k16 = 0; k16 < 4; ++k16)
#pragma unroll
          for (int r = 0; r < 4; ++r) S[m][k16][r] = fast_exp2(S[m][k16][r]);
#pragma unroll
        for (int kk = 0; kk < 2; ++kk) {
          u32x4 t;
          t[0] = pack2(S[m][2 * kk][0], S[m][2 * kk][1]); t[1] = pack2(S[m][2 * kk][2], S[m][2 * kk][3]);
          t[2] = pack2(S[m][2 * kk + 1][0], S[m][2 * kk + 1][1]); t[3] = pack2(S[m][2 * kk + 1][2], S[m][2 * kk + 1][3]);
          pb[m][kk] = __builtin_bit_cast(bf16x8, t);
          Osum[m] = mfma16(ones, pb[m][kk], Osum[m]);
        }
      }
#pragma unroll
      for (int kk = 0; kk < 2; ++kk) {
        bf16x8 vf[8];
#pragma unroll
        for (int dt = 0; dt < 8; ++dt) vf[dt] = *(const LAS bf16x8*)(vb + dt * 2048 + voff[kk]);
        SCHED;
#pragma unroll
        for (int dt = 0; dt < 8; ++dt) {
          O[0][dt] = mfma16(vf[dt], pb[0][kk], O[0][dt]);
          O[1][dt] = mfma16(vf[dt], pb[1][kk], O[1][dt]);
        }
      }
    }
  }
  WAIT_V(0);
#undef ATT_ISSUE
  float l0 = g == 0 ? Osum[0][0] : 0.f, l1 = g == 0 ? Osum[1][0] : 0.f;
  l0 += shx16(l0); l0 += shx32(l0, idx32);
  l1 += shx16(l1); l1 += shx32(l1, idx32);
  const float c1 = 1.0f / l0, c2 = lam / l1;
  float ss = 0.f;
#pragma unroll
  for (int dt = 0; dt < 8; ++dt)
#pragma unroll
    for (int r = 0; r < 4; ++r) { const float o = O[0][dt][r] * c1 - O[1][dt][r] * c2; O[0][dt][r] = o; ss += o * o; }
  ss += shx16(ss); ss += shx32(ss, idx32);
  const float rinv = rsqrtf(ss * (1.0f / 128.0f) + 1e-5f);
  if (qpos < LSEQ) {
    u16* dst = W_MIX(p) + (size_t)(b * LSEQ + qpos) * DM + hh * 128 + 4 * g;
#pragma unroll
    for (int dt = 0; dt < 8; ++dt) {
      const int dv0 = 16 * dt + 4 * g;
      u32x2 o;
      o[0] = pack2(O[0][dt][0] * rinv * sg[dv0 + 0], O[0][dt][1] * rinv * sg[dv0 + 1]);
      o[1] = pack2(O[0][dt][2] * rinv * sg[dv0 + 2], O[0][dt][3] * rinv * sg[dv0 + 3]);
      *(u32x2*)(dst + 16 * dt) = o;
    }
  }
}

DI void conv_item(const Params& p, int layer, int item, int tid, int wq) {
  const int ch = (tid & 63) * 8, t0 = item * 16 + 4 * wq;
  const int pos0 = t0 % LSEQ;
  const bool head = pos0 == 0;
  const u16* row0 = W_PROJ(p) + (size_t)t0 * INC;
  u32x4 gc[6], zz[6], gb[4];
#pragma unroll
  for (int j = 0; j < 6; ++j) {
    const u16* r2 = row0 + (ptrdiff_t)((head && j < 2) ? 0 : (j - 2)) * INC;
    gc[j] = *(const u32x4*)(r2 + 2048 + ch); zz[j] = *(const u32x4*)(r2 + 2560 + ch);
  }
#pragma unroll
  for (int i = 0; i < 4; ++i) gb[i] = *(const u32x4*)(row0 + (size_t)i * INC + 1536 + ch);
  const float* cw = P_CONV_W(p) + (size_t)layer * 3 * 512 + ch;
  float w0[8], w1[8], w2[8];
#pragma unroll
  for (int e = 0; e < 8; ++e) { w0[e] = cw[e]; w1[e] = cw[512 + e]; w2[e] = cw[1024 + e]; }
  float pr[6][8];
#pragma unroll
  for (int j = 0; j < 6; ++j) {
    const float keep = (head && j < 2) ? 0.f : 1.f;
#pragma unroll
    for (int e = 0; e < 4; ++e) { pr[j][2 * e] = keep * bflo(gc[j][e]) * bflo(zz[j][e]); pr[j][2 * e + 1] = keep * bfhi(gc[j][e]) * bfhi(zz[j][e]); }
  }
#pragma unroll
  for (int i = 0; i < 4; ++i) {
    u32x4 o;
#pragma unroll
    for (int e = 0; e < 4; ++e) {
      const float a0 = w0[2 * e] * pr[i][2 * e] + w1[2 * e] * pr[i + 1][2 * e] + w2[2 * e] * pr[i + 2][2 * e];
      const float a1 = w0[2 * e + 1] * pr[i][2 * e + 1] + w1[2 * e + 1] * pr[i + 1][2 * e + 1] + w2[2 * e + 1] * pr[i + 2][2 * e + 1];
      o[e] = pack2(bflo(gb[i][e]) * a0, bfhi(gb[i][e]) * a1);
    }
    *(u32x4*)(W_MIX(p) + (size_t)(t0 + i) * DM + 512 + ch) = o;
  }
}

DI void phase_prologue(const Params& p, char* smem, int wave) {
  const int tid = otid_w(wave), lane = tid & 63, wid = wave, hb = wave >> 2, htid = tid & 255;
  const int nblk = gridDim.x, bid = blockIdx.x;
  const size_t gtid = (size_t)bid * NTHREADS + tid, gthreads = (size_t)nblk * NTHREADS;
  float* sm = (float*)(smem + hb * LDS_HALF);
  for (int it0 = bid; it0 < 2048; it0 += nblk) {
    const int it = it0 * 2 + hb;
    if (it < 3072) {
      const int l = it / 768, r = it % 768, kb = r / 48, nb = r % 48;
      transpose_tile(P_W_IN(p) + (size_t)l * 1024 * 3072, 3072, W_WIN(p) + (size_t)l * 3072 * 1024, 1024, kb * 64, nb * 64, sm, htid);
    } else {
      const int i2 = it - 3072, l = i2 / 256, r = i2 % 256, kb = r / 16, nb = r % 16;
      transpose_tile(P_W_OUT(p) + (size_t)l * 1024 * 1024, 1024, W_WOUT(p) + (size_t)l * 1024 * 1024, 1024, kb * 64, nb * 64, sm, htid);
    }
  }
  convert_straight(P_W_Q(p), W_WQB(p), (size_t)4 * 1024 * 2048 / 8, gtid, gthreads);
  convert_straight(P_SUB_KEYS(p), W_SKB(p), (size_t)4 * 16 * 128 * 128 / 8, gtid, gthreads);
  for (int t = bid * 8 + wid; t < TTOK; t += nblk * 8) {
    const int b = t / LSEQ, pos = t - b * LSEQ;
    const float* src = pos < NMETA ? P_META(p) + (size_t)pos * DM : P_X(p) + ((size_t)b * SEQ + pos - NMETA) * DM;
    float v[16];
    load_row_f32<0>(src, v, lane);
    ln_row<0>(v, P_LN_IN_G(p), P_LN_IN_B(p), lane);
    store_row_bf16<0>(W_H(p) + (size_t)t * DM, v, lane);
  }
}

DI void phase_fold(const Params& p, char* smem, int wave) {
  const int tid = otid_w(wave), hb = wave >> 2, htid = tid & 255;
  for (int it0 = blockIdx.x; it0 < 256; it0 += gridDim.x) {
    const int it = it0 * 2 + hb;
    const int l = it >> 7, hp = (it >> 3) & 15, mt = it & 7;
    gemm_tile_fold(W_WQB(p) + (size_t)l * 1024 * 2048 + hp * 128, 2048, W_SKB(p) + ((size_t)l * 16 + hp) * 128 * 128, 128, 128, mt * 128, smem + hb * 65536,
                   W_WSC(p) + (size_t)l * 2048 * 1024 + (size_t)hp * 128 * 1024, htid);
  }
}

DI bool tile_order(int i, int nM, int nN, int& pm, int& pn) {
  const int nwg = nM * nN;
  const long L = (long)i * gridDim.x + blockIdx.x;
  if (L >= nwg) return false;
  int wgid = (int)L;
  { const int q = nwg / 8, r = nwg % 8, xcd = wgid % 8, off = wgid / 8; wgid = (xcd < r ? xcd * (q + 1) : r * (q + 1) + (xcd - r) * q) + off; }
  const int nig = 8 * nN, gid = wgid / nig, fm = gid * 8, gsz = (nM - fm) < 8 ? (nM - fm) : 8;
  pm = fm + ((wgid % nig) % gsz); pn = (wgid % nig) / gsz;
  return true;
}

DI void convert_tables(const Params& p, int layer, int lane, int slot, int nslots) {
  for (int r = slot; r < 2 * PEER_N; r += nslots) {

    const bool isv = r >= PEER_N;
    const int e = isv ? r - PEER_N : r;
    const float* src = (isv ? P_PEER_V(p) : P_PEER_U(p)) + ((size_t)layer * PEER_N + e) * DM + 16 * lane;
    f32x4 a[4];
#pragma unroll
    for (int k = 0; k < 4; ++k) a[k] = *(const f32x4*)(src + 4 * k);
    float am = 0.f;
#pragma unroll
    for (int k = 0; k < 4; ++k) am = fmaxf(am, fmaxf(fmaxf(fabsf(a[k][0]), fabsf(a[k][1])), fmaxf(fabsf(a[k][2]), fabsf(a[k][3]))));
    am = wave_max_nonneg(am);
    const float top = isv ? 224.0f : 127.0f;
    const float sc = am > 0.f ? top / am : 1.0f;
    if (lane == 0) (isv ? W_SV(p) : W_SU(p))[e] = am > 0.f ? am / top : 1.0f;
    u32x4 o;
#pragma unroll
    for (int k = 0; k < 4; ++k) {
      if (isv) {
        int w = 0;
        w = __builtin_amdgcn_cvt_pk_fp8_f32(a[k][0] * sc, a[k][1] * sc, w, false);
        w = __builtin_amdgcn_cvt_pk_fp8_f32(a[k][2] * sc, a[k][3] * sc, w, true);
        o[k] = (unsigned)w;
      } else {
        const int q0 = __float2int_rn(a[k][0] * sc), q1 = __float2int_rn(a[k][1] * sc), q2 = __float2int_rn(a[k][2] * sc), q3 = __float2int_rn(a[k][3] * sc);
        o[k] = ((unsigned)q0 & 255u) | (((unsigned)q1 & 255u) << 8) | (((unsigned)q2 & 255u) << 16) | ((unsigned)q3 << 24);
      }
    }
    *(u32x4*)((isv ? W_VB(p) : W_UB(p)) + (size_t)(lane >> 3) * (PEER_N * 128) + (size_t)e * 128 + 16 * (lane & 7)) = o;
  }
}

DI void phase_gemm(const Params& p, int layer, int which, char* smem, int wave) {
  const int tid0 = otid_w(wave);
  const u16* W = which == 0 ? W_WIN(p) + (size_t)layer * 3072 * 1024 : (which == 1 ? W_WOUT(p) + (size_t)layer * 1024 * 1024 : W_WSC(p) + (size_t)layer * 2048 * 1024);
  const u16* X = which == 1 ? W_MIX(p) : W_H(p);
  const int nN = which == 0 ? 12 : (which == 1 ? 4 : 8);
  int pm, pn;
  for (int i = 0; tile_order(i, 258, nN, pm, pn); ++i) {
    const bool vt = (which == 0) && (pn == 4 || pn == 5);
    const int mode = which == 0 ? (vt ? EPI_VT : EPI_PROJ) : (which == 1 ? EPI_OUT : EPI_TOPK);
    int tid = tid0;
    asm volatile("" : "+v"(tid));
    gemm256_tile(p, mode, layer, vt ? X : W, vt ? W : X, vt ? pm * 256 : pn * 256, vt ? pn * 256 : pm * 256, (lchar*)smem, tid, wave);
  }
  if (which == 1) {
    const int rem = (258 * 4) % (int)gridDim.x, nidle = (int)gridDim.x - rem;
    if ((int)blockIdx.x >= rem) convert_tables(p, layer, tid0 & 63, ((int)blockIdx.x - rem) * 8 + wave, nidle * 8);
  }
}

DI void phase_attn(const Params& p, int layer, char* smem, int wave) {
  const int tid = otid_w(wave), lane = tid & 63, hb = wave >> 2, htid = tid & 255;
  const float lam_init = 0.8f - 0.6f * expf(-0.3f * (float)layer);
  float d1 = P_LQ1(p)[layer * 64 + lane] * P_LK1(p)[layer * 64 + lane], d2 = P_LQ2(p)[layer * 64 + lane] * P_LK2(p)[layer * 64 + lane];
  d1 = wave_sum(d1); d2 = wave_sum(d2);
  const float lam = expf(d1) - expf(d2) + lam_init;
  for (int rd = 0; rd * (int)gridDim.x < 2176; ++rd) {
    const int o = rd * gridDim.x + ((rd & 1) ? (int)gridDim.x - 1 - (int)blockIdx.x : (int)blockIdx.x);
    if (o < 2176) { const int jq = 16 - (o >> 7), bh = o & 127; attn_item(p, layer, bh >> 2, bh & 3, jq, (lchar*)smem, lam, 1.0f - lam_init, tid, wave); }
  }
  for (int it = blockIdx.x; it < 2064; it += gridDim.x) conv_item(p, layer, it * 2 + hb, htid, wave & 3);
}

DI void phase_ln(const Params& p, int layer, int which, int wave) {
  const int tid = otid_w(wave), lane = tid & 63, wid = wave;
  const int stride = gridDim.x * 8;
  const float* lg = (which ? P_LN2_G(p) : P_LN1_G(p)) + layer * DM;
  const float* lb = (which ? P_LN2_B(p) : P_LN1_B(p)) + layer * DM;
  const bool final_out = which && (layer == DEPTH - 1);
  float gg[16], bb[16];
#pragma unroll
  for (int hh = 0; hh < 2; ++hh) {
    const int c = hh * 512 + 8 * lane;
    const f32x4 g0 = *(const f32x4*)(lg + c), g1 = *(const f32x4*)(lg + c + 4), b0 = *(const f32x4*)(lb + c), b1 = *(const f32x4*)(lb + c + 4);
#pragma unroll
    for (int e = 0; e < 4; ++e) { gg[hh * 8 + e] = g0[e]; gg[hh * 8 + 4 + e] = g1[e]; bb[hh * 8 + e] = b0[e]; bb[hh * 8 + 4 + e] = b1[e]; }
  }
  const int t0 = blockIdx.x * 8 + wid;
#define LN_LOAD(T, RA, RB) do { const int _t = (T) < TTOK ? (T) : t0; const u16* _s = W_Y(p) + (size_t)_t * DM + 8 * lane; \
    RA = *(const u32x4*)(_s); RB = *(const u32x4*)(_s + 512); } while (0)
#define LN_ROW(T, RA, RB) do { if ((T) < TTOK) { float v[16]; \
    _Pragma("unroll") for (int e = 0; e < 4; ++e) { v[2 * e] = bflo(RA[e]); v[2 * e + 1] = bfhi(RA[e]); v[8 + 2 * e] = bflo(RB[e]); v[8 + 2 * e + 1] = bfhi(RB[e]); } \
    float sm = 0.f; _Pragma("unroll") for (int i = 0; i < 16; ++i) sm += v[i]; \
    const float mu = wave_sum(sm) * (1.0f / 1024.0f); \
    float q = 0.f; _Pragma("unroll") for (int i = 0; i < 16; ++i) { const float d = v[i] - mu; q += d * d; } \
    const float rstd = rsqrtf(wave_sum(q) * (1.0f / 1024.0f) + 1e-5f); \
    _Pragma("unroll") for (int i = 0; i < 16; ++i) v[i] = (v[i] - mu) * rstd * gg[i] + bb[i]; \
    if (final_out) { const int b = (T) / LSEQ, pos = (T) - b * LSEQ; \
      if (pos >= NMETA) { float* dst = p.out + ((size_t)b * SEQ + pos - NMETA) * DM; \
        _Pragma("unroll") for (int hh = 0; hh < 2; ++hh) { \
          *(f32x4*)(dst + hh * 512 + 8 * lane) = (f32x4){v[hh * 8], v[hh * 8 + 1], v[hh * 8 + 2], v[hh * 8 + 3]}; \
          *(f32x4*)(dst + hh * 512 + 8 * lane + 4) = (f32x4){v[hh * 8 + 4], v[hh * 8 + 5], v[hh * 8 + 6], v[hh * 8 + 7]}; } } \
    } else { store_row_bf16<0>(W_H(p) + (size_t)(T) * DM, v, lane); } } } while (0)
  u32x4 rAa, rAb, rBa, rBb;
  LN_LOAD(t0, rAa, rAb);
  for (int t = t0; t < TTOK; t += 2 * stride) {
    LN_LOAD(t + stride, rBa, rBb);
    LN_ROW(t, rAa, rAb);
    LN_LOAD(t + 2 * stride, rAa, rAb);
    LN_ROW(t + stride, rBa, rBb);
  }
#undef LN_LOAD
#undef LN_ROW
}

#define DPP_F(v, ctrl) __int_as_float(__builtin_amdgcn_update_dpp(0, __float_as_int(v), (ctrl), 0xf, 0xf, true))
#define PEER_META(T, IA, IB, HA, HB) do { const int _t = (T) < TTOK ? (T) : wslot; \
    IA = *(const u32x4*)(W_IDX(p) + (size_t)_t * 128 + r * 16); IB = *(const u32x4*)(W_IDX(p) + (size_t)_t * 128 + r * 16 + 8); \
    const u16* _hp = W_H(p) + (size_t)_t * DM + x * 128 + 16 * c; HA = *(const u32x4*)(_hp); HB = *(const u32x4*)(_hp + 8); } while (0)
DI unsigned row_off(unsigned w, unsigned c16, bool hi) {
  unsigned r; const unsigned m = 128u;
  if (hi) asm("v_mad_u32_u16 %0, %1, %2, %3 op_sel:[1,0,0,0]" : "=v"(r) : "v"(w), "v"(m), "v"(c16));
  else asm("v_mad_u32_u16 %0, %1, %2, %3" : "=v"(r) : "v"(w), "v"(m), "v"(c16));
  return r;
}
#define PEER_GATHER(TAB, IA, IB, RR) do { _Pragma("unroll") for (int g = 0; g < 16; ++g) { \
    const unsigned _w = (g < 8 ? IA : IB)[(g >> 1) & 3]; RR[g] = *(const u32x4*)((TAB) + row_off(_w, c16, (g & 1) != 0)); } } while (0)
#define PEER_UNPACK(XS, HA, HB) do { _Pragma("unroll") for (int e = 0; e < 4; ++e) { \
    XS[e] = (f32x2){bflo(HA[e]), bfhi(HA[e])}; XS[4 + e] = (f32x2){bflo(HB[e]), bfhi(HB[e])}; } } while (0)

#define DPP_I(v, ctrl) __builtin_amdgcn_update_dpp(0, (v), (ctrl), 0xf, 0xf, true)
DI int reduce_scatter8(int d0, int d1, int d2, int d3, int d4, int d5, int d6, int d7, int c) {
  const bool b2 = c >= 4, b1 = (c & 2) != 0, b0 = (c & 1) != 0;
  const int e0 = (b2 ? d4 : d0) + DPP_I(b2 ? d0 : d4, 0x141);
  const int e1 = (b2 ? d5 : d1) + DPP_I(b2 ? d1 : d5, 0x141);
  const int e2 = (b2 ? d6 : d2) + DPP_I(b2 ? d2 : d6, 0x141);
  const int e3 = (b2 ? d7 : d3) + DPP_I(b2 ? d3 : d7, 0x141);
  const int f0 = (b1 ? e2 : e0) + DPP_I(b1 ? e0 : e2, 0x4E);
  const int f1 = (b1 ? e3 : e1) + DPP_I(b1 ? e1 : e3, 0x4E);
  return (b0 ? f1 : f0) + DPP_I(b0 ? f0 : f1, 0xB1);
}
DI void phase_peer_dots(const Params& p, int layer, int wave) {
  const int tid = otid_w(wave), lane = tid & 63, wid = wave, c = lane & 7, r = lane >> 3;
  const int x = blockIdx.x & 7, wslot = (blockIdx.x >> 3) * 8 + wid, nslot = (gridDim.x >> 3) * 8;
  const unsigned char* ub = W_UB(p) + (size_t)x * (PEER_N * 128);
  const unsigned c16 = (unsigned)c * 16u;
  u16* pd = W_Y(p);
  u32x4 iAa, iBa, iAb, iBb;
  u32x4 hAa, hBa, hAb, hBb, rrA[16], rrB[16];
  int xq[4];
  float xscale;
#define DOTS_QUANT(HA, HB) do { float _xv[16]; \
    _Pragma("unroll") for (int e = 0; e < 4; ++e) { _xv[2 * e] = bflo(HA[e]); _xv[2 * e + 1] = bfhi(HA[e]); _xv[8 + 2 * e] = bflo(HB[e]); _xv[8 + 2 * e + 1] = bfhi(HB[e]); } \
    float _am = 0.f; _Pragma("unroll") for (int e = 0; e < 16; ++e) _am = fmaxf(_am, fabsf(_xv[e])); \
    _am = DPP_MAX(_am, 0xB1); _am = DPP_MAX(_am, 0x4E); _am = DPP_MAX(_am, 0x141); \
    const float _qs = _am > 0.f ? 127.0f / _am : 0.f; xscale = _am * (1.0f / 127.0f); \
    _Pragma("unroll") for (int k = 0; k < 4; ++k) { \
      const int q0 = __float2int_rn(_xv[4 * k] * _qs), q1 = __float2int_rn(_xv[4 * k + 1] * _qs), q2 = __float2int_rn(_xv[4 * k + 2] * _qs), q3 = __float2int_rn(_xv[4 * k + 3] * _qs); \
      xq[k] = (int)(((unsigned)q0 & 255u) | (((unsigned)q1 & 255u) << 8) | (((unsigned)q2 & 255u) << 16) | ((unsigned)q3 << 24)); } } while (0)
#define DOTS_COMPUTE(T, RR) do { if ((T) < TTOK) { int dd[16]; \
    _Pragma("unroll") for (int g = 0; g < 16; ++g) { int d = 0; \
      _Pragma("unroll") for (int k = 0; k < 4; ++k) d = __builtin_amdgcn_sdot4((int)RR[g][k], xq[k], d, false); \
      dd[g] = d; } \
    const int pA = reduce_scatter8(dd[0], dd[1], dd[2], dd[3], dd[4], dd[5], dd[6], dd[7], c); \
    const int pB = reduce_scatter8(dd[8], dd[9], dd[10], dd[11], dd[12], dd[13], dd[14], dd[15], c); \
    u16* _dst = pd + ((size_t)(T) * 8 + x) * 128 + r * 16 + c;        \
    _dst[0] = (u16)(pack2((float)pA * xscale, 0.f) & 0xffffu); _dst[8] = (u16)(pack2((float)pB * xscale, 0.f) & 0xffffu); } } while (0)
  int t = wslot;
  PEER_META(t, iAa, iBa, hAa, hBa);
  PEER_META(t + nslot, iAb, iBb, hAb, hBb);
  PEER_GATHER(ub, iAa, iBa, rrA);
  for (; t < TTOK; t += 2 * nslot) {
    DOTS_QUANT(hAa, hBa);
    PEER_META(t + 2 * nslot, iAa, iBa, hAa, hBa);
    PEER_GATHER(ub, iAb, iBb, rrB);
    DOTS_COMPUTE(t, rrA);
    DOTS_QUANT(hAb, hBb);
    PEER_META(t + 3 * nslot, iAb, iBb, hAb, hBb);
    PEER_GATHER(ub, iAa, iBa, rrA);
    DOTS_COMPUTE(t + nslot, rrB);
  }
#undef DOTS_COMPUTE
#undef DOTS_QUANT
}

DI void phase_peer_w(const Params& p, int layer, int wave) {
  const int tid = otid_w(wave), lane = tid & 63, wid = wave;
  const u16* pd = W_Y(p);
  const int stride = gridDim.x * 8, t0 = blockIdx.x * 8 + wid;
  for (int t = t0; t < TTOK; t += 2 * stride) {
    unsigned pv[2][8], iv[2];
    f32x2 gv[2];
#pragma unroll
    for (int u = 0; u < 2; ++u) {
      const int tu = (t + u * stride) < TTOK ? (t + u * stride) : t0;
#pragma unroll
      for (int xx = 0; xx < 8; ++xx) pv[u][xx] = *(const unsigned*)(pd + ((size_t)tu * 8 + xx) * 128 + 2 * lane);
      iv[u] = *(const unsigned*)(W_IDX(p) + (size_t)tu * 128 + 2 * lane);
      gv[u] = *(const f32x2*)(W_G(p) + (size_t)tu * 128 + 2 * lane);
    }
#pragma unroll
    for (int u = 0; u < 2; ++u) {
      const int tu = t + u * stride;
      if (tu < TTOK) {
        float s0 = 0.f, s1 = 0.f;
#pragma unroll
        for (int xx = 0; xx < 8; ++xx) { s0 += bflo(pv[u][xx]); s1 += bfhi(pv[u][xx]); }
        const int e0 = (int)(iv[u] & 0xffffu), e1 = (int)(iv[u] >> 16);
        const float a0 = s0 * W_SU(p)[e0], a1 = s1 * W_SU(p)[e1];
        const float w0 = gv[u][0] * (0.5f * a0 * (1.0f + erff(a0 * 0.7071067811865476f))) * W_SV(p)[e0];
        const float w1 = gv[u][1] * (0.5f * a1 * (1.0f + erff(a1 * 0.7071067811865476f))) * W_SV(p)[e1];
        *(unsigned*)(W_W16(p) + (size_t)tu * 128 + 2 * lane) = pack2(w0, w1);
      }
    }
  }
}

#define PEER_META_V(T, IA, IB, WA, WB, HR) do { const int _t = (T) < TTOK ? (T) : wslot; \
    IA = *(const u32x4*)(W_IDX(p) + (size_t)_t * 128 + r * 16); IB = *(const u32x4*)(W_IDX(p) + (size_t)_t * 128 + r * 16 + 8); \
    WA = *(const u32x4*)(W_W16(p) + (size_t)_t * 128 + r * 16); WB = *(const u32x4*)(W_W16(p) + (size_t)_t * 128 + r * 16 + 8); \
    HR = *(const u32x2*)(W_H(p) + (size_t)_t * DM + ocol); } while (0)
DI float swap32_add(float a, float b) {
  const u32x2 r = __builtin_amdgcn_permlane32_swap(__float_as_uint(a), __float_as_uint(b), false, false);
  return __uint_as_float(r[0]) + __uint_as_float(r[1]);
}
DI float swap16_add(float a, float b) {
  const u32x2 r = __builtin_amdgcn_permlane16_swap(__float_as_uint(a), __float_as_uint(b), false, false);
  return __uint_as_float(r[0]) + __uint_as_float(r[1]);
}
DI void phase_peer_v(const Params& p, int layer, int wave) {
  const int tid = otid_w(wave), lane = tid & 63, wid = wave, c = lane & 7, r = lane >> 3;
  const int x = blockIdx.x & 7, wslot = (blockIdx.x >> 3) * 8 + wid, nslot = (gridDim.x >> 3) * 8;
  const unsigned char* vb = W_VB(p) + (size_t)x * (PEER_N * 128);
  const unsigned c16 = (unsigned)c * 16u;
  u16* y2 = W_Y(p);
  const int ocol = x * 128 + 16 * c + 4 * ((lane >> 4) & 1) + 8 * (lane >> 5);
  u32x4 iAa, iBa, iAb, iBb;
  u32x4 wAa, wBa, wAb, wBb, wA, wB;
  u32x2 hRa, hRb, hR;
  u32x4 rrA[16], rrB[16];
#define V_COMPUTE(T, RR) do { if ((T) < TTOK) { f32x2 acc[8]; \
    _Pragma("unroll") for (int i = 0; i < 8; ++i) acc[i] = (f32x2){0.f, 0.f}; \
    _Pragma("unroll") for (int g = 0; g < 16; ++g) { \
      const unsigned _ww = (g < 8 ? wA : wB)[(g >> 1) & 3]; const float wj = (g & 1) ? bfhi(_ww) : bflo(_ww); \
      const f32x2 wj2 = (f32x2){wj, wj}; \
      _Pragma("unroll") for (int k = 0; k < 4; ++k) { \
        const f32x2 lo = __builtin_amdgcn_cvt_pk_f32_fp8((int)RR[g][k], false), hi = __builtin_amdgcn_cvt_pk_f32_fp8((int)RR[g][k], true); \
        acc[2 * k] += wj2 * lo; acc[2 * k + 1] += wj2 * hi; } } \
    float P8[8], Q4[4]; \
    _Pragma("unroll") for (int i = 0; i < 8; ++i) P8[i] = swap32_add(acc[i >> 1][i & 1], acc[(i + 8) >> 1][i & 1]);     \
    _Pragma("unroll") for (int i = 0; i < 4; ++i) Q4[i] = swap16_add(P8[i], P8[i + 4]);                                 \
    _Pragma("unroll") for (int i = 0; i < 4; ++i) Q4[i] += DPP_F(Q4[i], 0x128);                                         \
    if ((lane & 8) == 0) { u32x2 _o; \
      _o[0] = pack2(ALPHA * bflo(hR[0]) + Q4[0], ALPHA * bfhi(hR[0]) + Q4[1]); \
      _o[1] = pack2(ALPHA * bflo(hR[1]) + Q4[2], ALPHA * bfhi(hR[1]) + Q4[3]); \
      *(u32x2*)(y2 + (size_t)(T) * DM + ocol) = _o; } } } while (0)
  int t = wslot;
  PEER_META_V(t, iAa, iBa, wAa, wBa, hRa);
  PEER_META_V(t + nslot, iAb, iBb, wAb, wBb, hRb);
  PEER_GATHER(vb, iAa, iBa, rrA);
  for (; t < TTOK; t += 2 * nslot) {
    wA = wAa; wB = wBa; hR = hRa;
    PEER_META_V(t + 2 * nslot, iAa, iBa, wAa, wBa, hRa);
    PEER_GATHER(vb, iAb, iBb, rrB);
    V_COMPUTE(t, rrA);
    wA = wAb; wB = wBb; hR = hRb;
    PEER_META_V(t + 3 * nslot, iAb, iBb, wAb, wBb, hRb);
    PEER_GATHER(vb, iAa, iBa, rrA);
    V_COMPUTE(t + nslot, rrB);
  }
#undef V_COMPUTE
}

#define XB_TMO      128
#define XB_XCNT(j)  (256  + 64 * (j))
#define XB_XSUB(j)  (1280 + 64 * (j))
#define XB_XGEN(j)  (2304 + 64 * (j))
#define XB_TOP      3328
#define XB_TOPGEN   3392
#define XCD_BAR_WORDS 3456
#define XB_SPIN_CAP (1u << 22)
DI unsigned xb_ld(unsigned* p)              { return __hip_atomic_load(p, __ATOMIC_RELAXED, __HIP_MEMORY_SCOPE_AGENT); }
DI unsigned xb_add(unsigned* p, unsigned v) { return __hip_atomic_fetch_add(p, v, __ATOMIC_RELAXED, __HIP_MEMORY_SCOPE_AGENT); }
DI unsigned xb_xcc_id() { return (unsigned)__builtin_amdgcn_s_getreg((3 << 11) | 20) & 0xFu; }
#define XB_SPIN(cond, bar) do { unsigned _sp = 0; while (cond) { __builtin_amdgcn_s_sleep(1); \
    if ((++_sp & 255u) == 0u) { if (xb_ld(&(bar)[XB_TMO])) break; if (_sp > XB_SPIN_CAP) { atomicAdd(&(bar)[XB_TMO], 1u); break; } } } } while (0)
DI bool is_thread0(int wave) { unsigned z = 0u; asm volatile("" : "+v"(z)); return wave == 0 && __builtin_amdgcn_mbcnt_hi(~0u, __builtin_amdgcn_mbcnt_lo(~0u, z)) == 0u; }
DI void xcd_barrier_complete(unsigned* bar, unsigned x, unsigned& nloc, unsigned& nx) {
  const unsigned G = gridDim.x;
  unsigned sum, cnt, mine, sp = 0u;
  for (;;) {
    sum = 0u; cnt = 0u; mine = 0u;
#pragma unroll
    for (unsigned j = 0; j < 16; ++j) { const unsigned c = xb_ld(&bar[XB_XCNT(j)]); sum += c; cnt += (c > 0u) ? 1u : 0u; mine = (j == x) ? c : mine; }
    if (sum == G) break;
    __builtin_amdgcn_s_sleep(1);
    if ((++sp & 255u) == 0u) { if (xb_ld(&bar[XB_TMO])) break; if (sp > XB_SPIN_CAP) { atomicAdd(&bar[XB_TMO], 1u); break; } }
  }
  nloc = mine > 0u ? mine : 1u; nx = cnt > 0u ? cnt : 1u;
}
DI void xcd_barrier(unsigned* bar, volatile LAS unsigned* st, int wave) {
  asm volatile("s_waitcnt vmcnt(0)" ::: "memory");
  __syncthreads();
  if (is_thread0(wave)) {
    const unsigned x = xb_xcc_id();
    __builtin_amdgcn_s_waitcnt(0);
    unsigned nloc = st[0], nx = st[1];
    if (nloc == 0u) { xcd_barrier_complete(bar, x, nloc, nx); st[0] = nloc; st[1] = nx; }
    const unsigned old = xb_add(&bar[XB_XSUB(x)], 1u);
    const unsigned gen = old / nloc;
    if (old + 1u == (gen + 1u) * nloc) {
      __builtin_amdgcn_fence(__ATOMIC_RELEASE, "agent");
      asm volatile("s_waitcnt vmcnt(0)" ::: "memory");
      const unsigned og = xb_add(&bar[XB_TOP], 1u);
      const unsigned tg = og / nx;
      if (og + 1u == (tg + 1u) * nx) xb_add(&bar[XB_TOPGEN], 1u);
      else XB_SPIN(xb_ld(&bar[XB_TOPGEN]) == tg, bar);
      __builtin_amdgcn_fence(__ATOMIC_ACQUIRE, "agent");
      xb_add(&bar[XB_XGEN(x)], 1u);
      asm volatile("s_waitcnt vmcnt(0)" ::: "memory");
    } else {
      XB_SPIN(xb_ld(&bar[XB_XGEN(x)]) == gen, bar);
      __builtin_amdgcn_fence(__ATOMIC_ACQUIRE, "agent");
      asm volatile("s_waitcnt vmcnt(0)" ::: "memory");
    }
  }
  __syncthreads();
}

__global__ void __launch_bounds__(NTHREADS, 2) mega(Params p) {
  extern __shared__ __attribute__((aligned(16))) char smem[];
  cg::grid_group grid = cg::this_grid();
  const int wave = __builtin_amdgcn_readfirstlane((int)(threadIdx.x >> 6));
  unsigned* bar = (unsigned*)(p.ws + WS_BAR);
  volatile LAS unsigned* st = (volatile LAS unsigned*)((lchar*)smem + LDS_XB);
  if (threadIdx.x == 0) { st[0] = 0u; st[1] = 0u; (void)xb_add(&bar[XB_XCNT(xb_xcc_id())], 1u); }
  __syncthreads();
  phase_prologue(p, smem, wave);
  grid.sync();
  phase_fold(p, smem, wave);
  xcd_barrier(bar, st, wave);
#pragma unroll 1
  for (int step = 0; step < DEPTH * 9; ++step) {
    const int layer = step / 9, ph = step - layer * 9;
    if (ph == 0 || ph == 2 || ph == 4) phase_gemm(p, layer, ph >> 1, smem, wave);
    else if (ph == 1) phase_attn(p, layer, smem, wave);
    else if (ph == 3 || ph == 8) phase_ln(p, layer, ph == 8, wave);
    else if (ph == 5) phase_peer_dots(p, layer, wave);
    else if (ph == 6) phase_peer_w(p, layer, wave);
    else phase_peer_v(p, layer, wave);
    if (step + 1 < DEPTH * 9) xcd_barrier(bar, st, wave);
  }
}

extern "C" void kernel_launch(void* const* d_in, const int* in_sizes, int n_in, void* d_out, int out_size, void* d_ws, size_t ws_size,
                              hipStream_t stream) {
  static int grid_blocks = 0;
  if (grid_blocks == 0) {
    if (ws_size < WS_END) { fprintf(stderr, "kernel_launch: workspace too small: need %zu, got %zu\n", (size_t)WS_END, ws_size); grid_blocks = -1; return; }
    int dev = 0, cus = 0, per_cu = 0;
    hipGetDevice(&dev);
    hipDeviceGetAttribute(&cus, hipDeviceAttributeMultiprocessorCount, dev);
    hipFuncSetAttribute((const void*)mega, hipFuncAttributeMaxDynamicSharedMemorySize, LDS_BYTES);
    hipOccupancyMaxActiveBlocksPerMultiprocessor(&per_cu, (const void*)mega, NTHREADS, LDS_BYTES);
    if (per_cu < 1) per_cu = 1;
    if (per_cu > 1) per_cu = 1;
    grid_blocks = cus * per_cu;
  }
  if (grid_blocks < 0) return;
  Params p{};
  for (int i = 0; i < 21; ++i) p.in[i] = (const float*)d_in[i];
  p.out = (float*)d_out;
  p.ws = (char*)d_ws;
  if (hipMemsetAsync((char*)d_ws + WS_BAR, 0, 16384, stream) != hipSuccess) { fprintf(stderr, "kernel_launch: memset of the barrier words failed\n"); return; }
  void* args[] = {&p};
  hipError_t e = hipLaunchCooperativeKernel((const void*)mega, dim3(grid_blocks), dim3(NTHREADS), args, LDS_BYTES, stream);
  if (e != hipSuccess) fprintf(stderr, "cooperative launch failed: %s (grid %d)\n", hipGetErrorString(e), grid_blocks);
}
```
